# Optimizing an MI355X kernel written in HIP

```python
import jax, jax.numpy as jnp
from jax import lax
import numpy as np

D_MODEL = 2048
BATCH = 2
SEQ = 8192
DEPTH = 1

HEAD_DIM = 128
ROPE_DIM = HEAD_DIM // 4
ROPE_THETA = 500000.0
NORM_EPS = 1e-6
Q_BLOCK = 128

A_HEADS = 8
A_Q_RANK = 512
A_KV_RANK = 256
A_ROPE = ROPE_DIM
A_NOPE = HEAD_DIM - ROPE_DIM
A_V_DIM = HEAD_DIM
IDX_HEADS = 8
IDX_DIM = 64
IDX_ROPE = IDX_DIM // 4
IDX_TOPK_MAX = 256

B_HEADS = 8
B_GROUPS = 2
B_HPG = B_HEADS // B_GROUPS
CMP_LEN = 32
CMP_STRIDE = 16
CMP_HIDDEN = 256
SLC_LEN = 64
SLC_TOPN = 16
WINDOW = 512

N_EXPERTS = 32
TOP_K = 4
D_FF = D_MODEL
SWIGLU_ALPHA = 1.702
SWIGLU_LIMIT = 7.0
EXPERT_BLOCK = 256

IN_SIZES = (A_Q_RANK, A_KV_RANK, A_ROPE, IDX_DIM, IDX_HEADS,
            B_HEADS * HEAD_DIM, 6 * B_GROUPS * HEAD_DIM, 3 * B_HEADS, 2 * D_MODEL)
IN_COLS = sum(IN_SIZES)

kernel_name = 'hybrid_dsa_nsa_moe_block'


def rms_norm(x, g):
    xf = x.astype(jnp.float32)
    y = xf * lax.rsqrt(jnp.mean(xf * xf, axis=-1, keepdims=True) + NORM_EPS)
    return (y * g.astype(jnp.float32)).astype(x.dtype)


def layer_norm(x, g, b):
    xf = x.astype(jnp.float32)
    xc = xf - jnp.mean(xf, axis=-1, keepdims=True)
    y = xc * lax.rsqrt(jnp.mean(xc * xc, axis=-1, keepdims=True) + NORM_EPS)
    return (y * g.astype(jnp.float32) + b.astype(jnp.float32)).astype(x.dtype)


def rope_tables(positions, rot_dim):
    inv = jnp.power(ROPE_THETA, -jnp.arange(0, rot_dim, 2, dtype=jnp.float32) / rot_dim)
    ang = positions.astype(jnp.float32)[..., None] * inv
    return jnp.cos(ang), jnp.sin(ang)


def apply_partial_rope(x, cos, sin, rot_dim):
    extra = x.ndim - cos.ndim
    shape = cos.shape[:2] + (1,) * extra + cos.shape[2:]
    c = cos.reshape(shape).astype(x.dtype)
    s = sin.reshape(shape).astype(x.dtype)
    half = rot_dim // 2
    x1, x2, xp = x[..., :half], x[..., half:rot_dim], x[..., rot_dim:]
    return jnp.concatenate([x1 * c - x2 * s, x2 * c + x1 * s, xp], axis=-1)


def masked_softmax(s, mask):
    s = jnp.where(mask, s.astype(jnp.float32), -jnp.inf)
    m = jnp.max(s, axis=-1, keepdims=True)
    m = jnp.where(jnp.isfinite(m), m, 0.0)
    e = jnp.where(mask, jnp.exp(s - m), 0.0)
    return e / jnp.maximum(jnp.sum(e, axis=-1, keepdims=True), 1e-30)


def to_blocks(a):
    b, t = a.shape[:2]
    return jnp.moveaxis(a.reshape((b, t // Q_BLOCK, Q_BLOCK) + a.shape[2:]), 1, 0)


def from_blocks(a):
    a = jnp.moveaxis(a, 0, 1)
    return a.reshape((a.shape[0], a.shape[1] * a.shape[2]) + a.shape[3:])


def split_cols(z, sizes):
    offs = np.cumsum((0,) + tuple(sizes))
    return [z[..., int(offs[i]):int(offs[i + 1])] for i in range(len(sizes))]


def gather_rows(tbl, idx):
    return jax.vmap(lambda t, i: t[i])(tbl, idx)


def dsa_mixer(cq, ckv, krope, kidx, widx, cos_h, sin_h, cos_i, sin_i,
              a_cq_norm, a_ckv_norm, a_w_uq, a_w_uk, a_w_uv,
              idx_w_q, idx_k_norm_g, idx_k_norm_b):
    b, t = cq.shape[:2]
    topk = min(IDX_TOPK_MAX, t // 4)
    cq = rms_norm(cq, a_cq_norm)
    ckv = rms_norm(ckv, a_ckv_norm)
    q = jnp.einsum('btr,rhd->bthd', cq, a_w_uq)
    q_rope = apply_partial_rope(q[..., :A_ROPE], cos_h, sin_h, A_ROPE)
    q_abs = jnp.einsum('bthn,rhn->bthr', q[..., A_ROPE:], a_w_uk)
    k_rope = apply_partial_rope(krope, cos_h, sin_h, A_ROPE)
    q_idx = apply_partial_rope(jnp.einsum('btr,rhd->bthd', cq, idx_w_q), cos_i, sin_i, IDX_ROPE)
    k_idx = apply_partial_rope(layer_norm(kidx, idx_k_norm_g, idx_k_norm_b), cos_i, sin_i, IDX_ROPE)
    w_idx = widx * IDX_HEADS ** -0.5
    key_pos = jnp.arange(t)
    scale = HEAD_DIM ** -0.5

    def block(xs):
        qi, wi, qa, qr, tq = xs
        logits = jnp.einsum('bqhd,bsd->bqhs', qi, k_idx).astype(jnp.float32) * IDX_DIM ** -0.5
        score = jnp.einsum('bqh,bqhs->bqs', wi.astype(jnp.float32), jax.nn.relu(logits))
        causal = key_pos[None, :] <= tq[:, None]
        score = jnp.where(causal[None], score, -jnp.inf)
        _, sel = lax.top_k(score, topk)
        valid = sel <= tq[None, :, None]
        ckv_sel = gather_rows(ckv, sel)
        kr_sel = gather_rows(k_rope, sel)
        s = (jnp.einsum('bqhr,bqkr->bqhk', qa, ckv_sel)
             + jnp.einsum('bqhd,bqkd->bqhk', qr, kr_sel)) * scale
        p = masked_softmax(s, valid[:, :, None, :])
        return jnp.einsum('bqhk,bqkr->bqhr', p.astype(ckv_sel.dtype), ckv_sel)

    xs = (to_blocks(q_idx), to_blocks(w_idx), to_blocks(q_abs), to_blocks(q_rope),
          jnp.arange(t).reshape(t // Q_BLOCK, Q_BLOCK))
    o_lat = from_blocks(lax.map(block, xs))
    o = jnp.einsum('bthr,hrv->bthv', o_lat, a_w_uv)
    return o.reshape(b, t, A_HEADS * A_V_DIM)


def compress_blocks(tok, idx_cmp, pe, w1, w2):
    blocks = tok[:, idx_cmp] + pe[:, None, :]
    b, n, l, g, d = blocks.shape
    flat = jnp.moveaxis(blocks, 2, 3).reshape(b, n, g, l * d)
    return jax.nn.gelu(flat @ w1) @ w2


def nsa_mixer(q, kv, gates, cos_h, sin_h,
              cmp_k_pe, cmp_k_w1, cmp_k_w2, cmp_v_pe, cmp_v_w1, cmp_v_w2):
    b, t = q.shape[:2]
    n_cmp = (t - CMP_LEN) // CMP_STRIDE + 1
    n_slc = t // SLC_LEN
    n_sel = min(SLC_TOPN, n_slc)
    scale = HEAD_DIM ** -0.5
    k_c, v_c, k_s, v_s, k_w, v_w = [kv[:, :, i] for i in range(6)]
    q = apply_partial_rope(q, cos_h, sin_h, ROPE_DIM).reshape(b, t, B_GROUPS, B_HPG, HEAD_DIM)
    k_c = apply_partial_rope(k_c, cos_h, sin_h, ROPE_DIM)
    k_s = apply_partial_rope(k_s, cos_h, sin_h, ROPE_DIM)
    k_w = apply_partial_rope(k_w, cos_h, sin_h, ROPE_DIM)
    cmp_start = jnp.arange(n_cmp) * CMP_STRIDE
    cmp_end = cmp_start + CMP_LEN - 1
    idx_cmp = cmp_start[:, None] + jnp.arange(CMP_LEN)[None, :]
    kc = compress_blocks(k_c, idx_cmp, cmp_k_pe, cmp_k_w1, cmp_k_w2)
    vc = compress_blocks(v_c, idx_cmp, cmp_v_pe, cmp_v_w1, cmp_v_w2)
    slc_start = jnp.arange(n_slc) * SLC_LEN
    overlap = ((cmp_start[:, None] < slc_start[None, :] + SLC_LEN)
               & (cmp_end[:, None] >= slc_start[None, :])).astype(jnp.float32)
    ks_blk = jnp.moveaxis(k_s.reshape(b, n_slc, SLC_LEN, B_GROUPS, HEAD_DIM), 3, 1)
    vs_blk = jnp.moveaxis(v_s.reshape(b, n_slc, SLC_LEN, B_GROUPS, HEAD_DIM), 3, 1)
    pad = ((0, 0), (WINDOW, 0), (0, 0), (0, 0))
    kw_pad = jnp.pad(k_w, pad)
    vw_pad = jnp.pad(v_w, pad)
    blk_ids = jnp.arange(n_slc)
    win_off = jnp.arange(WINDOW + Q_BLOCK) - WINDOW
    gather_blocks = jax.vmap(jax.vmap(lambda tbl, idx: tbl[idx]))

    def block(xs):
        qb, gb, tq, q0 = xs
        sc = jnp.einsum('bqgjd,bngd->bqgjn', qb, kc) * scale
        cmask = cmp_end[None, :] <= tq[:, None]
        pc = masked_softmax(sc, cmask[None, :, None, None, :])
        oc = jnp.einsum('bqgjn,bngd->bqgjd', pc.astype(vc.dtype), vc)
        imp = jnp.einsum('bqgjn,nm->bqgm', pc, overlap)
        cur = tq // SLC_LEN
        forced = ((blk_ids[None, :] == 0) | (blk_ids[None, :] == cur[:, None])
                  | (blk_ids[None, :] == cur[:, None] - 1))
        adm = blk_ids[None, :] * SLC_LEN <= tq[:, None]
        imp = jnp.where(forced[None, :, None, :], jnp.inf, imp)
        imp = jnp.where(adm[None, :, None, :], imp, -jnp.inf)
        _, sel = lax.top_k(imp, n_sel)
        sel_t = jnp.transpose(sel, (0, 2, 1, 3))
        ks_g = gather_blocks(ks_blk, sel_t)
        vs_g = gather_blocks(vs_blk, sel_t)
        kpos = sel_t[..., None] * SLC_LEN + jnp.arange(SLC_LEN)
        smask = jnp.transpose(kpos <= tq[None, None, :, None, None], (0, 2, 1, 3, 4))
        smask = smask.reshape(b, Q_BLOCK, B_GROUPS, 1, n_sel * SLC_LEN)
        ss = jnp.einsum('bqgjd,bgqnsd->bqgjns', qb, ks_g) * scale
        ss = ss.reshape(b, Q_BLOCK, B_GROUPS, B_HPG, n_sel * SLC_LEN)
        ps = masked_softmax(ss, smask)
        os_ = jnp.einsum('bqgjk,bgqkd->bqgjd', ps.astype(vs_g.dtype),
                         vs_g.reshape(b, B_GROUPS, Q_BLOCK, n_sel * SLC_LEN, HEAD_DIM))
        kw_b = lax.dynamic_slice_in_dim(kw_pad, q0, WINDOW + Q_BLOCK, axis=1)
        vw_b = lax.dynamic_slice_in_dim(vw_pad, q0, WINDOW + Q_BLOCK, axis=1)
        wpos = q0 + win_off
        wmask = ((wpos[None, :] <= tq[:, None]) & (wpos[None, :] > tq[:, None] - WINDOW)
                 & (wpos[None, :] >= 0))
        sw = jnp.einsum('bqgjd,bsgd->bqgjs', qb, kw_b) * scale
        pw = masked_softmax(sw, wmask[None, :, None, None, :])
        ow = jnp.einsum('bqgjs,bsgd->bqgjd', pw.astype(vw_b.dtype), vw_b)
        g = gb.reshape(b, Q_BLOCK, B_GROUPS, B_HPG, 3)
        return g[..., 0:1] * oc + g[..., 1:2] * os_ + g[..., 2:3] * ow

    nb = t // Q_BLOCK
    xs = (to_blocks(q), to_blocks(gates), jnp.arange(t).reshape(nb, Q_BLOCK),
          jnp.arange(nb) * Q_BLOCK)
    o = from_blocks(lax.map(block, xs))
    return o.reshape(b, t, B_HEADS * HEAD_DIM)


def moe_ffn(h, w_router, b_router, w_gate_up, b_gate_up, w_down, b_down):
    b, t, d = h.shape
    n = b * t
    hf = h.reshape(n, d)
    logits = (hf @ w_router + b_router).astype(jnp.float32)
    top_val, top_idx = lax.top_k(logits, TOP_K)
    gates = jax.nn.softmax(top_val, axis=-1)
    nk = n * TOP_K
    e_flat = top_idx.reshape(nk)
    tok_flat = jnp.repeat(jnp.arange(n, dtype=jnp.int32), TOP_K)
    w_flat = gates.reshape(nk)
    order = jnp.argsort(e_flat)
    e_s, tok_s, w_s = e_flat[order], tok_flat[order], w_flat[order]
    counts = jnp.bincount(e_flat, length=N_EXPERTS)
    starts = jnp.cumsum(counts) - counts
    padded = (counts + EXPERT_BLOCK - 1) // EXPERT_BLOCK * EXPERT_BLOCK
    pend = jnp.cumsum(padded)
    pstart = pend - padded
    dest = pstart[e_s] + jnp.arange(nk) - starts[e_s]
    n_blocks = -(-nk // EXPERT_BLOCK) + N_EXPERTS
    p_rows = n_blocks * EXPERT_BLOCK
    pad_tok = jnp.full((p_rows,), n, jnp.int32).at[dest].set(tok_s)
    pad_w = jnp.zeros((p_rows,), jnp.float32).at[dest].set(w_s)
    blk_expert = jnp.minimum(
        jnp.searchsorted(pend, jnp.arange(n_blocks) * EXPERT_BLOCK, side='right'), N_EXPERTS - 1)
    x_src = jnp.concatenate([hf, jnp.zeros((1, d), hf.dtype)], axis=0)

    def expert_block(xs):
        tok, wt, e = xs
        xb = x_src[tok]
        gu = xb @ w_gate_up[e] + b_gate_up[e]
        gate, up = jnp.split(gu, 2, axis=-1)
        gate = jnp.minimum(gate, SWIGLU_LIMIT)
        up = jnp.clip(up, -SWIGLU_LIMIT, SWIGLU_LIMIT)
        act = gate * jax.nn.sigmoid(SWIGLU_ALPHA * gate) * (up + 1.0)
        y = act @ w_down[e] + b_down[e]
        return y * wt[:, None].astype(y.dtype)

    ys = lax.map(expert_block, (pad_tok.reshape(n_blocks, EXPERT_BLOCK),
                                pad_w.reshape(n_blocks, EXPERT_BLOCK), blk_expert))
    out = jax.ops.segment_sum(ys.reshape(p_rows, d), pad_tok, num_segments=n + 1)[:n]
    return out.reshape(b, t, d)


def setup_inputs(seed: int = 0) -> dict:
    key = jax.random.key(seed)
    ks = jax.random.split(key, 34)

    def nrm(k, shape, scale):
        return jax.random.normal(k, shape, jnp.float32) * scale

    D = D_MODEL
    positions = (jax.random.randint(ks[2], (BATCH, 1), 0, 4096)
                 + jnp.arange(SEQ)[None, :]).astype(jnp.int32)
    return {
        'x': nrm(ks[0], (BATCH, SEQ, D), 1.0),
        'c': nrm(ks[1], (BATCH, D), 1.0),
        'positions': positions,
        'w_ada': nrm(ks[3], (D, 6 * D), 0.5 * D ** -0.5),
        'b_ada': nrm(ks[4], (6 * D,), 0.02),
        'g_pre_mix': 1.0 + nrm(ks[5], (D,), 0.05),
        'g_post_mix': 1.0 + nrm(ks[6], (D,), 0.05),
        'g_pre_ffn': 1.0 + nrm(ks[7], (D,), 0.05),
        'g_post_ffn': 1.0 + nrm(ks[8], (D,), 0.05),
        'w_in': nrm(ks[9], (D, IN_COLS), D ** -0.5),
        'a_cq_norm': 1.0 + nrm(ks[10], (A_Q_RANK,), 0.05),
        'a_ckv_norm': 1.0 + nrm(ks[11], (A_KV_RANK,), 0.05),
        'a_w_uq': nrm(ks[12], (A_Q_RANK, A_HEADS, HEAD_DIM), A_Q_RANK ** -0.5),
        'a_w_uk': nrm(ks[13], (A_KV_RANK, A_HEADS, A_NOPE), A_KV_RANK ** -0.5),
        'a_w_uv': nrm(ks[14], (A_HEADS, A_KV_RANK, A_V_DIM), A_KV_RANK ** -0.5),
        'idx_w_q': nrm(ks[15], (A_Q_RANK, IDX_HEADS, IDX_DIM), A_Q_RANK ** -0.5),
        'idx_k_norm_g': 1.0 + nrm(ks[16], (IDX_DIM,), 0.05),
        'idx_k_norm_b': nrm(ks[17], (IDX_DIM,), 0.02),
        'cmp_k_pe': nrm(ks[18], (CMP_LEN, HEAD_DIM), 0.1),
        'cmp_k_w1': nrm(ks[19], (CMP_LEN * HEAD_DIM, CMP_HIDDEN), (CMP_LEN * HEAD_DIM) ** -0.5),
        'cmp_k_w2': nrm(ks[20], (CMP_HIDDEN, HEAD_DIM), CMP_HIDDEN ** -0.5),
        'cmp_v_pe': nrm(ks[21], (CMP_LEN, HEAD_DIM), 0.1),
        'cmp_v_w1': nrm(ks[22], (CMP_LEN * HEAD_DIM, CMP_HIDDEN), (CMP_LEN * HEAD_DIM) ** -0.5),
        'cmp_v_w2': nrm(ks[23], (CMP_HIDDEN, HEAD_DIM), CMP_HIDDEN ** -0.5),
        'w_br_a': nrm(ks[24], (A_HEADS * A_V_DIM, D), (A_HEADS * A_V_DIM) ** -0.5),
        'w_br_b': nrm(ks[25], (B_HEADS * HEAD_DIM, D), (B_HEADS * HEAD_DIM) ** -0.5),
        'w_out': nrm(ks[26], (D, D), D ** -0.5),
        'w_router': nrm(ks[27], (D, N_EXPERTS), D ** -0.5),
        'b_router': nrm(ks[28], (N_EXPERTS,), 0.01),
        'w_gate_up': nrm(ks[29], (N_EXPERTS, D, 2 * D_FF), D ** -0.5),
        'b_gate_up': nrm(ks[30], (N_EXPERTS, 2 * D_FF), 0.01),
        'w_down': nrm(ks[31], (N_EXPERTS, D_FF, D), D_FF ** -0.5),
        'b_down': nrm(ks[32], (N_EXPERTS, D), 0.01),
    }


def reference(x, c, positions, w_ada, b_ada, g_pre_mix, g_post_mix, g_pre_ffn, g_post_ffn,
              w_in, a_cq_norm, a_ckv_norm, a_w_uq, a_w_uk, a_w_uv,
              idx_w_q, idx_k_norm_g, idx_k_norm_b,
              cmp_k_pe, cmp_k_w1, cmp_k_w2, cmp_v_pe, cmp_v_w1, cmp_v_w2,
              w_br_a, w_br_b, w_out,
              w_router, b_router, w_gate_up, b_gate_up, w_down, b_down):
    b, t, _ = x.shape
    cos_h, sin_h = rope_tables(positions, ROPE_DIM)
    cos_i, sin_i = rope_tables(positions, IDX_ROPE)
    for _ in range(DEPTH):
        mod = (jax.nn.silu(c) @ w_ada + b_ada)[:, None, :]
        sh1, sc1, gt1, sh2, sc2, gt2 = jnp.split(mod, 6, axis=-1)
        h = rms_norm(x, g_pre_mix) * (1.0 + sc1) + sh1
        z = h @ w_in
        cq, ckv, krope, kidx, widx, bq, bkv, bgate, mgate = split_cols(z, IN_SIZES)
        o_a = dsa_mixer(cq, ckv, krope, kidx, widx, cos_h, sin_h, cos_i, sin_i,
                        a_cq_norm, a_ckv_norm, a_w_uq, a_w_uk, a_w_uv,
                        idx_w_q, idx_k_norm_g, idx_k_norm_b)
        o_b = nsa_mixer(bq.reshape(b, t, B_HEADS, HEAD_DIM),
                        bkv.reshape(b, t, 6, B_GROUPS, HEAD_DIM),
                        jax.nn.sigmoid(bgate).reshape(b, t, B_HEADS, 3),
                        cos_h, sin_h, cmp_k_pe, cmp_k_w1, cmp_k_w2,
                        cmp_v_pe, cmp_v_w1, cmp_v_w2)
        g_a, g_b = jnp.split(jax.nn.sigmoid(mgate), 2, axis=-1)
        merged = g_a * (o_a @ w_br_a) + g_b * (o_b @ w_br_b)
        x = x + gt1 * rms_norm(merged @ w_out, g_post_mix)
        h = rms_norm(x, g_pre_ffn) * (1.0 + sc2) + sh2
        y = moe_ffn(h, w_router, b_router, w_gate_up, b_gate_up, w_down, b_down)
        x = x + gt2 * rms_norm(y, g_post_ffn)
    return x
```

```cpp
#include <hip/hip_runtime.h>
#include <stdint.h>
#include <stdio.h>

#define LAS __attribute__((address_space(3)))
#define DI __device__ __forceinline__
typedef unsigned short bf16_t;
typedef short bf16x8 __attribute__((ext_vector_type(8)));
typedef float f32x4 __attribute__((ext_vector_type(4)));
typedef unsigned u32x4 __attribute__((ext_vector_type(4)));
typedef unsigned u32x2 __attribute__((ext_vector_type(2)));

#define PREP_PROBE_WC 0
#define PREP_PROBE_MODE 0
#define PREP_PROBE_NFAST 0
constexpr int NB = 2, T = 8192, NT = NB * T, D = 2048;
constexpr int ZC = 7680;
constexpr int ZC_CKV = 512, ZC_KROPE = 768, ZC_KIDX = 800, ZC_WIDX = 864, ZC_BGATE = 872, ZC_BQ = 1024, ZC_MG = 3584;
constexpr int QC = 2816;
constexpr int KVW = 288;
constexpr int NEXP = 32, SLOTS = 73728, MAXMT = SLOTS / 256;
constexpr float NORM_EPS = 1e-6f;
constexpr float ATT_SCALE = 0.08838834764831845f;
constexpr int LDS_BYTES = 152 * 1024;

constexpr size_t al256(size_t x) { return (x + 255) & ~(size_t)255; }
constexpr size_t ZERO_BYTES = 131072;
constexpr size_t O_MODACC = 16384, O_CNT = 114688;
constexpr size_t O_ROPE = ZERO_BYTES;
constexpr size_t O_WIN = O_ROPE + al256((size_t)NT * 48 * 4);
constexpr size_t O_WQ = O_WIN + al256((size_t)ZC * D * 2);
constexpr size_t O_WO = O_WQ + al256((size_t)QC * 512 * 2);
constexpr size_t O_WBRB = O_WO + al256((size_t)D * D * 2);
constexpr size_t O_WOUT = O_WBRB + al256((size_t)D * 1024 * 2);
constexpr size_t O_WC1 = O_WOUT + al256((size_t)D * D * 2);
constexpr size_t O_CBIAS = O_WC1 + al256((size_t)2 * 256 * 4096 * 2);
constexpr size_t O_CBP = O_CBIAS + al256(2 * 256 * 4);
constexpr size_t O_WRT = O_CBP + al256(64 * 2 * 256 * 4);
constexpr size_t O_WGU = O_WRT + al256((size_t)256 * D * 2);
constexpr size_t O_WDN = O_WGU + al256((size_t)NEXP * 4096 * D * 2);
constexpr size_t O_H = O_WDN + al256((size_t)NEXP * D * D * 2);
constexpr size_t O_Z = O_H + al256((size_t)NT * D * 2);
constexpr size_t O_CQN = O_Z + al256((size_t)NT * ZC * 2);
constexpr size_t O_KVT = O_CQN + al256((size_t)NT * 512 * 2);
constexpr size_t O_KIDX = O_KVT + al256((size_t)NT * KVW * 2);
constexpr size_t O_WIDX = O_KIDX + al256((size_t)NT * 64 * 2);
constexpr size_t O_GATES = O_WIDX + al256((size_t)NT * 8 * 4);
constexpr size_t O_BQ = O_GATES + al256((size_t)NT * 24 * 4);
constexpr size_t KVS_ONE = (size_t)NB * 2 * T * 128;
constexpr size_t O_KVS = O_BQ + al256((size_t)NT * 1024 * 2);
constexpr size_t O_QALL = O_KVS + al256(6 * KVS_ONE * 2 + 65536);
constexpr size_t O_C1P = O_QALL + al256((size_t)NT * QC * 2);
constexpr size_t O_KCVC = O_C1P + al256((size_t)16 * 2 * 2048 * 256 * 4);
constexpr size_t O_SEL = O_KCVC + al256((size_t)2 * 2048 * 128 * 2);
constexpr size_t O_NSEL = O_SEL + al256((size_t)NT * 256 * 2);
constexpr size_t O_OLAT = O_NSEL + al256((size_t)NT * 4);
constexpr size_t O_OB = O_OLAT + al256((size_t)NT * D * 2);
constexpr size_t O_MERGED = O_OB + al256((size_t)NT * 1024 * 2);
constexpr size_t O_MO = O_MERGED + al256((size_t)NT * D * 2);
constexpr size_t O_X1 = O_MO + al256((size_t)NT * D * 2);
constexpr size_t O_TOPI = O_X1 + al256((size_t)NT * D * 4);
constexpr size_t O_TOPW = O_TOPI + al256((size_t)NT * 4 * 4);
constexpr size_t O_TSLOT = O_TOPW + al256((size_t)NT * 4 * 4);
constexpr size_t O_SLOTW = O_TSLOT + al256((size_t)NT * 4 * 4);
constexpr size_t O_HS = O_SLOTW + al256((size_t)SLOTS * 4);
constexpr size_t O_ACT = O_HS + al256((size_t)SLOTS * D);
constexpr size_t O_YS = O_ACT + al256((size_t)SLOTS * D);
constexpr size_t O_OB8 = O_YS + al256((size_t)SLOTS * D * 2);
constexpr size_t O_MG8 = O_OB8 + al256((size_t)NT * 1024);
constexpr size_t O_WIN8 = O_MG8 + al256((size_t)NT * D);
constexpr size_t O_H8 = O_WIN8 + al256((size_t)ZC * D);
constexpr size_t WS_END = O_H8 + al256((size_t)NT * D);

struct Params {
    const float* x; const float* c; const int* pos; const float* w_ada; const float* b_ada;
    const float* g_pre_mix; const float* g_post_mix; const float* g_pre_ffn; const float* g_post_ffn;
    const float* w_in; const float* a_cq_norm; const float* a_ckv_norm; const float* a_w_uq; const float* a_w_uk; const float* a_w_uv;
    const float* idx_w_q; const float* idx_g; const float* idx_b;
    const float* cmp_k_pe; const float* cmp_k_w1; const float* cmp_k_w2; const float* cmp_v_pe; const float* cmp_v_w1; const float* cmp_v_w2;
    const float* w_br_a; const float* w_br_b; const float* w_out; const float* w_router; const float* b_router;
    const float* w_gate_up; const float* b_gate_up; const float* w_down; const float* b_down;
    float* out; char* ws;
};

DI int tid_fresh() { int t = threadIdx.x; asm volatile("" : "+v"(t)); return t; }
DI float bf2f(bf16_t v) { return __uint_as_float((unsigned)v << 16); }
DI float bflo(unsigned w) { return __uint_as_float(w << 16); }
DI float bfhi(unsigned w) { return __uint_as_float(w & 0xffff0000u); }
DI bf16_t f2bf(float f) { unsigned u = __float_as_uint(f); u += 0x7FFFu + ((u >> 16) & 1u); return (bf16_t)(u >> 16); }
DI unsigned pk2(float lo, float hi) { unsigned r; asm volatile("v_cvt_pk_bf16_f32 %0, %1, %2" : "=v"(r) : "v"(lo), "v"(hi)); return r; }
DI float wave_sum(float v) {
#pragma unroll
    for (int o = 1; o < 64; o <<= 1) v += __shfl_xor(v, o);
    return v;
}
DI float wave_max(float v) {
#pragma unroll
    for (int o = 1; o < 64; o <<= 1) v = fmaxf(v, __shfl_xor(v, o));
    return v;
}
DI float sigmoidf_(float v) { return 1.f / (1.f + __expf(-v)); }
DI void unpack8(const u32x4& w, float (&f)[8]) {
    f[0] = bflo(w[0]); f[1] = bfhi(w[0]); f[2] = bflo(w[1]); f[3] = bfhi(w[1]); f[4] = bflo(w[2]); f[5] = bfhi(w[2]); f[6] = bflo(w[3]); f[7] = bfhi(w[3]);
}
DI float mod_at(const Params& p, int b, int j) { return ((const float*)(p.ws + O_MODACC))[b * 12288 + j]; }

#define XB_TMO      128
#define XB_XCNT(j)  (256  + 64 * (j))
#define XB_XSUB(j)  (1280 + 64 * (j))
#define XB_XGEN(j)  (2304 + 64 * (j))
#define XB_TOP      3328
#define XB_TOPGEN   3392
#define XCD_BAR_WORDS 3456
#define XB_SPIN_CAP (1u << 22)
DI unsigned xb_ld(unsigned* p)              { return __hip_atomic_load(p, __ATOMIC_RELAXED, __HIP_MEMORY_SCOPE_AGENT); }
DI unsigned xb_add(unsigned* p, unsigned v) { return __hip_atomic_fetch_add(p, v, __ATOMIC_RELAXED, __HIP_MEMORY_SCOPE_AGENT); }
DI unsigned xb_xcc_id() { return (unsigned)__builtin_amdgcn_s_getreg((3 << 11) | 20) & 0xFu; }
#define XB_SPIN(cond, bar) do { unsigned _sp = 0; while (cond) { __builtin_amdgcn_s_sleep(1); \
    if ((++_sp & 255u) == 0u) { if (xb_ld(&(bar)[XB_TMO])) break; if (_sp > XB_SPIN_CAP) { atomicAdd(&(bar)[XB_TMO], 1u); break; } } } } while (0)
struct XcdBarrier { unsigned* bar; unsigned x; volatile LAS unsigned* st; };
DI XcdBarrier xcd_barrier_post(unsigned* bar, volatile LAS unsigned* st) {
    XcdBarrier b; b.bar = bar; b.x = xb_xcc_id(); b.st = st;
    if (threadIdx.x == 0) (void)xb_add(&bar[XB_XCNT(b.x)], 1u);
    return b;
}
DI void xcd_barrier_complete(unsigned* bar, unsigned x, unsigned& nloc, unsigned& nx) {
    const unsigned G = gridDim.x * gridDim.y * gridDim.z;
    unsigned sum, cnt, mine, sp = 0u;
    for (;;) {
        sum = 0u; cnt = 0u; mine = 0u;
#pragma unroll
        for (unsigned j = 0; j < 16; ++j) { const unsigned c = xb_ld(&bar[XB_XCNT(j)]); sum += c; cnt += (c > 0u) ? 1u : 0u; mine = (j == x) ? c : mine; }
        if (sum == G) break;
        __builtin_amdgcn_s_sleep(1);
        if ((++sp & 255u) == 0u) { if (xb_ld(&bar[XB_TMO])) break; if (sp > XB_SPIN_CAP) { atomicAdd(&bar[XB_TMO], 1u); break; } }
    }
    nloc = mine > 0u ? mine : 1u; nx = cnt > 0u ? cnt : 1u;
}
DI void xcd_barrier(const XcdBarrier& b) {
    asm volatile("s_waitcnt vmcnt(0)" ::: "memory");
    __syncthreads();
    if (threadIdx.x == 0) {
        unsigned* bar = b.bar;
        __builtin_amdgcn_s_waitcnt(0);
        unsigned nloc = b.st[0], nx = b.st[1];
        if (nloc == 0u) { xcd_barrier_complete(bar, b.x, nloc, nx); b.st[0] = nloc; b.st[1] = nx; }
        const unsigned old = xb_add(&bar[XB_XSUB(b.x)], 1u);
        const unsigned gen = old / nloc;
        if (old + 1u == (gen + 1u) * nloc) {
            __builtin_amdgcn_fence(__ATOMIC_RELEASE, "agent");
            asm volatile("s_waitcnt vmcnt(0)" ::: "memory");
            const unsigned og = xb_add(&bar[XB_TOP], 1u);
            const unsigned tg = og / nx;
            if (og + 1u == (tg + 1u) * nx) xb_add(&bar[XB_TOPGEN], 1u);
            else XB_SPIN(xb_ld(&bar[XB_TOPGEN]) == tg, bar);
            __builtin_amdgcn_fence(__ATOMIC_ACQUIRE, "agent");
            xb_add(&bar[XB_XGEN(b.x)], 1u);
            asm volatile("s_waitcnt vmcnt(0)" ::: "memory");
        } else {
            XB_SPIN(xb_ld(&bar[XB_XGEN(b.x)]) == gen, bar);
            __builtin_amdgcn_fence(__ATOMIC_ACQUIRE, "agent");
            asm volatile("s_waitcnt vmcnt(0)" ::: "memory");
        }
    }
    __syncthreads();
}

namespace pg8 {
constexpr int BM = 256, BK = 64, HALF = 128, HTB = HALF * BK * 2, STAGE_BYTES = 8 * HTB, NXCD = 8, WGM = 8;
DI int lds_byte(int r, int c) { const int st = (r >> 4) * 2 + (c >> 5), rr = r & 15, cc = c & 31, ob = rr * 64 + cc * 2; return st * 1024 + (ob ^ (((ob >> 9) & 1) << 5)); }
DI void stage_rc(int b, int& R, int& C) { const int st = b / 1024, sb = b % 1024, swz = sb ^ (((sb >> 9) & 1) << 5); R = (st >> 1) * 16 + swz / 64; C = (st & 1) * 32 + (swz % 64) / 2; }
DI int perm32(int rho) { const int n = rho >> 4, i = rho & 15; return 8 * (i >> 2) + 4 * n + (i & 3); }

struct Unit { int pm, pn, e; const char* a; const char* b; };
struct Gemm { int lda, ldb, K; };

struct PlainSched {
    int nM, nN, nwg, G, c; const char* A; const char* Bt; size_t a_tile, b_tile;
    DI void init(int M, int N, int G_, int c_, const void* A_, int lda, const void* Bt_, int ldb) {
        nM = M / BM; nN = N / BM; nwg = nM * nN; G = G_; c = c_; A = (const char*)A_; Bt = (const char*)Bt_; a_tile = (size_t)BM * lda * 2; b_tile = (size_t)BM * ldb * 2; }
    DI bool next(int i, Unit& u) const {
        const long L = (long)i * G + c; if (L >= nwg) return false;
        int wgid = (int)L; { const int q = nwg / NXCD, r = nwg % NXCD, xcd = wgid % NXCD, off = wgid / NXCD; wgid = (xcd < r ? xcd * (q + 1) : r * (q + 1) + (xcd - r) * q) + off; }
        const int nig = WGM * nN, gid = wgid / nig, fm = gid * WGM, gsz = (nM - fm) < WGM ? (nM - fm) : WGM;
        u.pm = fm + ((wgid % nig) % gsz); u.pn = (wgid % nig) / gsz; u.e = 0;
        u.a = A + (size_t)u.pm * a_tile; u.b = Bt + (size_t)u.pn * b_tile; return true;
    }
};

typedef int v4i_t __attribute__((ext_vector_type(4)));
typedef int v8i_t __attribute__((ext_vector_type(8)));
#ifndef PG8_SP2
#define PG8_SP2 true
#endif
template <class Epi, class Sched, bool SP2 = PG8_SP2>
DI void gemm_phase(LAS unsigned char* lds, const Gemm g, const Sched& S, const Epi& E) {
    const int tid = tid_fresh(), wid = __builtin_amdgcn_readfirstlane(tid >> 6), lane = tid & 63, wr = wid >> 2, wc = wid & 3, fr = lane & 15, fq = lane >> 4;
    const int K = g.K, nt = K / BK;
    unsigned voffA[2], voffB[2];
#pragma unroll
    for (int i = 0; i < 2; ++i) { int R, C; stage_rc(tid * 16 + i * 8192, R, C); const int Rb = Epi::PERM ? ((R & ~31) + perm32(R & 31)) : R;
        voffA[i] = (unsigned)(R * g.lda + C) * 2u; voffB[i] = (unsigned)(Rb * g.ldb + C) * 2u; }
    const size_t kstep = (size_t)(BK * 2);
    const size_t hstepA = (size_t)HALF * g.lda * 2, hstepB = (size_t)HALF * g.ldb * 2;
    const unsigned ldsw = (unsigned)wid * 1024u;
    const int aoff = lds_byte(wr * 64 + fr, fq * 8), boff = lds_byte(wc * 32 + fr, fq * 8);
#define PG8_SA(b, h) (((b) * 2 + (h)) * HTB)
#define PG8_SB(b, h) ((4 + (b) * 2 + (h)) * HTB)
#define PG8_STAGE(bufoff, gbase, voff) do { _Pragma("unroll") for (int _i = 0; _i < 2; ++_i) \
        __builtin_amdgcn_global_load_lds((const unsigned*)((const char*)(gbase) + (voff)[_i]), (LAS unsigned*)(lds + (bufoff) + ldsw + _i * 8192), 16, 0, 0); } while (0)
#define PG8_LDA(dst, b, h) do { _Pragma("unroll") for (int m = 0; m < 4; ++m) _Pragma("unroll") for (int k = 0; k < 2; ++k) dst[m][k] = *(const LAS bf16x8*)(lds + PG8_SA(b, h) + aoff + m * 2048 + k * 1024); } while (0)
#define PG8_LDB(dst, b, h) do { _Pragma("unroll") for (int n = 0; n < 2; ++n) _Pragma("unroll") for (int k = 0; k < 2; ++k) dst[n][k] = *(const LAS bf16x8*)(lds + PG8_SB(b, h) + boff + n * 2048 + k * 1024); } while (0)
#define PG8_MMA(ai, bj, At, Bt) do { __builtin_amdgcn_s_setprio(1); _Pragma("unroll") for (int m = 0; m < 4; ++m) _Pragma("unroll") for (int n = 0; n < 2; ++n) _Pragma("unroll") for (int k = 0; k < 2; ++k) \
        acc[ai][bj][m][n] = __builtin_amdgcn_mfma_f32_16x16x32_bf16(Bt[n][k], At[m][k], acc[ai][bj][m][n], 0, 0, 0); __builtin_amdgcn_s_setprio(0); } while (0)
#define PG8_WAIT_V(n) asm volatile("s_waitcnt vmcnt(" #n ")" ::: "memory")
#define PG8_WAIT_L(n) asm volatile("s_waitcnt lgkmcnt(" #n ")" ::: "memory")
#define PG8_BAR __builtin_amdgcn_s_barrier()
#define PG8_SCHED __builtin_amdgcn_sched_barrier(0)
    Unit cur, nxt; int ui = 0;
    if (!S.next(0, cur)) return;
    f32x4 acc[2][2][4][2];
#pragma unroll
    for (int a = 0; a < 2; ++a)
#pragma unroll
        for (int b = 0; b < 2; ++b)
#pragma unroll
            for (int m = 0; m < 4; ++m)
#pragma unroll
                for (int n = 0; n < 2; ++n) acc[a][b][m][n] = (f32x4){0.f, 0.f, 0.f, 0.f};
    bf16x8 At[4][2], B0[2][2], B1[2][2];
    const char* cA = cur.a; const char* cB = cur.b;
    if constexpr (SP2) {
        PG8_STAGE(PG8_SB(0, 0), cB, voffB); PG8_STAGE(PG8_SB(0, 1), cB + hstepB, voffB); PG8_STAGE(PG8_SA(0, 0), cA, voffA); PG8_STAGE(PG8_SA(0, 1), cA + hstepA, voffA);
        if (wr == 1) PG8_BAR;
        PG8_WAIT_V(2); PG8_BAR;
        PG8_STAGE(PG8_SB(1, 0), cB + kstep, voffB); PG8_STAGE(PG8_SA(1, 0), cA + kstep, voffA); PG8_STAGE(PG8_SB(1, 1), cB + hstepB + kstep, voffB);
        PG8_WAIT_V(6); PG8_BAR;
    } else {
        PG8_STAGE(PG8_SB(0, 0), cB, voffB); PG8_STAGE(PG8_SA(0, 0), cA, voffA); PG8_STAGE(PG8_SB(0, 1), cB + hstepB, voffB); PG8_STAGE(PG8_SA(0, 1), cA + hstepA, voffA);
        if (wr == 1) PG8_BAR;
        PG8_WAIT_V(4); PG8_BAR;
        PG8_STAGE(PG8_SB(1, 0), cB + kstep, voffB); PG8_STAGE(PG8_SA(1, 0), cA + kstep, voffA); PG8_STAGE(PG8_SB(1, 1), cB + hstepB + kstep, voffB);
        PG8_WAIT_V(6); PG8_BAR;
    }
    for (;;) {
        const bool has_next = S.next(ui + 1, nxt);
        const char* nA = has_next ? nxt.a : cA; const char* nB = has_next ? nxt.b : cB;
        for (int t = 0; t < nt; t += 2) {
            const bool last = (t == nt - 2);
            const char* a1 = cA + (size_t)(t + 1) * kstep;
            const char* a2 = last ? nA : cA + (size_t)(t + 2) * kstep; const char* b2 = last ? nB : cB + (size_t)(t + 2) * kstep;
            const char* a3 = a2 + kstep; const char* b3 = b2 + kstep;
            if constexpr (SP2) {
            PG8_LDB(B0, 0, 0); PG8_LDB(B1, 0, 1); PG8_SCHED; PG8_LDA(At, 0, 0); PG8_STAGE(PG8_SA(1, 1), a1 + hstepA, voffA);
            PG8_WAIT_V(8); PG8_WAIT_L(0); PG8_BAR; PG8_MMA(0, 0, At, B0); PG8_MMA(0, 1, At, B1); PG8_BAR; PG8_SCHED;
            PG8_LDA(At, 0, 1); PG8_STAGE(PG8_SB(0, 0), b2, voffB); PG8_STAGE(PG8_SB(0, 1), b2 + hstepB, voffB); PG8_STAGE(PG8_SA(0, 0), a2, voffA);
            PG8_WAIT_V(8); PG8_WAIT_L(0); PG8_BAR; PG8_MMA(1, 0, At, B0); PG8_MMA(1, 1, At, B1); PG8_BAR; PG8_SCHED;
            PG8_LDB(B0, 1, 0); PG8_LDB(B1, 1, 1); PG8_SCHED; PG8_LDA(At, 1, 0); PG8_STAGE(PG8_SA(0, 1), a2 + hstepA, voffA);
            PG8_WAIT_V(8); PG8_WAIT_L(0); PG8_BAR; PG8_MMA(0, 0, At, B0); PG8_MMA(0, 1, At, B1); PG8_BAR; PG8_SCHED;
            PG8_LDA(At, 1, 1); PG8_STAGE(PG8_SB(1, 0), b3, voffB); PG8_STAGE(PG8_SB(1, 1), b3 + hstepB, voffB); PG8_STAGE(PG8_SA(1, 0), a3, voffA);
            PG8_WAIT_V(8); PG8_WAIT_L(0); PG8_BAR; PG8_MMA(1, 0, At, B0); PG8_MMA(1, 1, At, B1); PG8_BAR; PG8_SCHED;
            } else {
            PG8_LDB(B0, 0, 0); PG8_SCHED; PG8_LDA(At, 0, 0); PG8_STAGE(PG8_SA(1, 1), a1 + hstepA, voffA);
            PG8_WAIT_L(8); PG8_BAR; PG8_WAIT_L(0); PG8_MMA(0, 0, At, B0); PG8_BAR; PG8_SCHED;
            PG8_LDB(B1, 0, 1); PG8_STAGE(PG8_SB(0, 0), b2, voffB);
            PG8_BAR; PG8_WAIT_L(0); PG8_MMA(0, 1, At, B1); PG8_BAR;
            PG8_LDA(At, 0, 1); PG8_STAGE(PG8_SA(0, 0), a2, voffA);
            PG8_BAR; PG8_WAIT_L(0); PG8_MMA(1, 0, At, B0); PG8_BAR; PG8_SCHED;
            PG8_STAGE(PG8_SB(0, 1), b2 + hstepB, voffB);
            PG8_WAIT_V(6); PG8_BAR; PG8_MMA(1, 1, At, B1); PG8_BAR;
            PG8_LDB(B0, 1, 0); PG8_SCHED; PG8_LDA(At, 1, 0); PG8_STAGE(PG8_SA(0, 1), a2 + hstepA, voffA);
            PG8_WAIT_L(8); PG8_BAR; PG8_WAIT_L(0); PG8_MMA(0, 0, At, B0); PG8_BAR; PG8_SCHED;
            PG8_LDB(B1, 1, 1); PG8_STAGE(PG8_SB(1, 0), b3, voffB);
            PG8_BAR; PG8_WAIT_L(0); PG8_MMA(0, 1, At, B1); PG8_BAR;
            PG8_LDA(At, 1, 1); PG8_STAGE(PG8_SA(1, 0), a3, voffA);
            PG8_BAR; PG8_WAIT_L(0); PG8_MMA(1, 0, At, B0); PG8_BAR; PG8_SCHED;
            PG8_STAGE(PG8_SB(1, 1), b3 + hstepB, voffB);
            PG8_WAIT_V(6); PG8_BAR; PG8_MMA(1, 1, At, B1); PG8_BAR;
            }
        }
        E(acc, cur, wr, wc, fr, fq);
        if (!has_next) break;
#pragma unroll
        for (int a = 0; a < 2; ++a)
#pragma unroll
            for (int b = 0; b < 2; ++b)
#pragma unroll
                for (int m = 0; m < 4; ++m)
#pragma unroll
                    for (int n = 0; n < 2; ++n) acc[a][b][m][n] = (f32x4){0.f, 0.f, 0.f, 0.f};
        cur = nxt; cA = nA; cB = nB; ++ui;
    }
    PG8_WAIT_V(0);
    if (wr == 0) PG8_BAR;
    PG8_BAR;
#undef PG8_SA
#undef PG8_SB
#undef PG8_STAGE
#undef PG8_LDA
#undef PG8_LDB
#undef PG8_MMA
#undef PG8_WAIT_V
#undef PG8_WAIT_L
#undef PG8_BAR
#undef PG8_SCHED
}

template <class Epi, class Sched, bool SP2 = PG8_SP2>
DI void gemm_phase_fp8(LAS unsigned char* lds, const Gemm g, const Sched& S, const Epi& E) {
    const int tid = tid_fresh(), wid = __builtin_amdgcn_readfirstlane(tid >> 6), lane = tid & 63, wr = wid >> 2, wc = wid & 3, fr = lane & 15, fq = lane >> 4;
    const int K = g.K, nt = K / BK;
    unsigned voffA[2], voffB[2];
#pragma unroll
    for (int i = 0; i < 2; ++i) { int R, C; stage_rc(tid * 16 + i * 8192, R, C); const int Rb = Epi::PERM ? ((R & ~31) + perm32(R & 31)) : R;
        voffA[i] = (unsigned)(R * g.lda + C) * 2u; voffB[i] = (unsigned)(Rb * g.ldb + C) * 2u; }
    const size_t kstep = (size_t)(BK * 2);
    const size_t hstepA = (size_t)HALF * g.lda * 2, hstepB = (size_t)HALF * g.ldb * 2;
    const unsigned ldsw = (unsigned)wid * 1024u;
    const int aoff = lds_byte(wr * 64 + fr, fq * 8), boff = lds_byte(wc * 32 + fr, fq * 8);
#define PG8_SA(b, h) (((b) * 2 + (h)) * HTB)
#define PG8_SB(b, h) ((4 + (b) * 2 + (h)) * HTB)
#define PG8_STAGE(bufoff, gbase, voff) do { _Pragma("unroll") for (int _i = 0; _i < 2; ++_i) \
        __builtin_amdgcn_global_load_lds((const unsigned*)((const char*)(gbase) + (voff)[_i]), (LAS unsigned*)(lds + (bufoff) + ldsw + _i * 8192), 16, 0, 0); } while (0)
#define PG8_LDA(dst, b, h) do { _Pragma("unroll") for (int m = 0; m < 4; ++m) { const v4i_t lo_ = *(const LAS v4i_t*)(lds + PG8_SA(b, h) + aoff + m * 2048), hi_ = *(const LAS v4i_t*)(lds + PG8_SA(b, h) + aoff + m * 2048 + 1024); dst[m] = __builtin_shufflevector(lo_, hi_, 0, 1, 2, 3, 4, 5, 6, 7); } } while (0)
#define PG8_LDB(dst, b, h) do { _Pragma("unroll") for (int n = 0; n < 2; ++n) { const v4i_t lo_ = *(const LAS v4i_t*)(lds + PG8_SB(b, h) + boff + n * 2048), hi_ = *(const LAS v4i_t*)(lds + PG8_SB(b, h) + boff + n * 2048 + 1024); dst[n] = __builtin_shufflevector(lo_, hi_, 0, 1, 2, 3, 4, 5, 6, 7); } } while (0)
#define PG8_MMA(ai, bj, At, Bt) do { __builtin_amdgcn_s_setprio(1); _Pragma("unroll") for (int m = 0; m < 4; ++m) _Pragma("unroll") for (int n = 0; n < 2; ++n) \
        asm volatile("v_mfma_scale_f32_16x16x128_f8f6f4 %0, %1, %2, %0, %3, %3 op_sel_hi:[0,0,0]" : "+v"(acc[ai][bj][m][n]) : "v"(Bt[n]), "v"(At[m]), "v"(sc127)); __builtin_amdgcn_s_setprio(0); } while (0)
#define PG8_WAIT_V(n) asm volatile("s_waitcnt vmcnt(" #n ")" ::: "memory")
#define PG8_WAIT_L(n) asm volatile("s_waitcnt lgkmcnt(" #n ")" ::: "memory")
#define PG8_BAR __builtin_amdgcn_s_barrier()
#define PG8_SCHED __builtin_amdgcn_sched_barrier(0)
    Unit cur, nxt; int ui = 0;
    if (!S.next(0, cur)) return;
    f32x4 acc[2][2][4][2];
#pragma unroll
    for (int a = 0; a < 2; ++a)
#pragma unroll
        for (int b = 0; b < 2; ++b)
#pragma unroll
            for (int m = 0; m < 4; ++m)
#pragma unroll
                for (int n = 0; n < 2; ++n) acc[a][b][m][n] = (f32x4){0.f, 0.f, 0.f, 0.f};
    v8i_t At[4], B0[2], B1[2];
    int sc127 = 127; asm volatile("" : "+v"(sc127));
    const char* cA = cur.a; const char* cB = cur.b;
    if constexpr (SP2) {
        PG8_STAGE(PG8_SB(0, 0), cB, voffB); PG8_STAGE(PG8_SB(0, 1), cB + hstepB, voffB); PG8_STAGE(PG8_SA(0, 0), cA, voffA); PG8_STAGE(PG8_SA(0, 1), cA + hstepA, voffA);
        if (wr == 1) PG8_BAR;
        PG8_WAIT_V(2); PG8_BAR;
        PG8_STAGE(PG8_SB(1, 0), cB + kstep, voffB); PG8_STAGE(PG8_SA(1, 0), cA + kstep, voffA); PG8_STAGE(PG8_SB(1, 1), cB + hstepB + kstep, voffB);
        PG8_WAIT_V(6); PG8_BAR;
    } else {
        PG8_STAGE(PG8_SB(0, 0), cB, voffB); PG8_STAGE(PG8_SA(0, 0), cA, voffA); PG8_STAGE(PG8_SB(0, 1), cB + hstepB, voffB); PG8_STAGE(PG8_SA(0, 1), cA + hstepA, voffA);
        if (wr == 1) PG8_BAR;
        PG8_WAIT_V(4); PG8_BAR;
        PG8_STAGE(PG8_SB(1, 0), cB + kstep, voffB); PG8_STAGE(PG8_SA(1, 0), cA + kstep, voffA); PG8_STAGE(PG8_SB(1, 1), cB + hstepB + kstep, voffB);
        PG8_WAIT_V(6); PG8_BAR;
    }
    for (;;) {
        const bool has_next = S.next(ui + 1, nxt);
        const char* nA = has_next ? nxt.a : cA; const char* nB = has_next ? nxt.b : cB;
        for (int t = 0; t < nt; t += 2) {
            const bool last = (t == nt - 2);
            const char* a1 = cA + (size_t)(t + 1) * kstep;
            const char* a2 = last ? nA : cA + (size_t)(t + 2) * kstep; const char* b2 = last ? nB : cB + (size_t)(t + 2) * kstep;
            const char* a3 = a2 + kstep; const char* b3 = b2 + kstep;
            if constexpr (SP2) {
            PG8_LDB(B0, 0, 0); PG8_LDB(B1, 0, 1); PG8_SCHED; PG8_LDA(At, 0, 0); PG8_STAGE(PG8_SA(1, 1), a1 + hstepA, voffA);
            PG8_WAIT_V(8); PG8_WAIT_L(0); PG8_BAR; PG8_MMA(0, 0, At, B0); PG8_MMA(0, 1, At, B1); PG8_BAR; PG8_SCHED;
            PG8_LDA(At, 0, 1); PG8_STAGE(PG8_SB(0, 0), b2, voffB); PG8_STAGE(PG8_SB(0, 1), b2 + hstepB, voffB); PG8_STAGE(PG8_SA(0, 0), a2, voffA);
            PG8_WAIT_V(8); PG8_WAIT_L(0); PG8_BAR; PG8_MMA(1, 0, At, B0); PG8_MMA(1, 1, At, B1); PG8_BAR; PG8_SCHED;
            PG8_LDB(B0, 1, 0); PG8_LDB(B1, 1, 1); PG8_SCHED; PG8_LDA(At, 1, 0); PG8_STAGE(PG8_SA(0, 1), a2 + hstepA, voffA);
            PG8_WAIT_V(8); PG8_WAIT_L(0); PG8_BAR; PG8_MMA(0, 0, At, B0); PG8_MMA(0, 1, At, B1); PG8_BAR; PG8_SCHED;
            PG8_LDA(At, 1, 1); PG8_STAGE(PG8_SB(1, 0), b3, voffB); PG8_STAGE(PG8_SB(1, 1), b3 + hstepB, voffB); PG8_STAGE(PG8_SA(1, 0), a3, voffA);
            PG8_WAIT_V(8); PG8_WAIT_L(0); PG8_BAR; PG8_MMA(1, 0, At, B0); PG8_MMA(1, 1, At, B1); PG8_BAR; PG8_SCHED;
            } else {
            PG8_LDB(B0, 0, 0); PG8_SCHED; PG8_LDA(At, 0, 0); PG8_STAGE(PG8_SA(1, 1), a1 + hstepA, voffA);
            PG8_WAIT_L(8); PG8_BAR; PG8_WAIT_L(0); PG8_MMA(0, 0, At, B0); PG8_BAR; PG8_SCHED;
            PG8_LDB(B1, 0, 1); PG8_STAGE(PG8_SB(0, 0), b2, voffB);
            PG8_BAR; PG8_WAIT_L(0); PG8_MMA(0, 1, At, B1); PG8_BAR;
            PG8_LDA(At, 0, 1); PG8_STAGE(PG8_SA(0, 0), a2, voffA);
            PG8_BAR; PG8_WAIT_L(0); PG8_MMA(1, 0, At, B0); PG8_BAR; PG8_SCHED;
            PG8_STAGE(PG8_SB(0, 1), b2 + hstepB, voffB);
            PG8_WAIT_V(6); PG8_BAR; PG8_MMA(1, 1, At, B1); PG8_BAR;
            PG8_LDB(B0, 1, 0); PG8_SCHED; PG8_LDA(At, 1, 0); PG8_STAGE(PG8_SA(0, 1), a2 + hstepA, voffA);
            PG8_WAIT_L(8); PG8_BAR; PG8_WAIT_L(0); PG8_MMA(0, 0, At, B0); PG8_BAR; PG8_SCHED;
            PG8_LDB(B1, 1, 1); PG8_STAGE(PG8_SB(1, 0), b3, voffB);
            PG8_BAR; PG8_WAIT_L(0); PG8_MMA(0, 1, At, B1); PG8_BAR;
            PG8_LDA(At, 1, 1); PG8_STAGE(PG8_SA(1, 0), a3, voffA);
            PG8_BAR; PG8_WAIT_L(0); PG8_MMA(1, 0, At, B0); PG8_BAR; PG8_SCHED;
            PG8_STAGE(PG8_SB(1, 1), b3 + hstepB, voffB);
            PG8_WAIT_V(6); PG8_BAR; PG8_MMA(1, 1, At, B1); PG8_BAR;
            }
        }
        asm volatile("s_nop 15\n\ts_nop 15" ::: "memory");
        E(acc, cur, wr, wc, fr, fq);
        if (!has_next) break;
#pragma unroll
        for (int a = 0; a < 2; ++a)
#pragma unroll
            for (int b = 0; b < 2; ++b)
#pragma unroll
                for (int m = 0; m < 4; ++m)
#pragma unroll
                    for (int n = 0; n < 2; ++n) acc[a][b][m][n] = (f32x4){0.f, 0.f, 0.f, 0.f};
        cur = nxt; cA = nA; cB = nB; ++ui;
    }
    PG8_WAIT_V(0);
    if (wr == 0) PG8_BAR;
    PG8_BAR;
#undef PG8_SA
#undef PG8_SB
#undef PG8_STAGE
#undef PG8_LDA
#undef PG8_LDB
#undef PG8_MMA
#undef PG8_WAIT_V
#undef PG8_WAIT_L
#undef PG8_BAR
#undef PG8_SCHED
}

typedef f32x4 Acc[2][2][4][2];
struct EpiBf16 {
    static constexpr bool PERM = true; bf16_t* O; int ldc; float scale;
    DI void operator()(const Acc& acc, const Unit& u, int wr, int wc, int fr, int fq) const {
        const int row0 = u.pm * BM + wr * 64 + fr, col0 = u.pn * BM + wc * 32 + 8 * fq;
#pragma unroll
        for (int ai = 0; ai < 2; ++ai)
#pragma unroll
            for (int m = 0; m < 4; ++m) { bf16_t* rowp = O + (size_t)(row0 + ai * HALF + m * 16) * ldc + col0;
#pragma unroll
                for (int bj = 0; bj < 2; ++bj) { const f32x4 v0 = acc[ai][bj][m][0] * scale, v1 = acc[ai][bj][m][1] * scale;
                    *(u32x4*)(rowp + bj * HALF) = (u32x4){pk2(v0[0], v0[1]), pk2(v0[2], v0[3]), pk2(v1[0], v1[1]), pk2(v1[2], v1[3])}; } }
    }
};
struct EpiC1 {
    static constexpr bool PERM = false; float* C;
    DI void operator()(const Acc& acc, const Unit& u, int wr, int wc, int fr, int fq) const {
        const int row0 = u.pm * BM + wr * 64 + fr, col0 = wc * 32 + 4 * fq;
        float* base = C + (size_t)u.e * 2048 * 256;
#pragma unroll
        for (int ai = 0; ai < 2; ++ai)
#pragma unroll
            for (int m = 0; m < 4; ++m) { float* rowp = base + (size_t)(row0 + ai * HALF + m * 16) * 256 + col0;
#pragma unroll
                for (int bj = 0; bj < 2; ++bj)
#pragma unroll
                    for (int n = 0; n < 2; ++n) *(f32x4*)(rowp + bj * HALF + n * 16) = acc[ai][bj][m][n]; }
    }
};
DI float clamp8(float v) { return __builtin_amdgcn_fmed3f(v, -448.f, 448.f); }
DI unsigned fp8x4(float a, float b, float c, float d) { int w = 0; w = __builtin_amdgcn_cvt_pk_fp8_f32(clamp8(a), clamp8(b), w, false); w = __builtin_amdgcn_cvt_pk_fp8_f32(clamp8(c), clamp8(d), w, true); return (unsigned)w; }
constexpr float W8_SCALE = 256.f, W8_INV = 1.f / 256.f, A8_SCALE = 16.f, A8W8_INV = 1.f / 4096.f, Y8_SCALE = 32.f, Y8_INV = 1.f / 32.f;
template <bool ADD> struct EpiMerge {
    static constexpr bool PERM = true; bf16_t* P; unsigned char* O8; const bf16_t* Z; int gcol0; float scale;
    DI void operator()(const Acc& acc, const Unit& u, int wr, int wc, int fr, int fq) const {
        const int row0 = u.pm * BM + wr * 64 + fr, col0 = u.pn * BM + wc * 32 + 8 * fq;
#pragma unroll
        for (int ai = 0; ai < 2; ++ai) {
            u32x4 gz[4][2], pz[4][2];
#pragma unroll
            for (int m = 0; m < 4; ++m) { const size_t row = (size_t)(row0 + ai * HALF + m * 16);
#pragma unroll
                for (int bj = 0; bj < 2; ++bj) { const int col = col0 + bj * HALF; gz[m][bj] = *(const u32x4*)(Z + row * ZC + gcol0 + col); if (ADD) pz[m][bj] = *(const u32x4*)(P + row * D + col); } }
#pragma unroll
            for (int m = 0; m < 4; ++m) { const size_t row = (size_t)(row0 + ai * HALF + m * 16);
#pragma unroll
                for (int bj = 0; bj < 2; ++bj) { const int col = col0 + bj * HALF;
                    float g[8], o[8]; unpack8(gz[m][bj], g);
                    const f32x4 v0 = acc[ai][bj][m][0] * scale, v1 = acc[ai][bj][m][1] * scale;
                    if (ADD) unpack8(pz[m][bj], o);
#pragma unroll
                    for (int j = 0; j < 8; ++j) { const float a = j < 4 ? v0[j & 3] : v1[j & 3]; o[j] = (ADD ? o[j] : 0.f) + sigmoidf_(g[j]) * a; }
                    if (ADD) *(u32x2*)(O8 + row * D + col) = (u32x2){fp8x4(o[0] * A8_SCALE, o[1] * A8_SCALE, o[2] * A8_SCALE, o[3] * A8_SCALE), fp8x4(o[4] * A8_SCALE, o[5] * A8_SCALE, o[6] * A8_SCALE, o[7] * A8_SCALE)};
                    else *(u32x4*)(P + row * D + col) = (u32x4){pk2(o[0], o[1]), pk2(o[2], o[3]), pk2(o[4], o[5]), pk2(o[6], o[7])}; } }
        }
    }
};
struct EpiGU {
    static constexpr bool PERM = true; unsigned char* O; const float* bias;
    DI void operator()(const Acc& acc, const Unit& u, int wr, int wc, int fr, int fq) const {
        const int row0 = u.pm * BM + wr * 64 + fr, c0 = u.pn * HALF + wc * 32 + 8 * fq;
        const float* bg = bias + (size_t)u.e * 4096 + c0; const float* bu = bg + 2048;
        float bgv[8], buv[8];
#pragma unroll
        for (int j = 0; j < 8; ++j) { bgv[j] = bg[j]; buv[j] = bu[j]; }
#pragma unroll
        for (int ai = 0; ai < 2; ++ai)
#pragma unroll
            for (int m = 0; m < 4; ++m) { unsigned char* rowp = O + (size_t)(row0 + ai * HALF + m * 16) * D + c0;
                float o[8];
#pragma unroll
                for (int j = 0; j < 8; ++j) { float gt = (j < 4 ? acc[ai][0][m][0][j & 3] : acc[ai][0][m][1][j & 3]) * W8_INV + bgv[j];
                    float up = (j < 4 ? acc[ai][1][m][0][j & 3] : acc[ai][1][m][1][j & 3]) * W8_INV + buv[j];
                    gt = fminf(gt, 7.f); up = fminf(fmaxf(up, -7.f), 7.f);
                    o[j] = gt * sigmoidf_(1.702f * gt) * (up + 1.f); }
                *(u32x2*)rowp = (u32x2){fp8x4(o[0], o[1], o[2], o[3]), fp8x4(o[4], o[5], o[6], o[7])}; }
    }
};
struct EpiDN {
    static constexpr bool PERM = true; unsigned char* O; const float* bias; const float* slotw;
    DI void operator()(const Acc& acc, const Unit& u, int wr, int wc, int fr, int fq) const {
        const int row0 = u.pm * BM + wr * 64 + fr, col0 = u.pn * BM + wc * 32 + 8 * fq;
        float bv[2][8];
#pragma unroll
        for (int bj = 0; bj < 2; ++bj)
#pragma unroll
            for (int j = 0; j < 8; ++j) bv[bj][j] = bias[(size_t)u.e * D + col0 + bj * HALF + j];
        float sw[2][4];
#pragma unroll
        for (int ai = 0; ai < 2; ++ai)
#pragma unroll
            for (int m = 0; m < 4; ++m) sw[ai][m] = slotw[row0 + ai * HALF + m * 16];
#pragma unroll
        for (int ai = 0; ai < 2; ++ai)
#pragma unroll
            for (int m = 0; m < 4; ++m) { const int row = row0 + ai * HALF + m * 16; const float w = sw[ai][m] * Y8_SCALE; unsigned char* rowp = O + (size_t)row * D + col0;
#pragma unroll
                for (int bj = 0; bj < 2; ++bj) { float o[8];
#pragma unroll
                    for (int j = 0; j < 8; ++j) o[j] = ((j < 4 ? acc[ai][bj][m][0][j & 3] : acc[ai][bj][m][1][j & 3]) * W8_INV + bv[bj][j]) * w;
                    *(u32x2*)(rowp + bj * HALF) = (u32x2){fp8x4(o[0], o[1], o[2], o[3]), fp8x4(o[4], o[5], o[6], o[7])}; } }
    }
};
struct C1Sched {
    int G, c; const char* kvs; const char* w;
    DI bool next(int i, Unit& u) const {
        const int L = i * G + c; if (L >= 256) return false;
        const int kv = L >> 7, s = (L >> 3) & 15, pm = L & 7;
        u.pm = pm; u.pn = 0; u.e = s * 2 + kv;
        u.a = kvs + ((size_t)kv * KVS_ONE + (size_t)pm * 256 * 2048 + (size_t)s * 256) * 2;
        u.b = w + ((size_t)kv * 256 * 4096 + (size_t)s * 256) * 2; return true;
    }
};
struct MoeSched {
    int G, c, nN, total; const LAS int* tile_e; const char* A; const char* W; size_t w_exp;
    DI bool next(int i, Unit& u) const {
        const int L = i * G + c; if (L >= total) return false;
        const int mt = L / nN, pn = L - mt * nN; const int e = __builtin_amdgcn_readfirstlane(tile_e[mt]);
        u.pm = mt; u.pn = pn; u.e = e;
        u.a = A + (size_t)mt * 256 * D; u.b = W + (size_t)e * w_exp + (size_t)pn * 256 * D; return true;
    }
};
}

DI int colmap(int kind, int n) {
    if (kind == 0) return n;
    if (kind == 1) {
        if (n < 872) return n;
        if (n < 896) return 3432 + (n - 872);
        if (n < 1024) return -1;
        if (n < 2048) return 872 + (n - 1024);
        if (n < 3584) return 1896 + (n - 2048);
        return 3456 + (n - 3584);
    }
    if (kind == 2) { const int pn = n >> 8, r = n & 255; return r < 128 ? pn * 128 + r : 2048 + pn * 128 + (r - 128); }
    if (kind == 4) return n < 32 ? n : -1;
    { const int h = n >> 5, d = n & 31; return h * 128 + d; }
}
struct TrJob { const float* src; bf16_t* dst; int ldsrc, lddst, kind, k0, n0; };
DI void tr_load(const TrJob& j, f32x4 (&v)[8], int t) {
    const int c4 = t & 63, r0 = t >> 6; const int sc = colmap(j.kind, j.n0 + 4 * c4);
#pragma unroll
    for (int q = 0; q < 8; ++q) v[q] = (f32x4){0.f, 0.f, 0.f, 0.f};
    if (sc >= 0) {
#pragma unroll
        for (int q = 0; q < 8; ++q) v[q] = __builtin_nontemporal_load((const f32x4*)(j.src + (size_t)(j.k0 + r0 + 8 * q) * j.ldsrc + sc));
    }
}
DI void tr_lds_write(const f32x4 (&v)[8], float* tile, int t) {
    const int c4 = t & 63, r0 = t >> 6;
#pragma unroll
    for (int q = 0; q < 8; ++q) { float* tp = tile + (r0 + 8 * q) * 257 + 4 * c4; tp[0] = v[q][0]; tp[1] = v[q][1]; tp[2] = v[q][2]; tp[3] = v[q][3]; }
}
DI void tr_store(const TrJob& j, const float* tile, int t) {
    const int kk8 = (t & 7) * 8, nb = t >> 3;
#pragma unroll
    for (int ps = 0; ps < 4; ++ps) { const int nn = nb + 64 * ps; const float* s = tile + kk8 * 257 + nn;
        u32x4 o = {pk2(s[0], s[257]), pk2(s[2 * 257], s[3 * 257]), pk2(s[4 * 257], s[5 * 257]), pk2(s[6 * 257], s[7 * 257])};
        *(u32x4*)(j.dst + (size_t)(j.n0 + nn) * j.lddst + j.k0 + kk8) = o; }
}
DI void tr_setup(TrJob& j, int u, int nK, const float* src, int ldsrc, int kind, bf16_t* dst, int lddst) {
    const int kt = u % nK, ntile = u / nK; j.src = src; j.dst = dst; j.ldsrc = ldsrc; j.lddst = lddst; j.kind = kind; j.k0 = kt * 64; j.n0 = ntile * 256;
}
DI float tr8_load(const TrJob& j, f32x4 (&v)[8], int t) {
    const int c4 = t & 31, r0 = t >> 5; const int sc = colmap(j.kind, j.n0 + 4 * c4); const int scc = sc < 0 ? 0 : sc;
#pragma unroll
    for (int q = 0; q < 8; ++q) v[q] = __builtin_nontemporal_load((const f32x4*)(j.src + (size_t)(j.k0 + r0 + 16 * q) * j.ldsrc + scc));
    return sc < 0 ? 0.f : 1.f;
}
DI void tr8_lds_write(const f32x4 (&v)[8], float ok, float* tile, int t) {
    const int c4 = t & 31, r0 = t >> 5;
#pragma unroll
    for (int q = 0; q < 8; ++q) { float* tp = tile + (r0 + 16 * q) * 129 + 4 * c4; tp[0] = v[q][0] * ok; tp[1] = v[q][1] * ok; tp[2] = v[q][2] * ok; tp[3] = v[q][3] * ok; }
}
DI void tr8_store(const TrJob& j, const float* tile, int t) {
    const int kc = t & 7, nb = t >> 3; constexpr float SC = pg8::W8_SCALE;
#pragma unroll
    for (int ps = 0; ps < 2; ++ps) { const int nn = nb + 64 * ps; const float* s = tile + (16 * kc) * 129 + nn;
        u32x4 o = {pg8::fp8x4(s[0] * SC, s[129] * SC, s[2 * 129] * SC, s[3 * 129] * SC), pg8::fp8x4(s[4 * 129] * SC, s[5 * 129] * SC, s[6 * 129] * SC, s[7 * 129] * SC),
                   pg8::fp8x4(s[8 * 129] * SC, s[9 * 129] * SC, s[10 * 129] * SC, s[11 * 129] * SC), pg8::fp8x4(s[12 * 129] * SC, s[13 * 129] * SC, s[14 * 129] * SC, s[15 * 129] * SC)};
        __builtin_nontemporal_store(o, (u32x4*)((unsigned char*)j.dst + (size_t)(j.n0 + nn) * j.lddst + j.k0 + 16 * kc)); }
}
DI void phase_prep(const Params& p, char* smem) {
    float* tile = (float*)smem;
    const int t = tid_fresh(), G = gridDim.x;
    constexpr int U_ADA = 256, U_ABS = 256, U_WO = 1024, U_CB = 128, SPECIAL = U_ADA + U_ABS + U_WO + U_CB;
    constexpr int U_WINB = 32 * 8, U_WIN = 16 * 44, U_IDXQ = 8 * 2, U_UQR = 8, U_BRB = 16 * 8, U_OUT = 32 * 8, U_C1 = 64, U_RT = 32, U_GU = 32 * 16, U_DN = 32 * 8;
    constexpr int NTR = U_WINB + U_IDXQ + U_UQR + 2 * U_C1 + U_RT, NTR8 = U_WIN + U_BRB + U_OUT + NEXP * (U_GU + U_DN);
    bf16_t* Wq = (bf16_t*)(p.ws + O_WQ);
    for (int u0 = blockIdx.x; u0 < SPECIAL; u0 += G) {
        int u = u0;
        if (u < U_ADA) {
            const int c4 = t % 12, kg = t / 12; f32x4 a0 = {0.f, 0.f, 0.f, 0.f}, a1 = {0.f, 0.f, 0.f, 0.f};
            if (kg < 42) { const int col = u * 48 + c4 * 4;
#pragma unroll 7
                for (int k = kg; k < 2048; k += 42) { const float c0 = p.c[k], c1 = p.c[2048 + k]; const float s0 = c0 * sigmoidf_(c0), s1 = c1 * sigmoidf_(c1);
                    const f32x4 w = *(const f32x4*)(p.w_ada + (size_t)k * 12288 + col); a0 += w * s0; a1 += w * s1; } }
            __syncthreads();
            if (kg < 42) { float* tp = tile + (kg * 12 + c4) * 8;
#pragma unroll
                for (int j = 0; j < 4; ++j) { tp[j] = a0[j]; tp[4 + j] = a1[j]; } }
            __syncthreads();
            if (t < 96) { const int bb = t / 48, cc = t % 48; float acc = 0.f;
                for (int g2 = 0; g2 < 42; ++g2) acc += tile[(g2 * 12 + (cc >> 2)) * 8 + bb * 4 + (cc & 3)];
                ((float*)(p.ws + O_MODACC))[bb * 12288 + u * 48 + cc] = acc + p.b_ada[u * 48 + cc]; }
            continue; }
        u -= U_ADA;
        if (u < U_ABS) {
            const int item = u * 512 + t, r0 = (item & 63) * 8, hc = item >> 6, h = hc >> 8, c = hc & 255;
            float acc[8];
#pragma unroll
            for (int j = 0; j < 8; ++j) acc[j] = 0.f;
#pragma unroll 4
            for (int n = 0; n < 96; ++n) { const float wk = p.a_w_uk[(size_t)c * 768 + h * 96 + n];
#pragma unroll
                for (int j = 0; j < 8; ++j) acc[j] += p.a_w_uq[(size_t)(r0 + j) * 1024 + h * 128 + 32 + n] * wk; }
            *(u32x4*)(Wq + (size_t)(h * 256 + c) * 512 + r0) = (u32x4){pk2(acc[0], acc[1]), pk2(acc[2], acc[3]), pk2(acc[4], acc[5]), pk2(acc[6], acc[7])};
            continue; }
        u -= U_ABS;
        if (u < U_WO) {
            const int item = u * 512 + t, n = item & 2047, kg = item >> 11, k0 = kg * 8, h = k0 >> 8;
            float acc[8];
#pragma unroll
            for (int j = 0; j < 8; ++j) acc[j] = 0.f;
#pragma unroll 4
            for (int v = 0; v < 128; ++v) { const float wb = p.w_br_a[(size_t)(h * 128 + v) * D + n];
#pragma unroll
                for (int j = 0; j < 8; ++j) acc[j] += p.a_w_uv[(size_t)(k0 + j) * 128 + v] * wb; }
            *(u32x2*)((unsigned char*)(p.ws + O_WO) + (size_t)n * D + k0) = (u32x2){pg8::fp8x4(acc[0] * pg8::W8_SCALE, acc[1] * pg8::W8_SCALE, acc[2] * pg8::W8_SCALE, acc[3] * pg8::W8_SCALE), pg8::fp8x4(acc[4] * pg8::W8_SCALE, acc[5] * pg8::W8_SCALE, acc[6] * pg8::W8_SCALE, acc[7] * pg8::W8_SCALE)};
            continue; }
        u -= U_WO;
        {
            const int kv = u >> 6, seg = u & 63;
            if (t < 256) { const float* pe = kv ? p.cmp_v_pe : p.cmp_k_pe; const float* w1 = kv ? p.cmp_v_w1 : p.cmp_k_w1; float a = 0.f;
#pragma unroll 16
                for (int i = seg * 64; i < seg * 64 + 64; ++i) a += pe[i] * w1[(size_t)i * 256 + t];
                ((float*)(p.ws + O_CBP))[(seg * 2 + kv) * 256 + t] = a; } }
    }
    auto setup = [&](TrJob& j, int u) {
        if (u < U_WINB) { tr_setup(j, u, 32, p.w_in, 7552, 1, (bf16_t*)(p.ws + O_WIN), D); return; } u -= U_WINB;
        if (u < U_IDXQ) { tr_setup(j, u, 8, p.idx_w_q, 512, 0, Wq + (size_t)2304 * 512, 512); return; } u -= U_IDXQ;
        if (u < U_UQR) { tr_setup(j, u, 8, p.a_w_uq, 1024, 3, Wq + (size_t)2048 * 512, 512); return; } u -= U_UQR;
        if (u < U_C1) { tr_setup(j, u, 64, p.cmp_k_w1, 256, 0, (bf16_t*)(p.ws + O_WC1), 4096); return; } u -= U_C1;
        if (u < U_C1) { tr_setup(j, u, 64, p.cmp_v_w1, 256, 0, (bf16_t*)(p.ws + O_WC1) + (size_t)256 * 4096, 4096); return; } u -= U_C1;
        tr_setup(j, u, 32, p.w_router, 32, 4, (bf16_t*)(p.ws + O_WRT), D);
    };
    auto setup8 = [&](TrJob& j, int u) {
        j.lddst = D;
        if (u < U_WIN) { j.src = p.w_in; j.ldsrc = 7552; j.kind = 1; j.dst = (bf16_t*)(p.ws + O_WIN8); j.k0 = (u & 15) * 128; j.n0 = 2048 + (u >> 4) * 128; return; } u -= U_WIN;
        if (u < U_BRB) { j.src = p.w_br_b; j.ldsrc = D; j.kind = 0; j.dst = (bf16_t*)(p.ws + O_WBRB); j.lddst = 1024; j.k0 = (u & 7) * 128; j.n0 = (u >> 3) * 128; return; } u -= U_BRB;
        if (u < U_OUT) { j.src = p.w_out; j.ldsrc = D; j.kind = 0; j.dst = (bf16_t*)(p.ws + O_WOUT); j.k0 = (u & 15) * 128; j.n0 = (u >> 4) * 128; return; } u -= U_OUT;
        const int e = u / (U_GU + U_DN), r = u - e * (U_GU + U_DN);
        if (r < U_GU) { j.src = p.w_gate_up + (size_t)e * D * 4096; j.ldsrc = 4096; j.kind = 2; j.dst = (bf16_t*)(p.ws + O_WGU + (size_t)e * 4096 * D); j.k0 = (r & 15) * 128; j.n0 = (r >> 4) * 128; }
        else { const int r2 = r - U_GU; j.src = p.w_down + (size_t)e * D * D; j.ldsrc = D; j.kind = 0; j.dst = (bf16_t*)(p.ws + O_WDN + (size_t)e * D * D); j.k0 = (r2 & 15) * 128; j.n0 = (r2 >> 4) * 128; }
        j.lddst = D;
    };
    TrJob cur, nxt; f32x4 v[8];
    int u = blockIdx.x;
    if (u < NTR) { setup(cur, u); tr_load(cur, v, t); }
#pragma unroll 1
    for (; u < NTR; u += G) {
        __syncthreads();
        tr_lds_write(v, tile, t);
        __syncthreads();
        const bool more = u + G < NTR;
        if (more) { setup(nxt, u + G); tr_load(nxt, v, t); }
        tr_store(cur, tile, t);
        cur = nxt;
    }
    u = blockIdx.x;
    f32x4 v2[8]; float ok1, ok2;
    auto clampu = [&](int x) { return x < NTR8 ? x : NTR8 - 1; };
    setup8(cur, clampu(u)); ok1 = tr8_load(cur, v, t);
    setup8(nxt, clampu(u + G)); ok2 = tr8_load(nxt, v2, t);
#pragma unroll 1
    for (; u < NTR8; u += 2 * G) {
        __syncthreads();
        tr8_lds_write(v, ok1, tile, t);
        __syncthreads();
        TrJob c = cur;
        setup8(cur, clampu(u + 2 * G)); ok1 = tr8_load(cur, v, t);
        tr8_store(c, tile, t);
        __syncthreads();
        tr8_lds_write(v2, ok2, tile, t);
        __syncthreads();
        c = nxt;
        setup8(nxt, clampu(u + 3 * G)); ok2 = tr8_load(nxt, v2, t);
        tr8_store(c, tile, t);
    }
#if PREP_PROBE_MODE >= 2
    {
        unsigned chk = 0; unsigned char* dummy = (unsigned char*)(p.ws + O_HS);
        constexpr int U0 = U_WIN + U_BRB + U_OUT;
        TrJob pj, pn; f32x4 w[8]; float okp;
        int uu = U0 + blockIdx.x;
        setup8(pj, uu); okp = tr8_load(pj, w, t);
#pragma unroll 1
        for (; uu < NTR8; uu += G) {
#if PREP_PROBE_MODE == 2
            __syncthreads();
            tr8_lds_write(w, okp, tile, t);
            __syncthreads();
            setup8(pn, clampu(uu + G)); okp = tr8_load(pn, w, t);
            {   const int kc = t & 7, nb = t >> 3; constexpr float SC = pg8::W8_SCALE;
#pragma unroll
                for (int ps = 0; ps < 2; ++ps) { const int nn = nb + 64 * ps; const float* s = tile + (16 * kc) * 129 + nn;
                    chk ^= pg8::fp8x4(s[0] * SC, s[129] * SC, s[2 * 129] * SC, s[3 * 129] * SC) ^ pg8::fp8x4(s[4 * 129] * SC, s[5 * 129] * SC, s[6 * 129] * SC, s[7 * 129] * SC)
                         ^ pg8::fp8x4(s[8 * 129] * SC, s[9 * 129] * SC, s[10 * 129] * SC, s[11 * 129] * SC) ^ pg8::fp8x4(s[12 * 129] * SC, s[13 * 129] * SC, s[14 * 129] * SC, s[15 * 129] * SC); } }
            pj = pn;
#else
            u32x4 o0 = {pg8::fp8x4(w[0][0], w[0][1], w[0][2], w[0][3]), pg8::fp8x4(w[1][0], w[1][1], w[1][2], w[1][3]), pg8::fp8x4(w[2][0], w[2][1], w[2][2], w[2][3]), pg8::fp8x4(w[3][0], w[3][1], w[3][2], w[3][3])};
            u32x4 o1 = {pg8::fp8x4(w[4][0], w[4][1], w[4][2], w[4][3]), pg8::fp8x4(w[5][0], w[5][1], w[5][2], w[5][3]), pg8::fp8x4(w[6][0], w[6][1], w[6][2], w[6][3]), pg8::fp8x4(w[7][0], w[7][1], w[7][2], w[7][3])};
            setup8(pn, clampu(uu + G)); okp = tr8_load(pn, w, t);
            u32x4* dp = (u32x4*)(dummy + ((size_t)(uu - U0) * 512 + t) * 32); dp[0] = o0; dp[1] = o1;
            pj = pn;
#endif
        }
        if (chk == 0x12345678u && okp == 3.f) ((unsigned*)(p.ws + 115200))[0] = chk;
    }
#endif
#if PREP_PROBE_WC > 0
    {
        constexpr int WC = PREP_PROBE_WC, RW = WC / 4, RS = 512 / RW, R = 16384 / WC;
        float acc = 0.f; const int c4 = t % RW, r0 = t / RW;
#pragma unroll 1
        for (int pass = 0; pass < 2; ++pass) {
            const float* base = pass ? p.w_down : p.w_gate_up; const int ld = pass ? 2048 : 4096;
            const int nK = 65536 / R, ntiles = nK * (ld / WC);
#pragma unroll 1
            for (int uu = blockIdx.x; uu < ntiles; uu += G) {
#if PREP_PROBE_NFAST
                const int nN = ld / WC, nt_ = uu % nN, kt = uu / nN;
#else
                const int kt = uu % nK, nt_ = uu / nK;
#endif
                f32x4 w[8];
#pragma unroll
                for (int q = 0; q < 8; ++q) w[q] = __builtin_nontemporal_load((const f32x4*)(base + (size_t)(kt * R + r0 + RS * q) * ld + nt_ * WC + 4 * c4));
#pragma unroll
                for (int q = 0; q < 8; ++q) acc += (w[q][0] + w[q][1]) + (w[q][2] + w[q][3]);
            }
        }
        if (acc == 12345.678f) ((float*)(p.ws + 115200))[0] = acc;
    }
#endif
}

DI void phase_h1(const Params& p) {
    const int tz_ = tid_fresh(); const int lane = tz_ & 63, wid = __builtin_amdgcn_readfirstlane(tz_ >> 6);
    if (blockIdx.x == 0) { float a = 0.f; const float* cbp = (const float*)(p.ws + O_CBP);
        for (int sg = 0; sg < 64; ++sg) a += cbp[sg * 512 + tz_];
        ((float*)(p.ws + O_CBIAS))[tz_] = a; }
    bf16_t* H = (bf16_t*)(p.ws + O_H); float* rope = (float*)(p.ws + O_ROPE);
    for (int tok = blockIdx.x * 8 + wid; tok < NT; tok += gridDim.x * 8) {
        const int b = tok >> 13;
        const f32x4* xr = (const f32x4*)(p.x + (size_t)tok * D) + lane;
        f32x4 v[8]; float ss = 0.f;
#pragma unroll
        for (int i = 0; i < 8; ++i) { v[i] = xr[64 * i]; ss += v[i][0] * v[i][0] + v[i][1] * v[i][1] + v[i][2] * v[i][2] + v[i][3] * v[i][3]; }
        const float rs = rsqrtf(wave_sum(ss) * (1.f / D) + NORM_EPS);
#pragma unroll
        for (int i = 0; i < 8; ++i) { const int col = 4 * (lane + 64 * i); float o[4];
#pragma unroll
            for (int j = 0; j < 4; ++j) o[j] = v[i][j] * rs * p.g_pre_mix[col + j] * (1.f + mod_at(p, b, 2048 + col + j)) + mod_at(p, b, col + j);
            *(u32x2*)(H + (size_t)tok * D + col) = (u32x2){pk2(o[0], o[1]), pk2(o[2], o[3])};
            *(unsigned*)((unsigned char*)(p.ws + O_H8) + (size_t)tok * D + col) = pg8::fp8x4(o[0], o[1], o[2], o[3]); }
        if (lane < 24) { const float fr = lane < 16 ? (float)(2 * lane) * (1.f / 32.f) : (float)(2 * (lane - 16)) * (1.f / 16.f);
            const float inv = exp2f(-fr * 18.931568569324174f);
            const float ang = (float)p.pos[tok] * inv; float s, c; sincosf(ang, &s, &c);
            rope[(size_t)tok * 48 + 2 * lane] = c; rope[(size_t)tok * 48 + 2 * lane + 1] = s; }
    }
}

DI void phase_zpost(const Params& p) {
    const int tz_ = tid_fresh(); const int lane = tz_ & 63, wid = __builtin_amdgcn_readfirstlane(tz_ >> 6);
    const bf16_t* Z = (const bf16_t*)(p.ws + O_Z); const float* rope = (const float*)(p.ws + O_ROPE);
    bf16_t* cqn = (bf16_t*)(p.ws + O_CQN); bf16_t* kvt = (bf16_t*)(p.ws + O_KVT); bf16_t* kidx = (bf16_t*)(p.ws + O_KIDX);
    float* widx = (float*)(p.ws + O_WIDX); float* gates = (float*)(p.ws + O_GATES); bf16_t* bq = (bf16_t*)(p.ws + O_BQ); bf16_t* kvs = (bf16_t*)(p.ws + O_KVS);
    for (int tok = blockIdx.x * 8 + wid; tok < NT; tok += gridDim.x * 8) {
        const int b = tok >> 13, tq = tok & (T - 1);
        const bf16_t* zr = Z + (size_t)tok * ZC; const float* rt = rope + (size_t)tok * 48;
        {
            float f[8]; unpack8(*(const u32x4*)(zr + lane * 8), f); float ss = 0.f;
#pragma unroll
            for (int j = 0; j < 8; ++j) ss += f[j] * f[j];
            const float rs = rsqrtf(wave_sum(ss) * (1.f / 512.f) + NORM_EPS);
#pragma unroll
            for (int j = 0; j < 8; ++j) f[j] = f[j] * rs * p.a_cq_norm[lane * 8 + j];
            *(u32x4*)(cqn + (size_t)tok * 512 + lane * 8) = (u32x4){pk2(f[0], f[1]), pk2(f[2], f[3]), pk2(f[4], f[5]), pk2(f[6], f[7])};
        }
        {
            const u32x2 w = *(const u32x2*)(zr + ZC_CKV + lane * 4); float f[4] = {bflo(w[0]), bfhi(w[0]), bflo(w[1]), bfhi(w[1])};
            const float rs = rsqrtf(wave_sum(f[0] * f[0] + f[1] * f[1] + f[2] * f[2] + f[3] * f[3]) * (1.f / 256.f) + NORM_EPS);
#pragma unroll
            for (int j = 0; j < 4; ++j) f[j] = f[j] * rs * p.a_ckv_norm[lane * 4 + j];
            *(u32x2*)(kvt + (size_t)tok * KVW + lane * 4) = (u32x2){pk2(f[0], f[1]), pk2(f[2], f[3])};
        }
        if (lane < 16) {
            const float x1 = bf2f(zr[ZC_KROPE + lane]), x2 = bf2f(zr[ZC_KROPE + 16 + lane]), c = rt[2 * lane], s = rt[2 * lane + 1];
            kvt[(size_t)tok * KVW + 256 + lane] = f2bf(x1 * c - x2 * s); kvt[(size_t)tok * KVW + 272 + lane] = f2bf(x2 * c + x1 * s);
        }
        {
            const float v = bf2f(zr[ZC_KIDX + lane]); const float mean = wave_sum(v) * (1.f / 64.f); const float xc = v - mean;
            const float var = wave_sum(xc * xc) * (1.f / 64.f);
            const float y = xc * rsqrtf(var + NORM_EPS) * p.idx_g[lane] + p.idx_b[lane];
            const float pr = __shfl_xor(y, 8); float o = y;
            if (lane < 8) o = y * rt[32 + 2 * lane] - pr * rt[33 + 2 * lane];
            else if (lane < 16) o = y * rt[32 + 2 * (lane - 8)] + pr * rt[33 + 2 * (lane - 8)];
            kidx[(size_t)tok * 64 + lane] = f2bf(o);
        }
        if (lane < 8) widx[(size_t)tok * 8 + lane] = bf2f(zr[ZC_WIDX + lane]) * (0.35355339059327373f * 0.125f);
        if (lane < 24) gates[(size_t)tok * 24 + lane] = sigmoidf_(bf2f(zr[ZC_BGATE + lane]));
#pragma unroll
        for (int ps = 0; ps < 3; ++ps) { const int slot = ps * 64 + lane;
            if (slot < 160) { const int hh = slot >> 3, part = slot & 7; const bf16_t* src = zr + ZC_BQ + hh * 128 + part * 16;
                float f[16]; { float a[8], c[8]; unpack8(*(const u32x4*)src, a); unpack8(*(const u32x4*)(src + 8), c);
#pragma unroll
                    for (int j = 0; j < 8; ++j) { f[j] = a[j]; f[8 + j] = c[j]; } }
                const bool dorope = hh < 8 || (((hh - 8) >> 1) & 1) == 0;
                if (dorope && part < 2) { const bf16_t* os = part == 0 ? src + 16 : src - 16; float g[16];
                    { float a[8], c[8]; unpack8(*(const u32x4*)os, a); unpack8(*(const u32x4*)(os + 8), c);
#pragma unroll
                      for (int j = 0; j < 8; ++j) { g[j] = a[j]; g[8 + j] = c[j]; } }
#pragma unroll
                    for (int i = 0; i < 16; ++i) { const float c = rt[2 * i], s = rt[2 * i + 1]; f[i] = part == 0 ? f[i] * c - g[i] * s : f[i] * c + g[i] * s; } }
                bf16_t* dst;
                if (hh < 8) dst = bq + (size_t)tok * 1024 + hh * 128 + part * 16;
                else { const int i6 = (hh - 8) >> 1, g = (hh - 8) & 1; dst = kvs + ((((size_t)i6 * NB + b) * 2 + g) * T + tq) * 128 + part * 16; }
                *(u32x4*)dst = (u32x4){pk2(f[0], f[1]), pk2(f[2], f[3]), pk2(f[4], f[5]), pk2(f[6], f[7])};
                *(u32x4*)(dst + 8) = (u32x4){pk2(f[8], f[9]), pk2(f[10], f[11]), pk2(f[12], f[13]), pk2(f[14], f[15])}; } }
    }
}

DI void c2_rows(const Params& p, char* smem) {
    const int tz_ = tid_fresh(); const int lane = tz_ & 63, wid = __builtin_amdgcn_readfirstlane(tz_ >> 6);
    float* hrow = (float*)smem + wid * 256;
    const float* c1p = (const float*)(p.ws + O_C1P); const float* cb = (const float*)(p.ws + O_CBIAS); bf16_t* kcvc = (bf16_t*)(p.ws + O_KCVC);
    for (int row = blockIdx.x * 8 + wid; row < 4096; row += gridDim.x * 8) {
        const int kv = row >> 11, r = row & 2047, n = r & 511;
        f32x4 a = *(const f32x4*)(cb + kv * 256 + lane * 4);
#pragma unroll
        for (int s = 0; s < 16; ++s) a += *(const f32x4*)(c1p + ((size_t)(s * 2 + kv) * 2048 + r) * 256 + lane * 4);
#pragma unroll
        for (int j = 0; j < 4; ++j) { const float v = a[j]; const float u = 0.7978845608028654f * (v + 0.044715f * v * v * v); hrow[lane * 4 + j] = 0.5f * v * (1.f + tanhf(u)); }
        asm volatile("s_waitcnt lgkmcnt(0)" ::: "memory");
        const float* w2 = kv ? p.cmp_v_w2 : p.cmp_k_w2;
        float o0 = 0.f, o1 = 0.f;
#pragma unroll 16
        for (int j = 0; j < 256; ++j) { const float hv = hrow[j]; const float2 w = *(const float2*)(w2 + j * 128 + lane * 2); o0 += hv * w.x; o1 += hv * w.y; }
        if (n == 511) { o0 = 0.f; o1 = 0.f; }
        *(unsigned*)(kcvc + (size_t)row * 128 + lane * 2) = pk2(o0, o1);
        asm volatile("s_waitcnt lgkmcnt(0)" ::: "memory");
    }
}

DI unsigned short f16key(float v) { const _Float16 h = (_Float16)v; unsigned short u = __builtin_bit_cast(unsigned short, h); return (u & 0x8000u) ? (unsigned short)~u : (unsigned short)(u | 0x8000u); }
DI void topk256_select(const LAS unsigned* scw, int nk, unsigned short* out, int lane) {
    const int nw = (nk + 127) >> 7;
    auto ldk = [&](int i) -> unsigned { const int wi = i * 64 + lane; unsigned v = scw[wi]; if (2 * wi >= nk) v = 0u; else if (2 * wi + 1 >= nk) v &= 0xffffu; return v; };
    unsigned Tv = 0u;
    for (int bit = 15; bit >= 0; --bit) { const unsigned cand = Tv | (1u << bit); int cnt = 0;
#pragma unroll 4
        for (int i = 0; i < nw; ++i) { const unsigned kv = ldk(i); cnt += __popcll(__ballot((kv & 0xffffu) >= cand)) + __popcll(__ballot((kv >> 16) >= cand)); }
        if (cnt >= 256) Tv = cand; }
    int cgt = 0;
#pragma unroll 4
    for (int i = 0; i < nw; ++i) { const unsigned kv = ldk(i); cgt += __popcll(__ballot((kv & 0xffffu) > Tv)) + __popcll(__ballot((kv >> 16) > Tv)); }
    const int need = 256 - cgt; int pos = 0, eqc = 0;
    const unsigned long long ltm = (1ull << lane) - 1ull;
#pragma unroll 2
    for (int i = 0; i < nw; ++i) {
        const unsigned kv = ldk(i); const unsigned lo = kv & 0xffffu, hi = kv >> 16;
        const bool elo = lo == Tv, ehi = hi == Tv;
        const unsigned long long mlo = __ballot(elo), mhi = __ballot(ehi);
        const int below = __popcll(mlo & ltm) + __popcll(mhi & ltm);
        const bool slo = lo > Tv || (elo && eqc + below < need), shi = hi > Tv || (ehi && eqc + below + (elo ? 1 : 0) < need);
        const unsigned long long s0 = __ballot(slo), s1 = __ballot(shi);
        const int plo = pos + __popcll(s0 & ltm), phi = pos + __popcll(s0) + __popcll(s1 & ltm);
        const int kidx = 2 * (i * 64 + lane);
        if (slo) out[plo] = (unsigned short)kidx;
        if (shi) out[phi] = (unsigned short)(kidx + 1);
        pos += __popcll(s0) + __popcll(s1); eqc += __popcll(mlo) + __popcll(mhi); }
}
DI void phase_indexer(const Params& p, char* smem) {
    const int tz_ = tid_fresh(); const int lane = tz_ & 63, wid = __builtin_amdgcn_readfirstlane(tz_ >> 6);
    LAS unsigned short* sc = (LAS unsigned short*)(LAS char*)smem + wid * 8192;
    float* qf = (float*)(smem + 131072) + wid * 512;
    const bf16_t* Q = (const bf16_t*)(p.ws + O_QALL); const bf16_t* KI = (const bf16_t*)(p.ws + O_KIDX); const float* WI = (const float*)(p.ws + O_WIDX);
    unsigned short* SEL = (unsigned short*)(p.ws + O_SEL); int* NSEL = (int*)(p.ws + O_NSEL);
    for (int tok = (int)(NT / 8 - 1 - blockIdx.x) * 8 + wid; tok >= 0; tok -= gridDim.x * 8) {
        const int b = tok >> 13, tq = tok & (T - 1), nk = tq + 1;
        unsigned short* out = SEL + (size_t)tok * 256;
        if (nk <= 256) { for (int i = lane; i < 256; i += 64) out[i] = (unsigned short)(i < nk ? i : 0); if (lane == 0) NSEL[tok] = nk; continue; }
        { float f[8]; unpack8(*(const u32x4*)(Q + (size_t)tok * QC + 2304 + lane * 8), f);
#pragma unroll
          for (int j = 0; j < 8; ++j) qf[lane * 8 + j] = f[j]; }
        float wh[8];
#pragma unroll
        for (int h = 0; h < 8; ++h) wh[h] = WI[(size_t)tok * 8 + h];
        asm volatile("s_waitcnt lgkmcnt(0)" ::: "memory");
        for (int s = lane; s < nk; s += 64) {
            const bf16_t* kr = KI + ((size_t)b * T + s) * 64; float d[8];
#pragma unroll
            for (int h = 0; h < 8; ++h) d[h] = 0.f;
#pragma unroll 2
            for (int c = 0; c < 8; ++c) { float kf[8]; unpack8(*(const u32x4*)(kr + c * 8), kf);
#pragma unroll
                for (int h = 0; h < 8; ++h) { const f32x4 q0 = *(const f32x4*)(qf + h * 64 + c * 8), q1 = *(const f32x4*)(qf + h * 64 + c * 8 + 4);
                    d[h] += q0[0] * kf[0] + q0[1] * kf[1] + q0[2] * kf[2] + q0[3] * kf[3] + q1[0] * kf[4] + q1[1] * kf[5] + q1[2] * kf[6] + q1[3] * kf[7]; } }
            float score = 0.f;
#pragma unroll
            for (int h = 0; h < 8; ++h) score += wh[h] * fmaxf(d[h], 0.f);
            sc[s] = f16key(score); }
        asm volatile("s_waitcnt lgkmcnt(0)" ::: "memory");
        topk256_select((const LAS unsigned*)sc, nk, out, lane);
        if (lane == 0) NSEL[tok] = 256;
        asm volatile("s_waitcnt lgkmcnt(0)" ::: "memory");
    }
}

DI void phase_mla(const Params& p, char* smem) {
    const int tz_ = tid_fresh(); const int lane = tz_ & 63, wid = __builtin_amdgcn_readfirstlane(tz_ >> 6);
    float* qf = (float*)smem + wid * (8 * KVW + 8 * 256 + 128);
    float* pf = qf + 8 * KVW; unsigned short* selw = (unsigned short*)(pf + 8 * 256);
    const bf16_t* Q = (const bf16_t*)(p.ws + O_QALL); const bf16_t* KV = (const bf16_t*)(p.ws + O_KVT);
    const unsigned short* SEL = (const unsigned short*)(p.ws + O_SEL); const int* NSEL = (const int*)(p.ws + O_NSEL); bf16_t* OL = (bf16_t*)(p.ws + O_OLAT);
    for (int tok = blockIdx.x * 8 + wid; tok < NT; tok += gridDim.x * 8) {
        const int b = tok >> 13; const int cnt = NSEL[tok];
        const bf16_t* qr = Q + (size_t)tok * QC;
#pragma unroll 4
        for (int i = 0; i < 36; ++i) { const int e = lane + 64 * i;
            const int h = e / KVW, d = e - h * KVW; qf[e] = bf2f(d < 256 ? qr[h * 256 + d] : qr[2048 + h * 32 + (d - 256)]); }
        *(u32x2*)(selw + lane * 4) = *(const u32x2*)(SEL + (size_t)tok * 256 + lane * 4);
        asm volatile("s_waitcnt lgkmcnt(0)" ::: "memory");
        const bf16_t* rows[4];
#pragma unroll
        for (int j = 0; j < 4; ++j) { const int k = lane + 64 * j; const int idx = k < cnt ? selw[k] : 0; rows[j] = KV + ((size_t)b * T + idx) * KVW; }
        float acc[4][8];
#pragma unroll
        for (int j = 0; j < 4; ++j)
#pragma unroll
            for (int h = 0; h < 8; ++h) acc[j][h] = 0.f;
#pragma unroll 1
        for (int c = 0; c < 36; ++c) { float kf[4][8];
#pragma unroll
            for (int j = 0; j < 4; ++j) unpack8(*(const u32x4*)(rows[j] + c * 8), kf[j]);
#pragma unroll
            for (int h = 0; h < 8; ++h) { const f32x4 q0 = *(const f32x4*)(qf + h * KVW + c * 8), q1 = *(const f32x4*)(qf + h * KVW + c * 8 + 4);
#pragma unroll
                for (int j = 0; j < 4; ++j) acc[j][h] += q0[0] * kf[j][0] + q0[1] * kf[j][1] + q0[2] * kf[j][2] + q0[3] * kf[j][3] + q1[0] * kf[j][4] + q1[1] * kf[j][5] + q1[2] * kf[j][6] + q1[3] * kf[j][7]; } }
#pragma unroll
        for (int h = 0; h < 8; ++h) { float m = -INFINITY;
#pragma unroll
            for (int j = 0; j < 4; ++j) { acc[j][h] = (lane + 64 * j < cnt) ? acc[j][h] * ATT_SCALE : -INFINITY; m = fmaxf(m, acc[j][h]); }
            m = wave_max(m); float l = 0.f;
#pragma unroll
            for (int j = 0; j < 4; ++j) { acc[j][h] = (lane + 64 * j < cnt) ? __expf(acc[j][h] - m) : 0.f; l += acc[j][h]; }
            l = 1.f / fmaxf(wave_sum(l), 1e-30f);
#pragma unroll
            for (int j = 0; j < 4; ++j) pf[h * 256 + lane + 64 * j] = acc[j][h] * l; }
        asm volatile("s_waitcnt lgkmcnt(0)" ::: "memory");
        float o[8][4];
#pragma unroll
        for (int h = 0; h < 8; ++h)
#pragma unroll
            for (int j = 0; j < 4; ++j) o[h][j] = 0.f;
#pragma unroll 1
        for (int k0 = 0; k0 < 256; k0 += 8) { u32x2 vv[8];
#pragma unroll
            for (int kk = 0; kk < 8; ++kk) { const int k = k0 + kk; const int idx = k < cnt ? selw[k] : 0; vv[kk] = *(const u32x2*)(KV + ((size_t)b * T + idx) * KVW + lane * 4); }
#pragma unroll
            for (int kk = 0; kk < 8; ++kk) { const float v0 = bflo(vv[kk][0]), v1 = bfhi(vv[kk][0]), v2 = bflo(vv[kk][1]), v3 = bfhi(vv[kk][1]);
#pragma unroll
                for (int h = 0; h < 8; ++h) { const float ph = pf[h * 256 + k0 + kk]; o[h][0] += ph * v0; o[h][1] += ph * v1; o[h][2] += ph * v2; o[h][3] += ph * v3; } } }
#pragma unroll
        for (int h = 0; h < 8; ++h) *(u32x2*)(OL + (size_t)tok * D + h * 256 + lane * 4) = (u32x2){pk2(o[h][0], o[h][1]), pk2(o[h][2], o[h][3])};
        asm volatile("s_waitcnt lgkmcnt(0)" ::: "memory");
    }
}

DI void nsa_score(const bf16_t* kr, const float* qf, float (&s)[4]) {
#pragma unroll
    for (int j = 0; j < 4; ++j) s[j] = 0.f;
#pragma unroll 4
    for (int c = 0; c < 16; ++c) { float kf[8]; unpack8(*(const u32x4*)(kr + c * 8), kf);
#pragma unroll
        for (int j = 0; j < 4; ++j) { const f32x4 q0 = *(const f32x4*)(qf + j * 128 + c * 8), q1 = *(const f32x4*)(qf + j * 128 + c * 8 + 4);
            s[j] += q0[0] * kf[0] + q0[1] * kf[1] + q0[2] * kf[2] + q0[3] * kf[3] + q1[0] * kf[4] + q1[1] * kf[5] + q1[2] * kf[6] + q1[3] * kf[7]; } }
}
DI void phase_nsa(const Params& p, char* smem) {
    const int tz_ = tid_fresh(); const int lane = tz_ & 63, wid = __builtin_amdgcn_readfirstlane(tz_ >> 6);
    float* qf = (float*)smem + wid * (512 + 256 + 512 + 16); float* pb = qf + 512; float* psum = pb + 256; int* blk = (int*)(psum + 512);
    const bf16_t* BQ = (const bf16_t*)(p.ws + O_BQ); const bf16_t* kvs = (const bf16_t*)(p.ws + O_KVS); const bf16_t* kcvc = (const bf16_t*)(p.ws + O_KCVC);
    const float* gates = (const float*)(p.ws + O_GATES); bf16_t* OB = (bf16_t*)(p.ws + O_OB);
#pragma unroll 1
    for (int item = (NT * 2 / 8 - 1 - (int)blockIdx.x) * 8 + wid; item >= 0; item -= gridDim.x * 8) {
        const int tok = item >> 1, g = item & 1, b = tok >> 13, tq = tok & (T - 1);
        { float f[8]; unpack8(*(const u32x4*)(BQ + (size_t)tok * 1024 + g * 512 + lane * 8), f);
#pragma unroll
          for (int j = 0; j < 8; ++j) qf[lane * 8 + j] = f[j]; }
        asm volatile("s_waitcnt lgkmcnt(0)" ::: "memory");
        const size_t bg = (size_t)(b * 2 + g);
        const int nmax = tq >= 31 ? (tq - 31) >> 4 : -1;
        float res[4][2], o[4][2], m[4], l[4]; int ns = 0;
#pragma unroll
        for (int j = 0; j < 4; ++j) { res[j][0] = 0.f; res[j][1] = 0.f; }
#pragma unroll 1
        for (int step = 0; step < 4; ++step) {
            const int kind = step < 2 ? 0 : step - 1;
            const int mode = step == 0 ? 1 : (step == 1 ? 2 : 0);
            const bf16_t* kbase; const bf16_t* vbase; int nch;
            if (kind == 0) { kbase = kcvc + bg * 512 * 128; vbase = kcvc + (size_t)2048 * 128 + bg * 512 * 128; nch = 8; }
            else if (kind == 1) { kbase = kvs + (2 * (size_t)NB * 2 + bg) * T * 128; vbase = kvs + (3 * (size_t)NB * 2 + bg) * T * 128; nch = ns; }
            else { kbase = kvs + (4 * (size_t)NB * 2 + bg) * T * 128; vbase = kvs + (5 * (size_t)NB * 2 + bg) * T * 128; nch = 8; }
            if (mode != 2) {
#pragma unroll
                for (int j = 0; j < 4; ++j) { m[j] = -INFINITY; l[j] = 0.f; } }
#pragma unroll
            for (int j = 0; j < 4; ++j) { o[j][0] = 0.f; o[j][1] = 0.f; }
#pragma unroll 1
            for (int c = 0; c < nch; ++c) {
                int base, lim_lo, lim_hi;
                if (kind == 0) { base = 64 * c; lim_lo = 0; lim_hi = nmax; }
                else if (kind == 1) { base = blk[c] * 64; lim_lo = 0; lim_hi = tq; }
                else { base = tq - 511 + 64 * c; lim_lo = 0; lim_hi = tq; }
                const bool active = base <= lim_hi && base + 63 >= lim_lo;
                if (!active) { if (mode == 2) psum[c * 64 + lane] = 0.f; continue; }
                const int key = base + lane; const bool valid = key >= lim_lo && key <= lim_hi;
                float s[4]; nsa_score(kbase + (size_t)(key < 0 ? 0 : key) * 128, qf, s);
                float ps = 0.f;
#pragma unroll
                for (int j = 0; j < 4; ++j) {
                    const float sv = valid ? s[j] * ATT_SCALE : -INFINITY; float pj;
                    if (mode == 2) { pj = valid ? __expf(sv - m[j]) * l[j] : 0.f; ps += pj; }
                    else { const float mn = fmaxf(m[j], wave_max(sv));
                        const float alpha = (m[j] == -INFINITY) ? 0.f : __expf(m[j] - mn);
                        pj = (sv == -INFINITY) ? 0.f : __expf(sv - mn);
                        l[j] = l[j] * alpha + wave_sum(pj); m[j] = mn; o[j][0] *= alpha; o[j][1] *= alpha; }
                    pb[j * 64 + lane] = pj; }
                if (mode == 2) psum[c * 64 + lane] = ps;
                if (mode != 1) {
                    asm volatile("s_waitcnt lgkmcnt(0)" ::: "memory");
#pragma unroll 1
                    for (int k0 = 0; k0 < 64; k0 += 8) { unsigned vv[8];
#pragma unroll
                        for (int kk = 0; kk < 8; ++kk) { const int kx = base + k0 + kk; vv[kk] = *(const unsigned*)(vbase + (size_t)(kx < 0 ? 0 : kx) * 128 + lane * 2); }
#pragma unroll
                        for (int kk = 0; kk < 8; ++kk) { const float v0 = bflo(vv[kk]), v1 = bfhi(vv[kk]);
#pragma unroll
                            for (int j = 0; j < 4; ++j) { const float ph = pb[j * 64 + k0 + kk]; o[j][0] += ph * v0; o[j][1] += ph * v1; } } } }
                asm volatile("s_waitcnt lgkmcnt(0)" ::: "memory");
            }
            if (step == 0) {
#pragma unroll
                for (int j = 0; j < 4; ++j) { if (m[j] == -INFINITY) m[j] = 0.f; l[j] = 1.f / fmaxf(l[j], 1e-30f); }
                continue; }
#pragma unroll
            for (int j = 0; j < 4; ++j) { const float gt = gates[(size_t)tok * 24 + (g * 4 + j) * 3 + kind]; const float il = (mode == 2) ? gt : gt / fmaxf(l[j], 1e-30f);
                res[j][0] += il * o[j][0]; res[j][1] += il * o[j][1]; }
            if (step == 1) {
                asm volatile("s_waitcnt lgkmcnt(0)" ::: "memory");
                const int cur = tq >> 6; unsigned key[2];
#pragma unroll
                for (int hh = 0; hh < 2; ++hh) { const int mb = lane + 64 * hh; float imp = 0.f;
#pragma unroll
                    for (int d = -1; d < 4; ++d) { const int n = 4 * mb + d; if (n >= 0 && n < 512) imp += psum[n]; }
                    const bool adm = mb <= cur, forced = mb == 0 || mb == cur || mb == cur - 1;
                    key[hh] = !adm ? 0u : (forced ? (0xFF000000u | (unsigned)(127 - mb)) : ((((__float_as_uint(imp) >> 7) + 1u) << 7) | (unsigned)(127 - mb))); }
                unsigned Tv = 0u;
                for (int bit = 31; bit >= 0; --bit) { const unsigned cand = Tv | (1u << bit);
                    const int cnt = __popcll(__ballot(key[0] >= cand)) + __popcll(__ballot(key[1] >= cand)); if (cnt >= 16) Tv = cand; }
                if (Tv == 0u) Tv = 1u;
                const unsigned long long m0 = __ballot(key[0] >= Tv), m1 = __ballot(key[1] >= Tv);
                const unsigned long long ltm = (1ull << lane) - 1ull;
                if (key[0] >= Tv) blk[__popcll(m0 & ltm)] = lane;
                if (key[1] >= Tv) blk[__popcll(m0) + __popcll(m1 & ltm)] = lane + 64;
                ns = __popcll(m0) + __popcll(m1);
                asm volatile("s_waitcnt lgkmcnt(0)" ::: "memory"); }
        }
#pragma unroll
        for (int j = 0; j < 4; ++j) *(unsigned*)(OB + (size_t)tok * 1024 + (g * 4 + j) * 128 + lane * 2) = pk2(res[j][0], res[j][1]);
        asm volatile("s_waitcnt lgkmcnt(0)" ::: "memory");
    }
}

typedef float f32x16 __attribute__((ext_vector_type(16)));
typedef short s16x4 __attribute__((ext_vector_type(4)));
#define MFMA32(a, b, c) __builtin_amdgcn_mfma_f32_32x32x16_bf16((a), (b), (c), 0, 0, 0)
DI unsigned offb(unsigned row, unsigned ch) { return 256u * row + 16u * (ch ^ (((row & 3u) << 2) | ((row >> 2) & 3u))); }
DI unsigned cvt2(float a, float b) { typedef __bf16 b2 __attribute__((ext_vector_type(2))); typedef float f2 __attribute__((ext_vector_type(2))); const b2 r = __builtin_convertvector((f2){a, b}, b2); return __builtin_bit_cast(unsigned, r); }
DI bf16x8 pack_p(const f32x16& x, int s) {
    const u32x4 w = {cvt2(x[8 * s], x[8 * s + 1]), cvt2(x[8 * s + 2], x[8 * s + 3]), cvt2(x[8 * s + 4], x[8 * s + 5]), cvt2(x[8 * s + 6], x[8 * s + 7])};
    return __builtin_bit_cast(bf16x8, w);
}
DI void nsa_tile_dma(LAS char* kb, LAS char* vb, const bf16_t* kt, const bf16_t* vt, int tid, int w) {
#pragma unroll
    for (int i = 0; i < 2; ++i) { const int id = tid + 512 * i; const unsigned row = id >> 4, pos = id & 15; const unsigned ch = pos ^ (((row & 3u) << 2) | ((row >> 2) & 3u));
        const size_t so = (size_t)row * 128 + ch * 8; const unsigned lo = (unsigned)(i * 512 + w * 64) * 16u;
        __builtin_amdgcn_global_load_lds((const unsigned*)(kt + so), (LAS unsigned*)(kb + lo), 16, 0, 0);
        __builtin_amdgcn_global_load_lds((const unsigned*)(vt + so), (LAS unsigned*)(vb + lo), 16, 0, 0); }
}
#define NSA_TR8(R, A, OFF) asm volatile( \
    "ds_read_b64_tr_b16 %0, %8 offset:%16\n\tds_read_b64_tr_b16 %1, %9 offset:%16\n\tds_read_b64_tr_b16 %2, %10 offset:%16\n\tds_read_b64_tr_b16 %3, %11 offset:%16\n\t" \
    "ds_read_b64_tr_b16 %4, %12 offset:%16\n\tds_read_b64_tr_b16 %5, %13 offset:%16\n\tds_read_b64_tr_b16 %6, %14 offset:%16\n\tds_read_b64_tr_b16 %7, %15 offset:%16\n\ts_waitcnt lgkmcnt(0)" \
    : "=&v"(R[0]), "=&v"(R[1]), "=&v"(R[2]), "=&v"(R[3]), "=&v"(R[4]), "=&v"(R[5]), "=&v"(R[6]), "=&v"(R[7]) \
    : "v"(A[0]), "v"(A[1]), "v"(A[2]), "v"(A[3]), "v"(A[4]), "v"(A[5]), "v"(A[6]), "v"(A[7]), "i"(OFF) : "memory")

#define NSA_TR4(R, A0, A1, A2, A3, OFF) asm volatile( \
    "ds_read_b64_tr_b16 %0, %4 offset:%8\n\tds_read_b64_tr_b16 %1, %5 offset:%8\n\tds_read_b64_tr_b16 %2, %6 offset:%8\n\tds_read_b64_tr_b16 %3, %7 offset:%8" \
    : "=&v"(R[0]), "=&v"(R[1]), "=&v"(R[2]), "=&v"(R[3]) : "v"(A0), "v"(A1), "v"(A2), "v"(A3), "i"(OFF) : "memory")
#define NSA_LWAIT(N, R) asm volatile("s_waitcnt lgkmcnt(" #N ")" : "+v"(R[0]), "+v"(R[1]), "+v"(R[2]), "+v"(R[3]) :: "memory")
struct NsaWave {
    float m, l;
    f32x16 O[4];
    bf16x8 q[8];
};
template <int MODE>
DI void nsa_tile_compute(NsaWave& W, unsigned kbuf, unsigned vbuf, const unsigned (&vaddr0)[8], int tq0, int kind, int kbeg, bool needmask, bool rowneed, int lane, LAS float* impA, LAS float* impL, int mblk0) {
    const int c = lane & 31, h = lane >> 5;
    constexpr float C2 = ATT_SCALE * 1.4426950408889634f;
    f32x16 s0, s1;
    const f32x16 zero16 = {0.f, 0.f, 0.f, 0.f, 0.f, 0.f, 0.f, 0.f, 0.f, 0.f, 0.f, 0.f, 0.f, 0.f, 0.f, 0.f};
    const unsigned f = ((c & 3u) << 2) | ((c >> 2) & 3u);
#ifndef NSA_REP_QK
#define NSA_REP_QK 1
#endif
    __builtin_amdgcn_s_setprio(1);
#pragma unroll 1
    for (int rq_ = 0; rq_ < NSA_REP_QK; ++rq_) {
        if (NSA_REP_QK > 1) asm volatile("" ::: "memory");
#pragma unroll
    for (int s = 0; s < 8; ++s) { const unsigned ch = (unsigned)(2 * s + h) ^ f;
        const bf16x8 a0 = *(const LAS bf16x8*)(size_t)(kbuf + 256u * c + 16u * ch), a1 = *(const LAS bf16x8*)(size_t)(kbuf + 8192u + 256u * c + 16u * ch);
        s0 = MFMA32(a0, W.q[s], s == 0 ? zero16 : s0); s1 = MFMA32(a1, W.q[s], s == 0 ? zero16 : s1); } }
    __builtin_amdgcn_s_setprio(0);
    if (needmask) {
        const int tq = tq0 + (c >> 2);
        const int lo = kind == 2 ? tq - 511 : 0, hi = kind == 0 ? (tq >= 31 ? (tq - 31) >> 4 : -1) : tq;
#pragma unroll
        for (int r = 0; r < 16; ++r) { const int k0 = kbeg + (r & 3) + 8 * (r >> 2) + 4 * h, k1 = k0 + 32;
            if (!(k0 >= lo && k0 <= hi)) s0[r] = -INFINITY;
            if (!(k1 >= lo && k1 <= hi)) s1[r] = -INFINITY; }
    }
    if (MODE != 2) {
        float mx = fmaxf(fmaxf(s0[0], s0[1]), s1[0]);
#pragma unroll
        for (int r = 2; r < 16; r += 2) mx = fmaxf(fmaxf(mx, s0[r]), s0[r + 1]);
#pragma unroll
        for (int r = 1; r < 15; r += 2) mx = fmaxf(fmaxf(mx, s1[r]), s1[r + 1]);
        mx = fmaxf(mx, s1[15]);
        mx = fmaxf(mx, __shfl_xor(mx, 32));
        if (!rowneed) mx = -INFINITY;
        const float mn = (W.m == -INFINITY || (mx - W.m) * C2 > 8.f) ? fmaxf(W.m, mx) : W.m;
        const float mu = (mn == -INFINITY) ? 0.f : mn;
        const float alpha = __builtin_amdgcn_exp2f((W.m - mu) * C2);
        const float nb = rowneed ? -mu * C2 : -INFINITY;
        float rs = 0.f;
#pragma unroll
        for (int r = 0; r < 16; ++r) { s0[r] = __builtin_amdgcn_exp2f(__builtin_fmaf(s0[r], C2, nb)); s1[r] = __builtin_amdgcn_exp2f(__builtin_fmaf(s1[r], C2, nb)); rs += s0[r] + s1[r]; }
        rs += __shfl_xor(rs, 32);
        W.l = W.l * alpha + rs; W.m = mn;
        if (MODE == 0 && !__all(alpha == 1.f)) {
#pragma unroll
            for (int d = 0; d < 4; ++d)
#pragma unroll
                for (int r = 0; r < 16; ++r) W.O[d][r] *= alpha; }
    } else {
#pragma unroll
        for (int r = 0; r < 16; ++r) { s0[r] = __builtin_amdgcn_exp2f((s0[r] - W.m) * C2) * W.l; s1[r] = __builtin_amdgcn_exp2f((s1[r] - W.m) * C2) * W.l; }
#pragma unroll
        for (int kb = 0; kb < 2; ++kb)
#pragma unroll
            for (int i = 0; i < 4; ++i) { const f32x16& sv = kb ? s1 : s0;
                float a = sv[4 * i] + sv[4 * i + 1] + sv[4 * i + 2] + sv[4 * i + 3], lv = sv[4 * i + 3];
                a += __shfl_xor(a, 1); a += __shfl_xor(a, 2); lv += __shfl_xor(lv, 1); lv += __shfl_xor(lv, 2);
                if ((c & 3) == 0) { const int mb = mblk0 + 8 * kb + 2 * i + h; impA[(c >> 2) * 128 + mb] = a; impL[(c >> 2) * 128 + mb] = lv; } }
    }
    if (MODE != 1) {
        unsigned vaddrl[8];
        { const unsigned q = (lane & 15) >> 2, pp = lane & 3, blk = (lane >> 4) & 1;
#pragma unroll
          for (int d = 0; d < 4; ++d)
#pragma unroll
              for (int t = 0; t < 2; ++t) vaddrl[2 * d + t] = vbuf + offb(8u * t + 4u * h + q, 4u * d + 2u * blk + (pp >> 1)) + 8u * (pp & 1u); }
        bf16x8 pf[4] = {pack_p(s0, 0), pack_p(s0, 1), pack_p(s1, 0), pack_p(s1, 1)};
        s16x4 RA[4], RB[4];
        asm volatile("s_waitcnt lgkmcnt(0)" ::: "memory");
        NSA_TR4(RA, vaddrl[0], vaddrl[1], vaddrl[2], vaddrl[3], 0);
        NSA_TR4(RB, vaddrl[4], vaddrl[5], vaddrl[6], vaddrl[7], 0);
#define NSA_PVSTEP(KS, NEXTOFF, HASNEXT) \
        NSA_LWAIT(4, RA); __builtin_amdgcn_sched_barrier(0); \
        { const bf16x8 v0_ = __builtin_shufflevector(RA[0], RA[1], 0, 1, 2, 3, 4, 5, 6, 7), v1_ = __builtin_shufflevector(RA[2], RA[3], 0, 1, 2, 3, 4, 5, 6, 7); \
          W.O[0] = MFMA32(v0_, pf[KS], W.O[0]); W.O[1] = MFMA32(v1_, pf[KS], W.O[1]); } \
        __builtin_amdgcn_sched_barrier(0); \
        if (HASNEXT) NSA_TR4(RA, vaddrl[0], vaddrl[1], vaddrl[2], vaddrl[3], NEXTOFF); \
        if (HASNEXT) NSA_LWAIT(4, RB); else NSA_LWAIT(0, RB); \
        __builtin_amdgcn_sched_barrier(0); \
        { const bf16x8 v2_ = __builtin_shufflevector(RB[0], RB[1], 0, 1, 2, 3, 4, 5, 6, 7), v3_ = __builtin_shufflevector(RB[2], RB[3], 0, 1, 2, 3, 4, 5, 6, 7); \
          W.O[2] = MFMA32(v2_, pf[KS], W.O[2]); W.O[3] = MFMA32(v3_, pf[KS], W.O[3]); } \
        __builtin_amdgcn_sched_barrier(0); \
        if (HASNEXT) NSA_TR4(RB, vaddrl[4], vaddrl[5], vaddrl[6], vaddrl[7], NEXTOFF);
        __builtin_amdgcn_s_setprio(1);
        NSA_PVSTEP(0, 4096, true) NSA_PVSTEP(1, 8192, true) NSA_PVSTEP(2, 12288, true) NSA_PVSTEP(3, 0, false)
        __builtin_amdgcn_s_setprio(0);
#undef NSA_PVSTEP
    }
}
DI void nsa_fold(const NsaWave& W, bf16_t* obrow, unsigned char* ob8row, float sc, bool first, bool last, int h) {
#pragma unroll
    for (int d = 0; d < 4; ++d)
#pragma unroll
        for (int i = 0; i < 4; ++i) { bf16_t* pp = obrow + 32 * d + 8 * i + 4 * h; float o0 = 0.f, o1 = 0.f, o2 = 0.f, o3 = 0.f;
            if (!first) { const u32x2 w = *(const u32x2*)pp; o0 = bflo(w[0]); o1 = bfhi(w[0]); o2 = bflo(w[1]); o3 = bfhi(w[1]); }
            o0 += sc * W.O[d][4 * i]; o1 += sc * W.O[d][4 * i + 1]; o2 += sc * W.O[d][4 * i + 2]; o3 += sc * W.O[d][4 * i + 3];
            if (last) *(unsigned*)(ob8row + 32 * d + 8 * i + 4 * h) = pg8::fp8x4(o0 * pg8::A8_SCALE, o1 * pg8::A8_SCALE, o2 * pg8::A8_SCALE, o3 * pg8::A8_SCALE);
            else *(u32x2*)pp = (u32x2){cvt2(o0, o1), cvt2(o2, o3)}; }
}
struct NsaRun { LAS char* L; unsigned lds0; const bf16_t* kbase; const bf16_t* vbase; int t0, nt, kind, tqmin, lo_min, lo_max, hi_min, hi_max, tid, w; LAS unsigned* selm; LAS float* impA; LAS float* impL; };
template <int MODE>
DI void nsa_tiles(NsaWave& W, const NsaRun& R, const unsigned (&vaddr)[8]) {
    if (R.nt <= 0) return;
    const int lane = R.tid & 63, c = lane & 31;
    __syncthreads();
    nsa_tile_dma(R.L, R.L + 16384, R.kbase + (size_t)R.t0 * 8192, R.vbase + (size_t)R.t0 * 8192, R.tid, R.w);
    asm volatile("s_waitcnt vmcnt(0)" ::: "memory");
    __syncthreads();
#pragma unroll 1
    for (int i = 0; i < R.nt; ++i) {
        const int cur = i & 1, tt = R.t0 + i, kbeg = tt * 64;
        if (i + 1 < R.nt) nsa_tile_dma(R.L + (cur ^ 1) * 32768, R.L + (cur ^ 1) * 32768 + 16384, R.kbase + (size_t)(tt + 1) * 8192, R.vbase + (size_t)(tt + 1) * 8192, R.tid, R.w);
        bool rowneed = true;
        if (R.kind == 1) { const unsigned wsel = R.selm[(c >> 2) * 4 + (tt >> 5)]; rowneed = (wsel >> (tt & 31)) & 1u; }
        const bool skip = kbeg > R.hi_max || kbeg + 63 < R.lo_min || (R.kind == 1 && __ballot(rowneed) == 0ull);
        if (!skip) {
            const bool needmask = !(kbeg >= R.lo_max && kbeg + 63 <= R.hi_min);
            const unsigned kb_ = R.lds0 + cur * 32768u, vb_ = kb_ + 16384u;
            nsa_tile_compute<MODE>(W, kb_, vb_, vaddr, R.tqmin, R.kind, kbeg, needmask, rowneed, lane, R.impA, R.impL, MODE == 2 ? tt * 16 : 0);
        }
        asm volatile("s_waitcnt vmcnt(0)" ::: "memory");
        __syncthreads();
    }
}
DI void phase_nsa_mfma(const Params& p, char* smem) {
    const int tid = tid_fresh(), lane = tid & 63, w = __builtin_amdgcn_readfirstlane(tid >> 6), c = lane & 31, h = lane >> 5;
    LAS char* L = (LAS char*)smem;
    const unsigned lds0 = (unsigned)(size_t)L;
    LAS float* impA = (LAS float*)(L + 65536) + w * 1024; LAS float* impL = (LAS float*)(L + 65536 + 32768) + w * 1024;
    LAS unsigned* selm = (LAS unsigned*)(L + 131072) + w * 32;
    const bf16_t* BQ = (const bf16_t*)(p.ws + O_BQ); const bf16_t* kvs = (const bf16_t*)(p.ws + O_KVS); const bf16_t* kcvc = (const bf16_t*)(p.ws + O_KCVC);
    const float* gates = (const float*)(p.ws + O_GATES); bf16_t* OB = (bf16_t*)(p.ws + O_OB);
    unsigned vaddr[8];
    { const unsigned q = (lane & 15) >> 2, pp = lane & 3, blk = (lane >> 4) & 1;
#pragma unroll
      for (int d = 0; d < 4; ++d)
#pragma unroll
          for (int t = 0; t < 2; ++t) vaddr[2 * d + t] = offb(8u * t + 4u * h + q, 4u * d + 2u * blk + (pp >> 1)) + 8u * (pp & 1u); }
#pragma unroll 1
    for (int P = blockIdx.x; P < 256; P += gridDim.x) {
#pragma unroll 1
        for (int half = 0; half < 2; ++half) {
            const int bg = P >> 6, x = P & 63, qb = half == 0 ? 127 - x : x, b = bg >> 1, g = bg & 1, q0 = qb * 64;
            NsaWave W;
            const int tqmin = q0 + 8 * w, tqmax = tqmin + 7; const int tok = b * T + tqmin + (c >> 2);
            { const bf16_t* qr = BQ + (size_t)tok * 1024 + (g * 4 + (c & 3)) * 128 + 8 * h;
#pragma unroll
              for (int s = 0; s < 8; ++s) W.q[s] = *(const bf16x8*)(qr + 16 * s); }
#pragma unroll
            for (int i = 0; i < 16; ++i) { impA[lane + 64 * i] = 0.f; impL[lane + 64 * i] = 0.f; }
            for (int step = 0; step < 4; ++step) {
                const int kind = step < 2 ? 0 : step - 1;
                const bf16_t* kbase; const bf16_t* vbase; int t0, nt;
                int lo_min, lo_max, hi_min, hi_max;
                if (kind == 0) { kbase = kcvc + (size_t)bg * 512 * 128; vbase = kcvc + (size_t)2048 * 128 + (size_t)bg * 512 * 128;
                    t0 = 0; const int nlast = (q0 + 63 - 31) >> 4; nt = q0 + 63 >= 31 ? (nlast >> 6) + 1 : 0;
                    lo_min = 0; lo_max = 0; hi_min = tqmin >= 31 ? (tqmin - 31) >> 4 : -1; hi_max = tqmax >= 31 ? (tqmax - 31) >> 4 : -1; }
                else if (kind == 1) { kbase = kvs + (2 * (size_t)NB * 2 + bg) * T * 128; vbase = kvs + (3 * (size_t)NB * 2 + bg) * T * 128;
                    t0 = 0; nt = qb + 1; lo_min = 0; lo_max = 0; hi_min = tqmin; hi_max = tqmax; }
                else { kbase = kvs + (4 * (size_t)NB * 2 + bg) * T * 128; vbase = kvs + (5 * (size_t)NB * 2 + bg) * T * 128;
                    t0 = qb >= 8 ? qb - 8 : 0; nt = qb - t0 + 1; lo_min = tqmin - 511; lo_max = tqmax - 511; hi_min = tqmin; hi_max = tqmax; }
                if (step != 1) { W.m = -INFINITY; W.l = 0.f; }
#pragma unroll
                for (int d = 0; d < 4; ++d)
#pragma unroll
                    for (int r = 0; r < 16; ++r) W.O[d][r] = 0.f;
                {   NsaRun R; R.L = L; R.lds0 = lds0; R.kbase = kbase; R.vbase = vbase; R.t0 = t0; R.nt = nt; R.kind = kind; R.tqmin = tqmin; R.lo_min = lo_min; R.lo_max = lo_max; R.hi_min = hi_min; R.hi_max = hi_max;
                    R.tid = tid; R.w = w; R.selm = selm; R.impA = impA; R.impL = impL;
                    if (step == 0) nsa_tiles<1>(W, R, vaddr); else if (step == 1) nsa_tiles<2>(W, R, vaddr); else nsa_tiles<0>(W, R, vaddr); }
                if (step == 0) { if (W.m == -INFINITY) W.m = 0.f; W.l = 1.f / fmaxf(W.l, 1e-30f); continue; }
                { int lz = lane; asm volatile("" : "+v"(lz)); const int cz = lz & 31; const int tokz = b * T + tqmin + (cz >> 2);
                  const float gv = gates[(size_t)tokz * 24 + (g * 4 + (cz & 3)) * 3 + kind];
                  nsa_fold(W, OB + (size_t)tokz * 1024 + (g * 4 + (cz & 3)) * 128, (unsigned char*)(p.ws + O_OB8) + (size_t)tokz * 1024 + (g * 4 + (cz & 3)) * 128, step == 1 ? gv : gv / fmaxf(W.l, 1e-30f), step == 1, step == 3, lz >> 5); }
                if (step == 1) {
                    asm volatile("s_waitcnt lgkmcnt(0)" ::: "memory");
#pragma unroll 1
                    for (int qi = 0; qi < 8; ++qi) { const int tqq = tqmin + qi, curb = tqq >> 6; unsigned key[2];
#pragma unroll
                        for (int hh = 0; hh < 2; ++hh) { const int mb = lane + 64 * hh; const float imp = impA[qi * 128 + mb] + (mb > 0 ? impL[qi * 128 + mb - 1] : 0.f);
                            const bool adm = mb <= curb, forced = mb == 0 || mb == curb || mb == curb - 1;
                            key[hh] = !adm ? 0u : (forced ? (0xFF000000u | (unsigned)(127 - mb)) : ((((__float_as_uint(imp) >> 7) + 1u) << 7) | (unsigned)(127 - mb))); }
                        unsigned Tv = 0u;
                        for (int bit = 31; bit >= 0; --bit) { const unsigned cand = Tv | (1u << bit);
                            const int cnt = __popcll(__ballot(key[0] >= cand)) + __popcll(__ballot(key[1] >= cand)); if (cnt >= 16) Tv = cand; }
                        if (Tv == 0u) Tv = 1u;
                        const unsigned long long m0 = __ballot(key[0] >= Tv), m1 = __ballot(key[1] >= Tv);
                        if (lane == 0) { selm[qi * 4] = (unsigned)m0; selm[qi * 4 + 1] = (unsigned)(m0 >> 32); selm[qi * 4 + 2] = (unsigned)m1; selm[qi * 4 + 3] = (unsigned)(m1 >> 32); } }
                    asm volatile("s_waitcnt lgkmcnt(0)" ::: "memory");
                }
            }
        }
    }
}

DI void topk256_hist(LAS unsigned short* sck, int nk, LAS unsigned* hist, unsigned short* out, int lane) {
    const int nit = (nk + 511) >> 9;
    const unsigned long long ltm = (1ull << lane) - 1ull;
    for (int k = nk + lane; k < 512 * nit; k += 64) sck[k] = 0;
    unsigned bsel = 0, cnt_above = 0;
#pragma unroll 1
    for (int pass = 0; pass < 2; ++pass) {
        *(LAS u32x4*)(hist + 4 * lane) = (u32x4){0u, 0u, 0u, 0u};
        asm volatile("s_waitcnt lgkmcnt(0)" ::: "memory");
#pragma unroll 1
        for (int i = 0; i < nit; ++i) { const int k0 = 8 * (i * 64 + lane); const u32x4 wv = *(const LAS u32x4*)(sck + k0);
#pragma unroll
            for (int j = 0; j < 8; ++j) { const unsigned key = (j & 1) ? (wv[j >> 1] >> 16) : (wv[j >> 1] & 0xffffu);
                if (pass == 0) __hip_atomic_fetch_add(hist + (key >> 8), 1u, __ATOMIC_RELAXED, __HIP_MEMORY_SCOPE_WORKGROUP);
                else if ((key >> 8) == bsel) __hip_atomic_fetch_add(hist + (key & 255u), 1u, __ATOMIC_RELAXED, __HIP_MEMORY_SCOPE_WORKGROUP); } }
        asm volatile("s_waitcnt lgkmcnt(0)" ::: "memory");
        const u32x4 c4 = *(const LAS u32x4*)(hist + 4 * lane);
        const unsigned tot = c4[0] + c4[1] + c4[2] + c4[3];
        unsigned inc = tot;
#pragma unroll
        for (int o = 1; o < 64; o <<= 1) { const unsigned v = __shfl_down(inc, o); if (lane + o < 64) inc += v; }
        unsigned above = cnt_above + inc - tot;
        int found = -1; unsigned fabove = 0;
#pragma unroll
        for (int bb = 3; bb >= 0; --bb) { if (found < 0 && above < 256u && above + c4[bb] >= 256u) { found = 4 * lane + bb; fabove = above; } above += c4[bb]; }
        const unsigned long long fm = __ballot(found >= 0); const int src = __builtin_ctzll(fm);
        const unsigned fb = (unsigned)__shfl(found, src); cnt_above = (unsigned)__shfl((int)fabove, src);
        bsel = pass == 0 ? fb : ((bsel << 8) | fb);
    }
    const unsigned Tv = bsel; const int need = 256 - (int)cnt_above; int pos = 0, eqc = 0;
#pragma unroll 1
    for (int i = 0; i < nit; ++i) { const int k0 = 8 * (i * 64 + lane); const u32x4 wv = *(const LAS u32x4*)(sck + k0);
        bool eq[8], sl[8]; bool anyeq = false;
#pragma unroll
        for (int j = 0; j < 8; ++j) { const unsigned key = (j & 1) ? (wv[j >> 1] >> 16) : (wv[j >> 1] & 0xffffu); eq[j] = key == Tv; sl[j] = key > Tv; anyeq |= eq[j]; }
        if (__ballot(anyeq) != 0ull) {
            int below = 0, own = 0, etot = 0;
#pragma unroll
            for (int j = 0; j < 8; ++j) { const unsigned long long em = __ballot(eq[j]); below += __popcll(em & ltm); etot += __popcll(em); }
#pragma unroll
            for (int j = 0; j < 8; ++j) if (eq[j]) { if (eqc + below + own < need) sl[j] = true; ++own; }
            eqc += etot; }
#pragma unroll
        for (int j = 0; j < 8; ++j) { const unsigned long long sm = __ballot(sl[j]); if (sl[j]) out[pos + __popcll(sm & ltm)] = (unsigned short)(k0 + j); pos += __popcll(sm); } }
}
DI void phase_indexer_mfma(const Params& p, char* smem) {
    const int tid = tid_fresh(), lane = tid & 63, w = __builtin_amdgcn_readfirstlane(tid >> 6), c = lane & 31, hh = lane >> 5;
    LAS unsigned short* sc = (LAS unsigned short*)(LAS char*)smem;
    LAS unsigned* hist = (LAS unsigned*)((LAS char*)smem + 131072) + w * 256;
    const bf16_t* Q = (const bf16_t*)(p.ws + O_QALL); const bf16_t* KI = (const bf16_t*)(p.ws + O_KIDX); const float* WI = (const float*)(p.ws + O_WIDX);
    unsigned short* SEL = (unsigned short*)(p.ws + O_SEL); int* NSEL = (int*)(p.ws + O_NSEL);
    const float* rope = (const float*)(p.ws + O_ROPE);
    c2_rows(p, smem);
    __syncthreads();
#pragma unroll 1
    for (int rnd = 0; rnd * (int)gridDim.x < NT / 8; ++rnd) {
        const int slot = (rnd & 1) ? (int)gridDim.x - 1 - (int)blockIdx.x : (int)blockIdx.x;
        const int u = NT / 8 - 1 - (rnd * (int)gridDim.x + slot);
        if (u < 0) continue;
        const int tok0 = u * 8, b = tok0 >> 13, q0 = tok0 & (T - 1), nkmax = q0 + 8;
        const int tok = tok0 + w, nk = q0 + w + 1;
        unsigned short* out = SEL + (size_t)tok * 256;
#ifndef IDX_REP_SCORE
#define IDX_REP_SCORE 1
#endif
#ifndef IDX_REP_SEL
#define IDX_REP_SEL 1
#endif
        for (int rs_ = 0; rs_ < IDX_REP_SCORE; ++rs_)
        if (nkmax > 256) {
            bf16x8 qa[2][4], Wf[2][2];
#pragma unroll
            for (int rb = 0; rb < 2; ++rb) { const bf16_t* qr = Q + (size_t)(tok0 + 4 * rb + (c >> 3)) * QC + 2304 + (c & 7) * 64 + 8 * hh;
#pragma unroll
                for (int s = 0; s < 4; ++s) qa[rb][s] = *(const bf16x8*)(qr + 16 * s);
                {
                    const float* rt = rope + (size_t)(tok0 + 4 * rb + (c >> 3)) * 48 + 32;
                    const u32x4 own = __builtin_bit_cast(u32x4, qa[rb][0]); u32x4 oth;
#pragma unroll
                    for (int k = 0; k < 4; ++k) oth[k] = (unsigned)__shfl_xor((int)own[k], 32);
                    float xa[8], xb[8], xr[8]; unpack8(own, xa); unpack8(oth, xb);
#pragma unroll
                    for (int j = 0; j < 8; ++j) { const float cs = rt[2 * j], sn = rt[2 * j + 1]; xr[j] = hh == 0 ? xa[j] * cs - xb[j] * sn : xa[j] * cs + xb[j] * sn; }
                    const u32x4 pk = {pk2(xr[0], xr[1]), pk2(xr[2], xr[3]), pk2(xr[4], xr[5]), pk2(xr[6], xr[7])};
                    qa[rb][0] = __builtin_bit_cast(bf16x8, pk); }
                { f32x4 wv = {0.f, 0.f, 0.f, 0.f}; if (c < 8) wv = *(const f32x4*)(WI + (size_t)(tok0 + c) * 8 + 4 * hh);
#pragma unroll
                  for (int sp = 0; sp < 2; ++sp) { const bool m0 = c == 4 * rb + 2 * sp, m1 = c == 4 * rb + 2 * sp + 1;
                      const u32x4 pkw = {m0 ? pk2(wv[0], wv[1]) : 0u, m0 ? pk2(wv[2], wv[3]) : 0u, m1 ? pk2(wv[0], wv[1]) : 0u, m1 ? pk2(wv[2], wv[3]) : 0u};
                      Wf[rb][sp] = __builtin_bit_cast(bf16x8, pkw); } } }
            const int npair = (nkmax + 63) >> 6;
            const bf16_t* kbase = KI + ((size_t)b * T + c) * 64 + 8 * hh;
            bf16x8 kb[2][4], kn[2][4];
            auto ldk = [&](bf16x8 (&dst)[2][4], int pr) {
#pragma unroll
                for (int tt = 0; tt < 2; ++tt) { int key0 = 64 * pr + 32 * tt; if (key0 + 31 >= T) key0 = T - 32;
#pragma unroll
                    for (int s = 0; s < 4; ++s) dst[tt][s] = *(const bf16x8*)(kbase + (size_t)key0 * 64 + 16 * s); } };
            if (w < npair) ldk(kb, w);
#pragma unroll 1
            for (int pr = w; pr < npair; pr += 8) {
                if (pr + 8 < npair) ldk(kn, pr + 8);
#pragma unroll
                for (int tt = 0; tt < 2; ++tt) {
                    const int key = 64 * pr + 32 * tt + c;
                    f32x16 a0, a1; const f32x16 z16 = {0.f, 0.f, 0.f, 0.f, 0.f, 0.f, 0.f, 0.f, 0.f, 0.f, 0.f, 0.f, 0.f, 0.f, 0.f, 0.f};
#pragma unroll
                    for (int s = 0; s < 4; ++s) { a0 = MFMA32(qa[0][s], kb[tt][s], s == 0 ? z16 : a0); a1 = MFMA32(qa[1][s], kb[tt][s], s == 0 ? z16 : a1); }
#pragma unroll
                    for (int i = 0; i < 16; ++i) { a0[i] = fmaxf(a0[i], 0.f); a1[i] = fmaxf(a1[i], 0.f); }
                    f32x16 d2 = MFMA32(Wf[0][0], pack_p(a0, 0), z16);
                    d2 = MFMA32(Wf[0][1], pack_p(a0, 1), d2); d2 = MFMA32(Wf[1][0], pack_p(a1, 0), d2); d2 = MFMA32(Wf[1][1], pack_p(a1, 1), d2);
                    if (key < 8192) {
#pragma unroll
                        for (int qq = 0; qq < 4; ++qq) sc[(4 * hh + qq) * 8192 + key] = f16key(d2[qq]); }
                }
#pragma unroll
                for (int tt = 0; tt < 2; ++tt)
#pragma unroll
                    for (int s = 0; s < 4; ++s) kb[tt][s] = kn[tt][s];
            }
        }
        __syncthreads();
        if (nk <= 256) { for (int i = lane; i < 256; i += 64) out[i] = (unsigned short)(i < nk ? i : 0); if (lane == 0) NSEL[tok] = nk; }
        else { for (int rs_ = 0; rs_ < IDX_REP_SEL; ++rs_) topk256_hist(sc + w * 8192, nk, hist, out, lane); if (lane == 0) NSEL[tok] = 256; }
        __syncthreads();
    }
}

#define MFMA16(a, b, c) __builtin_amdgcn_mfma_f32_16x16x32_bf16((a), (b), (c), 0, 0, 0)
#define MLA_ROW 592
#define MLA_TR8(R, BASE, OFF) asm volatile( \
    "ds_read_b64_tr_b16 %0, %8 offset:%9\n\tds_read_b64_tr_b16 %1, %8 offset:%10\n\tds_read_b64_tr_b16 %2, %8 offset:%11\n\tds_read_b64_tr_b16 %3, %8 offset:%12\n\t" \
    "ds_read_b64_tr_b16 %4, %8 offset:%13\n\tds_read_b64_tr_b16 %5, %8 offset:%14\n\tds_read_b64_tr_b16 %6, %8 offset:%15\n\tds_read_b64_tr_b16 %7, %8 offset:%16\n\ts_waitcnt lgkmcnt(0)" \
    : "=&v"(R[0]), "=&v"(R[1]), "=&v"(R[2]), "=&v"(R[3]), "=&v"(R[4]), "=&v"(R[5]), "=&v"(R[6]), "=&v"(R[7]) \
    : "v"(BASE), "i"(OFF), "i"((OFF) + 16 * MLA_ROW), "i"((OFF) + 32), "i"((OFF) + 32 + 16 * MLA_ROW), "i"((OFF) + 64), "i"((OFF) + 64 + 16 * MLA_ROW), "i"((OFF) + 96), "i"((OFF) + 96 + 16 * MLA_ROW) : "memory")
DI void phase_mla_mfma(const Params& p, char* smem) {
    const int tid = tid_fresh(), lane = tid & 63, w = __builtin_amdgcn_readfirstlane(tid >> 6), fr = lane & 15, g = lane >> 4;
    LAS char* buf = (LAS char*)smem + w * (32 * MLA_ROW);
    const unsigned lbase = (unsigned)(size_t)buf;
    const bf16_t* Q = (const bf16_t*)(p.ws + O_QALL); const bf16_t* KV = (const bf16_t*)(p.ws + O_KVT);
    const unsigned short* SEL = (const unsigned short*)(p.ws + O_SEL); const int* NSEL = (const int*)(p.ws + O_NSEL); bf16_t* OL = (bf16_t*)(p.ws + O_OLAT);
    constexpr float C2 = ATT_SCALE * 1.4426950408889634f;
    int pf_cnt = 0, pf_s0 = 0, pf_s1 = 0;
    { const int tok = blockIdx.x * 8 + w; if (tok < NT) { pf_cnt = NSEL[tok]; if (lane < 32) { pf_s0 = SEL[(size_t)tok * 256 + lane]; pf_s1 = SEL[(size_t)tok * 256 + 32 + lane]; } } }
#pragma unroll 1
    for (int tok = blockIdx.x * 8 + w; tok < NT; tok += gridDim.x * 8) {
        const int b = tok >> 13; const int cnt = pf_cnt; const int cur_s0 = pf_s0, cur_s1 = pf_s1;
        { const int tn = tok + gridDim.x * 8; if (tn < NT) { pf_cnt = NSEL[tn]; if (lane < 32) { pf_s0 = SEL[(size_t)tn * 256 + lane]; pf_s1 = SEL[(size_t)tn * 256 + 32 + lane]; } } }
        bf16x8 qf[9];
        { const bf16_t* qr = Q + (size_t)tok * QC; const bf16x8 z8 = {0, 0, 0, 0, 0, 0, 0, 0};
#pragma unroll
          for (int s = 0; s < 8; ++s) qf[s] = fr < 8 ? *(const bf16x8*)(qr + fr * 256 + 32 * s + 8 * g) : z8;
          qf[8] = fr < 8 ? *(const bf16x8*)(qr + 2048 + fr * 32 + 8 * g) : z8;
          {
              const float* rt = (const float*)(p.ws + O_ROPE) + (size_t)tok * 48;
              const u32x4 own = __builtin_bit_cast(u32x4, qf[8]); u32x4 oth;
#pragma unroll
              for (int k = 0; k < 4; ++k) oth[k] = (unsigned)__shfl_xor((int)own[k], 32);
              float xa[8], xb[8], xr[8]; unpack8(own, xa); unpack8(oth, xb);
#pragma unroll
              for (int j = 0; j < 8; ++j) { const int fi = 8 * (g & 1) + j; const float cs = rt[2 * fi], sn = rt[2 * fi + 1]; xr[j] = g < 2 ? xa[j] * cs - xb[j] * sn : xa[j] * cs + xb[j] * sn; }
              const u32x4 pk = {pk2(xr[0], xr[1]), pk2(xr[2], xr[3]), pk2(xr[4], xr[5]), pk2(xr[6], xr[7])};
              qf[8] = __builtin_bit_cast(bf16x8, pk); } }
        f32x4 O[16];
#pragma unroll
        for (int d = 0; d < 16; ++d) O[d] = (f32x4){0.f, 0.f, 0.f, 0.f};
        float m = -INFINITY, l = 0.f;
        const int nchunk = (cnt + 31) >> 5;
        u32x4 st[18]; int selv_n = 0;
        const bf16_t* kvb = KV + (size_t)b * T * KVW;
        auto issue = [&](int selv, int lz) {
#pragma unroll
            for (int i = 0; i < 16; ++i) { const int r0 = __builtin_amdgcn_readlane(selv, 2 * i), r1 = __builtin_amdgcn_readlane(selv, 2 * i + 1); const int row = lz < 32 ? r0 : r1;
                st[i] = *(const u32x4*)(kvb + (size_t)row * KVW + (lz & 31) * 8); }
#pragma unroll
            for (int i = 0; i < 2; ++i) { const int row = __shfl(selv, 16 * i + (lz >> 2)); st[16 + i] = *(const u32x4*)(kvb + (size_t)row * KVW + 256 + (lz & 3) * 8); } };
        { int lz = lane; asm volatile("" : "+v"(lz));
          int selv = 0; if (lz < 32 && lz < cnt) selv = cur_s0;
          if (lz < 32 && 32 + lz < cnt) selv_n = cur_s1;
          issue(selv, lz); }
#pragma unroll 1
        for (int ch = 0; ch < nchunk; ++ch) {
            int lz = lane; asm volatile("" : "+v"(lz));
#pragma unroll
            for (int i = 0; i < 16; ++i) *(LAS u32x4*)(buf + (2 * i + (lz >> 5)) * MLA_ROW + (lz & 31) * 16) = st[i];
#pragma unroll
            for (int i = 0; i < 2; ++i) *(LAS u32x4*)(buf + (16 * i + (lz >> 2)) * MLA_ROW + 512 + (lz & 3) * 16) = st[16 + i];
            if (ch + 1 < nchunk) {
                const int selv = selv_n; selv_n = 0;
                { const int k = (ch + 2) * 32 + lz; if (lz < 32 && k < cnt) selv_n = SEL[(size_t)tok * 256 + k]; }
                issue(selv, lz); }
            asm volatile("s_waitcnt lgkmcnt(0)" ::: "memory");
            const int frz = lz & 15, gz = lz >> 4;
            f32x4 s0, s1; const f32x4 z4 = {0.f, 0.f, 0.f, 0.f};
#pragma unroll
            for (int s = 0; s < 9; ++s) { const bf16x8 a0 = *(const LAS bf16x8*)(buf + frz * MLA_ROW + (32 * s + 8 * gz) * 2), a1 = *(const LAS bf16x8*)(buf + (frz + 16) * MLA_ROW + (32 * s + 8 * gz) * 2);
                s0 = MFMA16(a0, qf[s], s == 0 ? z4 : s0); s1 = MFMA16(a1, qf[s], s == 0 ? z4 : s1); }
            float mx = -INFINITY;
#pragma unroll
            for (int j = 0; j < 4; ++j) { if (ch * 32 + 4 * gz + j >= cnt) s0[j] = -INFINITY; if (ch * 32 + 16 + 4 * gz + j >= cnt) s1[j] = -INFINITY; mx = fmaxf(mx, fmaxf(s0[j], s1[j])); }
            mx = fmaxf(mx, __shfl_xor(mx, 16)); mx = fmaxf(mx, __shfl_xor(mx, 32));
            const float mn = fmaxf(m, mx), mu = (mn == -INFINITY) ? 0.f : mn;
            const float alpha = __builtin_amdgcn_exp2f((m - mu) * C2);
            float rs = 0.f;
#pragma unroll
            for (int j = 0; j < 4; ++j) { s0[j] = __builtin_amdgcn_exp2f((s0[j] - mu) * C2); s1[j] = __builtin_amdgcn_exp2f((s1[j] - mu) * C2); rs += s0[j] + s1[j]; }
            rs += __shfl_xor(rs, 16); rs += __shfl_xor(rs, 32);
            l = l * alpha + rs; m = mn;
            if (!__all(alpha == 1.f)) {
#pragma unroll
                for (int d = 0; d < 16; ++d) O[d] *= alpha; }
            const u32x4 pw = {cvt2(s0[0], s0[1]), cvt2(s0[2], s0[3]), cvt2(s1[0], s1[1]), cvt2(s1[2], s1[3])};
            const bf16x8 pf = __builtin_bit_cast(bf16x8, pw);
            const unsigned tb = lbase + (unsigned)(4 * gz + (frz >> 2)) * MLA_ROW + 8u * (frz & 3);
#pragma unroll
            for (int dq = 0; dq < 4; ++dq) { s16x4 R[8];
                if (dq == 0) MLA_TR8(R, tb, 0); else if (dq == 1) MLA_TR8(R, tb, 128); else if (dq == 2) MLA_TR8(R, tb, 256); else MLA_TR8(R, tb, 384);
#pragma unroll
                for (int d = 0; d < 4; ++d) { const bf16x8 vf = __builtin_shufflevector(R[2 * d], R[2 * d + 1], 0, 1, 2, 3, 4, 5, 6, 7); O[4 * dq + d] = MFMA16(vf, pf, O[4 * dq + d]); } }
            asm volatile("s_waitcnt lgkmcnt(0)" ::: "memory");
        }
        const float il16 = pg8::A8_SCALE / fmaxf(l, 1e-30f);
        if (fr < 8) {
#pragma unroll
            for (int d = 0; d < 16; ++d) *(unsigned*)((unsigned char*)OL + (size_t)tok * D + fr * 256 + 16 * d + 4 * g) = pg8::fp8x4(O[d][0] * il16, O[d][1] * il16, O[d][2] * il16, O[d][3] * il16); }
    }
}

DI void phase_post_mix(const Params& p, char* smem, bool count) {
    const int tz_ = tid_fresh(); const int lane = tz_ & 63, wid = __builtin_amdgcn_readfirstlane(tz_ >> 6);
    float* part = (float*)smem;
    int* lcnt = (int*)(smem + 8 * 32 * 33 * 4);
    const bf16_t* MO = (const bf16_t*)(p.ws + O_MO); float* X1 = (float*)(p.ws + O_X1); bf16_t* H = (bf16_t*)(p.ws + O_H); const bf16_t* WR = (const bf16_t*)(p.ws + O_WRT);
    int* TOPI = (int*)(p.ws + O_TOPI); float* TOPW = (float*)(p.ws + O_TOPW); int* cnts = (int*)(p.ws + O_CNT);
#pragma unroll 1
    for (int ck = blockIdx.x; ck < NT / 64; ck += gridDim.x) {
#pragma unroll 1
        for (int j = 0; j < 8; ++j) {
            const int tok = ck * 64 + wid * 8 + j, b = tok >> 13;
            float v[32]; float ss = 0.f;
#pragma unroll
            for (int i = 0; i < 8; ++i) { const u32x2 w = *(const u32x2*)(MO + (size_t)tok * D + 4 * (lane + 64 * i));
                v[4 * i] = bflo(w[0]); v[4 * i + 1] = bfhi(w[0]); v[4 * i + 2] = bflo(w[1]); v[4 * i + 3] = bfhi(w[1]); }
#pragma unroll
            for (int i = 0; i < 32; ++i) ss += v[i] * v[i];
            const float rs = rsqrtf(wave_sum(ss) * (1.f / D) + NORM_EPS);
            float ss2 = 0.f;
#pragma unroll
            for (int i = 0; i < 8; ++i) { const int col = 4 * (lane + 64 * i); const f32x4 xv = *(const f32x4*)(p.x + (size_t)tok * D + col); f32x4 o;
#pragma unroll
                for (int q = 0; q < 4; ++q) { o[q] = xv[q] + mod_at(p, b, 4096 + col + q) * (v[4 * i + q] * rs * p.g_post_mix[col + q]); v[4 * i + q] = o[q]; ss2 += o[q] * o[q]; }
                *(f32x4*)(X1 + (size_t)tok * D + col) = o; }
            const float rs2 = rsqrtf(wave_sum(ss2) * (1.f / D) + NORM_EPS);
#pragma unroll
            for (int i = 0; i < 8; ++i) { const int col = 4 * (lane + 64 * i); f32x4 hv;
#pragma unroll
                for (int q = 0; q < 4; ++q) hv[q] = v[4 * i + q] * rs2 * p.g_pre_ffn[col + q] * (1.f + mod_at(p, b, 4 * 2048 + col + q)) + mod_at(p, b, 3 * 2048 + col + q);
                *(u32x2*)(H + (size_t)tok * D + col) = (u32x2){pk2(hv[0], hv[1]), pk2(hv[2], hv[3])}; }
        }
        asm volatile("s_waitcnt vmcnt(0)" ::: "memory");
        __syncthreads();
        if (tz_ < 32) lcnt[tz_] = 0;
        {
            const int c = lane & 31, hh = lane >> 5, rb = wid & 1, ks = wid >> 1;
            const bf16_t* ap = H + (size_t)(ck * 64 + 32 * rb + c) * D + 512 * ks + 8 * hh; const bf16_t* bp = WR + (size_t)c * D + 512 * ks + 8 * hh;
            f32x16 acc;
#pragma unroll
            for (int i = 0; i < 16; ++i) acc[i] = 0.f;
#pragma unroll 8
            for (int sx = 0; sx < 32; ++sx) { const bf16x8 a = *(const bf16x8*)(ap + 16 * sx), bb = *(const bf16x8*)(bp + 16 * sx); acc = MFMA32(a, bb, acc); }
#pragma unroll
            for (int r = 0; r < 16; ++r) part[(wid * 32 + (r & 3) + 8 * (r >> 2) + 4 * hh) * 33 + c] = acc[r];
        }
        __syncthreads();
        if (tz_ < 64) {
            const int rbt = tz_ >> 5, row = tz_ & 31, tok = ck * 64 + tz_;
            float lg[32];
#pragma unroll
            for (int e = 0; e < 32; ++e) lg[e] = p.b_router[e] + part[((0 * 2 + rbt) * 32 + row) * 33 + e] + part[((1 * 2 + rbt) * 32 + row) * 33 + e] + part[((2 * 2 + rbt) * 32 + row) * 33 + e] + part[((3 * 2 + rbt) * 32 + row) * 33 + e];
            int te[4]; float tv[4];
#pragma unroll
            for (int k = 0; k < 4; ++k) { float mx = lg[0]; int bi = 0;
#pragma unroll
                for (int e = 1; e < 32; ++e) if (lg[e] > mx) { mx = lg[e]; bi = e; }
                te[k] = bi; tv[k] = mx;
#pragma unroll
                for (int e = 0; e < 32; ++e) if (e == bi) lg[e] = -INFINITY; }
            const float e1 = __expf(tv[1] - tv[0]), e2 = __expf(tv[2] - tv[0]), e3 = __expf(tv[3] - tv[0]); const float inv = 1.f / (1.f + e1 + e2 + e3);
            *(int4*)(TOPI + tok * 4) = make_int4(te[0], te[1], te[2], te[3]);
            *(f32x4*)(TOPW + tok * 4) = (f32x4){inv, e1 * inv, e2 * inv, e3 * inv};
            atomicAdd(lcnt + te[0], 1); atomicAdd(lcnt + te[1], 1); atomicAdd(lcnt + te[2], 1); atomicAdd(lcnt + te[3], 1);
        }
        __syncthreads();
        if (count && tz_ < 32) atomicAdd(cnts + tz_, lcnt[tz_]);
    }
}

DI int moe_tables(const Params& p, LAS int* tile_e, LAS int* pstart) {
    int* cnts = (int*)(p.ws + O_CNT);
    if (threadIdx.x < 64) {
        const int e = threadIdx.x & 31;
        const int c = __hip_atomic_load(cnts + e, __ATOMIC_RELAXED, __HIP_MEMORY_SCOPE_AGENT);
        const int nt = (c + 255) >> 8; int inc = nt;
#pragma unroll
        for (int o = 1; o < 32; o <<= 1) { const int v = __shfl_up(inc, o, 32); if (e >= o) inc += v; }
        const int start = inc - nt;
        if (threadIdx.x < 32) { pstart[e] = start * 256; for (int i = 0; i < nt; ++i) tile_e[start + i] = e; if (e == 31) pstart[NEXP] = inc; } }
    __syncthreads();
    return pstart[NEXP];
}
DI void phase_moe_gather(const Params& p, char* smem) {
    const int tz_ = tid_fresh(); const int lane = tz_ & 63, wid = __builtin_amdgcn_readfirstlane(tz_ >> 6);
    LAS int* tile_e = (LAS int*)(LAS char*)smem; LAS int* pstart = tile_e + 320; LAS int* lcnt = pstart + 40; LAS int* lbase = lcnt + 32;
    (void)moe_tables(p, tile_e, pstart);
    const bf16_t* H = (const bf16_t*)(p.ws + O_H); unsigned char* HS = (unsigned char*)(p.ws + O_HS);
    const int* TOPI = (const int*)(p.ws + O_TOPI); const float* TOPW = (const float*)(p.ws + O_TOPW); int* TSLOT = (int*)(p.ws + O_TSLOT); float* SLOTW = (float*)(p.ws + O_SLOTW);
    int* fill = (int*)(p.ws + O_CNT) + 32;
#pragma unroll 1
    for (int ck = blockIdx.x; ck < NT / 64; ck += gridDim.x) {
        const int tok0 = ck * 64 + wid * 8;
        __syncthreads();
        if (tz_ < 32) lcnt[tz_] = 0;
        __syncthreads();
        int e = 0, rank = 0;
        if (lane < 32) { e = TOPI[tok0 * 4 + lane]; rank = atomicAdd((int*)(lcnt + e), 1); }
        __syncthreads();
        if (tz_ < 32) lbase[tz_] = atomicAdd(fill + tz_, lcnt[tz_]);
        __syncthreads();
        int slot = 0;
        if (lane < 32) { slot = pstart[e] + lbase[e] + rank; TSLOT[tok0 * 4 + lane] = slot; SLOTW[slot] = TOPW[tok0 * 4 + lane]; }
#pragma unroll 2
        for (int j = 0; j < 8; ++j) { u32x2 hv[4];
#pragma unroll
            for (int i = 0; i < 4; ++i) { float f[8]; unpack8(*(const u32x4*)(H + (size_t)(tok0 + j) * D + 8 * (lane + 64 * i)), f);
                hv[i] = (u32x2){pg8::fp8x4(f[0], f[1], f[2], f[3]), pg8::fp8x4(f[4], f[5], f[6], f[7])}; }
#pragma unroll
            for (int k = 0; k < 4; ++k) { const int sl = __shfl(slot, j * 4 + k);
#pragma unroll
                for (int i = 0; i < 4; ++i) *(u32x2*)(HS + (size_t)sl * D + 8 * (lane + 64 * i)) = hv[i]; } }
    }
}
DI void phase_final(const Params& p) {
    const int tz_ = tid_fresh(); const int lane = tz_ & 63, wid = __builtin_amdgcn_readfirstlane(tz_ >> 6);
    const unsigned char* YS = (const unsigned char*)(p.ws + O_YS); const float* X1 = (const float*)(p.ws + O_X1); const int* TSLOT = (const int*)(p.ws + O_TSLOT);
    for (int tok = blockIdx.x * 8 + wid; tok < NT; tok += gridDim.x * 8) {
        const int b = tok >> 13; float v[32];
#pragma unroll
        for (int i = 0; i < 32; ++i) v[i] = 0.f;
#pragma unroll
        for (int k = 0; k < 4; ++k) { const int slot = TSLOT[tok * 4 + k];
#pragma unroll
            for (int i = 0; i < 8; ++i) { const unsigned w = *(const unsigned*)(YS + (size_t)slot * D + 4 * (lane + 64 * i));
                const auto lo = __builtin_amdgcn_cvt_pk_f32_fp8((int)w, false), hi = __builtin_amdgcn_cvt_pk_f32_fp8((int)w, true);
                v[4 * i] += lo[0]; v[4 * i + 1] += lo[1]; v[4 * i + 2] += hi[0]; v[4 * i + 3] += hi[1]; } }
#pragma unroll
        for (int i = 0; i < 32; ++i) v[i] *= pg8::Y8_INV;
        float ss = 0.f;
#pragma unroll
        for (int i = 0; i < 32; ++i) ss += v[i] * v[i];
        const float rs = rsqrtf(wave_sum(ss) * (1.f / D) + NORM_EPS);
#pragma unroll
        for (int i = 0; i < 8; ++i) { const int col = 4 * (lane + 64 * i); const f32x4 xv = *(const f32x4*)(X1 + (size_t)tok * D + col); f32x4 o;
#pragma unroll
            for (int j = 0; j < 4; ++j) o[j] = xv[j] + mod_at(p, b, 5 * 2048 + col + j) * (v[4 * i + j] * rs * p.g_post_ffn[col + j]);
            *(f32x4*)(p.out + (size_t)tok * D + col) = o; }
    }
}

#ifndef PHMASK
#define PHMASK 0xFFFFFFFFu
#endif
#define PHON(ph) (((PHMASK) >> (ph)) & 1u)
#ifndef REPMASK
#define REPMASK 0u
#endif
#define REP(ph) _Pragma("unroll 1") for (int rep_ = 0; rep_ <= (int)(((REPMASK) >> (ph)) & 1u); ++rep_)
enum { PH_PREP = 0, PH_H1, PH_GIN, PH_ZPOST, PH_GQ, PH_QROPE, PH_IDX, PH_MLA, PH_NSA, PH_MERGE, PH_GOUT, PH_POSTMIX, PH_GATHER, PH_GU, PH_DN, PH_FINAL, PH_END };

__global__ void __launch_bounds__(512, 2) mega(Params p, int lo, int hi) {
    extern __shared__ __attribute__((aligned(16))) char smem[];
    LAS unsigned char* lds = (LAS unsigned char*)(LAS char*)smem;
    volatile LAS unsigned* xbw = (volatile LAS unsigned*)(LAS char*)(smem + LDS_BYTES - 16);
    XcdBarrier bar; bar.bar = (unsigned*)p.ws; bar.x = 0; bar.st = xbw;
    if (hi - lo > 1) { if (threadIdx.x == 0) { xbw[0] = 0u; xbw[1] = 0u; } __syncthreads(); bar = xcd_barrier_post((unsigned*)p.ws, xbw); }
    const int G = gridDim.x, c = blockIdx.x;
#define SEAM(ph) if ((ph) + 1 < hi) xcd_barrier(bar);
    if (PHON(PH_PREP) && lo <= PH_PREP && PH_PREP < hi) { REP(PH_PREP) { phase_prep(p, smem); } SEAM(PH_PREP) }
    if (PHON(PH_H1) && lo <= PH_H1 && PH_H1 < hi) { REP(PH_H1) { phase_h1(p); } SEAM(PH_H1) }
    if (PHON(PH_GIN) && lo <= PH_GIN && PH_GIN < hi) { REP(PH_GIN) {
        { pg8::PlainSched S; S.init(NT, 2048, G, c, p.ws + O_H, D, p.ws + O_WIN, D);
          pg8::EpiBf16 E; E.O = (bf16_t*)(p.ws + O_Z); E.ldc = ZC; E.scale = 1.f;
          pg8::gemm_phase(lds, pg8::Gemm{D, D, D}, S, E); }
        { pg8::PlainSched S; S.init(NT, ZC - 2048, G, c, p.ws + O_H8, D / 2, p.ws + O_WIN8 + (size_t)2048 * D, D / 2);
          pg8::EpiBf16 E; E.O = (bf16_t*)(p.ws + O_Z) + 2048; E.ldc = ZC; E.scale = pg8::W8_INV;
          pg8::gemm_phase_fp8(lds, pg8::Gemm{D / 2, D / 2, D / 2}, S, E); }
        } SEAM(PH_GIN) }
    if (PHON(PH_ZPOST) && lo <= PH_ZPOST && PH_ZPOST < hi) { REP(PH_ZPOST) { phase_zpost(p); } SEAM(PH_ZPOST) }
    if (PHON(PH_GQ) && lo <= PH_GQ && PH_GQ < hi) { REP(PH_GQ) {
        { pg8::PlainSched S; S.init(NT, QC, G, c, p.ws + O_CQN, 512, p.ws + O_WQ, 512);
          pg8::EpiBf16 E; E.O = (bf16_t*)(p.ws + O_QALL); E.ldc = QC; E.scale = 1.f;
          pg8::gemm_phase(lds, pg8::Gemm{512, 512, 512}, S, E); }
        { pg8::C1Sched S; S.G = G; S.c = c; S.kvs = p.ws + O_KVS; S.w = p.ws + O_WC1;
          pg8::EpiC1 E; E.C = (float*)(p.ws + O_C1P);
          pg8::gemm_phase(lds, pg8::Gemm{2048, 4096, 256}, S, E); }
        } SEAM(PH_GQ) }
    if (PHON(PH_IDX) && lo <= PH_IDX && PH_IDX < hi) { REP(PH_IDX) {
#ifdef IDX_NAIVE
        phase_indexer(p, smem);
#else
        phase_indexer_mfma(p, smem);
#endif
        } SEAM(PH_IDX) }
    if (PHON(PH_MLA) && lo <= PH_MLA && PH_MLA < hi) { REP(PH_MLA) {
#ifdef MLA_NAIVE
        phase_mla(p, smem);
#else
        phase_mla_mfma(p, smem);
#endif
        } SEAM(PH_MLA) }
    if (PHON(PH_NSA) && lo <= PH_NSA && PH_NSA < hi) { REP(PH_NSA) {
#ifdef NSA_NAIVE
        phase_nsa(p, smem);
#else
        phase_nsa_mfma(p, smem);
#endif
        } SEAM(PH_NSA) }
    if (PHON(PH_MERGE) && lo <= PH_MERGE && PH_MERGE < hi) { REP(PH_MERGE) {
        { pg8::PlainSched S; S.init(NT, D, G, c, p.ws + O_OLAT, D / 2, p.ws + O_WO, D / 2);
          pg8::EpiMerge<false> E; E.P = (bf16_t*)(p.ws + O_MERGED); E.O8 = nullptr; E.Z = (const bf16_t*)(p.ws + O_Z); E.gcol0 = ZC_MG; E.scale = pg8::A8W8_INV;
          pg8::gemm_phase_fp8(lds, pg8::Gemm{D / 2, D / 2, D / 2}, S, E); }
        { pg8::PlainSched S; S.init(NT, D, G, c, p.ws + O_OB8, 512, p.ws + O_WBRB, 512);
          pg8::EpiMerge<true> E; E.P = (bf16_t*)(p.ws + O_MERGED); E.O8 = (unsigned char*)(p.ws + O_MG8); E.Z = (const bf16_t*)(p.ws + O_Z); E.gcol0 = ZC_MG + 2048; E.scale = pg8::A8W8_INV;
          pg8::gemm_phase_fp8(lds, pg8::Gemm{512, 512, 512}, S, E); }
        } SEAM(PH_MERGE) }
    if (PHON(PH_GOUT) && lo <= PH_GOUT && PH_GOUT < hi) { REP(PH_GOUT) {
        pg8::PlainSched S; S.init(NT, D, G, c, p.ws + O_MG8, D / 2, p.ws + O_WOUT, D / 2);
        pg8::EpiBf16 E; E.O = (bf16_t*)(p.ws + O_MO); E.ldc = D; E.scale = pg8::A8W8_INV;
        pg8::gemm_phase_fp8(lds, pg8::Gemm{D / 2, D / 2, D / 2}, S, E); } SEAM(PH_GOUT) }
    if (PHON(PH_POSTMIX) && lo <= PH_POSTMIX && PH_POSTMIX < hi) { REP(PH_POSTMIX) { phase_post_mix(p, smem, rep_ == 0); } SEAM(PH_POSTMIX) }
    if (PHON(PH_GATHER) && lo <= PH_GATHER && PH_GATHER < hi) { REP(PH_GATHER) { phase_moe_gather(p, smem); } SEAM(PH_GATHER) }
    if (PHON(PH_GU) && lo <= PH_GU && PH_GU < hi) { REP(PH_GU) {
        LAS int* tile_e = (LAS int*)(LAS char*)(smem + 131072); LAS int* pstart = tile_e + 320;
        const int mt = moe_tables(p, tile_e, pstart);
        pg8::MoeSched S; S.G = G; S.c = c; S.nN = 16; S.total = mt * 16; S.tile_e = tile_e; S.A = p.ws + O_HS; S.W = p.ws + O_WGU; S.w_exp = (size_t)4096 * D;
        pg8::EpiGU E; E.O = (unsigned char*)(p.ws + O_ACT); E.bias = p.b_gate_up;
        pg8::gemm_phase_fp8(lds, pg8::Gemm{D / 2, D / 2, D / 2}, S, E); } SEAM(PH_GU) }
    if (PHON(PH_DN) && lo <= PH_DN && PH_DN < hi) { REP(PH_DN) {
        LAS int* tile_e = (LAS int*)(LAS char*)(smem + 131072); LAS int* pstart = tile_e + 320;
        const int mt = moe_tables(p, tile_e, pstart);
        pg8::MoeSched S; S.G = G; S.c = c; S.nN = 8; S.total = mt * 8; S.tile_e = tile_e; S.A = p.ws + O_ACT; S.W = p.ws + O_WDN; S.w_exp = (size_t)D * D;
        pg8::EpiDN E; E.O = (unsigned char*)(p.ws + O_YS); E.bias = p.b_down; E.slotw = (const float*)(p.ws + O_SLOTW);
        pg8::gemm_phase_fp8(lds, pg8::Gemm{D / 2, D / 2, D / 2}, S, E); } SEAM(PH_DN) }
    if (PHON(PH_FINAL) && lo <= PH_FINAL && PH_FINAL < hi) { REP(PH_FINAL) { phase_final(p); } }
#undef SEAM
}

extern "C" void kernel_launch(void* const* d_in, const int* in_sizes, int n_in, void* d_out, int out_size, void* d_ws, size_t ws_size, hipStream_t stream) {
    static int grid = 0;
    if (grid == 0) {
        if (n_in != 33 || out_size != NT * D || ws_size < WS_END) { fprintf(stderr, "kernel_launch: unexpected shapes (n_in %d out %d ws %zu need %zu)\n", n_in, out_size, ws_size, (size_t)WS_END); grid = -1; return; }
        int dev = 0, cus = 0;
        if (hipGetDevice(&dev) != hipSuccess || hipDeviceGetAttribute(&cus, hipDeviceAttributeMultiprocessorCount, dev) != hipSuccess) { grid = -1; return; }
        if (hipFuncSetAttribute((const void*)mega, hipFuncAttributeMaxDynamicSharedMemorySize, LDS_BYTES) != hipSuccess) { fprintf(stderr, "kernel_launch: hipFuncSetAttribute failed\n"); grid = -1; return; }
        int per_cu = 0; (void)hipOccupancyMaxActiveBlocksPerMultiprocessor(&per_cu, (const void*)mega, 512, LDS_BYTES); (void)hipGetLastError();
        grid = cus;
    }
    if (grid < 0) return;
    Params p{};
    const float** pf = (const float**)&p;
    for (int i = 0; i < 33; ++i) pf[i] = (const float*)d_in[i];
    p.pos = (const int*)d_in[2];
    p.out = (float*)d_out; p.ws = (char*)d_ws;
    hipMemsetAsync(d_ws, 0, ZERO_BYTES, stream);
#ifdef MK_UNFUSED
    for (int ph = 0; ph < PH_END; ++ph) hipLaunchKernelGGL(mega, dim3(grid), dim3(512), LDS_BYTES, stream, p, ph, ph + 1);
#else
    hipLaunchKernelGGL(mega, dim3(grid), dim3(512), LDS_BYTES, stream, p, 0, (int)PH_END);
#endif
}
```

```cpp
#include <hip/hip_runtime.h>
#include <stdint.h>
#include <stdio.h>

#define LAS __attribute__((address_space(3)))
#define DI __device__ __forceinline__
typedef unsigned short bf16_t;
typedef short bf16x8 __attribute__((ext_vector_type(8)));
typedef float f32x4 __attribute__((ext_vector_type(4)));
typedef unsigned u32x4 __attribute__((ext_vector_type(4)));
typedef unsigned u32x2 __attribute__((ext_vector_type(2)));

#define PREP_PROBE_WC 0
#define PREP_PROBE_MODE 0
#define PREP_REP 0
#define PREP_REP_LO 0
#define PREP_REP_HI 100000
#define PREP_PROBE_NFAST 0
constexpr int NB = 2, T = 8192, NT = NB * T, D = 2048;
constexpr int ZC = 7680;
constexpr int ZC_CKV = 512, ZC_KROPE = 768, ZC_KIDX = 800, ZC_WIDX = 864, ZC_BGATE = 872, ZC_BQ = 1024, ZC_MG = 3584;
constexpr int QC = 2816;
constexpr int KVW = 288;
constexpr int NEXP = 32, SLOTS = 73728, MAXMT = SLOTS / 256;
constexpr float NORM_EPS = 1e-6f;
constexpr float ATT_SCALE = 0.08838834764831845f;
constexpr int LDS_BYTES = 152 * 1024;

constexpr size_t al256(size_t x) { return (x + 255) & ~(size_t)255; }
constexpr size_t ZERO_BYTES = 131072;
constexpr size_t O_MODACC = 16384, O_CNT = 114688;
constexpr size_t O_ROPE = ZERO_BYTES;
constexpr size_t O_WIN = O_ROPE + al256((size_t)NT * 48 * 4);
constexpr size_t O_WQ = O_WIN + al256((size_t)ZC * D * 2);
constexpr size_t O_WO = O_WQ + al256((size_t)QC * 512 * 2);
constexpr size_t O_WBRB = O_WO + al256((size_t)D * D * 2);
constexpr size_t O_WOUT = O_WBRB + al256((size_t)D * 1024 * 2);
constexpr size_t O_WC1 = O_WOUT + al256((size_t)D * D * 2);
constexpr size_t O_CBIAS = O_WC1 + al256((size_t)2 * 256 * 4096 * 2);
constexpr size_t O_CBP = O_CBIAS + al256(2 * 256 * 4);
constexpr size_t O_WRT = O_CBP + al256(64 * 2 * 256 * 4);
constexpr size_t O_WGU = O_WRT + al256((size_t)256 * D * 2);
constexpr size_t O_WDN = O_WGU + al256((size_t)NEXP * 4096 * D * 2);
constexpr size_t O_H = O_WDN + al256((size_t)NEXP * D * D * 2);
constexpr size_t O_Z = O_H + al256((size_t)NT * D * 2);
constexpr size_t O_CQN = O_Z + al256((size_t)NT * ZC * 2);
constexpr size_t O_KVT = O_CQN + al256((size_t)NT * 512 * 2);
constexpr size_t O_KIDX = O_KVT + al256((size_t)NT * KVW * 2);
constexpr size_t O_WIDX = O_KIDX + al256((size_t)NT * 64 * 2);
constexpr size_t O_GATES = O_WIDX + al256((size_t)NT * 8 * 4);
constexpr size_t O_BQ = O_GATES + al256((size_t)NT * 24 * 4);
constexpr size_t KVS_ONE = (size_t)NB * 2 * T * 128;
constexpr size_t O_KVS = O_BQ + al256((size_t)NT * 1024 * 2);
constexpr size_t O_QALL = O_KVS + al256(6 * KVS_ONE * 2 + 65536);
constexpr size_t O_C1P = O_QALL + al256((size_t)NT * QC * 2);
constexpr size_t O_KCVC = O_C1P + al256((size_t)16 * 2 * 2048 * 256 * 4);
constexpr size_t O_SEL = O_KCVC + al256((size_t)2 * 2048 * 128 * 2);
constexpr size_t O_NSEL = O_SEL + al256((size_t)NT * 256 * 2);
constexpr size_t O_OLAT = O_NSEL + al256((size_t)NT * 4);
constexpr size_t O_OB = O_OLAT + al256((size_t)NT * D * 2);
constexpr size_t O_MERGED = O_OB + al256((size_t)NT * 1024 * 2);
constexpr size_t O_MO = O_MERGED + al256((size_t)NT * D * 2);
constexpr size_t O_X1 = O_MO + al256((size_t)NT * D * 2);
constexpr size_t O_TOPI = O_X1 + al256((size_t)NT * D * 4);
constexpr size_t O_TOPW = O_TOPI + al256((size_t)NT * 4 * 4);
constexpr size_t O_TSLOT = O_TOPW + al256((size_t)NT * 4 * 4);
constexpr size_t O_SLOTW = O_TSLOT + al256((size_t)NT * 4 * 4);
constexpr size_t O_HS = O_SLOTW + al256((size_t)SLOTS * 4);
constexpr size_t O_ACT = O_HS + al256((size_t)SLOTS * D);
constexpr size_t O_YS = O_ACT + al256((size_t)SLOTS * D);
constexpr size_t O_OB8 = O_YS + al256((size_t)SLOTS * D * 2);
constexpr size_t O_MG8 = O_OB8 + al256((size_t)NT * 1024);
constexpr size_t O_WIN8 = O_MG8 + al256((size_t)NT * D);
constexpr size_t O_H8 = O_WIN8 + al256((size_t)ZC * D);
constexpr size_t WS_END = O_H8 + al256((size_t)NT * D);

struct Params {
    const float* x; const float* c; const int* pos; const float* w_ada; const float* b_ada;
    const float* g_pre_mix; const float* g_post_mix; const float* g_pre_ffn; const float* g_post_ffn;
    const float* w_in; const float* a_cq_norm; const float* a_ckv_norm; const float* a_w_uq; const float* a_w_uk; const float* a_w_uv;
    const float* idx_w_q; const float* idx_g; const float* idx_b;
    const float* cmp_k_pe; const float* cmp_k_w1; const float* cmp_k_w2; const float* cmp_v_pe; const float* cmp_v_w1; const float* cmp_v_w2;
    const float* w_br_a; const float* w_br_b; const float* w_out; const float* w_router; const float* b_router;
    const float* w_gate_up; const float* b_gate_up; const float* w_down; const float* b_down;
    float* out; char* ws;
};

DI int tid_fresh() { int t = threadIdx.x; asm volatile("" : "+v"(t)); return t; }
DI float bf2f(bf16_t v) { return __uint_as_float((unsigned)v << 16); }
DI float bflo(unsigned w) { return __uint_as_float(w << 16); }
DI float bfhi(unsigned w) { return __uint_as_float(w & 0xffff0000u); }
DI bf16_t f2bf(float f) { unsigned u = __float_as_uint(f); u += 0x7FFFu + ((u >> 16) & 1u); return (bf16_t)(u >> 16); }
DI unsigned pk2(float lo, float hi) { unsigned r; asm volatile("v_cvt_pk_bf16_f32 %0, %1, %2" : "=v"(r) : "v"(lo), "v"(hi)); return r; }
DI float wave_sum(float v) {
#pragma unroll
    for (int o = 1; o < 64; o <<= 1) v += __shfl_xor(v, o);
    return v;
}
DI float wave_max(float v) {
#pragma unroll
    for (int o = 1; o < 64; o <<= 1) v = fmaxf(v, __shfl_xor(v, o));
    return v;
}
DI float sigmoidf_(float v) { return 1.f / (1.f + __expf(-v)); }
DI void unpack8(const u32x4& w, float (&f)[8]) {
    f[0] = bflo(w[0]); f[1] = bfhi(w[0]); f[2] = bflo(w[1]); f[3] = bfhi(w[1]); f[4] = bflo(w[2]); f[5] = bfhi(w[2]); f[6] = bflo(w[3]); f[7] = bfhi(w[3]);
}
DI float mod_at(const Params& p, int b, int j) { return ((const float*)(p.ws + O_MODACC))[b * 12288 + j]; }

#define XB_TMO      128
#define XB_XCNT(j)  (256  + 64 * (j))
#define XB_XSUB(j)  (1280 + 64 * (j))
#define XB_XGEN(j)  (2304 + 64 * (j))
#define XB_TOP      3328
#define XB_TOPGEN   3392
#define XCD_BAR_WORDS 3456
#define XB_SPIN_CAP (1u << 22)
DI unsigned xb_ld(unsigned* p)              { return __hip_atomic_load(p, __ATOMIC_RELAXED, __HIP_MEMORY_SCOPE_AGENT); }
DI unsigned xb_add(unsigned* p, unsigned v) { return __hip_atomic_fetch_add(p, v, __ATOMIC_RELAXED, __HIP_MEMORY_SCOPE_AGENT); }
DI unsigned xb_xcc_id() { return (unsigned)__builtin_amdgcn_s_getreg((3 << 11) | 20) & 0xFu; }
#define XB_SPIN(cond, bar) do { unsigned _sp = 0; while (cond) { __builtin_amdgcn_s_sleep(1); \
    if ((++_sp & 255u) == 0u) { if (xb_ld(&(bar)[XB_TMO])) break; if (_sp > XB_SPIN_CAP) { atomicAdd(&(bar)[XB_TMO], 1u); break; } } } } while (0)
struct XcdBarrier { unsigned* bar; unsigned x; volatile LAS unsigned* st; };
DI XcdBarrier xcd_barrier_post(unsigned* bar, volatile LAS unsigned* st) {
    XcdBarrier b; b.bar = bar; b.x = xb_xcc_id(); b.st = st;
    if (threadIdx.x == 0) (void)xb_add(&bar[XB_XCNT(b.x)], 1u);
    return b;
}
DI void xcd_barrier_complete(unsigned* bar, unsigned x, unsigned& nloc, unsigned& nx) {
    const unsigned G = gridDim.x * gridDim.y * gridDim.z;
    unsigned sum, cnt, mine, sp = 0u;
    for (;;) {
        sum = 0u; cnt = 0u; mine = 0u;
#pragma unroll
        for (unsigned j = 0; j < 16; ++j) { const unsigned c = xb_ld(&bar[XB_XCNT(j)]); sum += c; cnt += (c > 0u) ? 1u : 0u; mine = (j == x) ? c : mine; }
        if (sum == G) break;
        __builtin_amdgcn_s_sleep(1);
        if ((++sp & 255u) == 0u) { if (xb_ld(&bar[XB_TMO])) break; if (sp > XB_SPIN_CAP) { atomicAdd(&bar[XB_TMO], 1u); break; } }
    }
    nloc = mine > 0u ? mine : 1u; nx = cnt > 0u ? cnt : 1u;
}
DI void xcd_barrier(const XcdBarrier& b) {
    asm volatile("s_waitcnt vmcnt(0)" ::: "memory");
    __syncthreads();
    if (threadIdx.x == 0) {
        unsigned* bar = b.bar;
        __builtin_amdgcn_s_waitcnt(0);
        unsigned nloc = b.st[0], nx = b.st[1];
        if (nloc == 0u) { xcd_barrier_complete(bar, b.x, nloc, nx); b.st[0] = nloc; b.st[1] = nx; }
        const unsigned old = xb_add(&bar[XB_XSUB(b.x)], 1u);
        const unsigned gen = old / nloc;
        if (old + 1u == (gen + 1u) * nloc) {
            __builtin_amdgcn_fence(__ATOMIC_RELEASE, "agent");
            asm volatile("s_waitcnt vmcnt(0)" ::: "memory");
            const unsigned og = xb_add(&bar[XB_TOP], 1u);
            const unsigned tg = og / nx;
            if (og + 1u == (tg + 1u) * nx) xb_add(&bar[XB_TOPGEN], 1u);
            else XB_SPIN(xb_ld(&bar[XB_TOPGEN]) == tg, bar);
            __builtin_amdgcn_fence(__ATOMIC_ACQUIRE, "agent");
            xb_add(&bar[XB_XGEN(b.x)], 1u);
            asm volatile("s_waitcnt vmcnt(0)" ::: "memory");
        } else {
            XB_SPIN(xb_ld(&bar[XB_XGEN(b.x)]) == gen, bar);
            __builtin_amdgcn_fence(__ATOMIC_ACQUIRE, "agent");
            asm volatile("s_waitcnt vmcnt(0)" ::: "memory");
        }
    }
    __syncthreads();
}

namespace pg8 {
constexpr int BM = 256, BK = 64, HALF = 128, HTB = HALF * BK * 2, STAGE_BYTES = 8 * HTB, NXCD = 8, WGM = 8;
DI int lds_byte(int r, int c) { const int st = (r >> 4) * 2 + (c >> 5), rr = r & 15, cc = c & 31, ob = rr * 64 + cc * 2; return st * 1024 + (ob ^ (((ob >> 9) & 1) << 5)); }
DI void stage_rc(int b, int& R, int& C) { const int st = b / 1024, sb = b % 1024, swz = sb ^ (((sb >> 9) & 1) << 5); R = (st >> 1) * 16 + swz / 64; C = (st & 1) * 32 + (swz % 64) / 2; }
DI int perm32(int rho) { const int n = rho >> 4, i = rho & 15; return 8 * (i >> 2) + 4 * n + (i & 3); }

struct Unit { int pm, pn, e; const char* a; const char* b; };
struct Gemm { int lda, ldb, K; int brow = ldb; int bk = BK * 2; };

struct PlainSched {
    int nM, nN, nwg, G, c; const char* A; const char* Bt; size_t a_tile, b_tile;
    DI void init(int M, int N, int G_, int c_, const void* A_, int lda, const void* Bt_, int ldb) {
        nM = M / BM; nN = N / BM; nwg = nM * nN; G = G_; c = c_; A = (const char*)A_; Bt = (const char*)Bt_; a_tile = (size_t)BM * lda * 2; b_tile = (size_t)BM * ldb * 2; }
    DI bool next(int i, Unit& u) const {
        const long L = (long)i * G + c; if (L >= nwg) return false;
        int wgid = (int)L; { const int q = nwg / NXCD, r = nwg % NXCD, xcd = wgid % NXCD, off = wgid / NXCD; wgid = (xcd < r ? xcd * (q + 1) : r * (q + 1) + (xcd - r) * q) + off; }
        const int nig = WGM * nN, gid = wgid / nig, fm = gid * WGM, gsz = (nM - fm) < WGM ? (nM - fm) : WGM;
        u.pm = fm + ((wgid % nig) % gsz); u.pn = (wgid % nig) / gsz; u.e = 0;
        u.a = A + (size_t)u.pm * a_tile; u.b = Bt + (size_t)u.pn * b_tile; return true;
    }
};

typedef int v4i_t __attribute__((ext_vector_type(4)));
typedef int v8i_t __attribute__((ext_vector_type(8)));
#ifndef PG8_SP2
#define PG8_SP2 true
#endif
template <class Epi, class Sched, bool SP2 = PG8_SP2>
DI void gemm_phase(LAS unsigned char* lds, const Gemm g, const Sched& S, const Epi& E) {
    const int tid = tid_fresh(), wid = __builtin_amdgcn_readfirstlane(tid >> 6), lane = tid & 63, wr = wid >> 2, wc = wid & 3, fr = lane & 15, fq = lane >> 4;
    const int K = g.K, nt = K / BK;
    unsigned voffA[2], voffB[2];
#pragma unroll
    for (int i = 0; i < 2; ++i) { int R, C; stage_rc(tid * 16 + i * 8192, R, C); const int Rb = Epi::PERM ? ((R & ~31) + perm32(R & 31)) : R;
        voffA[i] = (unsigned)(R * g.lda + C) * 2u; voffB[i] = (unsigned)(Rb * g.ldb + C) * 2u; }
    const size_t kstep = (size_t)(BK * 2);
    const size_t hstepA = (size_t)HALF * g.lda * 2, hstepB = (size_t)HALF * g.ldb * 2;
    const unsigned ldsw = (unsigned)wid * 1024u;
    const int aoff = lds_byte(wr * 64 + fr, fq * 8), boff = lds_byte(wc * 32 + fr, fq * 8);
#define PG8_SA(b, h) (((b) * 2 + (h)) * HTB)
#define PG8_SB(b, h) ((4 + (b) * 2 + (h)) * HTB)
#define PG8_STAGE(bufoff, gbase, voff) do { _Pragma("unroll") for (int _i = 0; _i < 2; ++_i) \
        __builtin_amdgcn_global_load_lds((const unsigned*)((const char*)(gbase) + (voff)[_i]), (LAS unsigned*)(lds + (bufoff) + ldsw + _i * 8192), 16, 0, 0); } while (0)
#define PG8_LDA(dst, b, h) do { _Pragma("unroll") for (int m = 0; m < 4; ++m) _Pragma("unroll") for (int k = 0; k < 2; ++k) dst[m][k] = *(const LAS bf16x8*)(lds + PG8_SA(b, h) + aoff + m * 2048 + k * 1024); } while (0)
#define PG8_LDB(dst, b, h) do { _Pragma("unroll") for (int n = 0; n < 2; ++n) _Pragma("unroll") for (int k = 0; k < 2; ++k) dst[n][k] = *(const LAS bf16x8*)(lds + PG8_SB(b, h) + boff + n * 2048 + k * 1024); } while (0)
#define PG8_MMA(ai, bj, At, Bt) do { __builtin_amdgcn_s_setprio(1); _Pragma("unroll") for (int m = 0; m < 4; ++m) _Pragma("unroll") for (int n = 0; n < 2; ++n) _Pragma("unroll") for (int k = 0; k < 2; ++k) \
        acc[ai][bj][m][n] = __builtin_amdgcn_mfma_f32_16x16x32_bf16(Bt[n][k], At[m][k], acc[ai][bj][m][n], 0, 0, 0); __builtin_amdgcn_s_setprio(0); } while (0)
#define PG8_WAIT_V(n) asm volatile("s_waitcnt vmcnt(" #n ")" ::: "memory")
#define PG8_WAIT_L(n) asm volatile("s_waitcnt lgkmcnt(" #n ")" ::: "memory")
#define PG8_BAR __builtin_amdgcn_s_barrier()
#define PG8_SCHED __builtin_amdgcn_sched_barrier(0)
    Unit cur, nxt; int ui = 0;
    if (!S.next(0, cur)) return;
    f32x4 acc[2][2][4][2];
#pragma unroll
    for (int a = 0; a < 2; ++a)
#pragma unroll
        for (int b = 0; b < 2; ++b)
#pragma unroll
            for (int m = 0; m < 4; ++m)
#pragma unroll
                for (int n = 0; n < 2; ++n) acc[a][b][m][n] = (f32x4){0.f, 0.f, 0.f, 0.f};
    bf16x8 At[4][2], B0[2][2], B1[2][2];
    const char* cA = cur.a; const char* cB = cur.b;
    if constexpr (SP2) {
        PG8_STAGE(PG8_SB(0, 0), cB, voffB); PG8_STAGE(PG8_SB(0, 1), cB + hstepB, voffB); PG8_STAGE(PG8_SA(0, 0), cA, voffA); PG8_STAGE(PG8_SA(0, 1), cA + hstepA, voffA);
        if (wr == 1) PG8_BAR;
        PG8_WAIT_V(2); PG8_BAR;
        PG8_STAGE(PG8_SB(1, 0), cB + kstep, voffB); PG8_STAGE(PG8_SA(1, 0), cA + kstep, voffA); PG8_STAGE(PG8_SB(1, 1), cB + hstepB + kstep, voffB);
        PG8_WAIT_V(6); PG8_BAR;
    } else {
        PG8_STAGE(PG8_SB(0, 0), cB, voffB); PG8_STAGE(PG8_SA(0, 0), cA, voffA); PG8_STAGE(PG8_SB(0, 1), cB + hstepB, voffB); PG8_STAGE(PG8_SA(0, 1), cA + hstepA, voffA);
        if (wr == 1) PG8_BAR;
        PG8_WAIT_V(4); PG8_BAR;
        PG8_STAGE(PG8_SB(1, 0), cB + kstep, voffB); PG8_STAGE(PG8_SA(1, 0), cA + kstep, voffA); PG8_STAGE(PG8_SB(1, 1), cB + hstepB + kstep, voffB);
        PG8_WAIT_V(6); PG8_BAR;
    }
    for (;;) {
        const bool has_next = S.next(ui + 1, nxt);
        const char* nA = has_next ? nxt.a : cA; const char* nB = has_next ? nxt.b : cB;
        for (int t = 0; t < nt; t += 2) {
            const bool last = (t == nt - 2);
            const char* a1 = cA + (size_t)(t + 1) * kstep;
            const char* a2 = last ? nA : cA + (size_t)(t + 2) * kstep; const char* b2 = last ? nB : cB + (size_t)(t + 2) * kstep;
            const char* a3 = a2 + kstep; const char* b3 = b2 + kstep;
            if constexpr (SP2) {
            PG8_LDB(B0, 0, 0); PG8_LDB(B1, 0, 1); PG8_SCHED; PG8_LDA(At, 0, 0); PG8_STAGE(PG8_SA(1, 1), a1 + hstepA, voffA);
            PG8_WAIT_V(8); PG8_WAIT_L(0); PG8_BAR; PG8_MMA(0, 0, At, B0); PG8_MMA(0, 1, At, B1); PG8_BAR; PG8_SCHED;
            PG8_LDA(At, 0, 1); PG8_STAGE(PG8_SB(0, 0), b2, voffB); PG8_STAGE(PG8_SB(0, 1), b2 + hstepB, voffB); PG8_STAGE(PG8_SA(0, 0), a2, voffA);
            PG8_WAIT_V(8); PG8_WAIT_L(0); PG8_BAR; PG8_MMA(1, 0, At, B0); PG8_MMA(1, 1, At, B1); PG8_BAR; PG8_SCHED;
            PG8_LDB(B0, 1, 0); PG8_LDB(B1, 1, 1); PG8_SCHED; PG8_LDA(At, 1, 0); PG8_STAGE(PG8_SA(0, 1), a2 + hstepA, voffA);
            PG8_WAIT_V(8); PG8_WAIT_L(0); PG8_BAR; PG8_MMA(0, 0, At, B0); PG8_MMA(0, 1, At, B1); PG8_BAR; PG8_SCHED;
            PG8_LDA(At, 1, 1); PG8_STAGE(PG8_SB(1, 0), b3, voffB); PG8_STAGE(PG8_SB(1, 1), b3 + hstepB, voffB); PG8_STAGE(PG8_SA(1, 0), a3, voffA);
            PG8_WAIT_V(8); PG8_WAIT_L(0); PG8_BAR; PG8_MMA(1, 0, At, B0); PG8_MMA(1, 1, At, B1); PG8_BAR; PG8_SCHED;
            } else {
            PG8_LDB(B0, 0, 0); PG8_SCHED; PG8_LDA(At, 0, 0); PG8_STAGE(PG8_SA(1, 1), a1 + hstepA, voffA);
            PG8_WAIT_L(8); PG8_BAR; PG8_WAIT_L(0); PG8_MMA(0, 0, At, B0); PG8_BAR; PG8_SCHED;
            PG8_LDB(B1, 0, 1); PG8_STAGE(PG8_SB(0, 0), b2, voffB);
            PG8_BAR; PG8_WAIT_L(0); PG8_MMA(0, 1, At, B1); PG8_BAR;
            PG8_LDA(At, 0, 1); PG8_STAGE(PG8_SA(0, 0), a2, voffA);
            PG8_BAR; PG8_WAIT_L(0); PG8_MMA(1, 0, At, B0); PG8_BAR; PG8_SCHED;
            PG8_STAGE(PG8_SB(0, 1), b2 + hstepB, voffB);
            PG8_WAIT_V(6); PG8_BAR; PG8_MMA(1, 1, At, B1); PG8_BAR;
            PG8_LDB(B0, 1, 0); PG8_SCHED; PG8_LDA(At, 1, 0); PG8_STAGE(PG8_SA(0, 1), a2 + hstepA, voffA);
            PG8_WAIT_L(8); PG8_BAR; PG8_WAIT_L(0); PG8_MMA(0, 0, At, B0); PG8_BAR; PG8_SCHED;
            PG8_LDB(B1, 1, 1); PG8_STAGE(PG8_SB(1, 0), b3, voffB);
            PG8_BAR; PG8_WAIT_L(0); PG8_MMA(0, 1, At, B1); PG8_BAR;
            PG8_LDA(At, 1, 1); PG8_STAGE(PG8_SA(1, 0), a3, voffA);
            PG8_BAR; PG8_WAIT_L(0); PG8_MMA(1, 0, At, B0); PG8_BAR; PG8_SCHED;
            PG8_STAGE(PG8_SB(1, 1), b3 + hstepB, voffB);
            PG8_WAIT_V(6); PG8_BAR; PG8_MMA(1, 1, At, B1); PG8_BAR;
            }
        }
        E(acc, cur, wr, wc, fr, fq);
        if (!has_next) break;
#pragma unroll
        for (int a = 0; a < 2; ++a)
#pragma unroll
            for (int b = 0; b < 2; ++b)
#pragma unroll
                for (int m = 0; m < 4; ++m)
#pragma unroll
                    for (int n = 0; n < 2; ++n) acc[a][b][m][n] = (f32x4){0.f, 0.f, 0.f, 0.f};
        cur = nxt; cA = nA; cB = nB; ++ui;
    }
    PG8_WAIT_V(0);
    if (wr == 0) PG8_BAR;
    PG8_BAR;
#undef PG8_SA
#undef PG8_SB
#undef PG8_STAGE
#undef PG8_LDA
#undef PG8_LDB
#undef PG8_MMA
#undef PG8_WAIT_V
#undef PG8_WAIT_L
#undef PG8_BAR
#undef PG8_SCHED
}

template <class Epi, class Sched, bool SP2 = PG8_SP2>
DI void gemm_phase_fp8(LAS unsigned char* lds, const Gemm g, const Sched& S, const Epi& E) {
    const int tid = tid_fresh(), wid = __builtin_amdgcn_readfirstlane(tid >> 6), lane = tid & 63, wr = wid >> 2, wc = wid & 3, fr = lane & 15, fq = lane >> 4;
    const int K = g.K, nt = K / BK;
    unsigned voffA[2], voffB[2];
#pragma unroll
    for (int i = 0; i < 2; ++i) { int R, C; stage_rc(tid * 16 + i * 8192, R, C); const int Rb = Epi::PERM ? ((R & ~31) + perm32(R & 31)) : R;
        voffA[i] = (unsigned)(R * g.lda + C) * 2u; voffB[i] = (unsigned)(Rb * g.brow + C) * 2u; }
    const size_t kstep = (size_t)(BK * 2), kstepB = (size_t)g.bk;
    const size_t hstepA = (size_t)HALF * g.lda * 2, hstepB = (size_t)HALF * g.ldb * 2;
    const unsigned ldsw = (unsigned)wid * 1024u;
    const int aoff = lds_byte(wr * 64 + fr, fq * 8), boff = lds_byte(wc * 32 + fr, fq * 8);
#define PG8_SA(b, h) (((b) * 2 + (h)) * HTB)
#define PG8_SB(b, h) ((4 + (b) * 2 + (h)) * HTB)
#define PG8_STAGE(bufoff, gbase, voff) do { _Pragma("unroll") for (int _i = 0; _i < 2; ++_i) \
        __builtin_amdgcn_global_load_lds((const unsigned*)((const char*)(gbase) + (voff)[_i]), (LAS unsigned*)(lds + (bufoff) + ldsw + _i * 8192), 16, 0, 0); } while (0)
#define PG8_LDA(dst, b, h) do { _Pragma("unroll") for (int m = 0; m < 4; ++m) { const v4i_t lo_ = *(const LAS v4i_t*)(lds + PG8_SA(b, h) + aoff + m * 2048), hi_ = *(const LAS v4i_t*)(lds + PG8_SA(b, h) + aoff + m * 2048 + 1024); dst[m] = __builtin_shufflevector(lo_, hi_, 0, 1, 2, 3, 4, 5, 6, 7); } } while (0)
#define PG8_LDB(dst, b, h) do { _Pragma("unroll") for (int n = 0; n < 2; ++n) { const v4i_t lo_ = *(const LAS v4i_t*)(lds + PG8_SB(b, h) + boff + n * 2048), hi_ = *(const LAS v4i_t*)(lds + PG8_SB(b, h) + boff + n * 2048 + 1024); dst[n] = __builtin_shufflevector(lo_, hi_, 0, 1, 2, 3, 4, 5, 6, 7); } } while (0)
#define PG8_MMA(ai, bj, At, Bt) do { __builtin_amdgcn_s_setprio(1); _Pragma("unroll") for (int m = 0; m < 4; ++m) _Pragma("unroll") for (int n = 0; n < 2; ++n) \
        asm volatile("v_mfma_scale_f32_16x16x128_f8f6f4 %0, %1, %2, %0, %3, %3 op_sel_hi:[0,0,0]" : "+v"(acc[ai][bj][m][n]) : "v"(Bt[n]), "v"(At[m]), "v"(sc127)); __builtin_amdgcn_s_setprio(0); } while (0)
#define PG8_WAIT_V(n) asm volatile("s_waitcnt vmcnt(" #n ")" ::: "memory")
#define PG8_WAIT_L(n) asm volatile("s_waitcnt lgkmcnt(" #n ")" ::: "memory")
#define PG8_BAR __builtin_amdgcn_s_barrier()
#define PG8_SCHED __builtin_amdgcn_sched_barrier(0)
    Unit cur, nxt; int ui = 0;
    if (!S.next(0, cur)) return;
    f32x4 acc[2][2][4][2];
#pragma unroll
    for (int a = 0; a < 2; ++a)
#pragma unroll
        for (int b = 0; b < 2; ++b)
#pragma unroll
            for (int m = 0; m < 4; ++m)
#pragma unroll
                for (int n = 0; n < 2; ++n) acc[a][b][m][n] = (f32x4){0.f, 0.f, 0.f, 0.f};
    v8i_t At[4], B0[2], B1[2];
    int sc127 = 127; asm volatile("" : "+v"(sc127));
    const char* cA = cur.a; const char* cB = cur.b;
    if constexpr (SP2) {
        PG8_STAGE(PG8_SB(0, 0), cB, voffB); PG8_STAGE(PG8_SB(0, 1), cB + hstepB, voffB); PG8_STAGE(PG8_SA(0, 0), cA, voffA); PG8_STAGE(PG8_SA(0, 1), cA + hstepA, voffA);
        if (wr == 1) PG8_BAR;
        PG8_WAIT_V(2); PG8_BAR;
        PG8_STAGE(PG8_SB(1, 0), cB + kstepB, voffB); PG8_STAGE(PG8_SA(1, 0), cA + kstep, voffA); PG8_STAGE(PG8_SB(1, 1), cB + hstepB + kstepB, voffB);
        PG8_WAIT_V(6); PG8_BAR;
    } else {
        PG8_STAGE(PG8_SB(0, 0), cB, voffB); PG8_STAGE(PG8_SA(0, 0), cA, voffA); PG8_STAGE(PG8_SB(0, 1), cB + hstepB, voffB); PG8_STAGE(PG8_SA(0, 1), cA + hstepA, voffA);
        if (wr == 1) PG8_BAR;
        PG8_WAIT_V(4); PG8_BAR;
        PG8_STAGE(PG8_SB(1, 0), cB + kstepB, voffB); PG8_STAGE(PG8_SA(1, 0), cA + kstep, voffA); PG8_STAGE(PG8_SB(1, 1), cB + hstepB + kstepB, voffB);
        PG8_WAIT_V(6); PG8_BAR;
    }
    for (;;) {
        const bool has_next = S.next(ui + 1, nxt);
        const char* nA = has_next ? nxt.a : cA; const char* nB = has_next ? nxt.b : cB;
        for (int t = 0; t < nt; t += 2) {
            const bool last = (t == nt - 2);
            const char* a1 = cA + (size_t)(t + 1) * kstep;
            const char* a2 = last ? nA : cA + (size_t)(t + 2) * kstep; const char* b2 = last ? nB : cB + (size_t)(t + 2) * kstepB;
            const char* a3 = a2 + kstep; const char* b3 = b2 + kstepB;
            if constexpr (SP2) {
            PG8_LDB(B0, 0, 0); PG8_LDB(B1, 0, 1); PG8_SCHED; PG8_LDA(At, 0, 0); PG8_STAGE(PG8_SA(1, 1), a1 + hstepA, voffA);
            PG8_WAIT_V(8); PG8_WAIT_L(0); PG8_BAR; PG8_MMA(0, 0, At, B0); PG8_MMA(0, 1, At, B1); PG8_BAR; PG8_SCHED;
            PG8_LDA(At, 0, 1); PG8_STAGE(PG8_SB(0, 0), b2, voffB); PG8_STAGE(PG8_SB(0, 1), b2 + hstepB, voffB); PG8_STAGE(PG8_SA(0, 0), a2, voffA);
            PG8_WAIT_V(8); PG8_WAIT_L(0); PG8_BAR; PG8_MMA(1, 0, At, B0); PG8_MMA(1, 1, At, B1); PG8_BAR; PG8_SCHED;
            PG8_LDB(B0, 1, 0); PG8_LDB(B1, 1, 1); PG8_SCHED; PG8_LDA(At, 1, 0); PG8_STAGE(PG8_SA(0, 1), a2 + hstepA, voffA);
            PG8_WAIT_V(8); PG8_WAIT_L(0); PG8_BAR; PG8_MMA(0, 0, At, B0); PG8_MMA(0, 1, At, B1); PG8_BAR; PG8_SCHED;
            PG8_LDA(At, 1, 1); PG8_STAGE(PG8_SB(1, 0), b3, voffB); PG8_STAGE(PG8_SB(1, 1), b3 + hstepB, voffB); PG8_STAGE(PG8_SA(1, 0), a3, voffA);
            PG8_WAIT_V(8); PG8_WAIT_L(0); PG8_BAR; PG8_MMA(1, 0, At, B0); PG8_MMA(1, 1, At, B1); PG8_BAR; PG8_SCHED;
            } else {
            PG8_LDB(B0, 0, 0); PG8_SCHED; PG8_LDA(At, 0, 0); PG8_STAGE(PG8_SA(1, 1), a1 + hstepA, voffA);
            PG8_WAIT_L(8); PG8_BAR; PG8_WAIT_L(0); PG8_MMA(0, 0, At, B0); PG8_BAR; PG8_SCHED;
            PG8_LDB(B1, 0, 1); PG8_STAGE(PG8_SB(0, 0), b2, voffB);
            PG8_BAR; PG8_WAIT_L(0); PG8_MMA(0, 1, At, B1); PG8_BAR;
            PG8_LDA(At, 0, 1); PG8_STAGE(PG8_SA(0, 0), a2, voffA);
            PG8_BAR; PG8_WAIT_L(0); PG8_MMA(1, 0, At, B0); PG8_BAR; PG8_SCHED;
            PG8_STAGE(PG8_SB(0, 1), b2 + hstepB, voffB);
            PG8_WAIT_V(6); PG8_BAR; PG8_MMA(1, 1, At, B1); PG8_BAR;
            PG8_LDB(B0, 1, 0); PG8_SCHED; PG8_LDA(At, 1, 0); PG8_STAGE(PG8_SA(0, 1), a2 + hstepA, voffA);
            PG8_WAIT_L(8); PG8_BAR; PG8_WAIT_L(0); PG8_MMA(0, 0, At, B0); PG8_BAR; PG8_SCHED;
            PG8_LDB(B1, 1, 1); PG8_STAGE(PG8_SB(1, 0), b3, voffB);
            PG8_BAR; PG8_WAIT_L(0); PG8_MMA(0, 1, At, B1); PG8_BAR;
            PG8_LDA(At, 1, 1); PG8_STAGE(PG8_SA(1, 0), a3, voffA);
            PG8_BAR; PG8_WAIT_L(0); PG8_MMA(1, 0, At, B0); PG8_BAR; PG8_SCHED;
            PG8_STAGE(PG8_SB(1, 1), b3 + hstepB, voffB);
            PG8_WAIT_V(6); PG8_BAR; PG8_MMA(1, 1, At, B1); PG8_BAR;
            }
        }
        asm volatile("s_nop 15\n\ts_nop 15" ::: "memory");
        E(acc, cur, wr, wc, fr, fq);
        if (!has_next) break;
#pragma unroll
        for (int a = 0; a < 2; ++a)
#pragma unroll
            for (int b = 0; b < 2; ++b)
#pragma unroll
                for (int m = 0; m < 4; ++m)
#pragma unroll
                    for (int n = 0; n < 2; ++n) acc[a][b][m][n] = (f32x4){0.f, 0.f, 0.f, 0.f};
        cur = nxt; cA = nA; cB = nB; ++ui;
    }
    PG8_WAIT_V(0);
    if (wr == 0) PG8_BAR;
    PG8_BAR;
#undef PG8_SA
#undef PG8_SB
#undef PG8_STAGE
#undef PG8_LDA
#undef PG8_LDB
#undef PG8_MMA
#undef PG8_WAIT_V
#undef PG8_WAIT_L
#undef PG8_BAR
#undef PG8_SCHED
}

typedef f32x4 Acc[2][2][4][2];
struct EpiBf16 {
    static constexpr bool PERM = true; bf16_t* O; int ldc; float scale;
    DI void operator()(const Acc& acc, const Unit& u, int wr, int wc, int fr, int fq) const {
        const int row0 = u.pm * BM + wr * 64 + fr, col0 = u.pn * BM + wc * 32 + 8 * fq;
#pragma unroll
        for (int ai = 0; ai < 2; ++ai)
#pragma unroll
            for (int m = 0; m < 4; ++m) { bf16_t* rowp = O + (size_t)(row0 + ai * HALF + m * 16) * ldc + col0;
#pragma unroll
                for (int bj = 0; bj < 2; ++bj) { const f32x4 v0 = acc[ai][bj][m][0] * scale, v1 = acc[ai][bj][m][1] * scale;
                    *(u32x4*)(rowp + bj * HALF) = (u32x4){pk2(v0[0], v0[1]), pk2(v0[2], v0[3]), pk2(v1[0], v1[1]), pk2(v1[2], v1[3])}; } }
    }
};
struct EpiC1 {
    static constexpr bool PERM = false; float* C;
    DI void operator()(const Acc& acc, const Unit& u, int wr, int wc, int fr, int fq) const {
        const int row0 = u.pm * BM + wr * 64 + fr, col0 = wc * 32 + 4 * fq;
        float* base = C + (size_t)u.e * 2048 * 256;
#pragma unroll
        for (int ai = 0; ai < 2; ++ai)
#pragma unroll
            for (int m = 0; m < 4; ++m) { float* rowp = base + (size_t)(row0 + ai * HALF + m * 16) * 256 + col0;
#pragma unroll
                for (int bj = 0; bj < 2; ++bj)
#pragma unroll
                    for (int n = 0; n < 2; ++n) *(f32x4*)(rowp + bj * HALF + n * 16) = acc[ai][bj][m][n]; }
    }
};
DI float clamp8(float v) { return __builtin_amdgcn_fmed3f(v, -448.f, 448.f); }
DI unsigned fp8x4(float a, float b, float c, float d) { int w = 0; w = __builtin_amdgcn_cvt_pk_fp8_f32(clamp8(a), clamp8(b), w, false); w = __builtin_amdgcn_cvt_pk_fp8_f32(clamp8(c), clamp8(d), w, true); return (unsigned)w; }
constexpr float W8_SCALE = 256.f, W8_INV = 1.f / 256.f, A8_SCALE = 16.f, A8W8_INV = 1.f / 4096.f, Y8_SCALE = 32.f, Y8_INV = 1.f / 32.f;
template <bool ADD> struct EpiMerge {
    static constexpr bool PERM = true; bf16_t* P; unsigned char* O8; const bf16_t* Z; int gcol0; float scale;
    DI void operator()(const Acc& acc, const Unit& u, int wr, int wc, int fr, int fq) const {
        const int row0 = u.pm * BM + wr * 64 + fr, col0 = u.pn * BM + wc * 32 + 8 * fq;
#pragma unroll
        for (int ai = 0; ai < 2; ++ai) {
            u32x4 gz[4][2], pz[4][2];
#pragma unroll
            for (int m = 0; m < 4; ++m) { const size_t row = (size_t)(row0 + ai * HALF + m * 16);
#pragma unroll
                for (int bj = 0; bj < 2; ++bj) { const int col = col0 + bj * HALF; gz[m][bj] = *(const u32x4*)(Z + row * ZC + gcol0 + col); if (ADD) pz[m][bj] = *(const u32x4*)(P + row * D + col); } }
#pragma unroll
            for (int m = 0; m < 4; ++m) { const size_t row = (size_t)(row0 + ai * HALF + m * 16);
#pragma unroll
                for (int bj = 0; bj < 2; ++bj) { const int col = col0 + bj * HALF;
                    float g[8], o[8]; unpack8(gz[m][bj], g);
                    const f32x4 v0 = acc[ai][bj][m][0] * scale, v1 = acc[ai][bj][m][1] * scale;
                    if (ADD) unpack8(pz[m][bj], o);
#pragma unroll
                    for (int j = 0; j < 8; ++j) { const float a = j < 4 ? v0[j & 3] : v1[j & 3]; o[j] = (ADD ? o[j] : 0.f) + sigmoidf_(g[j]) * a; }
                    if (ADD) *(u32x2*)(O8 + row * D + col) = (u32x2){fp8x4(o[0] * A8_SCALE, o[1] * A8_SCALE, o[2] * A8_SCALE, o[3] * A8_SCALE), fp8x4(o[4] * A8_SCALE, o[5] * A8_SCALE, o[6] * A8_SCALE, o[7] * A8_SCALE)};
                    else *(u32x4*)(P + row * D + col) = (u32x4){pk2(o[0], o[1]), pk2(o[2], o[3]), pk2(o[4], o[5]), pk2(o[6], o[7])}; } }
        }
    }
};
struct EpiGU {
    static constexpr bool PERM = true; unsigned char* O; const float* bias;
    DI void operator()(const Acc& acc, const Unit& u, int wr, int wc, int fr, int fq) const {
        const int row0 = u.pm * BM + wr * 64 + fr, c0 = u.pn * HALF + wc * 32 + 8 * fq;
        const float* bg = bias + (size_t)u.e * 4096 + c0; const float* bu = bg + 2048;
        float bgv[8], buv[8];
#pragma unroll
        for (int j = 0; j < 8; ++j) { bgv[j] = bg[j]; buv[j] = bu[j]; }
#pragma unroll
        for (int ai = 0; ai < 2; ++ai)
#pragma unroll
            for (int m = 0; m < 4; ++m) { unsigned char* rowp = O + (size_t)(row0 + ai * HALF + m * 16) * D + c0;
                float o[8];
#pragma unroll
                for (int j = 0; j < 8; ++j) { float gt = (j < 4 ? acc[ai][0][m][0][j & 3] : acc[ai][0][m][1][j & 3]) * W8_INV + bgv[j];
                    float up = (j < 4 ? acc[ai][1][m][0][j & 3] : acc[ai][1][m][1][j & 3]) * W8_INV + buv[j];
                    gt = fminf(gt, 7.f); up = fminf(fmaxf(up, -7.f), 7.f);
                    o[j] = gt * sigmoidf_(1.702f * gt) * (up + 1.f); }
                *(u32x2*)rowp = (u32x2){fp8x4(o[0], o[1], o[2], o[3]), fp8x4(o[4], o[5], o[6], o[7])}; }
    }
};
struct EpiDN {
    static constexpr bool PERM = true; unsigned char* O; const float* bias; const float* slotw;
    DI void operator()(const Acc& acc, const Unit& u, int wr, int wc, int fr, int fq) const {
        const int row0 = u.pm * BM + wr * 64 + fr, col0 = u.pn * BM + wc * 32 + 8 * fq;
        float bv[2][8];
#pragma unroll
        for (int bj = 0; bj < 2; ++bj)
#pragma unroll
            for (int j = 0; j < 8; ++j) bv[bj][j] = bias[(size_t)u.e * D + col0 + bj * HALF + j];
        float sw[2][4];
#pragma unroll
        for (int ai = 0; ai < 2; ++ai)
#pragma unroll
            for (int m = 0; m < 4; ++m) sw[ai][m] = slotw[row0 + ai * HALF + m * 16];
#pragma unroll
        for (int ai = 0; ai < 2; ++ai)
#pragma unroll
            for (int m = 0; m < 4; ++m) { const int row = row0 + ai * HALF + m * 16; const float w = sw[ai][m] * Y8_SCALE; unsigned char* rowp = O + (size_t)row * D + col0;
#pragma unroll
                for (int bj = 0; bj < 2; ++bj) { float o[8];
#pragma unroll
                    for (int j = 0; j < 8; ++j) o[j] = ((j < 4 ? acc[ai][bj][m][0][j & 3] : acc[ai][bj][m][1][j & 3]) * W8_INV + bv[bj][j]) * w;
                    *(u32x2*)(rowp + bj * HALF) = (u32x2){fp8x4(o[0], o[1], o[2], o[3]), fp8x4(o[4], o[5], o[6], o[7])}; } }
    }
};
struct C1Sched {
    int G, c; const char* kvs; const char* w;
    DI bool next(int i, Unit& u) const {
        const int L = i * G + c; if (L >= 256) return false;
        const int kv = L >> 7, s = (L >> 3) & 15, pm = L & 7;
        u.pm = pm; u.pn = 0; u.e = s * 2 + kv;
        u.a = kvs + ((size_t)kv * KVS_ONE + (size_t)pm * 256 * 2048 + (size_t)s * 256) * 2;
        u.b = w + ((size_t)kv * 256 * 4096 + (size_t)s * 256) * 2; return true;
    }
};
struct MoeSched {
    int G, c, nN, total; const LAS int* tile_e; const char* A; const char* W; size_t w_exp;
    DI bool next(int i, Unit& u) const {
        const int L = i * G + c; if (L >= total) return false;
        const int mt = L / nN, pn = L - mt * nN; const int e = __builtin_amdgcn_readfirstlane(tile_e[mt]);
        u.pm = mt; u.pn = pn; u.e = e;
        u.a = A + (size_t)mt * 256 * D; u.b = W + (size_t)e * w_exp + (size_t)pn * 256 * D; return true;
    }
};
}

DI int colmap(int kind, int n) {
    if (kind == 0) return n;
    if (kind == 1) {
        if (n < 872) return n;
        if (n < 896) return 3432 + (n - 872);
        if (n < 1024) return -1;
        if (n < 2048) return 872 + (n - 1024);
        if (n < 3584) return 1896 + (n - 2048);
        return 3456 + (n - 3584);
    }
    if (kind == 2) { const int pn = n >> 8, r = n & 255; return r < 128 ? pn * 128 + r : 2048 + pn * 128 + (r - 128); }
    if (kind == 4) return n < 32 ? n : -1;
    { const int h = n >> 5, d = n & 31; return h * 128 + d; }
}
struct TrJob { const float* src; bf16_t* dst; int ldsrc, lddst, kind, k0, n0, dk0, dn0; };
DI void tr_load(const TrJob& j, f32x4 (&v)[8], int t) {
    const int c4 = t & 63, r0 = t >> 6; const int sc = colmap(j.kind, j.n0 + 4 * c4);
#pragma unroll
    for (int q = 0; q < 8; ++q) v[q] = (f32x4){0.f, 0.f, 0.f, 0.f};
    if (sc >= 0) {
#pragma unroll
        for (int q = 0; q < 8; ++q) v[q] = __builtin_nontemporal_load((const f32x4*)(j.src + (size_t)(j.k0 + r0 + 8 * q) * j.ldsrc + sc));
    }
}
DI void tr_lds_write(const f32x4 (&v)[8], float* tile, int t) {
    const int c4 = t & 63, r0 = t >> 6;
#pragma unroll
    for (int q = 0; q < 8; ++q) { float* tp = tile + (r0 + 8 * q) * 257 + 4 * c4; tp[0] = v[q][0]; tp[1] = v[q][1]; tp[2] = v[q][2]; tp[3] = v[q][3]; }
}
DI void tr_store(const TrJob& j, const float* tile, int t) {
    const int kk8 = (t & 7) * 8, nb = t >> 3;
#pragma unroll
    for (int ps = 0; ps < 4; ++ps) { const int nn = nb + 64 * ps; const float* s = tile + kk8 * 257 + nn;
        u32x4 o = {pk2(s[0], s[257]), pk2(s[2 * 257], s[3 * 257]), pk2(s[4 * 257], s[5 * 257]), pk2(s[6 * 257], s[7 * 257])};
        *(u32x4*)(j.dst + (size_t)(j.n0 + nn) * j.lddst + j.k0 + kk8) = o; }
}
DI void tr_setup(TrJob& j, int u, int nK, const float* src, int ldsrc, int kind, bf16_t* dst, int lddst) {
    const int kt = u % nK, ntile = u / nK; j.src = src; j.dst = dst; j.ldsrc = ldsrc; j.lddst = lddst; j.kind = kind; j.k0 = kt * 64; j.n0 = ntile * 256;
}
DI float tr8_load(const TrJob& j, f32x4 (&v)[8], int t) {
    const int c4 = t & 31, r0 = t >> 5; const int sc = colmap(j.kind, j.n0 + 4 * c4); const int scc = sc < 0 ? 0 : sc;
#pragma unroll
    for (int q = 0; q < 8; ++q) v[q] = __builtin_nontemporal_load((const f32x4*)(j.src + (size_t)(j.k0 + r0 + 16 * q) * j.ldsrc + scc));
    return sc < 0 ? 0.f : 1.f;
}
DI void tr8_lds_write(const f32x4 (&v)[8], float ok, float* tile, int t) {
    const int c4 = t & 31, r0 = t >> 5;
#pragma unroll
    for (int q = 0; q < 8; ++q) { float* tp = tile + (r0 + 16 * q) * 129 + 4 * c4; tp[0] = v[q][0] * ok; tp[1] = v[q][1] * ok; tp[2] = v[q][2] * ok; tp[3] = v[q][3] * ok; }
}
DI void tr8_store(const TrJob& j, const float* tile, int t) {
    const int kc = t & 7, nb = t >> 3; constexpr float SC = pg8::W8_SCALE;
#pragma unroll
    for (int ps = 0; ps < 2; ++ps) { const int nn = nb + 64 * ps; const float* s = tile + (16 * kc) * 129 + nn;
        u32x4 o = {pg8::fp8x4(s[0] * SC, s[129] * SC, s[2 * 129] * SC, s[3 * 129] * SC), pg8::fp8x4(s[4 * 129] * SC, s[5 * 129] * SC, s[6 * 129] * SC, s[7 * 129] * SC),
                   pg8::fp8x4(s[8 * 129] * SC, s[9 * 129] * SC, s[10 * 129] * SC, s[11 * 129] * SC), pg8::fp8x4(s[12 * 129] * SC, s[13 * 129] * SC, s[14 * 129] * SC, s[15 * 129] * SC)};
        __builtin_nontemporal_store(o, (u32x4*)((unsigned char*)j.dst + (size_t)(j.dn0 + nn) * j.lddst + j.dk0 + 16 * kc)); }
}
DI void phase_prep(const Params& p, char* smem) {
    float* tile = (float*)smem;
    const int t = tid_fresh(), G = gridDim.x;
    constexpr int U_ADA = 256, U_ABS = 256, U_WO = 1024, U_CB = 128, SPECIAL = U_ADA + U_ABS + U_WO + U_CB;
    constexpr int U_WINB = 32 * 8, U_WIN = 16 * 44, U_IDXQ = 8 * 2, U_UQR = 8, U_BRB = 16 * 8, U_OUT = 32 * 8, U_C1 = 64, U_RT = 32, U_GU = 32 * 16, U_DN = 32 * 8;
    constexpr int NTR = U_WINB + U_IDXQ + U_UQR + 2 * U_C1 + U_RT, NTR8 = U_WIN + U_BRB + U_OUT + NEXP * (U_GU + U_DN);
    bf16_t* Wq = (bf16_t*)(p.ws + O_WQ);
    for (int rp_ = 0; rp_ < ((PREP_REP & 1) ? 2 : 1); ++rp_)
    for (int u0 = blockIdx.x; u0 < SPECIAL; u0 += G) {
        int u = u0;
        if (rp_ == 1 && (u0 < PREP_REP_LO || u0 >= PREP_REP_HI)) continue;
        if (u < U_ADA) {
            const int c4 = t % 12, kg = t / 12; f32x4 a0 = {0.f, 0.f, 0.f, 0.f}, a1 = {0.f, 0.f, 0.f, 0.f};
            if (kg < 42) { const int col = u * 48 + c4 * 4;
#pragma unroll 7
                for (int k = kg; k < 2048; k += 42) { const float c0 = p.c[k], c1 = p.c[2048 + k]; const float s0 = c0 * sigmoidf_(c0), s1 = c1 * sigmoidf_(c1);
                    const f32x4 w = *(const f32x4*)(p.w_ada + (size_t)k * 12288 + col); a0 += w * s0; a1 += w * s1; } }
            __syncthreads();
            if (kg < 42) { float* tp = tile + (kg * 12 + c4) * 8;
#pragma unroll
                for (int j = 0; j < 4; ++j) { tp[j] = a0[j]; tp[4 + j] = a1[j]; } }
            __syncthreads();
            if (t < 96) { const int bb = t / 48, cc = t % 48; float acc = 0.f;
                for (int g2 = 0; g2 < 42; ++g2) acc += tile[(g2 * 12 + (cc >> 2)) * 8 + bb * 4 + (cc & 3)];
                ((float*)(p.ws + O_MODACC))[bb * 12288 + u * 48 + cc] = acc + p.b_ada[u * 48 + cc]; }
            continue; }
        u -= U_ADA;
        if (u < U_ABS) {
            const int h = u >> 5, w = __builtin_amdgcn_readfirstlane(t >> 6), l = t & 63, c = (u & 31) * 8 + w;
            const float* ukp = p.a_w_uk + (size_t)c * 768 + h * 96;
            float acc[8];
#pragma unroll
            for (int j = 0; j < 8; ++j) acc[j] = 0.f;
#pragma unroll 1
            for (int ch = 0; ch < 3; ++ch) {
                __syncthreads();
#pragma unroll
                for (int q = 0; q < 8; ++q) { const int r = (t >> 3) + 64 * q;
                    *(f32x4*)(tile + r * 36 + 4 * (t & 7)) = *(const f32x4*)(p.a_w_uq + (size_t)r * 1024 + h * 128 + 32 + ch * 32 + 4 * (t & 7)); }
                __syncthreads();
#pragma unroll 2
                for (int n4 = 0; n4 < 8; ++n4) { const float k0 = ukp[ch * 32 + 4 * n4], k1 = ukp[ch * 32 + 4 * n4 + 1], k2 = ukp[ch * 32 + 4 * n4 + 2], k3 = ukp[ch * 32 + 4 * n4 + 3];
#pragma unroll
                    for (int j = 0; j < 8; ++j) { const f32x4 x = *(const f32x4*)(tile + (l + 64 * j) * 36 + 4 * n4);
                        acc[j] = __builtin_fmaf(x[0], k0, acc[j]); acc[j] = __builtin_fmaf(x[1], k1, acc[j]); acc[j] = __builtin_fmaf(x[2], k2, acc[j]); acc[j] = __builtin_fmaf(x[3], k3, acc[j]); } }
            }
#pragma unroll
            for (int j = 0; j < 8; ++j) Wq[(size_t)(h * 256 + c) * 512 + l + 64 * j] = f2bf(acc[j]);
            continue; }
        u -= U_ABS;
        if (u < U_WO) {
            const int n = (u & 3) * 512 + t, kg = u >> 2, k0 = kg * 8, h = k0 >> 8;
            const float* uvp = p.a_w_uv + (size_t)k0 * 128; const float* wbp = p.w_br_a + (size_t)(h * 128) * D + n;
            float acc[8];
#pragma unroll
            for (int j = 0; j < 8; ++j) acc[j] = 0.f;
#pragma unroll 4
            for (int v = 0; v < 128; ++v) { const float wb = wbp[(size_t)v * D];
#pragma unroll
                for (int j = 0; j < 8; ++j) acc[j] += uvp[j * 128 + v] * wb; }
            *(u32x2*)((unsigned char*)(p.ws + O_WO) + (size_t)n * D + k0) = (u32x2){pg8::fp8x4(acc[0] * pg8::W8_SCALE, acc[1] * pg8::W8_SCALE, acc[2] * pg8::W8_SCALE, acc[3] * pg8::W8_SCALE), pg8::fp8x4(acc[4] * pg8::W8_SCALE, acc[5] * pg8::W8_SCALE, acc[6] * pg8::W8_SCALE, acc[7] * pg8::W8_SCALE)};
            continue; }
        u -= U_WO;
        {
            const int kv = u >> 6, seg = u & 63;
            if (t < 256) { const float* pe = kv ? p.cmp_v_pe : p.cmp_k_pe; const float* w1 = kv ? p.cmp_v_w1 : p.cmp_k_w1; float a = 0.f;
#pragma unroll 16
                for (int i = seg * 64; i < seg * 64 + 64; ++i) a += pe[i] * w1[(size_t)i * 256 + t];
                ((float*)(p.ws + O_CBP))[(seg * 2 + kv) * 256 + t] = a; } }
    }
    auto setup = [&](TrJob& j, int u) {
        if (u < U_WINB) { tr_setup(j, u, 32, p.w_in, 7552, 1, (bf16_t*)(p.ws + O_WIN), D); return; } u -= U_WINB;
        if (u < U_IDXQ) { tr_setup(j, u, 8, p.idx_w_q, 512, 0, Wq + (size_t)2304 * 512, 512); return; } u -= U_IDXQ;
        if (u < U_UQR) { tr_setup(j, u, 8, p.a_w_uq, 1024, 3, Wq + (size_t)2048 * 512, 512); return; } u -= U_UQR;
        if (u < U_C1) { tr_setup(j, u, 64, p.cmp_k_w1, 256, 0, (bf16_t*)(p.ws + O_WC1), 4096); return; } u -= U_C1;
        if (u < U_C1) { tr_setup(j, u, 64, p.cmp_v_w1, 256, 0, (bf16_t*)(p.ws + O_WC1) + (size_t)256 * 4096, 4096); return; } u -= U_C1;
        tr_setup(j, u, 32, p.w_router, 32, 4, (bf16_t*)(p.ws + O_WRT), D);
    };
    auto setup8 = [&](TrJob& j, int u) {
        j.lddst = D;
        if (u < U_WIN) { j.src = p.w_in; j.ldsrc = 7552; j.kind = 1; j.dst = (bf16_t*)(p.ws + O_WIN8); j.k0 = (u & 15) * 128; j.n0 = 2048 + (u >> 4) * 128; j.dk0 = j.k0; j.dn0 = j.n0; return; } u -= U_WIN;
        if (u < U_BRB) { j.src = p.w_br_b; j.ldsrc = D; j.kind = 0; j.dst = (bf16_t*)(p.ws + O_WBRB); j.lddst = 1024; j.k0 = (u & 7) * 128; j.n0 = (u >> 3) * 128; j.dk0 = j.k0; j.dn0 = j.n0; return; } u -= U_BRB;
        if (u < U_OUT) { j.src = p.w_out; j.ldsrc = D; j.kind = 0; j.dst = (bf16_t*)(p.ws + O_WOUT); j.k0 = (u & 15) * 128; j.n0 = (u >> 4) * 128; j.dk0 = j.k0; j.dn0 = j.n0; return; } u -= U_OUT;
        const int e = u / (U_GU + U_DN), r = u - e * (U_GU + U_DN);
        if (r < U_GU) { j.src = p.w_gate_up + (size_t)e * D * 4096; j.ldsrc = 4096; j.kind = 2; j.dst = (bf16_t*)(p.ws + O_WGU + (size_t)e * 4096 * D + (size_t)r * 16384); j.k0 = (r & 15) * 128; j.n0 = (r >> 4) * 128; }
        else { const int r2 = r - U_GU; j.src = p.w_down + (size_t)e * D * D; j.ldsrc = D; j.kind = 0; j.dst = (bf16_t*)(p.ws + O_WDN + (size_t)e * D * D + (size_t)r2 * 16384); j.k0 = (r2 & 15) * 128; j.n0 = (r2 >> 4) * 128; }
        j.lddst = 128; j.dk0 = 0; j.dn0 = 0;
    };
    TrJob cur, nxt; f32x4 v[8];
    int u;
    for (int rp_ = 0; rp_ < ((PREP_REP & 2) ? 2 : 1); ++rp_) {
    u = blockIdx.x;
    if (u < NTR) { setup(cur, u); tr_load(cur, v, t); }
#pragma unroll 1
    for (; u < NTR; u += G) {
        __syncthreads();
        tr_lds_write(v, tile, t);
        __syncthreads();
        const bool more = u + G < NTR;
        if (more) { setup(nxt, u + G); tr_load(nxt, v, t); }
        tr_store(cur, tile, t);
        cur = nxt;
    }
    }
    auto clampu = [&](int x) { return x < NTR8 ? x : NTR8 - 1; };
    for (int rp_ = 0; rp_ < ((PREP_REP & 4) ? 2 : 1); ++rp_) {
    u = blockIdx.x;
    f32x4 v2[8]; float ok1, ok2;
    setup8(cur, clampu(u)); ok1 = tr8_load(cur, v, t);
    setup8(nxt, clampu(u + G)); ok2 = tr8_load(nxt, v2, t);
#pragma unroll 1
    for (; u < NTR8; u += 2 * G) {
        __syncthreads();
        tr8_lds_write(v, ok1, tile, t);
        __syncthreads();
        TrJob c = cur;
        setup8(cur, clampu(u + 2 * G)); ok1 = tr8_load(cur, v, t);
        tr8_store(c, tile, t);
        __syncthreads();
        tr8_lds_write(v2, ok2, tile, t);
        __syncthreads();
        c = nxt;
        setup8(nxt, clampu(u + 3 * G)); ok2 = tr8_load(nxt, v2, t);
        tr8_store(c, tile, t);
    }
    }
#if PREP_PROBE_MODE >= 2
    {
        unsigned chk = 0; unsigned char* dummy = (unsigned char*)(p.ws + O_HS);
        constexpr int U0 = U_WIN + U_BRB + U_OUT;
        TrJob pj, pn; f32x4 w[8]; float okp;
        int uu = U0 + blockIdx.x;
        setup8(pj, uu); okp = tr8_load(pj, w, t);
#pragma unroll 1
        for (; uu < NTR8; uu += G) {
#if PREP_PROBE_MODE == 2
            __syncthreads();
            tr8_lds_write(w, okp, tile, t);
            __syncthreads();
            setup8(pn, clampu(uu + G)); okp = tr8_load(pn, w, t);
            {   const int kc = t & 7, nb = t >> 3; constexpr float SC = pg8::W8_SCALE;
#pragma unroll
                for (int ps = 0; ps < 2; ++ps) { const int nn = nb + 64 * ps; const float* s = tile + (16 * kc) * 129 + nn;
                    chk ^= pg8::fp8x4(s[0] * SC, s[129] * SC, s[2 * 129] * SC, s[3 * 129] * SC) ^ pg8::fp8x4(s[4 * 129] * SC, s[5 * 129] * SC, s[6 * 129] * SC, s[7 * 129] * SC)
                         ^ pg8::fp8x4(s[8 * 129] * SC, s[9 * 129] * SC, s[10 * 129] * SC, s[11 * 129] * SC) ^ pg8::fp8x4(s[12 * 129] * SC, s[13 * 129] * SC, s[14 * 129] * SC, s[15 * 129] * SC); } }
            pj = pn;
#else
            u32x4 o0 = {pg8::fp8x4(w[0][0], w[0][1], w[0][2], w[0][3]), pg8::fp8x4(w[1][0], w[1][1], w[1][2], w[1][3]), pg8::fp8x4(w[2][0], w[2][1], w[2][2], w[2][3]), pg8::fp8x4(w[3][0], w[3][1], w[3][2], w[3][3])};
            u32x4 o1 = {pg8::fp8x4(w[4][0], w[4][1], w[4][2], w[4][3]), pg8::fp8x4(w[5][0], w[5][1], w[5][2], w[5][3]), pg8::fp8x4(w[6][0], w[6][1], w[6][2], w[6][3]), pg8::fp8x4(w[7][0], w[7][1], w[7][2], w[7][3])};
            setup8(pn, clampu(uu + G)); okp = tr8_load(pn, w, t);
            u32x4* dp = (u32x4*)(dummy + ((size_t)(uu - U0) * 512 + t) * 32); dp[0] = o0; dp[1] = o1;
            pj = pn;
#endif
        }
        if (chk == 0x12345678u && okp == 3.f) ((unsigned*)(p.ws + 115200))[0] = chk;
    }
#endif
#if PREP_PROBE_WC > 0
    {
        constexpr int WC = PREP_PROBE_WC, RW = WC / 4, RS = 512 / RW, R = 16384 / WC;
        float acc = 0.f; const int c4 = t % RW, r0 = t / RW;
#pragma unroll 1
        for (int pass = 0; pass < 2; ++pass) {
            const float* base = pass ? p.w_down : p.w_gate_up; const int ld = pass ? 2048 : 4096;
            const int nK = 65536 / R, ntiles = nK * (ld / WC);
#pragma unroll 1
            for (int uu = blockIdx.x; uu < ntiles; uu += G) {
#if PREP_PROBE_NFAST
                const int nN = ld / WC, nt_ = uu % nN, kt = uu / nN;
#else
                const int kt = uu % nK, nt_ = uu / nK;
#endif
                f32x4 w[8];
#pragma unroll
                for (int q = 0; q < 8; ++q) w[q] = __builtin_nontemporal_load((const f32x4*)(base + (size_t)(kt * R + r0 + RS * q) * ld + nt_ * WC + 4 * c4));
#pragma unroll
                for (int q = 0; q < 8; ++q) acc += (w[q][0] + w[q][1]) + (w[q][2] + w[q][3]);
            }
        }
        if (acc == 12345.678f) ((float*)(p.ws + 115200))[0] = acc;
    }
#endif
}

DI void phase_h1(const Params& p) {
    const int tz_ = tid_fresh(); const int lane = tz_ & 63, wid = __builtin_amdgcn_readfirstlane(tz_ >> 6);
    if (blockIdx.x == 0) { float a = 0.f; const float* cbp = (const float*)(p.ws + O_CBP);
        for (int sg = 0; sg < 64; ++sg) a += cbp[sg * 512 + tz_];
        ((float*)(p.ws + O_CBIAS))[tz_] = a; }
    bf16_t* H = (bf16_t*)(p.ws + O_H); float* rope = (float*)(p.ws + O_ROPE);
    for (int tok = blockIdx.x * 8 + wid; tok < NT; tok += gridDim.x * 8) {
        const int b = tok >> 13;
        const f32x4* xr = (const f32x4*)(p.x + (size_t)tok * D) + lane;
        f32x4 v[8]; float ss = 0.f;
#pragma unroll
        for (int i = 0; i < 8; ++i) { v[i] = xr[64 * i]; ss += v[i][0] * v[i][0] + v[i][1] * v[i][1] + v[i][2] * v[i][2] + v[i][3] * v[i][3]; }
        const float rs = rsqrtf(wave_sum(ss) * (1.f / D) + NORM_EPS);
#pragma unroll
        for (int i = 0; i < 8; ++i) { const int col = 4 * (lane + 64 * i); float o[4];
#pragma unroll
            for (int j = 0; j < 4; ++j) o[j] = v[i][j] * rs * p.g_pre_mix[col + j] * (1.f + mod_at(p, b, 2048 + col + j)) + mod_at(p, b, col + j);
            *(u32x2*)(H + (size_t)tok * D + col) = (u32x2){pk2(o[0], o[1]), pk2(o[2], o[3])};
            *(unsigned*)((unsigned char*)(p.ws + O_H8) + (size_t)tok * D + col) = pg8::fp8x4(o[0], o[1], o[2], o[3]); }
        if (lane < 24) { const float fr = lane < 16 ? (float)(2 * lane) * (1.f / 32.f) : (float)(2 * (lane - 16)) * (1.f / 16.f);
            const float inv = exp2f(-fr * 18.931568569324174f);
            const float ang = (float)p.pos[tok] * inv; float s, c; sincosf(ang, &s, &c);
            rope[(size_t)tok * 48 + 2 * lane] = c; rope[(size_t)tok * 48 + 2 * lane + 1] = s; }
    }
}

DI void phase_zpost(const Params& p) {
    const int tz_ = tid_fresh(); const int lane = tz_ & 63, wid = __builtin_amdgcn_readfirstlane(tz_ >> 6);
    const bf16_t* Z = (const bf16_t*)(p.ws + O_Z); const float* rope = (const float*)(p.ws + O_ROPE);
    bf16_t* cqn = (bf16_t*)(p.ws + O_CQN); bf16_t* kvt = (bf16_t*)(p.ws + O_KVT); bf16_t* kidx = (bf16_t*)(p.ws + O_KIDX);
    float* widx = (float*)(p.ws + O_WIDX); float* gates = (float*)(p.ws + O_GATES); bf16_t* bq = (bf16_t*)(p.ws + O_BQ); bf16_t* kvs = (bf16_t*)(p.ws + O_KVS);
    for (int tok = blockIdx.x * 8 + wid; tok < NT; tok += gridDim.x * 8) {
        const int b = tok >> 13, tq = tok & (T - 1);
        const bf16_t* zr = Z + (size_t)tok * ZC; const float* rt = rope + (size_t)tok * 48;
        {
            float f[8]; unpack8(*(const u32x4*)(zr + lane * 8), f); float ss = 0.f;
#pragma unroll
            for (int j = 0; j < 8; ++j) ss += f[j] * f[j];
            const float rs = rsqrtf(wave_sum(ss) * (1.f / 512.f) + NORM_EPS);
#pragma unroll
            for (int j = 0; j < 8; ++j) f[j] = f[j] * rs * p.a_cq_norm[lane * 8 + j];
            *(u32x4*)(cqn + (size_t)tok * 512 + lane * 8) = (u32x4){pk2(f[0], f[1]), pk2(f[2], f[3]), pk2(f[4], f[5]), pk2(f[6], f[7])};
        }
        {
            const u32x2 w = *(const u32x2*)(zr + ZC_CKV + lane * 4); float f[4] = {bflo(w[0]), bfhi(w[0]), bflo(w[1]), bfhi(w[1])};
            const float rs = rsqrtf(wave_sum(f[0] * f[0] + f[1] * f[1] + f[2] * f[2] + f[3] * f[3]) * (1.f / 256.f) + NORM_EPS);
#pragma unroll
            for (int j = 0; j < 4; ++j) f[j] = f[j] * rs * p.a_ckv_norm[lane * 4 + j];
            *(u32x2*)(kvt + (size_t)tok * KVW + lane * 4) = (u32x2){pk2(f[0], f[1]), pk2(f[2], f[3])};
        }
        if (lane < 16) {
            const float x1 = bf2f(zr[ZC_KROPE + lane]), x2 = bf2f(zr[ZC_KROPE + 16 + lane]), c = rt[2 * lane], s = rt[2 * lane + 1];
            kvt[(size_t)tok * KVW + 256 + lane] = f2bf(x1 * c - x2 * s); kvt[(size_t)tok * KVW + 272 + lane] = f2bf(x2 * c + x1 * s);
        }
        {
            const float v = bf2f(zr[ZC_KIDX + lane]); const float mean = wave_sum(v) * (1.f / 64.f); const float xc = v - mean;
            const float var = wave_sum(xc * xc) * (1.f / 64.f);
            const float y = xc * rsqrtf(var + NORM_EPS) * p.idx_g[lane] + p.idx_b[lane];
            const float pr = __shfl_xor(y, 8); float o = y;
            if (lane < 8) o = y * rt[32 + 2 * lane] - pr * rt[33 + 2 * lane];
            else if (lane < 16) o = y * rt[32 + 2 * (lane - 8)] + pr * rt[33 + 2 * (lane - 8)];
            kidx[(size_t)tok * 64 + lane] = f2bf(o);
        }
        if (lane < 8) widx[(size_t)tok * 8 + lane] = bf2f(zr[ZC_WIDX + lane]) * (0.35355339059327373f * 0.125f);
        if (lane < 24) gates[(size_t)tok * 24 + lane] = sigmoidf_(bf2f(zr[ZC_BGATE + lane]));
#pragma unroll
        for (int ps = 0; ps < 3; ++ps) { const int slot = ps * 64 + lane;
            if (slot < 160) { const int hh = slot >> 3, part = slot & 7; const bf16_t* src = zr + ZC_BQ + hh * 128 + part * 16;
                float f[16]; { float a[8], c[8]; unpack8(*(const u32x4*)src, a); unpack8(*(const u32x4*)(src + 8), c);
#pragma unroll
                    for (int j = 0; j < 8; ++j) { f[j] = a[j]; f[8 + j] = c[j]; } }
                const bool dorope = hh < 8 || (((hh - 8) >> 1) & 1) == 0;
                if (dorope && part < 2) { const bf16_t* os = part == 0 ? src + 16 : src - 16; float g[16];
                    { float a[8], c[8]; unpack8(*(const u32x4*)os, a); unpack8(*(const u32x4*)(os + 8), c);
#pragma unroll
                      for (int j = 0; j < 8; ++j) { g[j] = a[j]; g[8 + j] = c[j]; } }
#pragma unroll
                    for (int i = 0; i < 16; ++i) { const float c = rt[2 * i], s = rt[2 * i + 1]; f[i] = part == 0 ? f[i] * c - g[i] * s : f[i] * c + g[i] * s; } }
                bf16_t* dst;
                if (hh < 8) dst = bq + (size_t)tok * 1024 + hh * 128 + part * 16;
                else { const int i6 = (hh - 8) >> 1, g = (hh - 8) & 1; dst = kvs + ((((size_t)i6 * NB + b) * 2 + g) * T + tq) * 128 + part * 16; }
                *(u32x4*)dst = (u32x4){pk2(f[0], f[1]), pk2(f[2], f[3]), pk2(f[4], f[5]), pk2(f[6], f[7])};
                *(u32x4*)(dst + 8) = (u32x4){pk2(f[8], f[9]), pk2(f[10], f[11]), pk2(f[12], f[13]), pk2(f[14], f[15])}; } }
    }
}

DI void c2_rows(const Params& p, char* smem) {
    const int tz_ = tid_fresh(); const int lane = tz_ & 63, wid = __builtin_amdgcn_readfirstlane(tz_ >> 6);
    float* hrow = (float*)smem + wid * 256;
    const float* c1p = (const float*)(p.ws + O_C1P); const float* cb = (const float*)(p.ws + O_CBIAS); bf16_t* kcvc = (bf16_t*)(p.ws + O_KCVC);
    for (int row = blockIdx.x * 8 + wid; row < 4096; row += gridDim.x * 8) {
        const int kv = row >> 11, r = row & 2047, n = r & 511;
        f32x4 a = *(const f32x4*)(cb + kv * 256 + lane * 4);
#pragma unroll
        for (int s = 0; s < 16; ++s) a += *(const f32x4*)(c1p + ((size_t)(s * 2 + kv) * 2048 + r) * 256 + lane * 4);
#pragma unroll
        for (int j = 0; j < 4; ++j) { const float v = a[j]; const float u = 0.7978845608028654f * (v + 0.044715f * v * v * v); hrow[lane * 4 + j] = 0.5f * v * (1.f + tanhf(u)); }
        asm volatile("s_waitcnt lgkmcnt(0)" ::: "memory");
        const float* w2 = kv ? p.cmp_v_w2 : p.cmp_k_w2;
        float o0 = 0.f, o1 = 0.f;
#pragma unroll 16
        for (int j = 0; j < 256; ++j) { const float hv = hrow[j]; const float2 w = *(const float2*)(w2 + j * 128 + lane * 2); o0 += hv * w.x; o1 += hv * w.y; }
        if (n == 511) { o0 = 0.f; o1 = 0.f; }
        *(unsigned*)(kcvc + (size_t)row * 128 + lane * 2) = pk2(o0, o1);
        asm volatile("s_waitcnt lgkmcnt(0)" ::: "memory");
    }
}

DI unsigned short f16key(float v) { const _Float16 h = (_Float16)v; unsigned short u = __builtin_bit_cast(unsigned short, h); return (u & 0x8000u) ? (unsigned short)~u : (unsigned short)(u | 0x8000u); }
DI void topk256_select(const LAS unsigned* scw, int nk, unsigned short* out, int lane) {
    const int nw = (nk + 127) >> 7;
    auto ldk = [&](int i) -> unsigned { const int wi = i * 64 + lane; unsigned v = scw[wi]; if (2 * wi >= nk) v = 0u; else if (2 * wi + 1 >= nk) v &= 0xffffu; return v; };
    unsigned Tv = 0u;
    for (int bit = 15; bit >= 0; --bit) { const unsigned cand = Tv | (1u << bit); int cnt = 0;
#pragma unroll 4
        for (int i = 0; i < nw; ++i) { const unsigned kv = ldk(i); cnt += __popcll(__ballot((kv & 0xffffu) >= cand)) + __popcll(__ballot((kv >> 16) >= cand)); }
        if (cnt >= 256) Tv = cand; }
    int cgt = 0;
#pragma unroll 4
    for (int i = 0; i < nw; ++i) { const unsigned kv = ldk(i); cgt += __popcll(__ballot((kv & 0xffffu) > Tv)) + __popcll(__ballot((kv >> 16) > Tv)); }
    const int need = 256 - cgt; int pos = 0, eqc = 0;
    const unsigned long long ltm = (1ull << lane) - 1ull;
#pragma unroll 2
    for (int i = 0; i < nw; ++i) {
        const unsigned kv = ldk(i); const unsigned lo = kv & 0xffffu, hi = kv >> 16;
        const bool elo = lo == Tv, ehi = hi == Tv;
        const unsigned long long mlo = __ballot(elo), mhi = __ballot(ehi);
        const int below = __popcll(mlo & ltm) + __popcll(mhi & ltm);
        const bool slo = lo > Tv || (elo && eqc + below < need), shi = hi > Tv || (ehi && eqc + below + (elo ? 1 : 0) < need);
        const unsigned long long s0 = __ballot(slo), s1 = __ballot(shi);
        const int plo = pos + __popcll(s0 & ltm), phi = pos + __popcll(s0) + __popcll(s1 & ltm);
        const int kidx = 2 * (i * 64 + lane);
        if (slo) out[plo] = (unsigned short)kidx;
        if (shi) out[phi] = (unsigned short)(kidx + 1);
        pos += __popcll(s0) + __popcll(s1); eqc += __popcll(mlo) + __popcll(mhi); }
}
DI void phase_indexer(const Params& p, char* smem) {
    const int tz_ = tid_fresh(); const int lane = tz_ & 63, wid = __builtin_amdgcn_readfirstlane(tz_ >> 6);
    LAS unsigned short* sc = (LAS unsigned short*)(LAS char*)smem + wid * 8192;
    float* qf = (float*)(smem + 131072) + wid * 512;
    const bf16_t* Q = (const bf16_t*)(p.ws + O_QALL); const bf16_t* KI = (const bf16_t*)(p.ws + O_KIDX); const float* WI = (const float*)(p.ws + O_WIDX);
    unsigned short* SEL = (unsigned short*)(p.ws + O_SEL); int* NSEL = (int*)(p.ws + O_NSEL);
    for (int tok = (int)(NT / 8 - 1 - blockIdx.x) * 8 + wid; tok >= 0; tok -= gridDim.x * 8) {
        const int b = tok >> 13, tq = tok & (T - 1), nk = tq + 1;
        unsigned short* out = SEL + (size_t)tok * 256;
        if (nk <= 256) { for (int i = lane; i < 256; i += 64) out[i] = (unsigned short)(i < nk ? i : 0); if (lane == 0) NSEL[tok] = nk; continue; }
        { float f[8]; unpack8(*(const u32x4*)(Q + (size_t)tok * QC + 2304 + lane * 8), f);
#pragma unroll
          for (int j = 0; j < 8; ++j) qf[lane * 8 + j] = f[j]; }
        float wh[8];
#pragma unroll
        for (int h = 0; h < 8; ++h) wh[h] = WI[(size_t)tok * 8 + h];
        asm volatile("s_waitcnt lgkmcnt(0)" ::: "memory");
        for (int s = lane; s < nk; s += 64) {
            const bf16_t* kr = KI + ((size_t)b * T + s) * 64; float d[8];
#pragma unroll
            for (int h = 0; h < 8; ++h) d[h] = 0.f;
#pragma unroll 2
            for (int c = 0; c < 8; ++c) { float kf[8]; unpack8(*(const u32x4*)(kr + c * 8), kf);
#pragma unroll
                for (int h = 0; h < 8; ++h) { const f32x4 q0 = *(const f32x4*)(qf + h * 64 + c * 8), q1 = *(const f32x4*)(qf + h * 64 + c * 8 + 4);
                    d[h] += q0[0] * kf[0] + q0[1] * kf[1] + q0[2] * kf[2] + q0[3] * kf[3] + q1[0] * kf[4] + q1[1] * kf[5] + q1[2] * kf[6] + q1[3] * kf[7]; } }
            float score = 0.f;
#pragma unroll
            for (int h = 0; h < 8; ++h) score += wh[h] * fmaxf(d[h], 0.f);
            sc[s] = f16key(score); }
        asm volatile("s_waitcnt lgkmcnt(0)" ::: "memory");
        topk256_select((const LAS unsigned*)sc, nk, out, lane);
        if (lane == 0) NSEL[tok] = 256;
        asm volatile("s_waitcnt lgkmcnt(0)" ::: "memory");
    }
}

DI void phase_mla(const Params& p, char* smem) {
    const int tz_ = tid_fresh(); const int lane = tz_ & 63, wid = __builtin_amdgcn_readfirstlane(tz_ >> 6);
    float* qf = (float*)smem + wid * (8 * KVW + 8 * 256 + 128);
    float* pf = qf + 8 * KVW; unsigned short* selw = (unsigned short*)(pf + 8 * 256);
    const bf16_t* Q = (const bf16_t*)(p.ws + O_QALL); const bf16_t* KV = (const bf16_t*)(p.ws + O_KVT);
    const unsigned short* SEL = (const unsigned short*)(p.ws + O_SEL); const int* NSEL = (const int*)(p.ws + O_NSEL); bf16_t* OL = (bf16_t*)(p.ws + O_OLAT);
    for (int tok = blockIdx.x * 8 + wid; tok < NT; tok += gridDim.x * 8) {
        const int b = tok >> 13; const int cnt = NSEL[tok];
        const bf16_t* qr = Q + (size_t)tok * QC;
#pragma unroll 4
        for (int i = 0; i < 36; ++i) { const int e = lane + 64 * i;
            const int h = e / KVW, d = e - h * KVW; qf[e] = bf2f(d < 256 ? qr[h * 256 + d] : qr[2048 + h * 32 + (d - 256)]); }
        *(u32x2*)(selw + lane * 4) = *(const u32x2*)(SEL + (size_t)tok * 256 + lane * 4);
        asm volatile("s_waitcnt lgkmcnt(0)" ::: "memory");
        const bf16_t* rows[4];
#pragma unroll
        for (int j = 0; j < 4; ++j) { const int k = lane + 64 * j; const int idx = k < cnt ? selw[k] : 0; rows[j] = KV + ((size_t)b * T + idx) * KVW; }
        float acc[4][8];
#pragma unroll
        for (int j = 0; j < 4; ++j)
#pragma unroll
            for (int h = 0; h < 8; ++h) acc[j][h] = 0.f;
#pragma unroll 1
        for (int c = 0; c < 36; ++c) { float kf[4][8];
#pragma unroll
            for (int j = 0; j < 4; ++j) unpack8(*(const u32x4*)(rows[j] + c * 8), kf[j]);
#pragma unroll
            for (int h = 0; h < 8; ++h) { const f32x4 q0 = *(const f32x4*)(qf + h * KVW + c * 8), q1 = *(const f32x4*)(qf + h * KVW + c * 8 + 4);
#pragma unroll
                for (int j = 0; j < 4; ++j) acc[j][h] += q0[0] * kf[j][0] + q0[1] * kf[j][1] + q0[2] * kf[j][2] + q0[3] * kf[j][3] + q1[0] * kf[j][4] + q1[1] * kf[j][5] + q1[2] * kf[j][6] + q1[3] * kf[j][7]; } }
#pragma unroll
        for (int h = 0; h < 8; ++h) { float m = -INFINITY;
#pragma unroll
            for (int j = 0; j < 4; ++j) { acc[j][h] = (lane + 64 * j < cnt) ? acc[j][h] * ATT_SCALE : -INFINITY; m = fmaxf(m, acc[j][h]); }
            m = wave_max(m); float l = 0.f;
#pragma unroll
            for (int j = 0; j < 4; ++j) { acc[j][h] = (lane + 64 * j < cnt) ? __expf(acc[j][h] - m) : 0.f; l += acc[j][h]; }
            l = 1.f / fmaxf(wave_sum(l), 1e-30f);
#pragma unroll
            for (int j = 0; j < 4; ++j) pf[h * 256 + lane + 64 * j] = acc[j][h] * l; }
        asm volatile("s_waitcnt lgkmcnt(0)" ::: "memory");
        float o[8][4];
#pragma unroll
        for (int h = 0; h < 8; ++h)
#pragma unroll
            for (int j = 0; j < 4; ++j) o[h][j] = 0.f;
#pragma unroll 1
        for (int k0 = 0; k0 < 256; k0 += 8) { u32x2 vv[8];
#pragma unroll
            for (int kk = 0; kk < 8; ++kk) { const int k = k0 + kk; const int idx = k < cnt ? selw[k] : 0; vv[kk] = *(const u32x2*)(KV + ((size_t)b * T + idx) * KVW + lane * 4); }
#pragma unroll
            for (int kk = 0; kk < 8; ++kk) { const float v0 = bflo(vv[kk][0]), v1 = bfhi(vv[kk][0]), v2 = bflo(vv[kk][1]), v3 = bfhi(vv[kk][1]);
#pragma unroll
                for (int h = 0; h < 8; ++h) { const float ph = pf[h * 256 + k0 + kk]; o[h][0] += ph * v0; o[h][1] += ph * v1; o[h][2] += ph * v2; o[h][3] += ph * v3; } } }
#pragma unroll
        for (int h = 0; h < 8; ++h) *(u32x2*)(OL + (size_t)tok * D + h * 256 + lane * 4) = (u32x2){pk2(o[h][0], o[h][1]), pk2(o[h][2], o[h][3])};
        asm volatile("s_waitcnt lgkmcnt(0)" ::: "memory");
    }
}

DI void nsa_score(const bf16_t* kr, const float* qf, float (&s)[4]) {
#pragma unroll
    for (int j = 0; j < 4; ++j) s[j] = 0.f;
#pragma unroll 4
    for (int c = 0; c < 16; ++c) { float kf[8]; unpack8(*(const u32x4*)(kr + c * 8), kf);
#pragma unroll
        for (int j = 0; j < 4; ++j) { const f32x4 q0 = *(const f32x4*)(qf + j * 128 + c * 8), q1 = *(const f32x4*)(qf + j * 128 + c * 8 + 4);
            s[j] += q0[0] * kf[0] + q0[1] * kf[1] + q0[2] * kf[2] + q0[3] * kf[3] + q1[0] * kf[4] + q1[1] * kf[5] + q1[2] * kf[6] + q1[3] * kf[7]; } }
}
DI void phase_nsa(const Params& p, char* smem) {
    const int tz_ = tid_fresh(); const int lane = tz_ & 63, wid = __builtin_amdgcn_readfirstlane(tz_ >> 6);
    float* qf = (float*)smem + wid * (512 + 256 + 512 + 16); float* pb = qf + 512; float* psum = pb + 256; int* blk = (int*)(psum + 512);
    const bf16_t* BQ = (const bf16_t*)(p.ws + O_BQ); const bf16_t* kvs = (const bf16_t*)(p.ws + O_KVS); const bf16_t* kcvc = (const bf16_t*)(p.ws + O_KCVC);
    const float* gates = (const float*)(p.ws + O_GATES); bf16_t* OB = (bf16_t*)(p.ws + O_OB);
#pragma unroll 1
    for (int item = (NT * 2 / 8 - 1 - (int)blockIdx.x) * 8 + wid; item >= 0; item -= gridDim.x * 8) {
        const int tok = item >> 1, g = item & 1, b = tok >> 13, tq = tok & (T - 1);
        { float f[8]; unpack8(*(const u32x4*)(BQ + (size_t)tok * 1024 + g * 512 + lane * 8), f);
#pragma unroll
          for (int j = 0; j < 8; ++j) qf[lane * 8 + j] = f[j]; }
        asm volatile("s_waitcnt lgkmcnt(0)" ::: "memory");
        const size_t bg = (size_t)(b * 2 + g);
        const int nmax = tq >= 31 ? (tq - 31) >> 4 : -1;
        float res[4][2], o[4][2], m[4], l[4]; int ns = 0;
#pragma unroll
        for (int j = 0; j < 4; ++j) { res[j][0] = 0.f; res[j][1] = 0.f; }
#pragma unroll 1
        for (int step = 0; step < 4; ++step) {
            const int kind = step < 2 ? 0 : step - 1;
            const int mode = step == 0 ? 1 : (step == 1 ? 2 : 0);
            const bf16_t* kbase; const bf16_t* vbase; int nch;
            if (kind == 0) { kbase = kcvc + bg * 512 * 128; vbase = kcvc + (size_t)2048 * 128 + bg * 512 * 128; nch = 8; }
            else if (kind == 1) { kbase = kvs + (2 * (size_t)NB * 2 + bg) * T * 128; vbase = kvs + (3 * (size_t)NB * 2 + bg) * T * 128; nch = ns; }
            else { kbase = kvs + (4 * (size_t)NB * 2 + bg) * T * 128; vbase = kvs + (5 * (size_t)NB * 2 + bg) * T * 128; nch = 8; }
            if (mode != 2) {
#pragma unroll
                for (int j = 0; j < 4; ++j) { m[j] = -INFINITY; l[j] = 0.f; } }
#pragma unroll
            for (int j = 0; j < 4; ++j) { o[j][0] = 0.f; o[j][1] = 0.f; }
#pragma unroll 1
            for (int c = 0; c < nch; ++c) {
                int base, lim_lo, lim_hi;
                if (kind == 0) { base = 64 * c; lim_lo = 0; lim_hi = nmax; }
                else if (kind == 1) { base = blk[c] * 64; lim_lo = 0; lim_hi = tq; }
                else { base = tq - 511 + 64 * c; lim_lo = 0; lim_hi = tq; }
                const bool active = base <= lim_hi && base + 63 >= lim_lo;
                if (!active) { if (mode == 2) psum[c * 64 + lane] = 0.f; continue; }
                const int key = base + lane; const bool valid = key >= lim_lo && key <= lim_hi;
                float s[4]; nsa_score(kbase + (size_t)(key < 0 ? 0 : key) * 128, qf, s);
                float ps = 0.f;
#pragma unroll
                for (int j = 0; j < 4; ++j) {
                    const float sv = valid ? s[j] * ATT_SCALE : -INFINITY; float pj;
                    if (mode == 2) { pj = valid ? __expf(sv - m[j]) * l[j] : 0.f; ps += pj; }
                    else { const float mn = fmaxf(m[j], wave_max(sv));
                        const float alpha = (m[j] == -INFINITY) ? 0.f : __expf(m[j] - mn);
                        pj = (sv == -INFINITY) ? 0.f : __expf(sv - mn);
                        l[j] = l[j] * alpha + wave_sum(pj); m[j] = mn; o[j][0] *= alpha; o[j][1] *= alpha; }
                    pb[j * 64 + lane] = pj; }
                if (mode == 2) psum[c * 64 + lane] = ps;
                if (mode != 1) {
                    asm volatile("s_waitcnt lgkmcnt(0)" ::: "memory");
#pragma unroll 1
                    for (int k0 = 0; k0 < 64; k0 += 8) { unsigned vv[8];
#pragma unroll
                        for (int kk = 0; kk < 8; ++kk) { const int kx = base + k0 + kk; vv[kk] = *(const unsigned*)(vbase + (size_t)(kx < 0 ? 0 : kx) * 128 + lane * 2); }
#pragma unroll
                        for (int kk = 0; kk < 8; ++kk) { const float v0 = bflo(vv[kk]), v1 = bfhi(vv[kk]);
#pragma unroll
                            for (int j = 0; j < 4; ++j) { const float ph = pb[j * 64 + k0 + kk]; o[j][0] += ph * v0; o[j][1] += ph * v1; } } } }
                asm volatile("s_waitcnt lgkmcnt(0)" ::: "memory");
            }
            if (step == 0) {
#pragma unroll
                for (int j = 0; j < 4; ++j) { if (m[j] == -INFINITY) m[j] = 0.f; l[j] = 1.f / fmaxf(l[j], 1e-30f); }
                continue; }
#pragma unroll
            for (int j = 0; j < 4; ++j) { const float gt = gates[(size_t)tok * 24 + (g * 4 + j) * 3 + kind]; const float il = (mode == 2) ? gt : gt / fmaxf(l[j], 1e-30f);
                res[j][0] += il * o[j][0]; res[j][1] += il * o[j][1]; }
            if (step == 1) {
                asm volatile("s_waitcnt lgkmcnt(0)" ::: "memory");
                const int cur = tq >> 6; unsigned key[2];
#pragma unroll
                for (int hh = 0; hh < 2; ++hh) { const int mb = lane + 64 * hh; float imp = 0.f;
#pragma unroll
                    for (int d = -1; d < 4; ++d) { const int n = 4 * mb + d; if (n >= 0 && n < 512) imp += psum[n]; }
                    const bool adm = mb <= cur, forced = mb == 0 || mb == cur || mb == cur - 1;
                    key[hh] = !adm ? 0u : (forced ? (0xFF000000u | (unsigned)(127 - mb)) : ((((__float_as_uint(imp) >> 7) + 1u) << 7) | (unsigned)(127 - mb))); }
                unsigned Tv = 0u;
                for (int bit = 31; bit >= 0; --bit) { const unsigned cand = Tv | (1u << bit);
                    const int cnt = __popcll(__ballot(key[0] >= cand)) + __popcll(__ballot(key[1] >= cand)); if (cnt >= 16) Tv = cand; }
                if (Tv == 0u) Tv = 1u;
                const unsigned long long m0 = __ballot(key[0] >= Tv), m1 = __ballot(key[1] >= Tv);
                const unsigned long long ltm = (1ull << lane) - 1ull;
                if (key[0] >= Tv) blk[__popcll(m0 & ltm)] = lane;
                if (key[1] >= Tv) blk[__popcll(m0) + __popcll(m1 & ltm)] = lane + 64;
                ns = __popcll(m0) + __popcll(m1);
                asm volatile("s_waitcnt lgkmcnt(0)" ::: "memory"); }
        }
#pragma unroll
        for (int j = 0; j < 4; ++j) *(unsigned*)(OB + (size_t)tok * 1024 + (g * 4 + j) * 128 + lane * 2) = pk2(res[j][0], res[j][1]);
        asm volatile("s_waitcnt lgkmcnt(0)" ::: "memory");
    }
}

typedef float f32x16 __attribute__((ext_vector_type(16)));
typedef short s16x4 __attribute__((ext_vector_type(4)));
#define MFMA32(a, b, c) __builtin_amdgcn_mfma_f32_32x32x16_bf16((a), (b), (c), 0, 0, 0)
DI unsigned offb(unsigned row, unsigned ch) { return 256u * row + 16u * (ch ^ (((row & 3u) << 2) | ((row >> 2) & 3u))); }
DI unsigned cvt2(float a, float b) { typedef __bf16 b2 __attribute__((ext_vector_type(2))); typedef float f2 __attribute__((ext_vector_type(2))); const b2 r = __builtin_convertvector((f2){a, b}, b2); return __builtin_bit_cast(unsigned, r); }
DI bf16x8 pack_p(const f32x16& x, int s) {
    const u32x4 w = {cvt2(x[8 * s], x[8 * s + 1]), cvt2(x[8 * s + 2], x[8 * s + 3]), cvt2(x[8 * s + 4], x[8 * s + 5]), cvt2(x[8 * s + 6], x[8 * s + 7])};
    return __builtin_bit_cast(bf16x8, w);
}
DI void nsa_tile_dma(LAS char* kb, LAS char* vb, const bf16_t* kt, const bf16_t* vt, int tid, int w) {
#pragma unroll
    for (int i = 0; i < 2; ++i) { const int id = tid + 512 * i; const unsigned row = id >> 4, pos = id & 15; const unsigned ch = pos ^ (((row & 3u) << 2) | ((row >> 2) & 3u));
        const size_t so = (size_t)row * 128 + ch * 8; const unsigned lo = (unsigned)(i * 512 + w * 64) * 16u;
        __builtin_amdgcn_global_load_lds((const unsigned*)(kt + so), (LAS unsigned*)(kb + lo), 16, 0, 0);
        __builtin_amdgcn_global_load_lds((const unsigned*)(vt + so), (LAS unsigned*)(vb + lo), 16, 0, 0); }
}
#define NSA_TR8(R, A, OFF) asm volatile( \
    "ds_read_b64_tr_b16 %0, %8 offset:%16\n\tds_read_b64_tr_b16 %1, %9 offset:%16\n\tds_read_b64_tr_b16 %2, %10 offset:%16\n\tds_read_b64_tr_b16 %3, %11 offset:%16\n\t" \
    "ds_read_b64_tr_b16 %4, %12 offset:%16\n\tds_read_b64_tr_b16 %5, %13 offset:%16\n\tds_read_b64_tr_b16 %6, %14 offset:%16\n\tds_read_b64_tr_b16 %7, %15 offset:%16\n\ts_waitcnt lgkmcnt(0)" \
    : "=&v"(R[0]), "=&v"(R[1]), "=&v"(R[2]), "=&v"(R[3]), "=&v"(R[4]), "=&v"(R[5]), "=&v"(R[6]), "=&v"(R[7]) \
    : "v"(A[0]), "v"(A[1]), "v"(A[2]), "v"(A[3]), "v"(A[4]), "v"(A[5]), "v"(A[6]), "v"(A[7]), "i"(OFF) : "memory")

#define NSA_TR4(R, A0, A1, A2, A3, OFF) asm volatile( \
    "ds_read_b64_tr_b16 %0, %4 offset:%8\n\tds_read_b64_tr_b16 %1, %5 offset:%8\n\tds_read_b64_tr_b16 %2, %6 offset:%8\n\tds_read_b64_tr_b16 %3, %7 offset:%8" \
    : "=&v"(R[0]), "=&v"(R[1]), "=&v"(R[2]), "=&v"(R[3]) : "v"(A0), "v"(A1), "v"(A2), "v"(A3), "i"(OFF) : "memory")
#define NSA_LWAIT(N, R) asm volatile("s_waitcnt lgkmcnt(" #N ")" : "+v"(R[0]), "+v"(R[1]), "+v"(R[2]), "+v"(R[3]) :: "memory")
struct NsaWave {
    float m, l;
    f32x16 O[4];
    bf16x8 q[8];
};
template <int MODE>
DI void nsa_tile_compute(NsaWave& W, unsigned kbuf, unsigned vbuf, const unsigned (&vaddr0)[8], int tq0, int kind, int kbeg, bool needmask, bool rowneed, int lane, LAS float* impA, LAS float* impL, int mblk0) {
    const int c = lane & 31, h = lane >> 5;
    constexpr float C2 = ATT_SCALE * 1.4426950408889634f;
    f32x16 s0, s1;
    const f32x16 zero16 = {0.f, 0.f, 0.f, 0.f, 0.f, 0.f, 0.f, 0.f, 0.f, 0.f, 0.f, 0.f, 0.f, 0.f, 0.f, 0.f};
    const unsigned f = ((c & 3u) << 2) | ((c >> 2) & 3u);
#ifndef NSA_REP_QK
#define NSA_REP_QK 1
#endif
    __builtin_amdgcn_s_setprio(1);
#pragma unroll 1
    for (int rq_ = 0; rq_ < NSA_REP_QK; ++rq_) {
        if (NSA_REP_QK > 1) asm volatile("" ::: "memory");
#pragma unroll
    for (int s = 0; s < 8; ++s) { const unsigned ch = (unsigned)(2 * s + h) ^ f;
        const bf16x8 a0 = *(const LAS bf16x8*)(size_t)(kbuf + 256u * c + 16u * ch), a1 = *(const LAS bf16x8*)(size_t)(kbuf + 8192u + 256u * c + 16u * ch);
        s0 = MFMA32(a0, W.q[s], s == 0 ? zero16 : s0); s1 = MFMA32(a1, W.q[s], s == 0 ? zero16 : s1); } }
    __builtin_amdgcn_s_setprio(0);
    if (needmask) {
        const int tq = tq0 + (c >> 2);
        const int lo = kind == 2 ? tq - 511 : 0, hi = kind == 0 ? (tq >= 31 ? (tq - 31) >> 4 : -1) : tq;
#pragma unroll
        for (int r = 0; r < 16; ++r) { const int k0 = kbeg + (r & 3) + 8 * (r >> 2) + 4 * h, k1 = k0 + 32;
            if (!(k0 >= lo && k0 <= hi)) s0[r] = -INFINITY;
            if (!(k1 >= lo && k1 <= hi)) s1[r] = -INFINITY; }
    }
    if (MODE != 2) {
        float mx = fmaxf(fmaxf(s0[0], s0[1]), s1[0]);
#pragma unroll
        for (int r = 2; r < 16; r += 2) mx = fmaxf(fmaxf(mx, s0[r]), s0[r + 1]);
#pragma unroll
        for (int r = 1; r < 15; r += 2) mx = fmaxf(fmaxf(mx, s1[r]), s1[r + 1]);
        mx = fmaxf(mx, s1[15]);
        mx = fmaxf(mx, __shfl_xor(mx, 32));
        if (!rowneed) mx = -INFINITY;
        const float mn = (W.m == -INFINITY || (mx - W.m) * C2 > 8.f) ? fmaxf(W.m, mx) : W.m;
        const float mu = (mn == -INFINITY) ? 0.f : mn;
        const float alpha = __builtin_amdgcn_exp2f((W.m - mu) * C2);
        const float nb = rowneed ? -mu * C2 : -INFINITY;
        float rs = 0.f;
#pragma unroll
        for (int r = 0; r < 16; ++r) { s0[r] = __builtin_amdgcn_exp2f(__builtin_fmaf(s0[r], C2, nb)); s1[r] = __builtin_amdgcn_exp2f(__builtin_fmaf(s1[r], C2, nb)); rs += s0[r] + s1[r]; }
        rs += __shfl_xor(rs, 32);
        W.l = W.l * alpha + rs; W.m = mn;
        if (MODE == 0 && !__all(alpha == 1.f)) {
#pragma unroll
            for (int d = 0; d < 4; ++d)
#pragma unroll
                for (int r = 0; r < 16; ++r) W.O[d][r] *= alpha; }
    } else {
#pragma unroll
        for (int r = 0; r < 16; ++r) { s0[r] = __builtin_amdgcn_exp2f((s0[r] - W.m) * C2) * W.l; s1[r] = __builtin_amdgcn_exp2f((s1[r] - W.m) * C2) * W.l; }
#pragma unroll
        for (int kb = 0; kb < 2; ++kb)
#pragma unroll
            for (int i = 0; i < 4; ++i) { const f32x16& sv = kb ? s1 : s0;
                float a = sv[4 * i] + sv[4 * i + 1] + sv[4 * i + 2] + sv[4 * i + 3], lv = sv[4 * i + 3];
                a += __shfl_xor(a, 1); a += __shfl_xor(a, 2); lv += __shfl_xor(lv, 1); lv += __shfl_xor(lv, 2);
                if ((c & 3) == 0) { const int mb = mblk0 + 8 * kb + 2 * i + h; impA[(c >> 2) * 128 + mb] = a; impL[(c >> 2) * 128 + mb] = lv; } }
    }
    if (MODE != 1) {
        unsigned vaddrl[8];
        { const unsigned q = (lane & 15) >> 2, pp = lane & 3, blk = (lane >> 4) & 1;
#pragma unroll
          for (int d = 0; d < 4; ++d)
#pragma unroll
              for (int t = 0; t < 2; ++t) vaddrl[2 * d + t] = vbuf + offb(8u * t + 4u * h + q, 4u * d + 2u * blk + (pp >> 1)) + 8u * (pp & 1u); }
        bf16x8 pf[4] = {pack_p(s0, 0), pack_p(s0, 1), pack_p(s1, 0), pack_p(s1, 1)};
        s16x4 RA[4], RB[4];
        asm volatile("s_waitcnt lgkmcnt(0)" ::: "memory");
        NSA_TR4(RA, vaddrl[0], vaddrl[1], vaddrl[2], vaddrl[3], 0);
        NSA_TR4(RB, vaddrl[4], vaddrl[5], vaddrl[6], vaddrl[7], 0);
#define NSA_PVSTEP(KS, NEXTOFF, HASNEXT) \
        NSA_LWAIT(4, RA); __builtin_amdgcn_sched_barrier(0); \
        { const bf16x8 v0_ = __builtin_shufflevector(RA[0], RA[1], 0, 1, 2, 3, 4, 5, 6, 7), v1_ = __builtin_shufflevector(RA[2], RA[3], 0, 1, 2, 3, 4, 5, 6, 7); \
          W.O[0] = MFMA32(v0_, pf[KS], W.O[0]); W.O[1] = MFMA32(v1_, pf[KS], W.O[1]); } \
        __builtin_amdgcn_sched_barrier(0); \
        if (HASNEXT) NSA_TR4(RA, vaddrl[0], vaddrl[1], vaddrl[2], vaddrl[3], NEXTOFF); \
        if (HASNEXT) NSA_LWAIT(4, RB); else NSA_LWAIT(0, RB); \
        __builtin_amdgcn_sched_barrier(0); \
        { const bf16x8 v2_ = __builtin_shufflevector(RB[0], RB[1], 0, 1, 2, 3, 4, 5, 6, 7), v3_ = __builtin_shufflevector(RB[2], RB[3], 0, 1, 2, 3, 4, 5, 6, 7); \
          W.O[2] = MFMA32(v2_, pf[KS], W.O[2]); W.O[3] = MFMA32(v3_, pf[KS], W.O[3]); } \
        __builtin_amdgcn_sched_barrier(0); \
        if (HASNEXT) NSA_TR4(RB, vaddrl[4], vaddrl[5], vaddrl[6], vaddrl[7], NEXTOFF);
        __builtin_amdgcn_s_setprio(1);
        NSA_PVSTEP(0, 4096, true) NSA_PVSTEP(1, 8192, true) NSA_PVSTEP(2, 12288, true) NSA_PVSTEP(3, 0, false)
        __builtin_amdgcn_s_setprio(0);
#undef NSA_PVSTEP
    }
}
DI void nsa_fold(const NsaWave& W, bf16_t* obrow, unsigned char* ob8row, float sc, bool first, bool last, int h) {
#pragma unroll
    for (int d = 0; d < 4; ++d)
#pragma unroll
        for (int i = 0; i < 4; ++i) { bf16_t* pp = obrow + 32 * d + 8 * i + 4 * h; float o0 = 0.f, o1 = 0.f, o2 = 0.f, o3 = 0.f;
            if (!first) { const u32x2 w = *(const u32x2*)pp; o0 = bflo(w[0]); o1 = bfhi(w[0]); o2 = bflo(w[1]); o3 = bfhi(w[1]); }
            o0 += sc * W.O[d][4 * i]; o1 += sc * W.O[d][4 * i + 1]; o2 += sc * W.O[d][4 * i + 2]; o3 += sc * W.O[d][4 * i + 3];
            if (last) *(unsigned*)(ob8row + 32 * d + 8 * i + 4 * h) = pg8::fp8x4(o0 * pg8::A8_SCALE, o1 * pg8::A8_SCALE, o2 * pg8::A8_SCALE, o3 * pg8::A8_SCALE);
            else *(u32x2*)pp = (u32x2){cvt2(o0, o1), cvt2(o2, o3)}; }
}
struct NsaRun { LAS char* L; unsigned lds0; const bf16_t* kbase; const bf16_t* vbase; int t0, nt, kind, tqmin, lo_min, lo_max, hi_min, hi_max, tid, w; LAS unsigned* selm; LAS float* impA; LAS float* impL; };
template <int MODE>
DI void nsa_tiles(NsaWave& W, const NsaRun& R, const unsigned (&vaddr)[8]) {
    if (R.nt <= 0) return;
    const int lane = R.tid & 63, c = lane & 31;
    __syncthreads();
    nsa_tile_dma(R.L, R.L + 16384, R.kbase + (size_t)R.t0 * 8192, R.vbase + (size_t)R.t0 * 8192, R.tid, R.w);
    asm volatile("s_waitcnt vmcnt(0)" ::: "memory");
    __syncthreads();
#pragma unroll 1
    for (int i = 0; i < R.nt; ++i) {
        const int cur = i & 1, tt = R.t0 + i, kbeg = tt * 64;
        if (i + 1 < R.nt) nsa_tile_dma(R.L + (cur ^ 1) * 32768, R.L + (cur ^ 1) * 32768 + 16384, R.kbase + (size_t)(tt + 1) * 8192, R.vbase + (size_t)(tt + 1) * 8192, R.tid, R.w);
        bool rowneed = true;
        if (R.kind == 1) { const unsigned wsel = R.selm[(c >> 2) * 4 + (tt >> 5)]; rowneed = (wsel >> (tt & 31)) & 1u; }
        const bool skip = kbeg > R.hi_max || kbeg + 63 < R.lo_min || (R.kind == 1 && __ballot(rowneed) == 0ull);
        if (!skip) {
            const bool needmask = !(kbeg >= R.lo_max && kbeg + 63 <= R.hi_min);
            const unsigned kb_ = R.lds0 + cur * 32768u, vb_ = kb_ + 16384u;
            nsa_tile_compute<MODE>(W, kb_, vb_, vaddr, R.tqmin, R.kind, kbeg, needmask, rowneed, lane, R.impA, R.impL, MODE == 2 ? tt * 16 : 0);
        }
        asm volatile("s_waitcnt vmcnt(0)" ::: "memory");
        __syncthreads();
    }
}
DI void phase_nsa_mfma(const Params& p, char* smem) {
    const int tid = tid_fresh(), lane = tid & 63, w = __builtin_amdgcn_readfirstlane(tid >> 6), c = lane & 31, h = lane >> 5;
    LAS char* L = (LAS char*)smem;
    const unsigned lds0 = (unsigned)(size_t)L;
    LAS float* impA = (LAS float*)(L + 65536) + w * 1024; LAS float* impL = (LAS float*)(L + 65536 + 32768) + w * 1024;
    LAS unsigned* selm = (LAS unsigned*)(L + 131072) + w * 32;
    const bf16_t* BQ = (const bf16_t*)(p.ws + O_BQ); const bf16_t* kvs = (const bf16_t*)(p.ws + O_KVS); const bf16_t* kcvc = (const bf16_t*)(p.ws + O_KCVC);
    const float* gates = (const float*)(p.ws + O_GATES); bf16_t* OB = (bf16_t*)(p.ws + O_OB);
    unsigned vaddr[8];
    { const unsigned q = (lane & 15) >> 2, pp = lane & 3, blk = (lane >> 4) & 1;
#pragma unroll
      for (int d = 0; d < 4; ++d)
#pragma unroll
          for (int t = 0; t < 2; ++t) vaddr[2 * d + t] = offb(8u * t + 4u * h + q, 4u * d + 2u * blk + (pp >> 1)) + 8u * (pp & 1u); }
#pragma unroll 1
    for (int P = blockIdx.x; P < 256; P += gridDim.x) {
#pragma unroll 1
        for (int half = 0; half < 2; ++half) {
            const int bg = P >> 6, x = P & 63, qb = half == 0 ? 127 - x : x, b = bg >> 1, g = bg & 1, q0 = qb * 64;
            NsaWave W;
            const int tqmin = q0 + 8 * w, tqmax = tqmin + 7; const int tok = b * T + tqmin + (c >> 2);
            { const bf16_t* qr = BQ + (size_t)tok * 1024 + (g * 4 + (c & 3)) * 128 + 8 * h;
#pragma unroll
              for (int s = 0; s < 8; ++s) W.q[s] = *(const bf16x8*)(qr + 16 * s); }
#pragma unroll
            for (int i = 0; i < 16; ++i) { impA[lane + 64 * i] = 0.f; impL[lane + 64 * i] = 0.f; }
            for (int step = 0; step < 4; ++step) {
                const int kind = step < 2 ? 0 : step - 1;
                const bf16_t* kbase; const bf16_t* vbase; int t0, nt;
                int lo_min, lo_max, hi_min, hi_max;
                if (kind == 0) { kbase = kcvc + (size_t)bg * 512 * 128; vbase = kcvc + (size_t)2048 * 128 + (size_t)bg * 512 * 128;
                    t0 = 0; const int nlast = (q0 + 63 - 31) >> 4; nt = q0 + 63 >= 31 ? (nlast >> 6) + 1 : 0;
                    lo_min = 0; lo_max = 0; hi_min = tqmin >= 31 ? (tqmin - 31) >> 4 : -1; hi_max = tqmax >= 31 ? (tqmax - 31) >> 4 : -1; }
                else if (kind == 1) { kbase = kvs + (2 * (size_t)NB * 2 + bg) * T * 128; vbase = kvs + (3 * (size_t)NB * 2 + bg) * T * 128;
                    t0 = 0; nt = qb + 1; lo_min = 0; lo_max = 0; hi_min = tqmin; hi_max = tqmax; }
                else { kbase = kvs + (4 * (size_t)NB * 2 + bg) * T * 128; vbase = kvs + (5 * (size_t)NB * 2 + bg) * T * 128;
                    t0 = qb >= 8 ? qb - 8 : 0; nt = qb - t0 + 1; lo_min = tqmin - 511; lo_max = tqmax - 511; hi_min = tqmin; hi_max = tqmax; }
                if (step != 1) { W.m = -INFINITY; W.l = 0.f; }
#pragma unroll
                for (int d = 0; d < 4; ++d)
#pragma unroll
                    for (int r = 0; r < 16; ++r) W.O[d][r] = 0.f;
                {   NsaRun R; R.L = L; R.lds0 = lds0; R.kbase = kbase; R.vbase = vbase; R.t0 = t0; R.nt = nt; R.kind = kind; R.tqmin = tqmin; R.lo_min = lo_min; R.lo_max = lo_max; R.hi_min = hi_min; R.hi_max = hi_max;
                    R.tid = tid; R.w = w; R.selm = selm; R.impA = impA; R.impL = impL;
                    if (step == 0) nsa_tiles<1>(W, R, vaddr); else if (step == 1) nsa_tiles<2>(W, R, vaddr); else nsa_tiles<0>(W, R, vaddr); }
                if (step == 0) { if (W.m == -INFINITY) W.m = 0.f; W.l = 1.f / fmaxf(W.l, 1e-30f); continue; }
                { int lz = lane; asm volatile("" : "+v"(lz)); const int cz = lz & 31; const int tokz = b * T + tqmin + (cz >> 2);
                  const float gv = gates[(size_t)tokz * 24 + (g * 4 + (cz & 3)) * 3 + kind];
                  nsa_fold(W, OB + (size_t)tokz * 1024 + (g * 4 + (cz & 3)) * 128, (unsigned char*)(p.ws + O_OB8) + (size_t)tokz * 1024 + (g * 4 + (cz & 3)) * 128, step == 1 ? gv : gv / fmaxf(W.l, 1e-30f), step == 1, step == 3, lz >> 5); }
                if (step == 1) {
                    asm volatile("s_waitcnt lgkmcnt(0)" ::: "memory");
#pragma unroll 1
                    for (int qi = 0; qi < 8; ++qi) { const int tqq = tqmin + qi, curb = tqq >> 6; unsigned key[2];
#pragma unroll
                        for (int hh = 0; hh < 2; ++hh) { const int mb = lane + 64 * hh; const float imp = impA[qi * 128 + mb] + (mb > 0 ? impL[qi * 128 + mb - 1] : 0.f);
                            const bool adm = mb <= curb, forced = mb == 0 || mb == curb || mb == curb - 1;
                            key[hh] = !adm ? 0u : (forced ? (0xFF000000u | (unsigned)(127 - mb)) : ((((__float_as_uint(imp) >> 7) + 1u) << 7) | (unsigned)(127 - mb))); }
                        unsigned Tv = 0u;
                        for (int bit = 31; bit >= 0; --bit) { const unsigned cand = Tv | (1u << bit);
                            const int cnt = __popcll(__ballot(key[0] >= cand)) + __popcll(__ballot(key[1] >= cand)); if (cnt >= 16) Tv = cand; }
                        if (Tv == 0u) Tv = 1u;
                        const unsigned long long m0 = __ballot(key[0] >= Tv), m1 = __ballot(key[1] >= Tv);
                        if (lane == 0) { selm[qi * 4] = (unsigned)m0; selm[qi * 4 + 1] = (unsigned)(m0 >> 32); selm[qi * 4 + 2] = (unsigned)m1; selm[qi * 4 + 3] = (unsigned)(m1 >> 32); } }
                    asm volatile("s_waitcnt lgkmcnt(0)" ::: "memory");
                }
            }
        }
    }
}

DI void topk256_hist(LAS unsigned short* sck, int nk, LAS unsigned* hist, unsigned short* out, int lane) {
    const int nit = (nk + 511) >> 9;
    const unsigned long long ltm = (1ull << lane) - 1ull;
    for (int k = nk + lane; k < 512 * nit; k += 64) sck[k] = 0;
    unsigned bsel = 0, cnt_above = 0;
#pragma unroll 1
    for (int pass = 0; pass < 2; ++pass) {
        *(LAS u32x4*)(hist + 4 * lane) = (u32x4){0u, 0u, 0u, 0u};
        asm volatile("s_waitcnt lgkmcnt(0)" ::: "memory");
#pragma unroll 1
        for (int i = 0; i < nit; ++i) { const int k0 = 8 * (i * 64 + lane); const u32x4 wv = *(const LAS u32x4*)(sck + k0);
#pragma unroll
            for (int j = 0; j < 8; ++j) { const unsigned key = (j & 1) ? (wv[j >> 1] >> 16) : (wv[j >> 1] & 0xffffu);
                if (pass == 0) __hip_atomic_fetch_add(hist + (key >> 8), 1u, __ATOMIC_RELAXED, __HIP_MEMORY_SCOPE_WORKGROUP);
                else if ((key >> 8) == bsel) __hip_atomic_fetch_add(hist + (key & 255u), 1u, __ATOMIC_RELAXED, __HIP_MEMORY_SCOPE_WORKGROUP); } }
        asm volatile("s_waitcnt lgkmcnt(0)" ::: "memory");
        const u32x4 c4 = *(const LAS u32x4*)(hist + 4 * lane);
        const unsigned tot = c4[0] + c4[1] + c4[2] + c4[3];
        unsigned inc = tot;
#pragma unroll
        for (int o = 1; o < 64; o <<= 1) { const unsigned v = __shfl_down(inc, o); if (lane + o < 64) inc += v; }
        unsigned above = cnt_above + inc - tot;
        int found = -1; unsigned fabove = 0;
#pragma unroll
        for (int bb = 3; bb >= 0; --bb) { if (found < 0 && above < 256u && above + c4[bb] >= 256u) { found = 4 * lane + bb; fabove = above; } above += c4[bb]; }
        const unsigned long long fm = __ballot(found >= 0); const int src = __builtin_ctzll(fm);
        const unsigned fb = (unsigned)__shfl(found, src); cnt_above = (unsigned)__shfl((int)fabove, src);
        bsel = pass == 0 ? fb : ((bsel << 8) | fb);
    }
    const unsigned Tv = bsel; const int need = 256 - (int)cnt_above; int pos = 0, eqc = 0;
#pragma unroll 1
    for (int i = 0; i < nit; ++i) { const int k0 = 8 * (i * 64 + lane); const u32x4 wv = *(const LAS u32x4*)(sck + k0);
        bool eq[8], sl[8]; bool anyeq = false;
#pragma unroll
        for (int j = 0; j < 8; ++j) { const unsigned key = (j & 1) ? (wv[j >> 1] >> 16) : (wv[j >> 1] & 0xffffu); eq[j] = key == Tv; sl[j] = key > Tv; anyeq |= eq[j]; }
        if (__ballot(anyeq) != 0ull) {
            int below = 0, own = 0, etot = 0;
#pragma unroll
            for (int j = 0; j < 8; ++j) { const unsigned long long em = __ballot(eq[j]); below += __popcll(em & ltm); etot += __popcll(em); }
#pragma unroll
            for (int j = 0; j < 8; ++j) if (eq[j]) { if (eqc + below + own < need) sl[j] = true; ++own; }
            eqc += etot; }
#pragma unroll
        for (int j = 0; j < 8; ++j) { const unsigned long long sm = __ballot(sl[j]); if (sl[j]) out[pos + __popcll(sm & ltm)] = (unsigned short)(k0 + j); pos += __popcll(sm); } }
}
DI void phase_indexer_mfma(const Params& p, char* smem) {
    const int tid = tid_fresh(), lane = tid & 63, w = __builtin_amdgcn_readfirstlane(tid >> 6), c = lane & 31, hh = lane >> 5;
    LAS unsigned short* sc = (LAS unsigned short*)(LAS char*)smem;
    LAS unsigned* hist = (LAS unsigned*)((LAS char*)smem + 131072) + w * 256;
    const bf16_t* Q = (const bf16_t*)(p.ws + O_QALL); const bf16_t* KI = (const bf16_t*)(p.ws + O_KIDX); const float* WI = (const float*)(p.ws + O_WIDX);
    unsigned short* SEL = (unsigned short*)(p.ws + O_SEL); int* NSEL = (int*)(p.ws + O_NSEL);
    const float* rope = (const float*)(p.ws + O_ROPE);
    c2_rows(p, smem);
    __syncthreads();
#pragma unroll 1
    for (int rnd = 0; rnd * (int)gridDim.x < NT / 8; ++rnd) {
        const int slot = (rnd & 1) ? (int)gridDim.x - 1 - (int)blockIdx.x : (int)blockIdx.x;
        const int u = NT / 8 - 1 - (rnd * (int)gridDim.x + slot);
        if (u < 0) continue;
        const int tok0 = u * 8, b = tok0 >> 13, q0 = tok0 & (T - 1), nkmax = q0 + 8;
        const int tok = tok0 + w, nk = q0 + w + 1;
        unsigned short* out = SEL + (size_t)tok * 256;
#ifndef IDX_REP_SCORE
#define IDX_REP_SCORE 1
#endif
#ifndef IDX_REP_SEL
#define IDX_REP_SEL 1
#endif
        for (int rs_ = 0; rs_ < IDX_REP_SCORE; ++rs_)
        if (nkmax > 256) {
            bf16x8 qa[2][4], Wf[2][2];
#pragma unroll
            for (int rb = 0; rb < 2; ++rb) { const bf16_t* qr = Q + (size_t)(tok0 + 4 * rb + (c >> 3)) * QC + 2304 + (c & 7) * 64 + 8 * hh;
#pragma unroll
                for (int s = 0; s < 4; ++s) qa[rb][s] = *(const bf16x8*)(qr + 16 * s);
                {
                    const float* rt = rope + (size_t)(tok0 + 4 * rb + (c >> 3)) * 48 + 32;
                    const u32x4 own = __builtin_bit_cast(u32x4, qa[rb][0]); u32x4 oth;
#pragma unroll
                    for (int k = 0; k < 4; ++k) oth[k] = (unsigned)__shfl_xor((int)own[k], 32);
                    float xa[8], xb[8], xr[8]; unpack8(own, xa); unpack8(oth, xb);
#pragma unroll
                    for (int j = 0; j < 8; ++j) { const float cs = rt[2 * j], sn = rt[2 * j + 1]; xr[j] = hh == 0 ? xa[j] * cs - xb[j] * sn : xa[j] * cs + xb[j] * sn; }
                    const u32x4 pk = {pk2(xr[0], xr[1]), pk2(xr[2], xr[3]), pk2(xr[4], xr[5]), pk2(xr[6], xr[7])};
                    qa[rb][0] = __builtin_bit_cast(bf16x8, pk); }
                { f32x4 wv = {0.f, 0.f, 0.f, 0.f}; if (c < 8) wv = *(const f32x4*)(WI + (size_t)(tok0 + c) * 8 + 4 * hh);
#pragma unroll
                  for (int sp = 0; sp < 2; ++sp) { const bool m0 = c == 4 * rb + 2 * sp, m1 = c == 4 * rb + 2 * sp + 1;
                      const u32x4 pkw = {m0 ? pk2(wv[0], wv[1]) : 0u, m0 ? pk2(wv[2], wv[3]) : 0u, m1 ? pk2(wv[0], wv[1]) : 0u, m1 ? pk2(wv[2], wv[3]) : 0u};
                      Wf[rb][sp] = __builtin_bit_cast(bf16x8, pkw); } } }
            const int npair = (nkmax + 63) >> 6;
            const bf16_t* kbase = KI + ((size_t)b * T + c) * 64 + 8 * hh;
            bf16x8 kb[2][4], kn[2][4];
            auto ldk = [&](bf16x8 (&dst)[2][4], int pr) {
#pragma unroll
                for (int tt = 0; tt < 2; ++tt) { int key0 = 64 * pr + 32 * tt; if (key0 + 31 >= T) key0 = T - 32;
#pragma unroll
                    for (int s = 0; s < 4; ++s) dst[tt][s] = *(const bf16x8*)(kbase + (size_t)key0 * 64 + 16 * s); } };
            if (w < npair) ldk(kb, w);
#pragma unroll 1
            for (int pr = w; pr < npair; pr += 8) {
                if (pr + 8 < npair) ldk(kn, pr + 8);
#pragma unroll
                for (int tt = 0; tt < 2; ++tt) {
                    const int key = 64 * pr + 32 * tt + c;
                    f32x16 a0, a1; const f32x16 z16 = {0.f, 0.f, 0.f, 0.f, 0.f, 0.f, 0.f, 0.f, 0.f, 0.f, 0.f, 0.f, 0.f, 0.f, 0.f, 0.f};
#pragma unroll
                    for (int s = 0; s < 4; ++s) { a0 = MFMA32(qa[0][s], kb[tt][s], s == 0 ? z16 : a0); a1 = MFMA32(qa[1][s], kb[tt][s], s == 0 ? z16 : a1); }
#pragma unroll
                    for (int i = 0; i < 16; ++i) { a0[i] = fmaxf(a0[i], 0.f); a1[i] = fmaxf(a1[i], 0.f); }
                    f32x16 d2 = MFMA32(Wf[0][0], pack_p(a0, 0), z16);
                    d2 = MFMA32(Wf[0][1], pack_p(a0, 1), d2); d2 = MFMA32(Wf[1][0], pack_p(a1, 0), d2); d2 = MFMA32(Wf[1][1], pack_p(a1, 1), d2);
                    if (key < 8192) {
#pragma unroll
                        for (int qq = 0; qq < 4; ++qq) sc[(4 * hh + qq) * 8192 + key] = f16key(d2[qq]); }
                }
#pragma unroll
                for (int tt = 0; tt < 2; ++tt)
#pragma unroll
                    for (int s = 0; s < 4; ++s) kb[tt][s] = kn[tt][s];
            }
        }
        __syncthreads();
        if (nk <= 256) { for (int i = lane; i < 256; i += 64) out[i] = (unsigned short)(i < nk ? i : 0); if (lane == 0) NSEL[tok] = nk; }
        else { for (int rs_ = 0; rs_ < IDX_REP_SEL; ++rs_) topk256_hist(sc + w * 8192, nk, hist, out, lane); if (lane == 0) NSEL[tok] = 256; }
        __syncthreads();
    }
}

#define MFMA16(a, b, c) __builtin_amdgcn_mfma_f32_16x16x32_bf16((a), (b), (c), 0, 0, 0)
#define MLA_ROW 592
#define MLA_TR8(R, BASE, OFF) asm volatile( \
    "ds_read_b64_tr_b16 %0, %8 offset:%9\n\tds_read_b64_tr_b16 %1, %8 offset:%10\n\tds_read_b64_tr_b16 %2, %8 offset:%11\n\tds_read_b64_tr_b16 %3, %8 offset:%12\n\t" \
    "ds_read_b64_tr_b16 %4, %8 offset:%13\n\tds_read_b64_tr_b16 %5, %8 offset:%14\n\tds_read_b64_tr_b16 %6, %8 offset:%15\n\tds_read_b64_tr_b16 %7, %8 offset:%16\n\ts_waitcnt lgkmcnt(0)" \
    : "=&v"(R[0]), "=&v"(R[1]), "=&v"(R[2]), "=&v"(R[3]), "=&v"(R[4]), "=&v"(R[5]), "=&v"(R[6]), "=&v"(R[7]) \
    : "v"(BASE), "i"(OFF), "i"((OFF) + 16 * MLA_ROW), "i"((OFF) + 32), "i"((OFF) + 32 + 16 * MLA_ROW), "i"((OFF) + 64), "i"((OFF) + 64 + 16 * MLA_ROW), "i"((OFF) + 96), "i"((OFF) + 96 + 16 * MLA_ROW) : "memory")
DI void phase_mla_mfma(const Params& p, char* smem) {
    const int tid = tid_fresh(), lane = tid & 63, w = __builtin_amdgcn_readfirstlane(tid >> 6), fr = lane & 15, g = lane >> 4;
    LAS char* buf = (LAS char*)smem + w * (32 * MLA_ROW);
    const unsigned lbase = (unsigned)(size_t)buf;
    const bf16_t* Q = (const bf16_t*)(p.ws + O_QALL); const bf16_t* KV = (const bf16_t*)(p.ws + O_KVT);
    const unsigned short* SEL = (const unsigned short*)(p.ws + O_SEL); const int* NSEL = (const int*)(p.ws + O_NSEL); bf16_t* OL = (bf16_t*)(p.ws + O_OLAT);
    constexpr float C2 = ATT_SCALE * 1.4426950408889634f;
    int pf_cnt = 0, pf_s0 = 0, pf_s1 = 0;
    { const int tok = blockIdx.x * 8 + w; if (tok < NT) { pf_cnt = NSEL[tok]; if (lane < 32) { pf_s0 = SEL[(size_t)tok * 256 + lane]; pf_s1 = SEL[(size_t)tok * 256 + 32 + lane]; } } }
#pragma unroll 1
    for (int tok = blockIdx.x * 8 + w; tok < NT; tok += gridDim.x * 8) {
        const int b = tok >> 13; const int cnt = pf_cnt; const int cur_s0 = pf_s0, cur_s1 = pf_s1;
        { const int tn = tok + gridDim.x * 8; if (tn < NT) { pf_cnt = NSEL[tn]; if (lane < 32) { pf_s0 = SEL[(size_t)tn * 256 + lane]; pf_s1 = SEL[(size_t)tn * 256 + 32 + lane]; } } }
        bf16x8 qf[9];
        { const bf16_t* qr = Q + (size_t)tok * QC; const bf16x8 z8 = {0, 0, 0, 0, 0, 0, 0, 0};
#pragma unroll
          for (int s = 0; s < 8; ++s) qf[s] = fr < 8 ? *(const bf16x8*)(qr + fr * 256 + 32 * s + 8 * g) : z8;
          qf[8] = fr < 8 ? *(const bf16x8*)(qr + 2048 + fr * 32 + 8 * g) : z8;
          {
              const float* rt = (const float*)(p.ws + O_ROPE) + (size_t)tok * 48;
              const u32x4 own = __builtin_bit_cast(u32x4, qf[8]); u32x4 oth;
#pragma unroll
              for (int k = 0; k < 4; ++k) oth[k] = (unsigned)__shfl_xor((int)own[k], 32);
              float xa[8], xb[8], xr[8]; unpack8(own, xa); unpack8(oth, xb);
#pragma unroll
              for (int j = 0; j < 8; ++j) { const int fi = 8 * (g & 1) + j; const float cs = rt[2 * fi], sn = rt[2 * fi + 1]; xr[j] = g < 2 ? xa[j] * cs - xb[j] * sn : xa[j] * cs + xb[j] * sn; }
              const u32x4 pk = {pk2(xr[0], xr[1]), pk2(xr[2], xr[3]), pk2(xr[4], xr[5]), pk2(xr[6], xr[7])};
              qf[8] = __builtin_bit_cast(bf16x8, pk); } }
        f32x4 O[16];
#pragma unroll
        for (int d = 0; d < 16; ++d) O[d] = (f32x4){0.f, 0.f, 0.f, 0.f};
        float m = -INFINITY, l = 0.f;
        const int nchunk = (cnt + 31) >> 5;
        u32x4 st[18]; int selv_n = 0;
        const bf16_t* kvb = KV + (size_t)b * T * KVW;
        auto issue = [&](int selv, int lz) {
#pragma unroll
            for (int i = 0; i < 16; ++i) { const int r0 = __builtin_amdgcn_readlane(selv, 2 * i), r1 = __builtin_amdgcn_readlane(selv, 2 * i + 1); const int row = lz < 32 ? r0 : r1;
                st[i] = *(const u32x4*)(kvb + (size_t)row * KVW + (lz & 31) * 8); }
#pragma unroll
            for (int i = 0; i < 2; ++i) { const int row = __shfl(selv, 16 * i + (lz >> 2)); st[16 + i] = *(const u32x4*)(kvb + (size_t)row * KVW + 256 + (lz & 3) * 8); } };
        { int lz = lane; asm volatile("" : "+v"(lz));
          int selv = 0; if (lz < 32 && lz < cnt) selv = cur_s0;
          if (lz < 32 && 32 + lz < cnt) selv_n = cur_s1;
          issue(selv, lz); }
#pragma unroll 1
        for (int ch = 0; ch < nchunk; ++ch) {
            int lz = lane; asm volatile("" : "+v"(lz));
#pragma unroll
            for (int i = 0; i < 16; ++i) *(LAS u32x4*)(buf + (2 * i + (lz >> 5)) * MLA_ROW + (lz & 31) * 16) = st[i];
#pragma unroll
            for (int i = 0; i < 2; ++i) *(LAS u32x4*)(buf + (16 * i + (lz >> 2)) * MLA_ROW + 512 + (lz & 3) * 16) = st[16 + i];
            if (ch + 1 < nchunk) {
                const int selv = selv_n; selv_n = 0;
                { const int k = (ch + 2) * 32 + lz; if (lz < 32 && k < cnt) selv_n = SEL[(size_t)tok * 256 + k]; }
                issue(selv, lz); }
            asm volatile("s_waitcnt lgkmcnt(0)" ::: "memory");
            const int frz = lz & 15, gz = lz >> 4;
            f32x4 s0, s1; const f32x4 z4 = {0.f, 0.f, 0.f, 0.f};
#pragma unroll
            for (int s = 0; s < 9; ++s) { const bf16x8 a0 = *(const LAS bf16x8*)(buf + frz * MLA_ROW + (32 * s + 8 * gz) * 2), a1 = *(const LAS bf16x8*)(buf + (frz + 16) * MLA_ROW + (32 * s + 8 * gz) * 2);
                s0 = MFMA16(a0, qf[s], s == 0 ? z4 : s0); s1 = MFMA16(a1, qf[s], s == 0 ? z4 : s1); }
            float mx = -INFINITY;
#pragma unroll
            for (int j = 0; j < 4; ++j) { if (ch * 32 + 4 * gz + j >= cnt) s0[j] = -INFINITY; if (ch * 32 + 16 + 4 * gz + j >= cnt) s1[j] = -INFINITY; mx = fmaxf(mx, fmaxf(s0[j], s1[j])); }
            mx = fmaxf(mx, __shfl_xor(mx, 16)); mx = fmaxf(mx, __shfl_xor(mx, 32));
            const float mn = fmaxf(m, mx), mu = (mn == -INFINITY) ? 0.f : mn;
            const float alpha = __builtin_amdgcn_exp2f((m - mu) * C2);
            float rs = 0.f;
#pragma unroll
            for (int j = 0; j < 4; ++j) { s0[j] = __builtin_amdgcn_exp2f((s0[j] - mu) * C2); s1[j] = __builtin_amdgcn_exp2f((s1[j] - mu) * C2); rs += s0[j] + s1[j]; }
            rs += __shfl_xor(rs, 16); rs += __shfl_xor(rs, 32);
            l = l * alpha + rs; m = mn;
            if (!__all(alpha == 1.f)) {
#pragma unroll
                for (int d = 0; d < 16; ++d) O[d] *= alpha; }
            const u32x4 pw = {cvt2(s0[0], s0[1]), cvt2(s0[2], s0[3]), cvt2(s1[0], s1[1]), cvt2(s1[2], s1[3])};
            const bf16x8 pf = __builtin_bit_cast(bf16x8, pw);
            const unsigned tb = lbase + (unsigned)(4 * gz + (frz >> 2)) * MLA_ROW + 8u * (frz & 3);
#pragma unroll
            for (int dq = 0; dq < 4; ++dq) { s16x4 R[8];
                if (dq == 0) MLA_TR8(R, tb, 0); else if (dq == 1) MLA_TR8(R, tb, 128); else if (dq == 2) MLA_TR8(R, tb, 256); else MLA_TR8(R, tb, 384);
#pragma unroll
                for (int d = 0; d < 4; ++d) { const bf16x8 vf = __builtin_shufflevector(R[2 * d], R[2 * d + 1], 0, 1, 2, 3, 4, 5, 6, 7); O[4 * dq + d] = MFMA16(vf, pf, O[4 * dq + d]); } }
            asm volatile("s_waitcnt lgkmcnt(0)" ::: "memory");
        }
        const float il16 = pg8::A8_SCALE / fmaxf(l, 1e-30f);
        if (fr < 8) {
#pragma unroll
            for (int d = 0; d < 16; ++d) *(unsigned*)((unsigned char*)OL + (size_t)tok * D + fr * 256 + 16 * d + 4 * g) = pg8::fp8x4(O[d][0] * il16, O[d][1] * il16, O[d][2] * il16, O[d][3] * il16); }
    }
}

DI void phase_post_mix(const Params& p, char* smem, bool count) {
    const int tz_ = tid_fresh(); const int lane = tz_ & 63, wid = __builtin_amdgcn_readfirstlane(tz_ >> 6);
    float* part = (float*)smem;
    int* lcnt = (int*)(smem + 8 * 32 * 33 * 4);
    const bf16_t* MO = (const bf16_t*)(p.ws + O_MO); float* X1 = (float*)(p.ws + O_X1); bf16_t* H = (bf16_t*)(p.ws + O_H); const bf16_t* WR = (const bf16_t*)(p.ws + O_WRT);
    int* TOPI = (int*)(p.ws + O_TOPI); float* TOPW = (float*)(p.ws + O_TOPW); int* cnts = (int*)(p.ws + O_CNT);
#pragma unroll 1
    for (int ck = blockIdx.x; ck < NT / 64; ck += gridDim.x) {
#pragma unroll 1
        for (int j = 0; j < 8; ++j) {
            const int tok = ck * 64 + wid * 8 + j, b = tok >> 13;
            float v[32]; float ss = 0.f;
#pragma unroll
            for (int i = 0; i < 8; ++i) { const u32x2 w = *(const u32x2*)(MO + (size_t)tok * D + 4 * (lane + 64 * i));
                v[4 * i] = bflo(w[0]); v[4 * i + 1] = bfhi(w[0]); v[4 * i + 2] = bflo(w[1]); v[4 * i + 3] = bfhi(w[1]); }
#pragma unroll
            for (int i = 0; i < 32; ++i) ss += v[i] * v[i];
            const float rs = rsqrtf(wave_sum(ss) * (1.f / D) + NORM_EPS);
            float ss2 = 0.f;
#pragma unroll
            for (int i = 0; i < 8; ++i) { const int col = 4 * (lane + 64 * i); const f32x4 xv = *(const f32x4*)(p.x + (size_t)tok * D + col); f32x4 o;
#pragma unroll
                for (int q = 0; q < 4; ++q) { o[q] = xv[q] + mod_at(p, b, 4096 + col + q) * (v[4 * i + q] * rs * p.g_post_mix[col + q]); v[4 * i + q] = o[q]; ss2 += o[q] * o[q]; }
                *(f32x4*)(X1 + (size_t)tok * D + col) = o; }
            const float rs2 = rsqrtf(wave_sum(ss2) * (1.f / D) + NORM_EPS);
#pragma unroll
            for (int i = 0; i < 8; ++i) { const int col = 4 * (lane + 64 * i); f32x4 hv;
#pragma unroll
                for (int q = 0; q < 4; ++q) hv[q] = v[4 * i + q] * rs2 * p.g_pre_ffn[col + q] * (1.f + mod_at(p, b, 4 * 2048 + col + q)) + mod_at(p, b, 3 * 2048 + col + q);
                *(u32x2*)(H + (size_t)tok * D + col) = (u32x2){pk2(hv[0], hv[1]), pk2(hv[2], hv[3])}; }
        }
        asm volatile("s_waitcnt vmcnt(0)" ::: "memory");
        __syncthreads();
        if (tz_ < 32) lcnt[tz_] = 0;
        {
            const int c = lane & 31, hh = lane >> 5, rb = wid & 1, ks = wid >> 1;
            const bf16_t* ap = H + (size_t)(ck * 64 + 32 * rb + c) * D + 512 * ks + 8 * hh; const bf16_t* bp = WR + (size_t)c * D + 512 * ks + 8 * hh;
            f32x16 acc;
#pragma unroll
            for (int i = 0; i < 16; ++i) acc[i] = 0.f;
#pragma unroll 8
            for (int sx = 0; sx < 32; ++sx) { const bf16x8 a = *(const bf16x8*)(ap + 16 * sx), bb = *(const bf16x8*)(bp + 16 * sx); acc = MFMA32(a, bb, acc); }
#pragma unroll
            for (int r = 0; r < 16; ++r) part[(wid * 32 + (r & 3) + 8 * (r >> 2) + 4 * hh) * 33 + c] = acc[r];
        }
        __syncthreads();
        if (tz_ < 64) {
            const int rbt = tz_ >> 5, row = tz_ & 31, tok = ck * 64 + tz_;
            float lg[32];
#pragma unroll
            for (int e = 0; e < 32; ++e) lg[e] = p.b_router[e] + part[((0 * 2 + rbt) * 32 + row) * 33 + e] + part[((1 * 2 + rbt) * 32 + row) * 33 + e] + part[((2 * 2 + rbt) * 32 + row) * 33 + e] + part[((3 * 2 + rbt) * 32 + row) * 33 + e];
            int te[4]; float tv[4];
#pragma unroll
            for (int k = 0; k < 4; ++k) { float mx = lg[0]; int bi = 0;
#pragma unroll
                for (int e = 1; e < 32; ++e) if (lg[e] > mx) { mx = lg[e]; bi = e; }
                te[k] = bi; tv[k] = mx;
#pragma unroll
                for (int e = 0; e < 32; ++e) if (e == bi) lg[e] = -INFINITY; }
            const float e1 = __expf(tv[1] - tv[0]), e2 = __expf(tv[2] - tv[0]), e3 = __expf(tv[3] - tv[0]); const float inv = 1.f / (1.f + e1 + e2 + e3);
            *(int4*)(TOPI + tok * 4) = make_int4(te[0], te[1], te[2], te[3]);
            *(f32x4*)(TOPW + tok * 4) = (f32x4){inv, e1 * inv, e2 * inv, e3 * inv};
            atomicAdd(lcnt + te[0], 1); atomicAdd(lcnt + te[1], 1); atomicAdd(lcnt + te[2], 1); atomicAdd(lcnt + te[3], 1);
        }
        __syncthreads();
        if (count && tz_ < 32) atomicAdd(cnts + tz_, lcnt[tz_]);
    }
}

DI int moe_tables(const Params& p, LAS int* tile_e, LAS int* pstart) {
    int* cnts = (int*)(p.ws + O_CNT);
    if (threadIdx.x < 64) {
        const int e = threadIdx.x & 31;
        const int c = __hip_atomic_load(cnts + e, __ATOMIC_RELAXED, __HIP_MEMORY_SCOPE_AGENT);
        const int nt = (c + 255) >> 8; int inc = nt;
#pragma unroll
        for (int o = 1; o < 32; o <<= 1) { const int v = __shfl_up(inc, o, 32); if (e >= o) inc += v; }
        const int start = inc - nt;
        if (threadIdx.x < 32) { pstart[e] = start * 256; for (int i = 0; i < nt; ++i) tile_e[start + i] = e; if (e == 31) pstart[NEXP] = inc; } }
    __syncthreads();
    return pstart[NEXP];
}
DI void phase_moe_gather(const Params& p, char* smem) {
    const int tz_ = tid_fresh(); const int lane = tz_ & 63, wid = __builtin_amdgcn_readfirstlane(tz_ >> 6);
    LAS int* tile_e = (LAS int*)(LAS char*)smem; LAS int* pstart = tile_e + 320; LAS int* lcnt = pstart + 40; LAS int* lbase = lcnt + 32;
    (void)moe_tables(p, tile_e, pstart);
    const bf16_t* H = (const bf16_t*)(p.ws + O_H); unsigned char* HS = (unsigned char*)(p.ws + O_HS);
    const int* TOPI = (const int*)(p.ws + O_TOPI); const float* TOPW = (const float*)(p.ws + O_TOPW); int* TSLOT = (int*)(p.ws + O_TSLOT); float* SLOTW = (float*)(p.ws + O_SLOTW);
    int* fill = (int*)(p.ws + O_CNT) + 32;
#pragma unroll 1
    for (int ck = blockIdx.x; ck < NT / 64; ck += gridDim.x) {
        const int tok0 = ck * 64 + wid * 8;
        __syncthreads();
        if (tz_ < 32) lcnt[tz_] = 0;
        __syncthreads();
        int e = 0, rank = 0;
        if (lane < 32) { e = TOPI[tok0 * 4 + lane]; rank = atomicAdd((int*)(lcnt + e), 1); }
        __syncthreads();
        if (tz_ < 32) lbase[tz_] = atomicAdd(fill + tz_, lcnt[tz_]);
        __syncthreads();
        int slot = 0;
        if (lane < 32) { slot = pstart[e] + lbase[e] + rank; TSLOT[tok0 * 4 + lane] = slot; SLOTW[slot] = TOPW[tok0 * 4 + lane]; }
#pragma unroll 2
        for (int j = 0; j < 8; ++j) { u32x2 hv[4];
#pragma unroll
            for (int i = 0; i < 4; ++i) { float f[8]; unpack8(*(const u32x4*)(H + (size_t)(tok0 + j) * D + 8 * (lane + 64 * i)), f);
                hv[i] = (u32x2){pg8::fp8x4(f[0], f[1], f[2], f[3]), pg8::fp8x4(f[4], f[5], f[6], f[7])}; }
#pragma unroll
            for (int k = 0; k < 4; ++k) { const int sl = __shfl(slot, j * 4 + k);
#pragma unroll
                for (int i = 0; i < 4; ++i) *(u32x2*)(HS + (size_t)sl * D + 8 * (lane + 64 * i)) = hv[i]; } }
    }
}
DI void phase_final(const Params& p) {
    const int tz_ = tid_fresh(); const int lane = tz_ & 63, wid = __builtin_amdgcn_readfirstlane(tz_ >> 6);
    const unsigned char* YS = (const unsigned char*)(p.ws + O_YS); const float* X1 = (const float*)(p.ws + O_X1); const int* TSLOT = (const int*)(p.ws + O_TSLOT);
    for (int tok = blockIdx.x * 8 + wid; tok < NT; tok += gridDim.x * 8) {
        const int b = tok >> 13; float v[32];
#pragma unroll
        for (int i = 0; i < 32; ++i) v[i] = 0.f;
#pragma unroll
        for (int k = 0; k < 4; ++k) { const int slot = TSLOT[tok * 4 + k];
#pragma unroll
            for (int i = 0; i < 8; ++i) { const unsigned w = *(const unsigned*)(YS + (size_t)slot * D + 4 * (lane + 64 * i));
                const auto lo = __builtin_amdgcn_cvt_pk_f32_fp8((int)w, false), hi = __builtin_amdgcn_cvt_pk_f32_fp8((int)w, true);
                v[4 * i] += lo[0]; v[4 * i + 1] += lo[1]; v[4 * i + 2] += hi[0]; v[4 * i + 3] += hi[1]; } }
#pragma unroll
        for (int i = 0; i < 32; ++i) v[i] *= pg8::Y8_INV;
        float ss = 0.f;
#pragma unroll
        for (int i = 0; i < 32; ++i) ss += v[i] * v[i];
        const float rs = rsqrtf(wave_sum(ss) * (1.f / D) + NORM_EPS);
#pragma unroll
        for (int i = 0; i < 8; ++i) { const int col = 4 * (lane + 64 * i); const f32x4 xv = *(const f32x4*)(X1 + (size_t)tok * D + col); f32x4 o;
#pragma unroll
            for (int j = 0; j < 4; ++j) o[j] = xv[j] + mod_at(p, b, 5 * 2048 + col + j) * (v[4 * i + j] * rs * p.g_post_ffn[col + j]);
            *(f32x4*)(p.out + (size_t)tok * D + col) = o; }
    }
}

#ifndef PHMASK
#define PHMASK 0xFFFFFFFFu
#endif
#define PHON(ph) (((PHMASK) >> (ph)) & 1u)
#ifndef REPMASK
#define REPMASK 0u
#endif
#define REP(ph) _Pragma("unroll 1") for (int rep_ = 0; rep_ <= (int)(((REPMASK) >> (ph)) & 1u); ++rep_)
enum { PH_PREP = 0, PH_H1, PH_GIN, PH_ZPOST, PH_GQ, PH_QROPE, PH_IDX, PH_MLA, PH_NSA, PH_MERGE, PH_GOUT, PH_POSTMIX, PH_GATHER, PH_GU, PH_DN, PH_FINAL, PH_END };

__global__ void __launch_bounds__(512, 2) mega(Params p, int lo, int hi) {
    extern __shared__ __attribute__((aligned(16))) char smem[];
    LAS unsigned char* lds = (LAS unsigned char*)(LAS char*)smem;
    volatile LAS unsigned* xbw = (volatile LAS unsigned*)(LAS char*)(smem + LDS_BYTES - 16);
    XcdBarrier bar; bar.bar = (unsigned*)p.ws; bar.x = 0; bar.st = xbw;
    if (hi - lo > 1) { if (threadIdx.x == 0) { xbw[0] = 0u; xbw[1] = 0u; } __syncthreads(); bar = xcd_barrier_post((unsigned*)p.ws, xbw); }
    const int G = gridDim.x, c = blockIdx.x;
#define SEAM(ph) if ((ph) + 1 < hi) xcd_barrier(bar);
    if (PHON(PH_PREP) && lo <= PH_PREP && PH_PREP < hi) { REP(PH_PREP) { phase_prep(p, smem); } SEAM(PH_PREP) }
    if (PHON(PH_H1) && lo <= PH_H1 && PH_H1 < hi) { REP(PH_H1) { phase_h1(p); } SEAM(PH_H1) }
    if (PHON(PH_GIN) && lo <= PH_GIN && PH_GIN < hi) { REP(PH_GIN) {
        { pg8::PlainSched S; S.init(NT, 2048, G, c, p.ws + O_H, D, p.ws + O_WIN, D);
          pg8::EpiBf16 E; E.O = (bf16_t*)(p.ws + O_Z); E.ldc = ZC; E.scale = 1.f;
          pg8::gemm_phase(lds, pg8::Gemm{D, D, D}, S, E); }
        { pg8::PlainSched S; S.init(NT, ZC - 2048, G, c, p.ws + O_H8, D / 2, p.ws + O_WIN8 + (size_t)2048 * D, D / 2);
          pg8::EpiBf16 E; E.O = (bf16_t*)(p.ws + O_Z) + 2048; E.ldc = ZC; E.scale = pg8::W8_INV;
          pg8::gemm_phase_fp8(lds, pg8::Gemm{D / 2, D / 2, D / 2}, S, E); }
        } SEAM(PH_GIN) }
    if (PHON(PH_ZPOST) && lo <= PH_ZPOST && PH_ZPOST < hi) { REP(PH_ZPOST) { phase_zpost(p); } SEAM(PH_ZPOST) }
    if (PHON(PH_GQ) && lo <= PH_GQ && PH_GQ < hi) { REP(PH_GQ) {
        { pg8::PlainSched S; S.init(NT, QC, G, c, p.ws + O_CQN, 512, p.ws + O_WQ, 512);
          pg8::EpiBf16 E; E.O = (bf16_t*)(p.ws + O_QALL); E.ldc = QC; E.scale = 1.f;
          pg8::gemm_phase(lds, pg8::Gemm{512, 512, 512}, S, E); }
        { pg8::C1Sched S; S.G = G; S.c = c; S.kvs = p.ws + O_KVS; S.w = p.ws + O_WC1;
          pg8::EpiC1 E; E.C = (float*)(p.ws + O_C1P);
          pg8::gemm_phase(lds, pg8::Gemm{2048, 4096, 256}, S, E); }
        } SEAM(PH_GQ) }
    if (PHON(PH_IDX) && lo <= PH_IDX && PH_IDX < hi) { REP(PH_IDX) {
#ifdef IDX_NAIVE
        phase_indexer(p, smem);
#else
        phase_indexer_mfma(p, smem);
#endif
        } SEAM(PH_IDX) }
    if (PHON(PH_MLA) && lo <= PH_MLA && PH_MLA < hi) { REP(PH_MLA) {
#ifdef MLA_NAIVE
        phase_mla(p, smem);
#else
        phase_mla_mfma(p, smem);
#endif
        } SEAM(PH_MLA) }
    if (PHON(PH_NSA) && lo <= PH_NSA && PH_NSA < hi) { REP(PH_NSA) {
#ifdef NSA_NAIVE
        phase_nsa(p, smem);
#else
        phase_nsa_mfma(p, smem);
#endif
        } SEAM(PH_NSA) }
    if (PHON(PH_MERGE) && lo <= PH_MERGE && PH_MERGE < hi) { REP(PH_MERGE) {
        { pg8::PlainSched S; S.init(NT, D, G, c, p.ws + O_OLAT, D / 2, p.ws + O_WO, D / 2);
          pg8::EpiMerge<false> E; E.P = (bf16_t*)(p.ws + O_MERGED); E.O8 = nullptr; E.Z = (const bf16_t*)(p.ws + O_Z); E.gcol0 = ZC_MG; E.scale = pg8::A8W8_INV;
          pg8::gemm_phase_fp8(lds, pg8::Gemm{D / 2, D / 2, D / 2}, S, E); }
        { pg8::PlainSched S; S.init(NT, D, G, c, p.ws + O_OB8, 512, p.ws + O_WBRB, 512);
          pg8::EpiMerge<true> E; E.P = (bf16_t*)(p.ws + O_MERGED); E.O8 = (unsigned char*)(p.ws + O_MG8); E.Z = (const bf16_t*)(p.ws + O_Z); E.gcol0 = ZC_MG + 2048; E.scale = pg8::A8W8_INV;
          pg8::gemm_phase_fp8(lds, pg8::Gemm{512, 512, 512}, S, E); }
        } SEAM(PH_MERGE) }
    if (PHON(PH_GOUT) && lo <= PH_GOUT && PH_GOUT < hi) { REP(PH_GOUT) {
        pg8::PlainSched S; S.init(NT, D, G, c, p.ws + O_MG8, D / 2, p.ws + O_WOUT, D / 2);
        pg8::EpiBf16 E; E.O = (bf16_t*)(p.ws + O_MO); E.ldc = D; E.scale = pg8::A8W8_INV;
        pg8::gemm_phase_fp8(lds, pg8::Gemm{D / 2, D / 2, D / 2}, S, E); } SEAM(PH_GOUT) }
    if (PHON(PH_POSTMIX) && lo <= PH_POSTMIX && PH_POSTMIX < hi) { REP(PH_POSTMIX) { phase_post_mix(p, smem, rep_ == 0); } SEAM(PH_POSTMIX) }
    if (PHON(PH_GATHER) && lo <= PH_GATHER && PH_GATHER < hi) { REP(PH_GATHER) { phase_moe_gather(p, smem); } SEAM(PH_GATHER) }
    if (PHON(PH_GU) && lo <= PH_GU && PH_GU < hi) { REP(PH_GU) {
        LAS int* tile_e = (LAS int*)(LAS char*)(smem + 131072); LAS int* pstart = tile_e + 320;
        const int mt = moe_tables(p, tile_e, pstart);
        pg8::MoeSched S; S.G = G; S.c = c; S.nN = 16; S.total = mt * 16; S.tile_e = tile_e; S.A = p.ws + O_HS; S.W = p.ws + O_WGU; S.w_exp = (size_t)4096 * D;
        pg8::EpiGU E; E.O = (unsigned char*)(p.ws + O_ACT); E.bias = p.b_gate_up;
        pg8::gemm_phase_fp8(lds, pg8::Gemm{D / 2, D / 2, D / 2, 64, 16384}, S, E); } SEAM(PH_GU) }
    if (PHON(PH_DN) && lo <= PH_DN && PH_DN < hi) { REP(PH_DN) {
        LAS int* tile_e = (LAS int*)(LAS char*)(smem + 131072); LAS int* pstart = tile_e + 320;
        const int mt = moe_tables(p, tile_e, pstart);
        pg8::MoeSched S; S.G = G; S.c = c; S.nN = 8; S.total = mt * 8; S.tile_e = tile_e; S.A = p.ws + O_ACT; S.W = p.ws + O_WDN; S.w_exp = (size_t)D * D;
        pg8::EpiDN E; E.O = (unsigned char*)(p.ws + O_YS); E.bias = p.b_down; E.slotw = (const float*)(p.ws + O_SLOTW);
        pg8::gemm_phase_fp8(lds, pg8::Gemm{D / 2, D / 2, D / 2, 64, 16384}, S, E); } SEAM(PH_DN) }
    if (PHON(PH_FINAL) && lo <= PH_FINAL && PH_FINAL < hi) { REP(PH_FINAL) { phase_final(p); } }
#undef SEAM
}

extern "C" void kernel_launch(void* const* d_in, const int* in_sizes, int n_in, void* d_out, int out_size, void* d_ws, size_t ws_size, hipStream_t stream) {
    static int grid = 0;
    if (grid == 0) {
        if (n_in != 33 || out_size != NT * D || ws_size < WS_END) { fprintf(stderr, "kernel_launch: unexpected shapes (n_in %d out %d ws %zu need %zu)\n", n_in, out_size, ws_size, (size_t)WS_END); grid = -1; return; }
        int dev = 0, cus = 0;
        if (hipGetDevice(&dev) != hipSuccess || hipDeviceGetAttribute(&cus, hipDeviceAttributeMultiprocessorCount, dev) != hipSuccess) { grid = -1; return; }
        if (hipFuncSetAttribute((const void*)mega, hipFuncAttributeMaxDynamicSharedMemorySize, LDS_BYTES) != hipSuccess) { fprintf(stderr, "kernel_launch: hipFuncSetAttribute failed\n"); grid = -1; return; }
        int per_cu = 0; (void)hipOccupancyMaxActiveBlocksPerMultiprocessor(&per_cu, (const void*)mega, 512, LDS_BYTES); (void)hipGetLastError();
        grid = cus;
    }
    if (grid < 0) return;
    Params p{};
    const float** pf = (const float**)&p;
    for (int i = 0; i < 33; ++i) pf[i] = (const float*)d_in[i];
    p.pos = (const int*)d_in[2];
    p.out = (float*)d_out; p.ws = (char*)d_ws;
    hipMemsetAsync(d_ws, 0, ZERO_BYTES, stream);
#ifdef MK_UNFUSED
    for (int ph = 0; ph < PH_END; ++ph) hipLaunchKernelGGL(mega, dim3(grid), dim3(512), LDS_BYTES, stream, p, ph, ph + 1);
#else
    hipLaunchKernelGGL(mega, dim3(grid), dim3(512), LDS_BYTES, stream, p, 0, (int)PH_END);
#endif
}
```

```cpp
#include <hip/hip_runtime.h>
#include <stdint.h>
#include <stdio.h>

#define LAS __attribute__((address_space(3)))
#define DI __device__ __forceinline__
typedef unsigned short bf16_t;
typedef short bf16x8 __attribute__((ext_vector_type(8)));
typedef float f32x4 __attribute__((ext_vector_type(4)));
typedef unsigned u32x4 __attribute__((ext_vector_type(4)));
typedef unsigned u32x2 __attribute__((ext_vector_type(2)));

#define PREP_PROBE_WC 0
#define PREP_PROBE_MODE 0
#define PREP_REP 0
#define PREP_REP_LO 0
#define PREP_REP_HI 100000
#define PREP_PROBE_NFAST 0
constexpr int NB = 2, T = 8192, NT = NB * T, D = 2048;
constexpr int ZC = 7680;
constexpr int ZC_CKV = 512, ZC_KROPE = 768, ZC_KIDX = 800, ZC_WIDX = 864, ZC_BGATE = 872, ZC_BQ = 1024, ZC_MG = 3584;
constexpr int QC = 2816;
constexpr int KVW = 288;
constexpr int NEXP = 32, SLOTS = 73728, MAXMT = SLOTS / 256;
constexpr float NORM_EPS = 1e-6f;
constexpr float ATT_SCALE = 0.08838834764831845f;
constexpr int LDS_BYTES = 152 * 1024;

constexpr size_t al256(size_t x) { return (x + 255) & ~(size_t)255; }
constexpr size_t ZERO_BYTES = 131072;
constexpr size_t O_MODACC = 16384, O_CNT = 114688;
constexpr size_t O_ROPE = ZERO_BYTES;
constexpr size_t O_WIN = O_ROPE + al256((size_t)NT * 48 * 4);
constexpr size_t O_WQ = O_WIN + al256((size_t)ZC * D * 2);
constexpr size_t O_WO = O_WQ + al256((size_t)QC * 512 * 2);
constexpr size_t O_WBRB = O_WO + al256((size_t)D * D * 2);
constexpr size_t O_WOUT = O_WBRB + al256((size_t)D * 1024 * 2);
constexpr size_t O_WC1 = O_WOUT + al256((size_t)D * D * 2);
constexpr size_t O_CBIAS = O_WC1 + al256((size_t)2 * 256 * 4096 * 2);
constexpr size_t O_CBP = O_CBIAS + al256(2 * 256 * 4);
constexpr size_t O_WRT = O_CBP + al256(64 * 2 * 256 * 4);
constexpr size_t O_WGU = O_WRT + al256((size_t)256 * D * 2);
constexpr size_t O_WDN = O_WGU + al256((size_t)NEXP * 4096 * D * 2);
constexpr size_t O_H = O_WDN + al256((size_t)NEXP * D * D * 2);
constexpr size_t O_Z = O_H + al256((size_t)NT * D * 2);
constexpr size_t O_CQN = O_Z + al256((size_t)NT * ZC * 2);
constexpr size_t O_KVT = O_CQN + al256((size_t)NT * 512 * 2);
constexpr size_t O_KIDX = O_KVT + al256((size_t)NT * KVW * 2);
constexpr size_t O_WIDX = O_KIDX + al256((size_t)NT * 64 * 2);
constexpr size_t O_GATES = O_WIDX + al256((size_t)NT * 8 * 4);
constexpr size_t O_BQ = O_GATES + al256((size_t)NT * 24 * 4);
constexpr size_t KVS_ONE = (size_t)NB * 2 * T * 128;
constexpr size_t O_KVS = O_BQ + al256((size_t)NT * 1024 * 2);
constexpr size_t O_QALL = O_KVS + al256(6 * KVS_ONE * 2 + 65536);
constexpr size_t O_C1P = O_QALL + al256((size_t)NT * QC * 2);
constexpr size_t O_KCVC = O_C1P + al256((size_t)16 * 2 * 2048 * 256 * 4);
constexpr size_t O_SEL = O_KCVC + al256((size_t)2 * 2048 * 128 * 2);
constexpr size_t O_NSEL = O_SEL + al256((size_t)NT * 256 * 2);
constexpr size_t O_OLAT = O_NSEL + al256((size_t)NT * 4);
constexpr size_t O_OB = O_OLAT + al256((size_t)NT * D * 2);
constexpr size_t O_MERGED = O_OB + al256((size_t)NT * 1024 * 2);
constexpr size_t O_MO = O_MERGED + al256((size_t)NT * D * 2);
constexpr size_t O_X1 = O_MO + al256((size_t)NT * D * 2);
constexpr size_t O_TOPI = O_X1 + al256((size_t)NT * D * 4);
constexpr size_t O_TOPW = O_TOPI + al256((size_t)NT * 4 * 4);
constexpr size_t O_TSLOT = O_TOPW + al256((size_t)NT * 4 * 4);
constexpr size_t O_SLOTW = O_TSLOT + al256((size_t)NT * 4 * 4);
constexpr size_t O_HS = O_SLOTW + al256((size_t)SLOTS * 4);
constexpr size_t O_ACT = O_HS + al256((size_t)SLOTS * D);
constexpr size_t O_YS = O_ACT + al256((size_t)SLOTS * D);
constexpr size_t O_OB8 = O_YS + al256((size_t)SLOTS * D * 2);
constexpr size_t O_MG8 = O_OB8 + al256((size_t)NT * 1024);
constexpr size_t O_WIN8 = O_MG8 + al256((size_t)NT * D);
constexpr size_t O_H8 = O_WIN8 + al256((size_t)ZC * D);
constexpr size_t WS_END = O_H8 + al256((size_t)NT * D);

struct Params {
    const float* x; const float* c; const int* pos; const float* w_ada; const float* b_ada;
    const float* g_pre_mix; const float* g_post_mix; const float* g_pre_ffn; const float* g_post_ffn;
    const float* w_in; const float* a_cq_norm; const float* a_ckv_norm; const float* a_w_uq; const float* a_w_uk; const float* a_w_uv;
    const float* idx_w_q; const float* idx_g; const float* idx_b;
    const float* cmp_k_pe; const float* cmp_k_w1; const float* cmp_k_w2; const float* cmp_v_pe; const float* cmp_v_w1; const float* cmp_v_w2;
    const float* w_br_a; const float* w_br_b; const float* w_out; const float* w_router; const float* b_router;
    const float* w_gate_up; const float* b_gate_up; const float* w_down; const float* b_down;
    float* out; char* ws;
};

DI int tid_fresh() { int t = threadIdx.x; asm volatile("" : "+v"(t)); return t; }
DI float bf2f(bf16_t v) { return __uint_as_float((unsigned)v << 16); }
DI float bflo(unsigned w) { return __uint_as_float(w << 16); }
DI float bfhi(unsigned w) { return __uint_as_float(w & 0xffff0000u); }
DI bf16_t f2bf(float f) { unsigned u = __float_as_uint(f); u += 0x7FFFu + ((u >> 16) & 1u); return (bf16_t)(u >> 16); }
DI unsigned pk2(float lo, float hi) { unsigned r; asm volatile("v_cvt_pk_bf16_f32 %0, %1, %2" : "=v"(r) : "v"(lo), "v"(hi)); return r; }
DI float wave_sum(float v) {
#pragma unroll
    for (int o = 1; o < 64; o <<= 1) v += __shfl_xor(v, o);
    return v;
}
DI float wave_max(float v) {
#pragma unroll
    for (int o = 1; o < 64; o <<= 1) v = fmaxf(v, __shfl_xor(v, o));
    return v;
}
DI float sigmoidf_(float v) { return 1.f / (1.f + __expf(-v)); }
DI void unpack8(const u32x4& w, float (&f)[8]) {
    f[0] = bflo(w[0]); f[1] = bfhi(w[0]); f[2] = bflo(w[1]); f[3] = bfhi(w[1]); f[4] = bflo(w[2]); f[5] = bfhi(w[2]); f[6] = bflo(w[3]); f[7] = bfhi(w[3]);
}
DI float mod_at(const Params& p, int b, int j) { return ((const float*)(p.ws + O_MODACC))[b * 12288 + j]; }

#define XB_TMO      128
#define XB_XCNT(j)  (256  + 64 * (j))
#define XB_XSUB(j)  (1280 + 64 * (j))
#define XB_XGEN(j)  (2304 + 64 * (j))
#define XB_TOP      3328
#define XB_TOPGEN   3392
#define XCD_BAR_WORDS 3456
#define XB_SPIN_CAP (1u << 22)
DI unsigned xb_ld(unsigned* p)              { return __hip_atomic_load(p, __ATOMIC_RELAXED, __HIP_MEMORY_SCOPE_AGENT); }
DI unsigned xb_add(unsigned* p, unsigned v) { return __hip_atomic_fetch_add(p, v, __ATOMIC_RELAXED, __HIP_MEMORY_SCOPE_AGENT); }
DI unsigned xb_xcc_id() { return (unsigned)__builtin_amdgcn_s_getreg((3 << 11) | 20) & 0xFu; }
#define XB_SPIN(cond, bar) do { unsigned _sp = 0; while (cond) { __builtin_amdgcn_s_sleep(1); \
    if ((++_sp & 255u) == 0u) { if (xb_ld(&(bar)[XB_TMO])) break; if (_sp > XB_SPIN_CAP) { atomicAdd(&(bar)[XB_TMO], 1u); break; } } } } while (0)
struct XcdBarrier { unsigned* bar; unsigned x; volatile LAS unsigned* st; };
DI XcdBarrier xcd_barrier_post(unsigned* bar, volatile LAS unsigned* st) {
    XcdBarrier b; b.bar = bar; b.x = xb_xcc_id(); b.st = st;
    if (threadIdx.x == 0) (void)xb_add(&bar[XB_XCNT(b.x)], 1u);
    return b;
}
DI void xcd_barrier_complete(unsigned* bar, unsigned x, unsigned& nloc, unsigned& nx) {
    const unsigned G = gridDim.x * gridDim.y * gridDim.z;
    unsigned sum, cnt, mine, sp = 0u;
    for (;;) {
        sum = 0u; cnt = 0u; mine = 0u;
#pragma unroll
        for (unsigned j = 0; j < 16; ++j) { const unsigned c = xb_ld(&bar[XB_XCNT(j)]); sum += c; cnt += (c > 0u) ? 1u : 0u; mine = (j == x) ? c : mine; }
        if (sum == G) break;
        __builtin_amdgcn_s_sleep(1);
        if ((++sp & 255u) == 0u) { if (xb_ld(&bar[XB_TMO])) break; if (sp > XB_SPIN_CAP) { atomicAdd(&bar[XB_TMO], 1u); break; } }
    }
    nloc = mine > 0u ? mine : 1u; nx = cnt > 0u ? cnt : 1u;
}
DI void xcd_barrier(const XcdBarrier& b) {
    asm volatile("s_waitcnt vmcnt(0)" ::: "memory");
    __syncthreads();
    if (threadIdx.x == 0) {
        unsigned* bar = b.bar;
        __builtin_amdgcn_s_waitcnt(0);
        unsigned nloc = b.st[0], nx = b.st[1];
        if (nloc == 0u) { xcd_barrier_complete(bar, b.x, nloc, nx); b.st[0] = nloc; b.st[1] = nx; }
        const unsigned old = xb_add(&bar[XB_XSUB(b.x)], 1u);
        const unsigned gen = old / nloc;
        if (old + 1u == (gen + 1u) * nloc) {
            __builtin_amdgcn_fence(__ATOMIC_RELEASE, "agent");
            asm volatile("s_waitcnt vmcnt(0)" ::: "memory");
            const unsigned og = xb_add(&bar[XB_TOP], 1u);
            const unsigned tg = og / nx;
            if (og + 1u == (tg + 1u) * nx) xb_add(&bar[XB_TOPGEN], 1u);
            else XB_SPIN(xb_ld(&bar[XB_TOPGEN]) == tg, bar);
            __builtin_amdgcn_fence(__ATOMIC_ACQUIRE, "agent");
            xb_add(&bar[XB_XGEN(b.x)], 1u);
            asm volatile("s_waitcnt vmcnt(0)" ::: "memory");
        } else {
            XB_SPIN(xb_ld(&bar[XB_XGEN(b.x)]) == gen, bar);
            __builtin_amdgcn_fence(__ATOMIC_ACQUIRE, "agent");
            asm volatile("s_waitcnt vmcnt(0)" ::: "memory");
        }
    }
    __syncthreads();
}

namespace pg8 {
constexpr int BM = 256, BK = 64, HALF = 128, HTB = HALF * BK * 2, STAGE_BYTES = 8 * HTB, NXCD = 8, WGM = 8;
DI int lds_byte(int r, int c) { const int st = (r >> 4) * 2 + (c >> 5), rr = r & 15, cc = c & 31, ob = rr * 64 + cc * 2; return st * 1024 + (ob ^ (((ob >> 9) & 1) << 5)); }
DI void stage_rc(int b, int& R, int& C) { const int st = b / 1024, sb = b % 1024, swz = sb ^ (((sb >> 9) & 1) << 5); R = (st >> 1) * 16 + swz / 64; C = (st & 1) * 32 + (swz % 64) / 2; }
DI int perm32(int rho) { const int n = rho >> 4, i = rho & 15; return 8 * (i >> 2) + 4 * n + (i & 3); }

struct Unit { int pm, pn, e; const char* a; const char* b; };
struct Gemm { int lda, ldb, K; int brow = ldb; int bk = BK * 2; };

struct PlainSched {
    int nM, nN, nwg, G, c; const char* A; const char* Bt; size_t a_tile, b_tile;
    DI void init(int M, int N, int G_, int c_, const void* A_, int lda, const void* Bt_, int ldb) {
        nM = M / BM; nN = N / BM; nwg = nM * nN; G = G_; c = c_; A = (const char*)A_; Bt = (const char*)Bt_; a_tile = (size_t)BM * lda * 2; b_tile = (size_t)BM * ldb * 2; }
    DI bool next(int i, Unit& u) const {
        const long L = (long)i * G + c; if (L >= nwg) return false;
        int wgid = (int)L; { const int q = nwg / NXCD, r = nwg % NXCD, xcd = wgid % NXCD, off = wgid / NXCD; wgid = (xcd < r ? xcd * (q + 1) : r * (q + 1) + (xcd - r) * q) + off; }
        const int nig = WGM * nN, gid = wgid / nig, fm = gid * WGM, gsz = (nM - fm) < WGM ? (nM - fm) : WGM;
        u.pm = fm + ((wgid % nig) % gsz); u.pn = (wgid % nig) / gsz; u.e = 0;
        u.a = A + (size_t)u.pm * a_tile; u.b = Bt + (size_t)u.pn * b_tile; return true;
    }
};

typedef int v4i_t __attribute__((ext_vector_type(4)));
typedef int v8i_t __attribute__((ext_vector_type(8)));
#ifndef PG8_SP2
#define PG8_SP2 true
#endif
template <class Epi, class Sched, bool SP2 = PG8_SP2>
DI void gemm_phase(LAS unsigned char* lds, const Gemm g, const Sched& S, const Epi& E) {
    const int tid = tid_fresh(), wid = __builtin_amdgcn_readfirstlane(tid >> 6), lane = tid & 63, wr = wid >> 2, wc = wid & 3, fr = lane & 15, fq = lane >> 4;
    const int K = g.K, nt = K / BK;
    unsigned voffA[2], voffB[2];
#pragma unroll
    for (int i = 0; i < 2; ++i) { int R, C; stage_rc(tid * 16 + i * 8192, R, C); const int Rb = Epi::PERM ? ((R & ~31) + perm32(R & 31)) : R;
        voffA[i] = (unsigned)(R * g.lda + C) * 2u; voffB[i] = (unsigned)(Rb * g.ldb + C) * 2u; }
    const size_t kstep = (size_t)(BK * 2);
    const size_t hstepA = (size_t)HALF * g.lda * 2, hstepB = (size_t)HALF * g.ldb * 2;
    const unsigned ldsw = (unsigned)wid * 1024u;
    const int aoff = lds_byte(wr * 64 + fr, fq * 8), boff = lds_byte(wc * 32 + fr, fq * 8);
#define PG8_SA(b, h) (((b) * 2 + (h)) * HTB)
#define PG8_SB(b, h) ((4 + (b) * 2 + (h)) * HTB)
#define PG8_STAGE(bufoff, gbase, voff) do { _Pragma("unroll") for (int _i = 0; _i < 2; ++_i) \
        __builtin_amdgcn_global_load_lds((const unsigned*)((const char*)(gbase) + (voff)[_i]), (LAS unsigned*)(lds + (bufoff) + ldsw + _i * 8192), 16, 0, 0); } while (0)
#define PG8_LDA(dst, b, h) do { _Pragma("unroll") for (int m = 0; m < 4; ++m) _Pragma("unroll") for (int k = 0; k < 2; ++k) dst[m][k] = *(const LAS bf16x8*)(lds + PG8_SA(b, h) + aoff + m * 2048 + k * 1024); } while (0)
#define PG8_LDB(dst, b, h) do { _Pragma("unroll") for (int n = 0; n < 2; ++n) _Pragma("unroll") for (int k = 0; k < 2; ++k) dst[n][k] = *(const LAS bf16x8*)(lds + PG8_SB(b, h) + boff + n * 2048 + k * 1024); } while (0)
#define PG8_MMA(ai, bj, At, Bt) do { __builtin_amdgcn_s_setprio(1); _Pragma("unroll") for (int m = 0; m < 4; ++m) _Pragma("unroll") for (int n = 0; n < 2; ++n) _Pragma("unroll") for (int k = 0; k < 2; ++k) \
        acc[ai][bj][m][n] = __builtin_amdgcn_mfma_f32_16x16x32_bf16(Bt[n][k], At[m][k], acc[ai][bj][m][n], 0, 0, 0); __builtin_amdgcn_s_setprio(0); } while (0)
#define PG8_WAIT_V(n) asm volatile("s_waitcnt vmcnt(" #n ")" ::: "memory")
#define PG8_WAIT_L(n) asm volatile("s_waitcnt lgkmcnt(" #n ")" ::: "memory")
#define PG8_BAR __builtin_amdgcn_s_barrier()
#define PG8_SCHED __builtin_amdgcn_sched_barrier(0)
    Unit cur, nxt; int ui = 0;
    if (!S.next(0, cur)) return;
    f32x4 acc[2][2][4][2];
#pragma unroll
    for (int a = 0; a < 2; ++a)
#pragma unroll
        for (int b = 0; b < 2; ++b)
#pragma unroll
            for (int m = 0; m < 4; ++m)
#pragma unroll
                for (int n = 0; n < 2; ++n) acc[a][b][m][n] = (f32x4){0.f, 0.f, 0.f, 0.f};
    bf16x8 At[4][2], B0[2][2], B1[2][2];
    const char* cA = cur.a; const char* cB = cur.b;
    if constexpr (SP2) {
        PG8_STAGE(PG8_SB(0, 0), cB, voffB); PG8_STAGE(PG8_SB(0, 1), cB + hstepB, voffB); PG8_STAGE(PG8_SA(0, 0), cA, voffA); PG8_STAGE(PG8_SA(0, 1), cA + hstepA, voffA);
        if (wr == 1) PG8_BAR;
        PG8_WAIT_V(2); PG8_BAR;
        PG8_STAGE(PG8_SB(1, 0), cB + kstep, voffB); PG8_STAGE(PG8_SA(1, 0), cA + kstep, voffA); PG8_STAGE(PG8_SB(1, 1), cB + hstepB + kstep, voffB);
        PG8_WAIT_V(6); PG8_BAR;
    } else {
        PG8_STAGE(PG8_SB(0, 0), cB, voffB); PG8_STAGE(PG8_SA(0, 0), cA, voffA); PG8_STAGE(PG8_SB(0, 1), cB + hstepB, voffB); PG8_STAGE(PG8_SA(0, 1), cA + hstepA, voffA);
        if (wr == 1) PG8_BAR;
        PG8_WAIT_V(4); PG8_BAR;
        PG8_STAGE(PG8_SB(1, 0), cB + kstep, voffB); PG8_STAGE(PG8_SA(1, 0), cA + kstep, voffA); PG8_STAGE(PG8_SB(1, 1), cB + hstepB + kstep, voffB);
        PG8_WAIT_V(6); PG8_BAR;
    }
    for (;;) {
        const bool has_next = S.next(ui + 1, nxt);
        const char* nA = has_next ? nxt.a : cA; const char* nB = has_next ? nxt.b : cB;
        for (int t = 0; t < nt; t += 2) {
            const bool last = (t == nt - 2);
            const char* a1 = cA + (size_t)(t + 1) * kstep;
            const char* a2 = last ? nA : cA + (size_t)(t + 2) * kstep; const char* b2 = last ? nB : cB + (size_t)(t + 2) * kstep;
            const char* a3 = a2 + kstep; const char* b3 = b2 + kstep;
            if constexpr (SP2) {
            PG8_LDB(B0, 0, 0); PG8_LDB(B1, 0, 1); PG8_SCHED; PG8_LDA(At, 0, 0); PG8_STAGE(PG8_SA(1, 1), a1 + hstepA, voffA);
            PG8_WAIT_V(8); PG8_WAIT_L(0); PG8_BAR; PG8_MMA(0, 0, At, B0); PG8_MMA(0, 1, At, B1); PG8_BAR; PG8_SCHED;
            PG8_LDA(At, 0, 1); PG8_STAGE(PG8_SB(0, 0), b2, voffB); PG8_STAGE(PG8_SB(0, 1), b2 + hstepB, voffB); PG8_STAGE(PG8_SA(0, 0), a2, voffA);
            PG8_WAIT_V(8); PG8_WAIT_L(0); PG8_BAR; PG8_MMA(1, 0, At, B0); PG8_MMA(1, 1, At, B1); PG8_BAR; PG8_SCHED;
            PG8_LDB(B0, 1, 0); PG8_LDB(B1, 1, 1); PG8_SCHED; PG8_LDA(At, 1, 0); PG8_STAGE(PG8_SA(0, 1), a2 + hstepA, voffA);
            PG8_WAIT_V(8); PG8_WAIT_L(0); PG8_BAR; PG8_MMA(0, 0, At, B0); PG8_MMA(0, 1, At, B1); PG8_BAR; PG8_SCHED;
            PG8_LDA(At, 1, 1); PG8_STAGE(PG8_SB(1, 0), b3, voffB); PG8_STAGE(PG8_SB(1, 1), b3 + hstepB, voffB); PG8_STAGE(PG8_SA(1, 0), a3, voffA);
            PG8_WAIT_V(8); PG8_WAIT_L(0); PG8_BAR; PG8_MMA(1, 0, At, B0); PG8_MMA(1, 1, At, B1); PG8_BAR; PG8_SCHED;
            } else {
            PG8_LDB(B0, 0, 0); PG8_SCHED; PG8_LDA(At, 0, 0); PG8_STAGE(PG8_SA(1, 1), a1 + hstepA, voffA);
            PG8_WAIT_L(8); PG8_BAR; PG8_WAIT_L(0); PG8_MMA(0, 0, At, B0); PG8_BAR; PG8_SCHED;
            PG8_LDB(B1, 0, 1); PG8_STAGE(PG8_SB(0, 0), b2, voffB);
            PG8_BAR; PG8_WAIT_L(0); PG8_MMA(0, 1, At, B1); PG8_BAR;
            PG8_LDA(At, 0, 1); PG8_STAGE(PG8_SA(0, 0), a2, voffA);
            PG8_BAR; PG8_WAIT_L(0); PG8_MMA(1, 0, At, B0); PG8_BAR; PG8_SCHED;
            PG8_STAGE(PG8_SB(0, 1), b2 + hstepB, voffB);
            PG8_WAIT_V(6); PG8_BAR; PG8_MMA(1, 1, At, B1); PG8_BAR;
            PG8_LDB(B0, 1, 0); PG8_SCHED; PG8_LDA(At, 1, 0); PG8_STAGE(PG8_SA(0, 1), a2 + hstepA, voffA);
            PG8_WAIT_L(8); PG8_BAR; PG8_WAIT_L(0); PG8_MMA(0, 0, At, B0); PG8_BAR; PG8_SCHED;
            PG8_LDB(B1, 1, 1); PG8_STAGE(PG8_SB(1, 0), b3, voffB);
            PG8_BAR; PG8_WAIT_L(0); PG8_MMA(0, 1, At, B1); PG8_BAR;
            PG8_LDA(At, 1, 1); PG8_STAGE(PG8_SA(1, 0), a3, voffA);
            PG8_BAR; PG8_WAIT_L(0); PG8_MMA(1, 0, At, B0); PG8_BAR; PG8_SCHED;
            PG8_STAGE(PG8_SB(1, 1), b3 + hstepB, voffB);
            PG8_WAIT_V(6); PG8_BAR; PG8_MMA(1, 1, At, B1); PG8_BAR;
            }
        }
        E(acc, cur, wr, wc, fr, fq);
        if (!has_next) break;
#pragma unroll
        for (int a = 0; a < 2; ++a)
#pragma unroll
            for (int b = 0; b < 2; ++b)
#pragma unroll
                for (int m = 0; m < 4; ++m)
#pragma unroll
                    for (int n = 0; n < 2; ++n) acc[a][b][m][n] = (f32x4){0.f, 0.f, 0.f, 0.f};
        cur = nxt; cA = nA; cB = nB; ++ui;
    }
    PG8_WAIT_V(0);
    if (wr == 0) PG8_BAR;
    PG8_BAR;
#undef PG8_SA
#undef PG8_SB
#undef PG8_STAGE
#undef PG8_LDA
#undef PG8_LDB
#undef PG8_MMA
#undef PG8_WAIT_V
#undef PG8_WAIT_L
#undef PG8_BAR
#undef PG8_SCHED
}

template <class Epi, class Sched, bool SP2 = PG8_SP2>
DI void gemm_phase_fp8(LAS unsigned char* lds, const Gemm g, const Sched& S, const Epi& E) {
    const int tid = tid_fresh(), wid = __builtin_amdgcn_readfirstlane(tid >> 6), lane = tid & 63, wr = wid >> 2, wc = wid & 3, fr = lane & 15, fq = lane >> 4;
    const int K = g.K, nt = K / BK;
    unsigned voffA[2], voffB[2];
#pragma unroll
    for (int i = 0; i < 2; ++i) { int R, C; stage_rc(tid * 16 + i * 8192, R, C); const int Rb = Epi::PERM ? ((R & ~31) + perm32(R & 31)) : R;
        voffA[i] = (unsigned)(R * g.lda + C) * 2u; voffB[i] = (unsigned)(Rb * g.brow + C) * 2u; }
    const size_t kstep = (size_t)(BK * 2), kstepB = (size_t)g.bk;
    const size_t hstepA = (size_t)HALF * g.lda * 2, hstepB = (size_t)HALF * g.ldb * 2;
    const unsigned ldsw = (unsigned)wid * 1024u;
    const int aoff = lds_byte(wr * 64 + fr, fq * 8), boff = lds_byte(wc * 32 + fr, fq * 8);
#define PG8_SA(b, h) (((b) * 2 + (h)) * HTB)
#define PG8_SB(b, h) ((4 + (b) * 2 + (h)) * HTB)
#define PG8_STAGE(bufoff, gbase, voff) do { _Pragma("unroll") for (int _i = 0; _i < 2; ++_i) \
        __builtin_amdgcn_global_load_lds((const unsigned*)((const char*)(gbase) + (voff)[_i]), (LAS unsigned*)(lds + (bufoff) + ldsw + _i * 8192), 16, 0, 0); } while (0)
#define PG8_LDA(dst, b, h) do { _Pragma("unroll") for (int m = 0; m < 4; ++m) { const v4i_t lo_ = *(const LAS v4i_t*)(lds + PG8_SA(b, h) + aoff + m * 2048), hi_ = *(const LAS v4i_t*)(lds + PG8_SA(b, h) + aoff + m * 2048 + 1024); dst[m] = __builtin_shufflevector(lo_, hi_, 0, 1, 2, 3, 4, 5, 6, 7); } } while (0)
#define PG8_LDB(dst, b, h) do { _Pragma("unroll") for (int n = 0; n < 2; ++n) { const v4i_t lo_ = *(const LAS v4i_t*)(lds + PG8_SB(b, h) + boff + n * 2048), hi_ = *(const LAS v4i_t*)(lds + PG8_SB(b, h) + boff + n * 2048 + 1024); dst[n] = __builtin_shufflevector(lo_, hi_, 0, 1, 2, 3, 4, 5, 6, 7); } } while (0)
#define PG8_MMA(ai, bj, At, Bt) do { __builtin_amdgcn_s_setprio(1); _Pragma("unroll") for (int m = 0; m < 4; ++m) _Pragma("unroll") for (int n = 0; n < 2; ++n) \
        asm volatile("v_mfma_scale_f32_16x16x128_f8f6f4 %0, %1, %2, %0, %3, %3 op_sel_hi:[0,0,0]" : "+v"(acc[ai][bj][m][n]) : "v"(Bt[n]), "v"(At[m]), "v"(sc127)); __builtin_amdgcn_s_setprio(0); } while (0)
#define PG8_WAIT_V(n) asm volatile("s_waitcnt vmcnt(" #n ")" ::: "memory")
#define PG8_WAIT_L(n) asm volatile("s_waitcnt lgkmcnt(" #n ")" ::: "memory")
#define PG8_BAR __builtin_amdgcn_s_barrier()
#define PG8_SCHED __builtin_amdgcn_sched_barrier(0)
    Unit cur, nxt; int ui = 0;
    if (!S.next(0, cur)) return;
    f32x4 acc[2][2][4][2];
#pragma unroll
    for (int a = 0; a < 2; ++a)
#pragma unroll
        for (int b = 0; b < 2; ++b)
#pragma unroll
            for (int m = 0; m < 4; ++m)
#pragma unroll
                for (int n = 0; n < 2; ++n) acc[a][b][m][n] = (f32x4){0.f, 0.f, 0.f, 0.f};
    v8i_t At[4], B0[2], B1[2];
    int sc127 = 127; asm volatile("" : "+v"(sc127));
    const char* cA = cur.a; const char* cB = cur.b;
    if constexpr (SP2) {
        PG8_STAGE(PG8_SB(0, 0), cB, voffB); PG8_STAGE(PG8_SB(0, 1), cB + hstepB, voffB); PG8_STAGE(PG8_SA(0, 0), cA, voffA); PG8_STAGE(PG8_SA(0, 1), cA + hstepA, voffA);
        if (wr == 1) PG8_BAR;
        PG8_WAIT_V(2); PG8_BAR;
        PG8_STAGE(PG8_SB(1, 0), cB + kstepB, voffB); PG8_STAGE(PG8_SA(1, 0), cA + kstep, voffA); PG8_STAGE(PG8_SB(1, 1), cB + hstepB + kstepB, voffB);
        PG8_WAIT_V(6); PG8_BAR;
    } else {
        PG8_STAGE(PG8_SB(0, 0), cB, voffB); PG8_STAGE(PG8_SA(0, 0), cA, voffA); PG8_STAGE(PG8_SB(0, 1), cB + hstepB, voffB); PG8_STAGE(PG8_SA(0, 1), cA + hstepA, voffA);
        if (wr == 1) PG8_BAR;
        PG8_WAIT_V(4); PG8_BAR;
        PG8_STAGE(PG8_SB(1, 0), cB + kstepB, voffB); PG8_STAGE(PG8_SA(1, 0), cA + kstep, voffA); PG8_STAGE(PG8_SB(1, 1), cB + hstepB + kstepB, voffB);
        PG8_WAIT_V(6); PG8_BAR;
    }
    for (;;) {
        const bool has_next = S.next(ui + 1, nxt);
        const char* nA = has_next ? nxt.a : cA; const char* nB = has_next ? nxt.b : cB;
        for (int t = 0; t < nt; t += 2) {
            const bool last = (t == nt - 2);
            const char* a1 = cA + (size_t)(t + 1) * kstep;
            const char* a2 = last ? nA : cA + (size_t)(t + 2) * kstep; const char* b2 = last ? nB : cB + (size_t)(t + 2) * kstepB;
            const char* a3 = a2 + kstep; const char* b3 = b2 + kstepB;
            if constexpr (SP2) {
            PG8_LDB(B0, 0, 0); PG8_LDB(B1, 0, 1); PG8_SCHED; PG8_LDA(At, 0, 0); PG8_STAGE(PG8_SA(1, 1), a1 + hstepA, voffA);
            PG8_WAIT_V(8); PG8_WAIT_L(0); PG8_BAR; PG8_MMA(0, 0, At, B0); PG8_MMA(0, 1, At, B1); PG8_BAR; PG8_SCHED;
            PG8_LDA(At, 0, 1); PG8_STAGE(PG8_SB(0, 0), b2, voffB); PG8_STAGE(PG8_SB(0, 1), b2 + hstepB, voffB); PG8_STAGE(PG8_SA(0, 0), a2, voffA);
            PG8_WAIT_V(8); PG8_WAIT_L(0); PG8_BAR; PG8_MMA(1, 0, At, B0); PG8_MMA(1, 1, At, B1); PG8_BAR; PG8_SCHED;
            PG8_LDB(B0, 1, 0); PG8_LDB(B1, 1, 1); PG8_SCHED; PG8_LDA(At, 1, 0); PG8_STAGE(PG8_SA(0, 1), a2 + hstepA, voffA);
            PG8_WAIT_V(8); PG8_WAIT_L(0); PG8_BAR; PG8_MMA(0, 0, At, B0); PG8_MMA(0, 1, At, B1); PG8_BAR; PG8_SCHED;
            PG8_LDA(At, 1, 1); PG8_STAGE(PG8_SB(1, 0), b3, voffB); PG8_STAGE(PG8_SB(1, 1), b3 + hstepB, voffB); PG8_STAGE(PG8_SA(1, 0), a3, voffA);
            PG8_WAIT_V(8); PG8_WAIT_L(0); PG8_BAR; PG8_MMA(1, 0, At, B0); PG8_MMA(1, 1, At, B1); PG8_BAR; PG8_SCHED;
            } else {
            PG8_LDB(B0, 0, 0); PG8_SCHED; PG8_LDA(At, 0, 0); PG8_STAGE(PG8_SA(1, 1), a1 + hstepA, voffA);
            PG8_WAIT_L(8); PG8_BAR; PG8_WAIT_L(0); PG8_MMA(0, 0, At, B0); PG8_BAR; PG8_SCHED;
            PG8_LDB(B1, 0, 1); PG8_STAGE(PG8_SB(0, 0), b2, voffB);
            PG8_BAR; PG8_WAIT_L(0); PG8_MMA(0, 1, At, B1); PG8_BAR;
            PG8_LDA(At, 0, 1); PG8_STAGE(PG8_SA(0, 0), a2, voffA);
            PG8_BAR; PG8_WAIT_L(0); PG8_MMA(1, 0, At, B0); PG8_BAR; PG8_SCHED;
            PG8_STAGE(PG8_SB(0, 1), b2 + hstepB, voffB);
            PG8_WAIT_V(6); PG8_BAR; PG8_MMA(1, 1, At, B1); PG8_BAR;
            PG8_LDB(B0, 1, 0); PG8_SCHED; PG8_LDA(At, 1, 0); PG8_STAGE(PG8_SA(0, 1), a2 + hstepA, voffA);
            PG8_WAIT_L(8); PG8_BAR; PG8_WAIT_L(0); PG8_MMA(0, 0, At, B0); PG8_BAR; PG8_SCHED;
            PG8_LDB(B1, 1, 1); PG8_STAGE(PG8_SB(1, 0), b3, voffB);
            PG8_BAR; PG8_WAIT_L(0); PG8_MMA(0, 1, At, B1); PG8_BAR;
            PG8_LDA(At, 1, 1); PG8_STAGE(PG8_SA(1, 0), a3, voffA);
            PG8_BAR; PG8_WAIT_L(0); PG8_MMA(1, 0, At, B0); PG8_BAR; PG8_SCHED;
            PG8_STAGE(PG8_SB(1, 1), b3 + hstepB, voffB);
            PG8_WAIT_V(6); PG8_BAR; PG8_MMA(1, 1, At, B1); PG8_BAR;
            }
        }
        asm volatile("s_nop 15\n\ts_nop 15" ::: "memory");
        E(acc, cur, wr, wc, fr, fq);
        if (!has_next) break;
#pragma unroll
        for (int a = 0; a < 2; ++a)
#pragma unroll
            for (int b = 0; b < 2; ++b)
#pragma unroll
                for (int m = 0; m < 4; ++m)
#pragma unroll
                    for (int n = 0; n < 2; ++n) acc[a][b][m][n] = (f32x4){0.f, 0.f, 0.f, 0.f};
        cur = nxt; cA = nA; cB = nB; ++ui;
    }
    PG8_WAIT_V(0);
    if (wr == 0) PG8_BAR;
    PG8_BAR;
#undef PG8_SA
#undef PG8_SB
#undef PG8_STAGE
#undef PG8_LDA
#undef PG8_LDB
#undef PG8_MMA
#undef PG8_WAIT_V
#undef PG8_WAIT_L
#undef PG8_BAR
#undef PG8_SCHED
}

typedef f32x4 Acc[2][2][4][2];
struct EpiBf16 {
    static constexpr bool PERM = true; bf16_t* O; int ldc; float scale;
    DI void operator()(const Acc& acc, const Unit& u, int wr, int wc, int fr, int fq) const {
        const int row0 = u.pm * BM + wr * 64 + fr, col0 = u.pn * BM + wc * 32 + 8 * fq;
#pragma unroll
        for (int ai = 0; ai < 2; ++ai)
#pragma unroll
            for (int m = 0; m < 4; ++m) { bf16_t* rowp = O + (size_t)(row0 + ai * HALF + m * 16) * ldc + col0;
#pragma unroll
                for (int bj = 0; bj < 2; ++bj) { const f32x4 v0 = acc[ai][bj][m][0] * scale, v1 = acc[ai][bj][m][1] * scale;
                    *(u32x4*)(rowp + bj * HALF) = (u32x4){pk2(v0[0], v0[1]), pk2(v0[2], v0[3]), pk2(v1[0], v1[1]), pk2(v1[2], v1[3])}; } }
    }
};
struct EpiC1 {
    static constexpr bool PERM = false; float* C;
    DI void operator()(const Acc& acc, const Unit& u, int wr, int wc, int fr, int fq) const {
        const int row0 = u.pm * BM + wr * 64 + fr, col0 = wc * 32 + 4 * fq;
        float* base = C + (size_t)u.e * 2048 * 256;
#pragma unroll
        for (int ai = 0; ai < 2; ++ai)
#pragma unroll
            for (int m = 0; m < 4; ++m) { float* rowp = base + (size_t)(row0 + ai * HALF + m * 16) * 256 + col0;
#pragma unroll
                for (int bj = 0; bj < 2; ++bj)
#pragma unroll
                    for (int n = 0; n < 2; ++n) *(f32x4*)(rowp + bj * HALF + n * 16) = acc[ai][bj][m][n]; }
    }
};
DI float clamp8(float v) { return __builtin_amdgcn_fmed3f(v, -448.f, 448.f); }
DI unsigned fp8x4(float a, float b, float c, float d) { int w = 0; w = __builtin_amdgcn_cvt_pk_fp8_f32(clamp8(a), clamp8(b), w, false); w = __builtin_amdgcn_cvt_pk_fp8_f32(clamp8(c), clamp8(d), w, true); return (unsigned)w; }
constexpr float W8_SCALE = 256.f, W8_INV = 1.f / 256.f, A8_SCALE = 16.f, A8W8_INV = 1.f / 4096.f, Y8_SCALE = 32.f, Y8_INV = 1.f / 32.f;
template <bool ADD> struct EpiMerge {
    static constexpr bool PERM = true; bf16_t* P; unsigned char* O8; const bf16_t* Z; int gcol0; float scale;
    DI void operator()(const Acc& acc, const Unit& u, int wr, int wc, int fr, int fq) const {
        const int row0 = u.pm * BM + wr * 64 + fr, col0 = u.pn * BM + wc * 32 + 8 * fq;
#pragma unroll
        for (int ai = 0; ai < 2; ++ai) {
            u32x4 gz[4][2], pz[4][2];
#pragma unroll
            for (int m = 0; m < 4; ++m) { const size_t row = (size_t)(row0 + ai * HALF + m * 16);
#pragma unroll
                for (int bj = 0; bj < 2; ++bj) { const int col = col0 + bj * HALF; gz[m][bj] = *(const u32x4*)(Z + row * ZC + gcol0 + col); if (ADD) pz[m][bj] = *(const u32x4*)(P + row * D + col); } }
#pragma unroll
            for (int m = 0; m < 4; ++m) { const size_t row = (size_t)(row0 + ai * HALF + m * 16);
#pragma unroll
                for (int bj = 0; bj < 2; ++bj) { const int col = col0 + bj * HALF;
                    float g[8], o[8]; unpack8(gz[m][bj], g);
                    const f32x4 v0 = acc[ai][bj][m][0] * scale, v1 = acc[ai][bj][m][1] * scale;
                    if (ADD) unpack8(pz[m][bj], o);
#pragma unroll
                    for (int j = 0; j < 8; ++j) { const float a = j < 4 ? v0[j & 3] : v1[j & 3]; o[j] = (ADD ? o[j] : 0.f) + sigmoidf_(g[j]) * a; }
                    if (ADD) *(u32x2*)(O8 + row * D + col) = (u32x2){fp8x4(o[0] * A8_SCALE, o[1] * A8_SCALE, o[2] * A8_SCALE, o[3] * A8_SCALE), fp8x4(o[4] * A8_SCALE, o[5] * A8_SCALE, o[6] * A8_SCALE, o[7] * A8_SCALE)};
                    else *(u32x4*)(P + row * D + col) = (u32x4){pk2(o[0], o[1]), pk2(o[2], o[3]), pk2(o[4], o[5]), pk2(o[6], o[7])}; } }
        }
    }
};
struct EpiGU {
    static constexpr bool PERM = true; unsigned char* O; const float* bias;
    DI void operator()(const Acc& acc, const Unit& u, int wr, int wc, int fr, int fq) const {
        const int row0 = u.pm * BM + wr * 64 + fr, c0 = u.pn * HALF + wc * 32 + 8 * fq;
        const float* bg = bias + (size_t)u.e * 4096 + c0; const float* bu = bg + 2048;
        float bgv[8], buv[8];
#pragma unroll
        for (int j = 0; j < 8; ++j) { bgv[j] = bg[j]; buv[j] = bu[j]; }
#pragma unroll
        for (int ai = 0; ai < 2; ++ai)
#pragma unroll
            for (int m = 0; m < 4; ++m) { unsigned char* rowp = O + (size_t)(row0 + ai * HALF + m * 16) * D + c0;
                float o[8];
#pragma unroll
                for (int j = 0; j < 8; ++j) { float gt = (j < 4 ? acc[ai][0][m][0][j & 3] : acc[ai][0][m][1][j & 3]) * W8_INV + bgv[j];
                    float up = (j < 4 ? acc[ai][1][m][0][j & 3] : acc[ai][1][m][1][j & 3]) * W8_INV + buv[j];
                    gt = fminf(gt, 7.f); up = fminf(fmaxf(up, -7.f), 7.f);
                    o[j] = gt * sigmoidf_(1.702f * gt) * (up + 1.f); }
                *(u32x2*)rowp = (u32x2){fp8x4(o[0], o[1], o[2], o[3]), fp8x4(o[4], o[5], o[6], o[7])}; }
    }
};
struct EpiDN {
    static constexpr bool PERM = true; unsigned char* O; const float* bias; const float* slotw;
    DI void operator()(const Acc& acc, const Unit& u, int wr, int wc, int fr, int fq) const {
        const int row0 = u.pm * BM + wr * 64 + fr, col0 = u.pn * BM + wc * 32 + 8 * fq;
        float bv[2][8];
#pragma unroll
        for (int bj = 0; bj < 2; ++bj)
#pragma unroll
            for (int j = 0; j < 8; ++j) bv[bj][j] = bias[(size_t)u.e * D + col0 + bj * HALF + j];
        float sw[2][4];
#pragma unroll
        for (int ai = 0; ai < 2; ++ai)
#pragma unroll
            for (int m = 0; m < 4; ++m) sw[ai][m] = slotw[row0 + ai * HALF + m * 16];
#pragma unroll
        for (int ai = 0; ai < 2; ++ai)
#pragma unroll
            for (int m = 0; m < 4; ++m) { const int row = row0 + ai * HALF + m * 16; const float w = sw[ai][m] * Y8_SCALE; unsigned char* rowp = O + (size_t)row * D + col0;
#pragma unroll
                for (int bj = 0; bj < 2; ++bj) { float o[8];
#pragma unroll
                    for (int j = 0; j < 8; ++j) o[j] = ((j < 4 ? acc[ai][bj][m][0][j & 3] : acc[ai][bj][m][1][j & 3]) * W8_INV + bv[bj][j]) * w;
                    *(u32x2*)(rowp + bj * HALF) = (u32x2){fp8x4(o[0], o[1], o[2], o[3]), fp8x4(o[4], o[5], o[6], o[7])}; } }
    }
};
struct C1Sched {
    int G, c; const char* kvs; const char* w;
    DI bool next(int i, Unit& u) const {
        const int L = i * G + c; if (L >= 256) return false;
        const int kv = L >> 7, s = (L >> 3) & 15, pm = L & 7;
        u.pm = pm; u.pn = 0; u.e = s * 2 + kv;
        u.a = kvs + ((size_t)kv * KVS_ONE + (size_t)pm * 256 * 2048 + (size_t)s * 256) * 2;
        u.b = w + ((size_t)kv * 256 * 4096 + (size_t)s * 256) * 2; return true;
    }
};
struct MoeSched {
    int G, c, nN, total; const LAS int* tile_e; const char* A; const char* W; size_t w_exp;
    DI bool next(int i, Unit& u) const {
        const int L = i * G + c; if (L >= total) return false;
        const int mt = L / nN, pn = L - mt * nN; const int e = __builtin_amdgcn_readfirstlane(tile_e[mt]);
        u.pm = mt; u.pn = pn; u.e = e;
        u.a = A + (size_t)mt * 256 * D; u.b = W + (size_t)e * w_exp + (size_t)pn * 256 * D; return true;
    }
};
}

DI int colmap(int kind, int n) {
    if (kind == 0) return n;
    if (kind == 1) {
        if (n < 872) return n;
        if (n < 896) return 3432 + (n - 872);
        if (n < 1024) return -1;
        if (n < 2048) return 872 + (n - 1024);
        if (n < 3584) return 1896 + (n - 2048);
        return 3456 + (n - 3584);
    }
    if (kind == 2) { const int pn = n >> 8, r = n & 255; return r < 128 ? pn * 128 + r : 2048 + pn * 128 + (r - 128); }
    if (kind == 4) return n < 32 ? n : -1;
    { const int h = n >> 5, d = n & 31; return h * 128 + d; }
}
struct TrJob { const float* src; bf16_t* dst; int ldsrc, lddst, kind, k0, n0, dk0, dn0; };
DI void tr_load(const TrJob& j, f32x4 (&v)[8], int t) {
    const int c4 = t & 63, r0 = t >> 6; const int sc = colmap(j.kind, j.n0 + 4 * c4);
#pragma unroll
    for (int q = 0; q < 8; ++q) v[q] = (f32x4){0.f, 0.f, 0.f, 0.f};
    if (sc >= 0) {
#pragma unroll
        for (int q = 0; q < 8; ++q) v[q] = __builtin_nontemporal_load((const f32x4*)(j.src + (size_t)(j.k0 + r0 + 8 * q) * j.ldsrc + sc));
    }
}
DI void tr_lds_write(const f32x4 (&v)[8], float* tile, int t) {
    const int c4 = t & 63, r0 = t >> 6;
#pragma unroll
    for (int q = 0; q < 8; ++q) { float* tp = tile + (r0 + 8 * q) * 257 + 4 * c4; tp[0] = v[q][0]; tp[1] = v[q][1]; tp[2] = v[q][2]; tp[3] = v[q][3]; }
}
DI void tr_store(const TrJob& j, const float* tile, int t) {
    const int kk8 = (t & 7) * 8, nb = t >> 3;
#pragma unroll
    for (int ps = 0; ps < 4; ++ps) { const int nn = nb + 64 * ps; const float* s = tile + kk8 * 257 + nn;
        u32x4 o = {pk2(s[0], s[257]), pk2(s[2 * 257], s[3 * 257]), pk2(s[4 * 257], s[5 * 257]), pk2(s[6 * 257], s[7 * 257])};
        *(u32x4*)(j.dst + (size_t)(j.n0 + nn) * j.lddst + j.k0 + kk8) = o; }
}
DI void tr_setup(TrJob& j, int u, int nK, const float* src, int ldsrc, int kind, bf16_t* dst, int lddst) {
    const int kt = u % nK, ntile = u / nK; j.src = src; j.dst = dst; j.ldsrc = ldsrc; j.lddst = lddst; j.kind = kind; j.k0 = kt * 64; j.n0 = ntile * 256;
}
DI float tr8_load(const TrJob& j, f32x4 (&v)[8], int t) {
    const int c4 = t & 31, r0 = t >> 5; const int sc = colmap(j.kind, j.n0 + 4 * c4); const int scc = sc < 0 ? 0 : sc;
#pragma unroll
    for (int q = 0; q < 8; ++q) v[q] = __builtin_nontemporal_load((const f32x4*)(j.src + (size_t)(j.k0 + r0 + 16 * q) * j.ldsrc + scc));
    return sc < 0 ? 0.f : 1.f;
}
DI void tr8_lds_write(const f32x4 (&v)[8], float ok, float* tile, int t) {
    const int c4 = t & 31, r0 = t >> 5;
#pragma unroll
    for (int q = 0; q < 8; ++q) { float* tp = tile + (r0 + 16 * q) * 129 + 4 * c4; tp[0] = v[q][0] * ok; tp[1] = v[q][1] * ok; tp[2] = v[q][2] * ok; tp[3] = v[q][3] * ok; }
}
DI void tr8_store(const TrJob& j, const float* tile, int t) {
    const int kc = t & 7, nb = t >> 3; constexpr float SC = pg8::W8_SCALE;
#pragma unroll
    for (int ps = 0; ps < 2; ++ps) { const int nn = nb + 64 * ps; const float* s = tile + (16 * kc) * 129 + nn;
        u32x4 o = {pg8::fp8x4(s[0] * SC, s[129] * SC, s[2 * 129] * SC, s[3 * 129] * SC), pg8::fp8x4(s[4 * 129] * SC, s[5 * 129] * SC, s[6 * 129] * SC, s[7 * 129] * SC),
                   pg8::fp8x4(s[8 * 129] * SC, s[9 * 129] * SC, s[10 * 129] * SC, s[11 * 129] * SC), pg8::fp8x4(s[12 * 129] * SC, s[13 * 129] * SC, s[14 * 129] * SC, s[15 * 129] * SC)};
        __builtin_nontemporal_store(o, (u32x4*)((unsigned char*)j.dst + (size_t)(j.dn0 + nn) * j.lddst + j.dk0 + 16 * kc)); }
}
DI void phase_prep(const Params& p, char* smem) {
    float* tile = (float*)smem;
    const int t = tid_fresh(), G = gridDim.x;
    constexpr int U_ADA = 256, U_ABS = 256, U_WO = 512, U_CB = 128, SPECIAL = U_ADA + U_ABS + U_WO + U_CB;
    constexpr int U_WINB = 32 * 8, U_WIN = 16 * 44, U_IDXQ = 8 * 2, U_UQR = 8, U_BRB = 16 * 8, U_OUT = 32 * 8, U_C1 = 64, U_RT = 32, U_GU = 32 * 16, U_DN = 32 * 8;
    constexpr int NTR = U_WINB + U_IDXQ + U_UQR + 2 * U_C1 + U_RT, NTR8 = U_WIN + U_BRB + U_OUT + NEXP * (U_GU + U_DN);
    bf16_t* Wq = (bf16_t*)(p.ws + O_WQ);
    for (int rp_ = 0; rp_ < ((PREP_REP & 1) ? 2 : 1); ++rp_)
    for (int u0 = blockIdx.x; u0 < SPECIAL; u0 += G) {
        int u = u0;
        if (rp_ == 1 && (u0 < PREP_REP_LO || u0 >= PREP_REP_HI)) continue;
        if (u < U_ADA) {
            const int c4 = t % 12, kg = t / 12; f32x4 a0 = {0.f, 0.f, 0.f, 0.f}, a1 = {0.f, 0.f, 0.f, 0.f};
            if (kg < 42) { const int col = u * 48 + c4 * 4;
#pragma unroll 7
                for (int k = kg; k < 2048; k += 42) { const float c0 = p.c[k], c1 = p.c[2048 + k]; const float s0 = c0 * sigmoidf_(c0), s1 = c1 * sigmoidf_(c1);
                    const f32x4 w = *(const f32x4*)(p.w_ada + (size_t)k * 12288 + col); a0 += w * s0; a1 += w * s1; } }
            __syncthreads();
            if (kg < 42) { float* tp = tile + (kg * 12 + c4) * 8;
#pragma unroll
                for (int j = 0; j < 4; ++j) { tp[j] = a0[j]; tp[4 + j] = a1[j]; } }
            __syncthreads();
            if (t < 96) { const int bb = t / 48, cc = t % 48; float acc = 0.f;
                for (int g2 = 0; g2 < 42; ++g2) acc += tile[(g2 * 12 + (cc >> 2)) * 8 + bb * 4 + (cc & 3)];
                ((float*)(p.ws + O_MODACC))[bb * 12288 + u * 48 + cc] = acc + p.b_ada[u * 48 + cc]; }
            continue; }
        u -= U_ADA;
        if (u < U_ABS) {
            const int h = u >> 5, w = __builtin_amdgcn_readfirstlane(t >> 6), l = t & 63, c = (u & 31) * 8 + w;
            const float* ukp = p.a_w_uk + (size_t)c * 768 + h * 96;
            float acc[8];
#pragma unroll
            for (int j = 0; j < 8; ++j) acc[j] = 0.f;
#pragma unroll 1
            for (int ch = 0; ch < 3; ++ch) {
                __syncthreads();
#pragma unroll
                for (int q = 0; q < 8; ++q) { const int r = (t >> 3) + 64 * q;
                    *(f32x4*)(tile + r * 36 + 4 * (t & 7)) = *(const f32x4*)(p.a_w_uq + (size_t)r * 1024 + h * 128 + 32 + ch * 32 + 4 * (t & 7)); }
                __syncthreads();
#pragma unroll 2
                for (int n4 = 0; n4 < 8; ++n4) { const float k0 = ukp[ch * 32 + 4 * n4], k1 = ukp[ch * 32 + 4 * n4 + 1], k2 = ukp[ch * 32 + 4 * n4 + 2], k3 = ukp[ch * 32 + 4 * n4 + 3];
#pragma unroll
                    for (int j = 0; j < 8; ++j) { const f32x4 x = *(const f32x4*)(tile + (l + 64 * j) * 36 + 4 * n4);
                        acc[j] = __builtin_fmaf(x[0], k0, acc[j]); acc[j] = __builtin_fmaf(x[1], k1, acc[j]); acc[j] = __builtin_fmaf(x[2], k2, acc[j]); acc[j] = __builtin_fmaf(x[3], k3, acc[j]); } }
            }
#pragma unroll
            for (int j = 0; j < 8; ++j) Wq[(size_t)(h * 256 + c) * 512 + l + 64 * j] = f2bf(acc[j]);
            continue; }
        u -= U_ABS;
        if (u < U_WO) {
            const int n = (u & 3) * 512 + t, k0 = (u >> 2) * 16, h = k0 >> 8;
            __syncthreads();
            *(f32x4*)(tile + 4 * t) = *(const f32x4*)(p.a_w_uv + (size_t)k0 * 128 + 4 * t);
            __syncthreads();
            const float* wbp = p.w_br_a + (size_t)(h * 128) * D + n;
            float acc[16];
#pragma unroll
            for (int j = 0; j < 16; ++j) acc[j] = 0.f;
#pragma unroll 2
            for (int v0 = 0; v0 < 128; v0 += 8) { float wb[8];
#pragma unroll
                for (int i = 0; i < 8; ++i) wb[i] = wbp[(size_t)(v0 + i) * D];
#pragma unroll
                for (int j = 0; j < 16; ++j) { const f32x4 a = *(const f32x4*)(tile + j * 128 + v0), b = *(const f32x4*)(tile + j * 128 + v0 + 4);
                    acc[j] = __builtin_fmaf(a[0], wb[0], acc[j]); acc[j] = __builtin_fmaf(a[1], wb[1], acc[j]); acc[j] = __builtin_fmaf(a[2], wb[2], acc[j]); acc[j] = __builtin_fmaf(a[3], wb[3], acc[j]);
                    acc[j] = __builtin_fmaf(b[0], wb[4], acc[j]); acc[j] = __builtin_fmaf(b[1], wb[5], acc[j]); acc[j] = __builtin_fmaf(b[2], wb[6], acc[j]); acc[j] = __builtin_fmaf(b[3], wb[7], acc[j]); } }
            constexpr float SW = pg8::W8_SCALE;
            *(u32x4*)((unsigned char*)(p.ws + O_WO) + (size_t)n * D + k0) = (u32x4){pg8::fp8x4(acc[0] * SW, acc[1] * SW, acc[2] * SW, acc[3] * SW), pg8::fp8x4(acc[4] * SW, acc[5] * SW, acc[6] * SW, acc[7] * SW),
                pg8::fp8x4(acc[8] * SW, acc[9] * SW, acc[10] * SW, acc[11] * SW), pg8::fp8x4(acc[12] * SW, acc[13] * SW, acc[14] * SW, acc[15] * SW)};
            continue; }
        u -= U_WO;
        {
            const int kv = u >> 6, seg = u & 63;
            if (t < 256) { const float* pe = kv ? p.cmp_v_pe : p.cmp_k_pe; const float* w1 = kv ? p.cmp_v_w1 : p.cmp_k_w1; float a = 0.f;
#pragma unroll 16
                for (int i = seg * 64; i < seg * 64 + 64; ++i) a += pe[i] * w1[(size_t)i * 256 + t];
                ((float*)(p.ws + O_CBP))[(seg * 2 + kv) * 256 + t] = a; } }
    }
    auto setup = [&](TrJob& j, int u) {
        if (u < U_WINB) { tr_setup(j, u, 32, p.w_in, 7552, 1, (bf16_t*)(p.ws + O_WIN), D); return; } u -= U_WINB;
        if (u < U_IDXQ) { tr_setup(j, u, 8, p.idx_w_q, 512, 0, Wq + (size_t)2304 * 512, 512); return; } u -= U_IDXQ;
        if (u < U_UQR) { tr_setup(j, u, 8, p.a_w_uq, 1024, 3, Wq + (size_t)2048 * 512, 512); return; } u -= U_UQR;
        if (u < U_C1) { tr_setup(j, u, 64, p.cmp_k_w1, 256, 0, (bf16_t*)(p.ws + O_WC1), 4096); return; } u -= U_C1;
        if (u < U_C1) { tr_setup(j, u, 64, p.cmp_v_w1, 256, 0, (bf16_t*)(p.ws + O_WC1) + (size_t)256 * 4096, 4096); return; } u -= U_C1;
        tr_setup(j, u, 32, p.w_router, 32, 4, (bf16_t*)(p.ws + O_WRT), D);
    };
    auto setup8 = [&](TrJob& j, int u) {
        j.lddst = D;
        if (u < U_WIN) { j.src = p.w_in; j.ldsrc = 7552; j.kind = 1; j.dst = (bf16_t*)(p.ws + O_WIN8); j.k0 = (u & 15) * 128; j.n0 = 2048 + (u >> 4) * 128; j.dk0 = j.k0; j.dn0 = j.n0; return; } u -= U_WIN;
        if (u < U_BRB) { j.src = p.w_br_b; j.ldsrc = D; j.kind = 0; j.dst = (bf16_t*)(p.ws + O_WBRB); j.lddst = 1024; j.k0 = (u & 7) * 128; j.n0 = (u >> 3) * 128; j.dk0 = j.k0; j.dn0 = j.n0; return; } u -= U_BRB;
        if (u < U_OUT) { j.src = p.w_out; j.ldsrc = D; j.kind = 0; j.dst = (bf16_t*)(p.ws + O_WOUT); j.k0 = (u & 15) * 128; j.n0 = (u >> 4) * 128; j.dk0 = j.k0; j.dn0 = j.n0; return; } u -= U_OUT;
        const int e = u / (U_GU + U_DN), r = u - e * (U_GU + U_DN);
        if (r < U_GU) { j.src = p.w_gate_up + (size_t)e * D * 4096; j.ldsrc = 4096; j.kind = 2; j.dst = (bf16_t*)(p.ws + O_WGU + (size_t)e * 4096 * D + (size_t)r * 16384); j.k0 = (r & 15) * 128; j.n0 = (r >> 4) * 128; }
        else { const int r2 = r - U_GU; j.src = p.w_down + (size_t)e * D * D; j.ldsrc = D; j.kind = 0; j.dst = (bf16_t*)(p.ws + O_WDN + (size_t)e * D * D + (size_t)r2 * 16384); j.k0 = (r2 & 15) * 128; j.n0 = (r2 >> 4) * 128; }
        j.lddst = 128; j.dk0 = 0; j.dn0 = 0;
    };
    TrJob cur, nxt; f32x4 v[8];
    int u;
    for (int rp_ = 0; rp_ < ((PREP_REP & 2) ? 2 : 1); ++rp_) {
    u = blockIdx.x;
    if (u < NTR) { setup(cur, u); tr_load(cur, v, t); }
#pragma unroll 1
    for (; u < NTR; u += G) {
        __syncthreads();
        tr_lds_write(v, tile, t);
        __syncthreads();
        const bool more = u + G < NTR;
        if (more) { setup(nxt, u + G); tr_load(nxt, v, t); }
        tr_store(cur, tile, t);
        cur = nxt;
    }
    }
    auto clampu = [&](int x) { return x < NTR8 ? x : NTR8 - 1; };
    for (int rp_ = 0; rp_ < ((PREP_REP & 4) ? 2 : 1); ++rp_) {
    u = blockIdx.x;
    f32x4 v2[8]; float ok1, ok2;
    setup8(cur, clampu(u)); ok1 = tr8_load(cur, v, t);
    setup8(nxt, clampu(u + G)); ok2 = tr8_load(nxt, v2, t);
#pragma unroll 1
    for (; u < NTR8; u += 2 * G) {
        __syncthreads();
        tr8_lds_write(v, ok1, tile, t);
        __syncthreads();
        TrJob c = cur;
        setup8(cur, clampu(u + 2 * G)); ok1 = tr8_load(cur, v, t);
        tr8_store(c, tile, t);
        __syncthreads();
        tr8_lds_write(v2, ok2, tile, t);
        __syncthreads();
        c = nxt;
        setup8(nxt, clampu(u + 3 * G)); ok2 = tr8_load(nxt, v2, t);
        tr8_store(c, tile, t);
    }
    }
#if PREP_PROBE_MODE >= 2
    {
        unsigned chk = 0; unsigned char* dummy = (unsigned char*)(p.ws + O_HS);
        constexpr int U0 = U_WIN + U_BRB + U_OUT;
        TrJob pj, pn; f32x4 w[8]; float okp;
        int uu = U0 + blockIdx.x;
        setup8(pj, uu); okp = tr8_load(pj, w, t);
#pragma unroll 1
        for (; uu < NTR8; uu += G) {
#if PREP_PROBE_MODE == 2
            __syncthreads();
            tr8_lds_write(w, okp, tile, t);
            __syncthreads();
            setup8(pn, clampu(uu + G)); okp = tr8_load(pn, w, t);
            {   const int kc = t & 7, nb = t >> 3; constexpr float SC = pg8::W8_SCALE;
#pragma unroll
                for (int ps = 0; ps < 2; ++ps) { const int nn = nb + 64 * ps; const float* s = tile + (16 * kc) * 129 + nn;
                    chk ^= pg8::fp8x4(s[0] * SC, s[129] * SC, s[2 * 129] * SC, s[3 * 129] * SC) ^ pg8::fp8x4(s[4 * 129] * SC, s[5 * 129] * SC, s[6 * 129] * SC, s[7 * 129] * SC)
                         ^ pg8::fp8x4(s[8 * 129] * SC, s[9 * 129] * SC, s[10 * 129] * SC, s[11 * 129] * SC) ^ pg8::fp8x4(s[12 * 129] * SC, s[13 * 129] * SC, s[14 * 129] * SC, s[15 * 129] * SC); } }
            pj = pn;
#else
            u32x4 o0 = {pg8::fp8x4(w[0][0], w[0][1], w[0][2], w[0][3]), pg8::fp8x4(w[1][0], w[1][1], w[1][2], w[1][3]), pg8::fp8x4(w[2][0], w[2][1], w[2][2], w[2][3]), pg8::fp8x4(w[3][0], w[3][1], w[3][2], w[3][3])};
            u32x4 o1 = {pg8::fp8x4(w[4][0], w[4][1], w[4][2], w[4][3]), pg8::fp8x4(w[5][0], w[5][1], w[5][2], w[5][3]), pg8::fp8x4(w[6][0], w[6][1], w[6][2], w[6][3]), pg8::fp8x4(w[7][0], w[7][1], w[7][2], w[7][3])};
            setup8(pn, clampu(uu + G)); okp = tr8_load(pn, w, t);
            u32x4* dp = (u32x4*)(dummy + ((size_t)(uu - U0) * 512 + t) * 32); dp[0] = o0; dp[1] = o1;
            pj = pn;
#endif
        }
        if (chk == 0x12345678u && okp == 3.f) ((unsigned*)(p.ws + 115200))[0] = chk;
    }
#endif
#if PREP_PROBE_WC > 0
    {
        constexpr int WC = PREP_PROBE_WC, RW = WC / 4, RS = 512 / RW, R = 16384 / WC;
        float acc = 0.f; const int c4 = t % RW, r0 = t / RW;
#pragma unroll 1
        for (int pass = 0; pass < 2; ++pass) {
            const float* base = pass ? p.w_down : p.w_gate_up; const int ld = pass ? 2048 : 4096;
            const int nK = 65536 / R, ntiles = nK * (ld / WC);
#pragma unroll 1
            for (int uu = blockIdx.x; uu < ntiles; uu += G) {
#if PREP_PROBE_NFAST
                const int nN = ld / WC, nt_ = uu % nN, kt = uu / nN;
#else
                const int kt = uu % nK, nt_ = uu / nK;
#endif
                f32x4 w[8];
#pragma unroll
                for (int q = 0; q < 8; ++q) w[q] = __builtin_nontemporal_load((const f32x4*)(base + (size_t)(kt * R + r0 + RS * q) * ld + nt_ * WC + 4 * c4));
#pragma unroll
                for (int q = 0; q < 8; ++q) acc += (w[q][0] + w[q][1]) + (w[q][2] + w[q][3]);
            }
        }
        if (acc == 12345.678f) ((float*)(p.ws + 115200))[0] = acc;
    }
#endif
}

DI void phase_h1(const Params& p) {
    const int tz_ = tid_fresh(); const int lane = tz_ & 63, wid = __builtin_amdgcn_readfirstlane(tz_ >> 6);
    if (blockIdx.x == 0) { float a = 0.f; const float* cbp = (const float*)(p.ws + O_CBP);
        for (int sg = 0; sg < 64; ++sg) a += cbp[sg * 512 + tz_];
        ((float*)(p.ws + O_CBIAS))[tz_] = a; }
    bf16_t* H = (bf16_t*)(p.ws + O_H); float* rope = (float*)(p.ws + O_ROPE);
    for (int tok = blockIdx.x * 8 + wid; tok < NT; tok += gridDim.x * 8) {
        const int b = tok >> 13;
        const f32x4* xr = (const f32x4*)(p.x + (size_t)tok * D) + lane;
        f32x4 v[8]; float ss = 0.f;
#pragma unroll
        for (int i = 0; i < 8; ++i) { v[i] = xr[64 * i]; ss += v[i][0] * v[i][0] + v[i][1] * v[i][1] + v[i][2] * v[i][2] + v[i][3] * v[i][3]; }
        const float rs = rsqrtf(wave_sum(ss) * (1.f / D) + NORM_EPS);
#pragma unroll
        for (int i = 0; i < 8; ++i) { const int col = 4 * (lane + 64 * i); float o[4];
#pragma unroll
            for (int j = 0; j < 4; ++j) o[j] = v[i][j] * rs * p.g_pre_mix[col + j] * (1.f + mod_at(p, b, 2048 + col + j)) + mod_at(p, b, col + j);
            *(u32x2*)(H + (size_t)tok * D + col) = (u32x2){pk2(o[0], o[1]), pk2(o[2], o[3])};
            *(unsigned*)((unsigned char*)(p.ws + O_H8) + (size_t)tok * D + col) = pg8::fp8x4(o[0], o[1], o[2], o[3]); }
        if (lane < 24) { const float fr = lane < 16 ? (float)(2 * lane) * (1.f / 32.f) : (float)(2 * (lane - 16)) * (1.f / 16.f);
            const float inv = exp2f(-fr * 18.931568569324174f);
            const float ang = (float)p.pos[tok] * inv; float s, c; sincosf(ang, &s, &c);
            rope[(size_t)tok * 48 + 2 * lane] = c; rope[(size_t)tok * 48 + 2 * lane + 1] = s; }
    }
}

DI void phase_zpost(const Params& p) {
    const int tz_ = tid_fresh(); const int lane = tz_ & 63, wid = __builtin_amdgcn_readfirstlane(tz_ >> 6);
    const bf16_t* Z = (const bf16_t*)(p.ws + O_Z); const float* rope = (const float*)(p.ws + O_ROPE);
    bf16_t* cqn = (bf16_t*)(p.ws + O_CQN); bf16_t* kvt = (bf16_t*)(p.ws + O_KVT); bf16_t* kidx = (bf16_t*)(p.ws + O_KIDX);
    float* widx = (float*)(p.ws + O_WIDX); float* gates = (float*)(p.ws + O_GATES); bf16_t* bq = (bf16_t*)(p.ws + O_BQ); bf16_t* kvs = (bf16_t*)(p.ws + O_KVS);
    for (int tok = blockIdx.x * 8 + wid; tok < NT; tok += gridDim.x * 8) {
        const int b = tok >> 13, tq = tok & (T - 1);
        const bf16_t* zr = Z + (size_t)tok * ZC; const float* rt = rope + (size_t)tok * 48;
        {
            float f[8]; unpack8(*(const u32x4*)(zr + lane * 8), f); float ss = 0.f;
#pragma unroll
            for (int j = 0; j < 8; ++j) ss += f[j] * f[j];
            const float rs = rsqrtf(wave_sum(ss) * (1.f / 512.f) + NORM_EPS);
#pragma unroll
            for (int j = 0; j < 8; ++j) f[j] = f[j] * rs * p.a_cq_norm[lane * 8 + j];
            *(u32x4*)(cqn + (size_t)tok * 512 + lane * 8) = (u32x4){pk2(f[0], f[1]), pk2(f[2], f[3]), pk2(f[4], f[5]), pk2(f[6], f[7])};
        }
        {
            const u32x2 w = *(const u32x2*)(zr + ZC_CKV + lane * 4); float f[4] = {bflo(w[0]), bfhi(w[0]), bflo(w[1]), bfhi(w[1])};
            const float rs = rsqrtf(wave_sum(f[0] * f[0] + f[1] * f[1] + f[2] * f[2] + f[3] * f[3]) * (1.f / 256.f) + NORM_EPS);
#pragma unroll
            for (int j = 0; j < 4; ++j) f[j] = f[j] * rs * p.a_ckv_norm[lane * 4 + j];
            *(u32x2*)(kvt + (size_t)tok * KVW + lane * 4) = (u32x2){pk2(f[0], f[1]), pk2(f[2], f[3])};
        }
        if (lane < 16) {
            const float x1 = bf2f(zr[ZC_KROPE + lane]), x2 = bf2f(zr[ZC_KROPE + 16 + lane]), c = rt[2 * lane], s = rt[2 * lane + 1];
            kvt[(size_t)tok * KVW + 256 + lane] = f2bf(x1 * c - x2 * s); kvt[(size_t)tok * KVW + 272 + lane] = f2bf(x2 * c + x1 * s);
        }
        {
            const float v = bf2f(zr[ZC_KIDX + lane]); const float mean = wave_sum(v) * (1.f / 64.f); const float xc = v - mean;
            const float var = wave_sum(xc * xc) * (1.f / 64.f);
            const float y = xc * rsqrtf(var + NORM_EPS) * p.idx_g[lane] + p.idx_b[lane];
            const float pr = __shfl_xor(y, 8); float o = y;
            if (lane < 8) o = y * rt[32 + 2 * lane] - pr * rt[33 + 2 * lane];
            else if (lane < 16) o = y * rt[32 + 2 * (lane - 8)] + pr * rt[33 + 2 * (lane - 8)];
            kidx[(size_t)tok * 64 + lane] = f2bf(o);
        }
        if (lane < 8) widx[(size_t)tok * 8 + lane] = bf2f(zr[ZC_WIDX + lane]) * (0.35355339059327373f * 0.125f);
        if (lane < 24) gates[(size_t)tok * 24 + lane] = sigmoidf_(bf2f(zr[ZC_BGATE + lane]));
#pragma unroll
        for (int ps = 0; ps < 3; ++ps) { const int slot = ps * 64 + lane;
            if (slot < 160) { const int hh = slot >> 3, part = slot & 7; const bf16_t* src = zr + ZC_BQ + hh * 128 + part * 16;
                float f[16]; { float a[8], c[8]; unpack8(*(const u32x4*)src, a); unpack8(*(const u32x4*)(src + 8), c);
#pragma unroll
                    for (int j = 0; j < 8; ++j) { f[j] = a[j]; f[8 + j] = c[j]; } }
                const bool dorope = hh < 8 || (((hh - 8) >> 1) & 1) == 0;
                if (dorope && part < 2) { const bf16_t* os = part == 0 ? src + 16 : src - 16; float g[16];
                    { float a[8], c[8]; unpack8(*(const u32x4*)os, a); unpack8(*(const u32x4*)(os + 8), c);
#pragma unroll
                      for (int j = 0; j < 8; ++j) { g[j] = a[j]; g[8 + j] = c[j]; } }
#pragma unroll
                    for (int i = 0; i < 16; ++i) { const float c = rt[2 * i], s = rt[2 * i + 1]; f[i] = part == 0 ? f[i] * c - g[i] * s : f[i] * c + g[i] * s; } }
                bf16_t* dst;
                if (hh < 8) dst = bq + (size_t)tok * 1024 + hh * 128 + part * 16;
                else { const int i6 = (hh - 8) >> 1, g = (hh - 8) & 1; dst = kvs + ((((size_t)i6 * NB + b) * 2 + g) * T + tq) * 128 + part * 16; }
                *(u32x4*)dst = (u32x4){pk2(f[0], f[1]), pk2(f[2], f[3]), pk2(f[4], f[5]), pk2(f[6], f[7])};
                *(u32x4*)(dst + 8) = (u32x4){pk2(f[8], f[9]), pk2(f[10], f[11]), pk2(f[12], f[13]), pk2(f[14], f[15])}; } }
    }
}

DI void c2_rows(const Params& p, char* smem) {
    const int tz_ = tid_fresh(); const int lane = tz_ & 63, wid = __builtin_amdgcn_readfirstlane(tz_ >> 6);
    float* hrow = (float*)smem + wid * 256;
    const float* c1p = (const float*)(p.ws + O_C1P); const float* cb = (const float*)(p.ws + O_CBIAS); bf16_t* kcvc = (bf16_t*)(p.ws + O_KCVC);
    for (int row = blockIdx.x * 8 + wid; row < 4096; row += gridDim.x * 8) {
        const int kv = row >> 11, r = row & 2047, n = r & 511;
        f32x4 a = *(const f32x4*)(cb + kv * 256 + lane * 4);
#pragma unroll
        for (int s = 0; s < 16; ++s) a += *(const f32x4*)(c1p + ((size_t)(s * 2 + kv) * 2048 + r) * 256 + lane * 4);
#pragma unroll
        for (int j = 0; j < 4; ++j) { const float v = a[j]; const float u = 0.7978845608028654f * (v + 0.044715f * v * v * v); hrow[lane * 4 + j] = 0.5f * v * (1.f + tanhf(u)); }
        asm volatile("s_waitcnt lgkmcnt(0)" ::: "memory");
        const float* w2 = kv ? p.cmp_v_w2 : p.cmp_k_w2;
        float o0 = 0.f, o1 = 0.f;
#pragma unroll 16
        for (int j = 0; j < 256; ++j) { const float hv = hrow[j]; const float2 w = *(const float2*)(w2 + j * 128 + lane * 2); o0 += hv * w.x; o1 += hv * w.y; }
        if (n == 511) { o0 = 0.f; o1 = 0.f; }
        *(unsigned*)(kcvc + (size_t)row * 128 + lane * 2) = pk2(o0, o1);
        asm volatile("s_waitcnt lgkmcnt(0)" ::: "memory");
    }
}

DI unsigned short f16key(float v) { const _Float16 h = (_Float16)v; unsigned short u = __builtin_bit_cast(unsigned short, h); return (u & 0x8000u) ? (unsigned short)~u : (unsigned short)(u | 0x8000u); }
DI void topk256_select(const LAS unsigned* scw, int nk, unsigned short* out, int lane) {
    const int nw = (nk + 127) >> 7;
    auto ldk = [&](int i) -> unsigned { const int wi = i * 64 + lane; unsigned v = scw[wi]; if (2 * wi >= nk) v = 0u; else if (2 * wi + 1 >= nk) v &= 0xffffu; return v; };
    unsigned Tv = 0u;
    for (int bit = 15; bit >= 0; --bit) { const unsigned cand = Tv | (1u << bit); int cnt = 0;
#pragma unroll 4
        for (int i = 0; i < nw; ++i) { const unsigned kv = ldk(i); cnt += __popcll(__ballot((kv & 0xffffu) >= cand)) + __popcll(__ballot((kv >> 16) >= cand)); }
        if (cnt >= 256) Tv = cand; }
    int cgt = 0;
#pragma unroll 4
    for (int i = 0; i < nw; ++i) { const unsigned kv = ldk(i); cgt += __popcll(__ballot((kv & 0xffffu) > Tv)) + __popcll(__ballot((kv >> 16) > Tv)); }
    const int need = 256 - cgt; int pos = 0, eqc = 0;
    const unsigned long long ltm = (1ull << lane) - 1ull;
#pragma unroll 2
    for (int i = 0; i < nw; ++i) {
        const unsigned kv = ldk(i); const unsigned lo = kv & 0xffffu, hi = kv >> 16;
        const bool elo = lo == Tv, ehi = hi == Tv;
        const unsigned long long mlo = __ballot(elo), mhi = __ballot(ehi);
        const int below = __popcll(mlo & ltm) + __popcll(mhi & ltm);
        const bool slo = lo > Tv || (elo && eqc + below < need), shi = hi > Tv || (ehi && eqc + below + (elo ? 1 : 0) < need);
        const unsigned long long s0 = __ballot(slo), s1 = __ballot(shi);
        const int plo = pos + __popcll(s0 & ltm), phi = pos + __popcll(s0) + __popcll(s1 & ltm);
        const int kidx = 2 * (i * 64 + lane);
        if (slo) out[plo] = (unsigned short)kidx;
        if (shi) out[phi] = (unsigned short)(kidx + 1);
        pos += __popcll(s0) + __popcll(s1); eqc += __popcll(mlo) + __popcll(mhi); }
}
DI void phase_indexer(const Params& p, char* smem) {
    const int tz_ = tid_fresh(); const int lane = tz_ & 63, wid = __builtin_amdgcn_readfirstlane(tz_ >> 6);
    LAS unsigned short* sc = (LAS unsigned short*)(LAS char*)smem + wid * 8192;
    float* qf = (float*)(smem + 131072) + wid * 512;
    const bf16_t* Q = (const bf16_t*)(p.ws + O_QALL); const bf16_t* KI = (const bf16_t*)(p.ws + O_KIDX); const float* WI = (const float*)(p.ws + O_WIDX);
    unsigned short* SEL = (unsigned short*)(p.ws + O_SEL); int* NSEL = (int*)(p.ws + O_NSEL);
    for (int tok = (int)(NT / 8 - 1 - blockIdx.x) * 8 + wid; tok >= 0; tok -= gridDim.x * 8) {
        const int b = tok >> 13, tq = tok & (T - 1), nk = tq + 1;
        unsigned short* out = SEL + (size_t)tok * 256;
        if (nk <= 256) { for (int i = lane; i < 256; i += 64) out[i] = (unsigned short)(i < nk ? i : 0); if (lane == 0) NSEL[tok] = nk; continue; }
        { float f[8]; unpack8(*(const u32x4*)(Q + (size_t)tok * QC + 2304 + lane * 8), f);
#pragma unroll
          for (int j = 0; j < 8; ++j) qf[lane * 8 + j] = f[j]; }
        float wh[8];
#pragma unroll
        for (int h = 0; h < 8; ++h) wh[h] = WI[(size_t)tok * 8 + h];
        asm volatile("s_waitcnt lgkmcnt(0)" ::: "memory");
        for (int s = lane; s < nk; s += 64) {
            const bf16_t* kr = KI + ((size_t)b * T + s) * 64; float d[8];
#pragma unroll
            for (int h = 0; h < 8; ++h) d[h] = 0.f;
#pragma unroll 2
            for (int c = 0; c < 8; ++c) { float kf[8]; unpack8(*(const u32x4*)(kr + c * 8), kf);
#pragma unroll
                for (int h = 0; h < 8; ++h) { const f32x4 q0 = *(const f32x4*)(qf + h * 64 + c * 8), q1 = *(const f32x4*)(qf + h * 64 + c * 8 + 4);
                    d[h] += q0[0] * kf[0] + q0[1] * kf[1] + q0[2] * kf[2] + q0[3] * kf[3] + q1[0] * kf[4] + q1[1] * kf[5] + q1[2] * kf[6] + q1[3] * kf[7]; } }
            float score = 0.f;
#pragma unroll
            for (int h = 0; h < 8; ++h) score += wh[h] * fmaxf(d[h], 0.f);
            sc[s] = f16key(score); }
        asm volatile("s_waitcnt lgkmcnt(0)" ::: "memory");
        topk256_select((const LAS unsigned*)sc, nk, out, lane);
        if (lane == 0) NSEL[tok] = 256;
        asm volatile("s_waitcnt lgkmcnt(0)" ::: "memory");
    }
}

DI void phase_mla(const Params& p, char* smem) {
    const int tz_ = tid_fresh(); const int lane = tz_ & 63, wid = __builtin_amdgcn_readfirstlane(tz_ >> 6);
    float* qf = (float*)smem + wid * (8 * KVW + 8 * 256 + 128);
    float* pf = qf + 8 * KVW; unsigned short* selw = (unsigned short*)(pf + 8 * 256);
    const bf16_t* Q = (const bf16_t*)(p.ws + O_QALL); const bf16_t* KV = (const bf16_t*)(p.ws + O_KVT);
    const unsigned short* SEL = (const unsigned short*)(p.ws + O_SEL); const int* NSEL = (const int*)(p.ws + O_NSEL); bf16_t* OL = (bf16_t*)(p.ws + O_OLAT);
    for (int tok = blockIdx.x * 8 + wid; tok < NT; tok += gridDim.x * 8) {
        const int b = tok >> 13; const int cnt = NSEL[tok];
        const bf16_t* qr = Q + (size_t)tok * QC;
#pragma unroll 4
        for (int i = 0; i < 36; ++i) { const int e = lane + 64 * i;
            const int h = e / KVW, d = e - h * KVW; qf[e] = bf2f(d < 256 ? qr[h * 256 + d] : qr[2048 + h * 32 + (d - 256)]); }
        *(u32x2*)(selw + lane * 4) = *(const u32x2*)(SEL + (size_t)tok * 256 + lane * 4);
        asm volatile("s_waitcnt lgkmcnt(0)" ::: "memory");
        const bf16_t* rows[4];
#pragma unroll
        for (int j = 0; j < 4; ++j) { const int k = lane + 64 * j; const int idx = k < cnt ? selw[k] : 0; rows[j] = KV + ((size_t)b * T + idx) * KVW; }
        float acc[4][8];
#pragma unroll
        for (int j = 0; j < 4; ++j)
#pragma unroll
            for (int h = 0; h < 8; ++h) acc[j][h] = 0.f;
#pragma unroll 1
        for (int c = 0; c < 36; ++c) { float kf[4][8];
#pragma unroll
            for (int j = 0; j < 4; ++j) unpack8(*(const u32x4*)(rows[j] + c * 8), kf[j]);
#pragma unroll
            for (int h = 0; h < 8; ++h) { const f32x4 q0 = *(const f32x4*)(qf + h * KVW + c * 8), q1 = *(const f32x4*)(qf + h * KVW + c * 8 + 4);
#pragma unroll
                for (int j = 0; j < 4; ++j) acc[j][h] += q0[0] * kf[j][0] + q0[1] * kf[j][1] + q0[2] * kf[j][2] + q0[3] * kf[j][3] + q1[0] * kf[j][4] + q1[1] * kf[j][5] + q1[2] * kf[j][6] + q1[3] * kf[j][7]; } }
#pragma unroll
        for (int h = 0; h < 8; ++h) { float m = -INFINITY;
#pragma unroll
            for (int j = 0; j < 4; ++j) { acc[j][h] = (lane + 64 * j < cnt) ? acc[j][h] * ATT_SCALE : -INFINITY; m = fmaxf(m, acc[j][h]); }
            m = wave_max(m); float l = 0.f;
#pragma unroll
            for (int j = 0; j < 4; ++j) { acc[j][h] = (lane + 64 * j < cnt) ? __expf(acc[j][h] - m) : 0.f; l += acc[j][h]; }
            l = 1.f / fmaxf(wave_sum(l), 1e-30f);
#pragma unroll
            for (int j = 0; j < 4; ++j) pf[h * 256 + lane + 64 * j] = acc[j][h] * l; }
        asm volatile("s_waitcnt lgkmcnt(0)" ::: "memory");
        float o[8][4];
#pragma unroll
        for (int h = 0; h < 8; ++h)
#pragma unroll
            for (int j = 0; j < 4; ++j) o[h][j] = 0.f;
#pragma unroll 1
        for (int k0 = 0; k0 < 256; k0 += 8) { u32x2 vv[8];
#pragma unroll
            for (int kk = 0; kk < 8; ++kk) { const int k = k0 + kk; const int idx = k < cnt ? selw[k] : 0; vv[kk] = *(const u32x2*)(KV + ((size_t)b * T + idx) * KVW + lane * 4); }
#pragma unroll
            for (int kk = 0; kk < 8; ++kk) { const float v0 = bflo(vv[kk][0]), v1 = bfhi(vv[kk][0]), v2 = bflo(vv[kk][1]), v3 = bfhi(vv[kk][1]);
#pragma unroll
                for (int h = 0; h < 8; ++h) { const float ph = pf[h * 256 + k0 + kk]; o[h][0] += ph * v0; o[h][1] += ph * v1; o[h][2] += ph * v2; o[h][3] += ph * v3; } } }
#pragma unroll
        for (int h = 0; h < 8; ++h) *(u32x2*)(OL + (size_t)tok * D + h * 256 + lane * 4) = (u32x2){pk2(o[h][0], o[h][1]), pk2(o[h][2], o[h][3])};
        asm volatile("s_waitcnt lgkmcnt(0)" ::: "memory");
    }
}

DI void nsa_score(const bf16_t* kr, const float* qf, float (&s)[4]) {
#pragma unroll
    for (int j = 0; j < 4; ++j) s[j] = 0.f;
#pragma unroll 4
    for (int c = 0; c < 16; ++c) { float kf[8]; unpack8(*(const u32x4*)(kr + c * 8), kf);
#pragma unroll
        for (int j = 0; j < 4; ++j) { const f32x4 q0 = *(const f32x4*)(qf + j * 128 + c * 8), q1 = *(const f32x4*)(qf + j * 128 + c * 8 + 4);
            s[j] += q0[0] * kf[0] + q0[1] * kf[1] + q0[2] * kf[2] + q0[3] * kf[3] + q1[0] * kf[4] + q1[1] * kf[5] + q1[2] * kf[6] + q1[3] * kf[7]; } }
}
DI void phase_nsa(const Params& p, char* smem) {
    const int tz_ = tid_fresh(); const int lane = tz_ & 63, wid = __builtin_amdgcn_readfirstlane(tz_ >> 6);
    float* qf = (float*)smem + wid * (512 + 256 + 512 + 16); float* pb = qf + 512; float* psum = pb + 256; int* blk = (int*)(psum + 512);
    const bf16_t* BQ = (const bf16_t*)(p.ws + O_BQ); const bf16_t* kvs = (const bf16_t*)(p.ws + O_KVS); const bf16_t* kcvc = (const bf16_t*)(p.ws + O_KCVC);
    const float* gates = (const float*)(p.ws + O_GATES); bf16_t* OB = (bf16_t*)(p.ws + O_OB);
#pragma unroll 1
    for (int item = (NT * 2 / 8 - 1 - (int)blockIdx.x) * 8 + wid; item >= 0; item -= gridDim.x * 8) {
        const int tok = item >> 1, g = item & 1, b = tok >> 13, tq = tok & (T - 1);
        { float f[8]; unpack8(*(const u32x4*)(BQ + (size_t)tok * 1024 + g * 512 + lane * 8), f);
#pragma unroll
          for (int j = 0; j < 8; ++j) qf[lane * 8 + j] = f[j]; }
        asm volatile("s_waitcnt lgkmcnt(0)" ::: "memory");
        const size_t bg = (size_t)(b * 2 + g);
        const int nmax = tq >= 31 ? (tq - 31) >> 4 : -1;
        float res[4][2], o[4][2], m[4], l[4]; int ns = 0;
#pragma unroll
        for (int j = 0; j < 4; ++j) { res[j][0] = 0.f; res[j][1] = 0.f; }
#pragma unroll 1
        for (int step = 0; step < 4; ++step) {
            const int kind = step < 2 ? 0 : step - 1;
            const int mode = step == 0 ? 1 : (step == 1 ? 2 : 0);
            const bf16_t* kbase; const bf16_t* vbase; int nch;
            if (kind == 0) { kbase = kcvc + bg * 512 * 128; vbase = kcvc + (size_t)2048 * 128 + bg * 512 * 128; nch = 8; }
            else if (kind == 1) { kbase = kvs + (2 * (size_t)NB * 2 + bg) * T * 128; vbase = kvs + (3 * (size_t)NB * 2 + bg) * T * 128; nch = ns; }
            else { kbase = kvs + (4 * (size_t)NB * 2 + bg) * T * 128; vbase = kvs + (5 * (size_t)NB * 2 + bg) * T * 128; nch = 8; }
            if (mode != 2) {
#pragma unroll
                for (int j = 0; j < 4; ++j) { m[j] = -INFINITY; l[j] = 0.f; } }
#pragma unroll
            for (int j = 0; j < 4; ++j) { o[j][0] = 0.f; o[j][1] = 0.f; }
#pragma unroll 1
            for (int c = 0; c < nch; ++c) {
                int base, lim_lo, lim_hi;
                if (kind == 0) { base = 64 * c; lim_lo = 0; lim_hi = nmax; }
                else if (kind == 1) { base = blk[c] * 64; lim_lo = 0; lim_hi = tq; }
                else { base = tq - 511 + 64 * c; lim_lo = 0; lim_hi = tq; }
                const bool active = base <= lim_hi && base + 63 >= lim_lo;
                if (!active) { if (mode == 2) psum[c * 64 + lane] = 0.f; continue; }
                const int key = base + lane; const bool valid = key >= lim_lo && key <= lim_hi;
                float s[4]; nsa_score(kbase + (size_t)(key < 0 ? 0 : key) * 128, qf, s);
                float ps = 0.f;
#pragma unroll
                for (int j = 0; j < 4; ++j) {
                    const float sv = valid ? s[j] * ATT_SCALE : -INFINITY; float pj;
                    if (mode == 2) { pj = valid ? __expf(sv - m[j]) * l[j] : 0.f; ps += pj; }
                    else { const float mn = fmaxf(m[j], wave_max(sv));
                        const float alpha = (m[j] == -INFINITY) ? 0.f : __expf(m[j] - mn);
                        pj = (sv == -INFINITY) ? 0.f : __expf(sv - mn);
                        l[j] = l[j] * alpha + wave_sum(pj); m[j] = mn; o[j][0] *= alpha; o[j][1] *= alpha; }
                    pb[j * 64 + lane] = pj; }
                if (mode == 2) psum[c * 64 + lane] = ps;
                if (mode != 1) {
                    asm volatile("s_waitcnt lgkmcnt(0)" ::: "memory");
#pragma unroll 1
                    for (int k0 = 0; k0 < 64; k0 += 8) { unsigned vv[8];
#pragma unroll
                        for (int kk = 0; kk < 8; ++kk) { const int kx = base + k0 + kk; vv[kk] = *(const unsigned*)(vbase + (size_t)(kx < 0 ? 0 : kx) * 128 + lane * 2); }
#pragma unroll
                        for (int kk = 0; kk < 8; ++kk) { const float v0 = bflo(vv[kk]), v1 = bfhi(vv[kk]);
#pragma unroll
                            for (int j = 0; j < 4; ++j) { const float ph = pb[j * 64 + k0 + kk]; o[j][0] += ph * v0; o[j][1] += ph * v1; } } } }
                asm volatile("s_waitcnt lgkmcnt(0)" ::: "memory");
            }
            if (step == 0) {
#pragma unroll
                for (int j = 0; j < 4; ++j) { if (m[j] == -INFINITY) m[j] = 0.f; l[j] = 1.f / fmaxf(l[j], 1e-30f); }
                continue; }
#pragma unroll
            for (int j = 0; j < 4; ++j) { const float gt = gates[(size_t)tok * 24 + (g * 4 + j) * 3 + kind]; const float il = (mode == 2) ? gt : gt / fmaxf(l[j], 1e-30f);
                res[j][0] += il * o[j][0]; res[j][1] += il * o[j][1]; }
            if (step == 1) {
                asm volatile("s_waitcnt lgkmcnt(0)" ::: "memory");
                const int cur = tq >> 6; unsigned key[2];
#pragma unroll
                for (int hh = 0; hh < 2; ++hh) { const int mb = lane + 64 * hh; float imp = 0.f;
#pragma unroll
                    for (int d = -1; d < 4; ++d) { const int n = 4 * mb + d; if (n >= 0 && n < 512) imp += psum[n]; }
                    const bool adm = mb <= cur, forced = mb == 0 || mb == cur || mb == cur - 1;
                    key[hh] = !adm ? 0u : (forced ? (0xFF000000u | (unsigned)(127 - mb)) : ((((__float_as_uint(imp) >> 7) + 1u) << 7) | (unsigned)(127 - mb))); }
                unsigned Tv = 0u;
                for (int bit = 31; bit >= 0; --bit) { const unsigned cand = Tv | (1u << bit);
                    const int cnt = __popcll(__ballot(key[0] >= cand)) + __popcll(__ballot(key[1] >= cand)); if (cnt >= 16) Tv = cand; }
                if (Tv == 0u) Tv = 1u;
                const unsigned long long m0 = __ballot(key[0] >= Tv), m1 = __ballot(key[1] >= Tv);
                const unsigned long long ltm = (1ull << lane) - 1ull;
                if (key[0] >= Tv) blk[__popcll(m0 & ltm)] = lane;
                if (key[1] >= Tv) blk[__popcll(m0) + __popcll(m1 & ltm)] = lane + 64;
                ns = __popcll(m0) + __popcll(m1);
                asm volatile("s_waitcnt lgkmcnt(0)" ::: "memory"); }
        }
#pragma unroll
        for (int j = 0; j < 4; ++j) *(unsigned*)(OB + (size_t)tok * 1024 + (g * 4 + j) * 128 + lane * 2) = pk2(res[j][0], res[j][1]);
        asm volatile("s_waitcnt lgkmcnt(0)" ::: "memory");
    }
}

typedef float f32x16 __attribute__((ext_vector_type(16)));
typedef short s16x4 __attribute__((ext_vector_type(4)));
#define MFMA32(a, b, c) __builtin_amdgcn_mfma_f32_32x32x16_bf16((a), (b), (c), 0, 0, 0)
DI unsigned offb(unsigned row, unsigned ch) { return 256u * row + 16u * (ch ^ (((row & 3u) << 2) | ((row >> 2) & 3u))); }
DI unsigned cvt2(float a, float b) { typedef __bf16 b2 __attribute__((ext_vector_type(2))); typedef float f2 __attribute__((ext_vector_type(2))); const b2 r = __builtin_convertvector((f2){a, b}, b2); return __builtin_bit_cast(unsigned, r); }
DI bf16x8 pack_p(const f32x16& x, int s) {
    const u32x4 w = {cvt2(x[8 * s], x[8 * s + 1]), cvt2(x[8 * s + 2], x[8 * s + 3]), cvt2(x[8 * s + 4], x[8 * s + 5]), cvt2(x[8 * s + 6], x[8 * s + 7])};
    return __builtin_bit_cast(bf16x8, w);
}
DI void nsa_tile_dma(LAS char* kb, LAS char* vb, const bf16_t* kt, const bf16_t* vt, int tid, int w) {
#pragma unroll
    for (int i = 0; i < 2; ++i) { const int id = tid + 512 * i; const unsigned row = id >> 4, pos = id & 15; const unsigned ch = pos ^ (((row & 3u) << 2) | ((row >> 2) & 3u));
        const size_t so = (size_t)row * 128 + ch * 8; const unsigned lo = (unsigned)(i * 512 + w * 64) * 16u;
        __builtin_amdgcn_global_load_lds((const unsigned*)(kt + so), (LAS unsigned*)(kb + lo), 16, 0, 0);
        __builtin_amdgcn_global_load_lds((const unsigned*)(vt + so), (LAS unsigned*)(vb + lo), 16, 0, 0); }
}
#define NSA_TR8(R, A, OFF) asm volatile( \
    "ds_read_b64_tr_b16 %0, %8 offset:%16\n\tds_read_b64_tr_b16 %1, %9 offset:%16\n\tds_read_b64_tr_b16 %2, %10 offset:%16\n\tds_read_b64_tr_b16 %3, %11 offset:%16\n\t" \
    "ds_read_b64_tr_b16 %4, %12 offset:%16\n\tds_read_b64_tr_b16 %5, %13 offset:%16\n\tds_read_b64_tr_b16 %6, %14 offset:%16\n\tds_read_b64_tr_b16 %7, %15 offset:%16\n\ts_waitcnt lgkmcnt(0)" \
    : "=&v"(R[0]), "=&v"(R[1]), "=&v"(R[2]), "=&v"(R[3]), "=&v"(R[4]), "=&v"(R[5]), "=&v"(R[6]), "=&v"(R[7]) \
    : "v"(A[0]), "v"(A[1]), "v"(A[2]), "v"(A[3]), "v"(A[4]), "v"(A[5]), "v"(A[6]), "v"(A[7]), "i"(OFF) : "memory")

#define NSA_TR4(R, A0, A1, A2, A3, OFF) asm volatile( \
    "ds_read_b64_tr_b16 %0, %4 offset:%8\n\tds_read_b64_tr_b16 %1, %5 offset:%8\n\tds_read_b64_tr_b16 %2, %6 offset:%8\n\tds_read_b64_tr_b16 %3, %7 offset:%8" \
    : "=&v"(R[0]), "=&v"(R[1]), "=&v"(R[2]), "=&v"(R[3]) : "v"(A0), "v"(A1), "v"(A2), "v"(A3), "i"(OFF) : "memory")
#define NSA_LWAIT(N, R) asm volatile("s_waitcnt lgkmcnt(" #N ")" : "+v"(R[0]), "+v"(R[1]), "+v"(R[2]), "+v"(R[3]) :: "memory")
struct NsaWave {
    float m, l;
    f32x16 O[4];
    bf16x8 q[8];
};
template <int MODE>
DI void nsa_tile_compute(NsaWave& W, unsigned kbuf, unsigned vbuf, const unsigned (&vaddr0)[8], int tq0, int kind, int kbeg, bool needmask, bool rowneed, int lane, LAS float* impA, LAS float* impL, int mblk0) {
    const int c = lane & 31, h = lane >> 5;
    constexpr float C2 = ATT_SCALE * 1.4426950408889634f;
    f32x16 s0, s1;
    const f32x16 zero16 = {0.f, 0.f, 0.f, 0.f, 0.f, 0.f, 0.f, 0.f, 0.f, 0.f, 0.f, 0.f, 0.f, 0.f, 0.f, 0.f};
    const unsigned f = ((c & 3u) << 2) | ((c >> 2) & 3u);
#ifndef NSA_REP_QK
#define NSA_REP_QK 1
#endif
    __builtin_amdgcn_s_setprio(1);
#pragma unroll 1
    for (int rq_ = 0; rq_ < NSA_REP_QK; ++rq_) {
        if (NSA_REP_QK > 1) asm volatile("" ::: "memory");
#pragma unroll
    for (int s = 0; s < 8; ++s) { const unsigned ch = (unsigned)(2 * s + h) ^ f;
        const bf16x8 a0 = *(const LAS bf16x8*)(size_t)(kbuf + 256u * c + 16u * ch), a1 = *(const LAS bf16x8*)(size_t)(kbuf + 8192u + 256u * c + 16u * ch);
        s0 = MFMA32(a0, W.q[s], s == 0 ? zero16 : s0); s1 = MFMA32(a1, W.q[s], s == 0 ? zero16 : s1); } }
    __builtin_amdgcn_s_setprio(0);
    if (needmask) {
        const int tq = tq0 + (c >> 2);
        const int lo = kind == 2 ? tq - 511 : 0, hi = kind == 0 ? (tq >= 31 ? (tq - 31) >> 4 : -1) : tq;
#pragma unroll
        for (int r = 0; r < 16; ++r) { const int k0 = kbeg + (r & 3) + 8 * (r >> 2) + 4 * h, k1 = k0 + 32;
            if (!(k0 >= lo && k0 <= hi)) s0[r] = -INFINITY;
            if (!(k1 >= lo && k1 <= hi)) s1[r] = -INFINITY; }
    }
    if (MODE != 2) {
        float mx = fmaxf(fmaxf(s0[0], s0[1]), s1[0]);
#pragma unroll
        for (int r = 2; r < 16; r += 2) mx = fmaxf(fmaxf(mx, s0[r]), s0[r + 1]);
#pragma unroll
        for (int r = 1; r < 15; r += 2) mx = fmaxf(fmaxf(mx, s1[r]), s1[r + 1]);
        mx = fmaxf(mx, s1[15]);
        mx = fmaxf(mx, __shfl_xor(mx, 32));
        if (!rowneed) mx = -INFINITY;
        const float mn = (W.m == -INFINITY || (mx - W.m) * C2 > 8.f) ? fmaxf(W.m, mx) : W.m;
        const float mu = (mn == -INFINITY) ? 0.f : mn;
        const float alpha = __builtin_amdgcn_exp2f((W.m - mu) * C2);
        const float nb = rowneed ? -mu * C2 : -INFINITY;
        float rs = 0.f;
#pragma unroll
        for (int r = 0; r < 16; ++r) { s0[r] = __builtin_amdgcn_exp2f(__builtin_fmaf(s0[r], C2, nb)); s1[r] = __builtin_amdgcn_exp2f(__builtin_fmaf(s1[r], C2, nb)); rs += s0[r] + s1[r]; }
        rs += __shfl_xor(rs, 32);
        W.l = W.l * alpha + rs; W.m = mn;
        if (MODE == 0 && !__all(alpha == 1.f)) {
#pragma unroll
            for (int d = 0; d < 4; ++d)
#pragma unroll
                for (int r = 0; r < 16; ++r) W.O[d][r] *= alpha; }
    } else {
#pragma unroll
        for (int r = 0; r < 16; ++r) { s0[r] = __builtin_amdgcn_exp2f((s0[r] - W.m) * C2) * W.l; s1[r] = __builtin_amdgcn_exp2f((s1[r] - W.m) * C2) * W.l; }
#pragma unroll
        for (int kb = 0; kb < 2; ++kb)
#pragma unroll
            for (int i = 0; i < 4; ++i) { const f32x16& sv = kb ? s1 : s0;
                float a = sv[4 * i] + sv[4 * i + 1] + sv[4 * i + 2] + sv[4 * i + 3], lv = sv[4 * i + 3];
                a += __shfl_xor(a, 1); a += __shfl_xor(a, 2); lv += __shfl_xor(lv, 1); lv += __shfl_xor(lv, 2);
                if ((c & 3) == 0) { const int mb = mblk0 + 8 * kb + 2 * i + h; impA[(c >> 2) * 128 + mb] = a; impL[(c >> 2) * 128 + mb] = lv; } }
    }
    if (MODE != 1) {
        unsigned vaddrl[8];
        { const unsigned q = (lane & 15) >> 2, pp = lane & 3, blk = (lane >> 4) & 1;
#pragma unroll
          for (int d = 0; d < 4; ++d)
#pragma unroll
              for (int t = 0; t < 2; ++t) vaddrl[2 * d + t] = vbuf + offb(8u * t + 4u * h + q, 4u * d + 2u * blk + (pp >> 1)) + 8u * (pp & 1u); }
        bf16x8 pf[4] = {pack_p(s0, 0), pack_p(s0, 1), pack_p(s1, 0), pack_p(s1, 1)};
        s16x4 RA[4], RB[4];
        asm volatile("s_waitcnt lgkmcnt(0)" ::: "memory");
        NSA_TR4(RA, vaddrl[0], vaddrl[1], vaddrl[2], vaddrl[3], 0);
        NSA_TR4(RB, vaddrl[4], vaddrl[5], vaddrl[6], vaddrl[7], 0);
#define NSA_PVSTEP(KS, NEXTOFF, HASNEXT) \
        NSA_LWAIT(4, RA); __builtin_amdgcn_sched_barrier(0); \
        { const bf16x8 v0_ = __builtin_shufflevector(RA[0], RA[1], 0, 1, 2, 3, 4, 5, 6, 7), v1_ = __builtin_shufflevector(RA[2], RA[3], 0, 1, 2, 3, 4, 5, 6, 7); \
          W.O[0] = MFMA32(v0_, pf[KS], W.O[0]); W.O[1] = MFMA32(v1_, pf[KS], W.O[1]); } \
        __builtin_amdgcn_sched_barrier(0); \
        if (HASNEXT) NSA_TR4(RA, vaddrl[0], vaddrl[1], vaddrl[2], vaddrl[3], NEXTOFF); \
        if (HASNEXT) NSA_LWAIT(4, RB); else NSA_LWAIT(0, RB); \
        __builtin_amdgcn_sched_barrier(0); \
        { const bf16x8 v2_ = __builtin_shufflevector(RB[0], RB[1], 0, 1, 2, 3, 4, 5, 6, 7), v3_ = __builtin_shufflevector(RB[2], RB[3], 0, 1, 2, 3, 4, 5, 6, 7); \
          W.O[2] = MFMA32(v2_, pf[KS], W.O[2]); W.O[3] = MFMA32(v3_, pf[KS], W.O[3]); } \
        __builtin_amdgcn_sched_barrier(0); \
        if (HASNEXT) NSA_TR4(RB, vaddrl[4], vaddrl[5], vaddrl[6], vaddrl[7], NEXTOFF);
        __builtin_amdgcn_s_setprio(1);
        NSA_PVSTEP(0, 4096, true) NSA_PVSTEP(1, 8192, true) NSA_PVSTEP(2, 12288, true) NSA_PVSTEP(3, 0, false)
        __builtin_amdgcn_s_setprio(0);
#undef NSA_PVSTEP
    }
}
DI void nsa_fold(const NsaWave& W, bf16_t* obrow, unsigned char* ob8row, float sc, bool first, bool last, int h) {
#pragma unroll
    for (int d = 0; d < 4; ++d)
#pragma unroll
        for (int i = 0; i < 4; ++i) { bf16_t* pp = obrow + 32 * d + 8 * i + 4 * h; float o0 = 0.f, o1 = 0.f, o2 = 0.f, o3 = 0.f;
            if (!first) { const u32x2 w = *(const u32x2*)pp; o0 = bflo(w[0]); o1 = bfhi(w[0]); o2 = bflo(w[1]); o3 = bfhi(w[1]); }
            o0 += sc * W.O[d][4 * i]; o1 += sc * W.O[d][4 * i + 1]; o2 += sc * W.O[d][4 * i + 2]; o3 += sc * W.O[d][4 * i + 3];
            if (last) *(unsigned*)(ob8row + 32 * d + 8 * i + 4 * h) = pg8::fp8x4(o0 * pg8::A8_SCALE, o1 * pg8::A8_SCALE, o2 * pg8::A8_SCALE, o3 * pg8::A8_SCALE);
            else *(u32x2*)pp = (u32x2){cvt2(o0, o1), cvt2(o2, o3)}; }
}
struct NsaRun { LAS char* L; unsigned lds0; const bf16_t* kbase; const bf16_t* vbase; int t0, nt, kind, tqmin, lo_min, lo_max, hi_min, hi_max, tid, w; LAS unsigned* selm; LAS float* impA; LAS float* impL; };
template <int MODE>
DI void nsa_tiles(NsaWave& W, const NsaRun& R, const unsigned (&vaddr)[8]) {
    if (R.nt <= 0) return;
    const int lane = R.tid & 63, c = lane & 31;
    __syncthreads();
    nsa_tile_dma(R.L, R.L + 16384, R.kbase + (size_t)R.t0 * 8192, R.vbase + (size_t)R.t0 * 8192, R.tid, R.w);
    asm volatile("s_waitcnt vmcnt(0)" ::: "memory");
    __syncthreads();
#pragma unroll 1
    for (int i = 0; i < R.nt; ++i) {
        const int cur = i & 1, tt = R.t0 + i, kbeg = tt * 64;
        if (i + 1 < R.nt) nsa_tile_dma(R.L + (cur ^ 1) * 32768, R.L + (cur ^ 1) * 32768 + 16384, R.kbase + (size_t)(tt + 1) * 8192, R.vbase + (size_t)(tt + 1) * 8192, R.tid, R.w);
        bool rowneed = true;
        if (R.kind == 1) { const unsigned wsel = R.selm[(c >> 2) * 4 + (tt >> 5)]; rowneed = (wsel >> (tt & 31)) & 1u; }
        const bool skip = kbeg > R.hi_max || kbeg + 63 < R.lo_min || (R.kind == 1 && __ballot(rowneed) == 0ull);
        if (!skip) {
            const bool needmask = !(kbeg >= R.lo_max && kbeg + 63 <= R.hi_min);
            const unsigned kb_ = R.lds0 + cur * 32768u, vb_ = kb_ + 16384u;
            nsa_tile_compute<MODE>(W, kb_, vb_, vaddr, R.tqmin, R.kind, kbeg, needmask, rowneed, lane, R.impA, R.impL, MODE == 2 ? tt * 16 : 0);
        }
        asm volatile("s_waitcnt vmcnt(0)" ::: "memory");
        __syncthreads();
    }
}
DI void phase_nsa_mfma(const Params& p, char* smem) {
    const int tid = tid_fresh(), lane = tid & 63, w = __builtin_amdgcn_readfirstlane(tid >> 6), c = lane & 31, h = lane >> 5;
    LAS char* L = (LAS char*)smem;
    const unsigned lds0 = (unsigned)(size_t)L;
    LAS float* impA = (LAS float*)(L + 65536) + w * 1024; LAS float* impL = (LAS float*)(L + 65536 + 32768) + w * 1024;
    LAS unsigned* selm = (LAS unsigned*)(L + 131072) + w * 32;
    const bf16_t* BQ = (const bf16_t*)(p.ws + O_BQ); const bf16_t* kvs = (const bf16_t*)(p.ws + O_KVS); const bf16_t* kcvc = (const bf16_t*)(p.ws + O_KCVC);
    const float* gates = (const float*)(p.ws + O_GATES); bf16_t* OB = (bf16_t*)(p.ws + O_OB);
    unsigned vaddr[8];
    { const unsigned q = (lane & 15) >> 2, pp = lane & 3, blk = (lane >> 4) & 1;
#pragma unroll
      for (int d = 0; d < 4; ++d)
#pragma unroll
          for (int t = 0; t < 2; ++t) vaddr[2 * d + t] = offb(8u * t + 4u * h + q, 4u * d + 2u * blk + (pp >> 1)) + 8u * (pp & 1u); }
#pragma unroll 1
    for (int P = blockIdx.x; P < 256; P += gridDim.x) {
#pragma unroll 1
        for (int half = 0; half < 2; ++half) {
            const int bg = P >> 6, x = P & 63, qb = half == 0 ? 127 - x : x, b = bg >> 1, g = bg & 1, q0 = qb * 64;
            NsaWave W;
            const int tqmin = q0 + 8 * w, tqmax = tqmin + 7; const int tok = b * T + tqmin + (c >> 2);
            { const bf16_t* qr = BQ + (size_t)tok * 1024 + (g * 4 + (c & 3)) * 128 + 8 * h;
#pragma unroll
              for (int s = 0; s < 8; ++s) W.q[s] = *(const bf16x8*)(qr + 16 * s); }
#pragma unroll
            for (int i = 0; i < 16; ++i) { impA[lane + 64 * i] = 0.f; impL[lane + 64 * i] = 0.f; }
            for (int step = 0; step < 4; ++step) {
                const int kind = step < 2 ? 0 : step - 1;
                const bf16_t* kbase; const bf16_t* vbase; int t0, nt;
                int lo_min, lo_max, hi_min, hi_max;
                if (kind == 0) { kbase = kcvc + (size_t)bg * 512 * 128; vbase = kcvc + (size_t)2048 * 128 + (size_t)bg * 512 * 128;
                    t0 = 0; const int nlast = (q0 + 63 - 31) >> 4; nt = q0 + 63 >= 31 ? (nlast >> 6) + 1 : 0;
                    lo_min = 0; lo_max = 0; hi_min = tqmin >= 31 ? (tqmin - 31) >> 4 : -1; hi_max = tqmax >= 31 ? (tqmax - 31) >> 4 : -1; }
                else if (kind == 1) { kbase = kvs + (2 * (size_t)NB * 2 + bg) * T * 128; vbase = kvs + (3 * (size_t)NB * 2 + bg) * T * 128;
                    t0 = 0; nt = qb + 1; lo_min = 0; lo_max = 0; hi_min = tqmin; hi_max = tqmax; }
                else { kbase = kvs + (4 * (size_t)NB * 2 + bg) * T * 128; vbase = kvs + (5 * (size_t)NB * 2 + bg) * T * 128;
                    t0 = qb >= 8 ? qb - 8 : 0; nt = qb - t0 + 1; lo_min = tqmin - 511; lo_max = tqmax - 511; hi_min = tqmin; hi_max = tqmax; }
                if (step != 1) { W.m = -INFINITY; W.l = 0.f; }
#pragma unroll
                for (int d = 0; d < 4; ++d)
#pragma unroll
                    for (int r = 0; r < 16; ++r) W.O[d][r] = 0.f;
                {   NsaRun R; R.L = L; R.lds0 = lds0; R.kbase = kbase; R.vbase = vbase; R.t0 = t0; R.nt = nt; R.kind = kind; R.tqmin = tqmin; R.lo_min = lo_min; R.lo_max = lo_max; R.hi_min = hi_min; R.hi_max = hi_max;
                    R.tid = tid; R.w = w; R.selm = selm; R.impA = impA; R.impL = impL;
                    if (step == 0) nsa_tiles<1>(W, R, vaddr); else if (step == 1) nsa_tiles<2>(W, R, vaddr); else nsa_tiles<0>(W, R, vaddr); }
                if (step == 0) { if (W.m == -INFINITY) W.m = 0.f; W.l = 1.f / fmaxf(W.l, 1e-30f); continue; }
                { int lz = lane; asm volatile("" : "+v"(lz)); const int cz = lz & 31; const int tokz = b * T + tqmin + (cz >> 2);
                  const float gv = gates[(size_t)tokz * 24 + (g * 4 + (cz & 3)) * 3 + kind];
                  nsa_fold(W, OB + (size_t)tokz * 1024 + (g * 4 + (cz & 3)) * 128, (unsigned char*)(p.ws + O_OB8) + (size_t)tokz * 1024 + (g * 4 + (cz & 3)) * 128, step == 1 ? gv : gv / fmaxf(W.l, 1e-30f), step == 1, step == 3, lz >> 5); }
                if (step == 1) {
                    asm volatile("s_waitcnt lgkmcnt(0)" ::: "memory");
#pragma unroll 1
                    for (int qi = 0; qi < 8; ++qi) { const int tqq = tqmin + qi, curb = tqq >> 6; unsigned key[2];
#pragma unroll
                        for (int hh = 0; hh < 2; ++hh) { const int mb = lane + 64 * hh; const float imp = impA[qi * 128 + mb] + (mb > 0 ? impL[qi * 128 + mb - 1] : 0.f);
                            const bool adm = mb <= curb, forced = mb == 0 || mb == curb || mb == curb - 1;
                            key[hh] = !adm ? 0u : (forced ? (0xFF000000u | (unsigned)(127 - mb)) : ((((__float_as_uint(imp) >> 7) + 1u) << 7) | (unsigned)(127 - mb))); }
                        unsigned Tv = 0u;
                        for (int bit = 31; bit >= 0; --bit) { const unsigned cand = Tv | (1u << bit);
                            const int cnt = __popcll(__ballot(key[0] >= cand)) + __popcll(__ballot(key[1] >= cand)); if (cnt >= 16) Tv = cand; }
                        if (Tv == 0u) Tv = 1u;
                        const unsigned long long m0 = __ballot(key[0] >= Tv), m1 = __ballot(key[1] >= Tv);
                        if (lane == 0) { selm[qi * 4] = (unsigned)m0; selm[qi * 4 + 1] = (unsigned)(m0 >> 32); selm[qi * 4 + 2] = (unsigned)m1; selm[qi * 4 + 3] = (unsigned)(m1 >> 32); } }
                    asm volatile("s_waitcnt lgkmcnt(0)" ::: "memory");
                }
            }
        }
    }
}

DI void topk256_hist(LAS unsigned short* sck, int nk, LAS unsigned* hist, unsigned short* out, int lane) {
    const int nit = (nk + 511) >> 9;
    const unsigned long long ltm = (1ull << lane) - 1ull;
    for (int k = nk + lane; k < 512 * nit; k += 64) sck[k] = 0;
    unsigned bsel = 0, cnt_above = 0;
#pragma unroll 1
    for (int pass = 0; pass < 2; ++pass) {
        *(LAS u32x4*)(hist + 4 * lane) = (u32x4){0u, 0u, 0u, 0u};
        asm volatile("s_waitcnt lgkmcnt(0)" ::: "memory");
#pragma unroll 1
        for (int i = 0; i < nit; ++i) { const int k0 = 8 * (i * 64 + lane); const u32x4 wv = *(const LAS u32x4*)(sck + k0);
#pragma unroll
            for (int j = 0; j < 8; ++j) { const unsigned key = (j & 1) ? (wv[j >> 1] >> 16) : (wv[j >> 1] & 0xffffu);
                if (pass == 0) __hip_atomic_fetch_add(hist + (key >> 8), 1u, __ATOMIC_RELAXED, __HIP_MEMORY_SCOPE_WORKGROUP);
                else if ((key >> 8) == bsel) __hip_atomic_fetch_add(hist + (key & 255u), 1u, __ATOMIC_RELAXED, __HIP_MEMORY_SCOPE_WORKGROUP); } }
        asm volatile("s_waitcnt lgkmcnt(0)" ::: "memory");
        const u32x4 c4 = *(const LAS u32x4*)(hist + 4 * lane);
        const unsigned tot = c4[0] + c4[1] + c4[2] + c4[3];
        unsigned inc = tot;
#pragma unroll
        for (int o = 1; o < 64; o <<= 1) { const unsigned v = __shfl_down(inc, o); if (lane + o < 64) inc += v; }
        unsigned above = cnt_above + inc - tot;
        int found = -1; unsigned fabove = 0;
#pragma unroll
        for (int bb = 3; bb >= 0; --bb) { if (found < 0 && above < 256u && above + c4[bb] >= 256u) { found = 4 * lane + bb; fabove = above; } above += c4[bb]; }
        const unsigned long long fm = __ballot(found >= 0); const int src = __builtin_ctzll(fm);
        const unsigned fb = (unsigned)__shfl(found, src); cnt_above = (unsigned)__shfl((int)fabove, src);
        bsel = pass == 0 ? fb : ((bsel << 8) | fb);
    }
    const unsigned Tv = bsel; const int need = 256 - (int)cnt_above; int pos = 0, eqc = 0;
#pragma unroll 1
    for (int i = 0; i < nit; ++i) { const int k0 = 8 * (i * 64 + lane); const u32x4 wv = *(const LAS u32x4*)(sck + k0);
        bool eq[8], sl[8]; bool anyeq = false;
#pragma unroll
        for (int j = 0; j < 8; ++j) { const unsigned key = (j & 1) ? (wv[j >> 1] >> 16) : (wv[j >> 1] & 0xffffu); eq[j] = key == Tv; sl[j] = key > Tv; anyeq |= eq[j]; }
        if (__ballot(anyeq) != 0ull) {
            int below = 0, own = 0, etot = 0;
#pragma unroll
            for (int j = 0; j < 8; ++j) { const unsigned long long em = __ballot(eq[j]); below += __popcll(em & ltm); etot += __popcll(em); }
#pragma unroll
            for (int j = 0; j < 8; ++j) if (eq[j]) { if (eqc + below + own < need) sl[j] = true; ++own; }
            eqc += etot; }
#pragma unroll
        for (int j = 0; j < 8; ++j) { const unsigned long long sm = __ballot(sl[j]); if (sl[j]) out[pos + __popcll(sm & ltm)] = (unsigned short)(k0 + j); pos += __popcll(sm); } }
}
DI void phase_indexer_mfma(const Params& p, char* smem) {
    const int tid = tid_fresh(), lane = tid & 63, w = __builtin_amdgcn_readfirstlane(tid >> 6), c = lane & 31, hh = lane >> 5;
    LAS unsigned short* sc = (LAS unsigned short*)(LAS char*)smem;
    LAS unsigned* hist = (LAS unsigned*)((LAS char*)smem + 131072) + w * 256;
    const bf16_t* Q = (const bf16_t*)(p.ws + O_QALL); const bf16_t* KI = (const bf16_t*)(p.ws + O_KIDX); const float* WI = (const float*)(p.ws + O_WIDX);
    unsigned short* SEL = (unsigned short*)(p.ws + O_SEL); int* NSEL = (int*)(p.ws + O_NSEL);
    const float* rope = (const float*)(p.ws + O_ROPE);
    c2_rows(p, smem);
    __syncthreads();
#pragma unroll 1
    for (int rnd = 0; rnd * (int)gridDim.x < NT / 8; ++rnd) {
        const int slot = (rnd & 1) ? (int)gridDim.x - 1 - (int)blockIdx.x : (int)blockIdx.x;
        const int u = NT / 8 - 1 - (rnd * (int)gridDim.x + slot);
        if (u < 0) continue;
        const int tok0 = u * 8, b = tok0 >> 13, q0 = tok0 & (T - 1), nkmax = q0 + 8;
        const int tok = tok0 + w, nk = q0 + w + 1;
        unsigned short* out = SEL + (size_t)tok * 256;
#ifndef IDX_REP_SCORE
#define IDX_REP_SCORE 1
#endif
#ifndef IDX_REP_SEL
#define IDX_REP_SEL 1
#endif
        for (int rs_ = 0; rs_ < IDX_REP_SCORE; ++rs_)
        if (nkmax > 256) {
            bf16x8 qa[2][4], Wf[2][2];
#pragma unroll
            for (int rb = 0; rb < 2; ++rb) { const bf16_t* qr = Q + (size_t)(tok0 + 4 * rb + (c >> 3)) * QC + 2304 + (c & 7) * 64 + 8 * hh;
#pragma unroll
                for (int s = 0; s < 4; ++s) qa[rb][s] = *(const bf16x8*)(qr + 16 * s);
                {
                    const float* rt = rope + (size_t)(tok0 + 4 * rb + (c >> 3)) * 48 + 32;
                    const u32x4 own = __builtin_bit_cast(u32x4, qa[rb][0]); u32x4 oth;
#pragma unroll
                    for (int k = 0; k < 4; ++k) oth[k] = (unsigned)__shfl_xor((int)own[k], 32);
                    float xa[8], xb[8], xr[8]; unpack8(own, xa); unpack8(oth, xb);
#pragma unroll
                    for (int j = 0; j < 8; ++j) { const float cs = rt[2 * j], sn = rt[2 * j + 1]; xr[j] = hh == 0 ? xa[j] * cs - xb[j] * sn : xa[j] * cs + xb[j] * sn; }
                    const u32x4 pk = {pk2(xr[0], xr[1]), pk2(xr[2], xr[3]), pk2(xr[4], xr[5]), pk2(xr[6], xr[7])};
                    qa[rb][0] = __builtin_bit_cast(bf16x8, pk); }
                { f32x4 wv = {0.f, 0.f, 0.f, 0.f}; if (c < 8) wv = *(const f32x4*)(WI + (size_t)(tok0 + c) * 8 + 4 * hh);
#pragma unroll
                  for (int sp = 0; sp < 2; ++sp) { const bool m0 = c == 4 * rb + 2 * sp, m1 = c == 4 * rb + 2 * sp + 1;
                      const u32x4 pkw = {m0 ? pk2(wv[0], wv[1]) : 0u, m0 ? pk2(wv[2], wv[3]) : 0u, m1 ? pk2(wv[0], wv[1]) : 0u, m1 ? pk2(wv[2], wv[3]) : 0u};
                      Wf[rb][sp] = __builtin_bit_cast(bf16x8, pkw); } } }
            const int npair = (nkmax + 63) >> 6;
            const bf16_t* kbase = KI + ((size_t)b * T + c) * 64 + 8 * hh;
            bf16x8 kb[2][4], kn[2][4];
            auto ldk = [&](bf16x8 (&dst)[2][4], int pr) {
#pragma unroll
                for (int tt = 0; tt < 2; ++tt) { int key0 = 64 * pr + 32 * tt; if (key0 + 31 >= T) key0 = T - 32;
#pragma unroll
                    for (int s = 0; s < 4; ++s) dst[tt][s] = *(const bf16x8*)(kbase + (size_t)key0 * 64 + 16 * s); } };
            if (w < npair) ldk(kb, w);
#pragma unroll 1
            for (int pr = w; pr < npair; pr += 8) {
                if (pr + 8 < npair) ldk(kn, pr + 8);
#pragma unroll
                for (int tt = 0; tt < 2; ++tt) {
                    const int key = 64 * pr + 32 * tt + c;
                    f32x16 a0, a1; const f32x16 z16 = {0.f, 0.f, 0.f, 0.f, 0.f, 0.f, 0.f, 0.f, 0.f, 0.f, 0.f, 0.f, 0.f, 0.f, 0.f, 0.f};
#pragma unroll
                    for (int s = 0; s < 4; ++s) { a0 = MFMA32(qa[0][s], kb[tt][s], s == 0 ? z16 : a0); a1 = MFMA32(qa[1][s], kb[tt][s], s == 0 ? z16 : a1); }
#pragma unroll
                    for (int i = 0; i < 16; ++i) { a0[i] = fmaxf(a0[i], 0.f); a1[i] = fmaxf(a1[i], 0.f); }
                    f32x16 d2 = MFMA32(Wf[0][0], pack_p(a0, 0), z16);
                    d2 = MFMA32(Wf[0][1], pack_p(a0, 1), d2); d2 = MFMA32(Wf[1][0], pack_p(a1, 0), d2); d2 = MFMA32(Wf[1][1], pack_p(a1, 1), d2);
                    if (key < 8192) {
#pragma unroll
                        for (int qq = 0; qq < 4; ++qq) sc[(4 * hh + qq) * 8192 + key] = f16key(d2[qq]); }
                }
#pragma unroll
                for (int tt = 0; tt < 2; ++tt)
#pragma unroll
                    for (int s = 0; s < 4; ++s) kb[tt][s] = kn[tt][s];
            }
        }
        __syncthreads();
        if (nk <= 256) { for (int i = lane; i < 256; i += 64) out[i] = (unsigned short)(i < nk ? i : 0); if (lane == 0) NSEL[tok] = nk; }
        else { for (int rs_ = 0; rs_ < IDX_REP_SEL; ++rs_) topk256_hist(sc + w * 8192, nk, hist, out, lane); if (lane == 0) NSEL[tok] = 256; }
        __syncthreads();
    }
}

#define MFMA16(a, b, c) __builtin_amdgcn_mfma_f32_16x16x32_bf16((a), (b), (c), 0, 0, 0)
#define MLA_ROW 592
#define MLA_TR8(R, BASE, OFF) asm volatile( \
    "ds_read_b64_tr_b16 %0, %8 offset:%9\n\tds_read_b64_tr_b16 %1, %8 offset:%10\n\tds_read_b64_tr_b16 %2, %8 offset:%11\n\tds_read_b64_tr_b16 %3, %8 offset:%12\n\t" \
    "ds_read_b64_tr_b16 %4, %8 offset:%13\n\tds_read_b64_tr_b16 %5, %8 offset:%14\n\tds_read_b64_tr_b16 %6, %8 offset:%15\n\tds_read_b64_tr_b16 %7, %8 offset:%16\n\ts_waitcnt lgkmcnt(0)" \
    : "=&v"(R[0]), "=&v"(R[1]), "=&v"(R[2]), "=&v"(R[3]), "=&v"(R[4]), "=&v"(R[5]), "=&v"(R[6]), "=&v"(R[7]) \
    : "v"(BASE), "i"(OFF), "i"((OFF) + 16 * MLA_ROW), "i"((OFF) + 32), "i"((OFF) + 32 + 16 * MLA_ROW), "i"((OFF) + 64), "i"((OFF) + 64 + 16 * MLA_ROW), "i"((OFF) + 96), "i"((OFF) + 96 + 16 * MLA_ROW) : "memory")
DI void phase_mla_mfma(const Params& p, char* smem) {
    const int tid = tid_fresh(), lane = tid & 63, w = __builtin_amdgcn_readfirstlane(tid >> 6), fr = lane & 15, g = lane >> 4;
    LAS char* buf = (LAS char*)smem + w * (32 * MLA_ROW);
    const unsigned lbase = (unsigned)(size_t)buf;
    const bf16_t* Q = (const bf16_t*)(p.ws + O_QALL); const bf16_t* KV = (const bf16_t*)(p.ws + O_KVT);
    const unsigned short* SEL = (const unsigned short*)(p.ws + O_SEL); const int* NSEL = (const int*)(p.ws + O_NSEL); bf16_t* OL = (bf16_t*)(p.ws + O_OLAT);
    constexpr float C2 = ATT_SCALE * 1.4426950408889634f;
    int pf_cnt = 0, pf_s0 = 0, pf_s1 = 0;
    { const int tok = blockIdx.x * 8 + w; if (tok < NT) { pf_cnt = NSEL[tok]; if (lane < 32) { pf_s0 = SEL[(size_t)tok * 256 + lane]; pf_s1 = SEL[(size_t)tok * 256 + 32 + lane]; } } }
#pragma unroll 1
    for (int tok = blockIdx.x * 8 + w; tok < NT; tok += gridDim.x * 8) {
        const int b = tok >> 13; const int cnt = pf_cnt; const int cur_s0 = pf_s0, cur_s1 = pf_s1;
        { const int tn = tok + gridDim.x * 8; if (tn < NT) { pf_cnt = NSEL[tn]; if (lane < 32) { pf_s0 = SEL[(size_t)tn * 256 + lane]; pf_s1 = SEL[(size_t)tn * 256 + 32 + lane]; } } }
        bf16x8 qf[9];
        { const bf16_t* qr = Q + (size_t)tok * QC; const bf16x8 z8 = {0, 0, 0, 0, 0, 0, 0, 0};
#pragma unroll
          for (int s = 0; s < 8; ++s) qf[s] = fr < 8 ? *(const bf16x8*)(qr + fr * 256 + 32 * s + 8 * g) : z8;
          qf[8] = fr < 8 ? *(const bf16x8*)(qr + 2048 + fr * 32 + 8 * g) : z8;
          {
              const float* rt = (const float*)(p.ws + O_ROPE) + (size_t)tok * 48;
              const u32x4 own = __builtin_bit_cast(u32x4, qf[8]); u32x4 oth;
#pragma unroll
              for (int k = 0; k < 4; ++k) oth[k] = (unsigned)__shfl_xor((int)own[k], 32);
              float xa[8], xb[8], xr[8]; unpack8(own, xa); unpack8(oth, xb);
#pragma unroll
              for (int j = 0; j < 8; ++j) { const int fi = 8 * (g & 1) + j; const float cs = rt[2 * fi], sn = rt[2 * fi + 1]; xr[j] = g < 2 ? xa[j] * cs - xb[j] * sn : xa[j] * cs + xb[j] * sn; }
              const u32x4 pk = {pk2(xr[0], xr[1]), pk2(xr[2], xr[3]), pk2(xr[4], xr[5]), pk2(xr[6], xr[7])};
              qf[8] = __builtin_bit_cast(bf16x8, pk); } }
        f32x4 O[16];
#pragma unroll
        for (int d = 0; d < 16; ++d) O[d] = (f32x4){0.f, 0.f, 0.f, 0.f};
        float m = -INFINITY, l = 0.f;
        const int nchunk = (cnt + 31) >> 5;
        u32x4 st[18]; int selv_n = 0;
        const bf16_t* kvb = KV + (size_t)b * T * KVW;
        auto issue = [&](int selv, int lz) {
#pragma unroll
            for (int i = 0; i < 16; ++i) { const int r0 = __builtin_amdgcn_readlane(selv, 2 * i), r1 = __builtin_amdgcn_readlane(selv, 2 * i + 1); const int row = lz < 32 ? r0 : r1;
                st[i] = *(const u32x4*)(kvb + (size_t)row * KVW + (lz & 31) * 8); }
#pragma unroll
            for (int i = 0; i < 2; ++i) { const int row = __shfl(selv, 16 * i + (lz >> 2)); st[16 + i] = *(const u32x4*)(kvb + (size_t)row * KVW + 256 + (lz & 3) * 8); } };
        { int lz = lane; asm volatile("" : "+v"(lz));
          int selv = 0; if (lz < 32 && lz < cnt) selv = cur_s0;
          if (lz < 32 && 32 + lz < cnt) selv_n = cur_s1;
          issue(selv, lz); }
#pragma unroll 1
        for (int ch = 0; ch < nchunk; ++ch) {
            int lz = lane; asm volatile("" : "+v"(lz));
#pragma unroll
            for (int i = 0; i < 16; ++i) *(LAS u32x4*)(buf + (2 * i + (lz >> 5)) * MLA_ROW + (lz & 31) * 16) = st[i];
#pragma unroll
            for (int i = 0; i < 2; ++i) *(LAS u32x4*)(buf + (16 * i + (lz >> 2)) * MLA_ROW + 512 + (lz & 3) * 16) = st[16 + i];
            if (ch + 1 < nchunk) {
                const int selv = selv_n; selv_n = 0;
                { const int k = (ch + 2) * 32 + lz; if (lz < 32 && k < cnt) selv_n = SEL[(size_t)tok * 256 + k]; }
                issue(selv, lz); }
            asm volatile("s_waitcnt lgkmcnt(0)" ::: "memory");
            const int frz = lz & 15, gz = lz >> 4;
            f32x4 s0, s1; const f32x4 z4 = {0.f, 0.f, 0.f, 0.f};
#pragma unroll
            for (int s = 0; s < 9; ++s) { const bf16x8 a0 = *(const LAS bf16x8*)(buf + frz * MLA_ROW + (32 * s + 8 * gz) * 2), a1 = *(const LAS bf16x8*)(buf + (frz + 16) * MLA_ROW + (32 * s + 8 * gz) * 2);
                s0 = MFMA16(a0, qf[s], s == 0 ? z4 : s0); s1 = MFMA16(a1, qf[s], s == 0 ? z4 : s1); }
            float mx = -INFINITY;
#pragma unroll
            for (int j = 0; j < 4; ++j) { if (ch * 32 + 4 * gz + j >= cnt) s0[j] = -INFINITY; if (ch * 32 + 16 + 4 * gz + j >= cnt) s1[j] = -INFINITY; mx = fmaxf(mx, fmaxf(s0[j], s1[j])); }
            mx = fmaxf(mx, __shfl_xor(mx, 16)); mx = fmaxf(mx, __shfl_xor(mx, 32));
            const float mn = fmaxf(m, mx), mu = (mn == -INFINITY) ? 0.f : mn;
            const float alpha = __builtin_amdgcn_exp2f((m - mu) * C2);
            float rs = 0.f;
#pragma unroll
            for (int j = 0; j < 4; ++j) { s0[j] = __builtin_amdgcn_exp2f((s0[j] - mu) * C2); s1[j] = __builtin_amdgcn_exp2f((s1[j] - mu) * C2); rs += s0[j] + s1[j]; }
            rs += __shfl_xor(rs, 16); rs += __shfl_xor(rs, 32);
            l = l * alpha + rs; m = mn;
            if (!__all(alpha == 1.f)) {
#pragma unroll
                for (int d = 0; d < 16; ++d) O[d] *= alpha; }
            const u32x4 pw = {cvt2(s0[0], s0[1]), cvt2(s0[2], s0[3]), cvt2(s1[0], s1[1]), cvt2(s1[2], s1[3])};
            const bf16x8 pf = __builtin_bit_cast(bf16x8, pw);
            const unsigned tb = lbase + (unsigned)(4 * gz + (frz >> 2)) * MLA_ROW + 8u * (frz & 3);
#pragma unroll
            for (int dq = 0; dq < 4; ++dq) { s16x4 R[8];
                if (dq == 0) MLA_TR8(R, tb, 0); else if (dq == 1) MLA_TR8(R, tb, 128); else if (dq == 2) MLA_TR8(R, tb, 256); else MLA_TR8(R, tb, 384);
#pragma unroll
                for (int d = 0; d < 4; ++d) { const bf16x8 vf = __builtin_shufflevector(R[2 * d], R[2 * d + 1], 0, 1, 2, 3, 4, 5, 6, 7); O[4 * dq + d] = MFMA16(vf, pf, O[4 * dq + d]); } }
            asm volatile("s_waitcnt lgkmcnt(0)" ::: "memory");
        }
        const float il16 = pg8::A8_SCALE / fmaxf(l, 1e-30f);
        if (fr < 8) {
#pragma unroll
            for (int d = 0; d < 16; ++d) *(unsigned*)((unsigned char*)OL + (size_t)tok * D + fr * 256 + 16 * d + 4 * g) = pg8::fp8x4(O[d][0] * il16, O[d][1] * il16, O[d][2] * il16, O[d][3] * il16); }
    }
}

DI void phase_post_mix(const Params& p, char* smem, bool count) {
    const int tz_ = tid_fresh(); const int lane = tz_ & 63, wid = __builtin_amdgcn_readfirstlane(tz_ >> 6);
    float* part = (float*)smem;
    int* lcnt = (int*)(smem + 8 * 32 * 33 * 4);
    const bf16_t* MO = (const bf16_t*)(p.ws + O_MO); float* X1 = (float*)(p.ws + O_X1); bf16_t* H = (bf16_t*)(p.ws + O_H); const bf16_t* WR = (const bf16_t*)(p.ws + O_WRT);
    int* TOPI = (int*)(p.ws + O_TOPI); float* TOPW = (float*)(p.ws + O_TOPW); int* cnts = (int*)(p.ws + O_CNT);
#pragma unroll 1
    for (int ck = blockIdx.x; ck < NT / 64; ck += gridDim.x) {
#pragma unroll 1
        for (int j = 0; j < 8; ++j) {
            const int tok = ck * 64 + wid * 8 + j, b = tok >> 13;
            float v[32]; float ss = 0.f;
#pragma unroll
            for (int i = 0; i < 8; ++i) { const u32x2 w = *(const u32x2*)(MO + (size_t)tok * D + 4 * (lane + 64 * i));
                v[4 * i] = bflo(w[0]); v[4 * i + 1] = bfhi(w[0]); v[4 * i + 2] = bflo(w[1]); v[4 * i + 3] = bfhi(w[1]); }
#pragma unroll
            for (int i = 0; i < 32; ++i) ss += v[i] * v[i];
            const float rs = rsqrtf(wave_sum(ss) * (1.f / D) + NORM_EPS);
            float ss2 = 0.f;
#pragma unroll
            for (int i = 0; i < 8; ++i) { const int col = 4 * (lane + 64 * i); const f32x4 xv = *(const f32x4*)(p.x + (size_t)tok * D + col); f32x4 o;
#pragma unroll
                for (int q = 0; q < 4; ++q) { o[q] = xv[q] + mod_at(p, b, 4096 + col + q) * (v[4 * i + q] * rs * p.g_post_mix[col + q]); v[4 * i + q] = o[q]; ss2 += o[q] * o[q]; }
                *(f32x4*)(X1 + (size_t)tok * D + col) = o; }
            const float rs2 = rsqrtf(wave_sum(ss2) * (1.f / D) + NORM_EPS);
#pragma unroll
            for (int i = 0; i < 8; ++i) { const int col = 4 * (lane + 64 * i); f32x4 hv;
#pragma unroll
                for (int q = 0; q < 4; ++q) hv[q] = v[4 * i + q] * rs2 * p.g_pre_ffn[col + q] * (1.f + mod_at(p, b, 4 * 2048 + col + q)) + mod_at(p, b, 3 * 2048 + col + q);
                *(u32x2*)(H + (size_t)tok * D + col) = (u32x2){pk2(hv[0], hv[1]), pk2(hv[2], hv[3])}; }
        }
        asm volatile("s_waitcnt vmcnt(0)" ::: "memory");
        __syncthreads();
        if (tz_ < 32) lcnt[tz_] = 0;
        {
            const int c = lane & 31, hh = lane >> 5, rb = wid & 1, ks = wid >> 1;
            const bf16_t* ap = H + (size_t)(ck * 64 + 32 * rb + c) * D + 512 * ks + 8 * hh; const bf16_t* bp = WR + (size_t)c * D + 512 * ks + 8 * hh;
            f32x16 acc;
#pragma unroll
            for (int i = 0; i < 16; ++i) acc[i] = 0.f;
#pragma unroll 8
            for (int sx = 0; sx < 32; ++sx) { const bf16x8 a = *(const bf16x8*)(ap + 16 * sx), bb = *(const bf16x8*)(bp + 16 * sx); acc = MFMA32(a, bb, acc); }
#pragma unroll
            for (int r = 0; r < 16; ++r) part[(wid * 32 + (r & 3) + 8 * (r >> 2) + 4 * hh) * 33 + c] = acc[r];
        }
        __syncthreads();
        if (tz_ < 64) {
            const int rbt = tz_ >> 5, row = tz_ & 31, tok = ck * 64 + tz_;
            float lg[32];
#pragma unroll
            for (int e = 0; e < 32; ++e) lg[e] = p.b_router[e] + part[((0 * 2 + rbt) * 32 + row) * 33 + e] + part[((1 * 2 + rbt) * 32 + row) * 33 + e] + part[((2 * 2 + rbt) * 32 + row) * 33 + e] + part[((3 * 2 + rbt) * 32 + row) * 33 + e];
            int te[4]; float tv[4];
#pragma unroll
            for (int k = 0; k < 4; ++k) { float mx = lg[0]; int bi = 0;
#pragma unroll
                for (int e = 1; e < 32; ++e) if (lg[e] > mx) { mx = lg[e]; bi = e; }
                te[k] = bi; tv[k] = mx;
#pragma unroll
                for (int e = 0; e < 32; ++e) if (e == bi) lg[e] = -INFINITY; }
            const float e1 = __expf(tv[1] - tv[0]), e2 = __expf(tv[2] - tv[0]), e3 = __expf(tv[3] - tv[0]); const float inv = 1.f / (1.f + e1 + e2 + e3);
            *(int4*)(TOPI + tok * 4) = make_int4(te[0], te[1], te[2], te[3]);
            *(f32x4*)(TOPW + tok * 4) = (f32x4){inv, e1 * inv, e2 * inv, e3 * inv};
            atomicAdd(lcnt + te[0], 1); atomicAdd(lcnt + te[1], 1); atomicAdd(lcnt + te[2], 1); atomicAdd(lcnt + te[3], 1);
        }
        __syncthreads();
        if (count && tz_ < 32) atomicAdd(cnts + tz_, lcnt[tz_]);
    }
}

DI int moe_tables(const Params& p, LAS int* tile_e, LAS int* pstart) {
    int* cnts = (int*)(p.ws + O_CNT);
    if (threadIdx.x < 64) {
        const int e = threadIdx.x & 31;
        const int c = __hip_atomic_load(cnts + e, __ATOMIC_RELAXED, __HIP_MEMORY_SCOPE_AGENT);
        const int nt = (c + 255) >> 8; int inc = nt;
#pragma unroll
        for (int o = 1; o < 32; o <<= 1) { const int v = __shfl_up(inc, o, 32); if (e >= o) inc += v; }
        const int start = inc - nt;
        if (threadIdx.x < 32) { pstart[e] = start * 256; for (int i = 0; i < nt; ++i) tile_e[start + i] = e; if (e == 31) pstart[NEXP] = inc; } }
    __syncthreads();
    return pstart[NEXP];
}
DI void phase_moe_gather(const Params& p, char* smem) {
    const int tz_ = tid_fresh(); const int lane = tz_ & 63, wid = __builtin_amdgcn_readfirstlane(tz_ >> 6);
    LAS int* tile_e = (LAS int*)(LAS char*)smem; LAS int* pstart = tile_e + 320; LAS int* lcnt = pstart + 40; LAS int* lbase = lcnt + 32;
    (void)moe_tables(p, tile_e, pstart);
    const bf16_t* H = (const bf16_t*)(p.ws + O_H); unsigned char* HS = (unsigned char*)(p.ws + O_HS);
    const int* TOPI = (const int*)(p.ws + O_TOPI); const float* TOPW = (const float*)(p.ws + O_TOPW); int* TSLOT = (int*)(p.ws + O_TSLOT); float* SLOTW = (float*)(p.ws + O_SLOTW);
    int* fill = (int*)(p.ws + O_CNT) + 32;
#pragma unroll 1
    for (int ck = blockIdx.x; ck < NT / 64; ck += gridDim.x) {
        const int tok0 = ck * 64 + wid * 8;
        __syncthreads();
        if (tz_ < 32) lcnt[tz_] = 0;
        __syncthreads();
        int e = 0, rank = 0;
        if (lane < 32) { e = TOPI[tok0 * 4 + lane]; rank = atomicAdd((int*)(lcnt + e), 1); }
        __syncthreads();
        if (tz_ < 32) lbase[tz_] = atomicAdd(fill + tz_, lcnt[tz_]);
        __syncthreads();
        int slot = 0;
        if (lane < 32) { slot = pstart[e] + lbase[e] + rank; TSLOT[tok0 * 4 + lane] = slot; SLOTW[slot] = TOPW[tok0 * 4 + lane]; }
#pragma unroll 2
        for (int j = 0; j < 8; ++j) { u32x2 hv[4];
#pragma unroll
            for (int i = 0; i < 4; ++i) { float f[8]; unpack8(*(const u32x4*)(H + (size_t)(tok0 + j) * D + 8 * (lane + 64 * i)), f);
                hv[i] = (u32x2){pg8::fp8x4(f[0], f[1], f[2], f[3]), pg8::fp8x4(f[4], f[5], f[6], f[7])}; }
#pragma unroll
            for (int k = 0; k < 4; ++k) { const int sl = __shfl(slot, j * 4 + k);
#pragma unroll
                for (int i = 0; i < 4; ++i) *(u32x2*)(HS + (size_t)sl * D + 8 * (lane + 64 * i)) = hv[i]; } }
    }
}
DI void phase_final(const Params& p) {
    const int tz_ = tid_fresh(); const int lane = tz_ & 63, wid = __builtin_amdgcn_readfirstlane(tz_ >> 6);
    const unsigned char* YS = (const unsigned char*)(p.ws + O_YS); const float* X1 = (const float*)(p.ws + O_X1); const int* TSLOT = (const int*)(p.ws + O_TSLOT);
    for (int tok = blockIdx.x * 8 + wid; tok < NT; tok += gridDim.x * 8) {
        const int b = tok >> 13; float v[32];
#pragma unroll
        for (int i = 0; i < 32; ++i) v[i] = 0.f;
#pragma unroll
        for (int k = 0; k < 4; ++k) { const int slot = TSLOT[tok * 4 + k];
#pragma unroll
            for (int i = 0; i < 8; ++i) { const unsigned w = *(const unsigned*)(YS + (size_t)slot * D + 4 * (lane + 64 * i));
                const auto lo = __builtin_amdgcn_cvt_pk_f32_fp8((int)w, false), hi = __builtin_amdgcn_cvt_pk_f32_fp8((int)w, true);
                v[4 * i] += lo[0]; v[4 * i + 1] += lo[1]; v[4 * i + 2] += hi[0]; v[4 * i + 3] += hi[1]; } }
#pragma unroll
        for (int i = 0; i < 32; ++i) v[i] *= pg8::Y8_INV;
        float ss = 0.f;
#pragma unroll
        for (int i = 0; i < 32; ++i) ss += v[i] * v[i];
        const float rs = rsqrtf(wave_sum(ss) * (1.f / D) + NORM_EPS);
#pragma unroll
        for (int i = 0; i < 8; ++i) { const int col = 4 * (lane + 64 * i); const f32x4 xv = *(const f32x4*)(X1 + (size_t)tok * D + col); f32x4 o;
#pragma unroll
            for (int j = 0; j < 4; ++j) o[j] = xv[j] + mod_at(p, b, 5 * 2048 + col + j) * (v[4 * i + j] * rs * p.g_post_ffn[col + j]);
            *(f32x4*)(p.out + (size_t)tok * D + col) = o; }
    }
}

#ifndef PHMASK
#define PHMASK 0xFFFFFFFFu
#endif
#define PHON(ph) (((PHMASK) >> (ph)) & 1u)
#ifndef REPMASK
#define REPMASK 0u
#endif
#define REP(ph) _Pragma("unroll 1") for (int rep_ = 0; rep_ <= (int)(((REPMASK) >> (ph)) & 1u); ++rep_)
enum { PH_PREP = 0, PH_H1, PH_GIN, PH_ZPOST, PH_GQ, PH_QROPE, PH_IDX, PH_MLA, PH_NSA, PH_MERGE, PH_GOUT, PH_POSTMIX, PH_GATHER, PH_GU, PH_DN, PH_FINAL, PH_END };

__global__ void __launch_bounds__(512, 2) mega(Params p, int lo, int hi) {
    extern __shared__ __attribute__((aligned(16))) char smem[];
    LAS unsigned char* lds = (LAS unsigned char*)(LAS char*)smem;
    volatile LAS unsigned* xbw = (volatile LAS unsigned*)(LAS char*)(smem + LDS_BYTES - 16);
    XcdBarrier bar; bar.bar = (unsigned*)p.ws; bar.x = 0; bar.st = xbw;
    if (hi - lo > 1) { if (threadIdx.x == 0) { xbw[0] = 0u; xbw[1] = 0u; } __syncthreads(); bar = xcd_barrier_post((unsigned*)p.ws, xbw); }
    const int G = gridDim.x, c = blockIdx.x;
#define SEAM(ph) if ((ph) + 1 < hi) xcd_barrier(bar);
    if (PHON(PH_PREP) && lo <= PH_PREP && PH_PREP < hi) { REP(PH_PREP) { phase_prep(p, smem); } SEAM(PH_PREP) }
    if (PHON(PH_H1) && lo <= PH_H1 && PH_H1 < hi) { REP(PH_H1) { phase_h1(p); } SEAM(PH_H1) }
    if (PHON(PH_GIN) && lo <= PH_GIN && PH_GIN < hi) { REP(PH_GIN) {
        { pg8::PlainSched S; S.init(NT, 2048, G, c, p.ws + O_H, D, p.ws + O_WIN, D);
          pg8::EpiBf16 E; E.O = (bf16_t*)(p.ws + O_Z); E.ldc = ZC; E.scale = 1.f;
          pg8::gemm_phase(lds, pg8::Gemm{D, D, D}, S, E); }
        { pg8::PlainSched S; S.init(NT, ZC - 2048, G, c, p.ws + O_H8, D / 2, p.ws + O_WIN8 + (size_t)2048 * D, D / 2);
          pg8::EpiBf16 E; E.O = (bf16_t*)(p.ws + O_Z) + 2048; E.ldc = ZC; E.scale = pg8::W8_INV;
          pg8::gemm_phase_fp8(lds, pg8::Gemm{D / 2, D / 2, D / 2}, S, E); }
        } SEAM(PH_GIN) }
    if (PHON(PH_ZPOST) && lo <= PH_ZPOST && PH_ZPOST < hi) { REP(PH_ZPOST) { phase_zpost(p); } SEAM(PH_ZPOST) }
    if (PHON(PH_GQ) && lo <= PH_GQ && PH_GQ < hi) { REP(PH_GQ) {
        { pg8::PlainSched S; S.init(NT, QC, G, c, p.ws + O_CQN, 512, p.ws + O_WQ, 512);
          pg8::EpiBf16 E; E.O = (bf16_t*)(p.ws + O_QALL); E.ldc = QC; E.scale = 1.f;
          pg8::gemm_phase(lds, pg8::Gemm{512, 512, 512}, S, E); }
        { pg8::C1Sched S; S.G = G; S.c = c; S.kvs = p.ws + O_KVS; S.w = p.ws + O_WC1;
          pg8::EpiC1 E; E.C = (float*)(p.ws + O_C1P);
          pg8::gemm_phase(lds, pg8::Gemm{2048, 4096, 256}, S, E); }
        } SEAM(PH_GQ) }
    if (PHON(PH_IDX) && lo <= PH_IDX && PH_IDX < hi) { REP(PH_IDX) {
#ifdef IDX_NAIVE
        phase_indexer(p, smem);
#else
        phase_indexer_mfma(p, smem);
#endif
        } SEAM(PH_IDX) }
    if (PHON(PH_MLA) && lo <= PH_MLA && PH_MLA < hi) { REP(PH_MLA) {
#ifdef MLA_NAIVE
        phase_mla(p, smem);
#else
        phase_mla_mfma(p, smem);
#endif
        } SEAM(PH_MLA) }
    if (PHON(PH_NSA) && lo <= PH_NSA && PH_NSA < hi) { REP(PH_NSA) {
#ifdef NSA_NAIVE
        phase_nsa(p, smem);
#else
        phase_nsa_mfma(p, smem);
#endif
        } SEAM(PH_NSA) }
    if (PHON(PH_MERGE) && lo <= PH_MERGE && PH_MERGE < hi) { REP(PH_MERGE) {
        { pg8::PlainSched S; S.init(NT, D, G, c, p.ws + O_OLAT, D / 2, p.ws + O_WO, D / 2);
          pg8::EpiMerge<false> E; E.P = (bf16_t*)(p.ws + O_MERGED); E.O8 = nullptr; E.Z = (const bf16_t*)(p.ws + O_Z); E.gcol0 = ZC_MG; E.scale = pg8::A8W8_INV;
          pg8::gemm_phase_fp8(lds, pg8::Gemm{D / 2, D / 2, D / 2}, S, E); }
        { pg8::PlainSched S; S.init(NT, D, G, c, p.ws + O_OB8, 512, p.ws + O_WBRB, 512);
          pg8::EpiMerge<true> E; E.P = (bf16_t*)(p.ws + O_MERGED); E.O8 = (unsigned char*)(p.ws + O_MG8); E.Z = (const bf16_t*)(p.ws + O_Z); E.gcol0 = ZC_MG + 2048; E.scale = pg8::A8W8_INV;
          pg8::gemm_phase_fp8(lds, pg8::Gemm{512, 512, 512}, S, E); }
        } SEAM(PH_MERGE) }
    if (PHON(PH_GOUT) && lo <= PH_GOUT && PH_GOUT < hi) { REP(PH_GOUT) {
        pg8::PlainSched S; S.init(NT, D, G, c, p.ws + O_MG8, D / 2, p.ws + O_WOUT, D / 2);
        pg8::EpiBf16 E; E.O = (bf16_t*)(p.ws + O_MO); E.ldc = D; E.scale = pg8::A8W8_INV;
        pg8::gemm_phase_fp8(lds, pg8::Gemm{D / 2, D / 2, D / 2}, S, E); } SEAM(PH_GOUT) }
    if (PHON(PH_POSTMIX) && lo <= PH_POSTMIX && PH_POSTMIX < hi) { REP(PH_POSTMIX) { phase_post_mix(p, smem, rep_ == 0); } SEAM(PH_POSTMIX) }
    if (PHON(PH_GATHER) && lo <= PH_GATHER && PH_GATHER < hi) { REP(PH_GATHER) { phase_moe_gather(p, smem); } SEAM(PH_GATHER) }
    if (PHON(PH_GU) && lo <= PH_GU && PH_GU < hi) { REP(PH_GU) {
        LAS int* tile_e = (LAS int*)(LAS char*)(smem + 131072); LAS int* pstart = tile_e + 320;
        const int mt = moe_tables(p, tile_e, pstart);
        pg8::MoeSched S; S.G = G; S.c = c; S.nN = 16; S.total = mt * 16; S.tile_e = tile_e; S.A = p.ws + O_HS; S.W = p.ws + O_WGU; S.w_exp = (size_t)4096 * D;
        pg8::EpiGU E; E.O = (unsigned char*)(p.ws + O_ACT); E.bias = p.b_gate_up;
        pg8::gemm_phase_fp8(lds, pg8::Gemm{D / 2, D / 2, D / 2, 64, 16384}, S, E); } SEAM(PH_GU) }
    if (PHON(PH_DN) && lo <= PH_DN && PH_DN < hi) { REP(PH_DN) {
        LAS int* tile_e = (LAS int*)(LAS char*)(smem + 131072); LAS int* pstart = tile_e + 320;
        const int mt = moe_tables(p, tile_e, pstart);
        pg8::MoeSched S; S.G = G; S.c = c; S.nN = 8; S.total = mt * 8; S.tile_e = tile_e; S.A = p.ws + O_ACT; S.W = p.ws + O_WDN; S.w_exp = (size_t)D * D;
        pg8::EpiDN E; E.O = (unsigned char*)(p.ws + O_YS); E.bias = p.b_down; E.slotw = (const float*)(p.ws + O_SLOTW);
        pg8::gemm_phase_fp8(lds, pg8::Gemm{D / 2, D / 2, D / 2, 64, 16384}, S, E); } SEAM(PH_DN) }
    if (PHON(PH_FINAL) && lo <= PH_FINAL && PH_FINAL < hi) { REP(PH_FINAL) { phase_final(p); } }
#undef SEAM
}

extern "C" void kernel_launch(void* const* d_in, const int* in_sizes, int n_in, void* d_out, int out_size, void* d_ws, size_t ws_size, hipStream_t stream) {
    static int grid = 0;
    if (grid == 0) {
        if (n_in != 33 || out_size != NT * D || ws_size < WS_END) { fprintf(stderr, "kernel_launch: unexpected shapes (n_in %d out %d ws %zu need %zu)\n", n_in, out_size, ws_size, (size_t)WS_END); grid = -1; return; }
        int dev = 0, cus = 0;
        if (hipGetDevice(&dev) != hipSuccess || hipDeviceGetAttribute(&cus, hipDeviceAttributeMultiprocessorCount, dev) != hipSuccess) { grid = -1; return; }
        if (hipFuncSetAttribute((const void*)mega, hipFuncAttributeMaxDynamicSharedMemorySize, LDS_BYTES) != hipSuccess) { fprintf(stderr, "kernel_launch: hipFuncSetAttribute failed\n"); grid = -1; return; }
        int per_cu = 0; (void)hipOccupancyMaxActiveBlocksPerMultiprocessor(&per_cu, (const void*)mega, 512, LDS_BYTES); (void)hipGetLastError();
        grid = cus;
    }
    if (grid < 0) return;
    Params p{};
    const float** pf = (const float**)&p;
    for (int i = 0; i < 33; ++i) pf[i] = (const float*)d_in[i];
    p.pos = (const int*)d_in[2];
    p.out = (float*)d_out; p.ws = (char*)d_ws;
    hipMemsetAsync(d_ws, 0, ZERO_BYTES, stream);
#ifdef MK_UNFUSED
    for (int ph = 0; ph < PH_END; ++ph) hipLaunchKernelGGL(mega, dim3(grid), dim3(512), LDS_BYTES, stream, p, ph, ph + 1);
#else
    hipLaunchKernelGGL(mega, dim3(grid), dim3(512), LDS_BYTES, stream, p, 0, (int)PH_END);
#endif
}
```

```cpp
#include <hip/hip_runtime.h>
#include <stdint.h>
#include <stdio.h>

#define LAS __attribute__((address_space(3)))
#define DI __device__ __forceinline__
typedef unsigned short bf16_t;
typedef short bf16x8 __attribute__((ext_vector_type(8)));
typedef float f32x4 __attribute__((ext_vector_type(4)));
typedef unsigned u32x4 __attribute__((ext_vector_type(4)));
typedef unsigned u32x2 __attribute__((ext_vector_type(2)));

#define PREP_PROBE_WC 0
#define PREP_PROBE_MODE 0
#define PREP_REP 0
#define PREP_REP_LO 0
#define PREP_REP_HI 100000
#define PREP_PROBE_NFAST 0
constexpr int NB = 2, T = 8192, NT = NB * T, D = 2048;
constexpr int ZC = 7680;
constexpr int ZC_CKV = 512, ZC_KROPE = 768, ZC_KIDX = 800, ZC_WIDX = 864, ZC_BGATE = 872, ZC_BQ = 1024, ZC_MG = 3584;
constexpr int QC = 2816;
constexpr int KVW = 288;
constexpr int NEXP = 32, SLOTS = 73728, MAXMT = SLOTS / 256;
constexpr float NORM_EPS = 1e-6f;
constexpr float ATT_SCALE = 0.08838834764831845f;
constexpr int LDS_BYTES = 152 * 1024;

constexpr size_t al256(size_t x) { return (x + 255) & ~(size_t)255; }
constexpr size_t ZERO_BYTES = 131072;
constexpr size_t O_MODACC = 16384, O_CNT = 114688;
constexpr size_t O_ROPE = ZERO_BYTES;
constexpr size_t O_WIN = O_ROPE + al256((size_t)NT * 48 * 4);
constexpr size_t O_WQ = O_WIN + al256((size_t)ZC * D * 2);
constexpr size_t O_WO = O_WQ + al256((size_t)QC * 512 * 2);
constexpr size_t O_WBRB = O_WO + al256((size_t)D * D * 2);
constexpr size_t O_WOUT = O_WBRB + al256((size_t)D * 1024 * 2);
constexpr size_t O_WC1 = O_WOUT + al256((size_t)D * D * 2);
constexpr size_t O_CBIAS = O_WC1 + al256((size_t)2 * 256 * 4096 * 2);
constexpr size_t O_CBP = O_CBIAS + al256(2 * 256 * 4);
constexpr size_t O_WRT = O_CBP + al256(64 * 2 * 256 * 4);
constexpr size_t O_WGU = O_WRT + al256((size_t)256 * D * 2);
constexpr size_t O_WDN = O_WGU + al256((size_t)NEXP * 4096 * D * 2);
constexpr size_t O_H = O_WDN + al256((size_t)NEXP * D * D * 2);
constexpr size_t O_Z = O_H + al256((size_t)NT * D * 2);
constexpr size_t O_CQN = O_Z + al256((size_t)NT * ZC * 2);
constexpr size_t O_KVT = O_CQN + al256((size_t)NT * 512 * 2);
constexpr size_t O_KIDX = O_KVT + al256((size_t)NT * KVW * 2);
constexpr size_t O_WIDX = O_KIDX + al256((size_t)NT * 64 * 2);
constexpr size_t O_GATES = O_WIDX + al256((size_t)NT * 8 * 4);
constexpr size_t O_BQ = O_GATES + al256((size_t)NT * 24 * 4);
constexpr size_t KVS_ONE = (size_t)NB * 2 * T * 128;
constexpr size_t O_KVS = O_BQ + al256((size_t)NT * 1024 * 2);
constexpr size_t O_QALL = O_KVS + al256(6 * KVS_ONE * 2 + 65536);
constexpr size_t O_C1P = O_QALL + al256((size_t)NT * QC * 2);
constexpr size_t O_KCVC = O_C1P + al256((size_t)16 * 2 * 2048 * 256 * 4);
constexpr size_t O_SEL = O_KCVC + al256((size_t)2 * 2048 * 128 * 2);
constexpr size_t O_NSEL = O_SEL + al256((size_t)NT * 256 * 2);
constexpr size_t O_OLAT = O_NSEL + al256((size_t)NT * 4);
constexpr size_t O_OB = O_OLAT + al256((size_t)NT * D * 2);
constexpr size_t O_MERGED = O_OB + al256((size_t)NT * 1024 * 2);
constexpr size_t O_MO = O_MERGED + al256((size_t)NT * D * 2);
constexpr size_t O_X1 = O_MO + al256((size_t)NT * D * 2);
constexpr size_t O_TOPI = O_X1 + al256((size_t)NT * D * 4);
constexpr size_t O_TOPW = O_TOPI + al256((size_t)NT * 4 * 4);
constexpr size_t O_TSLOT = O_TOPW + al256((size_t)NT * 4 * 4);
constexpr size_t O_SLOTW = O_TSLOT + al256((size_t)NT * 4 * 4);
constexpr size_t O_HS = O_SLOTW + al256((size_t)SLOTS * 4);
constexpr size_t O_ACT = O_HS + al256((size_t)SLOTS * D);
constexpr size_t O_YS = O_ACT + al256((size_t)SLOTS * D);
constexpr size_t O_OB8 = O_YS + al256((size_t)SLOTS * D * 2);
constexpr size_t O_MG8 = O_OB8 + al256((size_t)NT * 1024);
constexpr size_t O_WIN8 = O_MG8 + al256((size_t)NT * D);
constexpr size_t O_H8 = O_WIN8 + al256((size_t)ZC * D);
constexpr size_t WS_END = O_H8 + al256((size_t)NT * D);

struct Params {
    const float* x; const float* c; const int* pos; const float* w_ada; const float* b_ada;
    const float* g_pre_mix; const float* g_post_mix; const float* g_pre_ffn; const float* g_post_ffn;
    const float* w_in; const float* a_cq_norm; const float* a_ckv_norm; const float* a_w_uq; const float* a_w_uk; const float* a_w_uv;
    const float* idx_w_q; const float* idx_g; const float* idx_b;
    const float* cmp_k_pe; const float* cmp_k_w1; const float* cmp_k_w2; const float* cmp_v_pe; const float* cmp_v_w1; const float* cmp_v_w2;
    const float* w_br_a; const float* w_br_b; const float* w_out; const float* w_router; const float* b_router;
    const float* w_gate_up; const float* b_gate_up; const float* w_down; const float* b_down;
    float* out; char* ws;
};

DI int tid_fresh() { int t = threadIdx.x; asm volatile("" : "+v"(t)); return t; }
DI float bf2f(bf16_t v) { return __uint_as_float((unsigned)v << 16); }
DI float bflo(unsigned w) { return __uint_as_float(w << 16); }
DI float bfhi(unsigned w) { return __uint_as_float(w & 0xffff0000u); }
DI bf16_t f2bf(float f) { unsigned u = __float_as_uint(f); u += 0x7FFFu + ((u >> 16) & 1u); return (bf16_t)(u >> 16); }
DI unsigned pk2(float lo, float hi) { unsigned r; asm volatile("v_cvt_pk_bf16_f32 %0, %1, %2" : "=v"(r) : "v"(lo), "v"(hi)); return r; }
DI float wave_sum(float v) {
#pragma unroll
    for (int o = 1; o < 64; o <<= 1) v += __shfl_xor(v, o);
    return v;
}
DI float wave_max(float v) {
#pragma unroll
    for (int o = 1; o < 64; o <<= 1) v = fmaxf(v, __shfl_xor(v, o));
    return v;
}
DI float sigmoidf_(float v) { return 1.f / (1.f + __expf(-v)); }
DI void unpack8(const u32x4& w, float (&f)[8]) {
    f[0] = bflo(w[0]); f[1] = bfhi(w[0]); f[2] = bflo(w[1]); f[3] = bfhi(w[1]); f[4] = bflo(w[2]); f[5] = bfhi(w[2]); f[6] = bflo(w[3]); f[7] = bfhi(w[3]);
}
DI float mod_at(const Params& p, int b, int j) { return ((const float*)(p.ws + O_MODACC))[b * 12288 + j]; }

#define XB_TMO      128
#define XB_XCNT(j)  (256  + 64 * (j))
#define XB_XSUB(j)  (1280 + 64 * (j))
#define XB_XGEN(j)  (2304 + 64 * (j))
#define XB_TOP      3328
#define XB_TOPGEN   3392
#define XCD_BAR_WORDS 3456
#define XB_SPIN_CAP (1u << 22)
DI unsigned xb_ld(unsigned* p)              { return __hip_atomic_load(p, __ATOMIC_RELAXED, __HIP_MEMORY_SCOPE_AGENT); }
DI unsigned xb_add(unsigned* p, unsigned v) { return __hip_atomic_fetch_add(p, v, __ATOMIC_RELAXED, __HIP_MEMORY_SCOPE_AGENT); }
DI unsigned xb_xcc_id() { return (unsigned)__builtin_amdgcn_s_getreg((3 << 11) | 20) & 0xFu; }
#define XB_SPIN(cond, bar) do { unsigned _sp = 0; while (cond) { __builtin_amdgcn_s_sleep(1); \
    if ((++_sp & 255u) == 0u) { if (xb_ld(&(bar)[XB_TMO])) break; if (_sp > XB_SPIN_CAP) { atomicAdd(&(bar)[XB_TMO], 1u); break; } } } } while (0)
struct XcdBarrier { unsigned* bar; unsigned x; volatile LAS unsigned* st; };
DI XcdBarrier xcd_barrier_post(unsigned* bar, volatile LAS unsigned* st) {
    XcdBarrier b; b.bar = bar; b.x = xb_xcc_id(); b.st = st;
    if (threadIdx.x == 0) (void)xb_add(&bar[XB_XCNT(b.x)], 1u);
    return b;
}
DI void xcd_barrier_complete(unsigned* bar, unsigned x, unsigned& nloc, unsigned& nx) {
    const unsigned G = gridDim.x * gridDim.y * gridDim.z;
    unsigned sum, cnt, mine, sp = 0u;
    for (;;) {
        sum = 0u; cnt = 0u; mine = 0u;
#pragma unroll
        for (unsigned j = 0; j < 16; ++j) { const unsigned c = xb_ld(&bar[XB_XCNT(j)]); sum += c; cnt += (c > 0u) ? 1u : 0u; mine = (j == x) ? c : mine; }
        if (sum == G) break;
        __builtin_amdgcn_s_sleep(1);
        if ((++sp & 255u) == 0u) { if (xb_ld(&bar[XB_TMO])) break; if (sp > XB_SPIN_CAP) { atomicAdd(&bar[XB_TMO], 1u); break; } }
    }
    nloc = mine > 0u ? mine : 1u; nx = cnt > 0u ? cnt : 1u;
}
DI void xcd_barrier(const XcdBarrier& b) {
    asm volatile("s_waitcnt vmcnt(0)" ::: "memory");
    __syncthreads();
    if (threadIdx.x == 0) {
        unsigned* bar = b.bar;
        __builtin_amdgcn_s_waitcnt(0);
        unsigned nloc = b.st[0], nx = b.st[1];
        if (nloc == 0u) { xcd_barrier_complete(bar, b.x, nloc, nx); b.st[0] = nloc; b.st[1] = nx; }
        const unsigned old = xb_add(&bar[XB_XSUB(b.x)], 1u);
        const unsigned gen = old / nloc;
        if (old + 1u == (gen + 1u) * nloc) {
            __builtin_amdgcn_fence(__ATOMIC_RELEASE, "agent");
            asm volatile("s_waitcnt vmcnt(0)" ::: "memory");
            const unsigned og = xb_add(&bar[XB_TOP], 1u);
            const unsigned tg = og / nx;
            if (og + 1u == (tg + 1u) * nx) xb_add(&bar[XB_TOPGEN], 1u);
            else XB_SPIN(xb_ld(&bar[XB_TOPGEN]) == tg, bar);
            __builtin_amdgcn_fence(__ATOMIC_ACQUIRE, "agent");
            xb_add(&bar[XB_XGEN(b.x)], 1u);
            asm volatile("s_waitcnt vmcnt(0)" ::: "memory");
        } else {
            XB_SPIN(xb_ld(&bar[XB_XGEN(b.x)]) == gen, bar);
            __builtin_amdgcn_fence(__ATOMIC_ACQUIRE, "agent");
            asm volatile("s_waitcnt vmcnt(0)" ::: "memory");
        }
    }
    __syncthreads();
}

namespace pg8 {
constexpr int BM = 256, BK = 64, HALF = 128, HTB = HALF * BK * 2, STAGE_BYTES = 8 * HTB, NXCD = 8, WGM = 8;
DI int lds_byte(int r, int c) { const int st = (r >> 4) * 2 + (c >> 5), rr = r & 15, cc = c & 31, ob = rr * 64 + cc * 2; return st * 1024 + (ob ^ (((ob >> 9) & 1) << 5)); }
DI void stage_rc(int b, int& R, int& C) { const int st = b / 1024, sb = b % 1024, swz = sb ^ (((sb >> 9) & 1) << 5); R = (st >> 1) * 16 + swz / 64; C = (st & 1) * 32 + (swz % 64) / 2; }
DI int perm32(int rho) { const int n = rho >> 4, i = rho & 15; return 8 * (i >> 2) + 4 * n + (i & 3); }

struct Unit { int pm, pn, e; const char* a; const char* b; };
struct Gemm { int lda, ldb, K; int brow = ldb; int bk = BK * 2; };

struct PlainSched {
    int nM, nN, nwg, G, c; const char* A; const char* Bt; size_t a_tile, b_tile;
    DI void init(int M, int N, int G_, int c_, const void* A_, int lda, const void* Bt_, int ldb) {
        nM = M / BM; nN = N / BM; nwg = nM * nN; G = G_; c = c_; A = (const char*)A_; Bt = (const char*)Bt_; a_tile = (size_t)BM * lda * 2; b_tile = (size_t)BM * ldb * 2; }
    DI bool next(int i, Unit& u) const {
        const long L = (long)i * G + c; if (L >= nwg) return false;
        int wgid = (int)L; { const int q = nwg / NXCD, r = nwg % NXCD, xcd = wgid % NXCD, off = wgid / NXCD; wgid = (xcd < r ? xcd * (q + 1) : r * (q + 1) + (xcd - r) * q) + off; }
        const int nig = WGM * nN, gid = wgid / nig, fm = gid * WGM, gsz = (nM - fm) < WGM ? (nM - fm) : WGM;
        u.pm = fm + ((wgid % nig) % gsz); u.pn = (wgid % nig) / gsz; u.e = 0;
        u.a = A + (size_t)u.pm * a_tile; u.b = Bt + (size_t)u.pn * b_tile; return true;
    }
};

typedef int v4i_t __attribute__((ext_vector_type(4)));
typedef int v8i_t __attribute__((ext_vector_type(8)));
#ifndef PG8_SP2
#define PG8_SP2 true
#endif
template <class Epi, class Sched, bool SP2 = PG8_SP2>
DI void gemm_phase(LAS unsigned char* lds, const Gemm g, const Sched& S, const Epi& E) {
    const int tid = tid_fresh(), wid = __builtin_amdgcn_readfirstlane(tid >> 6), lane = tid & 63, wr = wid >> 2, wc = wid & 3, fr = lane & 15, fq = lane >> 4;
    const int K = g.K, nt = K / BK;
    unsigned voffA[2], voffB[2];
#pragma unroll
    for (int i = 0; i < 2; ++i) { int R, C; stage_rc(tid * 16 + i * 8192, R, C); const int Rb = Epi::PERM ? ((R & ~31) + perm32(R & 31)) : R;
        voffA[i] = (unsigned)(R * g.lda + C) * 2u; voffB[i] = (unsigned)(Rb * g.ldb + C) * 2u; }
    const size_t kstep = (size_t)(BK * 2);
    const size_t hstepA = (size_t)HALF * g.lda * 2, hstepB = (size_t)HALF * g.ldb * 2;
    const unsigned ldsw = (unsigned)wid * 1024u;
    const int aoff = lds_byte(wr * 64 + fr, fq * 8), boff = lds_byte(wc * 32 + fr, fq * 8);
#define PG8_SA(b, h) (((b) * 2 + (h)) * HTB)
#define PG8_SB(b, h) ((4 + (b) * 2 + (h)) * HTB)
#define PG8_STAGE(bufoff, gbase, voff) do { _Pragma("unroll") for (int _i = 0; _i < 2; ++_i) \
        __builtin_amdgcn_global_load_lds((const unsigned*)((const char*)(gbase) + (voff)[_i]), (LAS unsigned*)(lds + (bufoff) + ldsw + _i * 8192), 16, 0, 0); } while (0)
#define PG8_LDA(dst, b, h) do { _Pragma("unroll") for (int m = 0; m < 4; ++m) _Pragma("unroll") for (int k = 0; k < 2; ++k) dst[m][k] = *(const LAS bf16x8*)(lds + PG8_SA(b, h) + aoff + m * 2048 + k * 1024); } while (0)
#define PG8_LDB(dst, b, h) do { _Pragma("unroll") for (int n = 0; n < 2; ++n) _Pragma("unroll") for (int k = 0; k < 2; ++k) dst[n][k] = *(const LAS bf16x8*)(lds + PG8_SB(b, h) + boff + n * 2048 + k * 1024); } while (0)
#define PG8_MMA(ai, bj, At, Bt) do { __builtin_amdgcn_s_setprio(1); _Pragma("unroll") for (int m = 0; m < 4; ++m) _Pragma("unroll") for (int n = 0; n < 2; ++n) _Pragma("unroll") for (int k = 0; k < 2; ++k) \
        acc[ai][bj][m][n] = __builtin_amdgcn_mfma_f32_16x16x32_bf16(Bt[n][k], At[m][k], acc[ai][bj][m][n], 0, 0, 0); __builtin_amdgcn_s_setprio(0); } while (0)
#define PG8_WAIT_V(n) asm volatile("s_waitcnt vmcnt(" #n ")" ::: "memory")
#define PG8_WAIT_L(n) asm volatile("s_waitcnt lgkmcnt(" #n ")" ::: "memory")
#define PG8_BAR __builtin_amdgcn_s_barrier()
#define PG8_SCHED __builtin_amdgcn_sched_barrier(0)
    Unit cur, nxt; int ui = 0;
    if (!S.next(0, cur)) return;
    f32x4 acc[2][2][4][2];
#pragma unroll
    for (int a = 0; a < 2; ++a)
#pragma unroll
        for (int b = 0; b < 2; ++b)
#pragma unroll
            for (int m = 0; m < 4; ++m)
#pragma unroll
                for (int n = 0; n < 2; ++n) acc[a][b][m][n] = (f32x4){0.f, 0.f, 0.f, 0.f};
    bf16x8 At[4][2], B0[2][2], B1[2][2];
    const char* cA = cur.a; const char* cB = cur.b;
    if constexpr (SP2) {
        PG8_STAGE(PG8_SB(0, 0), cB, voffB); PG8_STAGE(PG8_SB(0, 1), cB + hstepB, voffB); PG8_STAGE(PG8_SA(0, 0), cA, voffA); PG8_STAGE(PG8_SA(0, 1), cA + hstepA, voffA);
        if (wr == 1) PG8_BAR;
        PG8_WAIT_V(2); PG8_BAR;
        PG8_STAGE(PG8_SB(1, 0), cB + kstep, voffB); PG8_STAGE(PG8_SA(1, 0), cA + kstep, voffA); PG8_STAGE(PG8_SB(1, 1), cB + hstepB + kstep, voffB);
        PG8_WAIT_V(6); PG8_BAR;
    } else {
        PG8_STAGE(PG8_SB(0, 0), cB, voffB); PG8_STAGE(PG8_SA(0, 0), cA, voffA); PG8_STAGE(PG8_SB(0, 1), cB + hstepB, voffB); PG8_STAGE(PG8_SA(0, 1), cA + hstepA, voffA);
        if (wr == 1) PG8_BAR;
        PG8_WAIT_V(4); PG8_BAR;
        PG8_STAGE(PG8_SB(1, 0), cB + kstep, voffB); PG8_STAGE(PG8_SA(1, 0), cA + kstep, voffA); PG8_STAGE(PG8_SB(1, 1), cB + hstepB + kstep, voffB);
        PG8_WAIT_V(6); PG8_BAR;
    }
    for (;;) {
        const bool has_next = S.next(ui + 1, nxt);
        const char* nA = has_next ? nxt.a : cA; const char* nB = has_next ? nxt.b : cB;
        for (int t = 0; t < nt; t += 2) {
            const bool last = (t == nt - 2);
            const char* a1 = cA + (size_t)(t + 1) * kstep;
            const char* a2 = last ? nA : cA + (size_t)(t + 2) * kstep; const char* b2 = last ? nB : cB + (size_t)(t + 2) * kstep;
            const char* a3 = a2 + kstep; const char* b3 = b2 + kstep;
            if constexpr (SP2) {
            PG8_LDB(B0, 0, 0); PG8_LDB(B1, 0, 1); PG8_SCHED; PG8_LDA(At, 0, 0); PG8_STAGE(PG8_SA(1, 1), a1 + hstepA, voffA);
            PG8_WAIT_V(8); PG8_WAIT_L(0); PG8_BAR; PG8_MMA(0, 0, At, B0); PG8_MMA(0, 1, At, B1); PG8_BAR; PG8_SCHED;
            PG8_LDA(At, 0, 1); PG8_STAGE(PG8_SB(0, 0), b2, voffB); PG8_STAGE(PG8_SB(0, 1), b2 + hstepB, voffB); PG8_STAGE(PG8_SA(0, 0), a2, voffA);
            PG8_WAIT_V(8); PG8_WAIT_L(0); PG8_BAR; PG8_MMA(1, 0, At, B0); PG8_MMA(1, 1, At, B1); PG8_BAR; PG8_SCHED;
            PG8_LDB(B0, 1, 0); PG8_LDB(B1, 1, 1); PG8_SCHED; PG8_LDA(At, 1, 0); PG8_STAGE(PG8_SA(0, 1), a2 + hstepA, voffA);
            PG8_WAIT_V(8); PG8_WAIT_L(0); PG8_BAR; PG8_MMA(0, 0, At, B0); PG8_MMA(0, 1, At, B1); PG8_BAR; PG8_SCHED;
            PG8_LDA(At, 1, 1); PG8_STAGE(PG8_SB(1, 0), b3, voffB); PG8_STAGE(PG8_SB(1, 1), b3 + hstepB, voffB); PG8_STAGE(PG8_SA(1, 0), a3, voffA);
            PG8_WAIT_V(8); PG8_WAIT_L(0); PG8_BAR; PG8_MMA(1, 0, At, B0); PG8_MMA(1, 1, At, B1); PG8_BAR; PG8_SCHED;
            } else {
            PG8_LDB(B0, 0, 0); PG8_SCHED; PG8_LDA(At, 0, 0); PG8_STAGE(PG8_SA(1, 1), a1 + hstepA, voffA);
            PG8_WAIT_L(8); PG8_BAR; PG8_WAIT_L(0); PG8_MMA(0, 0, At, B0); PG8_BAR; PG8_SCHED;
            PG8_LDB(B1, 0, 1); PG8_STAGE(PG8_SB(0, 0), b2, voffB);
            PG8_BAR; PG8_WAIT_L(0); PG8_MMA(0, 1, At, B1); PG8_BAR;
            PG8_LDA(At, 0, 1); PG8_STAGE(PG8_SA(0, 0), a2, voffA);
            PG8_BAR; PG8_WAIT_L(0); PG8_MMA(1, 0, At, B0); PG8_BAR; PG8_SCHED;
            PG8_STAGE(PG8_SB(0, 1), b2 + hstepB, voffB);
            PG8_WAIT_V(6); PG8_BAR; PG8_MMA(1, 1, At, B1); PG8_BAR;
            PG8_LDB(B0, 1, 0); PG8_SCHED; PG8_LDA(At, 1, 0); PG8_STAGE(PG8_SA(0, 1), a2 + hstepA, voffA);
            PG8_WAIT_L(8); PG8_BAR; PG8_WAIT_L(0); PG8_MMA(0, 0, At, B0); PG8_BAR; PG8_SCHED;
            PG8_LDB(B1, 1, 1); PG8_STAGE(PG8_SB(1, 0), b3, voffB);
            PG8_BAR; PG8_WAIT_L(0); PG8_MMA(0, 1, At, B1); PG8_BAR;
            PG8_LDA(At, 1, 1); PG8_STAGE(PG8_SA(1, 0), a3, voffA);
            PG8_BAR; PG8_WAIT_L(0); PG8_MMA(1, 0, At, B0); PG8_BAR; PG8_SCHED;
            PG8_STAGE(PG8_SB(1, 1), b3 + hstepB, voffB);
            PG8_WAIT_V(6); PG8_BAR; PG8_MMA(1, 1, At, B1); PG8_BAR;
            }
        }
        E(acc, cur, wr, wc, fr, fq);
        if (!has_next) break;
#pragma unroll
        for (int a = 0; a < 2; ++a)
#pragma unroll
            for (int b = 0; b < 2; ++b)
#pragma unroll
                for (int m = 0; m < 4; ++m)
#pragma unroll
                    for (int n = 0; n < 2; ++n) acc[a][b][m][n] = (f32x4){0.f, 0.f, 0.f, 0.f};
        cur = nxt; cA = nA; cB = nB; ++ui;
    }
    PG8_WAIT_V(0);
    if (wr == 0) PG8_BAR;
    PG8_BAR;
#undef PG8_SA
#undef PG8_SB
#undef PG8_STAGE
#undef PG8_LDA
#undef PG8_LDB
#undef PG8_MMA
#undef PG8_WAIT_V
#undef PG8_WAIT_L
#undef PG8_BAR
#undef PG8_SCHED
}

template <class Epi, class Sched, bool SP2 = PG8_SP2>
DI void gemm_phase_fp8(LAS unsigned char* lds, const Gemm g, const Sched& S, const Epi& E) {
    const int tid = tid_fresh(), wid = __builtin_amdgcn_readfirstlane(tid >> 6), lane = tid & 63, wr = wid >> 2, wc = wid & 3, fr = lane & 15, fq = lane >> 4;
    const int K = g.K, nt = K / BK;
    unsigned voffA[2], voffB[2];
#pragma unroll
    for (int i = 0; i < 2; ++i) { int R, C; stage_rc(tid * 16 + i * 8192, R, C); const int Rb = Epi::PERM ? ((R & ~31) + perm32(R & 31)) : R;
        voffA[i] = (unsigned)(R * g.lda + C) * 2u; voffB[i] = (unsigned)(Rb * g.brow + C) * 2u; }
    const size_t kstep = (size_t)(BK * 2), kstepB = (size_t)g.bk;
    const size_t hstepA = (size_t)HALF * g.lda * 2, hstepB = (size_t)HALF * g.ldb * 2;
    const unsigned ldsw = (unsigned)wid * 1024u;
    const int aoff = lds_byte(wr * 64 + fr, fq * 8), boff = lds_byte(wc * 32 + fr, fq * 8);
#define PG8_SA(b, h) (((b) * 2 + (h)) * HTB)
#define PG8_SB(b, h) ((4 + (b) * 2 + (h)) * HTB)
#define PG8_STAGE(bufoff, gbase, voff) do { _Pragma("unroll") for (int _i = 0; _i < 2; ++_i) \
        __builtin_amdgcn_global_load_lds((const unsigned*)((const char*)(gbase) + (voff)[_i]), (LAS unsigned*)(lds + (bufoff) + ldsw + _i * 8192), 16, 0, 0); } while (0)
#define PG8_LDA(dst, b, h) do { _Pragma("unroll") for (int m = 0; m < 4; ++m) { const v4i_t lo_ = *(const LAS v4i_t*)(lds + PG8_SA(b, h) + aoff + m * 2048), hi_ = *(const LAS v4i_t*)(lds + PG8_SA(b, h) + aoff + m * 2048 + 1024); dst[m] = __builtin_shufflevector(lo_, hi_, 0, 1, 2, 3, 4, 5, 6, 7); } } while (0)
#define PG8_LDB(dst, b, h) do { _Pragma("unroll") for (int n = 0; n < 2; ++n) { const v4i_t lo_ = *(const LAS v4i_t*)(lds + PG8_SB(b, h) + boff + n * 2048), hi_ = *(const LAS v4i_t*)(lds + PG8_SB(b, h) + boff + n * 2048 + 1024); dst[n] = __builtin_shufflevector(lo_, hi_, 0, 1, 2, 3, 4, 5, 6, 7); } } while (0)
#define PG8_MMA(ai, bj, At, Bt) do { __builtin_amdgcn_s_setprio(1); _Pragma("unroll") for (int m = 0; m < 4; ++m) _Pragma("unroll") for (int n = 0; n < 2; ++n) \
        asm volatile("v_mfma_scale_f32_16x16x128_f8f6f4 %0, %1, %2, %0, %3, %3 op_sel_hi:[0,0,0]" : "+v"(acc[ai][bj][m][n]) : "v"(Bt[n]), "v"(At[m]), "v"(sc127)); __builtin_amdgcn_s_setprio(0); } while (0)
#define PG8_WAIT_V(n) asm volatile("s_waitcnt vmcnt(" #n ")" ::: "memory")
#define PG8_WAIT_L(n) asm volatile("s_waitcnt lgkmcnt(" #n ")" ::: "memory")
#define PG8_BAR __builtin_amdgcn_s_barrier()
#define PG8_SCHED __builtin_amdgcn_sched_barrier(0)
    Unit cur, nxt; int ui = 0;
    if (!S.next(0, cur)) return;
    f32x4 acc[2][2][4][2];
#pragma unroll
    for (int a = 0; a < 2; ++a)
#pragma unroll
        for (int b = 0; b < 2; ++b)
#pragma unroll
            for (int m = 0; m < 4; ++m)
#pragma unroll
                for (int n = 0; n < 2; ++n) acc[a][b][m][n] = (f32x4){0.f, 0.f, 0.f, 0.f};
    v8i_t At[4], B0[2], B1[2];
    int sc127 = 127; asm volatile("" : "+v"(sc127));
    const char* cA = cur.a; const char* cB = cur.b;
    if constexpr (SP2) {
        PG8_STAGE(PG8_SB(0, 0), cB, voffB); PG8_STAGE(PG8_SB(0, 1), cB + hstepB, voffB); PG8_STAGE(PG8_SA(0, 0), cA, voffA); PG8_STAGE(PG8_SA(0, 1), cA + hstepA, voffA);
        if (wr == 1) PG8_BAR;
        PG8_WAIT_V(2); PG8_BAR;
        PG8_STAGE(PG8_SB(1, 0), cB + kstepB, voffB); PG8_STAGE(PG8_SA(1, 0), cA + kstep, voffA); PG8_STAGE(PG8_SB(1, 1), cB + hstepB + kstepB, voffB);
        PG8_WAIT_V(6); PG8_BAR;
    } else {
        PG8_STAGE(PG8_SB(0, 0), cB, voffB); PG8_STAGE(PG8_SA(0, 0), cA, voffA); PG8_STAGE(PG8_SB(0, 1), cB + hstepB, voffB); PG8_STAGE(PG8_SA(0, 1), cA + hstepA, voffA);
        if (wr == 1) PG8_BAR;
        PG8_WAIT_V(4); PG8_BAR;
        PG8_STAGE(PG8_SB(1, 0), cB + kstepB, voffB); PG8_STAGE(PG8_SA(1, 0), cA + kstep, voffA); PG8_STAGE(PG8_SB(1, 1), cB + hstepB + kstepB, voffB);
        PG8_WAIT_V(6); PG8_BAR;
    }
    for (;;) {
        const bool has_next = S.next(ui + 1, nxt);
        const char* nA = has_next ? nxt.a : cA; const char* nB = has_next ? nxt.b : cB;
        for (int t = 0; t < nt; t += 2) {
            const bool last = (t == nt - 2);
            const char* a1 = cA + (size_t)(t + 1) * kstep;
            const char* a2 = last ? nA : cA + (size_t)(t + 2) * kstep; const char* b2 = last ? nB : cB + (size_t)(t + 2) * kstepB;
            const char* a3 = a2 + kstep; const char* b3 = b2 + kstepB;
            if constexpr (SP2) {
            PG8_LDB(B0, 0, 0); PG8_LDB(B1, 0, 1); PG8_SCHED; PG8_LDA(At, 0, 0); PG8_STAGE(PG8_SA(1, 1), a1 + hstepA, voffA);
            PG8_WAIT_V(8); PG8_WAIT_L(0); PG8_BAR; PG8_MMA(0, 0, At, B0); PG8_MMA(0, 1, At, B1); PG8_BAR; PG8_SCHED;
            PG8_LDA(At, 0, 1); PG8_STAGE(PG8_SB(0, 0), b2, voffB); PG8_STAGE(PG8_SB(0, 1), b2 + hstepB, voffB); PG8_STAGE(PG8_SA(0, 0), a2, voffA);
            PG8_WAIT_V(8); PG8_WAIT_L(0); PG8_BAR; PG8_MMA(1, 0, At, B0); PG8_MMA(1, 1, At, B1); PG8_BAR; PG8_SCHED;
            PG8_LDB(B0, 1, 0); PG8_LDB(B1, 1, 1); PG8_SCHED; PG8_LDA(At, 1, 0); PG8_STAGE(PG8_SA(0, 1), a2 + hstepA, voffA);
            PG8_WAIT_V(8); PG8_WAIT_L(0); PG8_BAR; PG8_MMA(0, 0, At, B0); PG8_MMA(0, 1, At, B1); PG8_BAR; PG8_SCHED;
            PG8_LDA(At, 1, 1); PG8_STAGE(PG8_SB(1, 0), b3, voffB); PG8_STAGE(PG8_SB(1, 1), b3 + hstepB, voffB); PG8_STAGE(PG8_SA(1, 0), a3, voffA);
            PG8_WAIT_V(8); PG8_WAIT_L(0); PG8_BAR; PG8_MMA(1, 0, At, B0); PG8_MMA(1, 1, At, B1); PG8_BAR; PG8_SCHED;
            } else {
            PG8_LDB(B0, 0, 0); PG8_SCHED; PG8_LDA(At, 0, 0); PG8_STAGE(PG8_SA(1, 1), a1 + hstepA, voffA);
            PG8_WAIT_L(8); PG8_BAR; PG8_WAIT_L(0); PG8_MMA(0, 0, At, B0); PG8_BAR; PG8_SCHED;
            PG8_LDB(B1, 0, 1); PG8_STAGE(PG8_SB(0, 0), b2, voffB);
            PG8_BAR; PG8_WAIT_L(0); PG8_MMA(0, 1, At, B1); PG8_BAR;
            PG8_LDA(At, 0, 1); PG8_STAGE(PG8_SA(0, 0), a2, voffA);
            PG8_BAR; PG8_WAIT_L(0); PG8_MMA(1, 0, At, B0); PG8_BAR; PG8_SCHED;
            PG8_STAGE(PG8_SB(0, 1), b2 + hstepB, voffB);
            PG8_WAIT_V(6); PG8_BAR; PG8_MMA(1, 1, At, B1); PG8_BAR;
            PG8_LDB(B0, 1, 0); PG8_SCHED; PG8_LDA(At, 1, 0); PG8_STAGE(PG8_SA(0, 1), a2 + hstepA, voffA);
            PG8_WAIT_L(8); PG8_BAR; PG8_WAIT_L(0); PG8_MMA(0, 0, At, B0); PG8_BAR; PG8_SCHED;
            PG8_LDB(B1, 1, 1); PG8_STAGE(PG8_SB(1, 0), b3, voffB);
            PG8_BAR; PG8_WAIT_L(0); PG8_MMA(0, 1, At, B1); PG8_BAR;
            PG8_LDA(At, 1, 1); PG8_STAGE(PG8_SA(1, 0), a3, voffA);
            PG8_BAR; PG8_WAIT_L(0); PG8_MMA(1, 0, At, B0); PG8_BAR; PG8_SCHED;
            PG8_STAGE(PG8_SB(1, 1), b3 + hstepB, voffB);
            PG8_WAIT_V(6); PG8_BAR; PG8_MMA(1, 1, At, B1); PG8_BAR;
            }
        }
        asm volatile("s_nop 15\n\ts_nop 15" ::: "memory");
        E(acc, cur, wr, wc, fr, fq);
        if (!has_next) break;
#pragma unroll
        for (int a = 0; a < 2; ++a)
#pragma unroll
            for (int b = 0; b < 2; ++b)
#pragma unroll
                for (int m = 0; m < 4; ++m)
#pragma unroll
                    for (int n = 0; n < 2; ++n) acc[a][b][m][n] = (f32x4){0.f, 0.f, 0.f, 0.f};
        cur = nxt; cA = nA; cB = nB; ++ui;
    }
    PG8_WAIT_V(0);
    if (wr == 0) PG8_BAR;
    PG8_BAR;
#undef PG8_SA
#undef PG8_SB
#undef PG8_STAGE
#undef PG8_LDA
#undef PG8_LDB
#undef PG8_MMA
#undef PG8_WAIT_V
#undef PG8_WAIT_L
#undef PG8_BAR
#undef PG8_SCHED
}

typedef f32x4 Acc[2][2][4][2];
struct EpiBf16 {
    static constexpr bool PERM = true; bf16_t* O; int ldc; float scale;
    DI void operator()(const Acc& acc, const Unit& u, int wr, int wc, int fr, int fq) const {
        const int row0 = u.pm * BM + wr * 64 + fr, col0 = u.pn * BM + wc * 32 + 8 * fq;
#pragma unroll
        for (int ai = 0; ai < 2; ++ai)
#pragma unroll
            for (int m = 0; m < 4; ++m) { bf16_t* rowp = O + (size_t)(row0 + ai * HALF + m * 16) * ldc + col0;
#pragma unroll
                for (int bj = 0; bj < 2; ++bj) { const f32x4 v0 = acc[ai][bj][m][0] * scale, v1 = acc[ai][bj][m][1] * scale;
                    *(u32x4*)(rowp + bj * HALF) = (u32x4){pk2(v0[0], v0[1]), pk2(v0[2], v0[3]), pk2(v1[0], v1[1]), pk2(v1[2], v1[3])}; } }
    }
};
struct EpiC1 {
    static constexpr bool PERM = false; float* C;
    DI void operator()(const Acc& acc, const Unit& u, int wr, int wc, int fr, int fq) const {
        const int row0 = u.pm * BM + wr * 64 + fr, col0 = wc * 32 + 4 * fq;
        float* base = C + (size_t)u.e * 2048 * 256;
#pragma unroll
        for (int ai = 0; ai < 2; ++ai)
#pragma unroll
            for (int m = 0; m < 4; ++m) { float* rowp = base + (size_t)(row0 + ai * HALF + m * 16) * 256 + col0;
#pragma unroll
                for (int bj = 0; bj < 2; ++bj)
#pragma unroll
                    for (int n = 0; n < 2; ++n) *(f32x4*)(rowp + bj * HALF + n * 16) = acc[ai][bj][m][n]; }
    }
};
DI float clamp8(float v) { return __builtin_amdgcn_fmed3f(v, -448.f, 448.f); }
DI unsigned fp8x4(float a, float b, float c, float d) { int w = 0; w = __builtin_amdgcn_cvt_pk_fp8_f32(clamp8(a), clamp8(b), w, false); w = __builtin_amdgcn_cvt_pk_fp8_f32(clamp8(c), clamp8(d), w, true); return (unsigned)w; }
constexpr float W8_SCALE = 256.f, W8_INV = 1.f / 256.f, A8_SCALE = 16.f, A8W8_INV = 1.f / 4096.f, Y8_SCALE = 32.f, Y8_INV = 1.f / 32.f;
template <bool ADD> struct EpiMerge {
    static constexpr bool PERM = true; bf16_t* P; unsigned char* O8; const bf16_t* Z; int gcol0; float scale;
    DI void operator()(const Acc& acc, const Unit& u, int wr, int wc, int fr, int fq) const {
        const int row0 = u.pm * BM + wr * 64 + fr, col0 = u.pn * BM + wc * 32 + 8 * fq;
#pragma unroll
        for (int ai = 0; ai < 2; ++ai) {
            u32x4 gz[4][2], pz[4][2];
#pragma unroll
            for (int m = 0; m < 4; ++m) { const size_t row = (size_t)(row0 + ai * HALF + m * 16);
#pragma unroll
                for (int bj = 0; bj < 2; ++bj) { const int col = col0 + bj * HALF; gz[m][bj] = *(const u32x4*)(Z + row * ZC + gcol0 + col); if (ADD) pz[m][bj] = *(const u32x4*)(P + row * D + col); } }
#pragma unroll
            for (int m = 0; m < 4; ++m) { const size_t row = (size_t)(row0 + ai * HALF + m * 16);
#pragma unroll
                for (int bj = 0; bj < 2; ++bj) { const int col = col0 + bj * HALF;
                    float g[8], o[8]; unpack8(gz[m][bj], g);
                    const f32x4 v0 = acc[ai][bj][m][0] * scale, v1 = acc[ai][bj][m][1] * scale;
                    if (ADD) unpack8(pz[m][bj], o);
#pragma unroll
                    for (int j = 0; j < 8; ++j) { const float a = j < 4 ? v0[j & 3] : v1[j & 3]; o[j] = (ADD ? o[j] : 0.f) + sigmoidf_(g[j]) * a; }
                    if (ADD) *(u32x2*)(O8 + row * D + col) = (u32x2){fp8x4(o[0] * A8_SCALE, o[1] * A8_SCALE, o[2] * A8_SCALE, o[3] * A8_SCALE), fp8x4(o[4] * A8_SCALE, o[5] * A8_SCALE, o[6] * A8_SCALE, o[7] * A8_SCALE)};
                    else *(u32x4*)(P + row * D + col) = (u32x4){pk2(o[0], o[1]), pk2(o[2], o[3]), pk2(o[4], o[5]), pk2(o[6], o[7])}; } }
        }
    }
};
struct EpiGU {
    static constexpr bool PERM = true; unsigned char* O; const float* bias;
    DI void operator()(const Acc& acc, const Unit& u, int wr, int wc, int fr, int fq) const {
        const int row0 = u.pm * BM + wr * 64 + fr, c0 = u.pn * HALF + wc * 32 + 8 * fq;
        const float* bg = bias + (size_t)u.e * 4096 + c0; const float* bu = bg + 2048;
        float bgv[8], buv[8];
#pragma unroll
        for (int j = 0; j < 8; ++j) { bgv[j] = bg[j]; buv[j] = bu[j]; }
#pragma unroll
        for (int ai = 0; ai < 2; ++ai)
#pragma unroll
            for (int m = 0; m < 4; ++m) { unsigned char* rowp = O + (size_t)(row0 + ai * HALF + m * 16) * D + c0;
                float o[8];
#pragma unroll
                for (int j = 0; j < 8; ++j) { float gt = (j < 4 ? acc[ai][0][m][0][j & 3] : acc[ai][0][m][1][j & 3]) * W8_INV + bgv[j];
                    float up = (j < 4 ? acc[ai][1][m][0][j & 3] : acc[ai][1][m][1][j & 3]) * W8_INV + buv[j];
                    gt = fminf(gt, 7.f); up = fminf(fmaxf(up, -7.f), 7.f);
                    o[j] = gt * sigmoidf_(1.702f * gt) * (up + 1.f); }
                *(u32x2*)rowp = (u32x2){fp8x4(o[0], o[1], o[2], o[3]), fp8x4(o[4], o[5], o[6], o[7])}; }
    }
};
struct EpiDN {
    static constexpr bool PERM = true; unsigned char* O; const float* bias; const float* slotw;
    DI void operator()(const Acc& acc, const Unit& u, int wr, int wc, int fr, int fq) const {
        const int row0 = u.pm * BM + wr * 64 + fr, col0 = u.pn * BM + wc * 32 + 8 * fq;
        float bv[2][8];
#pragma unroll
        for (int bj = 0; bj < 2; ++bj)
#pragma unroll
            for (int j = 0; j < 8; ++j) bv[bj][j] = bias[(size_t)u.e * D + col0 + bj * HALF + j];
        float sw[2][4];
#pragma unroll
        for (int ai = 0; ai < 2; ++ai)
#pragma unroll
            for (int m = 0; m < 4; ++m) sw[ai][m] = slotw[row0 + ai * HALF + m * 16];
#pragma unroll
        for (int ai = 0; ai < 2; ++ai)
#pragma unroll
            for (int m = 0; m < 4; ++m) { const int row = row0 + ai * HALF + m * 16; const float w = sw[ai][m] * Y8_SCALE; unsigned char* rowp = O + (size_t)row * D + col0;
#pragma unroll
                for (int bj = 0; bj < 2; ++bj) { float o[8];
#pragma unroll
                    for (int j = 0; j < 8; ++j) o[j] = ((j < 4 ? acc[ai][bj][m][0][j & 3] : acc[ai][bj][m][1][j & 3]) * W8_INV + bv[bj][j]) * w;
                    *(u32x2*)(rowp + bj * HALF) = (u32x2){fp8x4(o[0], o[1], o[2], o[3]), fp8x4(o[4], o[5], o[6], o[7])}; } }
    }
};
struct C1Sched {
    int G, c; const char* kvs; const char* w;
    DI bool next(int i, Unit& u) const {
        const int L = i * G + c; if (L >= 256) return false;
        const int kv = L >> 7, s = (L >> 3) & 15, pm = L & 7;
        u.pm = pm; u.pn = 0; u.e = s * 2 + kv;
        u.a = kvs + ((size_t)kv * KVS_ONE + (size_t)pm * 256 * 2048 + (size_t)s * 256) * 2;
        u.b = w + ((size_t)kv * 256 * 4096 + (size_t)s * 256) * 2; return true;
    }
};
struct MoeSched {
    int G, c, nN, total; const LAS int* tile_e; const char* A; const char* W; size_t w_exp;
    DI bool next(int i, Unit& u) const {
        const int L = i * G + c; if (L >= total) return false;
        const int mt = L / nN, pn = L - mt * nN; const int e = __builtin_amdgcn_readfirstlane(tile_e[mt]);
        u.pm = mt; u.pn = pn; u.e = e;
        u.a = A + (size_t)mt * 256 * D; u.b = W + (size_t)e * w_exp + (size_t)pn * 256 * D; return true;
    }
};
}

DI int colmap(int kind, int n) {
    if (kind == 0) return n;
    if (kind == 1) {
        if (n < 872) return n;
        if (n < 896) return 3432 + (n - 872);
        if (n < 1024) return -1;
        if (n < 2048) return 872 + (n - 1024);
        if (n < 3584) return 1896 + (n - 2048);
        return 3456 + (n - 3584);
    }
    if (kind == 2) { const int pn = n >> 8, r = n & 255; return r < 128 ? pn * 128 + r : 2048 + pn * 128 + (r - 128); }
    if (kind == 4) return n < 32 ? n : -1;
    { const int h = n >> 5, d = n & 31; return h * 128 + d; }
}
struct TrJob { const float* src; bf16_t* dst; int ldsrc, lddst, kind, k0, n0, dk0, dn0; };
DI void tr_load(const TrJob& j, f32x4 (&v)[8], int t) {
    const int c4 = t & 63, r0 = t >> 6; const int sc = colmap(j.kind, j.n0 + 4 * c4);
#pragma unroll
    for (int q = 0; q < 8; ++q) v[q] = (f32x4){0.f, 0.f, 0.f, 0.f};
    if (sc >= 0) {
#pragma unroll
        for (int q = 0; q < 8; ++q) v[q] = __builtin_nontemporal_load((const f32x4*)(j.src + (size_t)(j.k0 + r0 + 8 * q) * j.ldsrc + sc));
    }
}
DI void tr_lds_write(const f32x4 (&v)[8], float* tile, int t) {
    const int c4 = t & 63, r0 = t >> 6;
#pragma unroll
    for (int q = 0; q < 8; ++q) { float* tp = tile + (r0 + 8 * q) * 257 + 4 * c4; tp[0] = v[q][0]; tp[1] = v[q][1]; tp[2] = v[q][2]; tp[3] = v[q][3]; }
}
DI void tr_store(const TrJob& j, const float* tile, int t) {
    const int kk8 = (t & 7) * 8, nb = t >> 3;
#pragma unroll
    for (int ps = 0; ps < 4; ++ps) { const int nn = nb + 64 * ps; const float* s = tile + kk8 * 257 + nn;
        u32x4 o = {pk2(s[0], s[257]), pk2(s[2 * 257], s[3 * 257]), pk2(s[4 * 257], s[5 * 257]), pk2(s[6 * 257], s[7 * 257])};
        *(u32x4*)(j.dst + (size_t)(j.n0 + nn) * j.lddst + j.k0 + kk8) = o; }
}
DI void tr_setup(TrJob& j, int u, int nK, const float* src, int ldsrc, int kind, bf16_t* dst, int lddst) {
    const int kt = u % nK, ntile = u / nK; j.src = src; j.dst = dst; j.ldsrc = ldsrc; j.lddst = lddst; j.kind = kind; j.k0 = kt * 64; j.n0 = ntile * 256;
}
DI float tr8_load(const TrJob& j, f32x4 (&v)[8], int t) {
    const int c4 = t & 31, r0 = t >> 5; const int sc = colmap(j.kind, j.n0 + 4 * c4); const int scc = sc < 0 ? 0 : sc;
#pragma unroll
    for (int q = 0; q < 8; ++q) v[q] = __builtin_nontemporal_load((const f32x4*)(j.src + (size_t)(j.k0 + r0 + 16 * q) * j.ldsrc + scc));
    return sc < 0 ? 0.f : 1.f;
}
DI void tr8_lds_write(const f32x4 (&v)[8], float ok, float* tile, int t) {
    const int c4 = t & 31, r0 = t >> 5;
#pragma unroll
    for (int q = 0; q < 8; ++q) { float* tp = tile + (r0 + 16 * q) * 129 + 4 * c4; tp[0] = v[q][0] * ok; tp[1] = v[q][1] * ok; tp[2] = v[q][2] * ok; tp[3] = v[q][3] * ok; }
}
DI void tr8_store(const TrJob& j, const float* tile, int t) {
    const int kc = t & 7, nb = t >> 3; constexpr float SC = pg8::W8_SCALE;
#pragma unroll
    for (int ps = 0; ps < 2; ++ps) { const int nn = nb + 64 * ps; const float* s = tile + (16 * kc) * 129 + nn;
        u32x4 o = {pg8::fp8x4(s[0] * SC, s[129] * SC, s[2 * 129] * SC, s[3 * 129] * SC), pg8::fp8x4(s[4 * 129] * SC, s[5 * 129] * SC, s[6 * 129] * SC, s[7 * 129] * SC),
                   pg8::fp8x4(s[8 * 129] * SC, s[9 * 129] * SC, s[10 * 129] * SC, s[11 * 129] * SC), pg8::fp8x4(s[12 * 129] * SC, s[13 * 129] * SC, s[14 * 129] * SC, s[15 * 129] * SC)};
        __builtin_nontemporal_store(o, (u32x4*)((unsigned char*)j.dst + (size_t)(j.dn0 + nn) * j.lddst + j.dk0 + 16 * kc)); }
}
DI void phase_prep(const Params& p, char* smem) {
    float* tile = (float*)smem;
    const int t = tid_fresh(), G = gridDim.x;
    constexpr int U_ADA = 256, U_ABS = 256, U_WO = 512, U_CB = 128, SPECIAL = U_ADA + U_ABS + U_WO + U_CB;
    constexpr int U_WINB = 32 * 8, U_WIN = 16 * 44, U_IDXQ = 8 * 2, U_UQR = 8, U_BRB = 16 * 8, U_OUT = 32 * 8, U_C1 = 64, U_RT = 32, U_GU = 32 * 16, U_DN = 32 * 8;
    constexpr int NTR = U_WINB + U_IDXQ + U_UQR + 2 * U_C1 + U_RT, NTR8 = U_WIN + U_BRB + U_OUT + NEXP * (U_GU + U_DN);
    bf16_t* Wq = (bf16_t*)(p.ws + O_WQ);
    for (int rp_ = 0; rp_ < ((PREP_REP & 1) ? 2 : 1); ++rp_)
    for (int u0 = blockIdx.x; u0 < SPECIAL; u0 += G) {
        int u = u0;
        if (rp_ == 1 && (u0 < PREP_REP_LO || u0 >= PREP_REP_HI)) continue;
        if (u < U_ADA) {
            const int c4 = t % 12, kg = t / 12; f32x4 a0 = {0.f, 0.f, 0.f, 0.f}, a1 = {0.f, 0.f, 0.f, 0.f};
            if (kg < 42) { const int col = u * 48 + c4 * 4;
#pragma unroll 7
                for (int k = kg; k < 2048; k += 42) { const float c0 = p.c[k], c1 = p.c[2048 + k]; const float s0 = c0 * sigmoidf_(c0), s1 = c1 * sigmoidf_(c1);
                    const f32x4 w = *(const f32x4*)(p.w_ada + (size_t)k * 12288 + col); a0 += w * s0; a1 += w * s1; } }
            __syncthreads();
            if (kg < 42) { float* tp = tile + (kg * 12 + c4) * 8;
#pragma unroll
                for (int j = 0; j < 4; ++j) { tp[j] = a0[j]; tp[4 + j] = a1[j]; } }
            __syncthreads();
            if (t < 96) { const int bb = t / 48, cc = t % 48; float acc = 0.f;
                for (int g2 = 0; g2 < 42; ++g2) acc += tile[(g2 * 12 + (cc >> 2)) * 8 + bb * 4 + (cc & 3)];
                ((float*)(p.ws + O_MODACC))[bb * 12288 + u * 48 + cc] = acc + p.b_ada[u * 48 + cc]; }
            continue; }
        u -= U_ADA;
        if (u < U_ABS) {
            const int h = u >> 5, w = __builtin_amdgcn_readfirstlane(t >> 6), l = t & 63, c = (u & 31) * 8 + w;
            const float* ukp = p.a_w_uk + (size_t)c * 768 + h * 96;
            float acc[8];
#pragma unroll
            for (int j = 0; j < 8; ++j) acc[j] = 0.f;
#pragma unroll 1
            for (int ch = 0; ch < 3; ++ch) {
                __syncthreads();
#pragma unroll
                for (int q = 0; q < 8; ++q) { const int r = (t >> 3) + 64 * q;
                    *(f32x4*)(tile + r * 36 + 4 * (t & 7)) = *(const f32x4*)(p.a_w_uq + (size_t)r * 1024 + h * 128 + 32 + ch * 32 + 4 * (t & 7)); }
                __syncthreads();
#pragma unroll 2
                for (int n4 = 0; n4 < 8; ++n4) { const float k0 = ukp[ch * 32 + 4 * n4], k1 = ukp[ch * 32 + 4 * n4 + 1], k2 = ukp[ch * 32 + 4 * n4 + 2], k3 = ukp[ch * 32 + 4 * n4 + 3];
#pragma unroll
                    for (int j = 0; j < 8; ++j) { const f32x4 x = *(const f32x4*)(tile + (l + 64 * j) * 36 + 4 * n4);
                        acc[j] = __builtin_fmaf(x[0], k0, acc[j]); acc[j] = __builtin_fmaf(x[1], k1, acc[j]); acc[j] = __builtin_fmaf(x[2], k2, acc[j]); acc[j] = __builtin_fmaf(x[3], k3, acc[j]); } }
            }
#pragma unroll
            for (int j = 0; j < 8; ++j) Wq[(size_t)(h * 256 + c) * 512 + l + 64 * j] = f2bf(acc[j]);
            continue; }
        u -= U_ABS;
        if (u < U_WO) {
            const int n = (u & 3) * 512 + t, k0 = (u >> 2) * 16, h = k0 >> 8;
            __syncthreads();
            *(f32x4*)(tile + 4 * t) = *(const f32x4*)(p.a_w_uv + (size_t)k0 * 128 + 4 * t);
            __syncthreads();
            const float* wbp = p.w_br_a + (size_t)(h * 128) * D + n;
            float acc[16];
#pragma unroll
            for (int j = 0; j < 16; ++j) acc[j] = 0.f;
#pragma unroll 2
            for (int v0 = 0; v0 < 128; v0 += 8) { float wb[8];
#pragma unroll
                for (int i = 0; i < 8; ++i) wb[i] = wbp[(size_t)(v0 + i) * D];
#pragma unroll
                for (int j = 0; j < 16; ++j) { const f32x4 a = *(const f32x4*)(tile + j * 128 + v0), b = *(const f32x4*)(tile + j * 128 + v0 + 4);
                    acc[j] = __builtin_fmaf(a[0], wb[0], acc[j]); acc[j] = __builtin_fmaf(a[1], wb[1], acc[j]); acc[j] = __builtin_fmaf(a[2], wb[2], acc[j]); acc[j] = __builtin_fmaf(a[3], wb[3], acc[j]);
                    acc[j] = __builtin_fmaf(b[0], wb[4], acc[j]); acc[j] = __builtin_fmaf(b[1], wb[5], acc[j]); acc[j] = __builtin_fmaf(b[2], wb[6], acc[j]); acc[j] = __builtin_fmaf(b[3], wb[7], acc[j]); } }
            constexpr float SW = pg8::W8_SCALE;
            *(u32x4*)((unsigned char*)(p.ws + O_WO) + (size_t)n * D + k0) = (u32x4){pg8::fp8x4(acc[0] * SW, acc[1] * SW, acc[2] * SW, acc[3] * SW), pg8::fp8x4(acc[4] * SW, acc[5] * SW, acc[6] * SW, acc[7] * SW),
                pg8::fp8x4(acc[8] * SW, acc[9] * SW, acc[10] * SW, acc[11] * SW), pg8::fp8x4(acc[12] * SW, acc[13] * SW, acc[14] * SW, acc[15] * SW)};
            continue; }
        u -= U_WO;
        {
            const int kv = u >> 6, seg = u & 63;
            if (t < 256) { const float* pe = kv ? p.cmp_v_pe : p.cmp_k_pe; const float* w1 = kv ? p.cmp_v_w1 : p.cmp_k_w1; float a = 0.f;
#pragma unroll 16
                for (int i = seg * 64; i < seg * 64 + 64; ++i) a += pe[i] * w1[(size_t)i * 256 + t];
                ((float*)(p.ws + O_CBP))[(seg * 2 + kv) * 256 + t] = a; } }
    }
    auto setup = [&](TrJob& j, int u) {
        if (u < U_WINB) { tr_setup(j, u, 32, p.w_in, 7552, 1, (bf16_t*)(p.ws + O_WIN), D); return; } u -= U_WINB;
        if (u < U_IDXQ) { tr_setup(j, u, 8, p.idx_w_q, 512, 0, Wq + (size_t)2304 * 512, 512); return; } u -= U_IDXQ;
        if (u < U_UQR) { tr_setup(j, u, 8, p.a_w_uq, 1024, 3, Wq + (size_t)2048 * 512, 512); return; } u -= U_UQR;
        if (u < U_C1) { tr_setup(j, u, 64, p.cmp_k_w1, 256, 0, (bf16_t*)(p.ws + O_WC1), 4096); return; } u -= U_C1;
        if (u < U_C1) { tr_setup(j, u, 64, p.cmp_v_w1, 256, 0, (bf16_t*)(p.ws + O_WC1) + (size_t)256 * 4096, 4096); return; } u -= U_C1;
        tr_setup(j, u, 32, p.w_router, 32, 4, (bf16_t*)(p.ws + O_WRT), D);
    };
    auto setup8 = [&](TrJob& j, int u) {
        j.lddst = D;
        if (u < U_WIN) { j.src = p.w_in; j.ldsrc = 7552; j.kind = 1; j.dst = (bf16_t*)(p.ws + O_WIN8); j.k0 = (u & 15) * 128; j.n0 = 2048 + (u >> 4) * 128; j.dk0 = j.k0; j.dn0 = j.n0; return; } u -= U_WIN;
        if (u < U_BRB) { j.src = p.w_br_b; j.ldsrc = D; j.kind = 0; j.dst = (bf16_t*)(p.ws + O_WBRB); j.lddst = 1024; j.k0 = (u & 7) * 128; j.n0 = (u >> 3) * 128; j.dk0 = j.k0; j.dn0 = j.n0; return; } u -= U_BRB;
        if (u < U_OUT) { j.src = p.w_out; j.ldsrc = D; j.kind = 0; j.dst = (bf16_t*)(p.ws + O_WOUT); j.k0 = (u & 15) * 128; j.n0 = (u >> 4) * 128; j.dk0 = j.k0; j.dn0 = j.n0; return; } u -= U_OUT;
        const int e = u / (U_GU + U_DN), r = u - e * (U_GU + U_DN);
        if (r < U_GU) { j.src = p.w_gate_up + (size_t)e * D * 4096; j.ldsrc = 4096; j.kind = 2; j.dst = (bf16_t*)(p.ws + O_WGU + (size_t)e * 4096 * D + (size_t)r * 16384); j.k0 = (r & 15) * 128; j.n0 = (r >> 4) * 128; }
        else { const int r2 = r - U_GU; j.src = p.w_down + (size_t)e * D * D; j.ldsrc = D; j.kind = 0; j.dst = (bf16_t*)(p.ws + O_WDN + (size_t)e * D * D + (size_t)r2 * 16384); j.k0 = (r2 & 15) * 128; j.n0 = (r2 >> 4) * 128; }
        j.lddst = 128; j.dk0 = 0; j.dn0 = 0;
    };
    TrJob cur, nxt; f32x4 v[8];
    int u;
    for (int rp_ = 0; rp_ < ((PREP_REP & 2) ? 2 : 1); ++rp_) {
    u = blockIdx.x;
    if (u < NTR) { setup(cur, u); tr_load(cur, v, t); }
#pragma unroll 1
    for (; u < NTR; u += G) {
        __syncthreads();
        tr_lds_write(v, tile, t);
        __syncthreads();
        const bool more = u + G < NTR;
        if (more) { setup(nxt, u + G); tr_load(nxt, v, t); }
        tr_store(cur, tile, t);
        cur = nxt;
    }
    }
    auto clampu = [&](int x) { return x < NTR8 ? x : NTR8 - 1; };
    for (int rp_ = 0; rp_ < ((PREP_REP & 4) ? 2 : 1); ++rp_) {
    u = blockIdx.x;
    f32x4 v2[8]; float ok1, ok2;
    setup8(cur, clampu(u)); ok1 = tr8_load(cur, v, t);
    setup8(nxt, clampu(u + G)); ok2 = tr8_load(nxt, v2, t);
#pragma unroll 1
    for (; u < NTR8; u += 2 * G) {
        __syncthreads();
        tr8_lds_write(v, ok1, tile, t);
        __syncthreads();
        TrJob c = cur;
        setup8(cur, clampu(u + 2 * G)); ok1 = tr8_load(cur, v, t);
        tr8_store(c, tile, t);
        __syncthreads();
        tr8_lds_write(v2, ok2, tile, t);
        __syncthreads();
        c = nxt;
        setup8(nxt, clampu(u + 3 * G)); ok2 = tr8_load(nxt, v2, t);
        tr8_store(c, tile, t);
    }
    }
#if PREP_PROBE_MODE >= 2
    {
        unsigned chk = 0; unsigned char* dummy = (unsigned char*)(p.ws + O_HS);
        constexpr int U0 = U_WIN + U_BRB + U_OUT;
        TrJob pj, pn; f32x4 w[8]; float okp;
        int uu = U0 + blockIdx.x;
        setup8(pj, uu); okp = tr8_load(pj, w, t);
#pragma unroll 1
        for (; uu < NTR8; uu += G) {
#if PREP_PROBE_MODE == 2
            __syncthreads();
            tr8_lds_write(w, okp, tile, t);
            __syncthreads();
            setup8(pn, clampu(uu + G)); okp = tr8_load(pn, w, t);
            {   const int kc = t & 7, nb = t >> 3; constexpr float SC = pg8::W8_SCALE;
#pragma unroll
                for (int ps = 0; ps < 2; ++ps) { const int nn = nb + 64 * ps; const float* s = tile + (16 * kc) * 129 + nn;
                    chk ^= pg8::fp8x4(s[0] * SC, s[129] * SC, s[2 * 129] * SC, s[3 * 129] * SC) ^ pg8::fp8x4(s[4 * 129] * SC, s[5 * 129] * SC, s[6 * 129] * SC, s[7 * 129] * SC)
                         ^ pg8::fp8x4(s[8 * 129] * SC, s[9 * 129] * SC, s[10 * 129] * SC, s[11 * 129] * SC) ^ pg8::fp8x4(s[12 * 129] * SC, s[13 * 129] * SC, s[14 * 129] * SC, s[15 * 129] * SC); } }
            pj = pn;
#else
            u32x4 o0 = {pg8::fp8x4(w[0][0], w[0][1], w[0][2], w[0][3]), pg8::fp8x4(w[1][0], w[1][1], w[1][2], w[1][3]), pg8::fp8x4(w[2][0], w[2][1], w[2][2], w[2][3]), pg8::fp8x4(w[3][0], w[3][1], w[3][2], w[3][3])};
            u32x4 o1 = {pg8::fp8x4(w[4][0], w[4][1], w[4][2], w[4][3]), pg8::fp8x4(w[5][0], w[5][1], w[5][2], w[5][3]), pg8::fp8x4(w[6][0], w[6][1], w[6][2], w[6][3]), pg8::fp8x4(w[7][0], w[7][1], w[7][2], w[7][3])};
            setup8(pn, clampu(uu + G)); okp = tr8_load(pn, w, t);
            u32x4* dp = (u32x4*)(dummy + ((size_t)(uu - U0) * 512 + t) * 32); dp[0] = o0; dp[1] = o1;
            pj = pn;
#endif
        }
        if (chk == 0x12345678u && okp == 3.f) ((unsigned*)(p.ws + 115200))[0] = chk;
    }
#endif
#if PREP_PROBE_WC > 0
    {
        constexpr int WC = PREP_PROBE_WC, RW = WC / 4, RS = 512 / RW, R = 16384 / WC;
        float acc = 0.f; const int c4 = t % RW, r0 = t / RW;
#pragma unroll 1
        for (int pass = 0; pass < 2; ++pass) {
            const float* base = pass ? p.w_down : p.w_gate_up; const int ld = pass ? 2048 : 4096;
            const int nK = 65536 / R, ntiles = nK * (ld / WC);
#pragma unroll 1
            for (int uu = blockIdx.x; uu < ntiles; uu += G) {
#if PREP_PROBE_NFAST
                const int nN = ld / WC, nt_ = uu % nN, kt = uu / nN;
#else
                const int kt = uu % nK, nt_ = uu / nK;
#endif
                f32x4 w[8];
#pragma unroll
                for (int q = 0; q < 8; ++q) w[q] = __builtin_nontemporal_load((const f32x4*)(base + (size_t)(kt * R + r0 + RS * q) * ld + nt_ * WC + 4 * c4));
#pragma unroll
                for (int q = 0; q < 8; ++q) acc += (w[q][0] + w[q][1]) + (w[q][2] + w[q][3]);
            }
        }
        if (acc == 12345.678f) ((float*)(p.ws + 115200))[0] = acc;
    }
#endif
}

DI void phase_h1(const Params& p) {
    const int tz_ = tid_fresh(); const int lane = tz_ & 63, wid = __builtin_amdgcn_readfirstlane(tz_ >> 6);
    if (blockIdx.x == 0) { float a = 0.f; const float* cbp = (const float*)(p.ws + O_CBP);
        for (int sg = 0; sg < 64; ++sg) a += cbp[sg * 512 + tz_];
        ((float*)(p.ws + O_CBIAS))[tz_] = a; }
    bf16_t* H = (bf16_t*)(p.ws + O_H); float* rope = (float*)(p.ws + O_ROPE);
    for (int tok = blockIdx.x * 8 + wid; tok < NT; tok += gridDim.x * 8) {
        const int b = tok >> 13;
        const f32x4* xr = (const f32x4*)(p.x + (size_t)tok * D) + lane;
        f32x4 v[8]; float ss = 0.f;
#pragma unroll
        for (int i = 0; i < 8; ++i) { v[i] = xr[64 * i]; ss += v[i][0] * v[i][0] + v[i][1] * v[i][1] + v[i][2] * v[i][2] + v[i][3] * v[i][3]; }
        const float rs = rsqrtf(wave_sum(ss) * (1.f / D) + NORM_EPS);
#pragma unroll
        for (int i = 0; i < 8; ++i) { const int col = 4 * (lane + 64 * i); float o[4];
#pragma unroll
            for (int j = 0; j < 4; ++j) o[j] = v[i][j] * rs * p.g_pre_mix[col + j] * (1.f + mod_at(p, b, 2048 + col + j)) + mod_at(p, b, col + j);
            *(u32x2*)(H + (size_t)tok * D + col) = (u32x2){pk2(o[0], o[1]), pk2(o[2], o[3])};
            *(unsigned*)((unsigned char*)(p.ws + O_H8) + (size_t)tok * D + col) = pg8::fp8x4(o[0], o[1], o[2], o[3]); }
        if (lane < 24) { const float fr = lane < 16 ? (float)(2 * lane) * (1.f / 32.f) : (float)(2 * (lane - 16)) * (1.f / 16.f);
            const float inv = exp2f(-fr * 18.931568569324174f);
            const float ang = (float)p.pos[tok] * inv; float s, c; sincosf(ang, &s, &c);
            rope[(size_t)tok * 48 + 2 * lane] = c; rope[(size_t)tok * 48 + 2 * lane + 1] = s; }
    }
}

DI void phase_zpost(const Params& p) {
    const int tz_ = tid_fresh(); const int lane = tz_ & 63, wid = __builtin_amdgcn_readfirstlane(tz_ >> 6);
    const bf16_t* Z = (const bf16_t*)(p.ws + O_Z); const float* rope = (const float*)(p.ws + O_ROPE);
    bf16_t* cqn = (bf16_t*)(p.ws + O_CQN); bf16_t* kvt = (bf16_t*)(p.ws + O_KVT); bf16_t* kidx = (bf16_t*)(p.ws + O_KIDX);
    float* widx = (float*)(p.ws + O_WIDX); float* gates = (float*)(p.ws + O_GATES); bf16_t* bq = (bf16_t*)(p.ws + O_BQ); bf16_t* kvs = (bf16_t*)(p.ws + O_KVS);
    const f32x4 gq0 = *(const f32x4*)(p.a_cq_norm + lane * 8), gq1 = *(const f32x4*)(p.a_cq_norm + lane * 8 + 4), gkv = *(const f32x4*)(p.a_ckv_norm + lane * 4);
    const float ig = p.idx_g[lane], ibs = p.idx_b[lane];
    const int part = lane & 7;
    for (int tok = blockIdx.x * 8 + wid; tok < NT; tok += gridDim.x * 8) {
        const int b = tok >> 13, tq = tok & (T - 1);
        const bf16_t* zr = Z + (size_t)tok * ZC; const float* rt = rope + (size_t)tok * 48;
        const u32x4 rcq = *(const u32x4*)(zr + lane * 8);
        const u32x2 rkv = *(const u32x2*)(zr + ZC_CKV + lane * 4);
        const bf16_t rki = zr[ZC_KIDX + lane], rk1 = zr[ZC_KROPE + (lane & 15)], rk2 = zr[ZC_KROPE + 16 + (lane & 15)], rwi = zr[ZC_WIDX + (lane & 7)], rbg = zr[ZC_BGATE + (lane < 24 ? lane : 0)];
        u32x4 rh[3][2];
#pragma unroll
        for (int ps = 0; ps < 3; ++ps) { const int slot = ps * 64 + lane, s2 = slot < 160 ? slot : 159; const bf16_t* src = zr + ZC_BQ + (s2 >> 3) * 128 + (s2 & 7) * 16;
            rh[ps][0] = *(const u32x4*)src; rh[ps][1] = *(const u32x4*)(src + 8); }
        f32x4 rr[8];
#pragma unroll
        for (int i = 0; i < 8; ++i) rr[i] = *(const f32x4*)(rt + 4 * i);
        const float ric = rt[32 + 2 * (lane & 7)], ris = rt[33 + 2 * (lane & 7)], rkc = rt[2 * (lane & 15)], rks = rt[2 * (lane & 15) + 1];
        {
            float f[8]; unpack8(rcq, f); float ss = 0.f;
#pragma unroll
            for (int j = 0; j < 8; ++j) ss += f[j] * f[j];
            const float rs = rsqrtf(wave_sum(ss) * (1.f / 512.f) + NORM_EPS);
#pragma unroll
            for (int j = 0; j < 4; ++j) { f[j] = f[j] * rs * gq0[j]; f[4 + j] = f[4 + j] * rs * gq1[j]; }
            *(u32x4*)(cqn + (size_t)tok * 512 + lane * 8) = (u32x4){pk2(f[0], f[1]), pk2(f[2], f[3]), pk2(f[4], f[5]), pk2(f[6], f[7])};
        }
        {
            float f[4] = {bflo(rkv[0]), bfhi(rkv[0]), bflo(rkv[1]), bfhi(rkv[1])};
            const float rs = rsqrtf(wave_sum(f[0] * f[0] + f[1] * f[1] + f[2] * f[2] + f[3] * f[3]) * (1.f / 256.f) + NORM_EPS);
#pragma unroll
            for (int j = 0; j < 4; ++j) f[j] = f[j] * rs * gkv[j];
            *(u32x2*)(kvt + (size_t)tok * KVW + lane * 4) = (u32x2){pk2(f[0], f[1]), pk2(f[2], f[3])};
        }
        if (lane < 16) {
            const float x1 = bf2f(rk1), x2 = bf2f(rk2);
            kvt[(size_t)tok * KVW + 256 + lane] = f2bf(x1 * rkc - x2 * rks); kvt[(size_t)tok * KVW + 272 + lane] = f2bf(x2 * rkc + x1 * rks);
        }
        {
            const float v = bf2f(rki); const float mean = wave_sum(v) * (1.f / 64.f); const float xc = v - mean;
            const float var = wave_sum(xc * xc) * (1.f / 64.f);
            const float y = xc * rsqrtf(var + NORM_EPS) * ig + ibs;
            const float pr = __shfl_xor(y, 8); float o = y;
            if (lane < 8) o = y * ric - pr * ris;
            else if (lane < 16) o = y * ric + pr * ris;
            kidx[(size_t)tok * 64 + lane] = f2bf(o);
        }
        if (lane < 8) widx[(size_t)tok * 8 + lane] = bf2f(rwi) * (0.35355339059327373f * 0.125f);
        if (lane < 24) gates[(size_t)tok * 24 + lane] = sigmoidf_(bf2f(rbg));
#pragma unroll
        for (int ps = 0; ps < 3; ++ps) { const int slot = ps * 64 + lane; const int hh = slot >> 3;
            float f[16]; { float a[8], c[8]; unpack8(rh[ps][0], a); unpack8(rh[ps][1], c);
#pragma unroll
                for (int j = 0; j < 8; ++j) { f[j] = a[j]; f[8 + j] = c[j]; } }
            const bool dorope = (hh < 8 || (((hh - 8) >> 1) & 1) == 0) && part < 2;
#pragma unroll
            for (int i = 0; i < 16; ++i) { const float g = __shfl_xor(f[i], 1); const float c = rr[(2 * i) >> 2][(2 * i) & 3], s = rr[(2 * i + 1) >> 2][(2 * i + 1) & 3];
                const float ro = part == 0 ? f[i] * c - g * s : f[i] * c + g * s; f[i] = dorope ? ro : f[i]; }
            if (slot < 160) { bf16_t* dst;
                if (hh < 8) dst = bq + (size_t)tok * 1024 + hh * 128 + part * 16;
                else { const int i6 = (hh - 8) >> 1, g = (hh - 8) & 1; dst = kvs + ((((size_t)i6 * NB + b) * 2 + g) * T + tq) * 128 + part * 16; }
                *(u32x4*)dst = (u32x4){pk2(f[0], f[1]), pk2(f[2], f[3]), pk2(f[4], f[5]), pk2(f[6], f[7])};
                *(u32x4*)(dst + 8) = (u32x4){pk2(f[8], f[9]), pk2(f[10], f[11]), pk2(f[12], f[13]), pk2(f[14], f[15])}; } }
    }
}

DI void c2_rows(const Params& p, char* smem) {
    const int tz_ = tid_fresh(); const int lane = tz_ & 63, wid = __builtin_amdgcn_readfirstlane(tz_ >> 6);
    float* hrow = (float*)smem + wid * 256;
    const float* c1p = (const float*)(p.ws + O_C1P); const float* cb = (const float*)(p.ws + O_CBIAS); bf16_t* kcvc = (bf16_t*)(p.ws + O_KCVC);
    for (int row = blockIdx.x * 8 + wid; row < 4096; row += gridDim.x * 8) {
        const int kv = row >> 11, r = row & 2047, n = r & 511;
        f32x4 a = *(const f32x4*)(cb + kv * 256 + lane * 4);
#pragma unroll
        for (int s = 0; s < 16; ++s) a += *(const f32x4*)(c1p + ((size_t)(s * 2 + kv) * 2048 + r) * 256 + lane * 4);
#pragma unroll
        for (int j = 0; j < 4; ++j) { const float v = a[j]; const float u = 0.7978845608028654f * (v + 0.044715f * v * v * v); hrow[lane * 4 + j] = 0.5f * v * (1.f + tanhf(u)); }
        asm volatile("s_waitcnt lgkmcnt(0)" ::: "memory");
        const float* w2 = kv ? p.cmp_v_w2 : p.cmp_k_w2;
        float o0 = 0.f, o1 = 0.f;
#pragma unroll 16
        for (int j = 0; j < 256; ++j) { const float hv = hrow[j]; const float2 w = *(const float2*)(w2 + j * 128 + lane * 2); o0 += hv * w.x; o1 += hv * w.y; }
        if (n == 511) { o0 = 0.f; o1 = 0.f; }
        *(unsigned*)(kcvc + (size_t)row * 128 + lane * 2) = pk2(o0, o1);
        asm volatile("s_waitcnt lgkmcnt(0)" ::: "memory");
    }
}

DI unsigned short f16key(float v) { const _Float16 h = (_Float16)v; unsigned short u = __builtin_bit_cast(unsigned short, h); return (u & 0x8000u) ? (unsigned short)~u : (unsigned short)(u | 0x8000u); }
DI void topk256_select(const LAS unsigned* scw, int nk, unsigned short* out, int lane) {
    const int nw = (nk + 127) >> 7;
    auto ldk = [&](int i) -> unsigned { const int wi = i * 64 + lane; unsigned v = scw[wi]; if (2 * wi >= nk) v = 0u; else if (2 * wi + 1 >= nk) v &= 0xffffu; return v; };
    unsigned Tv = 0u;
    for (int bit = 15; bit >= 0; --bit) { const unsigned cand = Tv | (1u << bit); int cnt = 0;
#pragma unroll 4
        for (int i = 0; i < nw; ++i) { const unsigned kv = ldk(i); cnt += __popcll(__ballot((kv & 0xffffu) >= cand)) + __popcll(__ballot((kv >> 16) >= cand)); }
        if (cnt >= 256) Tv = cand; }
    int cgt = 0;
#pragma unroll 4
    for (int i = 0; i < nw; ++i) { const unsigned kv = ldk(i); cgt += __popcll(__ballot((kv & 0xffffu) > Tv)) + __popcll(__ballot((kv >> 16) > Tv)); }
    const int need = 256 - cgt; int pos = 0, eqc = 0;
    const unsigned long long ltm = (1ull << lane) - 1ull;
#pragma unroll 2
    for (int i = 0; i < nw; ++i) {
        const unsigned kv = ldk(i); const unsigned lo = kv & 0xffffu, hi = kv >> 16;
        const bool elo = lo == Tv, ehi = hi == Tv;
        const unsigned long long mlo = __ballot(elo), mhi = __ballot(ehi);
        const int below = __popcll(mlo & ltm) + __popcll(mhi & ltm);
        const bool slo = lo > Tv || (elo && eqc + below < need), shi = hi > Tv || (ehi && eqc + below + (elo ? 1 : 0) < need);
        const unsigned long long s0 = __ballot(slo), s1 = __ballot(shi);
        const int plo = pos + __popcll(s0 & ltm), phi = pos + __popcll(s0) + __popcll(s1 & ltm);
        const int kidx = 2 * (i * 64 + lane);
        if (slo) out[plo] = (unsigned short)kidx;
        if (shi) out[phi] = (unsigned short)(kidx + 1);
        pos += __popcll(s0) + __popcll(s1); eqc += __popcll(mlo) + __popcll(mhi); }
}
DI void phase_indexer(const Params& p, char* smem) {
    const int tz_ = tid_fresh(); const int lane = tz_ & 63, wid = __builtin_amdgcn_readfirstlane(tz_ >> 6);
    LAS unsigned short* sc = (LAS unsigned short*)(LAS char*)smem + wid * 8192;
    float* qf = (float*)(smem + 131072) + wid * 512;
    const bf16_t* Q = (const bf16_t*)(p.ws + O_QALL); const bf16_t* KI = (const bf16_t*)(p.ws + O_KIDX); const float* WI = (const float*)(p.ws + O_WIDX);
    unsigned short* SEL = (unsigned short*)(p.ws + O_SEL); int* NSEL = (int*)(p.ws + O_NSEL);
    for (int tok = (int)(NT / 8 - 1 - blockIdx.x) * 8 + wid; tok >= 0; tok -= gridDim.x * 8) {
        const int b = tok >> 13, tq = tok & (T - 1), nk = tq + 1;
        unsigned short* out = SEL + (size_t)tok * 256;
        if (nk <= 256) { for (int i = lane; i < 256; i += 64) out[i] = (unsigned short)(i < nk ? i : 0); if (lane == 0) NSEL[tok] = nk; continue; }
        { float f[8]; unpack8(*(const u32x4*)(Q + (size_t)tok * QC + 2304 + lane * 8), f);
#pragma unroll
          for (int j = 0; j < 8; ++j) qf[lane * 8 + j] = f[j]; }
        float wh[8];
#pragma unroll
        for (int h = 0; h < 8; ++h) wh[h] = WI[(size_t)tok * 8 + h];
        asm volatile("s_waitcnt lgkmcnt(0)" ::: "memory");
        for (int s = lane; s < nk; s += 64) {
            const bf16_t* kr = KI + ((size_t)b * T + s) * 64; float d[8];
#pragma unroll
            for (int h = 0; h < 8; ++h) d[h] = 0.f;
#pragma unroll 2
            for (int c = 0; c < 8; ++c) { float kf[8]; unpack8(*(const u32x4*)(kr + c * 8), kf);
#pragma unroll
                for (int h = 0; h < 8; ++h) { const f32x4 q0 = *(const f32x4*)(qf + h * 64 + c * 8), q1 = *(const f32x4*)(qf + h * 64 + c * 8 + 4);
                    d[h] += q0[0] * kf[0] + q0[1] * kf[1] + q0[2] * kf[2] + q0[3] * kf[3] + q1[0] * kf[4] + q1[1] * kf[5] + q1[2] * kf[6] + q1[3] * kf[7]; } }
            float score = 0.f;
#pragma unroll
            for (int h = 0; h < 8; ++h) score += wh[h] * fmaxf(d[h], 0.f);
            sc[s] = f16key(score); }
        asm volatile("s_waitcnt lgkmcnt(0)" ::: "memory");
        topk256_select((const LAS unsigned*)sc, nk, out, lane);
        if (lane == 0) NSEL[tok] = 256;
        asm volatile("s_waitcnt lgkmcnt(0)" ::: "memory");
    }
}

DI void phase_mla(const Params& p, char* smem) {
    const int tz_ = tid_fresh(); const int lane = tz_ & 63, wid = __builtin_amdgcn_readfirstlane(tz_ >> 6);
    float* qf = (float*)smem + wid * (8 * KVW + 8 * 256 + 128);
    float* pf = qf + 8 * KVW; unsigned short* selw = (unsigned short*)(pf + 8 * 256);
    const bf16_t* Q = (const bf16_t*)(p.ws + O_QALL); const bf16_t* KV = (const bf16_t*)(p.ws + O_KVT);
    const unsigned short* SEL = (const unsigned short*)(p.ws + O_SEL); const int* NSEL = (const int*)(p.ws + O_NSEL); bf16_t* OL = (bf16_t*)(p.ws + O_OLAT);
    for (int tok = blockIdx.x * 8 + wid; tok < NT; tok += gridDim.x * 8) {
        const int b = tok >> 13; const int cnt = NSEL[tok];
        const bf16_t* qr = Q + (size_t)tok * QC;
#pragma unroll 4
        for (int i = 0; i < 36; ++i) { const int e = lane + 64 * i;
            const int h = e / KVW, d = e - h * KVW; qf[e] = bf2f(d < 256 ? qr[h * 256 + d] : qr[2048 + h * 32 + (d - 256)]); }
        *(u32x2*)(selw + lane * 4) = *(const u32x2*)(SEL + (size_t)tok * 256 + lane * 4);
        asm volatile("s_waitcnt lgkmcnt(0)" ::: "memory");
        const bf16_t* rows[4];
#pragma unroll
        for (int j = 0; j < 4; ++j) { const int k = lane + 64 * j; const int idx = k < cnt ? selw[k] : 0; rows[j] = KV + ((size_t)b * T + idx) * KVW; }
        float acc[4][8];
#pragma unroll
        for (int j = 0; j < 4; ++j)
#pragma unroll
            for (int h = 0; h < 8; ++h) acc[j][h] = 0.f;
#pragma unroll 1
        for (int c = 0; c < 36; ++c) { float kf[4][8];
#pragma unroll
            for (int j = 0; j < 4; ++j) unpack8(*(const u32x4*)(rows[j] + c * 8), kf[j]);
#pragma unroll
            for (int h = 0; h < 8; ++h) { const f32x4 q0 = *(const f32x4*)(qf + h * KVW + c * 8), q1 = *(const f32x4*)(qf + h * KVW + c * 8 + 4);
#pragma unroll
                for (int j = 0; j < 4; ++j) acc[j][h] += q0[0] * kf[j][0] + q0[1] * kf[j][1] + q0[2] * kf[j][2] + q0[3] * kf[j][3] + q1[0] * kf[j][4] + q1[1] * kf[j][5] + q1[2] * kf[j][6] + q1[3] * kf[j][7]; } }
#pragma unroll
        for (int h = 0; h < 8; ++h) { float m = -INFINITY;
#pragma unroll
            for (int j = 0; j < 4; ++j) { acc[j][h] = (lane + 64 * j < cnt) ? acc[j][h] * ATT_SCALE : -INFINITY; m = fmaxf(m, acc[j][h]); }
            m = wave_max(m); float l = 0.f;
#pragma unroll
            for (int j = 0; j < 4; ++j) { acc[j][h] = (lane + 64 * j < cnt) ? __expf(acc[j][h] - m) : 0.f; l += acc[j][h]; }
            l = 1.f / fmaxf(wave_sum(l), 1e-30f);
#pragma unroll
            for (int j = 0; j < 4; ++j) pf[h * 256 + lane + 64 * j] = acc[j][h] * l; }
        asm volatile("s_waitcnt lgkmcnt(0)" ::: "memory");
        float o[8][4];
#pragma unroll
        for (int h = 0; h < 8; ++h)
#pragma unroll
            for (int j = 0; j < 4; ++j) o[h][j] = 0.f;
#pragma unroll 1
        for (int k0 = 0; k0 < 256; k0 += 8) { u32x2 vv[8];
#pragma unroll
            for (int kk = 0; kk < 8; ++kk) { const int k = k0 + kk; const int idx = k < cnt ? selw[k] : 0; vv[kk] = *(const u32x2*)(KV + ((size_t)b * T + idx) * KVW + lane * 4); }
#pragma unroll
            for (int kk = 0; kk < 8; ++kk) { const float v0 = bflo(vv[kk][0]), v1 = bfhi(vv[kk][0]), v2 = bflo(vv[kk][1]), v3 = bfhi(vv[kk][1]);
#pragma unroll
                for (int h = 0; h < 8; ++h) { const float ph = pf[h * 256 + k0 + kk]; o[h][0] += ph * v0; o[h][1] += ph * v1; o[h][2] += ph * v2; o[h][3] += ph * v3; } } }
#pragma unroll
        for (int h = 0; h < 8; ++h) *(u32x2*)(OL + (size_t)tok * D + h * 256 + lane * 4) = (u32x2){pk2(o[h][0], o[h][1]), pk2(o[h][2], o[h][3])};
        asm volatile("s_waitcnt lgkmcnt(0)" ::: "memory");
    }
}

DI void nsa_score(const bf16_t* kr, const float* qf, float (&s)[4]) {
#pragma unroll
    for (int j = 0; j < 4; ++j) s[j] = 0.f;
#pragma unroll 4
    for (int c = 0; c < 16; ++c) { float kf[8]; unpack8(*(const u32x4*)(kr + c * 8), kf);
#pragma unroll
        for (int j = 0; j < 4; ++j) { const f32x4 q0 = *(const f32x4*)(qf + j * 128 + c * 8), q1 = *(const f32x4*)(qf + j * 128 + c * 8 + 4);
            s[j] += q0[0] * kf[0] + q0[1] * kf[1] + q0[2] * kf[2] + q0[3] * kf[3] + q1[0] * kf[4] + q1[1] * kf[5] + q1[2] * kf[6] + q1[3] * kf[7]; } }
}
DI void phase_nsa(const Params& p, char* smem) {
    const int tz_ = tid_fresh(); const int lane = tz_ & 63, wid = __builtin_amdgcn_readfirstlane(tz_ >> 6);
    float* qf = (float*)smem + wid * (512 + 256 + 512 + 16); float* pb = qf + 512; float* psum = pb + 256; int* blk = (int*)(psum + 512);
    const bf16_t* BQ = (const bf16_t*)(p.ws + O_BQ); const bf16_t* kvs = (const bf16_t*)(p.ws + O_KVS); const bf16_t* kcvc = (const bf16_t*)(p.ws + O_KCVC);
    const float* gates = (const float*)(p.ws + O_GATES); bf16_t* OB = (bf16_t*)(p.ws + O_OB);
#pragma unroll 1
    for (int item = (NT * 2 / 8 - 1 - (int)blockIdx.x) * 8 + wid; item >= 0; item -= gridDim.x * 8) {
        const int tok = item >> 1, g = item & 1, b = tok >> 13, tq = tok & (T - 1);
        { float f[8]; unpack8(*(const u32x4*)(BQ + (size_t)tok * 1024 + g * 512 + lane * 8), f);
#pragma unroll
          for (int j = 0; j < 8; ++j) qf[lane * 8 + j] = f[j]; }
        asm volatile("s_waitcnt lgkmcnt(0)" ::: "memory");
        const size_t bg = (size_t)(b * 2 + g);
        const int nmax = tq >= 31 ? (tq - 31) >> 4 : -1;
        float res[4][2], o[4][2], m[4], l[4]; int ns = 0;
#pragma unroll
        for (int j = 0; j < 4; ++j) { res[j][0] = 0.f; res[j][1] = 0.f; }
#pragma unroll 1
        for (int step = 0; step < 4; ++step) {
            const int kind = step < 2 ? 0 : step - 1;
            const int mode = step == 0 ? 1 : (step == 1 ? 2 : 0);
            const bf16_t* kbase; const bf16_t* vbase; int nch;
            if (kind == 0) { kbase = kcvc + bg * 512 * 128; vbase = kcvc + (size_t)2048 * 128 + bg * 512 * 128; nch = 8; }
            else if (kind == 1) { kbase = kvs + (2 * (size_t)NB * 2 + bg) * T * 128; vbase = kvs + (3 * (size_t)NB * 2 + bg) * T * 128; nch = ns; }
            else { kbase = kvs + (4 * (size_t)NB * 2 + bg) * T * 128; vbase = kvs + (5 * (size_t)NB * 2 + bg) * T * 128; nch = 8; }
            if (mode != 2) {
#pragma unroll
                for (int j = 0; j < 4; ++j) { m[j] = -INFINITY; l[j] = 0.f; } }
#pragma unroll
            for (int j = 0; j < 4; ++j) { o[j][0] = 0.f; o[j][1] = 0.f; }
#pragma unroll 1
            for (int c = 0; c < nch; ++c) {
                int base, lim_lo, lim_hi;
                if (kind == 0) { base = 64 * c; lim_lo = 0; lim_hi = nmax; }
                else if (kind == 1) { base = blk[c] * 64; lim_lo = 0; lim_hi = tq; }
                else { base = tq - 511 + 64 * c; lim_lo = 0; lim_hi = tq; }
                const bool active = base <= lim_hi && base + 63 >= lim_lo;
                if (!active) { if (mode == 2) psum[c * 64 + lane] = 0.f; continue; }
                const int key = base + lane; const bool valid = key >= lim_lo && key <= lim_hi;
                float s[4]; nsa_score(kbase + (size_t)(key < 0 ? 0 : key) * 128, qf, s);
                float ps = 0.f;
#pragma unroll
                for (int j = 0; j < 4; ++j) {
                    const float sv = valid ? s[j] * ATT_SCALE : -INFINITY; float pj;
                    if (mode == 2) { pj = valid ? __expf(sv - m[j]) * l[j] : 0.f; ps += pj; }
                    else { const float mn = fmaxf(m[j], wave_max(sv));
                        const float alpha = (m[j] == -INFINITY) ? 0.f : __expf(m[j] - mn);
                        pj = (sv == -INFINITY) ? 0.f : __expf(sv - mn);
                        l[j] = l[j] * alpha + wave_sum(pj); m[j] = mn; o[j][0] *= alpha; o[j][1] *= alpha; }
                    pb[j * 64 + lane] = pj; }
                if (mode == 2) psum[c * 64 + lane] = ps;
                if (mode != 1) {
                    asm volatile("s_waitcnt lgkmcnt(0)" ::: "memory");
#pragma unroll 1
                    for (int k0 = 0; k0 < 64; k0 += 8) { unsigned vv[8];
#pragma unroll
                        for (int kk = 0; kk < 8; ++kk) { const int kx = base + k0 + kk; vv[kk] = *(const unsigned*)(vbase + (size_t)(kx < 0 ? 0 : kx) * 128 + lane * 2); }
#pragma unroll
                        for (int kk = 0; kk < 8; ++kk) { const float v0 = bflo(vv[kk]), v1 = bfhi(vv[kk]);
#pragma unroll
                            for (int j = 0; j < 4; ++j) { const float ph = pb[j * 64 + k0 + kk]; o[j][0] += ph * v0; o[j][1] += ph * v1; } } } }
                asm volatile("s_waitcnt lgkmcnt(0)" ::: "memory");
            }
            if (step == 0) {
#pragma unroll
                for (int j = 0; j < 4; ++j) { if (m[j] == -INFINITY) m[j] = 0.f; l[j] = 1.f / fmaxf(l[j], 1e-30f); }
                continue; }
#pragma unroll
            for (int j = 0; j < 4; ++j) { const float gt = gates[(size_t)tok * 24 + (g * 4 + j) * 3 + kind]; const float il = (mode == 2) ? gt : gt / fmaxf(l[j], 1e-30f);
                res[j][0] += il * o[j][0]; res[j][1] += il * o[j][1]; }
            if (step == 1) {
                asm volatile("s_waitcnt lgkmcnt(0)" ::: "memory");
                const int cur = tq >> 6; unsigned key[2];
#pragma unroll
                for (int hh = 0; hh < 2; ++hh) { const int mb = lane + 64 * hh; float imp = 0.f;
#pragma unroll
                    for (int d = -1; d < 4; ++d) { const int n = 4 * mb + d; if (n >= 0 && n < 512) imp += psum[n]; }
                    const bool adm = mb <= cur, forced = mb == 0 || mb == cur || mb == cur - 1;
                    key[hh] = !adm ? 0u : (forced ? (0xFF000000u | (unsigned)(127 - mb)) : ((((__float_as_uint(imp) >> 7) + 1u) << 7) | (unsigned)(127 - mb))); }
                unsigned Tv = 0u;
                for (int bit = 31; bit >= 0; --bit) { const unsigned cand = Tv | (1u << bit);
                    const int cnt = __popcll(__ballot(key[0] >= cand)) + __popcll(__ballot(key[1] >= cand)); if (cnt >= 16) Tv = cand; }
                if (Tv == 0u) Tv = 1u;
                const unsigned long long m0 = __ballot(key[0] >= Tv), m1 = __ballot(key[1] >= Tv);
                const unsigned long long ltm = (1ull << lane) - 1ull;
                if (key[0] >= Tv) blk[__popcll(m0 & ltm)] = lane;
                if (key[1] >= Tv) blk[__popcll(m0) + __popcll(m1 & ltm)] = lane + 64;
                ns = __popcll(m0) + __popcll(m1);
                asm volatile("s_waitcnt lgkmcnt(0)" ::: "memory"); }
        }
#pragma unroll
        for (int j = 0; j < 4; ++j) *(unsigned*)(OB + (size_t)tok * 1024 + (g * 4 + j) * 128 + lane * 2) = pk2(res[j][0], res[j][1]);
        asm volatile("s_waitcnt lgkmcnt(0)" ::: "memory");
    }
}

typedef float f32x16 __attribute__((ext_vector_type(16)));
typedef short s16x4 __attribute__((ext_vector_type(4)));
#define MFMA32(a, b, c) __builtin_amdgcn_mfma_f32_32x32x16_bf16((a), (b), (c), 0, 0, 0)
DI unsigned offb(unsigned row, unsigned ch) { return 256u * row + 16u * (ch ^ (((row & 3u) << 2) | ((row >> 2) & 3u))); }
DI unsigned cvt2(float a, float b) { typedef __bf16 b2 __attribute__((ext_vector_type(2))); typedef float f2 __attribute__((ext_vector_type(2))); const b2 r = __builtin_convertvector((f2){a, b}, b2); return __builtin_bit_cast(unsigned, r); }
DI bf16x8 pack_p(const f32x16& x, int s) {
    const u32x4 w = {cvt2(x[8 * s], x[8 * s + 1]), cvt2(x[8 * s + 2], x[8 * s + 3]), cvt2(x[8 * s + 4], x[8 * s + 5]), cvt2(x[8 * s + 6], x[8 * s + 7])};
    return __builtin_bit_cast(bf16x8, w);
}
DI void nsa_tile_dma(LAS char* kb, LAS char* vb, const bf16_t* kt, const bf16_t* vt, int tid, int w) {
#pragma unroll
    for (int i = 0; i < 2; ++i) { const int id = tid + 512 * i; const unsigned row = id >> 4, pos = id & 15; const unsigned ch = pos ^ (((row & 3u) << 2) | ((row >> 2) & 3u));
        const size_t so = (size_t)row * 128 + ch * 8; const unsigned lo = (unsigned)(i * 512 + w * 64) * 16u;
        __builtin_amdgcn_global_load_lds((const unsigned*)(kt + so), (LAS unsigned*)(kb + lo), 16, 0, 0);
        __builtin_amdgcn_global_load_lds((const unsigned*)(vt + so), (LAS unsigned*)(vb + lo), 16, 0, 0); }
}
#define NSA_TR8(R, A, OFF) asm volatile( \
    "ds_read_b64_tr_b16 %0, %8 offset:%16\n\tds_read_b64_tr_b16 %1, %9 offset:%16\n\tds_read_b64_tr_b16 %2, %10 offset:%16\n\tds_read_b64_tr_b16 %3, %11 offset:%16\n\t" \
    "ds_read_b64_tr_b16 %4, %12 offset:%16\n\tds_read_b64_tr_b16 %5, %13 offset:%16\n\tds_read_b64_tr_b16 %6, %14 offset:%16\n\tds_read_b64_tr_b16 %7, %15 offset:%16\n\ts_waitcnt lgkmcnt(0)" \
    : "=&v"(R[0]), "=&v"(R[1]), "=&v"(R[2]), "=&v"(R[3]), "=&v"(R[4]), "=&v"(R[5]), "=&v"(R[6]), "=&v"(R[7]) \
    : "v"(A[0]), "v"(A[1]), "v"(A[2]), "v"(A[3]), "v"(A[4]), "v"(A[5]), "v"(A[6]), "v"(A[7]), "i"(OFF) : "memory")

#define NSA_TR4(R, A0, A1, A2, A3, OFF) asm volatile( \
    "ds_read_b64_tr_b16 %0, %4 offset:%8\n\tds_read_b64_tr_b16 %1, %5 offset:%8\n\tds_read_b64_tr_b16 %2, %6 offset:%8\n\tds_read_b64_tr_b16 %3, %7 offset:%8" \
    : "=&v"(R[0]), "=&v"(R[1]), "=&v"(R[2]), "=&v"(R[3]) : "v"(A0), "v"(A1), "v"(A2), "v"(A3), "i"(OFF) : "memory")
#define NSA_LWAIT(N, R) asm volatile("s_waitcnt lgkmcnt(" #N ")" : "+v"(R[0]), "+v"(R[1]), "+v"(R[2]), "+v"(R[3]) :: "memory")
struct NsaWave {
    float m, l;
    f32x16 O[4];
    bf16x8 q[8];
};
template <int MODE>
DI void nsa_tile_compute(NsaWave& W, unsigned kbuf, unsigned vbuf, const unsigned (&vaddr0)[8], int tq0, int kind, int kbeg, bool needmask, bool rowneed, int lane, LAS float* impA, LAS float* impL, int mblk0) {
    const int c = lane & 31, h = lane >> 5;
    constexpr float C2 = ATT_SCALE * 1.4426950408889634f;
    f32x16 s0, s1;
    const f32x16 zero16 = {0.f, 0.f, 0.f, 0.f, 0.f, 0.f, 0.f, 0.f, 0.f, 0.f, 0.f, 0.f, 0.f, 0.f, 0.f, 0.f};
    const unsigned f = ((c & 3u) << 2) | ((c >> 2) & 3u);
#ifndef NSA_REP_QK
#define NSA_REP_QK 1
#endif
    __builtin_amdgcn_s_setprio(1);
#pragma unroll 1
    for (int rq_ = 0; rq_ < NSA_REP_QK; ++rq_) {
        if (NSA_REP_QK > 1) asm volatile("" ::: "memory");
#pragma unroll
    for (int s = 0; s < 8; ++s) { const unsigned ch = (unsigned)(2 * s + h) ^ f;
        const bf16x8 a0 = *(const LAS bf16x8*)(size_t)(kbuf + 256u * c + 16u * ch), a1 = *(const LAS bf16x8*)(size_t)(kbuf + 8192u + 256u * c + 16u * ch);
        s0 = MFMA32(a0, W.q[s], s == 0 ? zero16 : s0); s1 = MFMA32(a1, W.q[s], s == 0 ? zero16 : s1); } }
    __builtin_amdgcn_s_setprio(0);
    if (needmask) {
        const int tq = tq0 + (c >> 2);
        const int lo = kind == 2 ? tq - 511 : 0, hi = kind == 0 ? (tq >= 31 ? (tq - 31) >> 4 : -1) : tq;
#pragma unroll
        for (int r = 0; r < 16; ++r) { const int k0 = kbeg + (r & 3) + 8 * (r >> 2) + 4 * h, k1 = k0 + 32;
            if (!(k0 >= lo && k0 <= hi)) s0[r] = -INFINITY;
            if (!(k1 >= lo && k1 <= hi)) s1[r] = -INFINITY; }
    }
    if (MODE != 2) {
        float mx = fmaxf(fmaxf(s0[0], s0[1]), s1[0]);
#pragma unroll
        for (int r = 2; r < 16; r += 2) mx = fmaxf(fmaxf(mx, s0[r]), s0[r + 1]);
#pragma unroll
        for (int r = 1; r < 15; r += 2) mx = fmaxf(fmaxf(mx, s1[r]), s1[r + 1]);
        mx = fmaxf(mx, s1[15]);
        mx = fmaxf(mx, __shfl_xor(mx, 32));
        if (!rowneed) mx = -INFINITY;
        const float mn = (W.m == -INFINITY || (mx - W.m) * C2 > 8.f) ? fmaxf(W.m, mx) : W.m;
        const float mu = (mn == -INFINITY) ? 0.f : mn;
        const float alpha = __builtin_amdgcn_exp2f((W.m - mu) * C2);
        const float nb = rowneed ? -mu * C2 : -INFINITY;
        float rs = 0.f;
#pragma unroll
        for (int r = 0; r < 16; ++r) { s0[r] = __builtin_amdgcn_exp2f(__builtin_fmaf(s0[r], C2, nb)); s1[r] = __builtin_amdgcn_exp2f(__builtin_fmaf(s1[r], C2, nb)); rs += s0[r] + s1[r]; }
        rs += __shfl_xor(rs, 32);
        W.l = W.l * alpha + rs; W.m = mn;
        if (MODE == 0 && !__all(alpha == 1.f)) {
#pragma unroll
            for (int d = 0; d < 4; ++d)
#pragma unroll
                for (int r = 0; r < 16; ++r) W.O[d][r] *= alpha; }
    } else {
#pragma unroll
        for (int r = 0; r < 16; ++r) { s0[r] = __builtin_amdgcn_exp2f((s0[r] - W.m) * C2) * W.l; s1[r] = __builtin_amdgcn_exp2f((s1[r] - W.m) * C2) * W.l; }
#pragma unroll
        for (int kb = 0; kb < 2; ++kb)
#pragma unroll
            for (int i = 0; i < 4; ++i) { const f32x16& sv = kb ? s1 : s0;
                float a = sv[4 * i] + sv[4 * i + 1] + sv[4 * i + 2] + sv[4 * i + 3], lv = sv[4 * i + 3];
                a += __shfl_xor(a, 1); a += __shfl_xor(a, 2); lv += __shfl_xor(lv, 1); lv += __shfl_xor(lv, 2);
                if ((c & 3) == 0) { const int mb = mblk0 + 8 * kb + 2 * i + h; impA[(c >> 2) * 128 + mb] = a; impL[(c >> 2) * 128 + mb] = lv; } }
    }
    if (MODE != 1) {
        unsigned vaddrl[8];
        { const unsigned q = (lane & 15) >> 2, pp = lane & 3, blk = (lane >> 4) & 1;
#pragma unroll
          for (int d = 0; d < 4; ++d)
#pragma unroll
              for (int t = 0; t < 2; ++t) vaddrl[2 * d + t] = vbuf + offb(8u * t + 4u * h + q, 4u * d + 2u * blk + (pp >> 1)) + 8u * (pp & 1u); }
        bf16x8 pf[4] = {pack_p(s0, 0), pack_p(s0, 1), pack_p(s1, 0), pack_p(s1, 1)};
        s16x4 RA[4], RB[4];
        asm volatile("s_waitcnt lgkmcnt(0)" ::: "memory");
        NSA_TR4(RA, vaddrl[0], vaddrl[1], vaddrl[2], vaddrl[3], 0);
        NSA_TR4(RB, vaddrl[4], vaddrl[5], vaddrl[6], vaddrl[7], 0);
#define NSA_PVSTEP(KS, NEXTOFF, HASNEXT) \
        NSA_LWAIT(4, RA); __builtin_amdgcn_sched_barrier(0); \
        { const bf16x8 v0_ = __builtin_shufflevector(RA[0], RA[1], 0, 1, 2, 3, 4, 5, 6, 7), v1_ = __builtin_shufflevector(RA[2], RA[3], 0, 1, 2, 3, 4, 5, 6, 7); \
          W.O[0] = MFMA32(v0_, pf[KS], W.O[0]); W.O[1] = MFMA32(v1_, pf[KS], W.O[1]); } \
        __builtin_amdgcn_sched_barrier(0); \
        if (HASNEXT) NSA_TR4(RA, vaddrl[0], vaddrl[1], vaddrl[2], vaddrl[3], NEXTOFF); \
        if (HASNEXT) NSA_LWAIT(4, RB); else NSA_LWAIT(0, RB); \
        __builtin_amdgcn_sched_barrier(0); \
        { const bf16x8 v2_ = __builtin_shufflevector(RB[0], RB[1], 0, 1, 2, 3, 4, 5, 6, 7), v3_ = __builtin_shufflevector(RB[2], RB[3], 0, 1, 2, 3, 4, 5, 6, 7); \
          W.O[2] = MFMA32(v2_, pf[KS], W.O[2]); W.O[3] = MFMA32(v3_, pf[KS], W.O[3]); } \
        __builtin_amdgcn_sched_barrier(0); \
        if (HASNEXT) NSA_TR4(RB, vaddrl[4], vaddrl[5], vaddrl[6], vaddrl[7], NEXTOFF);
        __builtin_amdgcn_s_setprio(1);
        NSA_PVSTEP(0, 4096, true) NSA_PVSTEP(1, 8192, true) NSA_PVSTEP(2, 12288, true) NSA_PVSTEP(3, 0, false)
        __builtin_amdgcn_s_setprio(0);
#undef NSA_PVSTEP
    }
}
DI void nsa_fold(const NsaWave& W, bf16_t* obrow, unsigned char* ob8row, float sc, bool first, bool last, int h) {
#pragma unroll
    for (int d = 0; d < 4; ++d)
#pragma unroll
        for (int i = 0; i < 4; ++i) { bf16_t* pp = obrow + 32 * d + 8 * i + 4 * h; float o0 = 0.f, o1 = 0.f, o2 = 0.f, o3 = 0.f;
            if (!first) { const u32x2 w = *(const u32x2*)pp; o0 = bflo(w[0]); o1 = bfhi(w[0]); o2 = bflo(w[1]); o3 = bfhi(w[1]); }
            o0 += sc * W.O[d][4 * i]; o1 += sc * W.O[d][4 * i + 1]; o2 += sc * W.O[d][4 * i + 2]; o3 += sc * W.O[d][4 * i + 3];
            if (last) *(unsigned*)(ob8row + 32 * d + 8 * i + 4 * h) = pg8::fp8x4(o0 * pg8::A8_SCALE, o1 * pg8::A8_SCALE, o2 * pg8::A8_SCALE, o3 * pg8::A8_SCALE);
            else *(u32x2*)pp = (u32x2){cvt2(o0, o1), cvt2(o2, o3)}; }
}
struct NsaRun { LAS char* L; unsigned lds0; const bf16_t* kbase; const bf16_t* vbase; int t0, nt, kind, tqmin, lo_min, lo_max, hi_min, hi_max, tid, w; LAS unsigned* selm; LAS float* impA; LAS float* impL; };
template <int MODE>
DI void nsa_tiles(NsaWave& W, const NsaRun& R, const unsigned (&vaddr)[8]) {
    if (R.nt <= 0) return;
    const int lane = R.tid & 63, c = lane & 31;
    __syncthreads();
    nsa_tile_dma(R.L, R.L + 16384, R.kbase + (size_t)R.t0 * 8192, R.vbase + (size_t)R.t0 * 8192, R.tid, R.w);
    asm volatile("s_waitcnt vmcnt(0)" ::: "memory");
    __syncthreads();
#pragma unroll 1
    for (int i = 0; i < R.nt; ++i) {
        const int cur = i & 1, tt = R.t0 + i, kbeg = tt * 64;
        if (i + 1 < R.nt) nsa_tile_dma(R.L + (cur ^ 1) * 32768, R.L + (cur ^ 1) * 32768 + 16384, R.kbase + (size_t)(tt + 1) * 8192, R.vbase + (size_t)(tt + 1) * 8192, R.tid, R.w);
        bool rowneed = true;
        if (R.kind == 1) { const unsigned wsel = R.selm[(c >> 2) * 4 + (tt >> 5)]; rowneed = (wsel >> (tt & 31)) & 1u; }
        const bool skip = kbeg > R.hi_max || kbeg + 63 < R.lo_min || (R.kind == 1 && __ballot(rowneed) == 0ull);
        if (!skip) {
            const bool needmask = !(kbeg >= R.lo_max && kbeg + 63 <= R.hi_min);
            const unsigned kb_ = R.lds0 + cur * 32768u, vb_ = kb_ + 16384u;
            nsa_tile_compute<MODE>(W, kb_, vb_, vaddr, R.tqmin, R.kind, kbeg, needmask, rowneed, lane, R.impA, R.impL, MODE == 2 ? tt * 16 : 0);
        }
        asm volatile("s_waitcnt vmcnt(0)" ::: "memory");
        __syncthreads();
    }
}
DI void phase_nsa_mfma(const Params& p, char* smem) {
    const int tid = tid_fresh(), lane = tid & 63, w = __builtin_amdgcn_readfirstlane(tid >> 6), c = lane & 31, h = lane >> 5;
    LAS char* L = (LAS char*)smem;
    const unsigned lds0 = (unsigned)(size_t)L;
    LAS float* impA = (LAS float*)(L + 65536) + w * 1024; LAS float* impL = (LAS float*)(L + 65536 + 32768) + w * 1024;
    LAS unsigned* selm = (LAS unsigned*)(L + 131072) + w * 32;
    const bf16_t* BQ = (const bf16_t*)(p.ws + O_BQ); const bf16_t* kvs = (const bf16_t*)(p.ws + O_KVS); const bf16_t* kcvc = (const bf16_t*)(p.ws + O_KCVC);
    const float* gates = (const float*)(p.ws + O_GATES); bf16_t* OB = (bf16_t*)(p.ws + O_OB);
    unsigned vaddr[8];
    { const unsigned q = (lane & 15) >> 2, pp = lane & 3, blk = (lane >> 4) & 1;
#pragma unroll
      for (int d = 0; d < 4; ++d)
#pragma unroll
          for (int t = 0; t < 2; ++t) vaddr[2 * d + t] = offb(8u * t + 4u * h + q, 4u * d + 2u * blk + (pp >> 1)) + 8u * (pp & 1u); }
#pragma unroll 1
    for (int P = blockIdx.x; P < 256; P += gridDim.x) {
#pragma unroll 1
        for (int half = 0; half < 2; ++half) {
            const int bg = P >> 6, x = P & 63, qb = half == 0 ? 127 - x : x, b = bg >> 1, g = bg & 1, q0 = qb * 64;
            NsaWave W;
            const int tqmin = q0 + 8 * w, tqmax = tqmin + 7; const int tok = b * T + tqmin + (c >> 2);
            { const bf16_t* qr = BQ + (size_t)tok * 1024 + (g * 4 + (c & 3)) * 128 + 8 * h;
#pragma unroll
              for (int s = 0; s < 8; ++s) W.q[s] = *(const bf16x8*)(qr + 16 * s); }
#pragma unroll
            for (int i = 0; i < 16; ++i) { impA[lane + 64 * i] = 0.f; impL[lane + 64 * i] = 0.f; }
            for (int step = 0; step < 4; ++step) {
                const int kind = step < 2 ? 0 : step - 1;
                const bf16_t* kbase; const bf16_t* vbase; int t0, nt;
                int lo_min, lo_max, hi_min, hi_max;
                if (kind == 0) { kbase = kcvc + (size_t)bg * 512 * 128; vbase = kcvc + (size_t)2048 * 128 + (size_t)bg * 512 * 128;
                    t0 = 0; const int nlast = (q0 + 63 - 31) >> 4; nt = q0 + 63 >= 31 ? (nlast >> 6) + 1 : 0;
                    lo_min = 0; lo_max = 0; hi_min = tqmin >= 31 ? (tqmin - 31) >> 4 : -1; hi_max = tqmax >= 31 ? (tqmax - 31) >> 4 : -1; }
                else if (kind == 1) { kbase = kvs + (2 * (size_t)NB * 2 + bg) * T * 128; vbase = kvs + (3 * (size_t)NB * 2 + bg) * T * 128;
                    t0 = 0; nt = qb + 1; lo_min = 0; lo_max = 0; hi_min = tqmin; hi_max = tqmax; }
                else { kbase = kvs + (4 * (size_t)NB * 2 + bg) * T * 128; vbase = kvs + (5 * (size_t)NB * 2 + bg) * T * 128;
                    t0 = qb >= 8 ? qb - 8 : 0; nt = qb - t0 + 1; lo_min = tqmin - 511; lo_max = tqmax - 511; hi_min = tqmin; hi_max = tqmax; }
                if (step != 1) { W.m = -INFINITY; W.l = 0.f; }
#pragma unroll
                for (int d = 0; d < 4; ++d)
#pragma unroll
                    for (int r = 0; r < 16; ++r) W.O[d][r] = 0.f;
                {   NsaRun R; R.L = L; R.lds0 = lds0; R.kbase = kbase; R.vbase = vbase; R.t0 = t0; R.nt = nt; R.kind = kind; R.tqmin = tqmin; R.lo_min = lo_min; R.lo_max = lo_max; R.hi_min = hi_min; R.hi_max = hi_max;
                    R.tid = tid; R.w = w; R.selm = selm; R.impA = impA; R.impL = impL;
                    if (step == 0) nsa_tiles<1>(W, R, vaddr); else if (step == 1) nsa_tiles<2>(W, R, vaddr); else nsa_tiles<0>(W, R, vaddr); }
                if (step == 0) { if (W.m == -INFINITY) W.m = 0.f; W.l = 1.f / fmaxf(W.l, 1e-30f); continue; }
                { int lz = lane; asm volatile("" : "+v"(lz)); const int cz = lz & 31; const int tokz = b * T + tqmin + (cz >> 2);
                  const float gv = gates[(size_t)tokz * 24 + (g * 4 + (cz & 3)) * 3 + kind];
                  nsa_fold(W, OB + (size_t)tokz * 1024 + (g * 4 + (cz & 3)) * 128, (unsigned char*)(p.ws + O_OB8) + (size_t)tokz * 1024 + (g * 4 + (cz & 3)) * 128, step == 1 ? gv : gv / fmaxf(W.l, 1e-30f), step == 1, step == 3, lz >> 5); }
                if (step == 1) {
                    asm volatile("s_waitcnt lgkmcnt(0)" ::: "memory");
#pragma unroll 1
                    for (int qi = 0; qi < 8; ++qi) { const int tqq = tqmin + qi, curb = tqq >> 6; unsigned key[2];
#pragma unroll
                        for (int hh = 0; hh < 2; ++hh) { const int mb = lane + 64 * hh; const float imp = impA[qi * 128 + mb] + (mb > 0 ? impL[qi * 128 + mb - 1] : 0.f);
                            const bool adm = mb <= curb, forced = mb == 0 || mb == curb || mb == curb - 1;
                            key[hh] = !adm ? 0u : (forced ? (0xFF000000u | (unsigned)(127 - mb)) : ((((__float_as_uint(imp) >> 7) + 1u) << 7) | (unsigned)(127 - mb))); }
                        unsigned Tv = 0u;
                        for (int bit = 31; bit >= 0; --bit) { const unsigned cand = Tv | (1u << bit);
                            const int cnt = __popcll(__ballot(key[0] >= cand)) + __popcll(__ballot(key[1] >= cand)); if (cnt >= 16) Tv = cand; }
                        if (Tv == 0u) Tv = 1u;
                        const unsigned long long m0 = __ballot(key[0] >= Tv), m1 = __ballot(key[1] >= Tv);
                        if (lane == 0) { selm[qi * 4] = (unsigned)m0; selm[qi * 4 + 1] = (unsigned)(m0 >> 32); selm[qi * 4 + 2] = (unsigned)m1; selm[qi * 4 + 3] = (unsigned)(m1 >> 32); } }
                    asm volatile("s_waitcnt lgkmcnt(0)" ::: "memory");
                }
            }
        }
    }
}

DI void topk256_hist(LAS unsigned short* sck, int nk, LAS unsigned* hist, unsigned short* out, int lane) {
    const int nit = (nk + 511) >> 9;
    const unsigned long long ltm = (1ull << lane) - 1ull;
    for (int k = nk + lane; k < 512 * nit; k += 64) sck[k] = 0;
    unsigned bsel = 0, cnt_above = 0;
#pragma unroll 1
    for (int pass = 0; pass < 2; ++pass) {
        *(LAS u32x4*)(hist + 4 * lane) = (u32x4){0u, 0u, 0u, 0u};
        asm volatile("s_waitcnt lgkmcnt(0)" ::: "memory");
#pragma unroll 1
        for (int i = 0; i < nit; ++i) { const int k0 = 8 * (i * 64 + lane); const u32x4 wv = *(const LAS u32x4*)(sck + k0);
#pragma unroll
            for (int j = 0; j < 8; ++j) { const unsigned key = (j & 1) ? (wv[j >> 1] >> 16) : (wv[j >> 1] & 0xffffu);
                if (pass == 0) __hip_atomic_fetch_add(hist + (key >> 8), 1u, __ATOMIC_RELAXED, __HIP_MEMORY_SCOPE_WORKGROUP);
                else if ((key >> 8) == bsel) __hip_atomic_fetch_add(hist + (key & 255u), 1u, __ATOMIC_RELAXED, __HIP_MEMORY_SCOPE_WORKGROUP); } }
        asm volatile("s_waitcnt lgkmcnt(0)" ::: "memory");
        const u32x4 c4 = *(const LAS u32x4*)(hist + 4 * lane);
        const unsigned tot = c4[0] + c4[1] + c4[2] + c4[3];
        unsigned inc = tot;
#pragma unroll
        for (int o = 1; o < 64; o <<= 1) { const unsigned v = __shfl_down(inc, o); if (lane + o < 64) inc += v; }
        unsigned above = cnt_above + inc - tot;
        int found = -1; unsigned fabove = 0;
#pragma unroll
        for (int bb = 3; bb >= 0; --bb) { if (found < 0 && above < 256u && above + c4[bb] >= 256u) { found = 4 * lane + bb; fabove = above; } above += c4[bb]; }
        const unsigned long long fm = __ballot(found >= 0); const int src = __builtin_ctzll(fm);
        const unsigned fb = (unsigned)__shfl(found, src); cnt_above = (unsigned)__shfl((int)fabove, src);
        bsel = pass == 0 ? fb : ((bsel << 8) | fb);
    }
    const unsigned Tv = bsel; const int need = 256 - (int)cnt_above; int pos = 0, eqc = 0;
#pragma unroll 1
    for (int i = 0; i < nit; ++i) { const int k0 = 8 * (i * 64 + lane); const u32x4 wv = *(const LAS u32x4*)(sck + k0);
        bool eq[8], sl[8]; bool anyeq = false;
#pragma unroll
        for (int j = 0; j < 8; ++j) { const unsigned key = (j & 1) ? (wv[j >> 1] >> 16) : (wv[j >> 1] & 0xffffu); eq[j] = key == Tv; sl[j] = key > Tv; anyeq |= eq[j]; }
        if (__ballot(anyeq) != 0ull) {
            int below = 0, own = 0, etot = 0;
#pragma unroll
            for (int j = 0; j < 8; ++j) { const unsigned long long em = __ballot(eq[j]); below += __popcll(em & ltm); etot += __popcll(em); }
#pragma unroll
            for (int j = 0; j < 8; ++j) if (eq[j]) { if (eqc + below + own < need) sl[j] = true; ++own; }
            eqc += etot; }
#pragma unroll
        for (int j = 0; j < 8; ++j) { const unsigned long long sm = __ballot(sl[j]); if (sl[j]) out[pos + __popcll(sm & ltm)] = (unsigned short)(k0 + j); pos += __popcll(sm); } }
}
DI void phase_indexer_mfma(const Params& p, char* smem) {
    const int tid = tid_fresh(), lane = tid & 63, w = __builtin_amdgcn_readfirstlane(tid >> 6), c = lane & 31, hh = lane >> 5;
    LAS unsigned short* sc = (LAS unsigned short*)(LAS char*)smem;
    LAS unsigned* hist = (LAS unsigned*)((LAS char*)smem + 131072) + w * 256;
    const bf16_t* Q = (const bf16_t*)(p.ws + O_QALL); const bf16_t* KI = (const bf16_t*)(p.ws + O_KIDX); const float* WI = (const float*)(p.ws + O_WIDX);
    unsigned short* SEL = (unsigned short*)(p.ws + O_SEL); int* NSEL = (int*)(p.ws + O_NSEL);
    const float* rope = (const float*)(p.ws + O_ROPE);
    c2_rows(p, smem);
    __syncthreads();
#pragma unroll 1
    for (int rnd = 0; rnd * (int)gridDim.x < NT / 8; ++rnd) {
        const int slot = (rnd & 1) ? (int)gridDim.x - 1 - (int)blockIdx.x : (int)blockIdx.x;
        const int u = NT / 8 - 1 - (rnd * (int)gridDim.x + slot);
        if (u < 0) continue;
        const int tok0 = u * 8, b = tok0 >> 13, q0 = tok0 & (T - 1), nkmax = q0 + 8;
        const int tok = tok0 + w, nk = q0 + w + 1;
        unsigned short* out = SEL + (size_t)tok * 256;
#ifndef IDX_REP_SCORE
#define IDX_REP_SCORE 1
#endif
#ifndef IDX_REP_SEL
#define IDX_REP_SEL 1
#endif
        for (int rs_ = 0; rs_ < IDX_REP_SCORE; ++rs_)
        if (nkmax > 256) {
            bf16x8 qa[2][4], Wf[2][2];
#pragma unroll
            for (int rb = 0; rb < 2; ++rb) { const bf16_t* qr = Q + (size_t)(tok0 + 4 * rb + (c >> 3)) * QC + 2304 + (c & 7) * 64 + 8 * hh;
#pragma unroll
                for (int s = 0; s < 4; ++s) qa[rb][s] = *(const bf16x8*)(qr + 16 * s);
                {
                    const float* rt = rope + (size_t)(tok0 + 4 * rb + (c >> 3)) * 48 + 32;
                    const u32x4 own = __builtin_bit_cast(u32x4, qa[rb][0]); u32x4 oth;
#pragma unroll
                    for (int k = 0; k < 4; ++k) oth[k] = (unsigned)__shfl_xor((int)own[k], 32);
                    float xa[8], xb[8], xr[8]; unpack8(own, xa); unpack8(oth, xb);
#pragma unroll
                    for (int j = 0; j < 8; ++j) { const float cs = rt[2 * j], sn = rt[2 * j + 1]; xr[j] = hh == 0 ? xa[j] * cs - xb[j] * sn : xa[j] * cs + xb[j] * sn; }
                    const u32x4 pk = {pk2(xr[0], xr[1]), pk2(xr[2], xr[3]), pk2(xr[4], xr[5]), pk2(xr[6], xr[7])};
                    qa[rb][0] = __builtin_bit_cast(bf16x8, pk); }
                { f32x4 wv = {0.f, 0.f, 0.f, 0.f}; if (c < 8) wv = *(const f32x4*)(WI + (size_t)(tok0 + c) * 8 + 4 * hh);
#pragma unroll
                  for (int sp = 0; sp < 2; ++sp) { const bool m0 = c == 4 * rb + 2 * sp, m1 = c == 4 * rb + 2 * sp + 1;
                      const u32x4 pkw = {m0 ? pk2(wv[0], wv[1]) : 0u, m0 ? pk2(wv[2], wv[3]) : 0u, m1 ? pk2(wv[0], wv[1]) : 0u, m1 ? pk2(wv[2], wv[3]) : 0u};
                      Wf[rb][sp] = __builtin_bit_cast(bf16x8, pkw); } } }
            const int npair = (nkmax + 63) >> 6;
            const bf16_t* kbase = KI + ((size_t)b * T + c) * 64 + 8 * hh;
            bf16x8 kb[2][4], kn[2][4];
            auto ldk = [&](bf16x8 (&dst)[2][4], int pr) {
#pragma unroll
                for (int tt = 0; tt < 2; ++tt) { int key0 = 64 * pr + 32 * tt; if (key0 + 31 >= T) key0 = T - 32;
#pragma unroll
                    for (int s = 0; s < 4; ++s) dst[tt][s] = *(const bf16x8*)(kbase + (size_t)key0 * 64 + 16 * s); } };
            if (w < npair) ldk(kb, w);
#pragma unroll 1
            for (int pr = w; pr < npair; pr += 8) {
                if (pr + 8 < npair) ldk(kn, pr + 8);
#pragma unroll
                for (int tt = 0; tt < 2; ++tt) {
                    const int key = 64 * pr + 32 * tt + c;
                    f32x16 a0, a1; const f32x16 z16 = {0.f, 0.f, 0.f, 0.f, 0.f, 0.f, 0.f, 0.f, 0.f, 0.f, 0.f, 0.f, 0.f, 0.f, 0.f, 0.f};
#pragma unroll
                    for (int s = 0; s < 4; ++s) { a0 = MFMA32(qa[0][s], kb[tt][s], s == 0 ? z16 : a0); a1 = MFMA32(qa[1][s], kb[tt][s], s == 0 ? z16 : a1); }
#pragma unroll
                    for (int i = 0; i < 16; ++i) { a0[i] = fmaxf(a0[i], 0.f); a1[i] = fmaxf(a1[i], 0.f); }
                    f32x16 d2 = MFMA32(Wf[0][0], pack_p(a0, 0), z16);
                    d2 = MFMA32(Wf[0][1], pack_p(a0, 1), d2); d2 = MFMA32(Wf[1][0], pack_p(a1, 0), d2); d2 = MFMA32(Wf[1][1], pack_p(a1, 1), d2);
                    if (key < 8192) {
#pragma unroll
                        for (int qq = 0; qq < 4; ++qq) sc[(4 * hh + qq) * 8192 + key] = f16key(d2[qq]); }
                }
#pragma unroll
                for (int tt = 0; tt < 2; ++tt)
#pragma unroll
                    for (int s = 0; s < 4; ++s) kb[tt][s] = kn[tt][s];
            }
        }
        __syncthreads();
        if (nk <= 256) { for (int i = lane; i < 256; i += 64) out[i] = (unsigned short)(i < nk ? i : 0); if (lane == 0) NSEL[tok] = nk; }
        else { for (int rs_ = 0; rs_ < IDX_REP_SEL; ++rs_) topk256_hist(sc + w * 8192, nk, hist, out, lane); if (lane == 0) NSEL[tok] = 256; }
        __syncthreads();
    }
}

#define MFMA16(a, b, c) __builtin_amdgcn_mfma_f32_16x16x32_bf16((a), (b), (c), 0, 0, 0)
#define MLA_ROW 592
#define MLA_TR8(R, BASE, OFF) asm volatile( \
    "ds_read_b64_tr_b16 %0, %8 offset:%9\n\tds_read_b64_tr_b16 %1, %8 offset:%10\n\tds_read_b64_tr_b16 %2, %8 offset:%11\n\tds_read_b64_tr_b16 %3, %8 offset:%12\n\t" \
    "ds_read_b64_tr_b16 %4, %8 offset:%13\n\tds_read_b64_tr_b16 %5, %8 offset:%14\n\tds_read_b64_tr_b16 %6, %8 offset:%15\n\tds_read_b64_tr_b16 %7, %8 offset:%16\n\ts_waitcnt lgkmcnt(0)" \
    : "=&v"(R[0]), "=&v"(R[1]), "=&v"(R[2]), "=&v"(R[3]), "=&v"(R[4]), "=&v"(R[5]), "=&v"(R[6]), "=&v"(R[7]) \
    : "v"(BASE), "i"(OFF), "i"((OFF) + 16 * MLA_ROW), "i"((OFF) + 32), "i"((OFF) + 32 + 16 * MLA_ROW), "i"((OFF) + 64), "i"((OFF) + 64 + 16 * MLA_ROW), "i"((OFF) + 96), "i"((OFF) + 96 + 16 * MLA_ROW) : "memory")
DI void phase_mla_mfma(const Params& p, char* smem) {
    const int tid = tid_fresh(), lane = tid & 63, w = __builtin_amdgcn_readfirstlane(tid >> 6), fr = lane & 15, g = lane >> 4;
    LAS char* buf = (LAS char*)smem + w * (32 * MLA_ROW);
    const unsigned lbase = (unsigned)(size_t)buf;
    const bf16_t* Q = (const bf16_t*)(p.ws + O_QALL); const bf16_t* KV = (const bf16_t*)(p.ws + O_KVT);
    const unsigned short* SEL = (const unsigned short*)(p.ws + O_SEL); const int* NSEL = (const int*)(p.ws + O_NSEL); bf16_t* OL = (bf16_t*)(p.ws + O_OLAT);
    constexpr float C2 = ATT_SCALE * 1.4426950408889634f;
    int pf_cnt = 0, pf_s0 = 0, pf_s1 = 0;
    { const int tok = blockIdx.x * 8 + w; if (tok < NT) { pf_cnt = NSEL[tok]; if (lane < 32) { pf_s0 = SEL[(size_t)tok * 256 + lane]; pf_s1 = SEL[(size_t)tok * 256 + 32 + lane]; } } }
#pragma unroll 1
    for (int tok = blockIdx.x * 8 + w; tok < NT; tok += gridDim.x * 8) {
        const int b = tok >> 13; const int cnt = pf_cnt; const int cur_s0 = pf_s0, cur_s1 = pf_s1;
        { const int tn = tok + gridDim.x * 8; if (tn < NT) { pf_cnt = NSEL[tn]; if (lane < 32) { pf_s0 = SEL[(size_t)tn * 256 + lane]; pf_s1 = SEL[(size_t)tn * 256 + 32 + lane]; } } }
        bf16x8 qf[9];
        { const bf16_t* qr = Q + (size_t)tok * QC; const bf16x8 z8 = {0, 0, 0, 0, 0, 0, 0, 0};
#pragma unroll
          for (int s = 0; s < 8; ++s) qf[s] = fr < 8 ? *(const bf16x8*)(qr + fr * 256 + 32 * s + 8 * g) : z8;
          qf[8] = fr < 8 ? *(const bf16x8*)(qr + 2048 + fr * 32 + 8 * g) : z8;
          {
              const float* rt = (const float*)(p.ws + O_ROPE) + (size_t)tok * 48;
              const u32x4 own = __builtin_bit_cast(u32x4, qf[8]); u32x4 oth;
#pragma unroll
              for (int k = 0; k < 4; ++k) oth[k] = (unsigned)__shfl_xor((int)own[k], 32);
              float xa[8], xb[8], xr[8]; unpack8(own, xa); unpack8(oth, xb);
#pragma unroll
              for (int j = 0; j < 8; ++j) { const int fi = 8 * (g & 1) + j; const float cs = rt[2 * fi], sn = rt[2 * fi + 1]; xr[j] = g < 2 ? xa[j] * cs - xb[j] * sn : xa[j] * cs + xb[j] * sn; }
              const u32x4 pk = {pk2(xr[0], xr[1]), pk2(xr[2], xr[3]), pk2(xr[4], xr[5]), pk2(xr[6], xr[7])};
              qf[8] = __builtin_bit_cast(bf16x8, pk); } }
        f32x4 O[16];
#pragma unroll
        for (int d = 0; d < 16; ++d) O[d] = (f32x4){0.f, 0.f, 0.f, 0.f};
        float m = -INFINITY, l = 0.f;
        const int nchunk = (cnt + 31) >> 5;
        u32x4 st[18]; int selv_n = 0;
        const bf16_t* kvb = KV + (size_t)b * T * KVW;
        auto issue = [&](int selv, int lz) {
#pragma unroll
            for (int i = 0; i < 16; ++i) { const int r0 = __builtin_amdgcn_readlane(selv, 2 * i), r1 = __builtin_amdgcn_readlane(selv, 2 * i + 1); const int row = lz < 32 ? r0 : r1;
                st[i] = *(const u32x4*)(kvb + (size_t)row * KVW + (lz & 31) * 8); }
#pragma unroll
            for (int i = 0; i < 2; ++i) { const int row = __shfl(selv, 16 * i + (lz >> 2)); st[16 + i] = *(const u32x4*)(kvb + (size_t)row * KVW + 256 + (lz & 3) * 8); } };
        { int lz = lane; asm volatile("" : "+v"(lz));
          int selv = 0; if (lz < 32 && lz < cnt) selv = cur_s0;
          if (lz < 32 && 32 + lz < cnt) selv_n = cur_s1;
          issue(selv, lz); }
#pragma unroll 1
        for (int ch = 0; ch < nchunk; ++ch) {
            int lz = lane; asm volatile("" : "+v"(lz));
#pragma unroll
            for (int i = 0; i < 16; ++i) *(LAS u32x4*)(buf + (2 * i + (lz >> 5)) * MLA_ROW + (lz & 31) * 16) = st[i];
#pragma unroll
            for (int i = 0; i < 2; ++i) *(LAS u32x4*)(buf + (16 * i + (lz >> 2)) * MLA_ROW + 512 + (lz & 3) * 16) = st[16 + i];
            if (ch + 1 < nchunk) {
                const int selv = selv_n; selv_n = 0;
                { const int k = (ch + 2) * 32 + lz; if (lz < 32 && k < cnt) selv_n = SEL[(size_t)tok * 256 + k]; }
                issue(selv, lz); }
            asm volatile("s_waitcnt lgkmcnt(0)" ::: "memory");
            const int frz = lz & 15, gz = lz >> 4;
            f32x4 s0, s1; const f32x4 z4 = {0.f, 0.f, 0.f, 0.f};
#pragma unroll
            for (int s = 0; s < 9; ++s) { const bf16x8 a0 = *(const LAS bf16x8*)(buf + frz * MLA_ROW + (32 * s + 8 * gz) * 2), a1 = *(const LAS bf16x8*)(buf + (frz + 16) * MLA_ROW + (32 * s + 8 * gz) * 2);
                s0 = MFMA16(a0, qf[s], s == 0 ? z4 : s0); s1 = MFMA16(a1, qf[s], s == 0 ? z4 : s1); }
            float mx = -INFINITY;
#pragma unroll
            for (int j = 0; j < 4; ++j) { if (ch * 32 + 4 * gz + j >= cnt) s0[j] = -INFINITY; if (ch * 32 + 16 + 4 * gz + j >= cnt) s1[j] = -INFINITY; mx = fmaxf(mx, fmaxf(s0[j], s1[j])); }
            mx = fmaxf(mx, __shfl_xor(mx, 16)); mx = fmaxf(mx, __shfl_xor(mx, 32));
            const float mn = fmaxf(m, mx), mu = (mn == -INFINITY) ? 0.f : mn;
            const float alpha = __builtin_amdgcn_exp2f((m - mu) * C2);
            float rs = 0.f;
#pragma unroll
            for (int j = 0; j < 4; ++j) { s0[j] = __builtin_amdgcn_exp2f((s0[j] - mu) * C2); s1[j] = __builtin_amdgcn_exp2f((s1[j] - mu) * C2); rs += s0[j] + s1[j]; }
            rs += __shfl_xor(rs, 16); rs += __shfl_xor(rs, 32);
            l = l * alpha + rs; m = mn;
            if (!__all(alpha == 1.f)) {
#pragma unroll
                for (int d = 0; d < 16; ++d) O[d] *= alpha; }
            const u32x4 pw = {cvt2(s0[0], s0[1]), cvt2(s0[2], s0[3]), cvt2(s1[0], s1[1]), cvt2(s1[2], s1[3])};
            const bf16x8 pf = __builtin_bit_cast(bf16x8, pw);
            const unsigned tb = lbase + (unsigned)(4 * gz + (frz >> 2)) * MLA_ROW + 8u * (frz & 3);
#pragma unroll
            for (int dq = 0; dq < 4; ++dq) { s16x4 R[8];
                if (dq == 0) MLA_TR8(R, tb, 0); else if (dq == 1) MLA_TR8(R, tb, 128); else if (dq == 2) MLA_TR8(R, tb, 256); else MLA_TR8(R, tb, 384);
#pragma unroll
                for (int d = 0; d < 4; ++d) { const bf16x8 vf = __builtin_shufflevector(R[2 * d], R[2 * d + 1], 0, 1, 2, 3, 4, 5, 6, 7); O[4 * dq + d] = MFMA16(vf, pf, O[4 * dq + d]); } }
            asm volatile("s_waitcnt lgkmcnt(0)" ::: "memory");
        }
        const float il16 = pg8::A8_SCALE / fmaxf(l, 1e-30f);
        if (fr < 8) {
#pragma unroll
            for (int d = 0; d < 16; ++d) *(unsigned*)((unsigned char*)OL + (size_t)tok * D + fr * 256 + 16 * d + 4 * g) = pg8::fp8x4(O[d][0] * il16, O[d][1] * il16, O[d][2] * il16, O[d][3] * il16); }
    }
}

DI void phase_post_mix(const Params& p, char* smem, bool count) {
    const int tz_ = tid_fresh(); const int lane = tz_ & 63, wid = __builtin_amdgcn_readfirstlane(tz_ >> 6);
    float* part = (float*)smem;
    int* lcnt = (int*)(smem + 8 * 32 * 33 * 4);
    const bf16_t* MO = (const bf16_t*)(p.ws + O_MO); float* X1 = (float*)(p.ws + O_X1); bf16_t* H = (bf16_t*)(p.ws + O_H); const bf16_t* WR = (const bf16_t*)(p.ws + O_WRT);
    int* TOPI = (int*)(p.ws + O_TOPI); float* TOPW = (float*)(p.ws + O_TOPW); int* cnts = (int*)(p.ws + O_CNT);
#pragma unroll 1
    for (int ck = blockIdx.x; ck < NT / 64; ck += gridDim.x) {
#pragma unroll 1
        for (int j = 0; j < 8; ++j) {
            const int tok = ck * 64 + wid * 8 + j, b = tok >> 13;
            float v[32]; float ss = 0.f;
#pragma unroll
            for (int i = 0; i < 8; ++i) { const u32x2 w = *(const u32x2*)(MO + (size_t)tok * D + 4 * (lane + 64 * i));
                v[4 * i] = bflo(w[0]); v[4 * i + 1] = bfhi(w[0]); v[4 * i + 2] = bflo(w[1]); v[4 * i + 3] = bfhi(w[1]); }
#pragma unroll
            for (int i = 0; i < 32; ++i) ss += v[i] * v[i];
            const float rs = rsqrtf(wave_sum(ss) * (1.f / D) + NORM_EPS);
            float ss2 = 0.f;
#pragma unroll
            for (int i = 0; i < 8; ++i) { const int col = 4 * (lane + 64 * i); const f32x4 xv = *(const f32x4*)(p.x + (size_t)tok * D + col); f32x4 o;
#pragma unroll
                for (int q = 0; q < 4; ++q) { o[q] = xv[q] + mod_at(p, b, 4096 + col + q) * (v[4 * i + q] * rs * p.g_post_mix[col + q]); v[4 * i + q] = o[q]; ss2 += o[q] * o[q]; }
                *(f32x4*)(X1 + (size_t)tok * D + col) = o; }
            const float rs2 = rsqrtf(wave_sum(ss2) * (1.f / D) + NORM_EPS);
#pragma unroll
            for (int i = 0; i < 8; ++i) { const int col = 4 * (lane + 64 * i); f32x4 hv;
#pragma unroll
                for (int q = 0; q < 4; ++q) hv[q] = v[4 * i + q] * rs2 * p.g_pre_ffn[col + q] * (1.f + mod_at(p, b, 4 * 2048 + col + q)) + mod_at(p, b, 3 * 2048 + col + q);
                *(u32x2*)(H + (size_t)tok * D + col) = (u32x2){pk2(hv[0], hv[1]), pk2(hv[2], hv[3])}; }
        }
        asm volatile("s_waitcnt vmcnt(0)" ::: "memory");
        __syncthreads();
        if (tz_ < 32) lcnt[tz_] = 0;
        {
            const int c = lane & 31, hh = lane >> 5, rb = wid & 1, ks = wid >> 1;
            const bf16_t* ap = H + (size_t)(ck * 64 + 32 * rb + c) * D + 512 * ks + 8 * hh; const bf16_t* bp = WR + (size_t)c * D + 512 * ks + 8 * hh;
            f32x16 acc;
#pragma unroll
            for (int i = 0; i < 16; ++i) acc[i] = 0.f;
#pragma unroll 8
            for (int sx = 0; sx < 32; ++sx) { const bf16x8 a = *(const bf16x8*)(ap + 16 * sx), bb = *(const bf16x8*)(bp + 16 * sx); acc = MFMA32(a, bb, acc); }
#pragma unroll
            for (int r = 0; r < 16; ++r) part[(wid * 32 + (r & 3) + 8 * (r >> 2) + 4 * hh) * 33 + c] = acc[r];
        }
        __syncthreads();
        if (tz_ < 64) {
            const int rbt = tz_ >> 5, row = tz_ & 31, tok = ck * 64 + tz_;
            float lg[32];
#pragma unroll
            for (int e = 0; e < 32; ++e) lg[e] = p.b_router[e] + part[((0 * 2 + rbt) * 32 + row) * 33 + e] + part[((1 * 2 + rbt) * 32 + row) * 33 + e] + part[((2 * 2 + rbt) * 32 + row) * 33 + e] + part[((3 * 2 + rbt) * 32 + row) * 33 + e];
            int te[4]; float tv[4];
#pragma unroll
            for (int k = 0; k < 4; ++k) { float mx = lg[0]; int bi = 0;
#pragma unroll
                for (int e = 1; e < 32; ++e) if (lg[e] > mx) { mx = lg[e]; bi = e; }
                te[k] = bi; tv[k] = mx;
#pragma unroll
                for (int e = 0; e < 32; ++e) if (e == bi) lg[e] = -INFINITY; }
            const float e1 = __expf(tv[1] - tv[0]), e2 = __expf(tv[2] - tv[0]), e3 = __expf(tv[3] - tv[0]); const float inv = 1.f / (1.f + e1 + e2 + e3);
            *(int4*)(TOPI + tok * 4) = make_int4(te[0], te[1], te[2], te[3]);
            *(f32x4*)(TOPW + tok * 4) = (f32x4){inv, e1 * inv, e2 * inv, e3 * inv};
            atomicAdd(lcnt + te[0], 1); atomicAdd(lcnt + te[1], 1); atomicAdd(lcnt + te[2], 1); atomicAdd(lcnt + te[3], 1);
        }
        __syncthreads();
        if (count && tz_ < 32) atomicAdd(cnts + tz_, lcnt[tz_]);
    }
}

DI int moe_tables(const Params& p, LAS int* tile_e, LAS int* pstart) {
    int* cnts = (int*)(p.ws + O_CNT);
    if (threadIdx.x < 64) {
        const int e = threadIdx.x & 31;
        const int c = __hip_atomic_load(cnts + e, __ATOMIC_RELAXED, __HIP_MEMORY_SCOPE_AGENT);
        const int nt = (c + 255) >> 8; int inc = nt;
#pragma unroll
        for (int o = 1; o < 32; o <<= 1) { const int v = __shfl_up(inc, o, 32); if (e >= o) inc += v; }
        const int start = inc - nt;
        if (threadIdx.x < 32) { pstart[e] = start * 256; for (int i = 0; i < nt; ++i) tile_e[start + i] = e; if (e == 31) pstart[NEXP] = inc; } }
    __syncthreads();
    return pstart[NEXP];
}
DI void phase_moe_gather(const Params& p, char* smem) {
    const int tz_ = tid_fresh(); const int lane = tz_ & 63, wid = __builtin_amdgcn_readfirstlane(tz_ >> 6);
    LAS int* tile_e = (LAS int*)(LAS char*)smem; LAS int* pstart = tile_e + 320; LAS int* lcnt = pstart + 40; LAS int* lbase = lcnt + 32;
    (void)moe_tables(p, tile_e, pstart);
    const bf16_t* H = (const bf16_t*)(p.ws + O_H); unsigned char* HS = (unsigned char*)(p.ws + O_HS);
    const int* TOPI = (const int*)(p.ws + O_TOPI); const float* TOPW = (const float*)(p.ws + O_TOPW); int* TSLOT = (int*)(p.ws + O_TSLOT); float* SLOTW = (float*)(p.ws + O_SLOTW);
    int* fill = (int*)(p.ws + O_CNT) + 32;
#pragma unroll 1
    for (int ck = blockIdx.x; ck < NT / 64; ck += gridDim.x) {
        const int tok0 = ck * 64 + wid * 8;
        __syncthreads();
        if (tz_ < 32) lcnt[tz_] = 0;
        __syncthreads();
        int e = 0, rank = 0;
        if (lane < 32) { e = TOPI[tok0 * 4 + lane]; rank = atomicAdd((int*)(lcnt + e), 1); }
        __syncthreads();
        if (tz_ < 32) lbase[tz_] = atomicAdd(fill + tz_, lcnt[tz_]);
        __syncthreads();
        int slot = 0;
        if (lane < 32) { slot = pstart[e] + lbase[e] + rank; TSLOT[tok0 * 4 + lane] = slot; SLOTW[slot] = TOPW[tok0 * 4 + lane]; }
#pragma unroll 2
        for (int j = 0; j < 8; ++j) { u32x2 hv[4];
#pragma unroll
            for (int i = 0; i < 4; ++i) { float f[8]; unpack8(*(const u32x4*)(H + (size_t)(tok0 + j) * D + 8 * (lane + 64 * i)), f);
                hv[i] = (u32x2){pg8::fp8x4(f[0], f[1], f[2], f[3]), pg8::fp8x4(f[4], f[5], f[6], f[7])}; }
#pragma unroll
            for (int k = 0; k < 4; ++k) { const int sl = __shfl(slot, j * 4 + k);
#pragma unroll
                for (int i = 0; i < 4; ++i) *(u32x2*)(HS + (size_t)sl * D + 8 * (lane + 64 * i)) = hv[i]; } }
    }
}
DI void phase_final(const Params& p) {
    const int tz_ = tid_fresh(); const int lane = tz_ & 63, wid = __builtin_amdgcn_readfirstlane(tz_ >> 6);
    const unsigned char* YS = (const unsigned char*)(p.ws + O_YS); const float* X1 = (const float*)(p.ws + O_X1); const int* TSLOT = (const int*)(p.ws + O_TSLOT);
    for (int tok = blockIdx.x * 8 + wid; tok < NT; tok += gridDim.x * 8) {
        const int b = tok >> 13; float v[32];
#pragma unroll
        for (int i = 0; i < 32; ++i) v[i] = 0.f;
#pragma unroll
        for (int k = 0; k < 4; ++k) { const int slot = TSLOT[tok * 4 + k];
#pragma unroll
            for (int i = 0; i < 8; ++i) { const unsigned w = *(const unsigned*)(YS + (size_t)slot * D + 4 * (lane + 64 * i));
                const auto lo = __builtin_amdgcn_cvt_pk_f32_fp8((int)w, false), hi = __builtin_amdgcn_cvt_pk_f32_fp8((int)w, true);
                v[4 * i] += lo[0]; v[4 * i + 1] += lo[1]; v[4 * i + 2] += hi[0]; v[4 * i + 3] += hi[1]; } }
#pragma unroll
        for (int i = 0; i < 32; ++i) v[i] *= pg8::Y8_INV;
        float ss = 0.f;
#pragma unroll
        for (int i = 0; i < 32; ++i) ss += v[i] * v[i];
        const float rs = rsqrtf(wave_sum(ss) * (1.f / D) + NORM_EPS);
#pragma unroll
        for (int i = 0; i < 8; ++i) { const int col = 4 * (lane + 64 * i); const f32x4 xv = *(const f32x4*)(X1 + (size_t)tok * D + col); f32x4 o;
#pragma unroll
            for (int j = 0; j < 4; ++j) o[j] = xv[j] + mod_at(p, b, 5 * 2048 + col + j) * (v[4 * i + j] * rs * p.g_post_ffn[col + j]);
            *(f32x4*)(p.out + (size_t)tok * D + col) = o; }
    }
}

#ifndef PHMASK
#define PHMASK 0xFFFFFFFFu
#endif
#define PHON(ph) (((PHMASK) >> (ph)) & 1u)
#ifndef REPMASK
#define REPMASK 0u
#endif
#define REP(ph) _Pragma("unroll 1") for (int rep_ = 0; rep_ <= (int)(((REPMASK) >> (ph)) & 1u); ++rep_)
enum { PH_PREP = 0, PH_H1, PH_GIN, PH_ZPOST, PH_GQ, PH_QROPE, PH_IDX, PH_MLA, PH_NSA, PH_MERGE, PH_GOUT, PH_POSTMIX, PH_GATHER, PH_GU, PH_DN, PH_FINAL, PH_END };

__global__ void __launch_bounds__(512, 2) mega(Params p, int lo, int hi) {
    extern __shared__ __attribute__((aligned(16))) char smem[];
    LAS unsigned char* lds = (LAS unsigned char*)(LAS char*)smem;
    volatile LAS unsigned* xbw = (volatile LAS unsigned*)(LAS char*)(smem + LDS_BYTES - 16);
    XcdBarrier bar; bar.bar = (unsigned*)p.ws; bar.x = 0; bar.st = xbw;
    if (hi - lo > 1) { if (threadIdx.x == 0) { xbw[0] = 0u; xbw[1] = 0u; } __syncthreads(); bar = xcd_barrier_post((unsigned*)p.ws, xbw); }
    const int G = gridDim.x, c = blockIdx.x;
#define SEAM(ph) if ((ph) + 1 < hi) xcd_barrier(bar);
    if (PHON(PH_PREP) && lo <= PH_PREP && PH_PREP < hi) { REP(PH_PREP) { phase_prep(p, smem); } SEAM(PH_PREP) }
    if (PHON(PH_H1) && lo <= PH_H1 && PH_H1 < hi) { REP(PH_H1) { phase_h1(p); } SEAM(PH_H1) }
    if (PHON(PH_GIN) && lo <= PH_GIN && PH_GIN < hi) { REP(PH_GIN) {
        { pg8::PlainSched S; S.init(NT, 2048, G, c, p.ws + O_H, D, p.ws + O_WIN, D);
          pg8::EpiBf16 E; E.O = (bf16_t*)(p.ws + O_Z); E.ldc = ZC; E.scale = 1.f;
          pg8::gemm_phase(lds, pg8::Gemm{D, D, D}, S, E); }
        { pg8::PlainSched S; S.init(NT, ZC - 2048, G, c, p.ws + O_H8, D / 2, p.ws + O_WIN8 + (size_t)2048 * D, D / 2);
          pg8::EpiBf16 E; E.O = (bf16_t*)(p.ws + O_Z) + 2048; E.ldc = ZC; E.scale = pg8::W8_INV;
          pg8::gemm_phase_fp8(lds, pg8::Gemm{D / 2, D / 2, D / 2}, S, E); }
        } SEAM(PH_GIN) }
    if (PHON(PH_ZPOST) && lo <= PH_ZPOST && PH_ZPOST < hi) { REP(PH_ZPOST) { phase_zpost(p); } SEAM(PH_ZPOST) }
    if (PHON(PH_GQ) && lo <= PH_GQ && PH_GQ < hi) { REP(PH_GQ) {
        { pg8::PlainSched S; S.init(NT, QC, G, c, p.ws + O_CQN, 512, p.ws + O_WQ, 512);
          pg8::EpiBf16 E; E.O = (bf16_t*)(p.ws + O_QALL); E.ldc = QC; E.scale = 1.f;
          pg8::gemm_phase(lds, pg8::Gemm{512, 512, 512}, S, E); }
        { pg8::C1Sched S; S.G = G; S.c = c; S.kvs = p.ws + O_KVS; S.w = p.ws + O_WC1;
          pg8::EpiC1 E; E.C = (float*)(p.ws + O_C1P);
          pg8::gemm_phase(lds, pg8::Gemm{2048, 4096, 256}, S, E); }
        } SEAM(PH_GQ) }
    if (PHON(PH_IDX) && lo <= PH_IDX && PH_IDX < hi) { REP(PH_IDX) {
#ifdef IDX_NAIVE
        phase_indexer(p, smem);
#else
        phase_indexer_mfma(p, smem);
#endif
        } SEAM(PH_IDX) }
    if (PHON(PH_MLA) && lo <= PH_MLA && PH_MLA < hi) { REP(PH_MLA) {
#ifdef MLA_NAIVE
        phase_mla(p, smem);
#else
        phase_mla_mfma(p, smem);
#endif
        } SEAM(PH_MLA) }
    if (PHON(PH_NSA) && lo <= PH_NSA && PH_NSA < hi) { REP(PH_NSA) {
#ifdef NSA_NAIVE
        phase_nsa(p, smem);
#else
        phase_nsa_mfma(p, smem);
#endif
        } SEAM(PH_NSA) }
    if (PHON(PH_MERGE) && lo <= PH_MERGE && PH_MERGE < hi) { REP(PH_MERGE) {
        { pg8::PlainSched S; S.init(NT, D, G, c, p.ws + O_OLAT, D / 2, p.ws + O_WO, D / 2);
          pg8::EpiMerge<false> E; E.P = (bf16_t*)(p.ws + O_MERGED); E.O8 = nullptr; E.Z = (const bf16_t*)(p.ws + O_Z); E.gcol0 = ZC_MG; E.scale = pg8::A8W8_INV;
          pg8::gemm_phase_fp8(lds, pg8::Gemm{D / 2, D / 2, D / 2}, S, E); }
        { pg8::PlainSched S; S.init(NT, D, G, c, p.ws + O_OB8, 512, p.ws + O_WBRB, 512);
          pg8::EpiMerge<true> E; E.P = (bf16_t*)(p.ws + O_MERGED); E.O8 = (unsigned char*)(p.ws + O_MG8); E.Z = (const bf16_t*)(p.ws + O_Z); E.gcol0 = ZC_MG + 2048; E.scale = pg8::A8W8_INV;
          pg8::gemm_phase_fp8(lds, pg8::Gemm{512, 512, 512}, S, E); }
        } SEAM(PH_MERGE) }
    if (PHON(PH_GOUT) && lo <= PH_GOUT && PH_GOUT < hi) { REP(PH_GOUT) {
        pg8::PlainSched S; S.init(NT, D, G, c, p.ws + O_MG8, D / 2, p.ws + O_WOUT, D / 2);
        pg8::EpiBf16 E; E.O = (bf16_t*)(p.ws + O_MO); E.ldc = D; E.scale = pg8::A8W8_INV;
        pg8::gemm_phase_fp8(lds, pg8::Gemm{D / 2, D / 2, D / 2}, S, E); } SEAM(PH_GOUT) }
    if (PHON(PH_POSTMIX) && lo <= PH_POSTMIX && PH_POSTMIX < hi) { REP(PH_POSTMIX) { phase_post_mix(p, smem, rep_ == 0); } SEAM(PH_POSTMIX) }
    if (PHON(PH_GATHER) && lo <= PH_GATHER && PH_GATHER < hi) { REP(PH_GATHER) { phase_moe_gather(p, smem); } SEAM(PH_GATHER) }
    if (PHON(PH_GU) && lo <= PH_GU && PH_GU < hi) { REP(PH_GU) {
        LAS int* tile_e = (LAS int*)(LAS char*)(smem + 131072); LAS int* pstart = tile_e + 320;
        const int mt = moe_tables(p, tile_e, pstart);
        pg8::MoeSched S; S.G = G; S.c = c; S.nN = 16; S.total = mt * 16; S.tile_e = tile_e; S.A = p.ws + O_HS; S.W = p.ws + O_WGU; S.w_exp = (size_t)4096 * D;
        pg8::EpiGU E; E.O = (unsigned char*)(p.ws + O_ACT); E.bias = p.b_gate_up;
        pg8::gemm_phase_fp8(lds, pg8::Gemm{D / 2, D / 2, D / 2, 64, 16384}, S, E); } SEAM(PH_GU) }
    if (PHON(PH_DN) && lo <= PH_DN && PH_DN < hi) { REP(PH_DN) {
        LAS int* tile_e = (LAS int*)(LAS char*)(smem + 131072); LAS int* pstart = tile_e + 320;
        const int mt = moe_tables(p, tile_e, pstart);
        pg8::MoeSched S; S.G = G; S.c = c; S.nN = 8; S.total = mt * 8; S.tile_e = tile_e; S.A = p.ws + O_ACT; S.W = p.ws + O_WDN; S.w_exp = (size_t)D * D;
        pg8::EpiDN E; E.O = (unsigned char*)(p.ws + O_YS); E.bias = p.b_down; E.slotw = (const float*)(p.ws + O_SLOTW);
        pg8::gemm_phase_fp8(lds, pg8::Gemm{D / 2, D / 2, D / 2, 64, 16384}, S, E); } SEAM(PH_DN) }
    if (PHON(PH_FINAL) && lo <= PH_FINAL && PH_FINAL < hi) { REP(PH_FINAL) { phase_final(p); } }
#undef SEAM
}

extern "C" void kernel_launch(void* const* d_in, const int* in_sizes, int n_in, void* d_out, int out_size, void* d_ws, size_t ws_size, hipStream_t stream) {
    static int grid = 0;
    if (grid == 0) {
        if (n_in != 33 || out_size != NT * D || ws_size < WS_END) { fprintf(stderr, "kernel_launch: unexpected shapes (n_in %d out %d ws %zu need %zu)\n", n_in, out_size, ws_size, (size_t)WS_END); grid = -1; return; }
        int dev = 0, cus = 0;
        if (hipGetDevice(&dev) != hipSuccess || hipDeviceGetAttribute(&cus, hipDeviceAttributeMultiprocessorCount, dev) != hipSuccess) { grid = -1; return; }
        if (hipFuncSetAttribute((const void*)mega, hipFuncAttributeMaxDynamicSharedMemorySize, LDS_BYTES) != hipSuccess) { fprintf(stderr, "kernel_launch: hipFuncSetAttribute failed\n"); grid = -1; return; }
        int per_cu = 0; (void)hipOccupancyMaxActiveBlocksPerMultiprocessor(&per_cu, (const void*)mega, 512, LDS_BYTES); (void)hipGetLastError();
        grid = cus;
    }
    if (grid < 0) return;
    Params p{};
    const float** pf = (const float**)&p;
    for (int i = 0; i < 33; ++i) pf[i] = (const float*)d_in[i];
    p.pos = (const int*)d_in[2];
    p.out = (float*)d_out; p.ws = (char*)d_ws;
    hipMemsetAsync(d_ws, 0, ZERO_BYTES, stream);
#ifdef MK_UNFUSED
    for (int ph = 0; ph < PH_END; ++ph) hipLaunchKernelGGL(mega, dim3(grid), dim3(512), LDS_BYTES, stream, p, ph, ph + 1);
#else
    hipLaunchKernelGGL(mega, dim3(grid), dim3(512), LDS_BYTES, stream, p, 0, (int)PH_END);
#endif
}
```

```cpp
#include <hip/hip_runtime.h>
#include <stdint.h>
#include <stdio.h>

#define LAS __attribute__((address_space(3)))
#define DI __device__ __forceinline__
typedef unsigned short bf16_t;
typedef short bf16x8 __attribute__((ext_vector_type(8)));
typedef float f32x4 __attribute__((ext_vector_type(4)));
typedef unsigned u32x4 __attribute__((ext_vector_type(4)));
typedef unsigned u32x2 __attribute__((ext_vector_type(2)));

#define PREP_PROBE_WC 0
#define PREP_PROBE_MODE 0
#define PREP_REP 0
#define PREP_REP_LO 0
#define PREP_REP_HI 100000
#define PREP_PROBE_NFAST 0
constexpr int NB = 2, T = 8192, NT = NB * T, D = 2048;
constexpr int ZC = 7680;
constexpr int ZC_CKV = 512, ZC_KROPE = 768, ZC_KIDX = 800, ZC_WIDX = 864, ZC_BGATE = 872, ZC_BQ = 1024, ZC_MG = 3584;
constexpr int QC = 2816;
constexpr int KVW = 288;
constexpr int NEXP = 32, SLOTS = 73728, MAXMT = SLOTS / 256;
constexpr float NORM_EPS = 1e-6f;
constexpr float ATT_SCALE = 0.08838834764831845f;
constexpr int LDS_BYTES = 152 * 1024;

constexpr size_t al256(size_t x) { return (x + 255) & ~(size_t)255; }
constexpr size_t ZERO_BYTES = 131072;
constexpr size_t O_MODACC = 16384, O_CNT = 114688;
constexpr size_t O_ROPE = ZERO_BYTES;
constexpr size_t O_WIN = O_ROPE + al256((size_t)NT * 48 * 4);
constexpr size_t O_WQ = O_WIN + al256((size_t)ZC * D * 2);
constexpr size_t O_WO = O_WQ + al256((size_t)QC * 512 * 2);
constexpr size_t O_WBRB = O_WO + al256((size_t)D * D * 2);
constexpr size_t O_WOUT = O_WBRB + al256((size_t)D * 1024 * 2);
constexpr size_t O_WC1 = O_WOUT + al256((size_t)D * D * 2);
constexpr size_t O_CBIAS = O_WC1 + al256((size_t)2 * 256 * 4096 * 2);
constexpr size_t O_CBP = O_CBIAS + al256(2 * 256 * 4);
constexpr size_t O_WRT = O_CBP + al256(64 * 2 * 256 * 4);
constexpr size_t O_WGU = O_WRT + al256((size_t)256 * D * 2);
constexpr size_t O_WDN = O_WGU + al256((size_t)NEXP * 4096 * D * 2);
constexpr size_t O_H = O_WDN + al256((size_t)NEXP * D * D * 2);
constexpr size_t O_Z = O_H + al256((size_t)NT * D * 2);
constexpr size_t O_CQN = O_Z + al256((size_t)NT * ZC * 2);
constexpr size_t O_KVT = O_CQN + al256((size_t)NT * 512 * 2);
constexpr size_t O_KIDX = O_KVT + al256((size_t)NT * KVW * 2);
constexpr size_t O_WIDX = O_KIDX + al256((size_t)NT * 64 * 2);
constexpr size_t O_GATES = O_WIDX + al256((size_t)NT * 8 * 4);
constexpr size_t O_BQ = O_GATES + al256((size_t)NT * 24 * 4);
constexpr size_t KVS_ONE = (size_t)NB * 2 * T * 128;
constexpr size_t O_KVS = O_BQ + al256((size_t)NT * 1024 * 2);
constexpr size_t O_QALL = O_KVS + al256(6 * KVS_ONE * 2 + 65536);
constexpr size_t O_C1P = O_QALL + al256((size_t)NT * QC * 2);
constexpr size_t O_KCVC = O_C1P + al256((size_t)16 * 2 * 2048 * 256 * 4);
constexpr size_t O_SEL = O_KCVC + al256((size_t)2 * 2048 * 128 * 2);
constexpr size_t O_NSEL = O_SEL + al256((size_t)NT * 256 * 2);
constexpr size_t O_OLAT = O_NSEL + al256((size_t)NT * 4);
constexpr size_t O_OB = O_OLAT + al256((size_t)NT * D * 2);
constexpr size_t O_MERGED = O_OB + al256((size_t)NT * 1024 * 2);
constexpr size_t O_MO = O_MERGED + al256((size_t)NT * D * 2);
constexpr size_t O_X1 = O_MO + al256((size_t)NT * D * 2);
constexpr size_t O_TOPI = O_X1 + al256((size_t)NT * D * 4);
constexpr size_t O_TOPW = O_TOPI + al256((size_t)NT * 4 * 4);
constexpr size_t O_TSLOT = O_TOPW + al256((size_t)NT * 4 * 4);
constexpr size_t O_SLOTW = O_TSLOT + al256((size_t)NT * 4 * 4);
constexpr size_t O_HS = O_SLOTW + al256((size_t)SLOTS * 4);
constexpr size_t O_ACT = O_HS + al256((size_t)SLOTS * D);
constexpr size_t O_YS = O_ACT + al256((size_t)SLOTS * D);
constexpr size_t O_OB8 = O_YS + al256((size_t)SLOTS * D * 2);
constexpr size_t O_MG8 = O_OB8 + al256((size_t)NT * 1024);
constexpr size_t O_WIN8 = O_MG8 + al256((size_t)NT * D);
constexpr size_t O_H8 = O_WIN8 + al256((size_t)ZC * D);
constexpr size_t WS_END = O_H8 + al256((size_t)NT * D);

struct Params {
    const float* x; const float* c; const int* pos; const float* w_ada; const float* b_ada;
    const float* g_pre_mix; const float* g_post_mix; const float* g_pre_ffn; const float* g_post_ffn;
    const float* w_in; const float* a_cq_norm; const float* a_ckv_norm; const float* a_w_uq; const float* a_w_uk; const float* a_w_uv;
    const float* idx_w_q; const float* idx_g; const float* idx_b;
    const float* cmp_k_pe; const float* cmp_k_w1; const float* cmp_k_w2; const float* cmp_v_pe; const float* cmp_v_w1; const float* cmp_v_w2;
    const float* w_br_a; const float* w_br_b; const float* w_out; const float* w_router; const float* b_router;
    const float* w_gate_up; const float* b_gate_up; const float* w_down; const float* b_down;
    float* out; char* ws;
};

DI int tid_fresh() { int t = threadIdx.x; asm volatile("" : "+v"(t)); return t; }
DI float bf2f(bf16_t v) { return __uint_as_float((unsigned)v << 16); }
DI float bflo(unsigned w) { return __uint_as_float(w << 16); }
DI float bfhi(unsigned w) { return __uint_as_float(w & 0xffff0000u); }
DI bf16_t f2bf(float f) { unsigned u = __float_as_uint(f); u += 0x7FFFu + ((u >> 16) & 1u); return (bf16_t)(u >> 16); }
DI unsigned pk2(float lo, float hi) { unsigned r; asm volatile("v_cvt_pk_bf16_f32 %0, %1, %2" : "=v"(r) : "v"(lo), "v"(hi)); return r; }
DI float wave_sum(float v) {
#pragma unroll
    for (int o = 1; o < 64; o <<= 1) v += __shfl_xor(v, o);
    return v;
}
DI float wave_max(float v) {
#pragma unroll
    for (int o = 1; o < 64; o <<= 1) v = fmaxf(v, __shfl_xor(v, o));
    return v;
}
DI float sigmoidf_(float v) { return 1.f / (1.f + __expf(-v)); }
DI void unpack8(const u32x4& w, float (&f)[8]) {
    f[0] = bflo(w[0]); f[1] = bfhi(w[0]); f[2] = bflo(w[1]); f[3] = bfhi(w[1]); f[4] = bflo(w[2]); f[5] = bfhi(w[2]); f[6] = bflo(w[3]); f[7] = bfhi(w[3]);
}
DI float mod_at(const Params& p, int b, int j) { return ((const float*)(p.ws + O_MODACC))[b * 12288 + j]; }

#define XB_TMO      128
#define XB_XCNT(j)  (256  + 64 * (j))
#define XB_XSUB(j)  (1280 + 64 * (j))
#define XB_XGEN(j)  (2304 + 64 * (j))
#define XB_TOP      3328
#define XB_TOPGEN   3392
#define XCD_BAR_WORDS 3456
#define XB_SPIN_CAP (1u << 22)
DI unsigned xb_ld(unsigned* p)              { return __hip_atomic_load(p, __ATOMIC_RELAXED, __HIP_MEMORY_SCOPE_AGENT); }
DI unsigned xb_add(unsigned* p, unsigned v) { return __hip_atomic_fetch_add(p, v, __ATOMIC_RELAXED, __HIP_MEMORY_SCOPE_AGENT); }
DI unsigned xb_xcc_id() { return (unsigned)__builtin_amdgcn_s_getreg((3 << 11) | 20) & 0xFu; }
#define XB_SPIN(cond, bar) do { unsigned _sp = 0; while (cond) { __builtin_amdgcn_s_sleep(1); \
    if ((++_sp & 255u) == 0u) { if (xb_ld(&(bar)[XB_TMO])) break; if (_sp > XB_SPIN_CAP) { atomicAdd(&(bar)[XB_TMO], 1u); break; } } } } while (0)
struct XcdBarrier { unsigned* bar; unsigned x; volatile LAS unsigned* st; };
DI XcdBarrier xcd_barrier_post(unsigned* bar, volatile LAS unsigned* st) {
    XcdBarrier b; b.bar = bar; b.x = xb_xcc_id(); b.st = st;
    if (threadIdx.x == 0) (void)xb_add(&bar[XB_XCNT(b.x)], 1u);
    return b;
}
DI void xcd_barrier_complete(unsigned* bar, unsigned x, unsigned& nloc, unsigned& nx) {
    const unsigned G = gridDim.x * gridDim.y * gridDim.z;
    unsigned sum, cnt, mine, sp = 0u;
    for (;;) {
        sum = 0u; cnt = 0u; mine = 0u;
#pragma unroll
        for (unsigned j = 0; j < 16; ++j) { const unsigned c = xb_ld(&bar[XB_XCNT(j)]); sum += c; cnt += (c > 0u) ? 1u : 0u; mine = (j == x) ? c : mine; }
        if (sum == G) break;
        __builtin_amdgcn_s_sleep(1);
        if ((++sp & 255u) == 0u) { if (xb_ld(&bar[XB_TMO])) break; if (sp > XB_SPIN_CAP) { atomicAdd(&bar[XB_TMO], 1u); break; } }
    }
    nloc = mine > 0u ? mine : 1u; nx = cnt > 0u ? cnt : 1u;
}
DI void xcd_barrier(const XcdBarrier& b) {
    asm volatile("s_waitcnt vmcnt(0)" ::: "memory");
    __syncthreads();
    if (threadIdx.x == 0) {
        unsigned* bar = b.bar;
        __builtin_amdgcn_s_waitcnt(0);
        unsigned nloc = b.st[0], nx = b.st[1];
        if (nloc == 0u) { xcd_barrier_complete(bar, b.x, nloc, nx); b.st[0] = nloc; b.st[1] = nx; }
        const unsigned old = xb_add(&bar[XB_XSUB(b.x)], 1u);
        const unsigned gen = old / nloc;
        if (old + 1u == (gen + 1u) * nloc) {
            __builtin_amdgcn_fence(__ATOMIC_RELEASE, "agent");
            asm volatile("s_waitcnt vmcnt(0)" ::: "memory");
            const unsigned og = xb_add(&bar[XB_TOP], 1u);
            const unsigned tg = og / nx;
            if (og + 1u == (tg + 1u) * nx) xb_add(&bar[XB_TOPGEN], 1u);
            else XB_SPIN(xb_ld(&bar[XB_TOPGEN]) == tg, bar);
            __builtin_amdgcn_fence(__ATOMIC_ACQUIRE, "agent");
            xb_add(&bar[XB_XGEN(b.x)], 1u);
            asm volatile("s_waitcnt vmcnt(0)" ::: "memory");
        } else {
            XB_SPIN(xb_ld(&bar[XB_XGEN(b.x)]) == gen, bar);
            __builtin_amdgcn_fence(__ATOMIC_ACQUIRE, "agent");
            asm volatile("s_waitcnt vmcnt(0)" ::: "memory");
        }
    }
    __syncthreads();
}

namespace pg8 {
constexpr int BM = 256, BK = 64, HALF = 128, HTB = HALF * BK * 2, STAGE_BYTES = 8 * HTB, NXCD = 8, WGM = 8;
DI int lds_byte(int r, int c) { const int st = (r >> 4) * 2 + (c >> 5), rr = r & 15, cc = c & 31, ob = rr * 64 + cc * 2; return st * 1024 + (ob ^ (((ob >> 9) & 1) << 5)); }
DI void stage_rc(int b, int& R, int& C) { const int st = b / 1024, sb = b % 1024, swz = sb ^ (((sb >> 9) & 1) << 5); R = (st >> 1) * 16 + swz / 64; C = (st & 1) * 32 + (swz % 64) / 2; }
DI int perm32(int rho) { const int n = rho >> 4, i = rho & 15; return 8 * (i >> 2) + 4 * n + (i & 3); }

struct Unit { int pm, pn, e; const char* a; const char* b; };
struct Gemm { int lda, ldb, K; int brow = ldb; int bk = BK * 2; };

struct PlainSched {
    int nM, nN, nwg, G, c; const char* A; const char* Bt; size_t a_tile, b_tile;
    DI void init(int M, int N, int G_, int c_, const void* A_, int lda, const void* Bt_, int ldb) {
        nM = M / BM; nN = N / BM; nwg = nM * nN; G = G_; c = c_; A = (const char*)A_; Bt = (const char*)Bt_; a_tile = (size_t)BM * lda * 2; b_tile = (size_t)BM * ldb * 2; }
    DI bool next(int i, Unit& u) const {
        const long L = (long)i * G + c; if (L >= nwg) return false;
        int wgid = (int)L; { const int q = nwg / NXCD, r = nwg % NXCD, xcd = wgid % NXCD, off = wgid / NXCD; wgid = (xcd < r ? xcd * (q + 1) : r * (q + 1) + (xcd - r) * q) + off; }
        const int nig = WGM * nN, gid = wgid / nig, fm = gid * WGM, gsz = (nM - fm) < WGM ? (nM - fm) : WGM;
        u.pm = fm + ((wgid % nig) % gsz); u.pn = (wgid % nig) / gsz; u.e = 0;
        u.a = A + (size_t)u.pm * a_tile; u.b = Bt + (size_t)u.pn * b_tile; return true;
    }
};

typedef int v4i_t __attribute__((ext_vector_type(4)));
typedef int v8i_t __attribute__((ext_vector_type(8)));
#ifndef PG8_SP2
#define PG8_SP2 true
#endif
template <class Epi, class Sched, bool SP2 = PG8_SP2>
DI void gemm_phase(LAS unsigned char* lds, const Gemm g, const Sched& S, const Epi& E) {
    const int tid = tid_fresh(), wid = __builtin_amdgcn_readfirstlane(tid >> 6), lane = tid & 63, wr = wid >> 2, wc = wid & 3, fr = lane & 15, fq = lane >> 4;
    const int K = g.K, nt = K / BK;
    unsigned voffA[2], voffB[2];
#pragma unroll
    for (int i = 0; i < 2; ++i) { int R, C; stage_rc(tid * 16 + i * 8192, R, C); const int Rb = Epi::PERM ? ((R & ~31) + perm32(R & 31)) : R;
        voffA[i] = (unsigned)(R * g.lda + C) * 2u; voffB[i] = (unsigned)(Rb * g.ldb + C) * 2u; }
    const size_t kstep = (size_t)(BK * 2);
    const size_t hstepA = (size_t)HALF * g.lda * 2, hstepB = (size_t)HALF * g.ldb * 2;
    const unsigned ldsw = (unsigned)wid * 1024u;
    const int aoff = lds_byte(wr * 64 + fr, fq * 8), boff = lds_byte(wc * 32 + fr, fq * 8);
#define PG8_SA(b, h) (((b) * 2 + (h)) * HTB)
#define PG8_SB(b, h) ((4 + (b) * 2 + (h)) * HTB)
#define PG8_STAGE(bufoff, gbase, voff) do { _Pragma("unroll") for (int _i = 0; _i < 2; ++_i) \
        __builtin_amdgcn_global_load_lds((const unsigned*)((const char*)(gbase) + (voff)[_i]), (LAS unsigned*)(lds + (bufoff) + ldsw + _i * 8192), 16, 0, 0); } while (0)
#define PG8_LDA(dst, b, h) do { _Pragma("unroll") for (int m = 0; m < 4; ++m) _Pragma("unroll") for (int k = 0; k < 2; ++k) dst[m][k] = *(const LAS bf16x8*)(lds + PG8_SA(b, h) + aoff + m * 2048 + k * 1024); } while (0)
#define PG8_LDB(dst, b, h) do { _Pragma("unroll") for (int n = 0; n < 2; ++n) _Pragma("unroll") for (int k = 0; k < 2; ++k) dst[n][k] = *(const LAS bf16x8*)(lds + PG8_SB(b, h) + boff + n * 2048 + k * 1024); } while (0)
#define PG8_MMA(ai, bj, At, Bt) do { __builtin_amdgcn_s_setprio(1); _Pragma("unroll") for (int m = 0; m < 4; ++m) _Pragma("unroll") for (int n = 0; n < 2; ++n) _Pragma("unroll") for (int k = 0; k < 2; ++k) \
        acc[ai][bj][m][n] = __builtin_amdgcn_mfma_f32_16x16x32_bf16(Bt[n][k], At[m][k], acc[ai][bj][m][n], 0, 0, 0); __builtin_amdgcn_s_setprio(0); } while (0)
#define PG8_WAIT_V(n) asm volatile("s_waitcnt vmcnt(" #n ")" ::: "memory")
#define PG8_WAIT_L(n) asm volatile("s_waitcnt lgkmcnt(" #n ")" ::: "memory")
#define PG8_BAR __builtin_amdgcn_s_barrier()
#define PG8_SCHED __builtin_amdgcn_sched_barrier(0)
    Unit cur, nxt; int ui = 0;
    if (!S.next(0, cur)) return;
    f32x4 acc[2][2][4][2];
#pragma unroll
    for (int a = 0; a < 2; ++a)
#pragma unroll
        for (int b = 0; b < 2; ++b)
#pragma unroll
            for (int m = 0; m < 4; ++m)
#pragma unroll
                for (int n = 0; n < 2; ++n) acc[a][b][m][n] = (f32x4){0.f, 0.f, 0.f, 0.f};
    bf16x8 At[4][2], B0[2][2], B1[2][2];
    const char* cA = cur.a; const char* cB = cur.b;
    if constexpr (SP2) {
        PG8_STAGE(PG8_SB(0, 0), cB, voffB); PG8_STAGE(PG8_SB(0, 1), cB + hstepB, voffB); PG8_STAGE(PG8_SA(0, 0), cA, voffA); PG8_STAGE(PG8_SA(0, 1), cA + hstepA, voffA);
        if (wr == 1) PG8_BAR;
        PG8_WAIT_V(2); PG8_BAR;
        PG8_STAGE(PG8_SB(1, 0), cB + kstep, voffB); PG8_STAGE(PG8_SA(1, 0), cA + kstep, voffA); PG8_STAGE(PG8_SB(1, 1), cB + hstepB + kstep, voffB);
        PG8_WAIT_V(6); PG8_BAR;
    } else {
        PG8_STAGE(PG8_SB(0, 0), cB, voffB); PG8_STAGE(PG8_SA(0, 0), cA, voffA); PG8_STAGE(PG8_SB(0, 1), cB + hstepB, voffB); PG8_STAGE(PG8_SA(0, 1), cA + hstepA, voffA);
        if (wr == 1) PG8_BAR;
        PG8_WAIT_V(4); PG8_BAR;
        PG8_STAGE(PG8_SB(1, 0), cB + kstep, voffB); PG8_STAGE(PG8_SA(1, 0), cA + kstep, voffA); PG8_STAGE(PG8_SB(1, 1), cB + hstepB + kstep, voffB);
        PG8_WAIT_V(6); PG8_BAR;
    }
    for (;;) {
        const bool has_next = S.next(ui + 1, nxt);
        const char* nA = has_next ? nxt.a : cA; const char* nB = has_next ? nxt.b : cB;
        for (int t = 0; t < nt; t += 2) {
            const bool last = (t == nt - 2);
            const char* a1 = cA + (size_t)(t + 1) * kstep;
            const char* a2 = last ? nA : cA + (size_t)(t + 2) * kstep; const char* b2 = last ? nB : cB + (size_t)(t + 2) * kstep;
            const char* a3 = a2 + kstep; const char* b3 = b2 + kstep;
            if constexpr (SP2) {
            PG8_LDB(B0, 0, 0); PG8_LDB(B1, 0, 1); PG8_SCHED; PG8_LDA(At, 0, 0); PG8_STAGE(PG8_SA(1, 1), a1 + hstepA, voffA);
            PG8_WAIT_V(8); PG8_WAIT_L(0); PG8_BAR; PG8_MMA(0, 0, At, B0); PG8_MMA(0, 1, At, B1); PG8_BAR; PG8_SCHED;
            PG8_LDA(At, 0, 1); PG8_STAGE(PG8_SB(0, 0), b2, voffB); PG8_STAGE(PG8_SB(0, 1), b2 + hstepB, voffB); PG8_STAGE(PG8_SA(0, 0), a2, voffA);
            PG8_WAIT_V(8); PG8_WAIT_L(0); PG8_BAR; PG8_MMA(1, 0, At, B0); PG8_MMA(1, 1, At, B1); PG8_BAR; PG8_SCHED;
            PG8_LDB(B0, 1, 0); PG8_LDB(B1, 1, 1); PG8_SCHED; PG8_LDA(At, 1, 0); PG8_STAGE(PG8_SA(0, 1), a2 + hstepA, voffA);
            PG8_WAIT_V(8); PG8_WAIT_L(0); PG8_BAR; PG8_MMA(0, 0, At, B0); PG8_MMA(0, 1, At, B1); PG8_BAR; PG8_SCHED;
            PG8_LDA(At, 1, 1); PG8_STAGE(PG8_SB(1, 0), b3, voffB); PG8_STAGE(PG8_SB(1, 1), b3 + hstepB, voffB); PG8_STAGE(PG8_SA(1, 0), a3, voffA);
            PG8_WAIT_V(8); PG8_WAIT_L(0); PG8_BAR; PG8_MMA(1, 0, At, B0); PG8_MMA(1, 1, At, B1); PG8_BAR; PG8_SCHED;
            } else {
            PG8_LDB(B0, 0, 0); PG8_SCHED; PG8_LDA(At, 0, 0); PG8_STAGE(PG8_SA(1, 1), a1 + hstepA, voffA);
            PG8_WAIT_L(8); PG8_BAR; PG8_WAIT_L(0); PG8_MMA(0, 0, At, B0); PG8_BAR; PG8_SCHED;
            PG8_LDB(B1, 0, 1); PG8_STAGE(PG8_SB(0, 0), b2, voffB);
            PG8_BAR; PG8_WAIT_L(0); PG8_MMA(0, 1, At, B1); PG8_BAR;
            PG8_LDA(At, 0, 1); PG8_STAGE(PG8_SA(0, 0), a2, voffA);
            PG8_BAR; PG8_WAIT_L(0); PG8_MMA(1, 0, At, B0); PG8_BAR; PG8_SCHED;
            PG8_STAGE(PG8_SB(0, 1), b2 + hstepB, voffB);
            PG8_WAIT_V(6); PG8_BAR; PG8_MMA(1, 1, At, B1); PG8_BAR;
            PG8_LDB(B0, 1, 0); PG8_SCHED; PG8_LDA(At, 1, 0); PG8_STAGE(PG8_SA(0, 1), a2 + hstepA, voffA);
            PG8_WAIT_L(8); PG8_BAR; PG8_WAIT_L(0); PG8_MMA(0, 0, At, B0); PG8_BAR; PG8_SCHED;
            PG8_LDB(B1, 1, 1); PG8_STAGE(PG8_SB(1, 0), b3, voffB);
            PG8_BAR; PG8_WAIT_L(0); PG8_MMA(0, 1, At, B1); PG8_BAR;
            PG8_LDA(At, 1, 1); PG8_STAGE(PG8_SA(1, 0), a3, voffA);
            PG8_BAR; PG8_WAIT_L(0); PG8_MMA(1, 0, At, B0); PG8_BAR; PG8_SCHED;
            PG8_STAGE(PG8_SB(1, 1), b3 + hstepB, voffB);
            PG8_WAIT_V(6); PG8_BAR; PG8_MMA(1, 1, At, B1); PG8_BAR;
            }
        }
        E(acc, cur, wr, wc, fr, fq);
        if (!has_next) break;
#pragma unroll
        for (int a = 0; a < 2; ++a)
#pragma unroll
            for (int b = 0; b < 2; ++b)
#pragma unroll
                for (int m = 0; m < 4; ++m)
#pragma unroll
                    for (int n = 0; n < 2; ++n) acc[a][b][m][n] = (f32x4){0.f, 0.f, 0.f, 0.f};
        cur = nxt; cA = nA; cB = nB; ++ui;
    }
    PG8_WAIT_V(0);
    if (wr == 0) PG8_BAR;
    PG8_BAR;
#undef PG8_SA
#undef PG8_SB
#undef PG8_STAGE
#undef PG8_LDA
#undef PG8_LDB
#undef PG8_MMA
#undef PG8_WAIT_V
#undef PG8_WAIT_L
#undef PG8_BAR
#undef PG8_SCHED
}

template <class Epi, class Sched, bool SP2 = PG8_SP2>
DI void gemm_phase_fp8(LAS unsigned char* lds, const Gemm g, const Sched& S, const Epi& E) {
    const int tid = tid_fresh(), wid = __builtin_amdgcn_readfirstlane(tid >> 6), lane = tid & 63, wr = wid >> 2, wc = wid & 3, fr = lane & 15, fq = lane >> 4;
    const int K = g.K, nt = K / BK;
    unsigned voffA[2], voffB[2];
#pragma unroll
    for (int i = 0; i < 2; ++i) { int R, C; stage_rc(tid * 16 + i * 8192, R, C); const int Rb = Epi::PERM ? ((R & ~31) + perm32(R & 31)) : R;
        voffA[i] = (unsigned)(R * g.lda + C) * 2u; voffB[i] = (unsigned)(Rb * g.brow + C) * 2u; }
    const size_t kstep = (size_t)(BK * 2), kstepB = (size_t)g.bk;
    const size_t hstepA = (size_t)HALF * g.lda * 2, hstepB = (size_t)HALF * g.ldb * 2;
    const unsigned ldsw = (unsigned)wid * 1024u;
    const int aoff = lds_byte(wr * 64 + fr, fq * 8), boff = lds_byte(wc * 32 + fr, fq * 8);
#define PG8_SA(b, h) (((b) * 2 + (h)) * HTB)
#define PG8_SB(b, h) ((4 + (b) * 2 + (h)) * HTB)
#define PG8_STAGE(bufoff, gbase, voff) do { _Pragma("unroll") for (int _i = 0; _i < 2; ++_i) \
        __builtin_amdgcn_global_load_lds((const unsigned*)((const char*)(gbase) + (voff)[_i]), (LAS unsigned*)(lds + (bufoff) + ldsw + _i * 8192), 16, 0, 0); } while (0)
#define PG8_LDA(dst, b, h) do { _Pragma("unroll") for (int m = 0; m < 4; ++m) { const v4i_t lo_ = *(const LAS v4i_t*)(lds + PG8_SA(b, h) + aoff + m * 2048), hi_ = *(const LAS v4i_t*)(lds + PG8_SA(b, h) + aoff + m * 2048 + 1024); dst[m] = __builtin_shufflevector(lo_, hi_, 0, 1, 2, 3, 4, 5, 6, 7); } } while (0)
#define PG8_LDB(dst, b, h) do { _Pragma("unroll") for (int n = 0; n < 2; ++n) { const v4i_t lo_ = *(const LAS v4i_t*)(lds + PG8_SB(b, h) + boff + n * 2048), hi_ = *(const LAS v4i_t*)(lds + PG8_SB(b, h) + boff + n * 2048 + 1024); dst[n] = __builtin_shufflevector(lo_, hi_, 0, 1, 2, 3, 4, 5, 6, 7); } } while (0)
#define PG8_MMA(ai, bj, At, Bt) do { __builtin_amdgcn_s_setprio(1); _Pragma("unroll") for (int m = 0; m < 4; ++m) _Pragma("unroll") for (int n = 0; n < 2; ++n) \
        asm volatile("v_mfma_scale_f32_16x16x128_f8f6f4 %0, %1, %2, %0, %3, %3 op_sel_hi:[0,0,0]" : "+v"(acc[ai][bj][m][n]) : "v"(Bt[n]), "v"(At[m]), "v"(sc127)); __builtin_amdgcn_s_setprio(0); } while (0)
#define PG8_WAIT_V(n) asm volatile("s_waitcnt vmcnt(" #n ")" ::: "memory")
#define PG8_WAIT_L(n) asm volatile("s_waitcnt lgkmcnt(" #n ")" ::: "memory")
#define PG8_BAR __builtin_amdgcn_s_barrier()
#define PG8_SCHED __builtin_amdgcn_sched_barrier(0)
    Unit cur, nxt; int ui = 0;
    if (!S.next(0, cur)) return;
    f32x4 acc[2][2][4][2];
#pragma unroll
    for (int a = 0; a < 2; ++a)
#pragma unroll
        for (int b = 0; b < 2; ++b)
#pragma unroll
            for (int m = 0; m < 4; ++m)
#pragma unroll
                for (int n = 0; n < 2; ++n) acc[a][b][m][n] = (f32x4){0.f, 0.f, 0.f, 0.f};
    v8i_t At[4], B0[2], B1[2];
    int sc127 = 127; asm volatile("" : "+v"(sc127));
    const char* cA = cur.a; const char* cB = cur.b;
    if constexpr (SP2) {
        PG8_STAGE(PG8_SB(0, 0), cB, voffB); PG8_STAGE(PG8_SB(0, 1), cB + hstepB, voffB); PG8_STAGE(PG8_SA(0, 0), cA, voffA); PG8_STAGE(PG8_SA(0, 1), cA + hstepA, voffA);
        if (wr == 1) PG8_BAR;
        PG8_WAIT_V(2); PG8_BAR;
        PG8_STAGE(PG8_SB(1, 0), cB + kstepB, voffB); PG8_STAGE(PG8_SA(1, 0), cA + kstep, voffA); PG8_STAGE(PG8_SB(1, 1), cB + hstepB + kstepB, voffB);
        PG8_WAIT_V(6); PG8_BAR;
    } else {
        PG8_STAGE(PG8_SB(0, 0), cB, voffB); PG8_STAGE(PG8_SA(0, 0), cA, voffA); PG8_STAGE(PG8_SB(0, 1), cB + hstepB, voffB); PG8_STAGE(PG8_SA(0, 1), cA + hstepA, voffA);
        if (wr == 1) PG8_BAR;
        PG8_WAIT_V(4); PG8_BAR;
        PG8_STAGE(PG8_SB(1, 0), cB + kstepB, voffB); PG8_STAGE(PG8_SA(1, 0), cA + kstep, voffA); PG8_STAGE(PG8_SB(1, 1), cB + hstepB + kstepB, voffB);
        PG8_WAIT_V(6); PG8_BAR;
    }
    for (;;) {
        const bool has_next = S.next(ui + 1, nxt);
        const char* nA = has_next ? nxt.a : cA; const char* nB = has_next ? nxt.b : cB;
        for (int t = 0; t < nt; t += 2) {
            const bool last = (t == nt - 2);
            const char* a1 = cA + (size_t)(t + 1) * kstep;
            const char* a2 = last ? nA : cA + (size_t)(t + 2) * kstep; const char* b2 = last ? nB : cB + (size_t)(t + 2) * kstepB;
            const char* a3 = a2 + kstep; const char* b3 = b2 + kstepB;
            if constexpr (SP2) {
            PG8_LDB(B0, 0, 0); PG8_LDB(B1, 0, 1); PG8_SCHED; PG8_LDA(At, 0, 0); PG8_STAGE(PG8_SA(1, 1), a1 + hstepA, voffA);
            PG8_WAIT_V(8); PG8_WAIT_L(0); PG8_BAR; PG8_MMA(0, 0, At, B0); PG8_MMA(0, 1, At, B1); PG8_BAR; PG8_SCHED;
            PG8_LDA(At, 0, 1); PG8_STAGE(PG8_SB(0, 0), b2, voffB); PG8_STAGE(PG8_SB(0, 1), b2 + hstepB, voffB); PG8_STAGE(PG8_SA(0, 0), a2, voffA);
            PG8_WAIT_V(8); PG8_WAIT_L(0); PG8_BAR; PG8_MMA(1, 0, At, B0); PG8_MMA(1, 1, At, B1); PG8_BAR; PG8_SCHED;
            PG8_LDB(B0, 1, 0); PG8_LDB(B1, 1, 1); PG8_SCHED; PG8_LDA(At, 1, 0); PG8_STAGE(PG8_SA(0, 1), a2 + hstepA, voffA);
            PG8_WAIT_V(8); PG8_WAIT_L(0); PG8_BAR; PG8_MMA(0, 0, At, B0); PG8_MMA(0, 1, At, B1); PG8_BAR; PG8_SCHED;
            PG8_LDA(At, 1, 1); PG8_STAGE(PG8_SB(1, 0), b3, voffB); PG8_STAGE(PG8_SB(1, 1), b3 + hstepB, voffB); PG8_STAGE(PG8_SA(1, 0), a3, voffA);
            PG8_WAIT_V(8); PG8_WAIT_L(0); PG8_BAR; PG8_MMA(1, 0, At, B0); PG8_MMA(1, 1, At, B1); PG8_BAR; PG8_SCHED;
            } else {
            PG8_LDB(B0, 0, 0); PG8_SCHED; PG8_LDA(At, 0, 0); PG8_STAGE(PG8_SA(1, 1), a1 + hstepA, voffA);
            PG8_WAIT_L(8); PG8_BAR; PG8_WAIT_L(0); PG8_MMA(0, 0, At, B0); PG8_BAR; PG8_SCHED;
            PG8_LDB(B1, 0, 1); PG8_STAGE(PG8_SB(0, 0), b2, voffB);
            PG8_BAR; PG8_WAIT_L(0); PG8_MMA(0, 1, At, B1); PG8_BAR;
            PG8_LDA(At, 0, 1); PG8_STAGE(PG8_SA(0, 0), a2, voffA);
            PG8_BAR; PG8_WAIT_L(0); PG8_MMA(1, 0, At, B0); PG8_BAR; PG8_SCHED;
            PG8_STAGE(PG8_SB(0, 1), b2 + hstepB, voffB);
            PG8_WAIT_V(6); PG8_BAR; PG8_MMA(1, 1, At, B1); PG8_BAR;
            PG8_LDB(B0, 1, 0); PG8_SCHED; PG8_LDA(At, 1, 0); PG8_STAGE(PG8_SA(0, 1), a2 + hstepA, voffA);
            PG8_WAIT_L(8); PG8_BAR; PG8_WAIT_L(0); PG8_MMA(0, 0, At, B0); PG8_BAR; PG8_SCHED;
            PG8_LDB(B1, 1, 1); PG8_STAGE(PG8_SB(1, 0), b3, voffB);
            PG8_BAR; PG8_WAIT_L(0); PG8_MMA(0, 1, At, B1); PG8_BAR;
            PG8_LDA(At, 1, 1); PG8_STAGE(PG8_SA(1, 0), a3, voffA);
            PG8_BAR; PG8_WAIT_L(0); PG8_MMA(1, 0, At, B0); PG8_BAR; PG8_SCHED;
            PG8_STAGE(PG8_SB(1, 1), b3 + hstepB, voffB);
            PG8_WAIT_V(6); PG8_BAR; PG8_MMA(1, 1, At, B1); PG8_BAR;
            }
        }
        asm volatile("s_nop 15\n\ts_nop 15" ::: "memory");
        E(acc, cur, wr, wc, fr, fq);
        if (!has_next) break;
#pragma unroll
        for (int a = 0; a < 2; ++a)
#pragma unroll
            for (int b = 0; b < 2; ++b)
#pragma unroll
                for (int m = 0; m < 4; ++m)
#pragma unroll
                    for (int n = 0; n < 2; ++n) acc[a][b][m][n] = (f32x4){0.f, 0.f, 0.f, 0.f};
        cur = nxt; cA = nA; cB = nB; ++ui;
    }
    PG8_WAIT_V(0);
    if (wr == 0) PG8_BAR;
    PG8_BAR;
#undef PG8_SA
#undef PG8_SB
#undef PG8_STAGE
#undef PG8_LDA
#undef PG8_LDB
#undef PG8_MMA
#undef PG8_WAIT_V
#undef PG8_WAIT_L
#undef PG8_BAR
#undef PG8_SCHED
}

typedef f32x4 Acc[2][2][4][2];
struct EpiBf16 {
    static constexpr bool PERM = true; bf16_t* O; int ldc; float scale;
    DI void operator()(const Acc& acc, const Unit& u, int wr, int wc, int fr, int fq) const {
        const int row0 = u.pm * BM + wr * 64 + fr, col0 = u.pn * BM + wc * 32 + 8 * fq;
#pragma unroll
        for (int ai = 0; ai < 2; ++ai)
#pragma unroll
            for (int m = 0; m < 4; ++m) { bf16_t* rowp = O + (size_t)(row0 + ai * HALF + m * 16) * ldc + col0;
#pragma unroll
                for (int bj = 0; bj < 2; ++bj) { const f32x4 v0 = acc[ai][bj][m][0] * scale, v1 = acc[ai][bj][m][1] * scale;
                    *(u32x4*)(rowp + bj * HALF) = (u32x4){pk2(v0[0], v0[1]), pk2(v0[2], v0[3]), pk2(v1[0], v1[1]), pk2(v1[2], v1[3])}; } }
    }
};
struct EpiC1 {
    static constexpr bool PERM = false; float* C;
    DI void operator()(const Acc& acc, const Unit& u, int wr, int wc, int fr, int fq) const {
        const int row0 = u.pm * BM + wr * 64 + fr, col0 = wc * 32 + 4 * fq;
        float* base = C + (size_t)u.e * 2048 * 256;
#pragma unroll
        for (int ai = 0; ai < 2; ++ai)
#pragma unroll
            for (int m = 0; m < 4; ++m) { float* rowp = base + (size_t)(row0 + ai * HALF + m * 16) * 256 + col0;
#pragma unroll
                for (int bj = 0; bj < 2; ++bj)
#pragma unroll
                    for (int n = 0; n < 2; ++n) *(f32x4*)(rowp + bj * HALF + n * 16) = acc[ai][bj][m][n]; }
    }
};
DI float clamp8(float v) { return __builtin_amdgcn_fmed3f(v, -448.f, 448.f); }
DI unsigned fp8x4(float a, float b, float c, float d) { int w = 0; w = __builtin_amdgcn_cvt_pk_fp8_f32(clamp8(a), clamp8(b), w, false); w = __builtin_amdgcn_cvt_pk_fp8_f32(clamp8(c), clamp8(d), w, true); return (unsigned)w; }
constexpr float W8_SCALE = 256.f, W8_INV = 1.f / 256.f, A8_SCALE = 16.f, A8W8_INV = 1.f / 4096.f, Y8_SCALE = 32.f, Y8_INV = 1.f / 32.f;
template <bool ADD> struct EpiMerge {
    static constexpr bool PERM = true; bf16_t* P; unsigned char* O8; const bf16_t* Z; int gcol0; float scale;
    DI void operator()(const Acc& acc, const Unit& u, int wr, int wc, int fr, int fq) const {
        const int row0 = u.pm * BM + wr * 64 + fr, col0 = u.pn * BM + wc * 32 + 8 * fq;
#pragma unroll
        for (int ai = 0; ai < 2; ++ai) {
            u32x4 gz[4][2], pz[4][2];
#pragma unroll
            for (int m = 0; m < 4; ++m) { const size_t row = (size_t)(row0 + ai * HALF + m * 16);
#pragma unroll
                for (int bj = 0; bj < 2; ++bj) { const int col = col0 + bj * HALF; gz[m][bj] = *(const u32x4*)(Z + row * ZC + gcol0 + col); if (ADD) pz[m][bj] = *(const u32x4*)(P + row * D + col); } }
#pragma unroll
            for (int m = 0; m < 4; ++m) { const size_t row = (size_t)(row0 + ai * HALF + m * 16);
#pragma unroll
                for (int bj = 0; bj < 2; ++bj) { const int col = col0 + bj * HALF;
                    float g[8], o[8]; unpack8(gz[m][bj], g);
                    const f32x4 v0 = acc[ai][bj][m][0] * scale, v1 = acc[ai][bj][m][1] * scale;
                    if (ADD) unpack8(pz[m][bj], o);
#pragma unroll
                    for (int j = 0; j < 8; ++j) { const float a = j < 4 ? v0[j & 3] : v1[j & 3]; o[j] = (ADD ? o[j] : 0.f) + sigmoidf_(g[j]) * a; }
                    if (ADD) *(u32x2*)(O8 + row * D + col) = (u32x2){fp8x4(o[0] * A8_SCALE, o[1] * A8_SCALE, o[2] * A8_SCALE, o[3] * A8_SCALE), fp8x4(o[4] * A8_SCALE, o[5] * A8_SCALE, o[6] * A8_SCALE, o[7] * A8_SCALE)};
                    else *(u32x4*)(P + row * D + col) = (u32x4){pk2(o[0], o[1]), pk2(o[2], o[3]), pk2(o[4], o[5]), pk2(o[6], o[7])}; } }
        }
    }
};
struct EpiGU {
    static constexpr bool PERM = true; unsigned char* O; const float* bias;
    DI void operator()(const Acc& acc, const Unit& u, int wr, int wc, int fr, int fq) const {
        const int row0 = u.pm * BM + wr * 64 + fr, c0 = u.pn * HALF + wc * 32 + 8 * fq;
        const float* bg = bias + (size_t)u.e * 4096 + c0; const float* bu = bg + 2048;
        float bgv[8], buv[8];
#pragma unroll
        for (int j = 0; j < 8; ++j) { bgv[j] = bg[j]; buv[j] = bu[j]; }
#pragma unroll
        for (int ai = 0; ai < 2; ++ai)
#pragma unroll
            for (int m = 0; m < 4; ++m) { unsigned char* rowp = O + (size_t)(row0 + ai * HALF + m * 16) * D + c0;
                float o[8];
#pragma unroll
                for (int j = 0; j < 8; ++j) { float gt = (j < 4 ? acc[ai][0][m][0][j & 3] : acc[ai][0][m][1][j & 3]) * W8_INV + bgv[j];
                    float up = (j < 4 ? acc[ai][1][m][0][j & 3] : acc[ai][1][m][1][j & 3]) * W8_INV + buv[j];
                    gt = fminf(gt, 7.f); up = fminf(fmaxf(up, -7.f), 7.f);
                    o[j] = gt * sigmoidf_(1.702f * gt) * (up + 1.f); }
                *(u32x2*)rowp = (u32x2){fp8x4(o[0], o[1], o[2], o[3]), fp8x4(o[4], o[5], o[6], o[7])}; }
    }
};
struct EpiDN {
    static constexpr bool PERM = true; unsigned char* O; const float* bias; const float* slotw;
    DI void operator()(const Acc& acc, const Unit& u, int wr, int wc, int fr, int fq) const {
        const int row0 = u.pm * BM + wr * 64 + fr, col0 = u.pn * BM + wc * 32 + 8 * fq;
        float bv[2][8];
#pragma unroll
        for (int bj = 0; bj < 2; ++bj)
#pragma unroll
            for (int j = 0; j < 8; ++j) bv[bj][j] = bias[(size_t)u.e * D + col0 + bj * HALF + j];
        float sw[2][4];
#pragma unroll
        for (int ai = 0; ai < 2; ++ai)
#pragma unroll
            for (int m = 0; m < 4; ++m) sw[ai][m] = slotw[row0 + ai * HALF + m * 16];
#pragma unroll
        for (int ai = 0; ai < 2; ++ai)
#pragma unroll
            for (int m = 0; m < 4; ++m) { const int row = row0 + ai * HALF + m * 16; const float w = sw[ai][m] * Y8_SCALE; unsigned char* rowp = O + (size_t)row * D + col0;
#pragma unroll
                for (int bj = 0; bj < 2; ++bj) { float o[8];
#pragma unroll
                    for (int j = 0; j < 8; ++j) o[j] = ((j < 4 ? acc[ai][bj][m][0][j & 3] : acc[ai][bj][m][1][j & 3]) * W8_INV + bv[bj][j]) * w;
                    *(u32x2*)(rowp + bj * HALF) = (u32x2){fp8x4(o[0], o[1], o[2], o[3]), fp8x4(o[4], o[5], o[6], o[7])}; } }
    }
};
struct C1Sched {
    int G, c; const char* kvs; const char* w;
    DI bool next(int i, Unit& u) const {
        const int L = i * G + c; if (L >= 256) return false;
        const int kv = L >> 7, s = (L >> 3) & 15, pm = L & 7;
        u.pm = pm; u.pn = 0; u.e = s * 2 + kv;
        u.a = kvs + ((size_t)kv * KVS_ONE + (size_t)pm * 256 * 2048 + (size_t)s * 256) * 2;
        u.b = w + ((size_t)kv * 256 * 4096 + (size_t)s * 256) * 2; return true;
    }
};
struct MoeSched {
    int G, c, nN, total; const LAS int* tile_e; const char* A; const char* W; size_t w_exp;
    DI bool next(int i, Unit& u) const {
        const int L = i * G + c; if (L >= total) return false;
        const int mt = L / nN, pn = L - mt * nN; const int e = __builtin_amdgcn_readfirstlane(tile_e[mt]);
        u.pm = mt; u.pn = pn; u.e = e;
        u.a = A + (size_t)mt * 256 * D; u.b = W + (size_t)e * w_exp + (size_t)pn * 256 * D; return true;
    }
};
}

DI int colmap(int kind, int n) {
    if (kind == 0) return n;
    if (kind == 1) {
        if (n < 872) return n;
        if (n < 896) return 3432 + (n - 872);
        if (n < 1024) return -1;
        if (n < 2048) return 872 + (n - 1024);
        if (n < 3584) return 1896 + (n - 2048);
        return 3456 + (n - 3584);
    }
    if (kind == 2) { const int pn = n >> 8, r = n & 255; return r < 128 ? pn * 128 + r : 2048 + pn * 128 + (r - 128); }
    if (kind == 4) return n < 32 ? n : -1;
    { const int h = n >> 5, d = n & 31; return h * 128 + d; }
}
struct TrJob { const float* src; bf16_t* dst; int ldsrc, lddst, kind, k0, n0, dk0, dn0; };
DI void tr_load(const TrJob& j, f32x4 (&v)[8], int t) {
    const int c4 = t & 63, r0 = t >> 6; const int sc = colmap(j.kind, j.n0 + 4 * c4);
#pragma unroll
    for (int q = 0; q < 8; ++q) v[q] = (f32x4){0.f, 0.f, 0.f, 0.f};
    if (sc >= 0) {
#pragma unroll
        for (int q = 0; q < 8; ++q) v[q] = __builtin_nontemporal_load((const f32x4*)(j.src + (size_t)(j.k0 + r0 + 8 * q) * j.ldsrc + sc));
    }
}
DI void tr_lds_write(const f32x4 (&v)[8], float* tile, int t) {
    const int c4 = t & 63, r0 = t >> 6;
#pragma unroll
    for (int q = 0; q < 8; ++q) { float* tp = tile + (r0 + 8 * q) * 257 + 4 * c4; tp[0] = v[q][0]; tp[1] = v[q][1]; tp[2] = v[q][2]; tp[3] = v[q][3]; }
}
DI void tr_store(const TrJob& j, const float* tile, int t) {
    const int kk8 = (t & 7) * 8, nb = t >> 3;
#pragma unroll
    for (int ps = 0; ps < 4; ++ps) { const int nn = nb + 64 * ps; const float* s = tile + kk8 * 257 + nn;
        u32x4 o = {pk2(s[0], s[257]), pk2(s[2 * 257], s[3 * 257]), pk2(s[4 * 257], s[5 * 257]), pk2(s[6 * 257], s[7 * 257])};
        *(u32x4*)(j.dst + (size_t)(j.n0 + nn) * j.lddst + j.k0 + kk8) = o; }
}
DI void tr_setup(TrJob& j, int u, int nK, const float* src, int ldsrc, int kind, bf16_t* dst, int lddst) {
    const int kt = u % nK, ntile = u / nK; j.src = src; j.dst = dst; j.ldsrc = ldsrc; j.lddst = lddst; j.kind = kind; j.k0 = kt * 64; j.n0 = ntile * 256;
}
DI float tr8_load(const TrJob& j, f32x4 (&v)[8], int t) {
    const int c4 = t & 31, r0 = t >> 5; const int sc = colmap(j.kind, j.n0 + 4 * c4); const int scc = sc < 0 ? 0 : sc;
#pragma unroll
    for (int q = 0; q < 8; ++q) v[q] = __builtin_nontemporal_load((const f32x4*)(j.src + (size_t)(j.k0 + r0 + 16 * q) * j.ldsrc + scc));
    return sc < 0 ? 0.f : 1.f;
}
DI void tr8_lds_write(const f32x4 (&v)[8], float ok, float* tile, int t) {
    const int c4 = t & 31, r0 = t >> 5;
#pragma unroll
    for (int q = 0; q < 8; ++q) { float* tp = tile + (r0 + 16 * q) * 129 + 4 * c4; tp[0] = v[q][0] * ok; tp[1] = v[q][1] * ok; tp[2] = v[q][2] * ok; tp[3] = v[q][3] * ok; }
}
DI void tr8_store(const TrJob& j, const float* tile, int t) {
    const int kc = t & 7, nb = t >> 3; constexpr float SC = pg8::W8_SCALE;
#pragma unroll
    for (int ps = 0; ps < 2; ++ps) { const int nn = nb + 64 * ps; const float* s = tile + (16 * kc) * 129 + nn;
        u32x4 o = {pg8::fp8x4(s[0] * SC, s[129] * SC, s[2 * 129] * SC, s[3 * 129] * SC), pg8::fp8x4(s[4 * 129] * SC, s[5 * 129] * SC, s[6 * 129] * SC, s[7 * 129] * SC),
                   pg8::fp8x4(s[8 * 129] * SC, s[9 * 129] * SC, s[10 * 129] * SC, s[11 * 129] * SC), pg8::fp8x4(s[12 * 129] * SC, s[13 * 129] * SC, s[14 * 129] * SC, s[15 * 129] * SC)};
        __builtin_nontemporal_store(o, (u32x4*)((unsigned char*)j.dst + (size_t)(j.dn0 + nn) * j.lddst + j.dk0 + 16 * kc)); }
}
DI void phase_prep(const Params& p, char* smem) {
    float* tile = (float*)smem;
    const int t = tid_fresh(), G = gridDim.x;
    constexpr int U_ADA = 256, U_ABS = 256, U_WO = 512, U_CB = 128, SPECIAL = U_ADA + U_ABS + U_WO + U_CB;
    constexpr int U_WINB = 32 * 8, U_WIN = 16 * 44, U_IDXQ = 8 * 2, U_UQR = 8, U_BRB = 16 * 8, U_OUT = 32 * 8, U_C1 = 64, U_RT = 32, U_GU = 32 * 16, U_DN = 32 * 8;
    constexpr int NTR = U_WINB + U_IDXQ + U_UQR + 2 * U_C1 + U_RT, NTR8 = U_WIN + U_BRB + U_OUT + NEXP * (U_GU + U_DN);
    bf16_t* Wq = (bf16_t*)(p.ws + O_WQ);
    for (int rp_ = 0; rp_ < ((PREP_REP & 1) ? 2 : 1); ++rp_)
    for (int u0 = blockIdx.x; u0 < SPECIAL; u0 += G) {
        int u = u0;
        if (rp_ == 1 && (u0 < PREP_REP_LO || u0 >= PREP_REP_HI)) continue;
        if (u < U_ADA) {
            const int c4 = t % 12, kg = t / 12; f32x4 a0 = {0.f, 0.f, 0.f, 0.f}, a1 = {0.f, 0.f, 0.f, 0.f};
            if (kg < 42) { const int col = u * 48 + c4 * 4;
#pragma unroll 7
                for (int k = kg; k < 2048; k += 42) { const float c0 = p.c[k], c1 = p.c[2048 + k]; const float s0 = c0 * sigmoidf_(c0), s1 = c1 * sigmoidf_(c1);
                    const f32x4 w = *(const f32x4*)(p.w_ada + (size_t)k * 12288 + col); a0 += w * s0; a1 += w * s1; } }
            __syncthreads();
            if (kg < 42) { float* tp = tile + (kg * 12 + c4) * 8;
#pragma unroll
                for (int j = 0; j < 4; ++j) { tp[j] = a0[j]; tp[4 + j] = a1[j]; } }
            __syncthreads();
            if (t < 96) { const int bb = t / 48, cc = t % 48; float acc = 0.f;
                for (int g2 = 0; g2 < 42; ++g2) acc += tile[(g2 * 12 + (cc >> 2)) * 8 + bb * 4 + (cc & 3)];
                ((float*)(p.ws + O_MODACC))[bb * 12288 + u * 48 + cc] = acc + p.b_ada[u * 48 + cc]; }
            continue; }
        u -= U_ADA;
        if (u < U_ABS) {
            const int h = u >> 5, w = __builtin_amdgcn_readfirstlane(t >> 6), l = t & 63, c = (u & 31) * 8 + w;
            const float* ukp = p.a_w_uk + (size_t)c * 768 + h * 96;
            float acc[8];
#pragma unroll
            for (int j = 0; j < 8; ++j) acc[j] = 0.f;
#pragma unroll 1
            for (int ch = 0; ch < 3; ++ch) {
                __syncthreads();
#pragma unroll
                for (int q = 0; q < 8; ++q) { const int r = (t >> 3) + 64 * q;
                    *(f32x4*)(tile + r * 36 + 4 * (t & 7)) = *(const f32x4*)(p.a_w_uq + (size_t)r * 1024 + h * 128 + 32 + ch * 32 + 4 * (t & 7)); }
                __syncthreads();
#pragma unroll 2
                for (int n4 = 0; n4 < 8; ++n4) { const float k0 = ukp[ch * 32 + 4 * n4], k1 = ukp[ch * 32 + 4 * n4 + 1], k2 = ukp[ch * 32 + 4 * n4 + 2], k3 = ukp[ch * 32 + 4 * n4 + 3];
#pragma unroll
                    for (int j = 0; j < 8; ++j) { const f32x4 x = *(const f32x4*)(tile + (l + 64 * j) * 36 + 4 * n4);
                        acc[j] = __builtin_fmaf(x[0], k0, acc[j]); acc[j] = __builtin_fmaf(x[1], k1, acc[j]); acc[j] = __builtin_fmaf(x[2], k2, acc[j]); acc[j] = __builtin_fmaf(x[3], k3, acc[j]); } }
            }
#pragma unroll
            for (int j = 0; j < 8; ++j) Wq[(size_t)(h * 256 + c) * 512 + l + 64 * j] = f2bf(acc[j]);
            continue; }
        u -= U_ABS;
        if (u < U_WO) {
            const int n = (u & 3) * 512 + t, k0 = (u >> 2) * 16, h = k0 >> 8;
            __syncthreads();
            *(f32x4*)(tile + 4 * t) = *(const f32x4*)(p.a_w_uv + (size_t)k0 * 128 + 4 * t);
            __syncthreads();
            const float* wbp = p.w_br_a + (size_t)(h * 128) * D + n;
            float acc[16];
#pragma unroll
            for (int j = 0; j < 16; ++j) acc[j] = 0.f;
#pragma unroll 2
            for (int v0 = 0; v0 < 128; v0 += 8) { float wb[8];
#pragma unroll
                for (int i = 0; i < 8; ++i) wb[i] = wbp[(size_t)(v0 + i) * D];
#pragma unroll
                for (int j = 0; j < 16; ++j) { const f32x4 a = *(const f32x4*)(tile + j * 128 + v0), b = *(const f32x4*)(tile + j * 128 + v0 + 4);
                    acc[j] = __builtin_fmaf(a[0], wb[0], acc[j]); acc[j] = __builtin_fmaf(a[1], wb[1], acc[j]); acc[j] = __builtin_fmaf(a[2], wb[2], acc[j]); acc[j] = __builtin_fmaf(a[3], wb[3], acc[j]);
                    acc[j] = __builtin_fmaf(b[0], wb[4], acc[j]); acc[j] = __builtin_fmaf(b[1], wb[5], acc[j]); acc[j] = __builtin_fmaf(b[2], wb[6], acc[j]); acc[j] = __builtin_fmaf(b[3], wb[7], acc[j]); } }
            constexpr float SW = pg8::W8_SCALE;
            *(u32x4*)((unsigned char*)(p.ws + O_WO) + (size_t)n * D + k0) = (u32x4){pg8::fp8x4(acc[0] * SW, acc[1] * SW, acc[2] * SW, acc[3] * SW), pg8::fp8x4(acc[4] * SW, acc[5] * SW, acc[6] * SW, acc[7] * SW),
                pg8::fp8x4(acc[8] * SW, acc[9] * SW, acc[10] * SW, acc[11] * SW), pg8::fp8x4(acc[12] * SW, acc[13] * SW, acc[14] * SW, acc[15] * SW)};
            continue; }
        u -= U_WO;
        {
            const int kv = u >> 6, seg = u & 63;
            if (t < 256) { const float* pe = kv ? p.cmp_v_pe : p.cmp_k_pe; const float* w1 = kv ? p.cmp_v_w1 : p.cmp_k_w1; float a = 0.f;
#pragma unroll 16
                for (int i = seg * 64; i < seg * 64 + 64; ++i) a += pe[i] * w1[(size_t)i * 256 + t];
                ((float*)(p.ws + O_CBP))[(seg * 2 + kv) * 256 + t] = a; } }
    }
    auto setup = [&](TrJob& j, int u) {
        if (u < U_WINB) { tr_setup(j, u, 32, p.w_in, 7552, 1, (bf16_t*)(p.ws + O_WIN), D); return; } u -= U_WINB;
        if (u < U_IDXQ) { tr_setup(j, u, 8, p.idx_w_q, 512, 0, Wq + (size_t)2304 * 512, 512); return; } u -= U_IDXQ;
        if (u < U_UQR) { tr_setup(j, u, 8, p.a_w_uq, 1024, 3, Wq + (size_t)2048 * 512, 512); return; } u -= U_UQR;
        if (u < U_C1) { tr_setup(j, u, 64, p.cmp_k_w1, 256, 0, (bf16_t*)(p.ws + O_WC1), 4096); return; } u -= U_C1;
        if (u < U_C1) { tr_setup(j, u, 64, p.cmp_v_w1, 256, 0, (bf16_t*)(p.ws + O_WC1) + (size_t)256 * 4096, 4096); return; } u -= U_C1;
        tr_setup(j, u, 32, p.w_router, 32, 4, (bf16_t*)(p.ws + O_WRT), D);
    };
    auto setup8 = [&](TrJob& j, int u) {
        j.lddst = D;
        if (u < U_WIN) { j.src = p.w_in; j.ldsrc = 7552; j.kind = 1; j.dst = (bf16_t*)(p.ws + O_WIN8); j.k0 = (u & 15) * 128; j.n0 = 2048 + (u >> 4) * 128; j.dk0 = j.k0; j.dn0 = j.n0; return; } u -= U_WIN;
        if (u < U_BRB) { j.src = p.w_br_b; j.ldsrc = D; j.kind = 0; j.dst = (bf16_t*)(p.ws + O_WBRB); j.lddst = 1024; j.k0 = (u & 7) * 128; j.n0 = (u >> 3) * 128; j.dk0 = j.k0; j.dn0 = j.n0; return; } u -= U_BRB;
        if (u < U_OUT) { j.src = p.w_out; j.ldsrc = D; j.kind = 0; j.dst = (bf16_t*)(p.ws + O_WOUT); j.k0 = (u & 15) * 128; j.n0 = (u >> 4) * 128; j.dk0 = j.k0; j.dn0 = j.n0; return; } u -= U_OUT;
        const int e = u / (U_GU + U_DN), r = u - e * (U_GU + U_DN);
        if (r < U_GU) { j.src = p.w_gate_up + (size_t)e * D * 4096; j.ldsrc = 4096; j.kind = 2; j.dst = (bf16_t*)(p.ws + O_WGU + (size_t)e * 4096 * D + (size_t)r * 16384); j.k0 = (r & 15) * 128; j.n0 = (r >> 4) * 128; }
        else { const int r2 = r - U_GU; j.src = p.w_down + (size_t)e * D * D; j.ldsrc = D; j.kind = 0; j.dst = (bf16_t*)(p.ws + O_WDN + (size_t)e * D * D + (size_t)r2 * 16384); j.k0 = (r2 & 15) * 128; j.n0 = (r2 >> 4) * 128; }
        j.lddst = 128; j.dk0 = 0; j.dn0 = 0;
    };
    TrJob cur, nxt; f32x4 v[8];
    int u;
    for (int rp_ = 0; rp_ < ((PREP_REP & 2) ? 2 : 1); ++rp_) {
    u = blockIdx.x;
    if (u < NTR) { setup(cur, u); tr_load(cur, v, t); }
#pragma unroll 1
    for (; u < NTR; u += G) {
        __syncthreads();
        tr_lds_write(v, tile, t);
        __syncthreads();
        const bool more = u + G < NTR;
        if (more) { setup(nxt, u + G); tr_load(nxt, v, t); }
        tr_store(cur, tile, t);
        cur = nxt;
    }
    }
    auto clampu = [&](int x) { return x < NTR8 ? x : NTR8 - 1; };
    for (int rp_ = 0; rp_ < ((PREP_REP & 4) ? 2 : 1); ++rp_) {
    u = blockIdx.x;
    f32x4 v2[8]; float ok1, ok2;
    setup8(cur, clampu(u)); ok1 = tr8_load(cur, v, t);
    setup8(nxt, clampu(u + G)); ok2 = tr8_load(nxt, v2, t);
#pragma unroll 1
    for (; u < NTR8; u += 2 * G) {
        __syncthreads();
        tr8_lds_write(v, ok1, tile, t);
        __syncthreads();
        TrJob c = cur;
        setup8(cur, clampu(u + 2 * G)); ok1 = tr8_load(cur, v, t);
        tr8_store(c, tile, t);
        __syncthreads();
        tr8_lds_write(v2, ok2, tile, t);
        __syncthreads();
        c = nxt;
        setup8(nxt, clampu(u + 3 * G)); ok2 = tr8_load(nxt, v2, t);
        tr8_store(c, tile, t);
    }
    }
#if PREP_PROBE_MODE >= 2
    {
        unsigned chk = 0; unsigned char* dummy = (unsigned char*)(p.ws + O_HS);
        constexpr int U0 = U_WIN + U_BRB + U_OUT;
        TrJob pj, pn; f32x4 w[8]; float okp;
        int uu = U0 + blockIdx.x;
        setup8(pj, uu); okp = tr8_load(pj, w, t);
#pragma unroll 1
        for (; uu < NTR8; uu += G) {
#if PREP_PROBE_MODE == 2
            __syncthreads();
            tr8_lds_write(w, okp, tile, t);
            __syncthreads();
            setup8(pn, clampu(uu + G)); okp = tr8_load(pn, w, t);
            {   const int kc = t & 7, nb = t >> 3; constexpr float SC = pg8::W8_SCALE;
#pragma unroll
                for (int ps = 0; ps < 2; ++ps) { const int nn = nb + 64 * ps; const float* s = tile + (16 * kc) * 129 + nn;
                    chk ^= pg8::fp8x4(s[0] * SC, s[129] * SC, s[2 * 129] * SC, s[3 * 129] * SC) ^ pg8::fp8x4(s[4 * 129] * SC, s[5 * 129] * SC, s[6 * 129] * SC, s[7 * 129] * SC)
                         ^ pg8::fp8x4(s[8 * 129] * SC, s[9 * 129] * SC, s[10 * 129] * SC, s[11 * 129] * SC) ^ pg8::fp8x4(s[12 * 129] * SC, s[13 * 129] * SC, s[14 * 129] * SC, s[15 * 129] * SC); } }
            pj = pn;
#else
            u32x4 o0 = {pg8::fp8x4(w[0][0], w[0][1], w[0][2], w[0][3]), pg8::fp8x4(w[1][0], w[1][1], w[1][2], w[1][3]), pg8::fp8x4(w[2][0], w[2][1], w[2][2], w[2][3]), pg8::fp8x4(w[3][0], w[3][1], w[3][2], w[3][3])};
            u32x4 o1 = {pg8::fp8x4(w[4][0], w[4][1], w[4][2], w[4][3]), pg8::fp8x4(w[5][0], w[5][1], w[5][2], w[5][3]), pg8::fp8x4(w[6][0], w[6][1], w[6][2], w[6][3]), pg8::fp8x4(w[7][0], w[7][1], w[7][2], w[7][3])};
            setup8(pn, clampu(uu + G)); okp = tr8_load(pn, w, t);
            u32x4* dp = (u32x4*)(dummy + ((size_t)(uu - U0) * 512 + t) * 32); dp[0] = o0; dp[1] = o1;
            pj = pn;
#endif
        }
        if (chk == 0x12345678u && okp == 3.f) ((unsigned*)(p.ws + 115200))[0] = chk;
    }
#endif
#if PREP_PROBE_WC > 0
    {
        constexpr int WC = PREP_PROBE_WC, RW = WC / 4, RS = 512 / RW, R = 16384 / WC;
        float acc = 0.f; const int c4 = t % RW, r0 = t / RW;
#pragma unroll 1
        for (int pass = 0; pass < 2; ++pass) {
            const float* base = pass ? p.w_down : p.w_gate_up; const int ld = pass ? 2048 : 4096;
            const int nK = 65536 / R, ntiles = nK * (ld / WC);
#pragma unroll 1
            for (int uu = blockIdx.x; uu < ntiles; uu += G) {
#if PREP_PROBE_NFAST
                const int nN = ld / WC, nt_ = uu % nN, kt = uu / nN;
#else
                const int kt = uu % nK, nt_ = uu / nK;
#endif
                f32x4 w[8];
#pragma unroll
                for (int q = 0; q < 8; ++q) w[q] = __builtin_nontemporal_load((const f32x4*)(base + (size_t)(kt * R + r0 + RS * q) * ld + nt_ * WC + 4 * c4));
#pragma unroll
                for (int q = 0; q < 8; ++q) acc += (w[q][0] + w[q][1]) + (w[q][2] + w[q][3]);
            }
        }
        if (acc == 12345.678f) ((float*)(p.ws + 115200))[0] = acc;
    }
#endif
}

DI void phase_h1(const Params& p) {
    const int tz_ = tid_fresh(); const int lane = tz_ & 63, wid = __builtin_amdgcn_readfirstlane(tz_ >> 6);
    if (blockIdx.x == 0) { float a = 0.f; const float* cbp = (const float*)(p.ws + O_CBP);
        for (int sg = 0; sg < 64; ++sg) a += cbp[sg * 512 + tz_];
        ((float*)(p.ws + O_CBIAS))[tz_] = a; }
    bf16_t* H = (bf16_t*)(p.ws + O_H); float* rope = (float*)(p.ws + O_ROPE);
    for (int tok = blockIdx.x * 8 + wid; tok < NT; tok += gridDim.x * 8) {
        const int b = tok >> 13;
        const f32x4* xr = (const f32x4*)(p.x + (size_t)tok * D) + lane;
        f32x4 v[8]; float ss = 0.f;
#pragma unroll
        for (int i = 0; i < 8; ++i) { v[i] = xr[64 * i]; ss += v[i][0] * v[i][0] + v[i][1] * v[i][1] + v[i][2] * v[i][2] + v[i][3] * v[i][3]; }
        const float rs = rsqrtf(wave_sum(ss) * (1.f / D) + NORM_EPS);
#pragma unroll
        for (int i = 0; i < 8; ++i) { const int col = 4 * (lane + 64 * i); float o[4];
#pragma unroll
            for (int j = 0; j < 4; ++j) o[j] = v[i][j] * rs * p.g_pre_mix[col + j] * (1.f + mod_at(p, b, 2048 + col + j)) + mod_at(p, b, col + j);
            *(u32x2*)(H + (size_t)tok * D + col) = (u32x2){pk2(o[0], o[1]), pk2(o[2], o[3])};
            *(unsigned*)((unsigned char*)(p.ws + O_H8) + (size_t)tok * D + col) = pg8::fp8x4(o[0], o[1], o[2], o[3]); }
        if (lane < 24) { const float fr = lane < 16 ? (float)(2 * lane) * (1.f / 32.f) : (float)(2 * (lane - 16)) * (1.f / 16.f);
            const float inv = exp2f(-fr * 18.931568569324174f);
            const float ang = (float)p.pos[tok] * inv; float s, c; sincosf(ang, &s, &c);
            rope[(size_t)tok * 48 + 2 * lane] = c; rope[(size_t)tok * 48 + 2 * lane + 1] = s; }
    }
}

DI void phase_zpost(const Params& p) {
    const int tz_ = tid_fresh(); const int lane = tz_ & 63, wid = __builtin_amdgcn_readfirstlane(tz_ >> 6);
    const bf16_t* Z = (const bf16_t*)(p.ws + O_Z); const float* rope = (const float*)(p.ws + O_ROPE);
    bf16_t* cqn = (bf16_t*)(p.ws + O_CQN); bf16_t* kvt = (bf16_t*)(p.ws + O_KVT); bf16_t* kidx = (bf16_t*)(p.ws + O_KIDX);
    float* widx = (float*)(p.ws + O_WIDX); float* gates = (float*)(p.ws + O_GATES); bf16_t* bq = (bf16_t*)(p.ws + O_BQ); bf16_t* kvs = (bf16_t*)(p.ws + O_KVS);
    const f32x4 gq0 = *(const f32x4*)(p.a_cq_norm + lane * 8), gq1 = *(const f32x4*)(p.a_cq_norm + lane * 8 + 4), gkv = *(const f32x4*)(p.a_ckv_norm + lane * 4);
    const float ig = p.idx_g[lane], ibs = p.idx_b[lane];
    const int part = lane & 7;
    for (int tok = blockIdx.x * 8 + wid; tok < NT; tok += gridDim.x * 8) {
        const int b = tok >> 13, tq = tok & (T - 1);
        const bf16_t* zr = Z + (size_t)tok * ZC; const float* rt = rope + (size_t)tok * 48;
        const u32x4 rcq = *(const u32x4*)(zr + lane * 8);
        const u32x2 rkv = *(const u32x2*)(zr + ZC_CKV + lane * 4);
        const bf16_t rki = zr[ZC_KIDX + lane], rk1 = zr[ZC_KROPE + (lane & 15)], rk2 = zr[ZC_KROPE + 16 + (lane & 15)], rwi = zr[ZC_WIDX + (lane & 7)], rbg = zr[ZC_BGATE + (lane < 24 ? lane : 0)];
        u32x4 rh[3][2];
#pragma unroll
        for (int ps = 0; ps < 3; ++ps) { const int slot = ps * 64 + lane, s2 = slot < 160 ? slot : 159; const bf16_t* src = zr + ZC_BQ + (s2 >> 3) * 128 + (s2 & 7) * 16;
            rh[ps][0] = *(const u32x4*)src; rh[ps][1] = *(const u32x4*)(src + 8); }
        f32x4 rr[8];
#pragma unroll
        for (int i = 0; i < 8; ++i) rr[i] = *(const f32x4*)(rt + 4 * i);
        const float ric = rt[32 + 2 * (lane & 7)], ris = rt[33 + 2 * (lane & 7)], rkc = rt[2 * (lane & 15)], rks = rt[2 * (lane & 15) + 1];
        {
            float f[8]; unpack8(rcq, f); float ss = 0.f;
#pragma unroll
            for (int j = 0; j < 8; ++j) ss += f[j] * f[j];
            const float rs = rsqrtf(wave_sum(ss) * (1.f / 512.f) + NORM_EPS);
#pragma unroll
            for (int j = 0; j < 4; ++j) { f[j] = f[j] * rs * gq0[j]; f[4 + j] = f[4 + j] * rs * gq1[j]; }
            *(u32x4*)(cqn + (size_t)tok * 512 + lane * 8) = (u32x4){pk2(f[0], f[1]), pk2(f[2], f[3]), pk2(f[4], f[5]), pk2(f[6], f[7])};
        }
        {
            float f[4] = {bflo(rkv[0]), bfhi(rkv[0]), bflo(rkv[1]), bfhi(rkv[1])};
            const float rs = rsqrtf(wave_sum(f[0] * f[0] + f[1] * f[1] + f[2] * f[2] + f[3] * f[3]) * (1.f / 256.f) + NORM_EPS);
#pragma unroll
            for (int j = 0; j < 4; ++j) f[j] = f[j] * rs * gkv[j];
            *(u32x2*)(kvt + (size_t)tok * KVW + lane * 4) = (u32x2){pk2(f[0], f[1]), pk2(f[2], f[3])};
        }
        if (lane < 16) {
            const float x1 = bf2f(rk1), x2 = bf2f(rk2);
            kvt[(size_t)tok * KVW + 256 + lane] = f2bf(x1 * rkc - x2 * rks); kvt[(size_t)tok * KVW + 272 + lane] = f2bf(x2 * rkc + x1 * rks);
        }
        {
            const float v = bf2f(rki); const float mean = wave_sum(v) * (1.f / 64.f); const float xc = v - mean;
            const float var = wave_sum(xc * xc) * (1.f / 64.f);
            const float y = xc * rsqrtf(var + NORM_EPS) * ig + ibs;
            const float pr = __shfl_xor(y, 8); float o = y;
            if (lane < 8) o = y * ric - pr * ris;
            else if (lane < 16) o = y * ric + pr * ris;
            kidx[(size_t)tok * 64 + lane] = f2bf(o);
        }
        if (lane < 8) widx[(size_t)tok * 8 + lane] = bf2f(rwi) * (0.35355339059327373f * 0.125f);
        if (lane < 24) gates[(size_t)tok * 24 + lane] = sigmoidf_(bf2f(rbg));
#pragma unroll
        for (int ps = 0; ps < 3; ++ps) { const int slot = ps * 64 + lane; const int hh = slot >> 3;
            float f[16]; { float a[8], c[8]; unpack8(rh[ps][0], a); unpack8(rh[ps][1], c);
#pragma unroll
                for (int j = 0; j < 8; ++j) { f[j] = a[j]; f[8 + j] = c[j]; } }
            const bool dorope = (hh < 8 || (((hh - 8) >> 1) & 1) == 0) && part < 2;
#pragma unroll
            for (int i = 0; i < 16; ++i) { const float g = __shfl_xor(f[i], 1); const float c = rr[(2 * i) >> 2][(2 * i) & 3], s = rr[(2 * i + 1) >> 2][(2 * i + 1) & 3];
                const float ro = part == 0 ? f[i] * c - g * s : f[i] * c + g * s; f[i] = dorope ? ro : f[i]; }
            if (slot < 160) { bf16_t* dst;
                if (hh < 8) dst = bq + (size_t)tok * 1024 + hh * 128 + part * 16;
                else { const int i6 = (hh - 8) >> 1, g = (hh - 8) & 1; dst = kvs + ((((size_t)i6 * NB + b) * 2 + g) * T + tq) * 128 + part * 16; }
                *(u32x4*)dst = (u32x4){pk2(f[0], f[1]), pk2(f[2], f[3]), pk2(f[4], f[5]), pk2(f[6], f[7])};
                *(u32x4*)(dst + 8) = (u32x4){pk2(f[8], f[9]), pk2(f[10], f[11]), pk2(f[12], f[13]), pk2(f[14], f[15])}; } }
    }
}

DI void c2_rows(const Params& p, char* smem) {
    const int tz_ = tid_fresh(); const int lane = tz_ & 63, wid = __builtin_amdgcn_readfirstlane(tz_ >> 6);
    float* hrow = (float*)smem + wid * 256;
    const float* c1p = (const float*)(p.ws + O_C1P); const float* cb = (const float*)(p.ws + O_CBIAS); bf16_t* kcvc = (bf16_t*)(p.ws + O_KCVC);
    for (int row = blockIdx.x * 8 + wid; row < 4096; row += gridDim.x * 8) {
        const int kv = row >> 11, r = row & 2047, n = r & 511;
        f32x4 a = *(const f32x4*)(cb + kv * 256 + lane * 4);
#pragma unroll
        for (int s = 0; s < 16; ++s) a += *(const f32x4*)(c1p + ((size_t)(s * 2 + kv) * 2048 + r) * 256 + lane * 4);
#pragma unroll
        for (int j = 0; j < 4; ++j) { const float v = a[j]; const float u = 0.7978845608028654f * (v + 0.044715f * v * v * v); hrow[lane * 4 + j] = 0.5f * v * (1.f + tanhf(u)); }
        asm volatile("s_waitcnt lgkmcnt(0)" ::: "memory");
        const float* w2 = kv ? p.cmp_v_w2 : p.cmp_k_w2;
        float o0 = 0.f, o1 = 0.f;
#pragma unroll 16
        for (int j = 0; j < 256; ++j) { const float hv = hrow[j]; const float2 w = *(const float2*)(w2 + j * 128 + lane * 2); o0 += hv * w.x; o1 += hv * w.y; }
        if (n == 511) { o0 = 0.f; o1 = 0.f; }
        *(unsigned*)(kcvc + (size_t)row * 128 + lane * 2) = pk2(o0, o1);
        asm volatile("s_waitcnt lgkmcnt(0)" ::: "memory");
    }
}

DI unsigned short f16key(float v) { const _Float16 h = (_Float16)v; unsigned short u = __builtin_bit_cast(unsigned short, h); return (u & 0x8000u) ? (unsigned short)~u : (unsigned short)(u | 0x8000u); }
DI void topk256_select(const LAS unsigned* scw, int nk, unsigned short* out, int lane) {
    const int nw = (nk + 127) >> 7;
    auto ldk = [&](int i) -> unsigned { const int wi = i * 64 + lane; unsigned v = scw[wi]; if (2 * wi >= nk) v = 0u; else if (2 * wi + 1 >= nk) v &= 0xffffu; return v; };
    unsigned Tv = 0u;
    for (int bit = 15; bit >= 0; --bit) { const unsigned cand = Tv | (1u << bit); int cnt = 0;
#pragma unroll 4
        for (int i = 0; i < nw; ++i) { const unsigned kv = ldk(i); cnt += __popcll(__ballot((kv & 0xffffu) >= cand)) + __popcll(__ballot((kv >> 16) >= cand)); }
        if (cnt >= 256) Tv = cand; }
    int cgt = 0;
#pragma unroll 4
    for (int i = 0; i < nw; ++i) { const unsigned kv = ldk(i); cgt += __popcll(__ballot((kv & 0xffffu) > Tv)) + __popcll(__ballot((kv >> 16) > Tv)); }
    const int need = 256 - cgt; int pos = 0, eqc = 0;
    const unsigned long long ltm = (1ull << lane) - 1ull;
#pragma unroll 2
    for (int i = 0; i < nw; ++i) {
        const unsigned kv = ldk(i); const unsigned lo = kv & 0xffffu, hi = kv >> 16;
        const bool elo = lo == Tv, ehi = hi == Tv;
        const unsigned long long mlo = __ballot(elo), mhi = __ballot(ehi);
        const int below = __popcll(mlo & ltm) + __popcll(mhi & ltm);
        const bool slo = lo > Tv || (elo && eqc + below < need), shi = hi > Tv || (ehi && eqc + below + (elo ? 1 : 0) < need);
        const unsigned long long s0 = __ballot(slo), s1 = __ballot(shi);
        const int plo = pos + __popcll(s0 & ltm), phi = pos + __popcll(s0) + __popcll(s1 & ltm);
        const int kidx = 2 * (i * 64 + lane);
        if (slo) out[plo] = (unsigned short)kidx;
        if (shi) out[phi] = (unsigned short)(kidx + 1);
        pos += __popcll(s0) + __popcll(s1); eqc += __popcll(mlo) + __popcll(mhi); }
}
DI void phase_indexer(const Params& p, char* smem) {
    const int tz_ = tid_fresh(); const int lane = tz_ & 63, wid = __builtin_amdgcn_readfirstlane(tz_ >> 6);
    LAS unsigned short* sc = (LAS unsigned short*)(LAS char*)smem + wid * 8192;
    float* qf = (float*)(smem + 131072) + wid * 512;
    const bf16_t* Q = (const bf16_t*)(p.ws + O_QALL); const bf16_t* KI = (const bf16_t*)(p.ws + O_KIDX); const float* WI = (const float*)(p.ws + O_WIDX);
    unsigned short* SEL = (unsigned short*)(p.ws + O_SEL); int* NSEL = (int*)(p.ws + O_NSEL);
    for (int tok = (int)(NT / 8 - 1 - blockIdx.x) * 8 + wid; tok >= 0; tok -= gridDim.x * 8) {
        const int b = tok >> 13, tq = tok & (T - 1), nk = tq + 1;
        unsigned short* out = SEL + (size_t)tok * 256;
        if (nk <= 256) { for (int i = lane; i < 256; i += 64) out[i] = (unsigned short)(i < nk ? i : 0); if (lane == 0) NSEL[tok] = nk; continue; }
        { float f[8]; unpack8(*(const u32x4*)(Q + (size_t)tok * QC + 2304 + lane * 8), f);
#pragma unroll
          for (int j = 0; j < 8; ++j) qf[lane * 8 + j] = f[j]; }
        float wh[8];
#pragma unroll
        for (int h = 0; h < 8; ++h) wh[h] = WI[(size_t)tok * 8 + h];
        asm volatile("s_waitcnt lgkmcnt(0)" ::: "memory");
        for (int s = lane; s < nk; s += 64) {
            const bf16_t* kr = KI + ((size_t)b * T + s) * 64; float d[8];
#pragma unroll
            for (int h = 0; h < 8; ++h) d[h] = 0.f;
#pragma unroll 2
            for (int c = 0; c < 8; ++c) { float kf[8]; unpack8(*(const u32x4*)(kr + c * 8), kf);
#pragma unroll
                for (int h = 0; h < 8; ++h) { const f32x4 q0 = *(const f32x4*)(qf + h * 64 + c * 8), q1 = *(const f32x4*)(qf + h * 64 + c * 8 + 4);
                    d[h] += q0[0] * kf[0] + q0[1] * kf[1] + q0[2] * kf[2] + q0[3] * kf[3] + q1[0] * kf[4] + q1[1] * kf[5] + q1[2] * kf[6] + q1[3] * kf[7]; } }
            float score = 0.f;
#pragma unroll
            for (int h = 0; h < 8; ++h) score += wh[h] * fmaxf(d[h], 0.f);
            sc[s] = f16key(score); }
        asm volatile("s_waitcnt lgkmcnt(0)" ::: "memory");
        topk256_select((const LAS unsigned*)sc, nk, out, lane);
        if (lane == 0) NSEL[tok] = 256;
        asm volatile("s_waitcnt lgkmcnt(0)" ::: "memory");
    }
}

DI void phase_mla(const Params& p, char* smem) {
    const int tz_ = tid_fresh(); const int lane = tz_ & 63, wid = __builtin_amdgcn_readfirstlane(tz_ >> 6);
    float* qf = (float*)smem + wid * (8 * KVW + 8 * 256 + 128);
    float* pf = qf + 8 * KVW; unsigned short* selw = (unsigned short*)(pf + 8 * 256);
    const bf16_t* Q = (const bf16_t*)(p.ws + O_QALL); const bf16_t* KV = (const bf16_t*)(p.ws + O_KVT);
    const unsigned short* SEL = (const unsigned short*)(p.ws + O_SEL); const int* NSEL = (const int*)(p.ws + O_NSEL); bf16_t* OL = (bf16_t*)(p.ws + O_OLAT);
    for (int tok = blockIdx.x * 8 + wid; tok < NT; tok += gridDim.x * 8) {
        const int b = tok >> 13; const int cnt = NSEL[tok];
        const bf16_t* qr = Q + (size_t)tok * QC;
#pragma unroll 4
        for (int i = 0; i < 36; ++i) { const int e = lane + 64 * i;
            const int h = e / KVW, d = e - h * KVW; qf[e] = bf2f(d < 256 ? qr[h * 256 + d] : qr[2048 + h * 32 + (d - 256)]); }
        *(u32x2*)(selw + lane * 4) = *(const u32x2*)(SEL + (size_t)tok * 256 + lane * 4);
        asm volatile("s_waitcnt lgkmcnt(0)" ::: "memory");
        const bf16_t* rows[4];
#pragma unroll
        for (int j = 0; j < 4; ++j) { const int k = lane + 64 * j; const int idx = k < cnt ? selw[k] : 0; rows[j] = KV + ((size_t)b * T + idx) * KVW; }
        float acc[4][8];
#pragma unroll
        for (int j = 0; j < 4; ++j)
#pragma unroll
            for (int h = 0; h < 8; ++h) acc[j][h] = 0.f;
#pragma unroll 1
        for (int c = 0; c < 36; ++c) { float kf[4][8];
#pragma unroll
            for (int j = 0; j < 4; ++j) unpack8(*(const u32x4*)(rows[j] + c * 8), kf[j]);
#pragma unroll
            for (int h = 0; h < 8; ++h) { const f32x4 q0 = *(const f32x4*)(qf + h * KVW + c * 8), q1 = *(const f32x4*)(qf + h * KVW + c * 8 + 4);
#pragma unroll
                for (int j = 0; j < 4; ++j) acc[j][h] += q0[0] * kf[j][0] + q0[1] * kf[j][1] + q0[2] * kf[j][2] + q0[3] * kf[j][3] + q1[0] * kf[j][4] + q1[1] * kf[j][5] + q1[2] * kf[j][6] + q1[3] * kf[j][7]; } }
#pragma unroll
        for (int h = 0; h < 8; ++h) { float m = -INFINITY;
#pragma unroll
            for (int j = 0; j < 4; ++j) { acc[j][h] = (lane + 64 * j < cnt) ? acc[j][h] * ATT_SCALE : -INFINITY; m = fmaxf(m, acc[j][h]); }
            m = wave_max(m); float l = 0.f;
#pragma unroll
            for (int j = 0; j < 4; ++j) { acc[j][h] = (lane + 64 * j < cnt) ? __expf(acc[j][h] - m) : 0.f; l += acc[j][h]; }
            l = 1.f / fmaxf(wave_sum(l), 1e-30f);
#pragma unroll
            for (int j = 0; j < 4; ++j) pf[h * 256 + lane + 64 * j] = acc[j][h] * l; }
        asm volatile("s_waitcnt lgkmcnt(0)" ::: "memory");
        float o[8][4];
#pragma unroll
        for (int h = 0; h < 8; ++h)
#pragma unroll
            for (int j = 0; j < 4; ++j) o[h][j] = 0.f;
#pragma unroll 1
        for (int k0 = 0; k0 < 256; k0 += 8) { u32x2 vv[8];
#pragma unroll
            for (int kk = 0; kk < 8; ++kk) { const int k = k0 + kk; const int idx = k < cnt ? selw[k] : 0; vv[kk] = *(const u32x2*)(KV + ((size_t)b * T + idx) * KVW + lane * 4); }
#pragma unroll
            for (int kk = 0; kk < 8; ++kk) { const float v0 = bflo(vv[kk][0]), v1 = bfhi(vv[kk][0]), v2 = bflo(vv[kk][1]), v3 = bfhi(vv[kk][1]);
#pragma unroll
                for (int h = 0; h < 8; ++h) { const float ph = pf[h * 256 + k0 + kk]; o[h][0] += ph * v0; o[h][1] += ph * v1; o[h][2] += ph * v2; o[h][3] += ph * v3; } } }
#pragma unroll
        for (int h = 0; h < 8; ++h) *(u32x2*)(OL + (size_t)tok * D + h * 256 + lane * 4) = (u32x2){pk2(o[h][0], o[h][1]), pk2(o[h][2], o[h][3])};
        asm volatile("s_waitcnt lgkmcnt(0)" ::: "memory");
    }
}

DI void nsa_score(const bf16_t* kr, const float* qf, float (&s)[4]) {
#pragma unroll
    for (int j = 0; j < 4; ++j) s[j] = 0.f;
#pragma unroll 4
    for (int c = 0; c < 16; ++c) { float kf[8]; unpack8(*(const u32x4*)(kr + c * 8), kf);
#pragma unroll
        for (int j = 0; j < 4; ++j) { const f32x4 q0 = *(const f32x4*)(qf + j * 128 + c * 8), q1 = *(const f32x4*)(qf + j * 128 + c * 8 + 4);
            s[j] += q0[0] * kf[0] + q0[1] * kf[1] + q0[2] * kf[2] + q0[3] * kf[3] + q1[0] * kf[4] + q1[1] * kf[5] + q1[2] * kf[6] + q1[3] * kf[7]; } }
}
DI void phase_nsa(const Params& p, char* smem) {
    const int tz_ = tid_fresh(); const int lane = tz_ & 63, wid = __builtin_amdgcn_readfirstlane(tz_ >> 6);
    float* qf = (float*)smem + wid * (512 + 256 + 512 + 16); float* pb = qf + 512; float* psum = pb + 256; int* blk = (int*)(psum + 512);
    const bf16_t* BQ = (const bf16_t*)(p.ws + O_BQ); const bf16_t* kvs = (const bf16_t*)(p.ws + O_KVS); const bf16_t* kcvc = (const bf16_t*)(p.ws + O_KCVC);
    const float* gates = (const float*)(p.ws + O_GATES); bf16_t* OB = (bf16_t*)(p.ws + O_OB);
#pragma unroll 1
    for (int item = (NT * 2 / 8 - 1 - (int)blockIdx.x) * 8 + wid; item >= 0; item -= gridDim.x * 8) {
        const int tok = item >> 1, g = item & 1, b = tok >> 13, tq = tok & (T - 1);
        { float f[8]; unpack8(*(const u32x4*)(BQ + (size_t)tok * 1024 + g * 512 + lane * 8), f);
#pragma unroll
          for (int j = 0; j < 8; ++j) qf[lane * 8 + j] = f[j]; }
        asm volatile("s_waitcnt lgkmcnt(0)" ::: "memory");
        const size_t bg = (size_t)(b * 2 + g);
        const int nmax = tq >= 31 ? (tq - 31) >> 4 : -1;
        float res[4][2], o[4][2], m[4], l[4]; int ns = 0;
#pragma unroll
        for (int j = 0; j < 4; ++j) { res[j][0] = 0.f; res[j][1] = 0.f; }
#pragma unroll 1
        for (int step = 0; step < 4; ++step) {
            const int kind = step < 2 ? 0 : step - 1;
            const int mode = step == 0 ? 1 : (step == 1 ? 2 : 0);
            const bf16_t* kbase; const bf16_t* vbase; int nch;
            if (kind == 0) { kbase = kcvc + bg * 512 * 128; vbase = kcvc + (size_t)2048 * 128 + bg * 512 * 128; nch = 8; }
            else if (kind == 1) { kbase = kvs + (2 * (size_t)NB * 2 + bg) * T * 128; vbase = kvs + (3 * (size_t)NB * 2 + bg) * T * 128; nch = ns; }
            else { kbase = kvs + (4 * (size_t)NB * 2 + bg) * T * 128; vbase = kvs + (5 * (size_t)NB * 2 + bg) * T * 128; nch = 8; }
            if (mode != 2) {
#pragma unroll
                for (int j = 0; j < 4; ++j) { m[j] = -INFINITY; l[j] = 0.f; } }
#pragma unroll
            for (int j = 0; j < 4; ++j) { o[j][0] = 0.f; o[j][1] = 0.f; }
#pragma unroll 1
            for (int c = 0; c < nch; ++c) {
                int base, lim_lo, lim_hi;
                if (kind == 0) { base = 64 * c; lim_lo = 0; lim_hi = nmax; }
                else if (kind == 1) { base = blk[c] * 64; lim_lo = 0; lim_hi = tq; }
                else { base = tq - 511 + 64 * c; lim_lo = 0; lim_hi = tq; }
                const bool active = base <= lim_hi && base + 63 >= lim_lo;
                if (!active) { if (mode == 2) psum[c * 64 + lane] = 0.f; continue; }
                const int key = base + lane; const bool valid = key >= lim_lo && key <= lim_hi;
                float s[4]; nsa_score(kbase + (size_t)(key < 0 ? 0 : key) * 128, qf, s);
                float ps = 0.f;
#pragma unroll
                for (int j = 0; j < 4; ++j) {
                    const float sv = valid ? s[j] * ATT_SCALE : -INFINITY; float pj;
                    if (mode == 2) { pj = valid ? __expf(sv - m[j]) * l[j] : 0.f; ps += pj; }
                    else { const float mn = fmaxf(m[j], wave_max(sv));
                        const float alpha = (m[j] == -INFINITY) ? 0.f : __expf(m[j] - mn);
                        pj = (sv == -INFINITY) ? 0.f : __expf(sv - mn);
                        l[j] = l[j] * alpha + wave_sum(pj); m[j] = mn; o[j][0] *= alpha; o[j][1] *= alpha; }
                    pb[j * 64 + lane] = pj; }
                if (mode == 2) psum[c * 64 + lane] = ps;
                if (mode != 1) {
                    asm volatile("s_waitcnt lgkmcnt(0)" ::: "memory");
#pragma unroll 1
                    for (int k0 = 0; k0 < 64; k0 += 8) { unsigned vv[8];
#pragma unroll
                        for (int kk = 0; kk < 8; ++kk) { const int kx = base + k0 + kk; vv[kk] = *(const unsigned*)(vbase + (size_t)(kx < 0 ? 0 : kx) * 128 + lane * 2); }
#pragma unroll
                        for (int kk = 0; kk < 8; ++kk) { const float v0 = bflo(vv[kk]), v1 = bfhi(vv[kk]);
#pragma unroll
                            for (int j = 0; j < 4; ++j) { const float ph = pb[j * 64 + k0 + kk]; o[j][0] += ph * v0; o[j][1] += ph * v1; } } } }
                asm volatile("s_waitcnt lgkmcnt(0)" ::: "memory");
            }
            if (step == 0) {
#pragma unroll
                for (int j = 0; j < 4; ++j) { if (m[j] == -INFINITY) m[j] = 0.f; l[j] = 1.f / fmaxf(l[j], 1e-30f); }
                continue; }
#pragma unroll
            for (int j = 0; j < 4; ++j) { const float gt = gates[(size_t)tok * 24 + (g * 4 + j) * 3 + kind]; const float il = (mode == 2) ? gt : gt / fmaxf(l[j], 1e-30f);
                res[j][0] += il * o[j][0]; res[j][1] += il * o[j][1]; }
            if (step == 1) {
                asm volatile("s_waitcnt lgkmcnt(0)" ::: "memory");
                const int cur = tq >> 6; unsigned key[2];
#pragma unroll
                for (int hh = 0; hh < 2; ++hh) { const int mb = lane + 64 * hh; float imp = 0.f;
#pragma unroll
                    for (int d = -1; d < 4; ++d) { const int n = 4 * mb + d; if (n >= 0 && n < 512) imp += psum[n]; }
                    const bool adm = mb <= cur, forced = mb == 0 || mb == cur || mb == cur - 1;
                    key[hh] = !adm ? 0u : (forced ? (0xFF000000u | (unsigned)(127 - mb)) : ((((__float_as_uint(imp) >> 7) + 1u) << 7) | (unsigned)(127 - mb))); }
                unsigned Tv = 0u;
                for (int bit = 31; bit >= 0; --bit) { const unsigned cand = Tv | (1u << bit);
                    const int cnt = __popcll(__ballot(key[0] >= cand)) + __popcll(__ballot(key[1] >= cand)); if (cnt >= 16) Tv = cand; }
                if (Tv == 0u) Tv = 1u;
                const unsigned long long m0 = __ballot(key[0] >= Tv), m1 = __ballot(key[1] >= Tv);
                const unsigned long long ltm = (1ull << lane) - 1ull;
                if (key[0] >= Tv) blk[__popcll(m0 & ltm)] = lane;
                if (key[1] >= Tv) blk[__popcll(m0) + __popcll(m1 & ltm)] = lane + 64;
                ns = __popcll(m0) + __popcll(m1);
                asm volatile("s_waitcnt lgkmcnt(0)" ::: "memory"); }
        }
#pragma unroll
        for (int j = 0; j < 4; ++j) *(unsigned*)(OB + (size_t)tok * 1024 + (g * 4 + j) * 128 + lane * 2) = pk2(res[j][0], res[j][1]);
        asm volatile("s_waitcnt lgkmcnt(0)" ::: "memory");
    }
}

typedef float f32x16 __attribute__((ext_vector_type(16)));
typedef short s16x4 __attribute__((ext_vector_type(4)));
#define MFMA32(a, b, c) __builtin_amdgcn_mfma_f32_32x32x16_bf16((a), (b), (c), 0, 0, 0)
DI unsigned offb(unsigned row, unsigned ch) { return 256u * row + 16u * (ch ^ (((row & 3u) << 2) | ((row >> 2) & 3u))); }
DI unsigned cvt2(float a, float b) { typedef __bf16 b2 __attribute__((ext_vector_type(2))); typedef float f2 __attribute__((ext_vector_type(2))); const b2 r = __builtin_convertvector((f2){a, b}, b2); return __builtin_bit_cast(unsigned, r); }
DI bf16x8 pack_p(const f32x16& x, int s) {
    const u32x4 w = {cvt2(x[8 * s], x[8 * s + 1]), cvt2(x[8 * s + 2], x[8 * s + 3]), cvt2(x[8 * s + 4], x[8 * s + 5]), cvt2(x[8 * s + 6], x[8 * s + 7])};
    return __builtin_bit_cast(bf16x8, w);
}
DI void nsa_tile_dma(LAS char* kb, LAS char* vb, const bf16_t* kt, const bf16_t* vt, int tid, int w) {
#pragma unroll
    for (int i = 0; i < 2; ++i) { const int id = tid + 512 * i; const unsigned row = id >> 4, pos = id & 15; const unsigned ch = pos ^ (((row & 3u) << 2) | ((row >> 2) & 3u));
        const size_t so = (size_t)row * 128 + ch * 8; const unsigned lo = (unsigned)(i * 512 + w * 64) * 16u;
        __builtin_amdgcn_global_load_lds((const unsigned*)(kt + so), (LAS unsigned*)(kb + lo), 16, 0, 0);
        __builtin_amdgcn_global_load_lds((const unsigned*)(vt + so), (LAS unsigned*)(vb + lo), 16, 0, 0); }
}
#define NSA_TR8(R, A, OFF) asm volatile( \
    "ds_read_b64_tr_b16 %0, %8 offset:%16\n\tds_read_b64_tr_b16 %1, %9 offset:%16\n\tds_read_b64_tr_b16 %2, %10 offset:%16\n\tds_read_b64_tr_b16 %3, %11 offset:%16\n\t" \
    "ds_read_b64_tr_b16 %4, %12 offset:%16\n\tds_read_b64_tr_b16 %5, %13 offset:%16\n\tds_read_b64_tr_b16 %6, %14 offset:%16\n\tds_read_b64_tr_b16 %7, %15 offset:%16\n\ts_waitcnt lgkmcnt(0)" \
    : "=&v"(R[0]), "=&v"(R[1]), "=&v"(R[2]), "=&v"(R[3]), "=&v"(R[4]), "=&v"(R[5]), "=&v"(R[6]), "=&v"(R[7]) \
    : "v"(A[0]), "v"(A[1]), "v"(A[2]), "v"(A[3]), "v"(A[4]), "v"(A[5]), "v"(A[6]), "v"(A[7]), "i"(OFF) : "memory")

#define NSA_TR4(R, A0, A1, A2, A3, OFF) asm volatile( \
    "ds_read_b64_tr_b16 %0, %4 offset:%8\n\tds_read_b64_tr_b16 %1, %5 offset:%8\n\tds_read_b64_tr_b16 %2, %6 offset:%8\n\tds_read_b64_tr_b16 %3, %7 offset:%8" \
    : "=&v"(R[0]), "=&v"(R[1]), "=&v"(R[2]), "=&v"(R[3]) : "v"(A0), "v"(A1), "v"(A2), "v"(A3), "i"(OFF) : "memory")
#define NSA_LWAIT(N, R) asm volatile("s_waitcnt lgkmcnt(" #N ")" : "+v"(R[0]), "+v"(R[1]), "+v"(R[2]), "+v"(R[3]) :: "memory")
struct NsaWave {
    float m, l;
    f32x16 O[4];
    bf16x8 q[8];
};
template <int MODE>
DI void nsa_tile_compute(NsaWave& W, unsigned kbuf, unsigned vbuf, const unsigned (&vaddr0)[8], int tq0, int kind, int kbeg, bool needmask, bool rowneed, int lane, LAS float* impA, LAS float* impL, int mblk0) {
    const int c = lane & 31, h = lane >> 5;
    constexpr float C2 = ATT_SCALE * 1.4426950408889634f;
    f32x16 s0, s1;
    const f32x16 zero16 = {0.f, 0.f, 0.f, 0.f, 0.f, 0.f, 0.f, 0.f, 0.f, 0.f, 0.f, 0.f, 0.f, 0.f, 0.f, 0.f};
    const unsigned f = ((c & 3u) << 2) | ((c >> 2) & 3u);
#ifndef NSA_REP_QK
#define NSA_REP_QK 1
#endif
    __builtin_amdgcn_s_setprio(1);
#pragma unroll 1
    for (int rq_ = 0; rq_ < NSA_REP_QK; ++rq_) {
        if (NSA_REP_QK > 1) asm volatile("" ::: "memory");
#pragma unroll
    for (int s = 0; s < 8; ++s) { const unsigned ch = (unsigned)(2 * s + h) ^ f;
        const bf16x8 a0 = *(const LAS bf16x8*)(size_t)(kbuf + 256u * c + 16u * ch), a1 = *(const LAS bf16x8*)(size_t)(kbuf + 8192u + 256u * c + 16u * ch);
        s0 = MFMA32(a0, W.q[s], s == 0 ? zero16 : s0); s1 = MFMA32(a1, W.q[s], s == 0 ? zero16 : s1); } }
    __builtin_amdgcn_s_setprio(0);
    if (needmask) {
        const int tq = tq0 + (c >> 2);
        const int lo = kind == 2 ? tq - 511 : 0, hi = kind == 0 ? (tq >= 31 ? (tq - 31) >> 4 : -1) : tq;
#pragma unroll
        for (int r = 0; r < 16; ++r) { const int k0 = kbeg + (r & 3) + 8 * (r >> 2) + 4 * h, k1 = k0 + 32;
            if (!(k0 >= lo && k0 <= hi)) s0[r] = -INFINITY;
            if (!(k1 >= lo && k1 <= hi)) s1[r] = -INFINITY; }
    }
    if (MODE != 2) {
        float mx = fmaxf(fmaxf(s0[0], s0[1]), s1[0]);
#pragma unroll
        for (int r = 2; r < 16; r += 2) mx = fmaxf(fmaxf(mx, s0[r]), s0[r + 1]);
#pragma unroll
        for (int r = 1; r < 15; r += 2) mx = fmaxf(fmaxf(mx, s1[r]), s1[r + 1]);
        mx = fmaxf(mx, s1[15]);
        mx = fmaxf(mx, __shfl_xor(mx, 32));
        if (!rowneed) mx = -INFINITY;
        const float mn = (W.m == -INFINITY || (mx - W.m) * C2 > 8.f) ? fmaxf(W.m, mx) : W.m;
        const float mu = (mn == -INFINITY) ? 0.f : mn;
        const float alpha = __builtin_amdgcn_exp2f((W.m - mu) * C2);
        const float nb = rowneed ? -mu * C2 : -INFINITY;
        float rs = 0.f;
#pragma unroll
        for (int r = 0; r < 16; ++r) { s0[r] = __builtin_amdgcn_exp2f(__builtin_fmaf(s0[r], C2, nb)); s1[r] = __builtin_amdgcn_exp2f(__builtin_fmaf(s1[r], C2, nb)); rs += s0[r] + s1[r]; }
        rs += __shfl_xor(rs, 32);
        W.l = W.l * alpha + rs; W.m = mn;
        if (MODE == 0 && !__all(alpha == 1.f)) {
#pragma unroll
            for (int d = 0; d < 4; ++d)
#pragma unroll
                for (int r = 0; r < 16; ++r) W.O[d][r] *= alpha; }
    } else {
#pragma unroll
        for (int r = 0; r < 16; ++r) { s0[r] = __builtin_amdgcn_exp2f((s0[r] - W.m) * C2) * W.l; s1[r] = __builtin_amdgcn_exp2f((s1[r] - W.m) * C2) * W.l; }
#pragma unroll
        for (int kb = 0; kb < 2; ++kb)
#pragma unroll
            for (int i = 0; i < 4; ++i) { const f32x16& sv = kb ? s1 : s0;
                float a = sv[4 * i] + sv[4 * i + 1] + sv[4 * i + 2] + sv[4 * i + 3], lv = sv[4 * i + 3];
                a += __shfl_xor(a, 1); a += __shfl_xor(a, 2); lv += __shfl_xor(lv, 1); lv += __shfl_xor(lv, 2);
                if ((c & 3) == 0) { const int mb = mblk0 + 8 * kb + 2 * i + h; impA[(c >> 2) * 128 + mb] = a; impL[(c >> 2) * 128 + mb] = lv; } }
    }
    if (MODE != 1) {
        unsigned vaddrl[8];
        { const unsigned q = (lane & 15) >> 2, pp = lane & 3, blk = (lane >> 4) & 1;
#pragma unroll
          for (int d = 0; d < 4; ++d)
#pragma unroll
              for (int t = 0; t < 2; ++t) vaddrl[2 * d + t] = vbuf + offb(8u * t + 4u * h + q, 4u * d + 2u * blk + (pp >> 1)) + 8u * (pp & 1u); }
        bf16x8 pf[4] = {pack_p(s0, 0), pack_p(s0, 1), pack_p(s1, 0), pack_p(s1, 1)};
        s16x4 RA[4], RB[4];
        asm volatile("s_waitcnt lgkmcnt(0)" ::: "memory");
        NSA_TR4(RA, vaddrl[0], vaddrl[1], vaddrl[2], vaddrl[3], 0);
        NSA_TR4(RB, vaddrl[4], vaddrl[5], vaddrl[6], vaddrl[7], 0);
#define NSA_PVSTEP(KS, NEXTOFF, HASNEXT) \
        NSA_LWAIT(4, RA); __builtin_amdgcn_sched_barrier(0); \
        { const bf16x8 v0_ = __builtin_shufflevector(RA[0], RA[1], 0, 1, 2, 3, 4, 5, 6, 7), v1_ = __builtin_shufflevector(RA[2], RA[3], 0, 1, 2, 3, 4, 5, 6, 7); \
          W.O[0] = MFMA32(v0_, pf[KS], W.O[0]); W.O[1] = MFMA32(v1_, pf[KS], W.O[1]); } \
        __builtin_amdgcn_sched_barrier(0); \
        if (HASNEXT) NSA_TR4(RA, vaddrl[0], vaddrl[1], vaddrl[2], vaddrl[3], NEXTOFF); \
        if (HASNEXT) NSA_LWAIT(4, RB); else NSA_LWAIT(0, RB); \
        __builtin_amdgcn_sched_barrier(0); \
        { const bf16x8 v2_ = __builtin_shufflevector(RB[0], RB[1], 0, 1, 2, 3, 4, 5, 6, 7), v3_ = __builtin_shufflevector(RB[2], RB[3], 0, 1, 2, 3, 4, 5, 6, 7); \
          W.O[2] = MFMA32(v2_, pf[KS], W.O[2]); W.O[3] = MFMA32(v3_, pf[KS], W.O[3]); } \
        __builtin_amdgcn_sched_barrier(0); \
        if (HASNEXT) NSA_TR4(RB, vaddrl[4], vaddrl[5], vaddrl[6], vaddrl[7], NEXTOFF);
        __builtin_amdgcn_s_setprio(1);
        NSA_PVSTEP(0, 4096, true) NSA_PVSTEP(1, 8192, true) NSA_PVSTEP(2, 12288, true) NSA_PVSTEP(3, 0, false)
        __builtin_amdgcn_s_setprio(0);
#undef NSA_PVSTEP
    }
}
DI void nsa_fold(const NsaWave& W, bf16_t* obrow, unsigned char* ob8row, float sc, bool first, bool last, int h) {
#pragma unroll
    for (int d = 0; d < 4; ++d)
#pragma unroll
        for (int i = 0; i < 4; ++i) { bf16_t* pp = obrow + 32 * d + 8 * i + 4 * h; float o0 = 0.f, o1 = 0.f, o2 = 0.f, o3 = 0.f;
            if (!first) { const u32x2 w = *(const u32x2*)pp; o0 = bflo(w[0]); o1 = bfhi(w[0]); o2 = bflo(w[1]); o3 = bfhi(w[1]); }
            o0 += sc * W.O[d][4 * i]; o1 += sc * W.O[d][4 * i + 1]; o2 += sc * W.O[d][4 * i + 2]; o3 += sc * W.O[d][4 * i + 3];
            if (last) *(unsigned*)(ob8row + 32 * d + 8 * i + 4 * h) = pg8::fp8x4(o0 * pg8::A8_SCALE, o1 * pg8::A8_SCALE, o2 * pg8::A8_SCALE, o3 * pg8::A8_SCALE);
            else *(u32x2*)pp = (u32x2){cvt2(o0, o1), cvt2(o2, o3)}; }
}
struct NsaRun { LAS char* L; unsigned lds0; const bf16_t* kbase; const bf16_t* vbase; int t0, nt, kind, tqmin, lo_min, lo_max, hi_min, hi_max, tid, w; LAS unsigned* selm; LAS float* impA; LAS float* impL; };
template <int MODE>
DI void nsa_tiles(NsaWave& W, const NsaRun& R, const unsigned (&vaddr)[8]) {
    if (R.nt <= 0) return;
    const int lane = R.tid & 63, c = lane & 31;
    __syncthreads();
    nsa_tile_dma(R.L, R.L + 16384, R.kbase + (size_t)R.t0 * 8192, R.vbase + (size_t)R.t0 * 8192, R.tid, R.w);
    asm volatile("s_waitcnt vmcnt(0)" ::: "memory");
    __syncthreads();
#pragma unroll 1
    for (int i = 0; i < R.nt; ++i) {
        const int cur = i & 1, tt = R.t0 + i, kbeg = tt * 64;
        if (i + 1 < R.nt) nsa_tile_dma(R.L + (cur ^ 1) * 32768, R.L + (cur ^ 1) * 32768 + 16384, R.kbase + (size_t)(tt + 1) * 8192, R.vbase + (size_t)(tt + 1) * 8192, R.tid, R.w);
        bool rowneed = true;
        if (R.kind == 1) { const unsigned wsel = R.selm[(c >> 2) * 4 + (tt >> 5)]; rowneed = (wsel >> (tt & 31)) & 1u; }
        const bool skip = kbeg > R.hi_max || kbeg + 63 < R.lo_min || (R.kind == 1 && __ballot(rowneed) == 0ull);
        if (!skip) {
            const bool needmask = !(kbeg >= R.lo_max && kbeg + 63 <= R.hi_min);
            const unsigned kb_ = R.lds0 + cur * 32768u, vb_ = kb_ + 16384u;
            nsa_tile_compute<MODE>(W, kb_, vb_, vaddr, R.tqmin, R.kind, kbeg, needmask, rowneed, lane, R.impA, R.impL, MODE == 2 ? tt * 16 : 0);
        }
        asm volatile("s_waitcnt vmcnt(0)" ::: "memory");
        __syncthreads();
    }
}
DI void phase_nsa_mfma(const Params& p, char* smem) {
    const int tid = tid_fresh(), lane = tid & 63, w = __builtin_amdgcn_readfirstlane(tid >> 6), c = lane & 31, h = lane >> 5;
    LAS char* L = (LAS char*)smem;
    const unsigned lds0 = (unsigned)(size_t)L;
    LAS float* impA = (LAS float*)(L + 65536) + w * 1024; LAS float* impL = (LAS float*)(L + 65536 + 32768) + w * 1024;
    LAS unsigned* selm = (LAS unsigned*)(L + 131072) + w * 32;
    const bf16_t* BQ = (const bf16_t*)(p.ws + O_BQ); const bf16_t* kvs = (const bf16_t*)(p.ws + O_KVS); const bf16_t* kcvc = (const bf16_t*)(p.ws + O_KCVC);
    const float* gates = (const float*)(p.ws + O_GATES); bf16_t* OB = (bf16_t*)(p.ws + O_OB);
    unsigned vaddr[8];
    { const unsigned q = (lane & 15) >> 2, pp = lane & 3, blk = (lane >> 4) & 1;
#pragma unroll
      for (int d = 0; d < 4; ++d)
#pragma unroll
          for (int t = 0; t < 2; ++t) vaddr[2 * d + t] = offb(8u * t + 4u * h + q, 4u * d + 2u * blk + (pp >> 1)) + 8u * (pp & 1u); }
#pragma unroll 1
    for (int P = blockIdx.x; P < 256; P += gridDim.x) {
#pragma unroll 1
        for (int half = 0; half < 2; ++half) {
            const int bg = P >> 6, x = P & 63, qb = half == 0 ? 127 - x : x, b = bg >> 1, g = bg & 1, q0 = qb * 64;
            NsaWave W;
            const int tqmin = q0 + 8 * w, tqmax = tqmin + 7; const int tok = b * T + tqmin + (c >> 2);
            { const bf16_t* qr = BQ + (size_t)tok * 1024 + (g * 4 + (c & 3)) * 128 + 8 * h;
#pragma unroll
              for (int s = 0; s < 8; ++s) W.q[s] = *(const bf16x8*)(qr + 16 * s); }
#pragma unroll
            for (int i = 0; i < 16; ++i) { impA[lane + 64 * i] = 0.f; impL[lane + 64 * i] = 0.f; }
            for (int step = 0; step < 4; ++step) {
                const int kind = step < 2 ? 0 : step - 1;
                const bf16_t* kbase; const bf16_t* vbase; int t0, nt;
                int lo_min, lo_max, hi_min, hi_max;
                if (kind == 0) { kbase = kcvc + (size_t)bg * 512 * 128; vbase = kcvc + (size_t)2048 * 128 + (size_t)bg * 512 * 128;
                    t0 = 0; const int nlast = (q0 + 63 - 31) >> 4; nt = q0 + 63 >= 31 ? (nlast >> 6) + 1 : 0;
                    lo_min = 0; lo_max = 0; hi_min = tqmin >= 31 ? (tqmin - 31) >> 4 : -1; hi_max = tqmax >= 31 ? (tqmax - 31) >> 4 : -1; }
                else if (kind == 1) { kbase = kvs + (2 * (size_t)NB * 2 + bg) * T * 128; vbase = kvs + (3 * (size_t)NB * 2 + bg) * T * 128;
                    t0 = 0; nt = qb + 1; lo_min = 0; lo_max = 0; hi_min = tqmin; hi_max = tqmax; }
                else { kbase = kvs + (4 * (size_t)NB * 2 + bg) * T * 128; vbase = kvs + (5 * (size_t)NB * 2 + bg) * T * 128;
                    t0 = qb >= 8 ? qb - 8 : 0; nt = qb - t0 + 1; lo_min = tqmin - 511; lo_max = tqmax - 511; hi_min = tqmin; hi_max = tqmax; }
                if (step != 1) { W.m = -INFINITY; W.l = 0.f; }
#pragma unroll
                for (int d = 0; d < 4; ++d)
#pragma unroll
                    for (int r = 0; r < 16; ++r) W.O[d][r] = 0.f;
                {   NsaRun R; R.L = L; R.lds0 = lds0; R.kbase = kbase; R.vbase = vbase; R.t0 = t0; R.nt = nt; R.kind = kind; R.tqmin = tqmin; R.lo_min = lo_min; R.lo_max = lo_max; R.hi_min = hi_min; R.hi_max = hi_max;
                    R.tid = tid; R.w = w; R.selm = selm; R.impA = impA; R.impL = impL;
                    if (step == 0) nsa_tiles<1>(W, R, vaddr); else if (step == 1) nsa_tiles<2>(W, R, vaddr); else nsa_tiles<0>(W, R, vaddr); }
                if (step == 0) { if (W.m == -INFINITY) W.m = 0.f; W.l = 1.f / fmaxf(W.l, 1e-30f); continue; }
                { int lz = lane; asm volatile("" : "+v"(lz)); const int cz = lz & 31; const int tokz = b * T + tqmin + (cz >> 2);
                  const float gv = gates[(size_t)tokz * 24 + (g * 4 + (cz & 3)) * 3 + kind];
                  nsa_fold(W, OB + (size_t)tokz * 1024 + (g * 4 + (cz & 3)) * 128, (unsigned char*)(p.ws + O_OB8) + (size_t)tokz * 1024 + (g * 4 + (cz & 3)) * 128, step == 1 ? gv : gv / fmaxf(W.l, 1e-30f), step == 1, step == 3, lz >> 5); }
                if (step == 1) {
                    asm volatile("s_waitcnt lgkmcnt(0)" ::: "memory");
#pragma unroll 1
                    for (int qi = 0; qi < 8; ++qi) { const int tqq = tqmin + qi, curb = tqq >> 6; unsigned key[2];
#pragma unroll
                        for (int hh = 0; hh < 2; ++hh) { const int mb = lane + 64 * hh; const float imp = impA[qi * 128 + mb] + (mb > 0 ? impL[qi * 128 + mb - 1] : 0.f);
                            const bool adm = mb <= curb, forced = mb == 0 || mb == curb || mb == curb - 1;
                            key[hh] = !adm ? 0u : (forced ? (0xFF000000u | (unsigned)(127 - mb)) : ((((__float_as_uint(imp) >> 7) + 1u) << 7) | (unsigned)(127 - mb))); }
                        unsigned Tv = 0u;
                        for (int bit = 31; bit >= 0; --bit) { const unsigned cand = Tv | (1u << bit);
                            const int cnt = __popcll(__ballot(key[0] >= cand)) + __popcll(__ballot(key[1] >= cand)); if (cnt >= 16) Tv = cand; }
                        if (Tv == 0u) Tv = 1u;
                        const unsigned long long m0 = __ballot(key[0] >= Tv), m1 = __ballot(key[1] >= Tv);
                        if (lane == 0) { selm[qi * 4] = (unsigned)m0; selm[qi * 4 + 1] = (unsigned)(m0 >> 32); selm[qi * 4 + 2] = (unsigned)m1; selm[qi * 4 + 3] = (unsigned)(m1 >> 32); } }
                    asm volatile("s_waitcnt lgkmcnt(0)" ::: "memory");
                }
            }
        }
    }
}

DI void topk256_hist(LAS unsigned short* sck, int nk, LAS unsigned* hist, unsigned short* out, int lane) {
    const int nit = (nk + 511) >> 9;
    const unsigned long long ltm = (1ull << lane) - 1ull;
    for (int k = nk + lane; k < 512 * nit; k += 64) sck[k] = 0;
    unsigned bsel = 0, cnt_above = 0;
#pragma unroll 1
    for (int pass = 0; pass < 2; ++pass) {
        *(LAS u32x4*)(hist + 4 * lane) = (u32x4){0u, 0u, 0u, 0u};
        asm volatile("s_waitcnt lgkmcnt(0)" ::: "memory");
#pragma unroll 1
        for (int i = 0; i < nit; ++i) { const int k0 = 8 * (i * 64 + lane); const u32x4 wv = *(const LAS u32x4*)(sck + k0);
#pragma unroll
            for (int j = 0; j < 8; ++j) { const unsigned key = (j & 1) ? (wv[j >> 1] >> 16) : (wv[j >> 1] & 0xffffu);
                if (pass == 0) __hip_atomic_fetch_add(hist + (key >> 8), 1u, __ATOMIC_RELAXED, __HIP_MEMORY_SCOPE_WORKGROUP);
                else if ((key >> 8) == bsel) __hip_atomic_fetch_add(hist + (key & 255u), 1u, __ATOMIC_RELAXED, __HIP_MEMORY_SCOPE_WORKGROUP); } }
        asm volatile("s_waitcnt lgkmcnt(0)" ::: "memory");
        const u32x4 c4 = *(const LAS u32x4*)(hist + 4 * lane);
        const unsigned tot = c4[0] + c4[1] + c4[2] + c4[3];
        unsigned inc = tot;
#pragma unroll
        for (int o = 1; o < 64; o <<= 1) { const unsigned v = __shfl_down(inc, o); if (lane + o < 64) inc += v; }
        unsigned above = cnt_above + inc - tot;
        int found = -1; unsigned fabove = 0;
#pragma unroll
        for (int bb = 3; bb >= 0; --bb) { if (found < 0 && above < 256u && above + c4[bb] >= 256u) { found = 4 * lane + bb; fabove = above; } above += c4[bb]; }
        const unsigned long long fm = __ballot(found >= 0); const int src = __builtin_ctzll(fm);
        const unsigned fb = (unsigned)__shfl(found, src); cnt_above = (unsigned)__shfl((int)fabove, src);
        bsel = pass == 0 ? fb : ((bsel << 8) | fb);
    }
    const unsigned Tv = bsel; const int need = 256 - (int)cnt_above; int pos = 0, eqc = 0;
#pragma unroll 1
    for (int i = 0; i < nit; ++i) { const int k0 = 8 * (i * 64 + lane); const u32x4 wv = *(const LAS u32x4*)(sck + k0);
        bool eq[8], sl[8]; bool anyeq = false;
#pragma unroll
        for (int j = 0; j < 8; ++j) { const unsigned key = (j & 1) ? (wv[j >> 1] >> 16) : (wv[j >> 1] & 0xffffu); eq[j] = key == Tv; sl[j] = key > Tv; anyeq |= eq[j]; }
        if (__ballot(anyeq) != 0ull) {
            int below = 0, own = 0, etot = 0;
#pragma unroll
            for (int j = 0; j < 8; ++j) { const unsigned long long em = __ballot(eq[j]); below += __popcll(em & ltm); etot += __popcll(em); }
#pragma unroll
            for (int j = 0; j < 8; ++j) if (eq[j]) { if (eqc + below + own < need) sl[j] = true; ++own; }
            eqc += etot; }
#pragma unroll
        for (int j = 0; j < 8; ++j) { const unsigned long long sm = __ballot(sl[j]); if (sl[j]) out[pos + __popcll(sm & ltm)] = (unsigned short)(k0 + j); pos += __popcll(sm); } }
}
DI void phase_indexer_mfma(const Params& p, char* smem) {
    const int tid = tid_fresh(), lane = tid & 63, w = __builtin_amdgcn_readfirstlane(tid >> 6), c = lane & 31, hh = lane >> 5;
    LAS unsigned short* sc = (LAS unsigned short*)(LAS char*)smem;
    LAS unsigned* hist = (LAS unsigned*)((LAS char*)smem + 131072) + w * 256;
    const bf16_t* Q = (const bf16_t*)(p.ws + O_QALL); const bf16_t* KI = (const bf16_t*)(p.ws + O_KIDX); const float* WI = (const float*)(p.ws + O_WIDX);
    unsigned short* SEL = (unsigned short*)(p.ws + O_SEL); int* NSEL = (int*)(p.ws + O_NSEL);
    const float* rope = (const float*)(p.ws + O_ROPE);
    c2_rows(p, smem);
    __syncthreads();
#pragma unroll 1
    for (int rnd = 0; rnd * (int)gridDim.x < NT / 8; ++rnd) {
        const int slot = (rnd & 1) ? (int)gridDim.x - 1 - (int)blockIdx.x : (int)blockIdx.x;
        const int u = NT / 8 - 1 - (rnd * (int)gridDim.x + slot);
        if (u < 0) continue;
        const int tok0 = u * 8, b = tok0 >> 13, q0 = tok0 & (T - 1), nkmax = q0 + 8;
        const int tok = tok0 + w, nk = q0 + w + 1;
        unsigned short* out = SEL + (size_t)tok * 256;
#ifndef IDX_REP_SCORE
#define IDX_REP_SCORE 1
#endif
#ifndef IDX_REP_SEL
#define IDX_REP_SEL 1
#endif
        for (int rs_ = 0; rs_ < IDX_REP_SCORE; ++rs_)
        if (nkmax > 256) {
            bf16x8 qa[2][4], Wf[2][2];
#pragma unroll
            for (int rb = 0; rb < 2; ++rb) { const bf16_t* qr = Q + (size_t)(tok0 + 4 * rb + (c >> 3)) * QC + 2304 + (c & 7) * 64 + 8 * hh;
#pragma unroll
                for (int s = 0; s < 4; ++s) qa[rb][s] = *(const bf16x8*)(qr + 16 * s);
                {
                    const float* rt = rope + (size_t)(tok0 + 4 * rb + (c >> 3)) * 48 + 32;
                    const u32x4 own = __builtin_bit_cast(u32x4, qa[rb][0]); u32x4 oth;
#pragma unroll
                    for (int k = 0; k < 4; ++k) oth[k] = (unsigned)__shfl_xor((int)own[k], 32);
                    float xa[8], xb[8], xr[8]; unpack8(own, xa); unpack8(oth, xb);
#pragma unroll
                    for (int j = 0; j < 8; ++j) { const float cs = rt[2 * j], sn = rt[2 * j + 1]; xr[j] = hh == 0 ? xa[j] * cs - xb[j] * sn : xa[j] * cs + xb[j] * sn; }
                    const u32x4 pk = {pk2(xr[0], xr[1]), pk2(xr[2], xr[3]), pk2(xr[4], xr[5]), pk2(xr[6], xr[7])};
                    qa[rb][0] = __builtin_bit_cast(bf16x8, pk); }
                { f32x4 wv = {0.f, 0.f, 0.f, 0.f}; if (c < 8) wv = *(const f32x4*)(WI + (size_t)(tok0 + c) * 8 + 4 * hh);
#pragma unroll
                  for (int sp = 0; sp < 2; ++sp) { const bool m0 = c == 4 * rb + 2 * sp, m1 = c == 4 * rb + 2 * sp + 1;
                      const u32x4 pkw = {m0 ? pk2(wv[0], wv[1]) : 0u, m0 ? pk2(wv[2], wv[3]) : 0u, m1 ? pk2(wv[0], wv[1]) : 0u, m1 ? pk2(wv[2], wv[3]) : 0u};
                      Wf[rb][sp] = __builtin_bit_cast(bf16x8, pkw); } } }
            const int npair = (nkmax + 63) >> 6;
            const bf16_t* kbase = KI + ((size_t)b * T + c) * 64 + 8 * hh;
            bf16x8 kb[2][4], kn[2][4];
            auto ldk = [&](bf16x8 (&dst)[2][4], int pr) {
#pragma unroll
                for (int tt = 0; tt < 2; ++tt) { int key0 = 64 * pr + 32 * tt; if (key0 + 31 >= T) key0 = T - 32;
#pragma unroll
                    for (int s = 0; s < 4; ++s) dst[tt][s] = *(const bf16x8*)(kbase + (size_t)key0 * 64 + 16 * s); } };
            if (w < npair) ldk(kb, w);
#pragma unroll 1
            for (int pr = w; pr < npair; pr += 8) {
                if (pr + 8 < npair) ldk(kn, pr + 8);
#pragma unroll
                for (int tt = 0; tt < 2; ++tt) {
                    const int key = 64 * pr + 32 * tt + c;
                    f32x16 a0, a1; const f32x16 z16 = {0.f, 0.f, 0.f, 0.f, 0.f, 0.f, 0.f, 0.f, 0.f, 0.f, 0.f, 0.f, 0.f, 0.f, 0.f, 0.f};
#pragma unroll
                    for (int s = 0; s < 4; ++s) { a0 = MFMA32(qa[0][s], kb[tt][s], s == 0 ? z16 : a0); a1 = MFMA32(qa[1][s], kb[tt][s], s == 0 ? z16 : a1); }
#pragma unroll
                    for (int i = 0; i < 16; ++i) { a0[i] = fmaxf(a0[i], 0.f); a1[i] = fmaxf(a1[i], 0.f); }
                    f32x16 d2 = MFMA32(Wf[0][0], pack_p(a0, 0), z16);
                    d2 = MFMA32(Wf[0][1], pack_p(a0, 1), d2); d2 = MFMA32(Wf[1][0], pack_p(a1, 0), d2); d2 = MFMA32(Wf[1][1], pack_p(a1, 1), d2);
                    if (key < 8192) {
#pragma unroll
                        for (int qq = 0; qq < 4; ++qq) sc[(4 * hh + qq) * 8192 + key] = f16key(d2[qq]); }
                }
#pragma unroll
                for (int tt = 0; tt < 2; ++tt)
#pragma unroll
                    for (int s = 0; s < 4; ++s) kb[tt][s] = kn[tt][s];
            }
        }
        __syncthreads();
        if (nk <= 256) { for (int i = lane; i < 256; i += 64) out[i] = (unsigned short)(i < nk ? i : 0); if (lane == 0) NSEL[tok] = nk; }
        else { for (int rs_ = 0; rs_ < IDX_REP_SEL; ++rs_) topk256_hist(sc + w * 8192, nk, hist, out, lane); if (lane == 0) NSEL[tok] = 256; }
        __syncthreads();
    }
}

#define MFMA16(a, b, c) __builtin_amdgcn_mfma_f32_16x16x32_bf16((a), (b), (c), 0, 0, 0)
#define MLA_ROW 592
#define MLA_TR8(R, BASE, OFF) asm volatile( \
    "ds_read_b64_tr_b16 %0, %8 offset:%9\n\tds_read_b64_tr_b16 %1, %8 offset:%10\n\tds_read_b64_tr_b16 %2, %8 offset:%11\n\tds_read_b64_tr_b16 %3, %8 offset:%12\n\t" \
    "ds_read_b64_tr_b16 %4, %8 offset:%13\n\tds_read_b64_tr_b16 %5, %8 offset:%14\n\tds_read_b64_tr_b16 %6, %8 offset:%15\n\tds_read_b64_tr_b16 %7, %8 offset:%16\n\ts_waitcnt lgkmcnt(0)" \
    : "=&v"(R[0]), "=&v"(R[1]), "=&v"(R[2]), "=&v"(R[3]), "=&v"(R[4]), "=&v"(R[5]), "=&v"(R[6]), "=&v"(R[7]) \
    : "v"(BASE), "i"(OFF), "i"((OFF) + 16 * MLA_ROW), "i"((OFF) + 32), "i"((OFF) + 32 + 16 * MLA_ROW), "i"((OFF) + 64), "i"((OFF) + 64 + 16 * MLA_ROW), "i"((OFF) + 96), "i"((OFF) + 96 + 16 * MLA_ROW) : "memory")
DI void phase_mla_mfma(const Params& p, char* smem) {
    const int tid = tid_fresh(), lane = tid & 63, w = __builtin_amdgcn_readfirstlane(tid >> 6), fr = lane & 15, g = lane >> 4;
    LAS char* buf = (LAS char*)smem + w * (32 * MLA_ROW);
    const unsigned lbase = (unsigned)(size_t)buf;
    const bf16_t* Q = (const bf16_t*)(p.ws + O_QALL); const bf16_t* KV = (const bf16_t*)(p.ws + O_KVT);
    const unsigned short* SEL = (const unsigned short*)(p.ws + O_SEL); const int* NSEL = (const int*)(p.ws + O_NSEL); bf16_t* OL = (bf16_t*)(p.ws + O_OLAT);
    constexpr float C2 = ATT_SCALE * 1.4426950408889634f;
    int pf_cnt = 0, pf_s0 = 0, pf_s1 = 0;
    { const int tok = blockIdx.x * 8 + w; if (tok < NT) { pf_cnt = NSEL[tok]; if (lane < 32) { pf_s0 = SEL[(size_t)tok * 256 + lane]; pf_s1 = SEL[(size_t)tok * 256 + 32 + lane]; } } }
#pragma unroll 1
    for (int tok = blockIdx.x * 8 + w; tok < NT; tok += gridDim.x * 8) {
        const int b = tok >> 13; const int cnt = pf_cnt; const int cur_s0 = pf_s0, cur_s1 = pf_s1;
        { const int tn = tok + gridDim.x * 8; if (tn < NT) { pf_cnt = NSEL[tn]; if (lane < 32) { pf_s0 = SEL[(size_t)tn * 256 + lane]; pf_s1 = SEL[(size_t)tn * 256 + 32 + lane]; } } }
        bf16x8 qf[9];
        { const bf16_t* qr = Q + (size_t)tok * QC; const bf16x8 z8 = {0, 0, 0, 0, 0, 0, 0, 0};
#pragma unroll
          for (int s = 0; s < 8; ++s) qf[s] = fr < 8 ? *(const bf16x8*)(qr + fr * 256 + 32 * s + 8 * g) : z8;
          qf[8] = fr < 8 ? *(const bf16x8*)(qr + 2048 + fr * 32 + 8 * g) : z8;
          {
              const float* rt = (const float*)(p.ws + O_ROPE) + (size_t)tok * 48;
              const u32x4 own = __builtin_bit_cast(u32x4, qf[8]); u32x4 oth;
#pragma unroll
              for (int k = 0; k < 4; ++k) oth[k] = (unsigned)__shfl_xor((int)own[k], 32);
              float xa[8], xb[8], xr[8]; unpack8(own, xa); unpack8(oth, xb);
#pragma unroll
              for (int j = 0; j < 8; ++j) { const int fi = 8 * (g & 1) + j; const float cs = rt[2 * fi], sn = rt[2 * fi + 1]; xr[j] = g < 2 ? xa[j] * cs - xb[j] * sn : xa[j] * cs + xb[j] * sn; }
              const u32x4 pk = {pk2(xr[0], xr[1]), pk2(xr[2], xr[3]), pk2(xr[4], xr[5]), pk2(xr[6], xr[7])};
              qf[8] = __builtin_bit_cast(bf16x8, pk); } }
        f32x4 O[16];
#pragma unroll
        for (int d = 0; d < 16; ++d) O[d] = (f32x4){0.f, 0.f, 0.f, 0.f};
        float m = -INFINITY, l = 0.f;
        const int nchunk = (cnt + 31) >> 5;
        u32x4 st[18]; int selv_n = 0;
        const bf16_t* kvb = KV + (size_t)b * T * KVW;
        auto issue = [&](int selv, int lz) {
#pragma unroll
            for (int i = 0; i < 16; ++i) { const int r0 = __builtin_amdgcn_readlane(selv, 2 * i), r1 = __builtin_amdgcn_readlane(selv, 2 * i + 1); const int row = lz < 32 ? r0 : r1;
                st[i] = *(const u32x4*)(kvb + (size_t)row * KVW + (lz & 31) * 8); }
#pragma unroll
            for (int i = 0; i < 2; ++i) { const int row = __shfl(selv, 16 * i + (lz >> 2)); st[16 + i] = *(const u32x4*)(kvb + (size_t)row * KVW + 256 + (lz & 3) * 8); } };
        { int lz = lane; asm volatile("" : "+v"(lz));
          int selv = 0; if (lz < 32 && lz < cnt) selv = cur_s0;
          if (lz < 32 && 32 + lz < cnt) selv_n = cur_s1;
          issue(selv, lz); }
#pragma unroll 1
        for (int ch = 0; ch < nchunk; ++ch) {
            int lz = lane; asm volatile("" : "+v"(lz));
#pragma unroll
            for (int i = 0; i < 16; ++i) *(LAS u32x4*)(buf + (2 * i + (lz >> 5)) * MLA_ROW + (lz & 31) * 16) = st[i];
#pragma unroll
            for (int i = 0; i < 2; ++i) *(LAS u32x4*)(buf + (16 * i + (lz >> 2)) * MLA_ROW + 512 + (lz & 3) * 16) = st[16 + i];
            if (ch + 1 < nchunk) {
                const int selv = selv_n; selv_n = 0;
                { const int k = (ch + 2) * 32 + lz; if (lz < 32 && k < cnt) selv_n = SEL[(size_t)tok * 256 + k]; }
                issue(selv, lz); }
            asm volatile("s_waitcnt lgkmcnt(0)" ::: "memory");
            const int frz = lz & 15, gz = lz >> 4;
            f32x4 s0, s1; const f32x4 z4 = {0.f, 0.f, 0.f, 0.f};
#pragma unroll
            for (int s = 0; s < 9; ++s) { const bf16x8 a0 = *(const LAS bf16x8*)(buf + frz * MLA_ROW + (32 * s + 8 * gz) * 2), a1 = *(const LAS bf16x8*)(buf + (frz + 16) * MLA_ROW + (32 * s + 8 * gz) * 2);
                s0 = MFMA16(a0, qf[s], s == 0 ? z4 : s0); s1 = MFMA16(a1, qf[s], s == 0 ? z4 : s1); }
            float mx = -INFINITY;
#pragma unroll
            for (int j = 0; j < 4; ++j) { if (ch * 32 + 4 * gz + j >= cnt) s0[j] = -INFINITY; if (ch * 32 + 16 + 4 * gz + j >= cnt) s1[j] = -INFINITY; mx = fmaxf(mx, fmaxf(s0[j], s1[j])); }
            mx = fmaxf(mx, __shfl_xor(mx, 16)); mx = fmaxf(mx, __shfl_xor(mx, 32));
            const float mn = fmaxf(m, mx), mu = (mn == -INFINITY) ? 0.f : mn;
            const float alpha = __builtin_amdgcn_exp2f((m - mu) * C2);
            float rs = 0.f;
#pragma unroll
            for (int j = 0; j < 4; ++j) { s0[j] = __builtin_amdgcn_exp2f((s0[j] - mu) * C2); s1[j] = __builtin_amdgcn_exp2f((s1[j] - mu) * C2); rs += s0[j] + s1[j]; }
            rs += __shfl_xor(rs, 16); rs += __shfl_xor(rs, 32);
            l = l * alpha + rs; m = mn;
            if (!__all(alpha == 1.f)) {
#pragma unroll
                for (int d = 0; d < 16; ++d) O[d] *= alpha; }
            const u32x4 pw = {cvt2(s0[0], s0[1]), cvt2(s0[2], s0[3]), cvt2(s1[0], s1[1]), cvt2(s1[2], s1[3])};
            const bf16x8 pf = __builtin_bit_cast(bf16x8, pw);
            const unsigned tb = lbase + (unsigned)(4 * gz + (frz >> 2)) * MLA_ROW + 8u * (frz & 3);
#pragma unroll
            for (int dq = 0; dq < 4; ++dq) { s16x4 R[8];
                if (dq == 0) MLA_TR8(R, tb, 0); else if (dq == 1) MLA_TR8(R, tb, 128); else if (dq == 2) MLA_TR8(R, tb, 256); else MLA_TR8(R, tb, 384);
#pragma unroll
                for (int d = 0; d < 4; ++d) { const bf16x8 vf = __builtin_shufflevector(R[2 * d], R[2 * d + 1], 0, 1, 2, 3, 4, 5, 6, 7); O[4 * dq + d] = MFMA16(vf, pf, O[4 * dq + d]); } }
            asm volatile("s_waitcnt lgkmcnt(0)" ::: "memory");
        }
        const float il16 = pg8::A8_SCALE / fmaxf(l, 1e-30f);
        if (fr < 8) {
#pragma unroll
            for (int d = 0; d < 16; ++d) *(unsigned*)((unsigned char*)OL + (size_t)tok * D + fr * 256 + 16 * d + 4 * g) = pg8::fp8x4(O[d][0] * il16, O[d][1] * il16, O[d][2] * il16, O[d][3] * il16); }
    }
}

DI void phase_post_mix(const Params& p, char* smem, bool count) {
    const int tz_ = tid_fresh(); const int lane = tz_ & 63, wid = __builtin_amdgcn_readfirstlane(tz_ >> 6);
    float* part = (float*)smem;
    int* lcnt = (int*)(smem + 8 * 32 * 33 * 4);
    const bf16_t* MO = (const bf16_t*)(p.ws + O_MO); float* X1 = (float*)(p.ws + O_X1); bf16_t* H = (bf16_t*)(p.ws + O_H); const bf16_t* WR = (const bf16_t*)(p.ws + O_WRT);
    int* TOPI = (int*)(p.ws + O_TOPI); float* TOPW = (float*)(p.ws + O_TOPW); int* cnts = (int*)(p.ws + O_CNT);
    float* cvec = (float*)(smem + 36864);
#pragma unroll 1
    for (int ck = blockIdx.x; ck < NT / 64; ck += gridDim.x) {
        {   const int b = (ck * 64) >> 13;
            __syncthreads();
            *(f32x4*)(cvec + 4 * tz_) = *(const f32x4*)((const float*)(p.ws + O_MODACC) + b * 12288 + 4096 + 4 * tz_);
            *(f32x4*)(cvec + 2048 + 4 * tz_) = *(const f32x4*)(p.g_post_mix + 4 * tz_);
            *(f32x4*)(cvec + 4096 + 4 * tz_) = *(const f32x4*)(p.g_pre_ffn + 4 * tz_);
            *(f32x4*)(cvec + 6144 + 4 * tz_) = *(const f32x4*)((const float*)(p.ws + O_MODACC) + b * 12288 + 4 * 2048 + 4 * tz_);
            *(f32x4*)(cvec + 8192 + 4 * tz_) = *(const f32x4*)((const float*)(p.ws + O_MODACC) + b * 12288 + 3 * 2048 + 4 * tz_);
            __syncthreads(); }
#pragma unroll 1
        for (int j = 0; j < 8; ++j) {
            const int tok = ck * 64 + wid * 8 + j;
            u32x2 mo[8]; f32x4 xr[8];
#pragma unroll
            for (int i = 0; i < 8; ++i) { mo[i] = *(const u32x2*)(MO + (size_t)tok * D + 4 * (lane + 64 * i)); xr[i] = *(const f32x4*)(p.x + (size_t)tok * D + 4 * (lane + 64 * i)); }
            float v[32]; float ss = 0.f;
#pragma unroll
            for (int i = 0; i < 8; ++i) { const u32x2 w = mo[i];
                v[4 * i] = bflo(w[0]); v[4 * i + 1] = bfhi(w[0]); v[4 * i + 2] = bflo(w[1]); v[4 * i + 3] = bfhi(w[1]); }
#pragma unroll
            for (int i = 0; i < 32; ++i) ss += v[i] * v[i];
            const float rs = rsqrtf(wave_sum(ss) * (1.f / D) + NORM_EPS);
            float ss2 = 0.f;
#pragma unroll
            for (int i = 0; i < 8; ++i) { const int col = 4 * (lane + 64 * i); const f32x4 xv = xr[i], mg = *(const f32x4*)(cvec + col), gp = *(const f32x4*)(cvec + 2048 + col); f32x4 o;
#pragma unroll
                for (int q = 0; q < 4; ++q) { o[q] = xv[q] + mg[q] * (v[4 * i + q] * rs * gp[q]); v[4 * i + q] = o[q]; ss2 += o[q] * o[q]; }
                *(f32x4*)(X1 + (size_t)tok * D + col) = o; }
            const float rs2 = rsqrtf(wave_sum(ss2) * (1.f / D) + NORM_EPS);
#pragma unroll
            for (int i = 0; i < 8; ++i) { const int col = 4 * (lane + 64 * i); const f32x4 gf = *(const f32x4*)(cvec + 4096 + col), ms = *(const f32x4*)(cvec + 6144 + col), mh = *(const f32x4*)(cvec + 8192 + col); f32x4 hv;
#pragma unroll
                for (int q = 0; q < 4; ++q) hv[q] = v[4 * i + q] * rs2 * gf[q] * (1.f + ms[q]) + mh[q];
                *(u32x2*)(H + (size_t)tok * D + col) = (u32x2){pk2(hv[0], hv[1]), pk2(hv[2], hv[3])}; }
        }
        asm volatile("s_waitcnt vmcnt(0)" ::: "memory");
        __syncthreads();
        if (tz_ < 32) lcnt[tz_] = 0;
        {
            const int c = lane & 31, hh = lane >> 5, rb = wid & 1, ks = wid >> 1;
            const bf16_t* ap = H + (size_t)(ck * 64 + 32 * rb + c) * D + 512 * ks + 8 * hh; const bf16_t* bp = WR + (size_t)c * D + 512 * ks + 8 * hh;
            f32x16 acc;
#pragma unroll
            for (int i = 0; i < 16; ++i) acc[i] = 0.f;
#pragma unroll 8
            for (int sx = 0; sx < 32; ++sx) { const bf16x8 a = *(const bf16x8*)(ap + 16 * sx), bb = *(const bf16x8*)(bp + 16 * sx); acc = MFMA32(a, bb, acc); }
#pragma unroll
            for (int r = 0; r < 16; ++r) part[(wid * 32 + (r & 3) + 8 * (r >> 2) + 4 * hh) * 33 + c] = acc[r];
        }
        __syncthreads();
        if (tz_ < 64) {
            const int rbt = tz_ >> 5, row = tz_ & 31, tok = ck * 64 + tz_;
            float lg[32];
#pragma unroll
            for (int e = 0; e < 32; ++e) lg[e] = p.b_router[e] + part[((0 * 2 + rbt) * 32 + row) * 33 + e] + part[((1 * 2 + rbt) * 32 + row) * 33 + e] + part[((2 * 2 + rbt) * 32 + row) * 33 + e] + part[((3 * 2 + rbt) * 32 + row) * 33 + e];
            int te[4]; float tv[4];
#pragma unroll
            for (int k = 0; k < 4; ++k) { float mx = lg[0]; int bi = 0;
#pragma unroll
                for (int e = 1; e < 32; ++e) if (lg[e] > mx) { mx = lg[e]; bi = e; }
                te[k] = bi; tv[k] = mx;
#pragma unroll
                for (int e = 0; e < 32; ++e) if (e == bi) lg[e] = -INFINITY; }
            const float e1 = __expf(tv[1] - tv[0]), e2 = __expf(tv[2] - tv[0]), e3 = __expf(tv[3] - tv[0]); const float inv = 1.f / (1.f + e1 + e2 + e3);
            *(int4*)(TOPI + tok * 4) = make_int4(te[0], te[1], te[2], te[3]);
            *(f32x4*)(TOPW + tok * 4) = (f32x4){inv, e1 * inv, e2 * inv, e3 * inv};
            atomicAdd(lcnt + te[0], 1); atomicAdd(lcnt + te[1], 1); atomicAdd(lcnt + te[2], 1); atomicAdd(lcnt + te[3], 1);
        }
        __syncthreads();
        if (count && tz_ < 32) atomicAdd(cnts + tz_, lcnt[tz_]);
    }
}

DI int moe_tables(const Params& p, LAS int* tile_e, LAS int* pstart) {
    int* cnts = (int*)(p.ws + O_CNT);
    if (threadIdx.x < 64) {
        const int e = threadIdx.x & 31;
        const int c = __hip_atomic_load(cnts + e, __ATOMIC_RELAXED, __HIP_MEMORY_SCOPE_AGENT);
        const int nt = (c + 255) >> 8; int inc = nt;
#pragma unroll
        for (int o = 1; o < 32; o <<= 1) { const int v = __shfl_up(inc, o, 32); if (e >= o) inc += v; }
        const int start = inc - nt;
        if (threadIdx.x < 32) { pstart[e] = start * 256; for (int i = 0; i < nt; ++i) tile_e[start + i] = e; if (e == 31) pstart[NEXP] = inc; } }
    __syncthreads();
    return pstart[NEXP];
}
DI void phase_moe_gather(const Params& p, char* smem) {
    const int tz_ = tid_fresh(); const int lane = tz_ & 63, wid = __builtin_amdgcn_readfirstlane(tz_ >> 6);
    LAS int* tile_e = (LAS int*)(LAS char*)smem; LAS int* pstart = tile_e + 320; LAS int* lcnt = pstart + 40; LAS int* lbase = lcnt + 32;
    (void)moe_tables(p, tile_e, pstart);
    const bf16_t* H = (const bf16_t*)(p.ws + O_H); unsigned char* HS = (unsigned char*)(p.ws + O_HS);
    const int* TOPI = (const int*)(p.ws + O_TOPI); const float* TOPW = (const float*)(p.ws + O_TOPW); int* TSLOT = (int*)(p.ws + O_TSLOT); float* SLOTW = (float*)(p.ws + O_SLOTW);
    int* fill = (int*)(p.ws + O_CNT) + 32;
#pragma unroll 1
    for (int ck = blockIdx.x; ck < NT / 64; ck += gridDim.x) {
        const int tok0 = ck * 64 + wid * 8;
        __syncthreads();
        if (tz_ < 32) lcnt[tz_] = 0;
        __syncthreads();
        int e = 0, rank = 0;
        if (lane < 32) { e = TOPI[tok0 * 4 + lane]; rank = atomicAdd((int*)(lcnt + e), 1); }
        __syncthreads();
        if (tz_ < 32) lbase[tz_] = atomicAdd(fill + tz_, lcnt[tz_]);
        __syncthreads();
        int slot = 0;
        if (lane < 32) { slot = pstart[e] + lbase[e] + rank; TSLOT[tok0 * 4 + lane] = slot; SLOTW[slot] = TOPW[tok0 * 4 + lane]; }
#pragma unroll 2
        for (int j = 0; j < 8; ++j) { u32x2 hv[4];
#pragma unroll
            for (int i = 0; i < 4; ++i) { float f[8]; unpack8(*(const u32x4*)(H + (size_t)(tok0 + j) * D + 8 * (lane + 64 * i)), f);
                hv[i] = (u32x2){pg8::fp8x4(f[0], f[1], f[2], f[3]), pg8::fp8x4(f[4], f[5], f[6], f[7])}; }
#pragma unroll
            for (int k = 0; k < 4; ++k) { const int sl = __shfl(slot, j * 4 + k);
#pragma unroll
                for (int i = 0; i < 4; ++i) *(u32x2*)(HS + (size_t)sl * D + 8 * (lane + 64 * i)) = hv[i]; } }
    }
}
DI void phase_final(const Params& p) {
    const int tz_ = tid_fresh(); const int lane = tz_ & 63, wid = __builtin_amdgcn_readfirstlane(tz_ >> 6);
    const unsigned char* YS = (const unsigned char*)(p.ws + O_YS); const float* X1 = (const float*)(p.ws + O_X1); const int* TSLOT = (const int*)(p.ws + O_TSLOT);
    for (int tok = blockIdx.x * 8 + wid; tok < NT; tok += gridDim.x * 8) {
        const int b = tok >> 13; float v[32];
#pragma unroll
        for (int i = 0; i < 32; ++i) v[i] = 0.f;
#pragma unroll
        for (int k = 0; k < 4; ++k) { const int slot = TSLOT[tok * 4 + k];
#pragma unroll
            for (int i = 0; i < 8; ++i) { const unsigned w = *(const unsigned*)(YS + (size_t)slot * D + 4 * (lane + 64 * i));
                const auto lo = __builtin_amdgcn_cvt_pk_f32_fp8((int)w, false), hi = __builtin_amdgcn_cvt_pk_f32_fp8((int)w, true);
                v[4 * i] += lo[0]; v[4 * i + 1] += lo[1]; v[4 * i + 2] += hi[0]; v[4 * i + 3] += hi[1]; } }
#pragma unroll
        for (int i = 0; i < 32; ++i) v[i] *= pg8::Y8_INV;
        float ss = 0.f;
#pragma unroll
        for (int i = 0; i < 32; ++i) ss += v[i] * v[i];
        const float rs = rsqrtf(wave_sum(ss) * (1.f / D) + NORM_EPS);
#pragma unroll
        for (int i = 0; i < 8; ++i) { const int col = 4 * (lane + 64 * i); const f32x4 xv = *(const f32x4*)(X1 + (size_t)tok * D + col); f32x4 o;
#pragma unroll
            for (int j = 0; j < 4; ++j) o[j] = xv[j] + mod_at(p, b, 5 * 2048 + col + j) * (v[4 * i + j] * rs * p.g_post_ffn[col + j]);
            *(f32x4*)(p.out + (size_t)tok * D + col) = o; }
    }
}

#ifndef PHMASK
#define PHMASK 0xFFFFFFFFu
#endif
#define PHON(ph) (((PHMASK) >> (ph)) & 1u)
#ifndef REPMASK
#define REPMASK 0u
#endif
#define REP(ph) _Pragma("unroll 1") for (int rep_ = 0; rep_ <= (int)(((REPMASK) >> (ph)) & 1u); ++rep_)
enum { PH_PREP = 0, PH_H1, PH_GIN, PH_ZPOST, PH_GQ, PH_QROPE, PH_IDX, PH_MLA, PH_NSA, PH_MERGE, PH_GOUT, PH_POSTMIX, PH_GATHER, PH_GU, PH_DN, PH_FINAL, PH_END };

__global__ void __launch_bounds__(512, 2) mega(Params p, int lo, int hi) {
    extern __shared__ __attribute__((aligned(16))) char smem[];
    LAS unsigned char* lds = (LAS unsigned char*)(LAS char*)smem;
    volatile LAS unsigned* xbw = (volatile LAS unsigned*)(LAS char*)(smem + LDS_BYTES - 16);
    XcdBarrier bar; bar.bar = (unsigned*)p.ws; bar.x = 0; bar.st = xbw;
    if (hi - lo > 1) { if (threadIdx.x == 0) { xbw[0] = 0u; xbw[1] = 0u; } __syncthreads(); bar = xcd_barrier_post((unsigned*)p.ws, xbw); }
    const int G = gridDim.x, c = blockIdx.x;
#define SEAM(ph) if ((ph) + 1 < hi) xcd_barrier(bar);
    if (PHON(PH_PREP) && lo <= PH_PREP && PH_PREP < hi) { REP(PH_PREP) { phase_prep(p, smem); } SEAM(PH_PREP) }
    if (PHON(PH_H1) && lo <= PH_H1 && PH_H1 < hi) { REP(PH_H1) { phase_h1(p); } SEAM(PH_H1) }
    if (PHON(PH_GIN) && lo <= PH_GIN && PH_GIN < hi) { REP(PH_GIN) {
        { pg8::PlainSched S; S.init(NT, 2048, G, c, p.ws + O_H, D, p.ws + O_WIN, D);
          pg8::EpiBf16 E; E.O = (bf16_t*)(p.ws + O_Z); E.ldc = ZC; E.scale = 1.f;
          pg8::gemm_phase(lds, pg8::Gemm{D, D, D}, S, E); }
        { pg8::PlainSched S; S.init(NT, ZC - 2048, G, c, p.ws + O_H8, D / 2, p.ws + O_WIN8 + (size_t)2048 * D, D / 2);
          pg8::EpiBf16 E; E.O = (bf16_t*)(p.ws + O_Z) + 2048; E.ldc = ZC; E.scale = pg8::W8_INV;
          pg8::gemm_phase_fp8(lds, pg8::Gemm{D / 2, D / 2, D / 2}, S, E); }
        } SEAM(PH_GIN) }
    if (PHON(PH_ZPOST) && lo <= PH_ZPOST && PH_ZPOST < hi) { REP(PH_ZPOST) { phase_zpost(p); } SEAM(PH_ZPOST) }
    if (PHON(PH_GQ) && lo <= PH_GQ && PH_GQ < hi) { REP(PH_GQ) {
        { pg8::PlainSched S; S.init(NT, QC, G, c, p.ws + O_CQN, 512, p.ws + O_WQ, 512);
          pg8::EpiBf16 E; E.O = (bf16_t*)(p.ws + O_QALL); E.ldc = QC; E.scale = 1.f;
          pg8::gemm_phase(lds, pg8::Gemm{512, 512, 512}, S, E); }
        { pg8::C1Sched S; S.G = G; S.c = c; S.kvs = p.ws + O_KVS; S.w = p.ws + O_WC1;
          pg8::EpiC1 E; E.C = (float*)(p.ws + O_C1P);
          pg8::gemm_phase(lds, pg8::Gemm{2048, 4096, 256}, S, E); }
        } SEAM(PH_GQ) }
    if (PHON(PH_IDX) && lo <= PH_IDX && PH_IDX < hi) { REP(PH_IDX) {
#ifdef IDX_NAIVE
        phase_indexer(p, smem);
#else
        phase_indexer_mfma(p, smem);
#endif
        } SEAM(PH_IDX) }
    if (PHON(PH_MLA) && lo <= PH_MLA && PH_MLA < hi) { REP(PH_MLA) {
#ifdef MLA_NAIVE
        phase_mla(p, smem);
#else
        phase_mla_mfma(p, smem);
#endif
        } SEAM(PH_MLA) }
    if (PHON(PH_NSA) && lo <= PH_NSA && PH_NSA < hi) { REP(PH_NSA) {
#ifdef NSA_NAIVE
        phase_nsa(p, smem);
#else
        phase_nsa_mfma(p, smem);
#endif
        } SEAM(PH_NSA) }
    if (PHON(PH_MERGE) && lo <= PH_MERGE && PH_MERGE < hi) { REP(PH_MERGE) {
        { pg8::PlainSched S; S.init(NT, D, G, c, p.ws + O_OLAT, D / 2, p.ws + O_WO, D / 2);
          pg8::EpiMerge<false> E; E.P = (bf16_t*)(p.ws + O_MERGED); E.O8 = nullptr; E.Z = (const bf16_t*)(p.ws + O_Z); E.gcol0 = ZC_MG; E.scale = pg8::A8W8_INV;
          pg8::gemm_phase_fp8(lds, pg8::Gemm{D / 2, D / 2, D / 2}, S, E); }
        { pg8::PlainSched S; S.init(NT, D, G, c, p.ws + O_OB8, 512, p.ws + O_WBRB, 512);
          pg8::EpiMerge<true> E; E.P = (bf16_t*)(p.ws + O_MERGED); E.O8 = (unsigned char*)(p.ws + O_MG8); E.Z = (const bf16_t*)(p.ws + O_Z); E.gcol0 = ZC_MG + 2048; E.scale = pg8::A8W8_INV;
          pg8::gemm_phase_fp8(lds, pg8::Gemm{512, 512, 512}, S, E); }
        } SEAM(PH_MERGE) }
    if (PHON(PH_GOUT) && lo <= PH_GOUT && PH_GOUT < hi) { REP(PH_GOUT) {
        pg8::PlainSched S; S.init(NT, D, G, c, p.ws + O_MG8, D / 2, p.ws + O_WOUT, D / 2);
        pg8::EpiBf16 E; E.O = (bf16_t*)(p.ws + O_MO); E.ldc = D; E.scale = pg8::A8W8_INV;
        pg8::gemm_phase_fp8(lds, pg8::Gemm{D / 2, D / 2, D / 2}, S, E); } SEAM(PH_GOUT) }
    if (PHON(PH_POSTMIX) && lo <= PH_POSTMIX && PH_POSTMIX < hi) { REP(PH_POSTMIX) { phase_post_mix(p, smem, rep_ == 0); } SEAM(PH_POSTMIX) }
    if (PHON(PH_GATHER) && lo <= PH_GATHER && PH_GATHER < hi) { REP(PH_GATHER) { phase_moe_gather(p, smem); } SEAM(PH_GATHER) }
    if (PHON(PH_GU) && lo <= PH_GU && PH_GU < hi) { REP(PH_GU) {
        LAS int* tile_e = (LAS int*)(LAS char*)(smem + 131072); LAS int* pstart = tile_e + 320;
        const int mt = moe_tables(p, tile_e, pstart);
        pg8::MoeSched S; S.G = G; S.c = c; S.nN = 16; S.total = mt * 16; S.tile_e = tile_e; S.A = p.ws + O_HS; S.W = p.ws + O_WGU; S.w_exp = (size_t)4096 * D;
        pg8::EpiGU E; E.O = (unsigned char*)(p.ws + O_ACT); E.bias = p.b_gate_up;
        pg8::gemm_phase_fp8(lds, pg8::Gemm{D / 2, D / 2, D / 2, 64, 16384}, S, E); } SEAM(PH_GU) }
    if (PHON(PH_DN) && lo <= PH_DN && PH_DN < hi) { REP(PH_DN) {
        LAS int* tile_e = (LAS int*)(LAS char*)(smem + 131072); LAS int* pstart = tile_e + 320;
        const int mt = moe_tables(p, tile_e, pstart);
        pg8::MoeSched S; S.G = G; S.c = c; S.nN = 8; S.total = mt * 8; S.tile_e = tile_e; S.A = p.ws + O_ACT; S.W = p.ws + O_WDN; S.w_exp = (size_t)D * D;
        pg8::EpiDN E; E.O = (unsigned char*)(p.ws + O_YS); E.bias = p.b_down; E.slotw = (const float*)(p.ws + O_SLOTW);
        pg8::gemm_phase_fp8(lds, pg8::Gemm{D / 2, D / 2, D / 2, 64, 16384}, S, E); } SEAM(PH_DN) }
    if (PHON(PH_FINAL) && lo <= PH_FINAL && PH_FINAL < hi) { REP(PH_FINAL) { phase_final(p); } }
#undef SEAM
}

extern "C" void kernel_launch(void* const* d_in, const int* in_sizes, int n_in, void* d_out, int out_size, void* d_ws, size_t ws_size, hipStream_t stream) {
    static int grid = 0;
    if (grid == 0) {
        if (n_in != 33 || out_size != NT * D || ws_size < WS_END) { fprintf(stderr, "kernel_launch: unexpected shapes (n_in %d out %d ws %zu need %zu)\n", n_in, out_size, ws_size, (size_t)WS_END); grid = -1; return; }
        int dev = 0, cus = 0;
        if (hipGetDevice(&dev) != hipSuccess || hipDeviceGetAttribute(&cus, hipDeviceAttributeMultiprocessorCount, dev) != hipSuccess) { grid = -1; return; }
        if (hipFuncSetAttribute((const void*)mega, hipFuncAttributeMaxDynamicSharedMemorySize, LDS_BYTES) != hipSuccess) { fprintf(stderr, "kernel_launch: hipFuncSetAttribute failed\n"); grid = -1; return; }
        int per_cu = 0; (void)hipOccupancyMaxActiveBlocksPerMultiprocessor(&per_cu, (const void*)mega, 512, LDS_BYTES); (void)hipGetLastError();
        grid = cus;
    }
    if (grid < 0) return;
    Params p{};
    const float** pf = (const float**)&p;
    for (int i = 0; i < 33; ++i) pf[i] = (const float*)d_in[i];
    p.pos = (const int*)d_in[2];
    p.out = (float*)d_out; p.ws = (char*)d_ws;
    hipMemsetAsync(d_ws, 0, ZERO_BYTES, stream);
#ifdef MK_UNFUSED
    for (int ph = 0; ph < PH_END; ++ph) hipLaunchKernelGGL(mega, dim3(grid), dim3(512), LDS_BYTES, stream, p, ph, ph + 1);
#else
    hipLaunchKernelGGL(mega, dim3(grid), dim3(512), LDS_BYTES, stream, p, 0, (int)PH_END);
#endif
}
```

```cpp
#include <hip/hip_runtime.h>
#include <stdint.h>
#include <stdio.h>

#define LAS __attribute__((address_space(3)))
#define DI __device__ __forceinline__
typedef unsigned short bf16_t;
typedef short bf16x8 __attribute__((ext_vector_type(8)));
typedef float f32x4 __attribute__((ext_vector_type(4)));
typedef unsigned u32x4 __attribute__((ext_vector_type(4)));
typedef unsigned u32x2 __attribute__((ext_vector_type(2)));

#define PREP_PROBE_WC 0
#define PREP_PROBE_MODE 0
#define PREP_REP 0
#define SEL_REP 0
#define PREP_REP_LO 0
#define PREP_REP_HI 100000
#define PREP_PROBE_NFAST 0
constexpr int NB = 2, T = 8192, NT = NB * T, D = 2048;
constexpr int ZC = 7680;
constexpr int ZC_CKV = 512, ZC_KROPE = 768, ZC_KIDX = 800, ZC_WIDX = 864, ZC_BGATE = 872, ZC_BQ = 1024, ZC_MG = 3584;
constexpr int QC = 2816;
constexpr int KVW = 288;
constexpr int NEXP = 32, SLOTS = 73728, MAXMT = SLOTS / 256;
constexpr float NORM_EPS = 1e-6f;
constexpr float ATT_SCALE = 0.08838834764831845f;
constexpr int LDS_BYTES = 152 * 1024;

constexpr size_t al256(size_t x) { return (x + 255) & ~(size_t)255; }
constexpr size_t ZERO_BYTES = 131072;
constexpr size_t O_MODACC = 16384, O_CNT = 114688;
constexpr size_t O_ROPE = ZERO_BYTES;
constexpr size_t O_WIN = O_ROPE + al256((size_t)NT * 48 * 4);
constexpr size_t O_WQ = O_WIN + al256((size_t)ZC * D * 2);
constexpr size_t O_WO = O_WQ + al256((size_t)QC * 512 * 2);
constexpr size_t O_WBRB = O_WO + al256((size_t)D * D * 2);
constexpr size_t O_WOUT = O_WBRB + al256((size_t)D * 1024 * 2);
constexpr size_t O_WC1 = O_WOUT + al256((size_t)D * D * 2);
constexpr size_t O_CBIAS = O_WC1 + al256((size_t)2 * 256 * 4096 * 2);
constexpr size_t O_CBP = O_CBIAS + al256(2 * 256 * 4);
constexpr size_t O_WRT = O_CBP + al256(64 * 2 * 256 * 4);
constexpr size_t O_WGU = O_WRT + al256((size_t)256 * D * 2);
constexpr size_t O_WDN = O_WGU + al256((size_t)NEXP * 4096 * D * 2);
constexpr size_t O_H = O_WDN + al256((size_t)NEXP * D * D * 2);
constexpr size_t O_Z = O_H + al256((size_t)NT * D * 2);
constexpr size_t O_CQN = O_Z + al256((size_t)NT * ZC * 2);
constexpr size_t O_KVT = O_CQN + al256((size_t)NT * 512 * 2);
constexpr size_t O_KIDX = O_KVT + al256((size_t)NT * KVW * 2);
constexpr size_t O_WIDX = O_KIDX + al256((size_t)NT * 64 * 2);
constexpr size_t O_GATES = O_WIDX + al256((size_t)NT * 8 * 4);
constexpr size_t O_BQ = O_GATES + al256((size_t)NT * 24 * 4);
constexpr size_t KVS_ONE = (size_t)NB * 2 * T * 128;
constexpr size_t O_KVS = O_BQ + al256((size_t)NT * 1024 * 2);
constexpr size_t O_QALL = O_KVS + al256(6 * KVS_ONE * 2 + 65536);
constexpr size_t O_C1P = O_QALL + al256((size_t)NT * QC * 2);
constexpr size_t O_KCVC = O_C1P + al256((size_t)16 * 2 * 2048 * 256 * 4);
constexpr size_t O_SEL = O_KCVC + al256((size_t)2 * 2048 * 128 * 2);
constexpr size_t O_NSEL = O_SEL + al256((size_t)NT * 256 * 2);
constexpr size_t O_OLAT = O_NSEL + al256((size_t)NT * 4);
constexpr size_t O_OB = O_OLAT + al256((size_t)NT * D * 2);
constexpr size_t O_MERGED = O_OB + al256((size_t)NT * 1024 * 2);
constexpr size_t O_MO = O_MERGED + al256((size_t)NT * D * 2);
constexpr size_t O_X1 = O_MO + al256((size_t)NT * D * 2);
constexpr size_t O_TOPI = O_X1 + al256((size_t)NT * D * 4);
constexpr size_t O_TOPW = O_TOPI + al256((size_t)NT * 4 * 4);
constexpr size_t O_TSLOT = O_TOPW + al256((size_t)NT * 4 * 4);
constexpr size_t O_SLOTW = O_TSLOT + al256((size_t)NT * 4 * 4);
constexpr size_t O_HS = O_SLOTW + al256((size_t)SLOTS * 4);
constexpr size_t O_ACT = O_HS + al256((size_t)SLOTS * D);
constexpr size_t O_YS = O_ACT + al256((size_t)SLOTS * D);
constexpr size_t O_OB8 = O_YS + al256((size_t)SLOTS * D * 2);
constexpr size_t O_MG8 = O_OB8 + al256((size_t)NT * 1024);
constexpr size_t O_WIN8 = O_MG8 + al256((size_t)NT * D);
constexpr size_t O_H8 = O_WIN8 + al256((size_t)ZC * D);
constexpr size_t WS_END = O_H8 + al256((size_t)NT * D);

struct Params {
    const float* x; const float* c; const int* pos; const float* w_ada; const float* b_ada;
    const float* g_pre_mix; const float* g_post_mix; const float* g_pre_ffn; const float* g_post_ffn;
    const float* w_in; const float* a_cq_norm; const float* a_ckv_norm; const float* a_w_uq; const float* a_w_uk; const float* a_w_uv;
    const float* idx_w_q; const float* idx_g; const float* idx_b;
    const float* cmp_k_pe; const float* cmp_k_w1; const float* cmp_k_w2; const float* cmp_v_pe; const float* cmp_v_w1; const float* cmp_v_w2;
    const float* w_br_a; const float* w_br_b; const float* w_out; const float* w_router; const float* b_router;
    const float* w_gate_up; const float* b_gate_up; const float* w_down; const float* b_down;
    float* out; char* ws;
};

DI int tid_fresh() { int t = threadIdx.x; asm volatile("" : "+v"(t)); return t; }
DI float bf2f(bf16_t v) { return __uint_as_float((unsigned)v << 16); }
DI float bflo(unsigned w) { return __uint_as_float(w << 16); }
DI float bfhi(unsigned w) { return __uint_as_float(w & 0xffff0000u); }
DI bf16_t f2bf(float f) { unsigned u = __float_as_uint(f); u += 0x7FFFu + ((u >> 16) & 1u); return (bf16_t)(u >> 16); }
DI unsigned pk2(float lo, float hi) { unsigned r; asm volatile("v_cvt_pk_bf16_f32 %0, %1, %2" : "=v"(r) : "v"(lo), "v"(hi)); return r; }
DI float wave_sum(float v) {
#pragma unroll
    for (int o = 1; o < 64; o <<= 1) v += __shfl_xor(v, o);
    return v;
}
DI float wave_max(float v) {
#pragma unroll
    for (int o = 1; o < 64; o <<= 1) v = fmaxf(v, __shfl_xor(v, o));
    return v;
}
DI float sigmoidf_(float v) { return 1.f / (1.f + __expf(-v)); }
DI void unpack8(const u32x4& w, float (&f)[8]) {
    f[0] = bflo(w[0]); f[1] = bfhi(w[0]); f[2] = bflo(w[1]); f[3] = bfhi(w[1]); f[4] = bflo(w[2]); f[5] = bfhi(w[2]); f[6] = bflo(w[3]); f[7] = bfhi(w[3]);
}
DI float mod_at(const Params& p, int b, int j) { return ((const float*)(p.ws + O_MODACC))[b * 12288 + j]; }

#define XB_TMO      128
#define XB_XCNT(j)  (256  + 64 * (j))
#define XB_XSUB(j)  (1280 + 64 * (j))
#define XB_XGEN(j)  (2304 + 64 * (j))
#define XB_TOP      3328
#define XB_TOPGEN   3392
#define XCD_BAR_WORDS 3456
#define XB_SPIN_CAP (1u << 22)
DI unsigned xb_ld(unsigned* p)              { return __hip_atomic_load(p, __ATOMIC_RELAXED, __HIP_MEMORY_SCOPE_AGENT); }
DI unsigned xb_add(unsigned* p, unsigned v) { return __hip_atomic_fetch_add(p, v, __ATOMIC_RELAXED, __HIP_MEMORY_SCOPE_AGENT); }
DI unsigned xb_xcc_id() { return (unsigned)__builtin_amdgcn_s_getreg((3 << 11) | 20) & 0xFu; }
#define XB_SPIN(cond, bar) do { unsigned _sp = 0; while (cond) { __builtin_amdgcn_s_sleep(1); \
    if ((++_sp & 255u) == 0u) { if (xb_ld(&(bar)[XB_TMO])) break; if (_sp > XB_SPIN_CAP) { atomicAdd(&(bar)[XB_TMO], 1u); break; } } } } while (0)
struct XcdBarrier { unsigned* bar; unsigned x; volatile LAS unsigned* st; };
DI XcdBarrier xcd_barrier_post(unsigned* bar, volatile LAS unsigned* st) {
    XcdBarrier b; b.bar = bar; b.x = xb_xcc_id(); b.st = st;
    if (threadIdx.x == 0) (void)xb_add(&bar[XB_XCNT(b.x)], 1u);
    return b;
}
DI void xcd_barrier_complete(unsigned* bar, unsigned x, unsigned& nloc, unsigned& nx) {
    const unsigned G = gridDim.x * gridDim.y * gridDim.z;
    unsigned sum, cnt, mine, sp = 0u;
    for (;;) {
        sum = 0u; cnt = 0u; mine = 0u;
#pragma unroll
        for (unsigned j = 0; j < 16; ++j) { const unsigned c = xb_ld(&bar[XB_XCNT(j)]); sum += c; cnt += (c > 0u) ? 1u : 0u; mine = (j == x) ? c : mine; }
        if (sum == G) break;
        __builtin_amdgcn_s_sleep(1);
        if ((++sp & 255u) == 0u) { if (xb_ld(&bar[XB_TMO])) break; if (sp > XB_SPIN_CAP) { atomicAdd(&bar[XB_TMO], 1u); break; } }
    }
    nloc = mine > 0u ? mine : 1u; nx = cnt > 0u ? cnt : 1u;
}
DI void xcd_barrier(const XcdBarrier& b) {
    asm volatile("s_waitcnt vmcnt(0)" ::: "memory");
    __syncthreads();
    if (threadIdx.x == 0) {
        unsigned* bar = b.bar;
        __builtin_amdgcn_s_waitcnt(0);
        unsigned nloc = b.st[0], nx = b.st[1];
        if (nloc == 0u) { xcd_barrier_complete(bar, b.x, nloc, nx); b.st[0] = nloc; b.st[1] = nx; }
        const unsigned old = xb_add(&bar[XB_XSUB(b.x)], 1u);
        const unsigned gen = old / nloc;
        if (old + 1u == (gen + 1u) * nloc) {
            __builtin_amdgcn_fence(__ATOMIC_RELEASE, "agent");
            asm volatile("s_waitcnt vmcnt(0)" ::: "memory");
            const unsigned og = xb_add(&bar[XB_TOP], 1u);
            const unsigned tg = og / nx;
            if (og + 1u == (tg + 1u) * nx) xb_add(&bar[XB_TOPGEN], 1u);
            else XB_SPIN(xb_ld(&bar[XB_TOPGEN]) == tg, bar);
            __builtin_amdgcn_fence(__ATOMIC_ACQUIRE, "agent");
            xb_add(&bar[XB_XGEN(b.x)], 1u);
            asm volatile("s_waitcnt vmcnt(0)" ::: "memory");
        } else {
            XB_SPIN(xb_ld(&bar[XB_XGEN(b.x)]) == gen, bar);
            __builtin_amdgcn_fence(__ATOMIC_ACQUIRE, "agent");
            asm volatile("s_waitcnt vmcnt(0)" ::: "memory");
        }
    }
    __syncthreads();
}

namespace pg8 {
constexpr int BM = 256, BK = 64, HALF = 128, HTB = HALF * BK * 2, STAGE_BYTES = 8 * HTB, NXCD = 8, WGM = 8;
DI int lds_byte(int r, int c) { const int st = (r >> 4) * 2 + (c >> 5), rr = r & 15, cc = c & 31, ob = rr * 64 + cc * 2; return st * 1024 + (ob ^ (((ob >> 9) & 1) << 5)); }
DI void stage_rc(int b, int& R, int& C) { const int st = b / 1024, sb = b % 1024, swz = sb ^ (((sb >> 9) & 1) << 5); R = (st >> 1) * 16 + swz / 64; C = (st & 1) * 32 + (swz % 64) / 2; }
DI int perm32(int rho) { const int n = rho >> 4, i = rho & 15; return 8 * (i >> 2) + 4 * n + (i & 3); }

struct Unit { int pm, pn, e; const char* a; const char* b; };
struct Gemm { int lda, ldb, K; int brow = ldb; int bk = BK * 2; };

struct PlainSched {
    int nM, nN, nwg, G, c; const char* A; const char* Bt; size_t a_tile, b_tile;
    DI void init(int M, int N, int G_, int c_, const void* A_, int lda, const void* Bt_, int ldb) {
        nM = M / BM; nN = N / BM; nwg = nM * nN; G = G_; c = c_; A = (const char*)A_; Bt = (const char*)Bt_; a_tile = (size_t)BM * lda * 2; b_tile = (size_t)BM * ldb * 2; }
    DI bool next(int i, Unit& u) const {
        const long L = (long)i * G + c; if (L >= nwg) return false;
        int wgid = (int)L; { const int q = nwg / NXCD, r = nwg % NXCD, xcd = wgid % NXCD, off = wgid / NXCD; wgid = (xcd < r ? xcd * (q + 1) : r * (q + 1) + (xcd - r) * q) + off; }
        const int nig = WGM * nN, gid = wgid / nig, fm = gid * WGM, gsz = (nM - fm) < WGM ? (nM - fm) : WGM;
        u.pm = fm + ((wgid % nig) % gsz); u.pn = (wgid % nig) / gsz; u.e = 0;
        u.a = A + (size_t)u.pm * a_tile; u.b = Bt + (size_t)u.pn * b_tile; return true;
    }
};

typedef int v4i_t __attribute__((ext_vector_type(4)));
typedef int v8i_t __attribute__((ext_vector_type(8)));
#ifndef PG8_SP2
#define PG8_SP2 true
#endif
template <class Epi, class Sched, bool SP2 = PG8_SP2>
DI void gemm_phase(LAS unsigned char* lds, const Gemm g, const Sched& S, const Epi& E) {
    const int tid = tid_fresh(), wid = __builtin_amdgcn_readfirstlane(tid >> 6), lane = tid & 63, wr = wid >> 2, wc = wid & 3, fr = lane & 15, fq = lane >> 4;
    const int K = g.K, nt = K / BK;
    unsigned voffA[2], voffB[2];
#pragma unroll
    for (int i = 0; i < 2; ++i) { int R, C; stage_rc(tid * 16 + i * 8192, R, C); const int Rb = Epi::PERM ? ((R & ~31) + perm32(R & 31)) : R;
        voffA[i] = (unsigned)(R * g.lda + C) * 2u; voffB[i] = (unsigned)(Rb * g.ldb + C) * 2u; }
    const size_t kstep = (size_t)(BK * 2);
    const size_t hstepA = (size_t)HALF * g.lda * 2, hstepB = (size_t)HALF * g.ldb * 2;
    const unsigned ldsw = (unsigned)wid * 1024u;
    const int aoff = lds_byte(wr * 64 + fr, fq * 8), boff = lds_byte(wc * 32 + fr, fq * 8);
#define PG8_SA(b, h) (((b) * 2 + (h)) * HTB)
#define PG8_SB(b, h) ((4 + (b) * 2 + (h)) * HTB)
#define PG8_STAGE(bufoff, gbase, voff) do { _Pragma("unroll") for (int _i = 0; _i < 2; ++_i) \
        __builtin_amdgcn_global_load_lds((const unsigned*)((const char*)(gbase) + (voff)[_i]), (LAS unsigned*)(lds + (bufoff) + ldsw + _i * 8192), 16, 0, 0); } while (0)
#define PG8_LDA(dst, b, h) do { _Pragma("unroll") for (int m = 0; m < 4; ++m) _Pragma("unroll") for (int k = 0; k < 2; ++k) dst[m][k] = *(const LAS bf16x8*)(lds + PG8_SA(b, h) + aoff + m * 2048 + k * 1024); } while (0)
#define PG8_LDB(dst, b, h) do { _Pragma("unroll") for (int n = 0; n < 2; ++n) _Pragma("unroll") for (int k = 0; k < 2; ++k) dst[n][k] = *(const LAS bf16x8*)(lds + PG8_SB(b, h) + boff + n * 2048 + k * 1024); } while (0)
#define PG8_MMA(ai, bj, At, Bt) do { __builtin_amdgcn_s_setprio(1); _Pragma("unroll") for (int m = 0; m < 4; ++m) _Pragma("unroll") for (int n = 0; n < 2; ++n) _Pragma("unroll") for (int k = 0; k < 2; ++k) \
        acc[ai][bj][m][n] = __builtin_amdgcn_mfma_f32_16x16x32_bf16(Bt[n][k], At[m][k], acc[ai][bj][m][n], 0, 0, 0); __builtin_amdgcn_s_setprio(0); } while (0)
#define PG8_WAIT_V(n) asm volatile("s_waitcnt vmcnt(" #n ")" ::: "memory")
#define PG8_WAIT_L(n) asm volatile("s_waitcnt lgkmcnt(" #n ")" ::: "memory")
#define PG8_BAR __builtin_amdgcn_s_barrier()
#define PG8_SCHED __builtin_amdgcn_sched_barrier(0)
    Unit cur, nxt; int ui = 0;
    if (!S.next(0, cur)) return;
    f32x4 acc[2][2][4][2];
#pragma unroll
    for (int a = 0; a < 2; ++a)
#pragma unroll
        for (int b = 0; b < 2; ++b)
#pragma unroll
            for (int m = 0; m < 4; ++m)
#pragma unroll
                for (int n = 0; n < 2; ++n) acc[a][b][m][n] = (f32x4){0.f, 0.f, 0.f, 0.f};
    bf16x8 At[4][2], B0[2][2], B1[2][2];
    const char* cA = cur.a; const char* cB = cur.b;
    if constexpr (SP2) {
        PG8_STAGE(PG8_SB(0, 0), cB, voffB); PG8_STAGE(PG8_SB(0, 1), cB + hstepB, voffB); PG8_STAGE(PG8_SA(0, 0), cA, voffA); PG8_STAGE(PG8_SA(0, 1), cA + hstepA, voffA);
        if (wr == 1) PG8_BAR;
        PG8_WAIT_V(2); PG8_BAR;
        PG8_STAGE(PG8_SB(1, 0), cB + kstep, voffB); PG8_STAGE(PG8_SA(1, 0), cA + kstep, voffA); PG8_STAGE(PG8_SB(1, 1), cB + hstepB + kstep, voffB);
        PG8_WAIT_V(6); PG8_BAR;
    } else {
        PG8_STAGE(PG8_SB(0, 0), cB, voffB); PG8_STAGE(PG8_SA(0, 0), cA, voffA); PG8_STAGE(PG8_SB(0, 1), cB + hstepB, voffB); PG8_STAGE(PG8_SA(0, 1), cA + hstepA, voffA);
        if (wr == 1) PG8_BAR;
        PG8_WAIT_V(4); PG8_BAR;
        PG8_STAGE(PG8_SB(1, 0), cB + kstep, voffB); PG8_STAGE(PG8_SA(1, 0), cA + kstep, voffA); PG8_STAGE(PG8_SB(1, 1), cB + hstepB + kstep, voffB);
        PG8_WAIT_V(6); PG8_BAR;
    }
    for (;;) {
        const bool has_next = S.next(ui + 1, nxt);
        const char* nA = has_next ? nxt.a : cA; const char* nB = has_next ? nxt.b : cB;
        for (int t = 0; t < nt; t += 2) {
            const bool last = (t == nt - 2);
            const char* a1 = cA + (size_t)(t + 1) * kstep;
            const char* a2 = last ? nA : cA + (size_t)(t + 2) * kstep; const char* b2 = last ? nB : cB + (size_t)(t + 2) * kstep;
            const char* a3 = a2 + kstep; const char* b3 = b2 + kstep;
            if constexpr (SP2) {
            PG8_LDB(B0, 0, 0); PG8_LDB(B1, 0, 1); PG8_SCHED; PG8_LDA(At, 0, 0); PG8_STAGE(PG8_SA(1, 1), a1 + hstepA, voffA);
            PG8_WAIT_V(8); PG8_WAIT_L(0); PG8_BAR; PG8_MMA(0, 0, At, B0); PG8_MMA(0, 1, At, B1); PG8_BAR; PG8_SCHED;
            PG8_LDA(At, 0, 1); PG8_STAGE(PG8_SB(0, 0), b2, voffB); PG8_STAGE(PG8_SB(0, 1), b2 + hstepB, voffB); PG8_STAGE(PG8_SA(0, 0), a2, voffA);
            PG8_WAIT_V(8); PG8_WAIT_L(0); PG8_BAR; PG8_MMA(1, 0, At, B0); PG8_MMA(1, 1, At, B1); PG8_BAR; PG8_SCHED;
            PG8_LDB(B0, 1, 0); PG8_LDB(B1, 1, 1); PG8_SCHED; PG8_LDA(At, 1, 0); PG8_STAGE(PG8_SA(0, 1), a2 + hstepA, voffA);
            PG8_WAIT_V(8); PG8_WAIT_L(0); PG8_BAR; PG8_MMA(0, 0, At, B0); PG8_MMA(0, 1, At, B1); PG8_BAR; PG8_SCHED;
            PG8_LDA(At, 1, 1); PG8_STAGE(PG8_SB(1, 0), b3, voffB); PG8_STAGE(PG8_SB(1, 1), b3 + hstepB, voffB); PG8_STAGE(PG8_SA(1, 0), a3, voffA);
            PG8_WAIT_V(8); PG8_WAIT_L(0); PG8_BAR; PG8_MMA(1, 0, At, B0); PG8_MMA(1, 1, At, B1); PG8_BAR; PG8_SCHED;
            } else {
            PG8_LDB(B0, 0, 0); PG8_SCHED; PG8_LDA(At, 0, 0); PG8_STAGE(PG8_SA(1, 1), a1 + hstepA, voffA);
            PG8_WAIT_L(8); PG8_BAR; PG8_WAIT_L(0); PG8_MMA(0, 0, At, B0); PG8_BAR; PG8_SCHED;
            PG8_LDB(B1, 0, 1); PG8_STAGE(PG8_SB(0, 0), b2, voffB);
            PG8_BAR; PG8_WAIT_L(0); PG8_MMA(0, 1, At, B1); PG8_BAR;
            PG8_LDA(At, 0, 1); PG8_STAGE(PG8_SA(0, 0), a2, voffA);
            PG8_BAR; PG8_WAIT_L(0); PG8_MMA(1, 0, At, B0); PG8_BAR; PG8_SCHED;
            PG8_STAGE(PG8_SB(0, 1), b2 + hstepB, voffB);
            PG8_WAIT_V(6); PG8_BAR; PG8_MMA(1, 1, At, B1); PG8_BAR;
            PG8_LDB(B0, 1, 0); PG8_SCHED; PG8_LDA(At, 1, 0); PG8_STAGE(PG8_SA(0, 1), a2 + hstepA, voffA);
            PG8_WAIT_L(8); PG8_BAR; PG8_WAIT_L(0); PG8_MMA(0, 0, At, B0); PG8_BAR; PG8_SCHED;
            PG8_LDB(B1, 1, 1); PG8_STAGE(PG8_SB(1, 0), b3, voffB);
            PG8_BAR; PG8_WAIT_L(0); PG8_MMA(0, 1, At, B1); PG8_BAR;
            PG8_LDA(At, 1, 1); PG8_STAGE(PG8_SA(1, 0), a3, voffA);
            PG8_BAR; PG8_WAIT_L(0); PG8_MMA(1, 0, At, B0); PG8_BAR; PG8_SCHED;
            PG8_STAGE(PG8_SB(1, 1), b3 + hstepB, voffB);
            PG8_WAIT_V(6); PG8_BAR; PG8_MMA(1, 1, At, B1); PG8_BAR;
            }
        }
        E(acc, cur, wr, wc, fr, fq);
        if (!has_next) break;
#pragma unroll
        for (int a = 0; a < 2; ++a)
#pragma unroll
            for (int b = 0; b < 2; ++b)
#pragma unroll
                for (int m = 0; m < 4; ++m)
#pragma unroll
                    for (int n = 0; n < 2; ++n) acc[a][b][m][n] = (f32x4){0.f, 0.f, 0.f, 0.f};
        cur = nxt; cA = nA; cB = nB; ++ui;
    }
    PG8_WAIT_V(0);
    if (wr == 0) PG8_BAR;
    PG8_BAR;
#undef PG8_SA
#undef PG8_SB
#undef PG8_STAGE
#undef PG8_LDA
#undef PG8_LDB
#undef PG8_MMA
#undef PG8_WAIT_V
#undef PG8_WAIT_L
#undef PG8_BAR
#undef PG8_SCHED
}

template <class Epi, class Sched, bool SP2 = PG8_SP2>
DI void gemm_phase_fp8(LAS unsigned char* lds, const Gemm g, const Sched& S, const Epi& E) {
    const int tid = tid_fresh(), wid = __builtin_amdgcn_readfirstlane(tid >> 6), lane = tid & 63, wr = wid >> 2, wc = wid & 3, fr = lane & 15, fq = lane >> 4;
    const int K = g.K, nt = K / BK;
    unsigned voffA[2], voffB[2];
#pragma unroll
    for (int i = 0; i < 2; ++i) { int R, C; stage_rc(tid * 16 + i * 8192, R, C); const int Rb = Epi::PERM ? ((R & ~31) + perm32(R & 31)) : R;
        voffA[i] = (unsigned)(R * g.lda + C) * 2u; voffB[i] = (unsigned)(Rb * g.brow + C) * 2u; }
    const size_t kstep = (size_t)(BK * 2), kstepB = (size_t)g.bk;
    const size_t hstepA = (size_t)HALF * g.lda * 2, hstepB = (size_t)HALF * g.ldb * 2;
    const unsigned ldsw = (unsigned)wid * 1024u;
    const int aoff = lds_byte(wr * 64 + fr, fq * 8), boff = lds_byte(wc * 32 + fr, fq * 8);
#define PG8_SA(b, h) (((b) * 2 + (h)) * HTB)
#define PG8_SB(b, h) ((4 + (b) * 2 + (h)) * HTB)
#define PG8_STAGE(bufoff, gbase, voff) do { _Pragma("unroll") for (int _i = 0; _i < 2; ++_i) \
        __builtin_amdgcn_global_load_lds((const unsigned*)((const char*)(gbase) + (voff)[_i]), (LAS unsigned*)(lds + (bufoff) + ldsw + _i * 8192), 16, 0, 0); } while (0)
#define PG8_LDA(dst, b, h) do { _Pragma("unroll") for (int m = 0; m < 4; ++m) { const v4i_t lo_ = *(const LAS v4i_t*)(lds + PG8_SA(b, h) + aoff + m * 2048), hi_ = *(const LAS v4i_t*)(lds + PG8_SA(b, h) + aoff + m * 2048 + 1024); dst[m] = __builtin_shufflevector(lo_, hi_, 0, 1, 2, 3, 4, 5, 6, 7); } } while (0)
#define PG8_LDB(dst, b, h) do { _Pragma("unroll") for (int n = 0; n < 2; ++n) { const v4i_t lo_ = *(const LAS v4i_t*)(lds + PG8_SB(b, h) + boff + n * 2048), hi_ = *(const LAS v4i_t*)(lds + PG8_SB(b, h) + boff + n * 2048 + 1024); dst[n] = __builtin_shufflevector(lo_, hi_, 0, 1, 2, 3, 4, 5, 6, 7); } } while (0)
#define PG8_MMA(ai, bj, At, Bt) do { __builtin_amdgcn_s_setprio(1); _Pragma("unroll") for (int m = 0; m < 4; ++m) _Pragma("unroll") for (int n = 0; n < 2; ++n) \
        asm volatile("v_mfma_scale_f32_16x16x128_f8f6f4 %0, %1, %2, %0, %3, %3 op_sel_hi:[0,0,0]" : "+v"(acc[ai][bj][m][n]) : "v"(Bt[n]), "v"(At[m]), "v"(sc127)); __builtin_amdgcn_s_setprio(0); } while (0)
#define PG8_WAIT_V(n) asm volatile("s_waitcnt vmcnt(" #n ")" ::: "memory")
#define PG8_WAIT_L(n) asm volatile("s_waitcnt lgkmcnt(" #n ")" ::: "memory")
#define PG8_BAR __builtin_amdgcn_s_barrier()
#define PG8_SCHED __builtin_amdgcn_sched_barrier(0)
    Unit cur, nxt; int ui = 0;
    if (!S.next(0, cur)) return;
    f32x4 acc[2][2][4][2];
#pragma unroll
    for (int a = 0; a < 2; ++a)
#pragma unroll
        for (int b = 0; b < 2; ++b)
#pragma unroll
            for (int m = 0; m < 4; ++m)
#pragma unroll
                for (int n = 0; n < 2; ++n) acc[a][b][m][n] = (f32x4){0.f, 0.f, 0.f, 0.f};
    v8i_t At[4], B0[2], B1[2];
    int sc127 = 127; asm volatile("" : "+v"(sc127));
    const char* cA = cur.a; const char* cB = cur.b;
    if constexpr (SP2) {
        PG8_STAGE(PG8_SB(0, 0), cB, voffB); PG8_STAGE(PG8_SB(0, 1), cB + hstepB, voffB); PG8_STAGE(PG8_SA(0, 0), cA, voffA); PG8_STAGE(PG8_SA(0, 1), cA + hstepA, voffA);
        if (wr == 1) PG8_BAR;
        PG8_WAIT_V(2); PG8_BAR;
        PG8_STAGE(PG8_SB(1, 0), cB + kstepB, voffB); PG8_STAGE(PG8_SA(1, 0), cA + kstep, voffA); PG8_STAGE(PG8_SB(1, 1), cB + hstepB + kstepB, voffB);
        PG8_WAIT_V(6); PG8_BAR;
    } else {
        PG8_STAGE(PG8_SB(0, 0), cB, voffB); PG8_STAGE(PG8_SA(0, 0), cA, voffA); PG8_STAGE(PG8_SB(0, 1), cB + hstepB, voffB); PG8_STAGE(PG8_SA(0, 1), cA + hstepA, voffA);
        if (wr == 1) PG8_BAR;
        PG8_WAIT_V(4); PG8_BAR;
        PG8_STAGE(PG8_SB(1, 0), cB + kstepB, voffB); PG8_STAGE(PG8_SA(1, 0), cA + kstep, voffA); PG8_STAGE(PG8_SB(1, 1), cB + hstepB + kstepB, voffB);
        PG8_WAIT_V(6); PG8_BAR;
    }
    for (;;) {
        const bool has_next = S.next(ui + 1, nxt);
        const char* nA = has_next ? nxt.a : cA; const char* nB = has_next ? nxt.b : cB;
        for (int t = 0; t < nt; t += 2) {
            const bool last = (t == nt - 2);
            const char* a1 = cA + (size_t)(t + 1) * kstep;
            const char* a2 = last ? nA : cA + (size_t)(t + 2) * kstep; const char* b2 = last ? nB : cB + (size_t)(t + 2) * kstepB;
            const char* a3 = a2 + kstep; const char* b3 = b2 + kstepB;
            if constexpr (SP2) {
            PG8_LDB(B0, 0, 0); PG8_LDB(B1, 0, 1); PG8_SCHED; PG8_LDA(At, 0, 0); PG8_STAGE(PG8_SA(1, 1), a1 + hstepA, voffA);
            PG8_WAIT_V(8); PG8_WAIT_L(0); PG8_BAR; PG8_MMA(0, 0, At, B0); PG8_MMA(0, 1, At, B1); PG8_BAR; PG8_SCHED;
            PG8_LDA(At, 0, 1); PG8_STAGE(PG8_SB(0, 0), b2, voffB); PG8_STAGE(PG8_SB(0, 1), b2 + hstepB, voffB); PG8_STAGE(PG8_SA(0, 0), a2, voffA);
            PG8_WAIT_V(8); PG8_WAIT_L(0); PG8_BAR; PG8_MMA(1, 0, At, B0); PG8_MMA(1, 1, At, B1); PG8_BAR; PG8_SCHED;
            PG8_LDB(B0, 1, 0); PG8_LDB(B1, 1, 1); PG8_SCHED; PG8_LDA(At, 1, 0); PG8_STAGE(PG8_SA(0, 1), a2 + hstepA, voffA);
            PG8_WAIT_V(8); PG8_WAIT_L(0); PG8_BAR; PG8_MMA(0, 0, At, B0); PG8_MMA(0, 1, At, B1); PG8_BAR; PG8_SCHED;
            PG8_LDA(At, 1, 1); PG8_STAGE(PG8_SB(1, 0), b3, voffB); PG8_STAGE(PG8_SB(1, 1), b3 + hstepB, voffB); PG8_STAGE(PG8_SA(1, 0), a3, voffA);
            PG8_WAIT_V(8); PG8_WAIT_L(0); PG8_BAR; PG8_MMA(1, 0, At, B0); PG8_MMA(1, 1, At, B1); PG8_BAR; PG8_SCHED;
            } else {
            PG8_LDB(B0, 0, 0); PG8_SCHED; PG8_LDA(At, 0, 0); PG8_STAGE(PG8_SA(1, 1), a1 + hstepA, voffA);
            PG8_WAIT_L(8); PG8_BAR; PG8_WAIT_L(0); PG8_MMA(0, 0, At, B0); PG8_BAR; PG8_SCHED;
            PG8_LDB(B1, 0, 1); PG8_STAGE(PG8_SB(0, 0), b2, voffB);
            PG8_BAR; PG8_WAIT_L(0); PG8_MMA(0, 1, At, B1); PG8_BAR;
            PG8_LDA(At, 0, 1); PG8_STAGE(PG8_SA(0, 0), a2, voffA);
            PG8_BAR; PG8_WAIT_L(0); PG8_MMA(1, 0, At, B0); PG8_BAR; PG8_SCHED;
            PG8_STAGE(PG8_SB(0, 1), b2 + hstepB, voffB);
            PG8_WAIT_V(6); PG8_BAR; PG8_MMA(1, 1, At, B1); PG8_BAR;
            PG8_LDB(B0, 1, 0); PG8_SCHED; PG8_LDA(At, 1, 0); PG8_STAGE(PG8_SA(0, 1), a2 + hstepA, voffA);
            PG8_WAIT_L(8); PG8_BAR; PG8_WAIT_L(0); PG8_MMA(0, 0, At, B0); PG8_BAR; PG8_SCHED;
            PG8_LDB(B1, 1, 1); PG8_STAGE(PG8_SB(1, 0), b3, voffB);
            PG8_BAR; PG8_WAIT_L(0); PG8_MMA(0, 1, At, B1); PG8_BAR;
            PG8_LDA(At, 1, 1); PG8_STAGE(PG8_SA(1, 0), a3, voffA);
            PG8_BAR; PG8_WAIT_L(0); PG8_MMA(1, 0, At, B0); PG8_BAR; PG8_SCHED;
            PG8_STAGE(PG8_SB(1, 1), b3 + hstepB, voffB);
            PG8_WAIT_V(6); PG8_BAR; PG8_MMA(1, 1, At, B1); PG8_BAR;
            }
        }
        asm volatile("s_nop 15\n\ts_nop 15" ::: "memory");
        E(acc, cur, wr, wc, fr, fq);
        if (!has_next) break;
#pragma unroll
        for (int a = 0; a < 2; ++a)
#pragma unroll
            for (int b = 0; b < 2; ++b)
#pragma unroll
                for (int m = 0; m < 4; ++m)
#pragma unroll
                    for (int n = 0; n < 2; ++n) acc[a][b][m][n] = (f32x4){0.f, 0.f, 0.f, 0.f};
        cur = nxt; cA = nA; cB = nB; ++ui;
    }
    PG8_WAIT_V(0);
    if (wr == 0) PG8_BAR;
    PG8_BAR;
#undef PG8_SA
#undef PG8_SB
#undef PG8_STAGE
#undef PG8_LDA
#undef PG8_LDB
#undef PG8_MMA
#undef PG8_WAIT_V
#undef PG8_WAIT_L
#undef PG8_BAR
#undef PG8_SCHED
}

typedef f32x4 Acc[2][2][4][2];
struct EpiBf16 {
    static constexpr bool PERM = true; bf16_t* O; int ldc; float scale;
    DI void operator()(const Acc& acc, const Unit& u, int wr, int wc, int fr, int fq) const {
        const int row0 = u.pm * BM + wr * 64 + fr, col0 = u.pn * BM + wc * 32 + 8 * fq;
#pragma unroll
        for (int ai = 0; ai < 2; ++ai)
#pragma unroll
            for (int m = 0; m < 4; ++m) { bf16_t* rowp = O + (size_t)(row0 + ai * HALF + m * 16) * ldc + col0;
#pragma unroll
                for (int bj = 0; bj < 2; ++bj) { const f32x4 v0 = acc[ai][bj][m][0] * scale, v1 = acc[ai][bj][m][1] * scale;
                    *(u32x4*)(rowp + bj * HALF) = (u32x4){pk2(v0[0], v0[1]), pk2(v0[2], v0[3]), pk2(v1[0], v1[1]), pk2(v1[2], v1[3])}; } }
    }
};
struct EpiC1 {
    static constexpr bool PERM = false; float* C;
    DI void operator()(const Acc& acc, const Unit& u, int wr, int wc, int fr, int fq) const {
        const int row0 = u.pm * BM + wr * 64 + fr, col0 = wc * 32 + 4 * fq;
        float* base = C + (size_t)u.e * 2048 * 256;
#pragma unroll
        for (int ai = 0; ai < 2; ++ai)
#pragma unroll
            for (int m = 0; m < 4; ++m) { float* rowp = base + (size_t)(row0 + ai * HALF + m * 16) * 256 + col0;
#pragma unroll
                for (int bj = 0; bj < 2; ++bj)
#pragma unroll
                    for (int n = 0; n < 2; ++n) *(f32x4*)(rowp + bj * HALF + n * 16) = acc[ai][bj][m][n]; }
    }
};
DI float clamp8(float v) { return __builtin_amdgcn_fmed3f(v, -448.f, 448.f); }
DI unsigned fp8x4(float a, float b, float c, float d) { int w = 0; w = __builtin_amdgcn_cvt_pk_fp8_f32(clamp8(a), clamp8(b), w, false); w = __builtin_amdgcn_cvt_pk_fp8_f32(clamp8(c), clamp8(d), w, true); return (unsigned)w; }
constexpr float W8_SCALE = 256.f, W8_INV = 1.f / 256.f, A8_SCALE = 16.f, A8W8_INV = 1.f / 4096.f, Y8_SCALE = 32.f, Y8_INV = 1.f / 32.f;
template <bool ADD> struct EpiMerge {
    static constexpr bool PERM = true; bf16_t* P; unsigned char* O8; const bf16_t* Z; int gcol0; float scale;
    DI void operator()(const Acc& acc, const Unit& u, int wr, int wc, int fr, int fq) const {
        const int row0 = u.pm * BM + wr * 64 + fr, col0 = u.pn * BM + wc * 32 + 8 * fq;
#pragma unroll
        for (int ai = 0; ai < 2; ++ai) {
            u32x4 gz[4][2], pz[4][2];
#pragma unroll
            for (int m = 0; m < 4; ++m) { const size_t row = (size_t)(row0 + ai * HALF + m * 16);
#pragma unroll
                for (int bj = 0; bj < 2; ++bj) { const int col = col0 + bj * HALF; gz[m][bj] = *(const u32x4*)(Z + row * ZC + gcol0 + col); if (ADD) pz[m][bj] = *(const u32x4*)(P + row * D + col); } }
#pragma unroll
            for (int m = 0; m < 4; ++m) { const size_t row = (size_t)(row0 + ai * HALF + m * 16);
#pragma unroll
                for (int bj = 0; bj < 2; ++bj) { const int col = col0 + bj * HALF;
                    float g[8], o[8]; unpack8(gz[m][bj], g);
                    const f32x4 v0 = acc[ai][bj][m][0] * scale, v1 = acc[ai][bj][m][1] * scale;
                    if (ADD) unpack8(pz[m][bj], o);
#pragma unroll
                    for (int j = 0; j < 8; ++j) { const float a = j < 4 ? v0[j & 3] : v1[j & 3]; o[j] = (ADD ? o[j] : 0.f) + sigmoidf_(g[j]) * a; }
                    if (ADD) *(u32x2*)(O8 + row * D + col) = (u32x2){fp8x4(o[0] * A8_SCALE, o[1] * A8_SCALE, o[2] * A8_SCALE, o[3] * A8_SCALE), fp8x4(o[4] * A8_SCALE, o[5] * A8_SCALE, o[6] * A8_SCALE, o[7] * A8_SCALE)};
                    else *(u32x4*)(P + row * D + col) = (u32x4){pk2(o[0], o[1]), pk2(o[2], o[3]), pk2(o[4], o[5]), pk2(o[6], o[7])}; } }
        }
    }
};
struct EpiGU {
    static constexpr bool PERM = true; unsigned char* O; const float* bias;
    DI void operator()(const Acc& acc, const Unit& u, int wr, int wc, int fr, int fq) const {
        const int row0 = u.pm * BM + wr * 64 + fr, c0 = u.pn * HALF + wc * 32 + 8 * fq;
        const float* bg = bias + (size_t)u.e * 4096 + c0; const float* bu = bg + 2048;
        float bgv[8], buv[8];
#pragma unroll
        for (int j = 0; j < 8; ++j) { bgv[j] = bg[j]; buv[j] = bu[j]; }
#pragma unroll
        for (int ai = 0; ai < 2; ++ai)
#pragma unroll
            for (int m = 0; m < 4; ++m) { unsigned char* rowp = O + (size_t)(row0 + ai * HALF + m * 16) * D + c0;
                float o[8];
#pragma unroll
                for (int j = 0; j < 8; ++j) { float gt = (j < 4 ? acc[ai][0][m][0][j & 3] : acc[ai][0][m][1][j & 3]) * W8_INV + bgv[j];
                    float up = (j < 4 ? acc[ai][1][m][0][j & 3] : acc[ai][1][m][1][j & 3]) * W8_INV + buv[j];
                    gt = fminf(gt, 7.f); up = fminf(fmaxf(up, -7.f), 7.f);
                    o[j] = gt * sigmoidf_(1.702f * gt) * (up + 1.f); }
                *(u32x2*)rowp = (u32x2){fp8x4(o[0], o[1], o[2], o[3]), fp8x4(o[4], o[5], o[6], o[7])}; }
    }
};
struct EpiDN {
    static constexpr bool PERM = true; unsigned char* O; const float* bias; const float* slotw;
    DI void operator()(const Acc& acc, const Unit& u, int wr, int wc, int fr, int fq) const {
        const int row0 = u.pm * BM + wr * 64 + fr, col0 = u.pn * BM + wc * 32 + 8 * fq;
        float bv[2][8];
#pragma unroll
        for (int bj = 0; bj < 2; ++bj)
#pragma unroll
            for (int j = 0; j < 8; ++j) bv[bj][j] = bias[(size_t)u.e * D + col0 + bj * HALF + j];
        float sw[2][4];
#pragma unroll
        for (int ai = 0; ai < 2; ++ai)
#pragma unroll
            for (int m = 0; m < 4; ++m) sw[ai][m] = slotw[row0 + ai * HALF + m * 16];
#pragma unroll
        for (int ai = 0; ai < 2; ++ai)
#pragma unroll
            for (int m = 0; m < 4; ++m) { const int row = row0 + ai * HALF + m * 16; const float w = sw[ai][m] * Y8_SCALE; unsigned char* rowp = O + (size_t)row * D + col0;
#pragma unroll
                for (int bj = 0; bj < 2; ++bj) { float o[8];
#pragma unroll
                    for (int j = 0; j < 8; ++j) o[j] = ((j < 4 ? acc[ai][bj][m][0][j & 3] : acc[ai][bj][m][1][j & 3]) * W8_INV + bv[bj][j]) * w;
                    *(u32x2*)(rowp + bj * HALF) = (u32x2){fp8x4(o[0], o[1], o[2], o[3]), fp8x4(o[4], o[5], o[6], o[7])}; } }
    }
};
struct C1Sched {
    int G, c; const char* kvs; const char* w;
    DI bool next(int i, Unit& u) const {
        const int L = i * G + c; if (L >= 256) return false;
        const int kv = L >> 7, s = (L >> 3) & 15, pm = L & 7;
        u.pm = pm; u.pn = 0; u.e = s * 2 + kv;
        u.a = kvs + ((size_t)kv * KVS_ONE + (size_t)pm * 256 * 2048 + (size_t)s * 256) * 2;
        u.b = w + ((size_t)kv * 256 * 4096 + (size_t)s * 256) * 2; return true;
    }
};
struct MoeSched {
    int G, c, nN, total; const LAS int* tile_e; const char* A; const char* W; size_t w_exp;
    DI bool next(int i, Unit& u) const {
        const int L = i * G + c; if (L >= total) return false;
        const int mt = L / nN, pn = L - mt * nN; const int e = __builtin_amdgcn_readfirstlane(tile_e[mt]);
        u.pm = mt; u.pn = pn; u.e = e;
        u.a = A + (size_t)mt * 256 * D; u.b = W + (size_t)e * w_exp + (size_t)pn * 256 * D; return true;
    }
};
}

DI int colmap(int kind, int n) {
    if (kind == 0) return n;
    if (kind == 1) {
        if (n < 872) return n;
        if (n < 896) return 3432 + (n - 872);
        if (n < 1024) return -1;
        if (n < 2048) return 872 + (n - 1024);
        if (n < 3584) return 1896 + (n - 2048);
        return 3456 + (n - 3584);
    }
    if (kind == 2) { const int pn = n >> 8, r = n & 255; return r < 128 ? pn * 128 + r : 2048 + pn * 128 + (r - 128); }
    if (kind == 4) return n < 32 ? n : -1;
    { const int h = n >> 5, d = n & 31; return h * 128 + d; }
}
struct TrJob { const float* src; bf16_t* dst; int ldsrc, lddst, kind, k0, n0, dk0, dn0; };
DI void tr_load(const TrJob& j, f32x4 (&v)[8], int t) {
    const int c4 = t & 63, r0 = t >> 6; const int sc = colmap(j.kind, j.n0 + 4 * c4);
#pragma unroll
    for (int q = 0; q < 8; ++q) v[q] = (f32x4){0.f, 0.f, 0.f, 0.f};
    if (sc >= 0) {
#pragma unroll
        for (int q = 0; q < 8; ++q) v[q] = __builtin_nontemporal_load((const f32x4*)(j.src + (size_t)(j.k0 + r0 + 8 * q) * j.ldsrc + sc));
    }
}
DI void tr_lds_write(const f32x4 (&v)[8], float* tile, int t) {
    const int c4 = t & 63, r0 = t >> 6;
#pragma unroll
    for (int q = 0; q < 8; ++q) { float* tp = tile + (r0 + 8 * q) * 257 + 4 * c4; tp[0] = v[q][0]; tp[1] = v[q][1]; tp[2] = v[q][2]; tp[3] = v[q][3]; }
}
DI void tr_store(const TrJob& j, const float* tile, int t) {
    const int kk8 = (t & 7) * 8, nb = t >> 3;
#pragma unroll
    for (int ps = 0; ps < 4; ++ps) { const int nn = nb + 64 * ps; const float* s = tile + kk8 * 257 + nn;
        u32x4 o = {pk2(s[0], s[257]), pk2(s[2 * 257], s[3 * 257]), pk2(s[4 * 257], s[5 * 257]), pk2(s[6 * 257], s[7 * 257])};
        *(u32x4*)(j.dst + (size_t)(j.n0 + nn) * j.lddst + j.k0 + kk8) = o; }
}
DI void tr_setup(TrJob& j, int u, int nK, const float* src, int ldsrc, int kind, bf16_t* dst, int lddst) {
    const int kt = u % nK, ntile = u / nK; j.src = src; j.dst = dst; j.ldsrc = ldsrc; j.lddst = lddst; j.kind = kind; j.k0 = kt * 64; j.n0 = ntile * 256;
}
DI float tr8_load(const TrJob& j, f32x4 (&v)[8], int t) {
    const int c4 = t & 31, r0 = t >> 5; const int sc = colmap(j.kind, j.n0 + 4 * c4); const int scc = sc < 0 ? 0 : sc;
#pragma unroll
    for (int q = 0; q < 8; ++q) v[q] = __builtin_nontemporal_load((const f32x4*)(j.src + (size_t)(j.k0 + r0 + 16 * q) * j.ldsrc + scc));
    return sc < 0 ? 0.f : 1.f;
}
DI void tr8_lds_write(const f32x4 (&v)[8], float ok, float* tile, int t) {
    const int c4 = t & 31, r0 = t >> 5;
#pragma unroll
    for (int q = 0; q < 8; ++q) { float* tp = tile + (r0 + 16 * q) * 129 + 4 * c4; tp[0] = v[q][0] * ok; tp[1] = v[q][1] * ok; tp[2] = v[q][2] * ok; tp[3] = v[q][3] * ok; }
}
DI void tr8_store(const TrJob& j, const float* tile, int t) {
    const int kc = t & 7, nb = t >> 3; constexpr float SC = pg8::W8_SCALE;
#pragma unroll
    for (int ps = 0; ps < 2; ++ps) { const int nn = nb + 64 * ps; const float* s = tile + (16 * kc) * 129 + nn;
        u32x4 o = {pg8::fp8x4(s[0] * SC, s[129] * SC, s[2 * 129] * SC, s[3 * 129] * SC), pg8::fp8x4(s[4 * 129] * SC, s[5 * 129] * SC, s[6 * 129] * SC, s[7 * 129] * SC),
                   pg8::fp8x4(s[8 * 129] * SC, s[9 * 129] * SC, s[10 * 129] * SC, s[11 * 129] * SC), pg8::fp8x4(s[12 * 129] * SC, s[13 * 129] * SC, s[14 * 129] * SC, s[15 * 129] * SC)};
        __builtin_nontemporal_store(o, (u32x4*)((unsigned char*)j.dst + (size_t)(j.dn0 + nn) * j.lddst + j.dk0 + 16 * kc)); }
}
DI void phase_prep(const Params& p, char* smem) {
    float* tile = (float*)smem;
    const int t = tid_fresh(), G = gridDim.x;
    constexpr int U_ADA = 256, U_ABS = 256, U_WO = 512, U_CB = 128, SPECIAL = U_ADA + U_ABS + U_WO + U_CB;
    constexpr int U_WINB = 32 * 8, U_WIN = 16 * 44, U_IDXQ = 8 * 2, U_UQR = 8, U_BRB = 16 * 8, U_OUT = 32 * 8, U_C1 = 64, U_RT = 32, U_GU = 32 * 16, U_DN = 32 * 8;
    constexpr int NTR = U_WINB + U_IDXQ + U_UQR + 2 * U_C1 + U_RT, NTR8 = U_WIN + U_BRB + U_OUT + NEXP * (U_GU + U_DN);
    bf16_t* Wq = (bf16_t*)(p.ws + O_WQ);
    for (int rp_ = 0; rp_ < ((PREP_REP & 1) ? 2 : 1); ++rp_)
    for (int u0 = blockIdx.x; u0 < SPECIAL; u0 += G) {
        int u = u0;
        if (rp_ == 1 && (u0 < PREP_REP_LO || u0 >= PREP_REP_HI)) continue;
        if (u < U_ADA) {
            const int c4 = t % 12, kg = t / 12; f32x4 a0 = {0.f, 0.f, 0.f, 0.f}, a1 = {0.f, 0.f, 0.f, 0.f};
            if (kg < 42) { const int col = u * 48 + c4 * 4;
#pragma unroll 7
                for (int k = kg; k < 2048; k += 42) { const float c0 = p.c[k], c1 = p.c[2048 + k]; const float s0 = c0 * sigmoidf_(c0), s1 = c1 * sigmoidf_(c1);
                    const f32x4 w = *(const f32x4*)(p.w_ada + (size_t)k * 12288 + col); a0 += w * s0; a1 += w * s1; } }
            __syncthreads();
            if (kg < 42) { float* tp = tile + (kg * 12 + c4) * 8;
#pragma unroll
                for (int j = 0; j < 4; ++j) { tp[j] = a0[j]; tp[4 + j] = a1[j]; } }
            __syncthreads();
            if (t < 96) { const int bb = t / 48, cc = t % 48; float acc = 0.f;
                for (int g2 = 0; g2 < 42; ++g2) acc += tile[(g2 * 12 + (cc >> 2)) * 8 + bb * 4 + (cc & 3)];
                ((float*)(p.ws + O_MODACC))[bb * 12288 + u * 48 + cc] = acc + p.b_ada[u * 48 + cc]; }
            continue; }
        u -= U_ADA;
        if (u < U_ABS) {
            const int h = u >> 5, w = __builtin_amdgcn_readfirstlane(t >> 6), l = t & 63, c = (u & 31) * 8 + w;
            const float* ukp = p.a_w_uk + (size_t)c * 768 + h * 96;
            float acc[8];
#pragma unroll
            for (int j = 0; j < 8; ++j) acc[j] = 0.f;
#pragma unroll 1
            for (int ch = 0; ch < 3; ++ch) {
                __syncthreads();
#pragma unroll
                for (int q = 0; q < 8; ++q) { const int r = (t >> 3) + 64 * q;
                    *(f32x4*)(tile + r * 36 + 4 * (t & 7)) = *(const f32x4*)(p.a_w_uq + (size_t)r * 1024 + h * 128 + 32 + ch * 32 + 4 * (t & 7)); }
                __syncthreads();
#pragma unroll 2
                for (int n4 = 0; n4 < 8; ++n4) { const float k0 = ukp[ch * 32 + 4 * n4], k1 = ukp[ch * 32 + 4 * n4 + 1], k2 = ukp[ch * 32 + 4 * n4 + 2], k3 = ukp[ch * 32 + 4 * n4 + 3];
#pragma unroll
                    for (int j = 0; j < 8; ++j) { const f32x4 x = *(const f32x4*)(tile + (l + 64 * j) * 36 + 4 * n4);
                        acc[j] = __builtin_fmaf(x[0], k0, acc[j]); acc[j] = __builtin_fmaf(x[1], k1, acc[j]); acc[j] = __builtin_fmaf(x[2], k2, acc[j]); acc[j] = __builtin_fmaf(x[3], k3, acc[j]); } }
            }
#pragma unroll
            for (int j = 0; j < 8; ++j) Wq[(size_t)(h * 256 + c) * 512 + l + 64 * j] = f2bf(acc[j]);
            continue; }
        u -= U_ABS;
        if (u < U_WO) {
            const int n = (u & 3) * 512 + t, k0 = (u >> 2) * 16, h = k0 >> 8;
            __syncthreads();
            *(f32x4*)(tile + 4 * t) = *(const f32x4*)(p.a_w_uv + (size_t)k0 * 128 + 4 * t);
            __syncthreads();
            const float* wbp = p.w_br_a + (size_t)(h * 128) * D + n;
            float acc[16];
#pragma unroll
            for (int j = 0; j < 16; ++j) acc[j] = 0.f;
#pragma unroll 2
            for (int v0 = 0; v0 < 128; v0 += 8) { float wb[8];
#pragma unroll
                for (int i = 0; i < 8; ++i) wb[i] = wbp[(size_t)(v0 + i) * D];
#pragma unroll
                for (int j = 0; j < 16; ++j) { const f32x4 a = *(const f32x4*)(tile + j * 128 + v0), b = *(const f32x4*)(tile + j * 128 + v0 + 4);
                    acc[j] = __builtin_fmaf(a[0], wb[0], acc[j]); acc[j] = __builtin_fmaf(a[1], wb[1], acc[j]); acc[j] = __builtin_fmaf(a[2], wb[2], acc[j]); acc[j] = __builtin_fmaf(a[3], wb[3], acc[j]);
                    acc[j] = __builtin_fmaf(b[0], wb[4], acc[j]); acc[j] = __builtin_fmaf(b[1], wb[5], acc[j]); acc[j] = __builtin_fmaf(b[2], wb[6], acc[j]); acc[j] = __builtin_fmaf(b[3], wb[7], acc[j]); } }
            constexpr float SW = pg8::W8_SCALE;
            *(u32x4*)((unsigned char*)(p.ws + O_WO) + (size_t)n * D + k0) = (u32x4){pg8::fp8x4(acc[0] * SW, acc[1] * SW, acc[2] * SW, acc[3] * SW), pg8::fp8x4(acc[4] * SW, acc[5] * SW, acc[6] * SW, acc[7] * SW),
                pg8::fp8x4(acc[8] * SW, acc[9] * SW, acc[10] * SW, acc[11] * SW), pg8::fp8x4(acc[12] * SW, acc[13] * SW, acc[14] * SW, acc[15] * SW)};
            continue; }
        u -= U_WO;
        {
            const int kv = u >> 6, seg = u & 63;
            if (t < 256) { const float* pe = kv ? p.cmp_v_pe : p.cmp_k_pe; const float* w1 = kv ? p.cmp_v_w1 : p.cmp_k_w1; float a = 0.f;
#pragma unroll 16
                for (int i = seg * 64; i < seg * 64 + 64; ++i) a += pe[i] * w1[(size_t)i * 256 + t];
                ((float*)(p.ws + O_CBP))[(seg * 2 + kv) * 256 + t] = a; } }
    }
    auto setup = [&](TrJob& j, int u) {
        if (u < U_WINB) { tr_setup(j, u, 32, p.w_in, 7552, 1, (bf16_t*)(p.ws + O_WIN), D); return; } u -= U_WINB;
        if (u < U_IDXQ) { tr_setup(j, u, 8, p.idx_w_q, 512, 0, Wq + (size_t)2304 * 512, 512); return; } u -= U_IDXQ;
        if (u < U_UQR) { tr_setup(j, u, 8, p.a_w_uq, 1024, 3, Wq + (size_t)2048 * 512, 512); return; } u -= U_UQR;
        if (u < U_C1) { tr_setup(j, u, 64, p.cmp_k_w1, 256, 0, (bf16_t*)(p.ws + O_WC1), 4096); return; } u -= U_C1;
        if (u < U_C1) { tr_setup(j, u, 64, p.cmp_v_w1, 256, 0, (bf16_t*)(p.ws + O_WC1) + (size_t)256 * 4096, 4096); return; } u -= U_C1;
        tr_setup(j, u, 32, p.w_router, 32, 4, (bf16_t*)(p.ws + O_WRT), D);
    };
    auto setup8 = [&](TrJob& j, int u) {
        j.lddst = D;
        if (u < U_WIN) { j.src = p.w_in; j.ldsrc = 7552; j.kind = 1; j.dst = (bf16_t*)(p.ws + O_WIN8); j.k0 = (u & 15) * 128; j.n0 = 2048 + (u >> 4) * 128; j.dk0 = j.k0; j.dn0 = j.n0; return; } u -= U_WIN;
        if (u < U_BRB) { j.src = p.w_br_b; j.ldsrc = D; j.kind = 0; j.dst = (bf16_t*)(p.ws + O_WBRB); j.lddst = 1024; j.k0 = (u & 7) * 128; j.n0 = (u >> 3) * 128; j.dk0 = j.k0; j.dn0 = j.n0; return; } u -= U_BRB;
        if (u < U_OUT) { j.src = p.w_out; j.ldsrc = D; j.kind = 0; j.dst = (bf16_t*)(p.ws + O_WOUT); j.k0 = (u & 15) * 128; j.n0 = (u >> 4) * 128; j.dk0 = j.k0; j.dn0 = j.n0; return; } u -= U_OUT;
        const int e = u / (U_GU + U_DN), r = u - e * (U_GU + U_DN);
        if (r < U_GU) { j.src = p.w_gate_up + (size_t)e * D * 4096; j.ldsrc = 4096; j.kind = 2; j.dst = (bf16_t*)(p.ws + O_WGU + (size_t)e * 4096 * D + (size_t)r * 16384); j.k0 = (r & 15) * 128; j.n0 = (r >> 4) * 128; }
        else { const int r2 = r - U_GU; j.src = p.w_down + (size_t)e * D * D; j.ldsrc = D; j.kind = 0; j.dst = (bf16_t*)(p.ws + O_WDN + (size_t)e * D * D + (size_t)r2 * 16384); j.k0 = (r2 & 15) * 128; j.n0 = (r2 >> 4) * 128; }
        j.lddst = 128; j.dk0 = 0; j.dn0 = 0;
    };
    TrJob cur, nxt; f32x4 v[8];
    int u;
    for (int rp_ = 0; rp_ < ((PREP_REP & 2) ? 2 : 1); ++rp_) {
    u = blockIdx.x;
    if (u < NTR) { setup(cur, u); tr_load(cur, v, t); }
#pragma unroll 1
    for (; u < NTR; u += G) {
        __syncthreads();
        tr_lds_write(v, tile, t);
        __syncthreads();
        const bool more = u + G < NTR;
        if (more) { setup(nxt, u + G); tr_load(nxt, v, t); }
        tr_store(cur, tile, t);
        cur = nxt;
    }
    }
    auto clampu = [&](int x) { return x < NTR8 ? x : NTR8 - 1; };
    for (int rp_ = 0; rp_ < ((PREP_REP & 4) ? 2 : 1); ++rp_) {
    u = blockIdx.x;
    f32x4 v2[8]; float ok1, ok2;
    setup8(cur, clampu(u)); ok1 = tr8_load(cur, v, t);
    setup8(nxt, clampu(u + G)); ok2 = tr8_load(nxt, v2, t);
#pragma unroll 1
    for (; u < NTR8; u += 2 * G) {
        __syncthreads();
        tr8_lds_write(v, ok1, tile, t);
        __syncthreads();
        TrJob c = cur;
        setup8(cur, clampu(u + 2 * G)); ok1 = tr8_load(cur, v, t);
        tr8_store(c, tile, t);
        __syncthreads();
        tr8_lds_write(v2, ok2, tile, t);
        __syncthreads();
        c = nxt;
        setup8(nxt, clampu(u + 3 * G)); ok2 = tr8_load(nxt, v2, t);
        tr8_store(c, tile, t);
    }
    }
#if PREP_PROBE_MODE >= 2
    {
        unsigned chk = 0; unsigned char* dummy = (unsigned char*)(p.ws + O_HS);
        constexpr int U0 = U_WIN + U_BRB + U_OUT;
        TrJob pj, pn; f32x4 w[8]; float okp;
        int uu = U0 + blockIdx.x;
        setup8(pj, uu); okp = tr8_load(pj, w, t);
#pragma unroll 1
        for (; uu < NTR8; uu += G) {
#if PREP_PROBE_MODE == 2
            __syncthreads();
            tr8_lds_write(w, okp, tile, t);
            __syncthreads();
            setup8(pn, clampu(uu + G)); okp = tr8_load(pn, w, t);
            {   const int kc = t & 7, nb = t >> 3; constexpr float SC = pg8::W8_SCALE;
#pragma unroll
                for (int ps = 0; ps < 2; ++ps) { const int nn = nb + 64 * ps; const float* s = tile + (16 * kc) * 129 + nn;
                    chk ^= pg8::fp8x4(s[0] * SC, s[129] * SC, s[2 * 129] * SC, s[3 * 129] * SC) ^ pg8::fp8x4(s[4 * 129] * SC, s[5 * 129] * SC, s[6 * 129] * SC, s[7 * 129] * SC)
                         ^ pg8::fp8x4(s[8 * 129] * SC, s[9 * 129] * SC, s[10 * 129] * SC, s[11 * 129] * SC) ^ pg8::fp8x4(s[12 * 129] * SC, s[13 * 129] * SC, s[14 * 129] * SC, s[15 * 129] * SC); } }
            pj = pn;
#else
            u32x4 o0 = {pg8::fp8x4(w[0][0], w[0][1], w[0][2], w[0][3]), pg8::fp8x4(w[1][0], w[1][1], w[1][2], w[1][3]), pg8::fp8x4(w[2][0], w[2][1], w[2][2], w[2][3]), pg8::fp8x4(w[3][0], w[3][1], w[3][2], w[3][3])};
            u32x4 o1 = {pg8::fp8x4(w[4][0], w[4][1], w[4][2], w[4][3]), pg8::fp8x4(w[5][0], w[5][1], w[5][2], w[5][3]), pg8::fp8x4(w[6][0], w[6][1], w[6][2], w[6][3]), pg8::fp8x4(w[7][0], w[7][1], w[7][2], w[7][3])};
            setup8(pn, clampu(uu + G)); okp = tr8_load(pn, w, t);
            u32x4* dp = (u32x4*)(dummy + ((size_t)(uu - U0) * 512 + t) * 32); dp[0] = o0; dp[1] = o1;
            pj = pn;
#endif
        }
        if (chk == 0x12345678u && okp == 3.f) ((unsigned*)(p.ws + 115200))[0] = chk;
    }
#endif
#if PREP_PROBE_WC > 0
    {
        constexpr int WC = PREP_PROBE_WC, RW = WC / 4, RS = 512 / RW, R = 16384 / WC;
        float acc = 0.f; const int c4 = t % RW, r0 = t / RW;
#pragma unroll 1
        for (int pass = 0; pass < 2; ++pass) {
            const float* base = pass ? p.w_down : p.w_gate_up; const int ld = pass ? 2048 : 4096;
            const int nK = 65536 / R, ntiles = nK * (ld / WC);
#pragma unroll 1
            for (int uu = blockIdx.x; uu < ntiles; uu += G) {
#if PREP_PROBE_NFAST
                const int nN = ld / WC, nt_ = uu % nN, kt = uu / nN;
#else
                const int kt = uu % nK, nt_ = uu / nK;
#endif
                f32x4 w[8];
#pragma unroll
                for (int q = 0; q < 8; ++q) w[q] = __builtin_nontemporal_load((const f32x4*)(base + (size_t)(kt * R + r0 + RS * q) * ld + nt_ * WC + 4 * c4));
#pragma unroll
                for (int q = 0; q < 8; ++q) acc += (w[q][0] + w[q][1]) + (w[q][2] + w[q][3]);
            }
        }
        if (acc == 12345.678f) ((float*)(p.ws + 115200))[0] = acc;
    }
#endif
}

DI void phase_h1(const Params& p) {
    const int tz_ = tid_fresh(); const int lane = tz_ & 63, wid = __builtin_amdgcn_readfirstlane(tz_ >> 6);
    if (blockIdx.x == 0) { float a = 0.f; const float* cbp = (const float*)(p.ws + O_CBP);
        for (int sg = 0; sg < 64; ++sg) a += cbp[sg * 512 + tz_];
        ((float*)(p.ws + O_CBIAS))[tz_] = a; }
    bf16_t* H = (bf16_t*)(p.ws + O_H); float* rope = (float*)(p.ws + O_ROPE);
    for (int tok = blockIdx.x * 8 + wid; tok < NT; tok += gridDim.x * 8) {
        const int b = tok >> 13;
        const f32x4* xr = (const f32x4*)(p.x + (size_t)tok * D) + lane;
        f32x4 v[8]; float ss = 0.f;
#pragma unroll
        for (int i = 0; i < 8; ++i) { v[i] = xr[64 * i]; ss += v[i][0] * v[i][0] + v[i][1] * v[i][1] + v[i][2] * v[i][2] + v[i][3] * v[i][3]; }
        const float rs = rsqrtf(wave_sum(ss) * (1.f / D) + NORM_EPS);
#pragma unroll
        for (int i = 0; i < 8; ++i) { const int col = 4 * (lane + 64 * i); float o[4];
#pragma unroll
            for (int j = 0; j < 4; ++j) o[j] = v[i][j] * rs * p.g_pre_mix[col + j] * (1.f + mod_at(p, b, 2048 + col + j)) + mod_at(p, b, col + j);
            *(u32x2*)(H + (size_t)tok * D + col) = (u32x2){pk2(o[0], o[1]), pk2(o[2], o[3])};
            *(unsigned*)((unsigned char*)(p.ws + O_H8) + (size_t)tok * D + col) = pg8::fp8x4(o[0], o[1], o[2], o[3]); }
        if (lane < 24) { const float fr = lane < 16 ? (float)(2 * lane) * (1.f / 32.f) : (float)(2 * (lane - 16)) * (1.f / 16.f);
            const float inv = exp2f(-fr * 18.931568569324174f);
            const float ang = (float)p.pos[tok] * inv; float s, c; sincosf(ang, &s, &c);
            rope[(size_t)tok * 48 + 2 * lane] = c; rope[(size_t)tok * 48 + 2 * lane + 1] = s; }
    }
}

DI void phase_zpost(const Params& p) {
    const int tz_ = tid_fresh(); const int lane = tz_ & 63, wid = __builtin_amdgcn_readfirstlane(tz_ >> 6);
    const bf16_t* Z = (const bf16_t*)(p.ws + O_Z); const float* rope = (const float*)(p.ws + O_ROPE);
    bf16_t* cqn = (bf16_t*)(p.ws + O_CQN); bf16_t* kvt = (bf16_t*)(p.ws + O_KVT); bf16_t* kidx = (bf16_t*)(p.ws + O_KIDX);
    float* widx = (float*)(p.ws + O_WIDX); float* gates = (float*)(p.ws + O_GATES); bf16_t* bq = (bf16_t*)(p.ws + O_BQ); bf16_t* kvs = (bf16_t*)(p.ws + O_KVS);
    const f32x4 gq0 = *(const f32x4*)(p.a_cq_norm + lane * 8), gq1 = *(const f32x4*)(p.a_cq_norm + lane * 8 + 4), gkv = *(const f32x4*)(p.a_ckv_norm + lane * 4);
    const float ig = p.idx_g[lane], ibs = p.idx_b[lane];
    const int part = lane & 7;
    for (int tok = blockIdx.x * 8 + wid; tok < NT; tok += gridDim.x * 8) {
        const int b = tok >> 13, tq = tok & (T - 1);
        const bf16_t* zr = Z + (size_t)tok * ZC; const float* rt = rope + (size_t)tok * 48;
        const u32x4 rcq = *(const u32x4*)(zr + lane * 8);
        const u32x2 rkv = *(const u32x2*)(zr + ZC_CKV + lane * 4);
        const bf16_t rki = zr[ZC_KIDX + lane], rk1 = zr[ZC_KROPE + (lane & 15)], rk2 = zr[ZC_KROPE + 16 + (lane & 15)], rwi = zr[ZC_WIDX + (lane & 7)], rbg = zr[ZC_BGATE + (lane < 24 ? lane : 0)];
        u32x4 rh[3][2];
#pragma unroll
        for (int ps = 0; ps < 3; ++ps) { const int slot = ps * 64 + lane, s2 = slot < 160 ? slot : 159; const bf16_t* src = zr + ZC_BQ + (s2 >> 3) * 128 + (s2 & 7) * 16;
            rh[ps][0] = *(const u32x4*)src; rh[ps][1] = *(const u32x4*)(src + 8); }
        f32x4 rr[8];
#pragma unroll
        for (int i = 0; i < 8; ++i) rr[i] = *(const f32x4*)(rt + 4 * i);
        const float ric = rt[32 + 2 * (lane & 7)], ris = rt[33 + 2 * (lane & 7)], rkc = rt[2 * (lane & 15)], rks = rt[2 * (lane & 15) + 1];
        {
            float f[8]; unpack8(rcq, f); float ss = 0.f;
#pragma unroll
            for (int j = 0; j < 8; ++j) ss += f[j] * f[j];
            const float rs = rsqrtf(wave_sum(ss) * (1.f / 512.f) + NORM_EPS);
#pragma unroll
            for (int j = 0; j < 4; ++j) { f[j] = f[j] * rs * gq0[j]; f[4 + j] = f[4 + j] * rs * gq1[j]; }
            *(u32x4*)(cqn + (size_t)tok * 512 + lane * 8) = (u32x4){pk2(f[0], f[1]), pk2(f[2], f[3]), pk2(f[4], f[5]), pk2(f[6], f[7])};
        }
        {
            float f[4] = {bflo(rkv[0]), bfhi(rkv[0]), bflo(rkv[1]), bfhi(rkv[1])};
            const float rs = rsqrtf(wave_sum(f[0] * f[0] + f[1] * f[1] + f[2] * f[2] + f[3] * f[3]) * (1.f / 256.f) + NORM_EPS);
#pragma unroll
            for (int j = 0; j < 4; ++j) f[j] = f[j] * rs * gkv[j];
            *(u32x2*)(kvt + (size_t)tok * KVW + lane * 4) = (u32x2){pk2(f[0], f[1]), pk2(f[2], f[3])};
        }
        if (lane < 16) {
            const float x1 = bf2f(rk1), x2 = bf2f(rk2);
            kvt[(size_t)tok * KVW + 256 + lane] = f2bf(x1 * rkc - x2 * rks); kvt[(size_t)tok * KVW + 272 + lane] = f2bf(x2 * rkc + x1 * rks);
        }
        {
            const float v = bf2f(rki); const float mean = wave_sum(v) * (1.f / 64.f); const float xc = v - mean;
            const float var = wave_sum(xc * xc) * (1.f / 64.f);
            const float y = xc * rsqrtf(var + NORM_EPS) * ig + ibs;
            const float pr = __shfl_xor(y, 8); float o = y;
            if (lane < 8) o = y * ric - pr * ris;
            else if (lane < 16) o = y * ric + pr * ris;
            kidx[(size_t)tok * 64 + lane] = f2bf(o);
        }
        if (lane < 8) widx[(size_t)tok * 8 + lane] = bf2f(rwi) * (0.35355339059327373f * 0.125f);
        if (lane < 24) gates[(size_t)tok * 24 + lane] = sigmoidf_(bf2f(rbg));
#pragma unroll
        for (int ps = 0; ps < 3; ++ps) { const int slot = ps * 64 + lane; const int hh = slot >> 3;
            float f[16]; { float a[8], c[8]; unpack8(rh[ps][0], a); unpack8(rh[ps][1], c);
#pragma unroll
                for (int j = 0; j < 8; ++j) { f[j] = a[j]; f[8 + j] = c[j]; } }
            const bool dorope = (hh < 8 || (((hh - 8) >> 1) & 1) == 0) && part < 2;
#pragma unroll
            for (int i = 0; i < 16; ++i) { const float g = __shfl_xor(f[i], 1); const float c = rr[(2 * i) >> 2][(2 * i) & 3], s = rr[(2 * i + 1) >> 2][(2 * i + 1) & 3];
                const float ro = part == 0 ? f[i] * c - g * s : f[i] * c + g * s; f[i] = dorope ? ro : f[i]; }
            if (slot < 160) { bf16_t* dst;
                if (hh < 8) dst = bq + (size_t)tok * 1024 + hh * 128 + part * 16;
                else { const int i6 = (hh - 8) >> 1, g = (hh - 8) & 1; dst = kvs + ((((size_t)i6 * NB + b) * 2 + g) * T + tq) * 128 + part * 16; }
                *(u32x4*)dst = (u32x4){pk2(f[0], f[1]), pk2(f[2], f[3]), pk2(f[4], f[5]), pk2(f[6], f[7])};
                *(u32x4*)(dst + 8) = (u32x4){pk2(f[8], f[9]), pk2(f[10], f[11]), pk2(f[12], f[13]), pk2(f[14], f[15])}; } }
    }
}

DI void c2_rows(const Params& p, char* smem) {
    const int tz_ = tid_fresh(); const int lane = tz_ & 63, wid = __builtin_amdgcn_readfirstlane(tz_ >> 6);
    float* hrow = (float*)smem + wid * 256;
    const float* c1p = (const float*)(p.ws + O_C1P); const float* cb = (const float*)(p.ws + O_CBIAS); bf16_t* kcvc = (bf16_t*)(p.ws + O_KCVC);
    for (int row = blockIdx.x * 8 + wid; row < 4096; row += gridDim.x * 8) {
        const int kv = row >> 11, r = row & 2047, n = r & 511;
        f32x4 a = *(const f32x4*)(cb + kv * 256 + lane * 4);
#pragma unroll
        for (int s = 0; s < 16; ++s) a += *(const f32x4*)(c1p + ((size_t)(s * 2 + kv) * 2048 + r) * 256 + lane * 4);
#pragma unroll
        for (int j = 0; j < 4; ++j) { const float v = a[j]; const float u = 0.7978845608028654f * (v + 0.044715f * v * v * v); hrow[lane * 4 + j] = 0.5f * v * (1.f + tanhf(u)); }
        asm volatile("s_waitcnt lgkmcnt(0)" ::: "memory");
        const float* w2 = kv ? p.cmp_v_w2 : p.cmp_k_w2;
        float o0 = 0.f, o1 = 0.f;
#pragma unroll 16
        for (int j = 0; j < 256; ++j) { const float hv = hrow[j]; const float2 w = *(const float2*)(w2 + j * 128 + lane * 2); o0 += hv * w.x; o1 += hv * w.y; }
        if (n == 511) { o0 = 0.f; o1 = 0.f; }
        *(unsigned*)(kcvc + (size_t)row * 128 + lane * 2) = pk2(o0, o1);
        asm volatile("s_waitcnt lgkmcnt(0)" ::: "memory");
    }
}

DI unsigned short f16key(float v) { const _Float16 h = (_Float16)v; unsigned short u = __builtin_bit_cast(unsigned short, h); return (u & 0x8000u) ? (unsigned short)~u : (unsigned short)(u | 0x8000u); }
DI void topk256_select(const LAS unsigned* scw, int nk, unsigned short* out, int lane) {
    const int nw = (nk + 127) >> 7;
    auto ldk = [&](int i) -> unsigned { const int wi = i * 64 + lane; unsigned v = scw[wi]; if (2 * wi >= nk) v = 0u; else if (2 * wi + 1 >= nk) v &= 0xffffu; return v; };
    unsigned Tv = 0u;
    for (int bit = 15; bit >= 0; --bit) { const unsigned cand = Tv | (1u << bit); int cnt = 0;
#pragma unroll 4
        for (int i = 0; i < nw; ++i) { const unsigned kv = ldk(i); cnt += __popcll(__ballot((kv & 0xffffu) >= cand)) + __popcll(__ballot((kv >> 16) >= cand)); }
        if (cnt >= 256) Tv = cand; }
    int cgt = 0;
#pragma unroll 4
    for (int i = 0; i < nw; ++i) { const unsigned kv = ldk(i); cgt += __popcll(__ballot((kv & 0xffffu) > Tv)) + __popcll(__ballot((kv >> 16) > Tv)); }
    const int need = 256 - cgt; int pos = 0, eqc = 0;
    const unsigned long long ltm = (1ull << lane) - 1ull;
#pragma unroll 2
    for (int i = 0; i < nw; ++i) {
        const unsigned kv = ldk(i); const unsigned lo = kv & 0xffffu, hi = kv >> 16;
        const bool elo = lo == Tv, ehi = hi == Tv;
        const unsigned long long mlo = __ballot(elo), mhi = __ballot(ehi);
        const int below = __popcll(mlo & ltm) + __popcll(mhi & ltm);
        const bool slo = lo > Tv || (elo && eqc + below < need), shi = hi > Tv || (ehi && eqc + below + (elo ? 1 : 0) < need);
        const unsigned long long s0 = __ballot(slo), s1 = __ballot(shi);
        const int plo = pos + __popcll(s0 & ltm), phi = pos + __popcll(s0) + __popcll(s1 & ltm);
        const int kidx = 2 * (i * 64 + lane);
        if (slo) out[plo] = (unsigned short)kidx;
        if (shi) out[phi] = (unsigned short)(kidx + 1);
        pos += __popcll(s0) + __popcll(s1); eqc += __popcll(mlo) + __popcll(mhi); }
}
DI void phase_indexer(const Params& p, char* smem) {
    const int tz_ = tid_fresh(); const int lane = tz_ & 63, wid = __builtin_amdgcn_readfirstlane(tz_ >> 6);
    LAS unsigned short* sc = (LAS unsigned short*)(LAS char*)smem + wid * 8192;
    float* qf = (float*)(smem + 131072) + wid * 512;
    const bf16_t* Q = (const bf16_t*)(p.ws + O_QALL); const bf16_t* KI = (const bf16_t*)(p.ws + O_KIDX); const float* WI = (const float*)(p.ws + O_WIDX);
    unsigned short* SEL = (unsigned short*)(p.ws + O_SEL); int* NSEL = (int*)(p.ws + O_NSEL);
    for (int tok = (int)(NT / 8 - 1 - blockIdx.x) * 8 + wid; tok >= 0; tok -= gridDim.x * 8) {
        const int b = tok >> 13, tq = tok & (T - 1), nk = tq + 1;
        unsigned short* out = SEL + (size_t)tok * 256;
        if (nk <= 256) { for (int i = lane; i < 256; i += 64) out[i] = (unsigned short)(i < nk ? i : 0); if (lane == 0) NSEL[tok] = nk; continue; }
        { float f[8]; unpack8(*(const u32x4*)(Q + (size_t)tok * QC + 2304 + lane * 8), f);
#pragma unroll
          for (int j = 0; j < 8; ++j) qf[lane * 8 + j] = f[j]; }
        float wh[8];
#pragma unroll
        for (int h = 0; h < 8; ++h) wh[h] = WI[(size_t)tok * 8 + h];
        asm volatile("s_waitcnt lgkmcnt(0)" ::: "memory");
        for (int s = lane; s < nk; s += 64) {
            const bf16_t* kr = KI + ((size_t)b * T + s) * 64; float d[8];
#pragma unroll
            for (int h = 0; h < 8; ++h) d[h] = 0.f;
#pragma unroll 2
            for (int c = 0; c < 8; ++c) { float kf[8]; unpack8(*(const u32x4*)(kr + c * 8), kf);
#pragma unroll
                for (int h = 0; h < 8; ++h) { const f32x4 q0 = *(const f32x4*)(qf + h * 64 + c * 8), q1 = *(const f32x4*)(qf + h * 64 + c * 8 + 4);
                    d[h] += q0[0] * kf[0] + q0[1] * kf[1] + q0[2] * kf[2] + q0[3] * kf[3] + q1[0] * kf[4] + q1[1] * kf[5] + q1[2] * kf[6] + q1[3] * kf[7]; } }
            float score = 0.f;
#pragma unroll
            for (int h = 0; h < 8; ++h) score += wh[h] * fmaxf(d[h], 0.f);
            sc[s] = f16key(score); }
        asm volatile("s_waitcnt lgkmcnt(0)" ::: "memory");
        topk256_select((const LAS unsigned*)sc, nk, out, lane);
        if (lane == 0) NSEL[tok] = 256;
        asm volatile("s_waitcnt lgkmcnt(0)" ::: "memory");
    }
}

DI void phase_mla(const Params& p, char* smem) {
    const int tz_ = tid_fresh(); const int lane = tz_ & 63, wid = __builtin_amdgcn_readfirstlane(tz_ >> 6);
    float* qf = (float*)smem + wid * (8 * KVW + 8 * 256 + 128);
    float* pf = qf + 8 * KVW; unsigned short* selw = (unsigned short*)(pf + 8 * 256);
    const bf16_t* Q = (const bf16_t*)(p.ws + O_QALL); const bf16_t* KV = (const bf16_t*)(p.ws + O_KVT);
    const unsigned short* SEL = (const unsigned short*)(p.ws + O_SEL); const int* NSEL = (const int*)(p.ws + O_NSEL); bf16_t* OL = (bf16_t*)(p.ws + O_OLAT);
    for (int tok = blockIdx.x * 8 + wid; tok < NT; tok += gridDim.x * 8) {
        const int b = tok >> 13; const int cnt = NSEL[tok];
        const bf16_t* qr = Q + (size_t)tok * QC;
#pragma unroll 4
        for (int i = 0; i < 36; ++i) { const int e = lane + 64 * i;
            const int h = e / KVW, d = e - h * KVW; qf[e] = bf2f(d < 256 ? qr[h * 256 + d] : qr[2048 + h * 32 + (d - 256)]); }
        *(u32x2*)(selw + lane * 4) = *(const u32x2*)(SEL + (size_t)tok * 256 + lane * 4);
        asm volatile("s_waitcnt lgkmcnt(0)" ::: "memory");
        const bf16_t* rows[4];
#pragma unroll
        for (int j = 0; j < 4; ++j) { const int k = lane + 64 * j; const int idx = k < cnt ? selw[k] : 0; rows[j] = KV + ((size_t)b * T + idx) * KVW; }
        float acc[4][8];
#pragma unroll
        for (int j = 0; j < 4; ++j)
#pragma unroll
            for (int h = 0; h < 8; ++h) acc[j][h] = 0.f;
#pragma unroll 1
        for (int c = 0; c < 36; ++c) { float kf[4][8];
#pragma unroll
            for (int j = 0; j < 4; ++j) unpack8(*(const u32x4*)(rows[j] + c * 8), kf[j]);
#pragma unroll
            for (int h = 0; h < 8; ++h) { const f32x4 q0 = *(const f32x4*)(qf + h * KVW + c * 8), q1 = *(const f32x4*)(qf + h * KVW + c * 8 + 4);
#pragma unroll
                for (int j = 0; j < 4; ++j) acc[j][h] += q0[0] * kf[j][0] + q0[1] * kf[j][1] + q0[2] * kf[j][2] + q0[3] * kf[j][3] + q1[0] * kf[j][4] + q1[1] * kf[j][5] + q1[2] * kf[j][6] + q1[3] * kf[j][7]; } }
#pragma unroll
        for (int h = 0; h < 8; ++h) { float m = -INFINITY;
#pragma unroll
            for (int j = 0; j < 4; ++j) { acc[j][h] = (lane + 64 * j < cnt) ? acc[j][h] * ATT_SCALE : -INFINITY; m = fmaxf(m, acc[j][h]); }
            m = wave_max(m); float l = 0.f;
#pragma unroll
            for (int j = 0; j < 4; ++j) { acc[j][h] = (lane + 64 * j < cnt) ? __expf(acc[j][h] - m) : 0.f; l += acc[j][h]; }
            l = 1.f / fmaxf(wave_sum(l), 1e-30f);
#pragma unroll
            for (int j = 0; j < 4; ++j) pf[h * 256 + lane + 64 * j] = acc[j][h] * l; }
        asm volatile("s_waitcnt lgkmcnt(0)" ::: "memory");
        float o[8][4];
#pragma unroll
        for (int h = 0; h < 8; ++h)
#pragma unroll
            for (int j = 0; j < 4; ++j) o[h][j] = 0.f;
#pragma unroll 1
        for (int k0 = 0; k0 < 256; k0 += 8) { u32x2 vv[8];
#pragma unroll
            for (int kk = 0; kk < 8; ++kk) { const int k = k0 + kk; const int idx = k < cnt ? selw[k] : 0; vv[kk] = *(const u32x2*)(KV + ((size_t)b * T + idx) * KVW + lane * 4); }
#pragma unroll
            for (int kk = 0; kk < 8; ++kk) { const float v0 = bflo(vv[kk][0]), v1 = bfhi(vv[kk][0]), v2 = bflo(vv[kk][1]), v3 = bfhi(vv[kk][1]);
#pragma unroll
                for (int h = 0; h < 8; ++h) { const float ph = pf[h * 256 + k0 + kk]; o[h][0] += ph * v0; o[h][1] += ph * v1; o[h][2] += ph * v2; o[h][3] += ph * v3; } } }
#pragma unroll
        for (int h = 0; h < 8; ++h) *(u32x2*)(OL + (size_t)tok * D + h * 256 + lane * 4) = (u32x2){pk2(o[h][0], o[h][1]), pk2(o[h][2], o[h][3])};
        asm volatile("s_waitcnt lgkmcnt(0)" ::: "memory");
    }
}

DI void nsa_score(const bf16_t* kr, const float* qf, float (&s)[4]) {
#pragma unroll
    for (int j = 0; j < 4; ++j) s[j] = 0.f;
#pragma unroll 4
    for (int c = 0; c < 16; ++c) { float kf[8]; unpack8(*(const u32x4*)(kr + c * 8), kf);
#pragma unroll
        for (int j = 0; j < 4; ++j) { const f32x4 q0 = *(const f32x4*)(qf + j * 128 + c * 8), q1 = *(const f32x4*)(qf + j * 128 + c * 8 + 4);
            s[j] += q0[0] * kf[0] + q0[1] * kf[1] + q0[2] * kf[2] + q0[3] * kf[3] + q1[0] * kf[4] + q1[1] * kf[5] + q1[2] * kf[6] + q1[3] * kf[7]; } }
}
DI void phase_nsa(const Params& p, char* smem) {
    const int tz_ = tid_fresh(); const int lane = tz_ & 63, wid = __builtin_amdgcn_readfirstlane(tz_ >> 6);
    float* qf = (float*)smem + wid * (512 + 256 + 512 + 16); float* pb = qf + 512; float* psum = pb + 256; int* blk = (int*)(psum + 512);
    const bf16_t* BQ = (const bf16_t*)(p.ws + O_BQ); const bf16_t* kvs = (const bf16_t*)(p.ws + O_KVS); const bf16_t* kcvc = (const bf16_t*)(p.ws + O_KCVC);
    const float* gates = (const float*)(p.ws + O_GATES); bf16_t* OB = (bf16_t*)(p.ws + O_OB);
#pragma unroll 1
    for (int item = (NT * 2 / 8 - 1 - (int)blockIdx.x) * 8 + wid; item >= 0; item -= gridDim.x * 8) {
        const int tok = item >> 1, g = item & 1, b = tok >> 13, tq = tok & (T - 1);
        { float f[8]; unpack8(*(const u32x4*)(BQ + (size_t)tok * 1024 + g * 512 + lane * 8), f);
#pragma unroll
          for (int j = 0; j < 8; ++j) qf[lane * 8 + j] = f[j]; }
        asm volatile("s_waitcnt lgkmcnt(0)" ::: "memory");
        const size_t bg = (size_t)(b * 2 + g);
        const int nmax = tq >= 31 ? (tq - 31) >> 4 : -1;
        float res[4][2], o[4][2], m[4], l[4]; int ns = 0;
#pragma unroll
        for (int j = 0; j < 4; ++j) { res[j][0] = 0.f; res[j][1] = 0.f; }
#pragma unroll 1
        for (int step = 0; step < 4; ++step) {
            const int kind = step < 2 ? 0 : step - 1;
            const int mode = step == 0 ? 1 : (step == 1 ? 2 : 0);
            const bf16_t* kbase; const bf16_t* vbase; int nch;
            if (kind == 0) { kbase = kcvc + bg * 512 * 128; vbase = kcvc + (size_t)2048 * 128 + bg * 512 * 128; nch = 8; }
            else if (kind == 1) { kbase = kvs + (2 * (size_t)NB * 2 + bg) * T * 128; vbase = kvs + (3 * (size_t)NB * 2 + bg) * T * 128; nch = ns; }
            else { kbase = kvs + (4 * (size_t)NB * 2 + bg) * T * 128; vbase = kvs + (5 * (size_t)NB * 2 + bg) * T * 128; nch = 8; }
            if (mode != 2) {
#pragma unroll
                for (int j = 0; j < 4; ++j) { m[j] = -INFINITY; l[j] = 0.f; } }
#pragma unroll
            for (int j = 0; j < 4; ++j) { o[j][0] = 0.f; o[j][1] = 0.f; }
#pragma unroll 1
            for (int c = 0; c < nch; ++c) {
                int base, lim_lo, lim_hi;
                if (kind == 0) { base = 64 * c; lim_lo = 0; lim_hi = nmax; }
                else if (kind == 1) { base = blk[c] * 64; lim_lo = 0; lim_hi = tq; }
                else { base = tq - 511 + 64 * c; lim_lo = 0; lim_hi = tq; }
                const bool active = base <= lim_hi && base + 63 >= lim_lo;
                if (!active) { if (mode == 2) psum[c * 64 + lane] = 0.f; continue; }
                const int key = base + lane; const bool valid = key >= lim_lo && key <= lim_hi;
                float s[4]; nsa_score(kbase + (size_t)(key < 0 ? 0 : key) * 128, qf, s);
                float ps = 0.f;
#pragma unroll
                for (int j = 0; j < 4; ++j) {
                    const float sv = valid ? s[j] * ATT_SCALE : -INFINITY; float pj;
                    if (mode == 2) { pj = valid ? __expf(sv - m[j]) * l[j] : 0.f; ps += pj; }
                    else { const float mn = fmaxf(m[j], wave_max(sv));
                        const float alpha = (m[j] == -INFINITY) ? 0.f : __expf(m[j] - mn);
                        pj = (sv == -INFINITY) ? 0.f : __expf(sv - mn);
                        l[j] = l[j] * alpha + wave_sum(pj); m[j] = mn; o[j][0] *= alpha; o[j][1] *= alpha; }
                    pb[j * 64 + lane] = pj; }
                if (mode == 2) psum[c * 64 + lane] = ps;
                if (mode != 1) {
                    asm volatile("s_waitcnt lgkmcnt(0)" ::: "memory");
#pragma unroll 1
                    for (int k0 = 0; k0 < 64; k0 += 8) { unsigned vv[8];
#pragma unroll
                        for (int kk = 0; kk < 8; ++kk) { const int kx = base + k0 + kk; vv[kk] = *(const unsigned*)(vbase + (size_t)(kx < 0 ? 0 : kx) * 128 + lane * 2); }
#pragma unroll
                        for (int kk = 0; kk < 8; ++kk) { const float v0 = bflo(vv[kk]), v1 = bfhi(vv[kk]);
#pragma unroll
                            for (int j = 0; j < 4; ++j) { const float ph = pb[j * 64 + k0 + kk]; o[j][0] += ph * v0; o[j][1] += ph * v1; } } } }
                asm volatile("s_waitcnt lgkmcnt(0)" ::: "memory");
            }
            if (step == 0) {
#pragma unroll
                for (int j = 0; j < 4; ++j) { if (m[j] == -INFINITY) m[j] = 0.f; l[j] = 1.f / fmaxf(l[j], 1e-30f); }
                continue; }
#pragma unroll
            for (int j = 0; j < 4; ++j) { const float gt = gates[(size_t)tok * 24 + (g * 4 + j) * 3 + kind]; const float il = (mode == 2) ? gt : gt / fmaxf(l[j], 1e-30f);
                res[j][0] += il * o[j][0]; res[j][1] += il * o[j][1]; }
            if (step == 1) {
                asm volatile("s_waitcnt lgkmcnt(0)" ::: "memory");
                const int cur = tq >> 6; unsigned key[2];
#pragma unroll
                for (int hh = 0; hh < 2; ++hh) { const int mb = lane + 64 * hh; float imp = 0.f;
#pragma unroll
                    for (int d = -1; d < 4; ++d) { const int n = 4 * mb + d; if (n >= 0 && n < 512) imp += psum[n]; }
                    const bool adm = mb <= cur, forced = mb == 0 || mb == cur || mb == cur - 1;
                    key[hh] = !adm ? 0u : (forced ? (0xFF000000u | (unsigned)(127 - mb)) : ((((__float_as_uint(imp) >> 7) + 1u) << 7) | (unsigned)(127 - mb))); }
                unsigned Tv = 0u;
                for (int bit = 31; bit >= 0; --bit) { const unsigned cand = Tv | (1u << bit);
                    const int cnt = __popcll(__ballot(key[0] >= cand)) + __popcll(__ballot(key[1] >= cand)); if (cnt >= 16) Tv = cand; }
                if (Tv == 0u) Tv = 1u;
                const unsigned long long m0 = __ballot(key[0] >= Tv), m1 = __ballot(key[1] >= Tv);
                const unsigned long long ltm = (1ull << lane) - 1ull;
                if (key[0] >= Tv) blk[__popcll(m0 & ltm)] = lane;
                if (key[1] >= Tv) blk[__popcll(m0) + __popcll(m1 & ltm)] = lane + 64;
                ns = __popcll(m0) + __popcll(m1);
                asm volatile("s_waitcnt lgkmcnt(0)" ::: "memory"); }
        }
#pragma unroll
        for (int j = 0; j < 4; ++j) *(unsigned*)(OB + (size_t)tok * 1024 + (g * 4 + j) * 128 + lane * 2) = pk2(res[j][0], res[j][1]);
        asm volatile("s_waitcnt lgkmcnt(0)" ::: "memory");
    }
}

typedef float f32x16 __attribute__((ext_vector_type(16)));
typedef short s16x4 __attribute__((ext_vector_type(4)));
#define MFMA32(a, b, c) __builtin_amdgcn_mfma_f32_32x32x16_bf16((a), (b), (c), 0, 0, 0)
DI unsigned offb(unsigned row, unsigned ch) { return 256u * row + 16u * (ch ^ (((row & 3u) << 2) | ((row >> 2) & 3u))); }
DI unsigned cvt2(float a, float b) { typedef __bf16 b2 __attribute__((ext_vector_type(2))); typedef float f2 __attribute__((ext_vector_type(2))); const b2 r = __builtin_convertvector((f2){a, b}, b2); return __builtin_bit_cast(unsigned, r); }
DI bf16x8 pack_relu(const f32x16& x, int s) {
    u32x4 w = {cvt2(x[8 * s], x[8 * s + 1]), cvt2(x[8 * s + 2], x[8 * s + 3]), cvt2(x[8 * s + 4], x[8 * s + 5]), cvt2(x[8 * s + 6], x[8 * s + 7])};
#pragma unroll
    for (int i = 0; i < 4; ++i) { unsigned r; asm volatile("v_pk_max_i16 %0, %1, 0" : "=v"(r) : "v"(w[i])); w[i] = r; }
    return __builtin_bit_cast(bf16x8, w);
}
DI bf16x8 pack_p(const f32x16& x, int s) {
    const u32x4 w = {cvt2(x[8 * s], x[8 * s + 1]), cvt2(x[8 * s + 2], x[8 * s + 3]), cvt2(x[8 * s + 4], x[8 * s + 5]), cvt2(x[8 * s + 6], x[8 * s + 7])};
    return __builtin_bit_cast(bf16x8, w);
}
DI void nsa_tile_dma(LAS char* kb, LAS char* vb, const bf16_t* kt, const bf16_t* vt, int tid, int w) {
#pragma unroll
    for (int i = 0; i < 2; ++i) { const int id = tid + 512 * i; const unsigned row = id >> 4, pos = id & 15; const unsigned ch = pos ^ (((row & 3u) << 2) | ((row >> 2) & 3u));
        const size_t so = (size_t)row * 128 + ch * 8; const unsigned lo = (unsigned)(i * 512 + w * 64) * 16u;
        __builtin_amdgcn_global_load_lds((const unsigned*)(kt + so), (LAS unsigned*)(kb + lo), 16, 0, 0);
        __builtin_amdgcn_global_load_lds((const unsigned*)(vt + so), (LAS unsigned*)(vb + lo), 16, 0, 0); }
}
#define NSA_TR8(R, A, OFF) asm volatile( \
    "ds_read_b64_tr_b16 %0, %8 offset:%16\n\tds_read_b64_tr_b16 %1, %9 offset:%16\n\tds_read_b64_tr_b16 %2, %10 offset:%16\n\tds_read_b64_tr_b16 %3, %11 offset:%16\n\t" \
    "ds_read_b64_tr_b16 %4, %12 offset:%16\n\tds_read_b64_tr_b16 %5, %13 offset:%16\n\tds_read_b64_tr_b16 %6, %14 offset:%16\n\tds_read_b64_tr_b16 %7, %15 offset:%16\n\ts_waitcnt lgkmcnt(0)" \
    : "=&v"(R[0]), "=&v"(R[1]), "=&v"(R[2]), "=&v"(R[3]), "=&v"(R[4]), "=&v"(R[5]), "=&v"(R[6]), "=&v"(R[7]) \
    : "v"(A[0]), "v"(A[1]), "v"(A[2]), "v"(A[3]), "v"(A[4]), "v"(A[5]), "v"(A[6]), "v"(A[7]), "i"(OFF) : "memory")

#define NSA_TR4(R, A0, A1, A2, A3, OFF) asm volatile( \
    "ds_read_b64_tr_b16 %0, %4 offset:%8\n\tds_read_b64_tr_b16 %1, %5 offset:%8\n\tds_read_b64_tr_b16 %2, %6 offset:%8\n\tds_read_b64_tr_b16 %3, %7 offset:%8" \
    : "=&v"(R[0]), "=&v"(R[1]), "=&v"(R[2]), "=&v"(R[3]) : "v"(A0), "v"(A1), "v"(A2), "v"(A3), "i"(OFF) : "memory")
#define NSA_LWAIT(N, R) asm volatile("s_waitcnt lgkmcnt(" #N ")" : "+v"(R[0]), "+v"(R[1]), "+v"(R[2]), "+v"(R[3]) :: "memory")
struct NsaWave {
    float m, l;
    f32x16 O[4];
    bf16x8 q[8];
};
template <int MODE>
DI void nsa_tile_compute(NsaWave& W, unsigned kbuf, unsigned vbuf, const unsigned (&vaddr0)[8], int tq0, int kind, int kbeg, bool needmask, bool rowneed, int lane, LAS float* impA, LAS float* impL, int mblk0) {
    const int c = lane & 31, h = lane >> 5;
    constexpr float C2 = ATT_SCALE * 1.4426950408889634f;
    f32x16 s0, s1;
    const f32x16 zero16 = {0.f, 0.f, 0.f, 0.f, 0.f, 0.f, 0.f, 0.f, 0.f, 0.f, 0.f, 0.f, 0.f, 0.f, 0.f, 0.f};
    const unsigned f = ((c & 3u) << 2) | ((c >> 2) & 3u);
#ifndef NSA_REP_QK
#define NSA_REP_QK 1
#endif
    __builtin_amdgcn_s_setprio(1);
#pragma unroll 1
    for (int rq_ = 0; rq_ < NSA_REP_QK; ++rq_) {
        if (NSA_REP_QK > 1) asm volatile("" ::: "memory");
#pragma unroll
    for (int s = 0; s < 8; ++s) { const unsigned ch = (unsigned)(2 * s + h) ^ f;
        const bf16x8 a0 = *(const LAS bf16x8*)(size_t)(kbuf + 256u * c + 16u * ch), a1 = *(const LAS bf16x8*)(size_t)(kbuf + 8192u + 256u * c + 16u * ch);
        s0 = MFMA32(a0, W.q[s], s == 0 ? zero16 : s0); s1 = MFMA32(a1, W.q[s], s == 0 ? zero16 : s1); } }
    __builtin_amdgcn_s_setprio(0);
    if (needmask) {
        const int tq = tq0 + (c >> 2);
        const int lo = kind == 2 ? tq - 511 : 0, hi = kind == 0 ? (tq >= 31 ? (tq - 31) >> 4 : -1) : tq;
#pragma unroll
        for (int r = 0; r < 16; ++r) { const int k0 = kbeg + (r & 3) + 8 * (r >> 2) + 4 * h, k1 = k0 + 32;
            if (!(k0 >= lo && k0 <= hi)) s0[r] = -INFINITY;
            if (!(k1 >= lo && k1 <= hi)) s1[r] = -INFINITY; }
    }
    if (MODE != 2) {
        float mx = fmaxf(fmaxf(s0[0], s0[1]), s1[0]);
#pragma unroll
        for (int r = 2; r < 16; r += 2) mx = fmaxf(fmaxf(mx, s0[r]), s0[r + 1]);
#pragma unroll
        for (int r = 1; r < 15; r += 2) mx = fmaxf(fmaxf(mx, s1[r]), s1[r + 1]);
        mx = fmaxf(mx, s1[15]);
        mx = fmaxf(mx, __shfl_xor(mx, 32));
        if (!rowneed) mx = -INFINITY;
        const float mn = (W.m == -INFINITY || (mx - W.m) * C2 > 8.f) ? fmaxf(W.m, mx) : W.m;
        const float mu = (mn == -INFINITY) ? 0.f : mn;
        const float alpha = __builtin_amdgcn_exp2f((W.m - mu) * C2);
        const float nb = rowneed ? -mu * C2 : -INFINITY;
        float rs = 0.f;
#pragma unroll
        for (int r = 0; r < 16; ++r) { s0[r] = __builtin_amdgcn_exp2f(__builtin_fmaf(s0[r], C2, nb)); s1[r] = __builtin_amdgcn_exp2f(__builtin_fmaf(s1[r], C2, nb)); rs += s0[r] + s1[r]; }
        rs += __shfl_xor(rs, 32);
        W.l = W.l * alpha + rs; W.m = mn;
        if (MODE == 0 && !__all(alpha == 1.f)) {
#pragma unroll
            for (int d = 0; d < 4; ++d)
#pragma unroll
                for (int r = 0; r < 16; ++r) W.O[d][r] *= alpha; }
    } else {
#pragma unroll
        for (int r = 0; r < 16; ++r) { s0[r] = __builtin_amdgcn_exp2f((s0[r] - W.m) * C2) * W.l; s1[r] = __builtin_amdgcn_exp2f((s1[r] - W.m) * C2) * W.l; }
#pragma unroll
        for (int kb = 0; kb < 2; ++kb)
#pragma unroll
            for (int i = 0; i < 4; ++i) { const f32x16& sv = kb ? s1 : s0;
                float a = sv[4 * i] + sv[4 * i + 1] + sv[4 * i + 2] + sv[4 * i + 3], lv = sv[4 * i + 3];
                a += __shfl_xor(a, 1); a += __shfl_xor(a, 2); lv += __shfl_xor(lv, 1); lv += __shfl_xor(lv, 2);
                if ((c & 3) == 0) { const int mb = mblk0 + 8 * kb + 2 * i + h; impA[(c >> 2) * 128 + mb] = a; impL[(c >> 2) * 128 + mb] = lv; } }
    }
    if (MODE != 1) {
        unsigned vaddrl[8];
        { const unsigned q = (lane & 15) >> 2, pp = lane & 3, blk = (lane >> 4) & 1;
#pragma unroll
          for (int d = 0; d < 4; ++d)
#pragma unroll
              for (int t = 0; t < 2; ++t) vaddrl[2 * d + t] = vbuf + offb(8u * t + 4u * h + q, 4u * d + 2u * blk + (pp >> 1)) + 8u * (pp & 1u); }
        bf16x8 pf[4] = {pack_p(s0, 0), pack_p(s0, 1), pack_p(s1, 0), pack_p(s1, 1)};
        s16x4 RA[4], RB[4];
        asm volatile("s_waitcnt lgkmcnt(0)" ::: "memory");
        NSA_TR4(RA, vaddrl[0], vaddrl[1], vaddrl[2], vaddrl[3], 0);
        NSA_TR4(RB, vaddrl[4], vaddrl[5], vaddrl[6], vaddrl[7], 0);
#define NSA_PVSTEP(KS, NEXTOFF, HASNEXT) \
        NSA_LWAIT(4, RA); __builtin_amdgcn_sched_barrier(0); \
        { const bf16x8 v0_ = __builtin_shufflevector(RA[0], RA[1], 0, 1, 2, 3, 4, 5, 6, 7), v1_ = __builtin_shufflevector(RA[2], RA[3], 0, 1, 2, 3, 4, 5, 6, 7); \
          W.O[0] = MFMA32(v0_, pf[KS], W.O[0]); W.O[1] = MFMA32(v1_, pf[KS], W.O[1]); } \
        __builtin_amdgcn_sched_barrier(0); \
        if (HASNEXT) NSA_TR4(RA, vaddrl[0], vaddrl[1], vaddrl[2], vaddrl[3], NEXTOFF); \
        if (HASNEXT) NSA_LWAIT(4, RB); else NSA_LWAIT(0, RB); \
        __builtin_amdgcn_sched_barrier(0); \
        { const bf16x8 v2_ = __builtin_shufflevector(RB[0], RB[1], 0, 1, 2, 3, 4, 5, 6, 7), v3_ = __builtin_shufflevector(RB[2], RB[3], 0, 1, 2, 3, 4, 5, 6, 7); \
          W.O[2] = MFMA32(v2_, pf[KS], W.O[2]); W.O[3] = MFMA32(v3_, pf[KS], W.O[3]); } \
        __builtin_amdgcn_sched_barrier(0); \
        if (HASNEXT) NSA_TR4(RB, vaddrl[4], vaddrl[5], vaddrl[6], vaddrl[7], NEXTOFF);
        __builtin_amdgcn_s_setprio(1);
        NSA_PVSTEP(0, 4096, true) NSA_PVSTEP(1, 8192, true) NSA_PVSTEP(2, 12288, true) NSA_PVSTEP(3, 0, false)
        __builtin_amdgcn_s_setprio(0);
#undef NSA_PVSTEP
    }
}
DI void nsa_fold(const NsaWave& W, bf16_t* obrow, unsigned char* ob8row, float sc, bool first, bool last, int h) {
#pragma unroll
    for (int d = 0; d < 4; ++d)
#pragma unroll
        for (int i = 0; i < 4; ++i) { bf16_t* pp = obrow + 32 * d + 8 * i + 4 * h; float o0 = 0.f, o1 = 0.f, o2 = 0.f, o3 = 0.f;
            if (!first) { const u32x2 w = *(const u32x2*)pp; o0 = bflo(w[0]); o1 = bfhi(w[0]); o2 = bflo(w[1]); o3 = bfhi(w[1]); }
            o0 += sc * W.O[d][4 * i]; o1 += sc * W.O[d][4 * i + 1]; o2 += sc * W.O[d][4 * i + 2]; o3 += sc * W.O[d][4 * i + 3];
            if (last) *(unsigned*)(ob8row + 32 * d + 8 * i + 4 * h) = pg8::fp8x4(o0 * pg8::A8_SCALE, o1 * pg8::A8_SCALE, o2 * pg8::A8_SCALE, o3 * pg8::A8_SCALE);
            else *(u32x2*)pp = (u32x2){cvt2(o0, o1), cvt2(o2, o3)}; }
}
struct NsaRun { LAS char* L; unsigned lds0; const bf16_t* kbase; const bf16_t* vbase; int t0, nt, kind, tqmin, lo_min, lo_max, hi_min, hi_max, tid, w; LAS unsigned* selm; LAS float* impA; LAS float* impL; };
template <int MODE>
DI void nsa_tiles(NsaWave& W, const NsaRun& R, const unsigned (&vaddr)[8]) {
    if (R.nt <= 0) return;
    const int lane = R.tid & 63, c = lane & 31;
    __syncthreads();
    nsa_tile_dma(R.L, R.L + 16384, R.kbase + (size_t)R.t0 * 8192, R.vbase + (size_t)R.t0 * 8192, R.tid, R.w);
    asm volatile("s_waitcnt vmcnt(0)" ::: "memory");
    __syncthreads();
#pragma unroll 1
    for (int i = 0; i < R.nt; ++i) {
        const int cur = i & 1, tt = R.t0 + i, kbeg = tt * 64;
        if (i + 1 < R.nt) nsa_tile_dma(R.L + (cur ^ 1) * 32768, R.L + (cur ^ 1) * 32768 + 16384, R.kbase + (size_t)(tt + 1) * 8192, R.vbase + (size_t)(tt + 1) * 8192, R.tid, R.w);
        bool rowneed = true;
        if (R.kind == 1) { const unsigned wsel = R.selm[(c >> 2) * 4 + (tt >> 5)]; rowneed = (wsel >> (tt & 31)) & 1u; }
        const bool skip = kbeg > R.hi_max || kbeg + 63 < R.lo_min || (R.kind == 1 && __ballot(rowneed) == 0ull);
        if (!skip) {
            const bool needmask = !(kbeg >= R.lo_max && kbeg + 63 <= R.hi_min);
            const unsigned kb_ = R.lds0 + cur * 32768u, vb_ = kb_ + 16384u;
            nsa_tile_compute<MODE>(W, kb_, vb_, vaddr, R.tqmin, R.kind, kbeg, needmask, rowneed, lane, R.impA, R.impL, MODE == 2 ? tt * 16 : 0);
        }
        asm volatile("s_waitcnt vmcnt(0)" ::: "memory");
        __syncthreads();
    }
}
DI void phase_nsa_mfma(const Params& p, char* smem) {
    const int tid = tid_fresh(), lane = tid & 63, w = __builtin_amdgcn_readfirstlane(tid >> 6), c = lane & 31, h = lane >> 5;
    LAS char* L = (LAS char*)smem;
    const unsigned lds0 = (unsigned)(size_t)L;
    LAS float* impA = (LAS float*)(L + 65536) + w * 1024; LAS float* impL = (LAS float*)(L + 65536 + 32768) + w * 1024;
    LAS unsigned* selm = (LAS unsigned*)(L + 131072) + w * 32;
    const bf16_t* BQ = (const bf16_t*)(p.ws + O_BQ); const bf16_t* kvs = (const bf16_t*)(p.ws + O_KVS); const bf16_t* kcvc = (const bf16_t*)(p.ws + O_KCVC);
    const float* gates = (const float*)(p.ws + O_GATES); bf16_t* OB = (bf16_t*)(p.ws + O_OB);
    unsigned vaddr[8];
    { const unsigned q = (lane & 15) >> 2, pp = lane & 3, blk = (lane >> 4) & 1;
#pragma unroll
      for (int d = 0; d < 4; ++d)
#pragma unroll
          for (int t = 0; t < 2; ++t) vaddr[2 * d + t] = offb(8u * t + 4u * h + q, 4u * d + 2u * blk + (pp >> 1)) + 8u * (pp & 1u); }
#pragma unroll 1
    for (int P = blockIdx.x; P < 256; P += gridDim.x) {
#pragma unroll 1
        for (int half = 0; half < 2; ++half) {
            const int bg = P >> 6, x = P & 63, qb = half == 0 ? 127 - x : x, b = bg >> 1, g = bg & 1, q0 = qb * 64;
            NsaWave W;
            const int tqmin = q0 + 8 * w, tqmax = tqmin + 7; const int tok = b * T + tqmin + (c >> 2);
            { const bf16_t* qr = BQ + (size_t)tok * 1024 + (g * 4 + (c & 3)) * 128 + 8 * h;
#pragma unroll
              for (int s = 0; s < 8; ++s) W.q[s] = *(const bf16x8*)(qr + 16 * s); }
#pragma unroll
            for (int i = 0; i < 16; ++i) { impA[lane + 64 * i] = 0.f; impL[lane + 64 * i] = 0.f; }
            for (int step = 0; step < 4; ++step) {
                const int kind = step < 2 ? 0 : step - 1;
                const bf16_t* kbase; const bf16_t* vbase; int t0, nt;
                int lo_min, lo_max, hi_min, hi_max;
                if (kind == 0) { kbase = kcvc + (size_t)bg * 512 * 128; vbase = kcvc + (size_t)2048 * 128 + (size_t)bg * 512 * 128;
                    t0 = 0; const int nlast = (q0 + 63 - 31) >> 4; nt = q0 + 63 >= 31 ? (nlast >> 6) + 1 : 0;
                    lo_min = 0; lo_max = 0; hi_min = tqmin >= 31 ? (tqmin - 31) >> 4 : -1; hi_max = tqmax >= 31 ? (tqmax - 31) >> 4 : -1; }
                else if (kind == 1) { kbase = kvs + (2 * (size_t)NB * 2 + bg) * T * 128; vbase = kvs + (3 * (size_t)NB * 2 + bg) * T * 128;
                    t0 = 0; nt = qb + 1; lo_min = 0; lo_max = 0; hi_min = tqmin; hi_max = tqmax; }
                else { kbase = kvs + (4 * (size_t)NB * 2 + bg) * T * 128; vbase = kvs + (5 * (size_t)NB * 2 + bg) * T * 128;
                    t0 = qb >= 8 ? qb - 8 : 0; nt = qb - t0 + 1; lo_min = tqmin - 511; lo_max = tqmax - 511; hi_min = tqmin; hi_max = tqmax; }
                if (step != 1) { W.m = -INFINITY; W.l = 0.f; }
#pragma unroll
                for (int d = 0; d < 4; ++d)
#pragma unroll
                    for (int r = 0; r < 16; ++r) W.O[d][r] = 0.f;
                {   NsaRun R; R.L = L; R.lds0 = lds0; R.kbase = kbase; R.vbase = vbase; R.t0 = t0; R.nt = nt; R.kind = kind; R.tqmin = tqmin; R.lo_min = lo_min; R.lo_max = lo_max; R.hi_min = hi_min; R.hi_max = hi_max;
                    R.tid = tid; R.w = w; R.selm = selm; R.impA = impA; R.impL = impL;
                    if (step == 0) nsa_tiles<1>(W, R, vaddr); else if (step == 1) nsa_tiles<2>(W, R, vaddr); else nsa_tiles<0>(W, R, vaddr); }
                if (step == 0) { if (W.m == -INFINITY) W.m = 0.f; W.l = 1.f / fmaxf(W.l, 1e-30f); continue; }
                { int lz = lane; asm volatile("" : "+v"(lz)); const int cz = lz & 31; const int tokz = b * T + tqmin + (cz >> 2);
                  const float gv = gates[(size_t)tokz * 24 + (g * 4 + (cz & 3)) * 3 + kind];
                  nsa_fold(W, OB + (size_t)tokz * 1024 + (g * 4 + (cz & 3)) * 128, (unsigned char*)(p.ws + O_OB8) + (size_t)tokz * 1024 + (g * 4 + (cz & 3)) * 128, step == 1 ? gv : gv / fmaxf(W.l, 1e-30f), step == 1, step == 3, lz >> 5); }
                if (step == 1) {
                    asm volatile("s_waitcnt lgkmcnt(0)" ::: "memory");
#pragma unroll 1
                    for (int qi = 0; qi < 8; ++qi) { const int tqq = tqmin + qi, curb = tqq >> 6; unsigned key[2];
#pragma unroll
                        for (int hh = 0; hh < 2; ++hh) { const int mb = lane + 64 * hh; const float imp = impA[qi * 128 + mb] + (mb > 0 ? impL[qi * 128 + mb - 1] : 0.f);
                            const bool adm = mb <= curb, forced = mb == 0 || mb == curb || mb == curb - 1;
                            key[hh] = !adm ? 0u : (forced ? (0xFF000000u | (unsigned)(127 - mb)) : ((((__float_as_uint(imp) >> 7) + 1u) << 7) | (unsigned)(127 - mb))); }
                        unsigned Tv = 0u;
                        for (int bit = 31; bit >= 0; --bit) { const unsigned cand = Tv | (1u << bit);
                            const int cnt = __popcll(__ballot(key[0] >= cand)) + __popcll(__ballot(key[1] >= cand)); if (cnt >= 16) Tv = cand; }
                        if (Tv == 0u) Tv = 1u;
                        const unsigned long long m0 = __ballot(key[0] >= Tv), m1 = __ballot(key[1] >= Tv);
                        if (lane == 0) { selm[qi * 4] = (unsigned)m0; selm[qi * 4 + 1] = (unsigned)(m0 >> 32); selm[qi * 4 + 2] = (unsigned)m1; selm[qi * 4 + 3] = (unsigned)(m1 >> 32); } }
                    asm volatile("s_waitcnt lgkmcnt(0)" ::: "memory");
                }
            }
        }
    }
}

DI void topk256_hist(LAS unsigned short* sck, int nk, LAS unsigned* hist, unsigned short* out, int lane) {
    const int nit = (nk + 511) >> 9;
    const unsigned long long ltm = (1ull << lane) - 1ull;
    const int sub = lane & 1;
    for (int k = nk + lane; k < 512 * nit; k += 64) sck[k] = 0;
    unsigned bsel = 0, cnt_above = 0;
#pragma unroll 1
    for (int rpp_ = 0; rpp_ < ((SEL_REP & 1) ? 2 : 1); ++rpp_) { bsel = 0; cnt_above = 0; asm volatile("" : "+v"(bsel), "+v"(cnt_above));
#pragma unroll 1
    for (int pass = 0; pass < 2; ++pass) {
        *(LAS u32x4*)(hist + 8 * lane) = (u32x4){0u, 0u, 0u, 0u}; *(LAS u32x4*)(hist + 8 * lane + 4) = (u32x4){0u, 0u, 0u, 0u};
        asm volatile("s_waitcnt lgkmcnt(0)" ::: "memory");
#pragma unroll 1
        for (int i = 0; i < nit; ++i) { const int k0 = 8 * (i * 64 + lane); const u32x4 wv = *(const LAS u32x4*)(sck + k0);
#pragma unroll
            for (int j = 0; j < 8; ++j) { const unsigned key = (j & 1) ? (wv[j >> 1] >> 16) : (wv[j >> 1] & 0xffffu);
                if (pass == 0) __hip_atomic_fetch_add(hist + 2 * (key >> 8) + sub, 1u, __ATOMIC_RELAXED, __HIP_MEMORY_SCOPE_WORKGROUP);
                else if ((key >> 8) == bsel) __hip_atomic_fetch_add(hist + 2 * (key & 255u) + sub, 1u, __ATOMIC_RELAXED, __HIP_MEMORY_SCOPE_WORKGROUP); } }
        asm volatile("s_waitcnt lgkmcnt(0)" ::: "memory");
        const u32x4 h0 = *(const LAS u32x4*)(hist + 8 * lane), h1 = *(const LAS u32x4*)(hist + 8 * lane + 4);
        const u32x4 c4 = {h0[0] + h0[1], h0[2] + h0[3], h1[0] + h1[1], h1[2] + h1[3]};
        const unsigned tot = c4[0] + c4[1] + c4[2] + c4[3];
        unsigned inc = tot;
#pragma unroll
        for (int o = 1; o < 64; o <<= 1) { const unsigned v = __shfl_down(inc, o); if (lane + o < 64) inc += v; }
        unsigned above = cnt_above + inc - tot;
        int found = -1; unsigned fabove = 0;
#pragma unroll
        for (int bb = 3; bb >= 0; --bb) { if (found < 0 && above < 256u && above + c4[bb] >= 256u) { found = 4 * lane + bb; fabove = above; } above += c4[bb]; }
        const unsigned long long fm = __ballot(found >= 0); const int src = __builtin_ctzll(fm);
        const unsigned fb = (unsigned)__shfl(found, src); cnt_above = (unsigned)__shfl((int)fabove, src);
        bsel = pass == 0 ? fb : ((bsel << 8) | fb);
    }
    }
    const unsigned Tv = bsel; const int need = 256 - (int)cnt_above; int pos = 0, eqc = 0;
#pragma unroll 1
    for (int rpe_ = 0; rpe_ < ((SEL_REP & 2) ? 2 : 1); ++rpe_) { pos = 0; eqc = 0; asm volatile("" : "+v"(pos), "+v"(eqc));
#pragma unroll 1
    for (int i = 0; i < nit; ++i) { const int k0 = 8 * (i * 64 + lane); const u32x4 wv = *(const LAS u32x4*)(sck + k0);
        bool eq[8], sl[8]; bool anyeq = false;
#pragma unroll
        for (int j = 0; j < 8; ++j) { const unsigned key = (j & 1) ? (wv[j >> 1] >> 16) : (wv[j >> 1] & 0xffffu); eq[j] = key == Tv; sl[j] = key > Tv; anyeq |= eq[j]; }
        if (__ballot(anyeq) != 0ull) {
            int below = 0, own = 0, etot = 0;
#pragma unroll
            for (int j = 0; j < 8; ++j) { const unsigned long long em = __ballot(eq[j]); below += __popcll(em & ltm); etot += __popcll(em); }
#pragma unroll
            for (int j = 0; j < 8; ++j) if (eq[j]) { if (eqc + below + own < need) sl[j] = true; ++own; }
            eqc += etot; }
#pragma unroll
        for (int j = 0; j < 8; ++j) { const unsigned long long sm = __ballot(sl[j]); if (sl[j]) out[pos + __popcll(sm & ltm)] = (unsigned short)(k0 + j); pos += __popcll(sm); } }
    }
}
DI void phase_indexer_mfma(const Params& p, char* smem) {
    const int tid = tid_fresh(), lane = tid & 63, w = __builtin_amdgcn_readfirstlane(tid >> 6), c = lane & 31, hh = lane >> 5;
    LAS unsigned short* sc = (LAS unsigned short*)(LAS char*)smem;
    LAS unsigned* hist = (LAS unsigned*)((LAS char*)smem + 131072) + w * 512;
    const bf16_t* Q = (const bf16_t*)(p.ws + O_QALL); const bf16_t* KI = (const bf16_t*)(p.ws + O_KIDX); const float* WI = (const float*)(p.ws + O_WIDX);
    unsigned short* SEL = (unsigned short*)(p.ws + O_SEL); int* NSEL = (int*)(p.ws + O_NSEL);
    const float* rope = (const float*)(p.ws + O_ROPE);
    c2_rows(p, smem);
    __syncthreads();
#pragma unroll 1
    for (int rnd = 0; rnd * (int)gridDim.x < NT / 8; ++rnd) {
        const int slot = (rnd & 1) ? (int)gridDim.x - 1 - (int)blockIdx.x : (int)blockIdx.x;
        const int u = NT / 8 - 1 - (rnd * (int)gridDim.x + slot);
        if (u < 0) continue;
        const int tok0 = u * 8, b = tok0 >> 13, q0 = tok0 & (T - 1), nkmax = q0 + 8;
        const int tok = tok0 + w, nk = q0 + w + 1;
        unsigned short* out = SEL + (size_t)tok * 256;
#ifndef IDX_REP_SCORE
#define IDX_REP_SCORE 1
#endif
#ifndef IDX_REP_SEL
#define IDX_REP_SEL 1
#endif
        for (int rs_ = 0; rs_ < IDX_REP_SCORE; ++rs_)
        if (nkmax > 256) {
            bf16x8 qa[2][4], Wf[2][2];
#pragma unroll
            for (int rb = 0; rb < 2; ++rb) { const bf16_t* qr = Q + (size_t)(tok0 + 4 * rb + (c >> 3)) * QC + 2304 + (c & 7) * 64 + 8 * hh;
#pragma unroll
                for (int s = 0; s < 4; ++s) qa[rb][s] = *(const bf16x8*)(qr + 16 * s);
                {
                    const float* rt = rope + (size_t)(tok0 + 4 * rb + (c >> 3)) * 48 + 32;
                    const u32x4 own = __builtin_bit_cast(u32x4, qa[rb][0]); u32x4 oth;
#pragma unroll
                    for (int k = 0; k < 4; ++k) oth[k] = (unsigned)__shfl_xor((int)own[k], 32);
                    float xa[8], xb[8], xr[8]; unpack8(own, xa); unpack8(oth, xb);
#pragma unroll
                    for (int j = 0; j < 8; ++j) { const float cs = rt[2 * j], sn = rt[2 * j + 1]; xr[j] = hh == 0 ? xa[j] * cs - xb[j] * sn : xa[j] * cs + xb[j] * sn; }
                    const u32x4 pk = {pk2(xr[0], xr[1]), pk2(xr[2], xr[3]), pk2(xr[4], xr[5]), pk2(xr[6], xr[7])};
                    qa[rb][0] = __builtin_bit_cast(bf16x8, pk); }
                { f32x4 wv = {0.f, 0.f, 0.f, 0.f}; if (c < 8) wv = *(const f32x4*)(WI + (size_t)(tok0 + c) * 8 + 4 * hh);
#pragma unroll
                  for (int sp = 0; sp < 2; ++sp) { const bool m0 = c == 4 * rb + 2 * sp, m1 = c == 4 * rb + 2 * sp + 1;
                      const u32x4 pkw = {m0 ? pk2(wv[0], wv[1]) : 0u, m0 ? pk2(wv[2], wv[3]) : 0u, m1 ? pk2(wv[0], wv[1]) : 0u, m1 ? pk2(wv[2], wv[3]) : 0u};
                      Wf[rb][sp] = __builtin_bit_cast(bf16x8, pkw); } } }
            const int npair = (nkmax + 63) >> 6;
            const bf16_t* kbase = KI + ((size_t)b * T + c) * 64 + 8 * hh;
            bf16x8 kb[2][4], kn[2][4];
            auto ldk = [&](bf16x8 (&dst)[2][4], int pr) {
#pragma unroll
                for (int tt = 0; tt < 2; ++tt) { int key0 = 64 * pr + 32 * tt; if (key0 + 31 >= T) key0 = T - 32;
#pragma unroll
                    for (int s = 0; s < 4; ++s) dst[tt][s] = *(const bf16x8*)(kbase + (size_t)key0 * 64 + 16 * s); } };
            if (w < npair) ldk(kb, w);
#pragma unroll
            for (int tt = 0; tt < 2; ++tt)
#pragma unroll
                for (int s = 0; s < 4; ++s) asm volatile("" : "+v"(kb[tt][s]));
#pragma unroll 1
            for (int pr = w; pr < npair; pr += 8) {
                if (pr + 8 < npair) ldk(kn, pr + 8);
#pragma unroll
                for (int tt = 0; tt < 2; ++tt) {
                    const int key = 64 * pr + 32 * tt + c;
                    f32x16 a0, a1; const f32x16 z16 = {0.f, 0.f, 0.f, 0.f, 0.f, 0.f, 0.f, 0.f, 0.f, 0.f, 0.f, 0.f, 0.f, 0.f, 0.f, 0.f};
#pragma unroll
                    for (int s = 0; s < 4; ++s) { a0 = MFMA32(qa[0][s], kb[tt][s], s == 0 ? z16 : a0); a1 = MFMA32(qa[1][s], kb[tt][s], s == 0 ? z16 : a1); }
                    f32x16 d2 = MFMA32(Wf[0][0], pack_relu(a0, 0), z16);
                    d2 = MFMA32(Wf[0][1], pack_relu(a0, 1), d2); d2 = MFMA32(Wf[1][0], pack_relu(a1, 0), d2); d2 = MFMA32(Wf[1][1], pack_relu(a1, 1), d2);
                    if (key < 8192) {
#pragma unroll
                        for (int qq = 0; qq < 4; ++qq) sc[(4 * hh + qq) * 8192 + key] = f16key(d2[qq]); }
                }
#pragma unroll
                for (int tt = 0; tt < 2; ++tt)
#pragma unroll
                    for (int s = 0; s < 4; ++s) kb[tt][s] = kn[tt][s];
            }
        }
        __syncthreads();
        if (nk <= 256) { for (int i = lane; i < 256; i += 64) out[i] = (unsigned short)(i < nk ? i : 0); if (lane == 0) NSEL[tok] = nk; }
        else { for (int rs_ = 0; rs_ < IDX_REP_SEL; ++rs_) topk256_hist(sc + w * 8192, nk, hist, out, lane); if (lane == 0) NSEL[tok] = 256; }
        __syncthreads();
    }
}

#define MFMA16(a, b, c) __builtin_amdgcn_mfma_f32_16x16x32_bf16((a), (b), (c), 0, 0, 0)
#define MLA_ROW 592
#define MLA_TR8(R, BASE, OFF) asm volatile( \
    "ds_read_b64_tr_b16 %0, %8 offset:%9\n\tds_read_b64_tr_b16 %1, %8 offset:%10\n\tds_read_b64_tr_b16 %2, %8 offset:%11\n\tds_read_b64_tr_b16 %3, %8 offset:%12\n\t" \
    "ds_read_b64_tr_b16 %4, %8 offset:%13\n\tds_read_b64_tr_b16 %5, %8 offset:%14\n\tds_read_b64_tr_b16 %6, %8 offset:%15\n\tds_read_b64_tr_b16 %7, %8 offset:%16\n\ts_waitcnt lgkmcnt(0)" \
    : "=&v"(R[0]), "=&v"(R[1]), "=&v"(R[2]), "=&v"(R[3]), "=&v"(R[4]), "=&v"(R[5]), "=&v"(R[6]), "=&v"(R[7]) \
    : "v"(BASE), "i"(OFF), "i"((OFF) + 16 * MLA_ROW), "i"((OFF) + 32), "i"((OFF) + 32 + 16 * MLA_ROW), "i"((OFF) + 64), "i"((OFF) + 64 + 16 * MLA_ROW), "i"((OFF) + 96), "i"((OFF) + 96 + 16 * MLA_ROW) : "memory")
DI void phase_mla_mfma(const Params& p, char* smem) {
    const int tid = tid_fresh(), lane = tid & 63, w = __builtin_amdgcn_readfirstlane(tid >> 6), fr = lane & 15, g = lane >> 4;
    LAS char* buf = (LAS char*)smem + w * (32 * MLA_ROW);
    const unsigned lbase = (unsigned)(size_t)buf;
    const bf16_t* Q = (const bf16_t*)(p.ws + O_QALL); const bf16_t* KV = (const bf16_t*)(p.ws + O_KVT);
    const unsigned short* SEL = (const unsigned short*)(p.ws + O_SEL); const int* NSEL = (const int*)(p.ws + O_NSEL); bf16_t* OL = (bf16_t*)(p.ws + O_OLAT);
    constexpr float C2 = ATT_SCALE * 1.4426950408889634f;
    int pf_cnt = 0, pf_s0 = 0, pf_s1 = 0;
    { const int tok = blockIdx.x * 8 + w; if (tok < NT) { pf_cnt = NSEL[tok]; if (lane < 32) { pf_s0 = SEL[(size_t)tok * 256 + lane]; pf_s1 = SEL[(size_t)tok * 256 + 32 + lane]; } } }
#pragma unroll 1
    for (int tok = blockIdx.x * 8 + w; tok < NT; tok += gridDim.x * 8) {
        const int b = tok >> 13; const int cnt = pf_cnt; const int cur_s0 = pf_s0, cur_s1 = pf_s1;
        { const int tn = tok + gridDim.x * 8; if (tn < NT) { pf_cnt = NSEL[tn]; if (lane < 32) { pf_s0 = SEL[(size_t)tn * 256 + lane]; pf_s1 = SEL[(size_t)tn * 256 + 32 + lane]; } } }
        bf16x8 qf[9];
        { const bf16_t* qr = Q + (size_t)tok * QC; const bf16x8 z8 = {0, 0, 0, 0, 0, 0, 0, 0};
#pragma unroll
          for (int s = 0; s < 8; ++s) qf[s] = fr < 8 ? *(const bf16x8*)(qr + fr * 256 + 32 * s + 8 * g) : z8;
          qf[8] = fr < 8 ? *(const bf16x8*)(qr + 2048 + fr * 32 + 8 * g) : z8;
          {
              const float* rt = (const float*)(p.ws + O_ROPE) + (size_t)tok * 48;
              const u32x4 own = __builtin_bit_cast(u32x4, qf[8]); u32x4 oth;
#pragma unroll
              for (int k = 0; k < 4; ++k) oth[k] = (unsigned)__shfl_xor((int)own[k], 32);
              float xa[8], xb[8], xr[8]; unpack8(own, xa); unpack8(oth, xb);
#pragma unroll
              for (int j = 0; j < 8; ++j) { const int fi = 8 * (g & 1) + j; const float cs = rt[2 * fi], sn = rt[2 * fi + 1]; xr[j] = g < 2 ? xa[j] * cs - xb[j] * sn : xa[j] * cs + xb[j] * sn; }
              const u32x4 pk = {pk2(xr[0], xr[1]), pk2(xr[2], xr[3]), pk2(xr[4], xr[5]), pk2(xr[6], xr[7])};
              qf[8] = __builtin_bit_cast(bf16x8, pk); } }
        f32x4 O[16];
#pragma unroll
        for (int d = 0; d < 16; ++d) O[d] = (f32x4){0.f, 0.f, 0.f, 0.f};
        float m = -INFINITY, l = 0.f;
        const int nchunk = (cnt + 31) >> 5;
        u32x4 st[18]; int selv_n = 0;
        const bf16_t* kvb = KV + (size_t)b * T * KVW;
        auto issue = [&](int selv, int lz) {
#pragma unroll
            for (int i = 0; i < 16; ++i) { const int r0 = __builtin_amdgcn_readlane(selv, 2 * i), r1 = __builtin_amdgcn_readlane(selv, 2 * i + 1); const int row = lz < 32 ? r0 : r1;
                st[i] = *(const u32x4*)(kvb + (size_t)row * KVW + (lz & 31) * 8); }
#pragma unroll
            for (int i = 0; i < 2; ++i) { const int row = __shfl(selv, 16 * i + (lz >> 2)); st[16 + i] = *(const u32x4*)(kvb + (size_t)row * KVW + 256 + (lz & 3) * 8); } };
        { int lz = lane; asm volatile("" : "+v"(lz));
          int selv = 0; if (lz < 32 && lz < cnt) selv = cur_s0;
          if (lz < 32 && 32 + lz < cnt) selv_n = cur_s1;
          issue(selv, lz); }
#pragma unroll 1
        for (int ch = 0; ch < nchunk; ++ch) {
            int lz = lane; asm volatile("" : "+v"(lz));
#pragma unroll
            for (int i = 0; i < 16; ++i) *(LAS u32x4*)(buf + (2 * i + (lz >> 5)) * MLA_ROW + (lz & 31) * 16) = st[i];
#pragma unroll
            for (int i = 0; i < 2; ++i) *(LAS u32x4*)(buf + (16 * i + (lz >> 2)) * MLA_ROW + 512 + (lz & 3) * 16) = st[16 + i];
            if (ch + 1 < nchunk) {
                const int selv = selv_n; selv_n = 0;
                { const int k = (ch + 2) * 32 + lz; if (lz < 32 && k < cnt) selv_n = SEL[(size_t)tok * 256 + k]; }
                issue(selv, lz); }
            asm volatile("s_waitcnt lgkmcnt(0)" ::: "memory");
            const int frz = lz & 15, gz = lz >> 4;
            f32x4 s0, s1; const f32x4 z4 = {0.f, 0.f, 0.f, 0.f};
#pragma unroll
            for (int s = 0; s < 9; ++s) { const bf16x8 a0 = *(const LAS bf16x8*)(buf + frz * MLA_ROW + (32 * s + 8 * gz) * 2), a1 = *(const LAS bf16x8*)(buf + (frz + 16) * MLA_ROW + (32 * s + 8 * gz) * 2);
                s0 = MFMA16(a0, qf[s], s == 0 ? z4 : s0); s1 = MFMA16(a1, qf[s], s == 0 ? z4 : s1); }
            float mx = -INFINITY;
#pragma unroll
            for (int j = 0; j < 4; ++j) { if (ch * 32 + 4 * gz + j >= cnt) s0[j] = -INFINITY; if (ch * 32 + 16 + 4 * gz + j >= cnt) s1[j] = -INFINITY; mx = fmaxf(mx, fmaxf(s0[j], s1[j])); }
            mx = fmaxf(mx, __shfl_xor(mx, 16)); mx = fmaxf(mx, __shfl_xor(mx, 32));
            const float mn = fmaxf(m, mx), mu = (mn == -INFINITY) ? 0.f : mn;
            const float alpha = __builtin_amdgcn_exp2f((m - mu) * C2);
            float rs = 0.f;
#pragma unroll
            for (int j = 0; j < 4; ++j) { s0[j] = __builtin_amdgcn_exp2f((s0[j] - mu) * C2); s1[j] = __builtin_amdgcn_exp2f((s1[j] - mu) * C2); rs += s0[j] + s1[j]; }
            rs += __shfl_xor(rs, 16); rs += __shfl_xor(rs, 32);
            l = l * alpha + rs; m = mn;
            if (!__all(alpha == 1.f)) {
#pragma unroll
                for (int d = 0; d < 16; ++d) O[d] *= alpha; }
            const u32x4 pw = {cvt2(s0[0], s0[1]), cvt2(s0[2], s0[3]), cvt2(s1[0], s1[1]), cvt2(s1[2], s1[3])};
            const bf16x8 pf = __builtin_bit_cast(bf16x8, pw);
            const unsigned tb = lbase + (unsigned)(4 * gz + (frz >> 2)) * MLA_ROW + 8u * (frz & 3);
#pragma unroll
            for (int dq = 0; dq < 4; ++dq) { s16x4 R[8];
                if (dq == 0) MLA_TR8(R, tb, 0); else if (dq == 1) MLA_TR8(R, tb, 128); else if (dq == 2) MLA_TR8(R, tb, 256); else MLA_TR8(R, tb, 384);
#pragma unroll
                for (int d = 0; d < 4; ++d) { const bf16x8 vf = __builtin_shufflevector(R[2 * d], R[2 * d + 1], 0, 1, 2, 3, 4, 5, 6, 7); O[4 * dq + d] = MFMA16(vf, pf, O[4 * dq + d]); } }
            asm volatile("s_waitcnt lgkmcnt(0)" ::: "memory");
        }
        const float il16 = pg8::A8_SCALE / fmaxf(l, 1e-30f);
        if (fr < 8) {
#pragma unroll
            for (int d = 0; d < 16; ++d) *(unsigned*)((unsigned char*)OL + (size_t)tok * D + fr * 256 + 16 * d + 4 * g) = pg8::fp8x4(O[d][0] * il16, O[d][1] * il16, O[d][2] * il16, O[d][3] * il16); }
    }
}

DI void phase_post_mix(const Params& p, char* smem, bool count) {
    const int tz_ = tid_fresh(); const int lane = tz_ & 63, wid = __builtin_amdgcn_readfirstlane(tz_ >> 6);
    float* part = (float*)smem;
    int* lcnt = (int*)(smem + 8 * 32 * 33 * 4);
    const bf16_t* MO = (const bf16_t*)(p.ws + O_MO); float* X1 = (float*)(p.ws + O_X1); bf16_t* H = (bf16_t*)(p.ws + O_H); const bf16_t* WR = (const bf16_t*)(p.ws + O_WRT);
    int* TOPI = (int*)(p.ws + O_TOPI); float* TOPW = (float*)(p.ws + O_TOPW); int* cnts = (int*)(p.ws + O_CNT);
    float* cvec = (float*)(smem + 36864);
#pragma unroll 1
    for (int ck = blockIdx.x; ck < NT / 64; ck += gridDim.x) {
        {   const int b = (ck * 64) >> 13;
            __syncthreads();
            *(f32x4*)(cvec + 4 * tz_) = *(const f32x4*)((const float*)(p.ws + O_MODACC) + b * 12288 + 4096 + 4 * tz_);
            *(f32x4*)(cvec + 2048 + 4 * tz_) = *(const f32x4*)(p.g_post_mix + 4 * tz_);
            *(f32x4*)(cvec + 4096 + 4 * tz_) = *(const f32x4*)(p.g_pre_ffn + 4 * tz_);
            *(f32x4*)(cvec + 6144 + 4 * tz_) = *(const f32x4*)((const float*)(p.ws + O_MODACC) + b * 12288 + 4 * 2048 + 4 * tz_);
            *(f32x4*)(cvec + 8192 + 4 * tz_) = *(const f32x4*)((const float*)(p.ws + O_MODACC) + b * 12288 + 3 * 2048 + 4 * tz_);
            __syncthreads(); }
#pragma unroll 1
        for (int j = 0; j < 8; ++j) {
            const int tok = ck * 64 + wid * 8 + j;
            u32x2 mo[8]; f32x4 xr[8];
#pragma unroll
            for (int i = 0; i < 8; ++i) { mo[i] = *(const u32x2*)(MO + (size_t)tok * D + 4 * (lane + 64 * i)); xr[i] = *(const f32x4*)(p.x + (size_t)tok * D + 4 * (lane + 64 * i)); }
            float v[32]; float ss = 0.f;
#pragma unroll
            for (int i = 0; i < 8; ++i) { const u32x2 w = mo[i];
                v[4 * i] = bflo(w[0]); v[4 * i + 1] = bfhi(w[0]); v[4 * i + 2] = bflo(w[1]); v[4 * i + 3] = bfhi(w[1]); }
#pragma unroll
            for (int i = 0; i < 32; ++i) ss += v[i] * v[i];
            const float rs = rsqrtf(wave_sum(ss) * (1.f / D) + NORM_EPS);
            float ss2 = 0.f;
#pragma unroll
            for (int i = 0; i < 8; ++i) { const int col = 4 * (lane + 64 * i); const f32x4 xv = xr[i], mg = *(const f32x4*)(cvec + col), gp = *(const f32x4*)(cvec + 2048 + col); f32x4 o;
#pragma unroll
                for (int q = 0; q < 4; ++q) { o[q] = xv[q] + mg[q] * (v[4 * i + q] * rs * gp[q]); v[4 * i + q] = o[q]; ss2 += o[q] * o[q]; }
                *(f32x4*)(X1 + (size_t)tok * D + col) = o; }
            const float rs2 = rsqrtf(wave_sum(ss2) * (1.f / D) + NORM_EPS);
#pragma unroll
            for (int i = 0; i < 8; ++i) { const int col = 4 * (lane + 64 * i); const f32x4 gf = *(const f32x4*)(cvec + 4096 + col), ms = *(const f32x4*)(cvec + 6144 + col), mh = *(const f32x4*)(cvec + 8192 + col); f32x4 hv;
#pragma unroll
                for (int q = 0; q < 4; ++q) hv[q] = v[4 * i + q] * rs2 * gf[q] * (1.f + ms[q]) + mh[q];
                *(u32x2*)(H + (size_t)tok * D + col) = (u32x2){pk2(hv[0], hv[1]), pk2(hv[2], hv[3])}; }
        }
        asm volatile("s_waitcnt vmcnt(0)" ::: "memory");
        __syncthreads();
        if (tz_ < 32) lcnt[tz_] = 0;
        {
            const int c = lane & 31, hh = lane >> 5, rb = wid & 1, ks = wid >> 1;
            const bf16_t* ap = H + (size_t)(ck * 64 + 32 * rb + c) * D + 512 * ks + 8 * hh; const bf16_t* bp = WR + (size_t)c * D + 512 * ks + 8 * hh;
            f32x16 acc;
#pragma unroll
            for (int i = 0; i < 16; ++i) acc[i] = 0.f;
#pragma unroll 8
            for (int sx = 0; sx < 32; ++sx) { const bf16x8 a = *(const bf16x8*)(ap + 16 * sx), bb = *(const bf16x8*)(bp + 16 * sx); acc = MFMA32(a, bb, acc); }
#pragma unroll
            for (int r = 0; r < 16; ++r) part[(wid * 32 + (r & 3) + 8 * (r >> 2) + 4 * hh) * 33 + c] = acc[r];
        }
        __syncthreads();
        if (tz_ < 64) {
            const int rbt = tz_ >> 5, row = tz_ & 31, tok = ck * 64 + tz_;
            float lg[32];
#pragma unroll
            for (int e = 0; e < 32; ++e) lg[e] = p.b_router[e] + part[((0 * 2 + rbt) * 32 + row) * 33 + e] + part[((1 * 2 + rbt) * 32 + row) * 33 + e] + part[((2 * 2 + rbt) * 32 + row) * 33 + e] + part[((3 * 2 + rbt) * 32 + row) * 33 + e];
            int te[4]; float tv[4];
#pragma unroll
            for (int k = 0; k < 4; ++k) { float mx = lg[0]; int bi = 0;
#pragma unroll
                for (int e = 1; e < 32; ++e) if (lg[e] > mx) { mx = lg[e]; bi = e; }
                te[k] = bi; tv[k] = mx;
#pragma unroll
                for (int e = 0; e < 32; ++e) if (e == bi) lg[e] = -INFINITY; }
            const float e1 = __expf(tv[1] - tv[0]), e2 = __expf(tv[2] - tv[0]), e3 = __expf(tv[3] - tv[0]); const float inv = 1.f / (1.f + e1 + e2 + e3);
            *(int4*)(TOPI + tok * 4) = make_int4(te[0], te[1], te[2], te[3]);
            *(f32x4*)(TOPW + tok * 4) = (f32x4){inv, e1 * inv, e2 * inv, e3 * inv};
            atomicAdd(lcnt + te[0], 1); atomicAdd(lcnt + te[1], 1); atomicAdd(lcnt + te[2], 1); atomicAdd(lcnt + te[3], 1);
        }
        __syncthreads();
        if (count && tz_ < 32) atomicAdd(cnts + tz_, lcnt[tz_]);
    }
}

DI int moe_tables(const Params& p, LAS int* tile_e, LAS int* pstart) {
    int* cnts = (int*)(p.ws + O_CNT);
    if (threadIdx.x < 64) {
        const int e = threadIdx.x & 31;
        const int c = __hip_atomic_load(cnts + e, __ATOMIC_RELAXED, __HIP_MEMORY_SCOPE_AGENT);
        const int nt = (c + 255) >> 8; int inc = nt;
#pragma unroll
        for (int o = 1; o < 32; o <<= 1) { const int v = __shfl_up(inc, o, 32); if (e >= o) inc += v; }
        const int start = inc - nt;
        if (threadIdx.x < 32) { pstart[e] = start * 256; for (int i = 0; i < nt; ++i) tile_e[start + i] = e; if (e == 31) pstart[NEXP] = inc; } }
    __syncthreads();
    return pstart[NEXP];
}
DI void phase_moe_gather(const Params& p, char* smem) {
    const int tz_ = tid_fresh(); const int lane = tz_ & 63, wid = __builtin_amdgcn_readfirstlane(tz_ >> 6);
    LAS int* tile_e = (LAS int*)(LAS char*)smem; LAS int* pstart = tile_e + 320; LAS int* lcnt = pstart + 40; LAS int* lbase = lcnt + 32;
    (void)moe_tables(p, tile_e, pstart);
    const bf16_t* H = (const bf16_t*)(p.ws + O_H); unsigned char* HS = (unsigned char*)(p.ws + O_HS);
    const int* TOPI = (const int*)(p.ws + O_TOPI); const float* TOPW = (const float*)(p.ws + O_TOPW); int* TSLOT = (int*)(p.ws + O_TSLOT); float* SLOTW = (float*)(p.ws + O_SLOTW);
    int* fill = (int*)(p.ws + O_CNT) + 32;
#pragma unroll 1
    for (int ck = blockIdx.x; ck < NT / 64; ck += gridDim.x) {
        const int tok0 = ck * 64 + wid * 8;
        __syncthreads();
        if (tz_ < 32) lcnt[tz_] = 0;
        __syncthreads();
        int e = 0, rank = 0;
        if (lane < 32) { e = TOPI[tok0 * 4 + lane]; rank = atomicAdd((int*)(lcnt + e), 1); }
        __syncthreads();
        if (tz_ < 32) lbase[tz_] = atomicAdd(fill + tz_, lcnt[tz_]);
        __syncthreads();
        int slot = 0;
        if (lane < 32) { slot = pstart[e] + lbase[e] + rank; TSLOT[tok0 * 4 + lane] = slot; SLOTW[slot] = TOPW[tok0 * 4 + lane]; }
#pragma unroll 2
        for (int j = 0; j < 8; ++j) { u32x2 hv[4];
#pragma unroll
            for (int i = 0; i < 4; ++i) { float f[8]; unpack8(*(const u32x4*)(H + (size_t)(tok0 + j) * D + 8 * (lane + 64 * i)), f);
                hv[i] = (u32x2){pg8::fp8x4(f[0], f[1], f[2], f[3]), pg8::fp8x4(f[4], f[5], f[6], f[7])}; }
#pragma unroll
            for (int k = 0; k < 4; ++k) { const int sl = __shfl(slot, j * 4 + k);
#pragma unroll
                for (int i = 0; i < 4; ++i) *(u32x2*)(HS + (size_t)sl * D + 8 * (lane + 64 * i)) = hv[i]; } }
    }
}
DI void phase_final(const Params& p) {
    const int tz_ = tid_fresh(); const int lane = tz_ & 63, wid = __builtin_amdgcn_readfirstlane(tz_ >> 6);
    const unsigned char* YS = (const unsigned char*)(p.ws + O_YS); const float* X1 = (const float*)(p.ws + O_X1); const int* TSLOT = (const int*)(p.ws + O_TSLOT);
    for (int tok = blockIdx.x * 8 + wid; tok < NT; tok += gridDim.x * 8) {
        const int b = tok >> 13; float v[32];
#pragma unroll
        for (int i = 0; i < 32; ++i) v[i] = 0.f;
#pragma unroll
        for (int k = 0; k < 4; ++k) { const int slot = TSLOT[tok * 4 + k];
#pragma unroll
            for (int i = 0; i < 8; ++i) { const unsigned w = *(const unsigned*)(YS + (size_t)slot * D + 4 * (lane + 64 * i));
                const auto lo = __builtin_amdgcn_cvt_pk_f32_fp8((int)w, false), hi = __builtin_amdgcn_cvt_pk_f32_fp8((int)w, true);
                v[4 * i] += lo[0]; v[4 * i + 1] += lo[1]; v[4 * i + 2] += hi[0]; v[4 * i + 3] += hi[1]; } }
#pragma unroll
        for (int i = 0; i < 32; ++i) v[i] *= pg8::Y8_INV;
        float ss = 0.f;
#pragma unroll
        for (int i = 0; i < 32; ++i) ss += v[i] * v[i];
        const float rs = rsqrtf(wave_sum(ss) * (1.f / D) + NORM_EPS);
#pragma unroll
        for (int i = 0; i < 8; ++i) { const int col = 4 * (lane + 64 * i); const f32x4 xv = *(const f32x4*)(X1 + (size_t)tok * D + col); f32x4 o;
#pragma unroll
            for (int j = 0; j < 4; ++j) o[j] = xv[j] + mod_at(p, b, 5 * 2048 + col + j) * (v[4 * i + j] * rs * p.g_post_ffn[col + j]);
            *(f32x4*)(p.out + (size_t)tok * D + col) = o; }
    }
}

#ifndef PHMASK
#define PHMASK 0xFFFFFFFFu
#endif
#define PHON(ph) (((PHMASK) >> (ph)) & 1u)
#ifndef REPMASK
#define REPMASK 0u
#endif
#define REP(ph) _Pragma("unroll 1") for (int rep_ = 0; rep_ <= (int)(((REPMASK) >> (ph)) & 1u); ++rep_)
enum { PH_PREP = 0, PH_H1, PH_GIN, PH_ZPOST, PH_GQ, PH_QROPE, PH_IDX, PH_MLA, PH_NSA, PH_MERGE, PH_GOUT, PH_POSTMIX, PH_GATHER, PH_GU, PH_DN, PH_FINAL, PH_END };

__global__ void __launch_bounds__(512, 2) mega(Params p, int lo, int hi) {
    extern __shared__ __attribute__((aligned(16))) char smem[];
    LAS unsigned char* lds = (LAS unsigned char*)(LAS char*)smem;
    volatile LAS unsigned* xbw = (volatile LAS unsigned*)(LAS char*)(smem + LDS_BYTES - 16);
    XcdBarrier bar; bar.bar = (unsigned*)p.ws; bar.x = 0; bar.st = xbw;
    if (hi - lo > 1) { if (threadIdx.x == 0) { xbw[0] = 0u; xbw[1] = 0u; } __syncthreads(); bar = xcd_barrier_post((unsigned*)p.ws, xbw); }
    const int G = gridDim.x, c = blockIdx.x;
#define SEAM(ph) if ((ph) + 1 < hi) xcd_barrier(bar);
    if (PHON(PH_PREP) && lo <= PH_PREP && PH_PREP < hi) { REP(PH_PREP) { phase_prep(p, smem); } SEAM(PH_PREP) }
    if (PHON(PH_H1) && lo <= PH_H1 && PH_H1 < hi) { REP(PH_H1) { phase_h1(p); } SEAM(PH_H1) }
    if (PHON(PH_GIN) && lo <= PH_GIN && PH_GIN < hi) { REP(PH_GIN) {
        { pg8::PlainSched S; S.init(NT, 2048, G, c, p.ws + O_H, D, p.ws + O_WIN, D);
          pg8::EpiBf16 E; E.O = (bf16_t*)(p.ws + O_Z); E.ldc = ZC; E.scale = 1.f;
          pg8::gemm_phase(lds, pg8::Gemm{D, D, D}, S, E); }
        { pg8::PlainSched S; S.init(NT, ZC - 2048, G, c, p.ws + O_H8, D / 2, p.ws + O_WIN8 + (size_t)2048 * D, D / 2);
          pg8::EpiBf16 E; E.O = (bf16_t*)(p.ws + O_Z) + 2048; E.ldc = ZC; E.scale = pg8::W8_INV;
          pg8::gemm_phase_fp8(lds, pg8::Gemm{D / 2, D / 2, D / 2}, S, E); }
        } SEAM(PH_GIN) }
    if (PHON(PH_ZPOST) && lo <= PH_ZPOST && PH_ZPOST < hi) { REP(PH_ZPOST) { phase_zpost(p); } SEAM(PH_ZPOST) }
    if (PHON(PH_GQ) && lo <= PH_GQ && PH_GQ < hi) { REP(PH_GQ) {
        { pg8::PlainSched S; S.init(NT, QC, G, c, p.ws + O_CQN, 512, p.ws + O_WQ, 512);
          pg8::EpiBf16 E; E.O = (bf16_t*)(p.ws + O_QALL); E.ldc = QC; E.scale = 1.f;
          pg8::gemm_phase(lds, pg8::Gemm{512, 512, 512}, S, E); }
        { pg8::C1Sched S; S.G = G; S.c = c; S.kvs = p.ws + O_KVS; S.w = p.ws + O_WC1;
          pg8::EpiC1 E; E.C = (float*)(p.ws + O_C1P);
          pg8::gemm_phase(lds, pg8::Gemm{2048, 4096, 256}, S, E); }
        } SEAM(PH_GQ) }
    if (PHON(PH_IDX) && lo <= PH_IDX && PH_IDX < hi) { REP(PH_IDX) {
#ifdef IDX_NAIVE
        phase_indexer(p, smem);
#else
        phase_indexer_mfma(p, smem);
#endif
        } SEAM(PH_IDX) }
    if (PHON(PH_MLA) && lo <= PH_MLA && PH_MLA < hi) { REP(PH_MLA) {
#ifdef MLA_NAIVE
        phase_mla(p, smem);
#else
        phase_mla_mfma(p, smem);
#endif
        } SEAM(PH_MLA) }
    if (PHON(PH_NSA) && lo <= PH_NSA && PH_NSA < hi) { REP(PH_NSA) {
#ifdef NSA_NAIVE
        phase_nsa(p, smem);
#else
        phase_nsa_mfma(p, smem);
#endif
        } SEAM(PH_NSA) }
    if (PHON(PH_MERGE) && lo <= PH_MERGE && PH_MERGE < hi) { REP(PH_MERGE) {
        { pg8::PlainSched S; S.init(NT, D, G, c, p.ws + O_OLAT, D / 2, p.ws + O_WO, D / 2);
          pg8::EpiMerge<false> E; E.P = (bf16_t*)(p.ws + O_MERGED); E.O8 = nullptr; E.Z = (const bf16_t*)(p.ws + O_Z); E.gcol0 = ZC_MG; E.scale = pg8::A8W8_INV;
          pg8::gemm_phase_fp8(lds, pg8::Gemm{D / 2, D / 2, D / 2}, S, E); }
        { pg8::PlainSched S; S.init(NT, D, G, c, p.ws + O_OB8, 512, p.ws + O_WBRB, 512);
          pg8::EpiMerge<true> E; E.P = (bf16_t*)(p.ws + O_MERGED); E.O8 = (unsigned char*)(p.ws + O_MG8); E.Z = (const bf16_t*)(p.ws + O_Z); E.gcol0 = ZC_MG + 2048; E.scale = pg8::A8W8_INV;
          pg8::gemm_phase_fp8(lds, pg8::Gemm{512, 512, 512}, S, E); }
        } SEAM(PH_MERGE) }
    if (PHON(PH_GOUT) && lo <= PH_GOUT && PH_GOUT < hi) { REP(PH_GOUT) {
        pg8::PlainSched S; S.init(NT, D, G, c, p.ws + O_MG8, D / 2, p.ws + O_WOUT, D / 2);
        pg8::EpiBf16 E; E.O = (bf16_t*)(p.ws + O_MO); E.ldc = D; E.scale = pg8::A8W8_INV;
        pg8::gemm_phase_fp8(lds, pg8::Gemm{D / 2, D / 2, D / 2}, S, E); } SEAM(PH_GOUT) }
    if (PHON(PH_POSTMIX) && lo <= PH_POSTMIX && PH_POSTMIX < hi) { REP(PH_POSTMIX) { phase_post_mix(p, smem, rep_ == 0); } SEAM(PH_POSTMIX) }
    if (PHON(PH_GATHER) && lo <= PH_GATHER && PH_GATHER < hi) { REP(PH_GATHER) { phase_moe_gather(p, smem); } SEAM(PH_GATHER) }
    if (PHON(PH_GU) && lo <= PH_GU && PH_GU < hi) { REP(PH_GU) {
        LAS int* tile_e = (LAS int*)(LAS char*)(smem + 131072); LAS int* pstart = tile_e + 320;
        const int mt = moe_tables(p, tile_e, pstart);
        pg8::MoeSched S; S.G = G; S.c = c; S.nN = 16; S.total = mt * 16; S.tile_e = tile_e; S.A = p.ws + O_HS; S.W = p.ws + O_WGU; S.w_exp = (size_t)4096 * D;
        pg8::EpiGU E; E.O = (unsigned char*)(p.ws + O_ACT); E.bias = p.b_gate_up;
        pg8::gemm_phase_fp8(lds, pg8::Gemm{D / 2, D / 2, D / 2, 64, 16384}, S, E); } SEAM(PH_GU) }
    if (PHON(PH_DN) && lo <= PH_DN && PH_DN < hi) { REP(PH_DN) {
        LAS int* tile_e = (LAS int*)(LAS char*)(smem + 131072); LAS int* pstart = tile_e + 320;
        const int mt = moe_tables(p, tile_e, pstart);
        pg8::MoeSched S; S.G = G; S.c = c; S.nN = 8; S.total = mt * 8; S.tile_e = tile_e; S.A = p.ws + O_ACT; S.W = p.ws + O_WDN; S.w_exp = (size_t)D * D;
        pg8::EpiDN E; E.O = (unsigned char*)(p.ws + O_YS); E.bias = p.b_down; E.slotw = (const float*)(p.ws + O_SLOTW);
        pg8::gemm_phase_fp8(lds, pg8::Gemm{D / 2, D / 2, D / 2, 64, 16384}, S, E); } SEAM(PH_DN) }
    if (PHON(PH_FINAL) && lo <= PH_FINAL && PH_FINAL < hi) { REP(PH_FINAL) { phase_final(p); } }
#undef SEAM
}

extern "C" void kernel_launch(void* const* d_in, const int* in_sizes, int n_in, void* d_out, int out_size, void* d_ws, size_t ws_size, hipStream_t stream) {
    static int grid = 0;
    if (grid == 0) {
        if (n_in != 33 || out_size != NT * D || ws_size < WS_END) { fprintf(stderr, "kernel_launch: unexpected shapes (n_in %d out %d ws %zu need %zu)\n", n_in, out_size, ws_size, (size_t)WS_END); grid = -1; return; }
        int dev = 0, cus = 0;
        if (hipGetDevice(&dev) != hipSuccess || hipDeviceGetAttribute(&cus, hipDeviceAttributeMultiprocessorCount, dev) != hipSuccess) { grid = -1; return; }
        if (hipFuncSetAttribute((const void*)mega, hipFuncAttributeMaxDynamicSharedMemorySize, LDS_BYTES) != hipSuccess) { fprintf(stderr, "kernel_launch: hipFuncSetAttribute failed\n"); grid = -1; return; }
        int per_cu = 0; (void)hipOccupancyMaxActiveBlocksPerMultiprocessor(&per_cu, (const void*)mega, 512, LDS_BYTES); (void)hipGetLastError();
        grid = cus;
    }
    if (grid < 0) return;
    Params p{};
    const float** pf = (const float**)&p;
    for (int i = 0; i < 33; ++i) pf[i] = (const float*)d_in[i];
    p.pos = (const int*)d_in[2];
    p.out = (float*)d_out; p.ws = (char*)d_ws;
    hipMemsetAsync(d_ws, 0, ZERO_BYTES, stream);
#ifdef MK_UNFUSED
    for (int ph = 0; ph < PH_END; ++ph) hipLaunchKernelGGL(mega, dim3(grid), dim3(512), LDS_BYTES, stream, p, ph, ph + 1);
#else
    hipLaunchKernelGGL(mega, dim3(grid), dim3(512), LDS_BYTES, stream, p, 0, (int)PH_END);
#endif
}
```

```cpp
#include <hip/hip_runtime.h>
#include <stdint.h>
#include <stdio.h>

#define LAS __attribute__((address_space(3)))
#define DI __device__ __forceinline__
typedef unsigned short bf16_t;
typedef short bf16x8 __attribute__((ext_vector_type(8)));
typedef float f32x4 __attribute__((ext_vector_type(4)));
typedef unsigned u32x4 __attribute__((ext_vector_type(4)));
typedef unsigned u32x2 __attribute__((ext_vector_type(2)));

#define PREP_PROBE_WC 0
#define PREP_PROBE_MODE 0
#define PREP_REP 0
#define SEL_REP 0
#define PREP_REP_LO 0
#define PREP_REP_HI 100000
#define PREP_PROBE_NFAST 0
constexpr int NB = 2, T = 8192, NT = NB * T, D = 2048;
constexpr int ZC = 7680;
constexpr int ZC_CKV = 512, ZC_KROPE = 768, ZC_KIDX = 800, ZC_WIDX = 864, ZC_BGATE = 872, ZC_BQ = 1024, ZC_MG = 3584;
constexpr int QC = 2816;
constexpr int KVW = 288;
constexpr int NEXP = 32, SLOTS = 73728, MAXMT = SLOTS / 256;
constexpr float NORM_EPS = 1e-6f;
constexpr float ATT_SCALE = 0.08838834764831845f;
constexpr int LDS_BYTES = 152 * 1024;

constexpr size_t al256(size_t x) { return (x + 255) & ~(size_t)255; }
constexpr size_t ZERO_BYTES = 131072;
constexpr size_t O_MODACC = 16384, O_CNT = 114688;
constexpr size_t O_ROPE = ZERO_BYTES;
constexpr size_t O_WIN = O_ROPE + al256((size_t)NT * 48 * 4);
constexpr size_t O_WQ = O_WIN + al256((size_t)ZC * D * 2);
constexpr size_t O_WO = O_WQ + al256((size_t)QC * 512 * 2);
constexpr size_t O_WBRB = O_WO + al256((size_t)D * D * 2);
constexpr size_t O_WOUT = O_WBRB + al256((size_t)D * 1024 * 2);
constexpr size_t O_WC1 = O_WOUT + al256((size_t)D * D * 2);
constexpr size_t O_CBIAS = O_WC1 + al256((size_t)2 * 256 * 4096 * 2);
constexpr size_t O_CBP = O_CBIAS + al256(2 * 256 * 4);
constexpr size_t O_WRT = O_CBP + al256(64 * 2 * 256 * 4);
constexpr size_t O_WGU = O_WRT + al256((size_t)256 * D * 2);
constexpr size_t O_WDN = O_WGU + al256((size_t)NEXP * 4096 * D * 2);
constexpr size_t O_H = O_WDN + al256((size_t)NEXP * D * D * 2);
constexpr size_t O_Z = O_H + al256((size_t)NT * D * 2);
constexpr size_t O_CQN = O_Z + al256((size_t)NT * ZC * 2);
constexpr size_t O_KVT = O_CQN + al256((size_t)NT * 512 * 2);
constexpr size_t O_KIDX = O_KVT + al256((size_t)NT * KVW * 2);
constexpr size_t O_WIDX = O_KIDX + al256((size_t)NT * 64 * 2);
constexpr size_t O_GATES = O_WIDX + al256((size_t)NT * 8 * 4);
constexpr size_t O_BQ = O_GATES + al256((size_t)NT * 24 * 4);
constexpr size_t KVS_ONE = (size_t)NB * 2 * T * 128;
constexpr size_t O_KVS = O_BQ + al256((size_t)NT * 1024 * 2);
constexpr size_t O_QALL = O_KVS + al256(6 * KVS_ONE * 2 + 65536);
constexpr size_t O_C1P = O_QALL + al256((size_t)NT * QC * 2);
constexpr size_t O_KCVC = O_C1P + al256((size_t)16 * 2 * 2048 * 256 * 4);
constexpr size_t O_SEL = O_KCVC + al256((size_t)2 * 2048 * 128 * 2);
constexpr size_t O_NSEL = O_SEL + al256((size_t)NT * 256 * 2);
constexpr size_t O_OLAT = O_NSEL + al256((size_t)NT * 4);
constexpr size_t O_OB = O_OLAT + al256((size_t)NT * D * 2);
constexpr size_t O_MERGED = O_OB + al256((size_t)NT * 1024 * 2);
constexpr size_t O_MO = O_MERGED + al256((size_t)NT * D * 2);
constexpr size_t O_X1 = O_MO + al256((size_t)NT * D * 2);
constexpr size_t O_TOPI = O_X1 + al256((size_t)NT * D * 4);
constexpr size_t O_TOPW = O_TOPI + al256((size_t)NT * 4 * 4);
constexpr size_t O_TSLOT = O_TOPW + al256((size_t)NT * 4 * 4);
constexpr size_t O_SLOTW = O_TSLOT + al256((size_t)NT * 4 * 4);
constexpr size_t O_HS = O_SLOTW + al256((size_t)SLOTS * 4);
constexpr size_t O_ACT = O_HS + al256((size_t)SLOTS * D);
constexpr size_t O_YS = O_ACT + al256((size_t)SLOTS * D);
constexpr size_t O_OB8 = O_YS + al256((size_t)SLOTS * D * 2);
constexpr size_t O_MG8 = O_OB8 + al256((size_t)NT * 1024);
constexpr size_t O_WIN8 = O_MG8 + al256((size_t)NT * D);
constexpr size_t O_H8 = O_WIN8 + al256((size_t)ZC * D);
constexpr size_t WS_END = O_H8 + al256((size_t)NT * D);

struct Params {
    const float* x; const float* c; const int* pos; const float* w_ada; const float* b_ada;
    const float* g_pre_mix; const float* g_post_mix; const float* g_pre_ffn; const float* g_post_ffn;
    const float* w_in; const float* a_cq_norm; const float* a_ckv_norm; const float* a_w_uq; const float* a_w_uk; const float* a_w_uv;
    const float* idx_w_q; const float* idx_g; const float* idx_b;
    const float* cmp_k_pe; const float* cmp_k_w1; const float* cmp_k_w2; const float* cmp_v_pe; const float* cmp_v_w1; const float* cmp_v_w2;
    const float* w_br_a; const float* w_br_b; const float* w_out; const float* w_router; const float* b_router;
    const float* w_gate_up; const float* b_gate_up; const float* w_down; const float* b_down;
    float* out; char* ws;
};

DI int tid_fresh() { int t = threadIdx.x; asm volatile("" : "+v"(t)); return t; }
DI float bf2f(bf16_t v) { return __uint_as_float((unsigned)v << 16); }
DI float bflo(unsigned w) { return __uint_as_float(w << 16); }
DI float bfhi(unsigned w) { return __uint_as_float(w & 0xffff0000u); }
DI bf16_t f2bf(float f) { unsigned u = __float_as_uint(f); u += 0x7FFFu + ((u >> 16) & 1u); return (bf16_t)(u >> 16); }
DI unsigned pk2(float lo, float hi) { unsigned r; asm volatile("v_cvt_pk_bf16_f32 %0, %1, %2" : "=v"(r) : "v"(lo), "v"(hi)); return r; }
DI float wave_sum(float v) {
#pragma unroll
    for (int o = 1; o < 64; o <<= 1) v += __shfl_xor(v, o);
    return v;
}
DI float wave_max(float v) {
#pragma unroll
    for (int o = 1; o < 64; o <<= 1) v = fmaxf(v, __shfl_xor(v, o));
    return v;
}
DI float sigmoidf_(float v) { return __builtin_amdgcn_rcpf(1.f + __expf(-v)); }
DI void unpack8(const u32x4& w, float (&f)[8]) {
    f[0] = bflo(w[0]); f[1] = bfhi(w[0]); f[2] = bflo(w[1]); f[3] = bfhi(w[1]); f[4] = bflo(w[2]); f[5] = bfhi(w[2]); f[6] = bflo(w[3]); f[7] = bfhi(w[3]);
}
DI float mod_at(const Params& p, int b, int j) { return ((const float*)(p.ws + O_MODACC))[b * 12288 + j]; }

#define XB_TMO      128
#define XB_XCNT(j)  (256  + 64 * (j))
#define XB_XSUB(j)  (1280 + 64 * (j))
#define XB_XGEN(j)  (2304 + 64 * (j))
#define XB_TOP      3328
#define XB_TOPGEN   3392
#define XCD_BAR_WORDS 3456
#define XB_SPIN_CAP (1u << 22)
DI unsigned xb_ld(unsigned* p)              { return __hip_atomic_load(p, __ATOMIC_RELAXED, __HIP_MEMORY_SCOPE_AGENT); }
DI unsigned xb_add(unsigned* p, unsigned v) { return __hip_atomic_fetch_add(p, v, __ATOMIC_RELAXED, __HIP_MEMORY_SCOPE_AGENT); }
DI unsigned xb_xcc_id() { return (unsigned)__builtin_amdgcn_s_getreg((3 << 11) | 20) & 0xFu; }
#define XB_SPIN(cond, bar) do { unsigned _sp = 0; while (cond) { __builtin_amdgcn_s_sleep(1); \
    if ((++_sp & 255u) == 0u) { if (xb_ld(&(bar)[XB_TMO])) break; if (_sp > XB_SPIN_CAP) { atomicAdd(&(bar)[XB_TMO], 1u); break; } } } } while (0)
struct XcdBarrier { unsigned* bar; unsigned x; volatile LAS unsigned* st; };
DI XcdBarrier xcd_barrier_post(unsigned* bar, volatile LAS unsigned* st) {
    XcdBarrier b; b.bar = bar; b.x = xb_xcc_id(); b.st = st;
    if (threadIdx.x == 0) (void)xb_add(&bar[XB_XCNT(b.x)], 1u);
    return b;
}
DI void xcd_barrier_complete(unsigned* bar, unsigned x, unsigned& nloc, unsigned& nx) {
    const unsigned G = gridDim.x * gridDim.y * gridDim.z;
    unsigned sum, cnt, mine, sp = 0u;
    for (;;) {
        sum = 0u; cnt = 0u; mine = 0u;
#pragma unroll
        for (unsigned j = 0; j < 16; ++j) { const unsigned c = xb_ld(&bar[XB_XCNT(j)]); sum += c; cnt += (c > 0u) ? 1u : 0u; mine = (j == x) ? c : mine; }
        if (sum == G) break;
        __builtin_amdgcn_s_sleep(1);
        if ((++sp & 255u) == 0u) { if (xb_ld(&bar[XB_TMO])) break; if (sp > XB_SPIN_CAP) { atomicAdd(&bar[XB_TMO], 1u); break; } }
    }
    nloc = mine > 0u ? mine : 1u; nx = cnt > 0u ? cnt : 1u;
}
DI void xcd_barrier(const XcdBarrier& b) {
    asm volatile("s_waitcnt vmcnt(0)" ::: "memory");
    __syncthreads();
    if (threadIdx.x == 0) {
        unsigned* bar = b.bar;
        __builtin_amdgcn_s_waitcnt(0);
        unsigned nloc = b.st[0], nx = b.st[1];
        if (nloc == 0u) { xcd_barrier_complete(bar, b.x, nloc, nx); b.st[0] = nloc; b.st[1] = nx; }
        const unsigned old = xb_add(&bar[XB_XSUB(b.x)], 1u);
        const unsigned gen = old / nloc;
        if (old + 1u == (gen + 1u) * nloc) {
            __builtin_amdgcn_fence(__ATOMIC_RELEASE, "agent");
            asm volatile("s_waitcnt vmcnt(0)" ::: "memory");
            const unsigned og = xb_add(&bar[XB_TOP], 1u);
            const unsigned tg = og / nx;
            if (og + 1u == (tg + 1u) * nx) xb_add(&bar[XB_TOPGEN], 1u);
            else XB_SPIN(xb_ld(&bar[XB_TOPGEN]) == tg, bar);
            __builtin_amdgcn_fence(__ATOMIC_ACQUIRE, "agent");
            xb_add(&bar[XB_XGEN(b.x)], 1u);
            asm volatile("s_waitcnt vmcnt(0)" ::: "memory");
        } else {
            XB_SPIN(xb_ld(&bar[XB_XGEN(b.x)]) == gen, bar);
            __builtin_amdgcn_fence(__ATOMIC_ACQUIRE, "agent");
            asm volatile("s_waitcnt vmcnt(0)" ::: "memory");
        }
    }
    __syncthreads();
}

namespace pg8 {
constexpr int BM = 256, BK = 64, HALF = 128, HTB = HALF * BK * 2, STAGE_BYTES = 8 * HTB, NXCD = 8, WGM = 8;
DI int lds_byte(int r, int c) { const int st = (r >> 4) * 2 + (c >> 5), rr = r & 15, cc = c & 31, ob = rr * 64 + cc * 2; return st * 1024 + (ob ^ (((ob >> 9) & 1) << 5)); }
DI void stage_rc(int b, int& R, int& C) { const int st = b / 1024, sb = b % 1024, swz = sb ^ (((sb >> 9) & 1) << 5); R = (st >> 1) * 16 + swz / 64; C = (st & 1) * 32 + (swz % 64) / 2; }
DI int perm32(int rho) { const int n = rho >> 4, i = rho & 15; return 8 * (i >> 2) + 4 * n + (i & 3); }

struct Unit { int pm, pn, e; const char* a; const char* b; };
struct Gemm { int lda, ldb, K; int brow = ldb; int bk = BK * 2; };

struct PlainSched {
    int nM, nN, nwg, G, c; const char* A; const char* Bt; size_t a_tile, b_tile;
    DI void init(int M, int N, int G_, int c_, const void* A_, int lda, const void* Bt_, int ldb) {
        nM = M / BM; nN = N / BM; nwg = nM * nN; G = G_; c = c_; A = (const char*)A_; Bt = (const char*)Bt_; a_tile = (size_t)BM * lda * 2; b_tile = (size_t)BM * ldb * 2; }
    DI bool next(int i, Unit& u) const {
        const long L = (long)i * G + c; if (L >= nwg) return false;
        int wgid = (int)L; { const int q = nwg / NXCD, r = nwg % NXCD, xcd = wgid % NXCD, off = wgid / NXCD; wgid = (xcd < r ? xcd * (q + 1) : r * (q + 1) + (xcd - r) * q) + off; }
        const int nig = WGM * nN, gid = wgid / nig, fm = gid * WGM, gsz = (nM - fm) < WGM ? (nM - fm) : WGM;
        u.pm = fm + ((wgid % nig) % gsz); u.pn = (wgid % nig) / gsz; u.e = 0;
        u.a = A + (size_t)u.pm * a_tile; u.b = Bt + (size_t)u.pn * b_tile; return true;
    }
};

typedef int v4i_t __attribute__((ext_vector_type(4)));
typedef int v8i_t __attribute__((ext_vector_type(8)));
#ifndef PG8_SP2
#define PG8_SP2 true
#endif
template <class Epi, class Sched, bool SP2 = PG8_SP2>
DI void gemm_phase(LAS unsigned char* lds, const Gemm g, const Sched& S, const Epi& E) {
    const int tid = tid_fresh(), wid = __builtin_amdgcn_readfirstlane(tid >> 6), lane = tid & 63, wr = wid >> 2, wc = wid & 3, fr = lane & 15, fq = lane >> 4;
    const int K = g.K, nt = K / BK;
    unsigned voffA[2], voffB[2];
#pragma unroll
    for (int i = 0; i < 2; ++i) { int R, C; stage_rc(tid * 16 + i * 8192, R, C); const int Rb = Epi::PERM ? ((R & ~31) + perm32(R & 31)) : R;
        voffA[i] = (unsigned)(R * g.lda + C) * 2u; voffB[i] = (unsigned)(Rb * g.ldb + C) * 2u; }
    const size_t kstep = (size_t)(BK * 2);
    const size_t hstepA = (size_t)HALF * g.lda * 2, hstepB = (size_t)HALF * g.ldb * 2;
    const unsigned ldsw = (unsigned)wid * 1024u;
    const int aoff = lds_byte(wr * 64 + fr, fq * 8), boff = lds_byte(wc * 32 + fr, fq * 8);
#define PG8_SA(b, h) (((b) * 2 + (h)) * HTB)
#define PG8_SB(b, h) ((4 + (b) * 2 + (h)) * HTB)
#define PG8_STAGE(bufoff, gbase, voff) do { _Pragma("unroll") for (int _i = 0; _i < 2; ++_i) \
        __builtin_amdgcn_global_load_lds((const unsigned*)((const char*)(gbase) + (voff)[_i]), (LAS unsigned*)(lds + (bufoff) + ldsw + _i * 8192), 16, 0, 0); } while (0)
#define PG8_LDA(dst, b, h) do { _Pragma("unroll") for (int m = 0; m < 4; ++m) _Pragma("unroll") for (int k = 0; k < 2; ++k) dst[m][k] = *(const LAS bf16x8*)(lds + PG8_SA(b, h) + aoff + m * 2048 + k * 1024); } while (0)
#define PG8_LDB(dst, b, h) do { _Pragma("unroll") for (int n = 0; n < 2; ++n) _Pragma("unroll") for (int k = 0; k < 2; ++k) dst[n][k] = *(const LAS bf16x8*)(lds + PG8_SB(b, h) + boff + n * 2048 + k * 1024); } while (0)
#define PG8_MMA(ai, bj, At, Bt) do { __builtin_amdgcn_s_setprio(1); _Pragma("unroll") for (int m = 0; m < 4; ++m) _Pragma("unroll") for (int n = 0; n < 2; ++n) _Pragma("unroll") for (int k = 0; k < 2; ++k) \
        acc[ai][bj][m][n] = __builtin_amdgcn_mfma_f32_16x16x32_bf16(Bt[n][k], At[m][k], acc[ai][bj][m][n], 0, 0, 0); __builtin_amdgcn_s_setprio(0); } while (0)
#define PG8_WAIT_V(n) asm volatile("s_waitcnt vmcnt(" #n ")" ::: "memory")
#define PG8_WAIT_L(n) asm volatile("s_waitcnt lgkmcnt(" #n ")" ::: "memory")
#define PG8_BAR __builtin_amdgcn_s_barrier()
#define PG8_SCHED __builtin_amdgcn_sched_barrier(0)
    Unit cur, nxt; int ui = 0;
    if (!S.next(0, cur)) return;
    f32x4 acc[2][2][4][2];
#pragma unroll
    for (int a = 0; a < 2; ++a)
#pragma unroll
        for (int b = 0; b < 2; ++b)
#pragma unroll
            for (int m = 0; m < 4; ++m)
#pragma unroll
                for (int n = 0; n < 2; ++n) acc[a][b][m][n] = (f32x4){0.f, 0.f, 0.f, 0.f};
    bf16x8 At[4][2], B0[2][2], B1[2][2];
    const char* cA = cur.a; const char* cB = cur.b;
    if constexpr (SP2) {
        PG8_STAGE(PG8_SB(0, 0), cB, voffB); PG8_STAGE(PG8_SB(0, 1), cB + hstepB, voffB); PG8_STAGE(PG8_SA(0, 0), cA, voffA); PG8_STAGE(PG8_SA(0, 1), cA + hstepA, voffA);
        if (wr == 1) PG8_BAR;
        PG8_WAIT_V(2); PG8_BAR;
        PG8_STAGE(PG8_SB(1, 0), cB + kstep, voffB); PG8_STAGE(PG8_SA(1, 0), cA + kstep, voffA); PG8_STAGE(PG8_SB(1, 1), cB + hstepB + kstep, voffB);
        PG8_WAIT_V(6); PG8_BAR;
    } else {
        PG8_STAGE(PG8_SB(0, 0), cB, voffB); PG8_STAGE(PG8_SA(0, 0), cA, voffA); PG8_STAGE(PG8_SB(0, 1), cB + hstepB, voffB); PG8_STAGE(PG8_SA(0, 1), cA + hstepA, voffA);
        if (wr == 1) PG8_BAR;
        PG8_WAIT_V(4); PG8_BAR;
        PG8_STAGE(PG8_SB(1, 0), cB + kstep, voffB); PG8_STAGE(PG8_SA(1, 0), cA + kstep, voffA); PG8_STAGE(PG8_SB(1, 1), cB + hstepB + kstep, voffB);
        PG8_WAIT_V(6); PG8_BAR;
    }
    for (;;) {
        const bool has_next = S.next(ui + 1, nxt);
        const char* nA = has_next ? nxt.a : cA; const char* nB = has_next ? nxt.b : cB;
        for (int t = 0; t < nt; t += 2) {
            const bool last = (t == nt - 2);
            const char* a1 = cA + (size_t)(t + 1) * kstep;
            const char* a2 = last ? nA : cA + (size_t)(t + 2) * kstep; const char* b2 = last ? nB : cB + (size_t)(t + 2) * kstep;
            const char* a3 = a2 + kstep; const char* b3 = b2 + kstep;
            if constexpr (SP2) {
            PG8_LDB(B0, 0, 0); PG8_LDB(B1, 0, 1); PG8_SCHED; PG8_LDA(At, 0, 0); PG8_STAGE(PG8_SA(1, 1), a1 + hstepA, voffA);
            PG8_WAIT_V(8); PG8_WAIT_L(0); PG8_BAR; PG8_MMA(0, 0, At, B0); PG8_MMA(0, 1, At, B1); PG8_BAR; PG8_SCHED;
            PG8_LDA(At, 0, 1); PG8_STAGE(PG8_SB(0, 0), b2, voffB); PG8_STAGE(PG8_SB(0, 1), b2 + hstepB, voffB); PG8_STAGE(PG8_SA(0, 0), a2, voffA);
            PG8_WAIT_V(8); PG8_WAIT_L(0); PG8_BAR; PG8_MMA(1, 0, At, B0); PG8_MMA(1, 1, At, B1); PG8_BAR; PG8_SCHED;
            PG8_LDB(B0, 1, 0); PG8_LDB(B1, 1, 1); PG8_SCHED; PG8_LDA(At, 1, 0); PG8_STAGE(PG8_SA(0, 1), a2 + hstepA, voffA);
            PG8_WAIT_V(8); PG8_WAIT_L(0); PG8_BAR; PG8_MMA(0, 0, At, B0); PG8_MMA(0, 1, At, B1); PG8_BAR; PG8_SCHED;
            PG8_LDA(At, 1, 1); PG8_STAGE(PG8_SB(1, 0), b3, voffB); PG8_STAGE(PG8_SB(1, 1), b3 + hstepB, voffB); PG8_STAGE(PG8_SA(1, 0), a3, voffA);
            PG8_WAIT_V(8); PG8_WAIT_L(0); PG8_BAR; PG8_MMA(1, 0, At, B0); PG8_MMA(1, 1, At, B1); PG8_BAR; PG8_SCHED;
            } else {
            PG8_LDB(B0, 0, 0); PG8_SCHED; PG8_LDA(At, 0, 0); PG8_STAGE(PG8_SA(1, 1), a1 + hstepA, voffA);
            PG8_WAIT_L(8); PG8_BAR; PG8_WAIT_L(0); PG8_MMA(0, 0, At, B0); PG8_BAR; PG8_SCHED;
            PG8_LDB(B1, 0, 1); PG8_STAGE(PG8_SB(0, 0), b2, voffB);
            PG8_BAR; PG8_WAIT_L(0); PG8_MMA(0, 1, At, B1); PG8_BAR;
            PG8_LDA(At, 0, 1); PG8_STAGE(PG8_SA(0, 0), a2, voffA);
            PG8_BAR; PG8_WAIT_L(0); PG8_MMA(1, 0, At, B0); PG8_BAR; PG8_SCHED;
            PG8_STAGE(PG8_SB(0, 1), b2 + hstepB, voffB);
            PG8_WAIT_V(6); PG8_BAR; PG8_MMA(1, 1, At, B1); PG8_BAR;
            PG8_LDB(B0, 1, 0); PG8_SCHED; PG8_LDA(At, 1, 0); PG8_STAGE(PG8_SA(0, 1), a2 + hstepA, voffA);
            PG8_WAIT_L(8); PG8_BAR; PG8_WAIT_L(0); PG8_MMA(0, 0, At, B0); PG8_BAR; PG8_SCHED;
            PG8_LDB(B1, 1, 1); PG8_STAGE(PG8_SB(1, 0), b3, voffB);
            PG8_BAR; PG8_WAIT_L(0); PG8_MMA(0, 1, At, B1); PG8_BAR;
            PG8_LDA(At, 1, 1); PG8_STAGE(PG8_SA(1, 0), a3, voffA);
            PG8_BAR; PG8_WAIT_L(0); PG8_MMA(1, 0, At, B0); PG8_BAR; PG8_SCHED;
            PG8_STAGE(PG8_SB(1, 1), b3 + hstepB, voffB);
            PG8_WAIT_V(6); PG8_BAR; PG8_MMA(1, 1, At, B1); PG8_BAR;
            }
        }
        E(acc, cur, wr, wc, fr, fq);
        if (!has_next) break;
#pragma unroll
        for (int a = 0; a < 2; ++a)
#pragma unroll
            for (int b = 0; b < 2; ++b)
#pragma unroll
                for (int m = 0; m < 4; ++m)
#pragma unroll
                    for (int n = 0; n < 2; ++n) acc[a][b][m][n] = (f32x4){0.f, 0.f, 0.f, 0.f};
        cur = nxt; cA = nA; cB = nB; ++ui;
    }
    PG8_WAIT_V(0);
    if (wr == 0) PG8_BAR;
    PG8_BAR;
#undef PG8_SA
#undef PG8_SB
#undef PG8_STAGE
#undef PG8_LDA
#undef PG8_LDB
#undef PG8_MMA
#undef PG8_WAIT_V
#undef PG8_WAIT_L
#undef PG8_BAR
#undef PG8_SCHED
}

template <class Epi, class Sched, bool SP2 = PG8_SP2>
DI void gemm_phase_fp8(LAS unsigned char* lds, const Gemm g, const Sched& S, const Epi& E) {
    const int tid = tid_fresh(), wid = __builtin_amdgcn_readfirstlane(tid >> 6), lane = tid & 63, wr = wid >> 2, wc = wid & 3, fr = lane & 15, fq = lane >> 4;
    const int K = g.K, nt = K / BK;
    unsigned voffA[2], voffB[2];
#pragma unroll
    for (int i = 0; i < 2; ++i) { int R, C; stage_rc(tid * 16 + i * 8192, R, C); const int Rb = Epi::PERM ? ((R & ~31) + perm32(R & 31)) : R;
        voffA[i] = (unsigned)(R * g.lda + C) * 2u; voffB[i] = (unsigned)(Rb * g.brow + C) * 2u; }
    const size_t kstep = (size_t)(BK * 2), kstepB = (size_t)g.bk;
    const size_t hstepA = (size_t)HALF * g.lda * 2, hstepB = (size_t)HALF * g.ldb * 2;
    const unsigned ldsw = (unsigned)wid * 1024u;
    const int aoff = lds_byte(wr * 64 + fr, fq * 8), boff = lds_byte(wc * 32 + fr, fq * 8);
#define PG8_SA(b, h) (((b) * 2 + (h)) * HTB)
#define PG8_SB(b, h) ((4 + (b) * 2 + (h)) * HTB)
#define PG8_STAGE(bufoff, gbase, voff) do { _Pragma("unroll") for (int _i = 0; _i < 2; ++_i) \
        __builtin_amdgcn_global_load_lds((const unsigned*)((const char*)(gbase) + (voff)[_i]), (LAS unsigned*)(lds + (bufoff) + ldsw + _i * 8192), 16, 0, 0); } while (0)
#define PG8_LDA(dst, b, h) do { _Pragma("unroll") for (int m = 0; m < 4; ++m) { const v4i_t lo_ = *(const LAS v4i_t*)(lds + PG8_SA(b, h) + aoff + m * 2048), hi_ = *(const LAS v4i_t*)(lds + PG8_SA(b, h) + aoff + m * 2048 + 1024); dst[m] = __builtin_shufflevector(lo_, hi_, 0, 1, 2, 3, 4, 5, 6, 7); } } while (0)
#define PG8_LDB(dst, b, h) do { _Pragma("unroll") for (int n = 0; n < 2; ++n) { const v4i_t lo_ = *(const LAS v4i_t*)(lds + PG8_SB(b, h) + boff + n * 2048), hi_ = *(const LAS v4i_t*)(lds + PG8_SB(b, h) + boff + n * 2048 + 1024); dst[n] = __builtin_shufflevector(lo_, hi_, 0, 1, 2, 3, 4, 5, 6, 7); } } while (0)
#define PG8_MMA(ai, bj, At, Bt) do { __builtin_amdgcn_s_setprio(1); _Pragma("unroll") for (int m = 0; m < 4; ++m) _Pragma("unroll") for (int n = 0; n < 2; ++n) \
        asm volatile("v_mfma_scale_f32_16x16x128_f8f6f4 %0, %1, %2, %0, %3, %3 op_sel_hi:[0,0,0]" : "+v"(acc[ai][bj][m][n]) : "v"(Bt[n]), "v"(At[m]), "v"(sc127)); __builtin_amdgcn_s_setprio(0); } while (0)
#define PG8_WAIT_V(n) asm volatile("s_waitcnt vmcnt(" #n ")" ::: "memory")
#define PG8_WAIT_L(n) asm volatile("s_waitcnt lgkmcnt(" #n ")" ::: "memory")
#define PG8_BAR __builtin_amdgcn_s_barrier()
#define PG8_SCHED __builtin_amdgcn_sched_barrier(0)
    Unit cur, nxt; int ui = 0;
    if (!S.next(0, cur)) return;
    f32x4 acc[2][2][4][2];
#pragma unroll
    for (int a = 0; a < 2; ++a)
#pragma unroll
        for (int b = 0; b < 2; ++b)
#pragma unroll
            for (int m = 0; m < 4; ++m)
#pragma unroll
                for (int n = 0; n < 2; ++n) acc[a][b][m][n] = (f32x4){0.f, 0.f, 0.f, 0.f};
    v8i_t At[4], B0[2], B1[2];
    int sc127 = 127; asm volatile("" : "+v"(sc127));
    const char* cA = cur.a; const char* cB = cur.b;
    if constexpr (SP2) {
        PG8_STAGE(PG8_SB(0, 0), cB, voffB); PG8_STAGE(PG8_SB(0, 1), cB + hstepB, voffB); PG8_STAGE(PG8_SA(0, 0), cA, voffA); PG8_STAGE(PG8_SA(0, 1), cA + hstepA, voffA);
        if (wr == 1) PG8_BAR;
        PG8_WAIT_V(2); PG8_BAR;
        PG8_STAGE(PG8_SB(1, 0), cB + kstepB, voffB); PG8_STAGE(PG8_SA(1, 0), cA + kstep, voffA); PG8_STAGE(PG8_SB(1, 1), cB + hstepB + kstepB, voffB);
        PG8_WAIT_V(6); PG8_BAR;
    } else {
        PG8_STAGE(PG8_SB(0, 0), cB, voffB); PG8_STAGE(PG8_SA(0, 0), cA, voffA); PG8_STAGE(PG8_SB(0, 1), cB + hstepB, voffB); PG8_STAGE(PG8_SA(0, 1), cA + hstepA, voffA);
        if (wr == 1) PG8_BAR;
        PG8_WAIT_V(4); PG8_BAR;
        PG8_STAGE(PG8_SB(1, 0), cB + kstepB, voffB); PG8_STAGE(PG8_SA(1, 0), cA + kstep, voffA); PG8_STAGE(PG8_SB(1, 1), cB + hstepB + kstepB, voffB);
        PG8_WAIT_V(6); PG8_BAR;
    }
    for (;;) {
        const bool has_next = S.next(ui + 1, nxt);
        const char* nA = has_next ? nxt.a : cA; const char* nB = has_next ? nxt.b : cB;
        for (int t = 0; t < nt; t += 2) {
            const bool last = (t == nt - 2);
            const char* a1 = cA + (size_t)(t + 1) * kstep;
            const char* a2 = last ? nA : cA + (size_t)(t + 2) * kstep; const char* b2 = last ? nB : cB + (size_t)(t + 2) * kstepB;
            const char* a3 = a2 + kstep; const char* b3 = b2 + kstepB;
            if constexpr (SP2) {
            PG8_LDB(B0, 0, 0); PG8_LDB(B1, 0, 1); PG8_SCHED; PG8_LDA(At, 0, 0); PG8_STAGE(PG8_SA(1, 1), a1 + hstepA, voffA);
            PG8_WAIT_V(8); PG8_WAIT_L(0); PG8_BAR; PG8_MMA(0, 0, At, B0); PG8_MMA(0, 1, At, B1); PG8_BAR; PG8_SCHED;
            PG8_LDA(At, 0, 1); PG8_STAGE(PG8_SB(0, 0), b2, voffB); PG8_STAGE(PG8_SB(0, 1), b2 + hstepB, voffB); PG8_STAGE(PG8_SA(0, 0), a2, voffA);
            PG8_WAIT_V(8); PG8_WAIT_L(0); PG8_BAR; PG8_MMA(1, 0, At, B0); PG8_MMA(1, 1, At, B1); PG8_BAR; PG8_SCHED;
            PG8_LDB(B0, 1, 0); PG8_LDB(B1, 1, 1); PG8_SCHED; PG8_LDA(At, 1, 0); PG8_STAGE(PG8_SA(0, 1), a2 + hstepA, voffA);
            PG8_WAIT_V(8); PG8_WAIT_L(0); PG8_BAR; PG8_MMA(0, 0, At, B0); PG8_MMA(0, 1, At, B1); PG8_BAR; PG8_SCHED;
            PG8_LDA(At, 1, 1); PG8_STAGE(PG8_SB(1, 0), b3, voffB); PG8_STAGE(PG8_SB(1, 1), b3 + hstepB, voffB); PG8_STAGE(PG8_SA(1, 0), a3, voffA);
            PG8_WAIT_V(8); PG8_WAIT_L(0); PG8_BAR; PG8_MMA(1, 0, At, B0); PG8_MMA(1, 1, At, B1); PG8_BAR; PG8_SCHED;
            } else {
            PG8_LDB(B0, 0, 0); PG8_SCHED; PG8_LDA(At, 0, 0); PG8_STAGE(PG8_SA(1, 1), a1 + hstepA, voffA);
            PG8_WAIT_L(8); PG8_BAR; PG8_WAIT_L(0); PG8_MMA(0, 0, At, B0); PG8_BAR; PG8_SCHED;
            PG8_LDB(B1, 0, 1); PG8_STAGE(PG8_SB(0, 0), b2, voffB);
            PG8_BAR; PG8_WAIT_L(0); PG8_MMA(0, 1, At, B1); PG8_BAR;
            PG8_LDA(At, 0, 1); PG8_STAGE(PG8_SA(0, 0), a2, voffA);
            PG8_BAR; PG8_WAIT_L(0); PG8_MMA(1, 0, At, B0); PG8_BAR; PG8_SCHED;
            PG8_STAGE(PG8_SB(0, 1), b2 + hstepB, voffB);
            PG8_WAIT_V(6); PG8_BAR; PG8_MMA(1, 1, At, B1); PG8_BAR;
            PG8_LDB(B0, 1, 0); PG8_SCHED; PG8_LDA(At, 1, 0); PG8_STAGE(PG8_SA(0, 1), a2 + hstepA, voffA);
            PG8_WAIT_L(8); PG8_BAR; PG8_WAIT_L(0); PG8_MMA(0, 0, At, B0); PG8_BAR; PG8_SCHED;
            PG8_LDB(B1, 1, 1); PG8_STAGE(PG8_SB(1, 0), b3, voffB);
            PG8_BAR; PG8_WAIT_L(0); PG8_MMA(0, 1, At, B1); PG8_BAR;
            PG8_LDA(At, 1, 1); PG8_STAGE(PG8_SA(1, 0), a3, voffA);
            PG8_BAR; PG8_WAIT_L(0); PG8_MMA(1, 0, At, B0); PG8_BAR; PG8_SCHED;
            PG8_STAGE(PG8_SB(1, 1), b3 + hstepB, voffB);
            PG8_WAIT_V(6); PG8_BAR; PG8_MMA(1, 1, At, B1); PG8_BAR;
            }
        }
        asm volatile("s_nop 15\n\ts_nop 15" ::: "memory");
        E(acc, cur, wr, wc, fr, fq);
        if (!has_next) break;
#pragma unroll
        for (int a = 0; a < 2; ++a)
#pragma unroll
            for (int b = 0; b < 2; ++b)
#pragma unroll
                for (int m = 0; m < 4; ++m)
#pragma unroll
                    for (int n = 0; n < 2; ++n) acc[a][b][m][n] = (f32x4){0.f, 0.f, 0.f, 0.f};
        cur = nxt; cA = nA; cB = nB; ++ui;
    }
    PG8_WAIT_V(0);
    if (wr == 0) PG8_BAR;
    PG8_BAR;
#undef PG8_SA
#undef PG8_SB
#undef PG8_STAGE
#undef PG8_LDA
#undef PG8_LDB
#undef PG8_MMA
#undef PG8_WAIT_V
#undef PG8_WAIT_L
#undef PG8_BAR
#undef PG8_SCHED
}

typedef f32x4 Acc[2][2][4][2];
struct EpiBf16 {
    static constexpr bool PERM = true; bf16_t* O; int ldc; float scale;
    DI void operator()(const Acc& acc, const Unit& u, int wr, int wc, int fr, int fq) const {
        const int row0 = u.pm * BM + wr * 64 + fr, col0 = u.pn * BM + wc * 32 + 8 * fq;
#pragma unroll
        for (int ai = 0; ai < 2; ++ai)
#pragma unroll
            for (int m = 0; m < 4; ++m) { bf16_t* rowp = O + (size_t)(row0 + ai * HALF + m * 16) * ldc + col0;
#pragma unroll
                for (int bj = 0; bj < 2; ++bj) { const f32x4 v0 = acc[ai][bj][m][0] * scale, v1 = acc[ai][bj][m][1] * scale;
                    *(u32x4*)(rowp + bj * HALF) = (u32x4){pk2(v0[0], v0[1]), pk2(v0[2], v0[3]), pk2(v1[0], v1[1]), pk2(v1[2], v1[3])}; } }
    }
};
struct EpiC1 {
    static constexpr bool PERM = false; float* C;
    DI void operator()(const Acc& acc, const Unit& u, int wr, int wc, int fr, int fq) const {
        const int row0 = u.pm * BM + wr * 64 + fr, col0 = wc * 32 + 4 * fq;
        float* base = C + (size_t)u.e * 2048 * 256;
#pragma unroll
        for (int ai = 0; ai < 2; ++ai)
#pragma unroll
            for (int m = 0; m < 4; ++m) { float* rowp = base + (size_t)(row0 + ai * HALF + m * 16) * 256 + col0;
#pragma unroll
                for (int bj = 0; bj < 2; ++bj)
#pragma unroll
                    for (int n = 0; n < 2; ++n) *(f32x4*)(rowp + bj * HALF + n * 16) = acc[ai][bj][m][n]; }
    }
};
DI float clamp8(float v) { return __builtin_amdgcn_fmed3f(v, -448.f, 448.f); }
DI unsigned fp8x4(float a, float b, float c, float d) { int w = 0; w = __builtin_amdgcn_cvt_pk_fp8_f32(clamp8(a), clamp8(b), w, false); w = __builtin_amdgcn_cvt_pk_fp8_f32(clamp8(c), clamp8(d), w, true); return (unsigned)w; }
constexpr float W8_SCALE = 256.f, W8_INV = 1.f / 256.f, A8_SCALE = 16.f, A8W8_INV = 1.f / 4096.f, Y8_SCALE = 32.f, Y8_INV = 1.f / 32.f;
template <bool ADD> struct EpiMerge {
    static constexpr bool PERM = true; bf16_t* P; unsigned char* O8; const bf16_t* Z; int gcol0; float scale;
    DI void operator()(const Acc& acc, const Unit& u, int wr, int wc, int fr, int fq) const {
        const int row0 = u.pm * BM + wr * 64 + fr, col0 = u.pn * BM + wc * 32 + 8 * fq;
#pragma unroll
        for (int ai = 0; ai < 2; ++ai) {
            u32x4 gz[4][2], pz[4][2];
#pragma unroll
            for (int m = 0; m < 4; ++m) { const size_t row = (size_t)(row0 + ai * HALF + m * 16);
#pragma unroll
                for (int bj = 0; bj < 2; ++bj) { const int col = col0 + bj * HALF; gz[m][bj] = *(const u32x4*)(Z + row * ZC + gcol0 + col); if (ADD) pz[m][bj] = *(const u32x4*)(P + row * D + col); } }
#pragma unroll
            for (int m = 0; m < 4; ++m) { const size_t row = (size_t)(row0 + ai * HALF + m * 16);
#pragma unroll
                for (int bj = 0; bj < 2; ++bj) { const int col = col0 + bj * HALF;
                    float g[8], o[8]; unpack8(gz[m][bj], g);
                    const f32x4 v0 = acc[ai][bj][m][0] * scale, v1 = acc[ai][bj][m][1] * scale;
                    if (ADD) unpack8(pz[m][bj], o);
#pragma unroll
                    for (int j = 0; j < 8; ++j) { const float a = j < 4 ? v0[j & 3] : v1[j & 3]; o[j] = (ADD ? o[j] : 0.f) + sigmoidf_(g[j]) * a; }
                    if (ADD) *(u32x2*)(O8 + row * D + col) = (u32x2){fp8x4(o[0] * A8_SCALE, o[1] * A8_SCALE, o[2] * A8_SCALE, o[3] * A8_SCALE), fp8x4(o[4] * A8_SCALE, o[5] * A8_SCALE, o[6] * A8_SCALE, o[7] * A8_SCALE)};
                    else *(u32x4*)(P + row * D + col) = (u32x4){pk2(o[0], o[1]), pk2(o[2], o[3]), pk2(o[4], o[5]), pk2(o[6], o[7])}; } }
        }
    }
};
struct EpiGU {
    static constexpr bool PERM = true; unsigned char* O; const float* bias;
    DI void operator()(const Acc& acc, const Unit& u, int wr, int wc, int fr, int fq) const {
        const int row0 = u.pm * BM + wr * 64 + fr, c0 = u.pn * HALF + wc * 32 + 8 * fq;
        const float* bg = bias + (size_t)u.e * 4096 + c0; const float* bu = bg + 2048;
        float bgv[8], buv[8];
#pragma unroll
        for (int j = 0; j < 8; ++j) { bgv[j] = bg[j]; buv[j] = bu[j]; }
#pragma unroll
        for (int ai = 0; ai < 2; ++ai)
#pragma unroll
            for (int m = 0; m < 4; ++m) { unsigned char* rowp = O + (size_t)(row0 + ai * HALF + m * 16) * D + c0;
                float o[8];
#pragma unroll
                for (int j = 0; j < 8; ++j) { float gt = (j < 4 ? acc[ai][0][m][0][j & 3] : acc[ai][0][m][1][j & 3]) * W8_INV + bgv[j];
                    float up = (j < 4 ? acc[ai][1][m][0][j & 3] : acc[ai][1][m][1][j & 3]) * W8_INV + buv[j];
                    gt = fminf(gt, 7.f); up = fminf(fmaxf(up, -7.f), 7.f);
                    o[j] = gt * sigmoidf_(1.702f * gt) * (up + 1.f); }
                *(u32x2*)rowp = (u32x2){fp8x4(o[0], o[1], o[2], o[3]), fp8x4(o[4], o[5], o[6], o[7])}; }
    }
};
struct EpiDN {
    static constexpr bool PERM = true; unsigned char* O; const float* bias; const float* slotw;
    DI void operator()(const Acc& acc, const Unit& u, int wr, int wc, int fr, int fq) const {
        const int row0 = u.pm * BM + wr * 64 + fr, col0 = u.pn * BM + wc * 32 + 8 * fq;
        float bv[2][8];
#pragma unroll
        for (int bj = 0; bj < 2; ++bj)
#pragma unroll
            for (int j = 0; j < 8; ++j) bv[bj][j] = bias[(size_t)u.e * D + col0 + bj * HALF + j];
        float sw[2][4];
#pragma unroll
        for (int ai = 0; ai < 2; ++ai)
#pragma unroll
            for (int m = 0; m < 4; ++m) sw[ai][m] = slotw[row0 + ai * HALF + m * 16];
#pragma unroll
        for (int ai = 0; ai < 2; ++ai)
#pragma unroll
            for (int m = 0; m < 4; ++m) { const int row = row0 + ai * HALF + m * 16; const float w = sw[ai][m] * Y8_SCALE; unsigned char* rowp = O + (size_t)row * D + col0;
#pragma unroll
                for (int bj = 0; bj < 2; ++bj) { float o[8];
#pragma unroll
                    for (int j = 0; j < 8; ++j) o[j] = ((j < 4 ? acc[ai][bj][m][0][j & 3] : acc[ai][bj][m][1][j & 3]) * W8_INV + bv[bj][j]) * w;
                    *(u32x2*)(rowp + bj * HALF) = (u32x2){fp8x4(o[0], o[1], o[2], o[3]), fp8x4(o[4], o[5], o[6], o[7])}; } }
    }
};
struct C1Sched {
    int G, c; const char* kvs; const char* w;
    DI bool next(int i, Unit& u) const {
        const int L = i * G + c; if (L >= 256) return false;
        const int kv = L >> 7, s = (L >> 3) & 15, pm = L & 7;
        u.pm = pm; u.pn = 0; u.e = s * 2 + kv;
        u.a = kvs + ((size_t)kv * KVS_ONE + (size_t)pm * 256 * 2048 + (size_t)s * 256) * 2;
        u.b = w + ((size_t)kv * 256 * 4096 + (size_t)s * 256) * 2; return true;
    }
};
struct MoeSched {
    int G, c, nN, total; const LAS int* tile_e; const char* A; const char* W; size_t w_exp;
    DI bool next(int i, Unit& u) const {
        const int L = i * G + c; if (L >= total) return false;
        const int mt = L / nN, pn = L - mt * nN; const int e = __builtin_amdgcn_readfirstlane(tile_e[mt]);
        u.pm = mt; u.pn = pn; u.e = e;
        u.a = A + (size_t)mt * 256 * D; u.b = W + (size_t)e * w_exp + (size_t)pn * 256 * D; return true;
    }
};
}

DI int colmap(int kind, int n) {
    if (kind == 0) return n;
    if (kind == 1) {
        if (n < 872) return n;
        if (n < 896) return 3432 + (n - 872);
        if (n < 1024) return -1;
        if (n < 2048) return 872 + (n - 1024);
        if (n < 3584) return 1896 + (n - 2048);
        return 3456 + (n - 3584);
    }
    if (kind == 2) { const int pn = n >> 8, r = n & 255; return r < 128 ? pn * 128 + r : 2048 + pn * 128 + (r - 128); }
    if (kind == 4) return n < 32 ? n : -1;
    { const int h = n >> 5, d = n & 31; return h * 128 + d; }
}
struct TrJob { const float* src; bf16_t* dst; int ldsrc, lddst, kind, k0, n0, dk0, dn0; };
DI void tr_load(const TrJob& j, f32x4 (&v)[8], int t) {
    const int c4 = t & 63, r0 = t >> 6; const int sc = colmap(j.kind, j.n0 + 4 * c4);
#pragma unroll
    for (int q = 0; q < 8; ++q) v[q] = (f32x4){0.f, 0.f, 0.f, 0.f};
    if (sc >= 0) {
#pragma unroll
        for (int q = 0; q < 8; ++q) v[q] = __builtin_nontemporal_load((const f32x4*)(j.src + (size_t)(j.k0 + r0 + 8 * q) * j.ldsrc + sc));
    }
}
DI void tr_lds_write(const f32x4 (&v)[8], float* tile, int t) {
    const int c4 = t & 63, r0 = t >> 6;
#pragma unroll
    for (int q = 0; q < 8; ++q) { float* tp = tile + (r0 + 8 * q) * 257 + 4 * c4; tp[0] = v[q][0]; tp[1] = v[q][1]; tp[2] = v[q][2]; tp[3] = v[q][3]; }
}
DI void tr_store(const TrJob& j, const float* tile, int t) {
    const int kk8 = (t & 7) * 8, nb = t >> 3;
#pragma unroll
    for (int ps = 0; ps < 4; ++ps) { const int nn = nb + 64 * ps; const float* s = tile + kk8 * 257 + nn;
        u32x4 o = {pk2(s[0], s[257]), pk2(s[2 * 257], s[3 * 257]), pk2(s[4 * 257], s[5 * 257]), pk2(s[6 * 257], s[7 * 257])};
        *(u32x4*)(j.dst + (size_t)(j.n0 + nn) * j.lddst + j.k0 + kk8) = o; }
}
DI void tr_setup(TrJob& j, int u, int nK, const float* src, int ldsrc, int kind, bf16_t* dst, int lddst) {
    const int kt = u % nK, ntile = u / nK; j.src = src; j.dst = dst; j.ldsrc = ldsrc; j.lddst = lddst; j.kind = kind; j.k0 = kt * 64; j.n0 = ntile * 256;
}
DI float tr8_load(const TrJob& j, f32x4 (&v)[8], int t) {
    const int c4 = t & 31, r0 = t >> 5; const int sc = colmap(j.kind, j.n0 + 4 * c4); const int scc = sc < 0 ? 0 : sc;
#pragma unroll
    for (int q = 0; q < 8; ++q) v[q] = __builtin_nontemporal_load((const f32x4*)(j.src + (size_t)(j.k0 + r0 + 16 * q) * j.ldsrc + scc));
    return sc < 0 ? 0.f : 1.f;
}
DI void tr8_lds_write(const f32x4 (&v)[8], float ok, float* tile, int t) {
    const int c4 = t & 31, r0 = t >> 5;
#pragma unroll
    for (int q = 0; q < 8; ++q) { float* tp = tile + (r0 + 16 * q) * 129 + 4 * c4; tp[0] = v[q][0] * ok; tp[1] = v[q][1] * ok; tp[2] = v[q][2] * ok; tp[3] = v[q][3] * ok; }
}
DI void tr8_store(const TrJob& j, const float* tile, int t) {
    const int kc = t & 7, nb = t >> 3; constexpr float SC = pg8::W8_SCALE;
#pragma unroll
    for (int ps = 0; ps < 2; ++ps) { const int nn = nb + 64 * ps; const float* s = tile + (16 * kc) * 129 + nn;
        u32x4 o = {pg8::fp8x4(s[0] * SC, s[129] * SC, s[2 * 129] * SC, s[3 * 129] * SC), pg8::fp8x4(s[4 * 129] * SC, s[5 * 129] * SC, s[6 * 129] * SC, s[7 * 129] * SC),
                   pg8::fp8x4(s[8 * 129] * SC, s[9 * 129] * SC, s[10 * 129] * SC, s[11 * 129] * SC), pg8::fp8x4(s[12 * 129] * SC, s[13 * 129] * SC, s[14 * 129] * SC, s[15 * 129] * SC)};
        __builtin_nontemporal_store(o, (u32x4*)((unsigned char*)j.dst + (size_t)(j.dn0 + nn) * j.lddst + j.dk0 + 16 * kc)); }
}
DI void phase_prep(const Params& p, char* smem) {
    float* tile = (float*)smem;
    const int t = tid_fresh(), G = gridDim.x;
    constexpr int U_ADA = 256, U_ABS = 256, U_WO = 512, U_CB = 128, SPECIAL = U_ADA + U_ABS + U_WO + U_CB;
    constexpr int U_WINB = 32 * 8, U_WIN = 16 * 44, U_IDXQ = 8 * 2, U_UQR = 8, U_BRB = 16 * 8, U_OUT = 32 * 8, U_C1 = 64, U_RT = 32, U_GU = 32 * 16, U_DN = 32 * 8;
    constexpr int NTR = U_WINB + U_IDXQ + U_UQR + 2 * U_C1 + U_RT, NTR8 = U_WIN + U_BRB + U_OUT + NEXP * (U_GU + U_DN);
    bf16_t* Wq = (bf16_t*)(p.ws + O_WQ);
    for (int rp_ = 0; rp_ < ((PREP_REP & 1) ? 2 : 1); ++rp_)
    for (int u0 = blockIdx.x; u0 < SPECIAL; u0 += G) {
        int u = u0;
        if (rp_ == 1 && (u0 < PREP_REP_LO || u0 >= PREP_REP_HI)) continue;
        if (u < U_ADA) {
            const int c4 = t % 12, kg = t / 12; f32x4 a0 = {0.f, 0.f, 0.f, 0.f}, a1 = {0.f, 0.f, 0.f, 0.f};
            if (kg < 42) { const int col = u * 48 + c4 * 4;
#pragma unroll 7
                for (int k = kg; k < 2048; k += 42) { const float c0 = p.c[k], c1 = p.c[2048 + k]; const float s0 = c0 * sigmoidf_(c0), s1 = c1 * sigmoidf_(c1);
                    const f32x4 w = *(const f32x4*)(p.w_ada + (size_t)k * 12288 + col); a0 += w * s0; a1 += w * s1; } }
            __syncthreads();
            if (kg < 42) { float* tp = tile + (kg * 12 + c4) * 8;
#pragma unroll
                for (int j = 0; j < 4; ++j) { tp[j] = a0[j]; tp[4 + j] = a1[j]; } }
            __syncthreads();
            if (t < 96) { const int bb = t / 48, cc = t % 48; float acc = 0.f;
                for (int g2 = 0; g2 < 42; ++g2) acc += tile[(g2 * 12 + (cc >> 2)) * 8 + bb * 4 + (cc & 3)];
                ((float*)(p.ws + O_MODACC))[bb * 12288 + u * 48 + cc] = acc + p.b_ada[u * 48 + cc]; }
            continue; }
        u -= U_ADA;
        if (u < U_ABS) {
            const int h = u >> 5, w = __builtin_amdgcn_readfirstlane(t >> 6), l = t & 63, c = (u & 31) * 8 + w;
            const float* ukp = p.a_w_uk + (size_t)c * 768 + h * 96;
            float acc[8];
#pragma unroll
            for (int j = 0; j < 8; ++j) acc[j] = 0.f;
#pragma unroll 1
            for (int ch = 0; ch < 3; ++ch) {
                __syncthreads();
#pragma unroll
                for (int q = 0; q < 8; ++q) { const int r = (t >> 3) + 64 * q;
                    *(f32x4*)(tile + r * 36 + 4 * (t & 7)) = *(const f32x4*)(p.a_w_uq + (size_t)r * 1024 + h * 128 + 32 + ch * 32 + 4 * (t & 7)); }
                __syncthreads();
#pragma unroll 2
                for (int n4 = 0; n4 < 8; ++n4) { const float k0 = ukp[ch * 32 + 4 * n4], k1 = ukp[ch * 32 + 4 * n4 + 1], k2 = ukp[ch * 32 + 4 * n4 + 2], k3 = ukp[ch * 32 + 4 * n4 + 3];
#pragma unroll
                    for (int j = 0; j < 8; ++j) { const f32x4 x = *(const f32x4*)(tile + (l + 64 * j) * 36 + 4 * n4);
                        acc[j] = __builtin_fmaf(x[0], k0, acc[j]); acc[j] = __builtin_fmaf(x[1], k1, acc[j]); acc[j] = __builtin_fmaf(x[2], k2, acc[j]); acc[j] = __builtin_fmaf(x[3], k3, acc[j]); } }
            }
#pragma unroll
            for (int j = 0; j < 8; ++j) Wq[(size_t)(h * 256 + c) * 512 + l + 64 * j] = f2bf(acc[j]);
            continue; }
        u -= U_ABS;
        if (u < U_WO) {
            const int n = (u & 3) * 512 + t, k0 = (u >> 2) * 16, h = k0 >> 8;
            __syncthreads();
            *(f32x4*)(tile + 4 * t) = *(const f32x4*)(p.a_w_uv + (size_t)k0 * 128 + 4 * t);
            __syncthreads();
            const float* wbp = p.w_br_a + (size_t)(h * 128) * D + n;
            float acc[16];
#pragma unroll
            for (int j = 0; j < 16; ++j) acc[j] = 0.f;
#pragma unroll 2
            for (int v0 = 0; v0 < 128; v0 += 8) { float wb[8];
#pragma unroll
                for (int i = 0; i < 8; ++i) wb[i] = wbp[(size_t)(v0 + i) * D];
#pragma unroll
                for (int j = 0; j < 16; ++j) { const f32x4 a = *(const f32x4*)(tile + j * 128 + v0), b = *(const f32x4*)(tile + j * 128 + v0 + 4);
                    acc[j] = __builtin_fmaf(a[0], wb[0], acc[j]); acc[j] = __builtin_fmaf(a[1], wb[1], acc[j]); acc[j] = __builtin_fmaf(a[2], wb[2], acc[j]); acc[j] = __builtin_fmaf(a[3], wb[3], acc[j]);
                    acc[j] = __builtin_fmaf(b[0], wb[4], acc[j]); acc[j] = __builtin_fmaf(b[1], wb[5], acc[j]); acc[j] = __builtin_fmaf(b[2], wb[6], acc[j]); acc[j] = __builtin_fmaf(b[3], wb[7], acc[j]); } }
            constexpr float SW = pg8::W8_SCALE;
            *(u32x4*)((unsigned char*)(p.ws + O_WO) + (size_t)n * D + k0) = (u32x4){pg8::fp8x4(acc[0] * SW, acc[1] * SW, acc[2] * SW, acc[3] * SW), pg8::fp8x4(acc[4] * SW, acc[5] * SW, acc[6] * SW, acc[7] * SW),
                pg8::fp8x4(acc[8] * SW, acc[9] * SW, acc[10] * SW, acc[11] * SW), pg8::fp8x4(acc[12] * SW, acc[13] * SW, acc[14] * SW, acc[15] * SW)};
            continue; }
        u -= U_WO;
        {
            const int kv = u >> 6, seg = u & 63;
            if (t < 256) { const float* pe = kv ? p.cmp_v_pe : p.cmp_k_pe; const float* w1 = kv ? p.cmp_v_w1 : p.cmp_k_w1; float a = 0.f;
#pragma unroll 16
                for (int i = seg * 64; i < seg * 64 + 64; ++i) a += pe[i] * w1[(size_t)i * 256 + t];
                ((float*)(p.ws + O_CBP))[(seg * 2 + kv) * 256 + t] = a; } }
    }
    auto setup = [&](TrJob& j, int u) {
        if (u < U_WINB) { tr_setup(j, u, 32, p.w_in, 7552, 1, (bf16_t*)(p.ws + O_WIN), D); return; } u -= U_WINB;
        if (u < U_IDXQ) { tr_setup(j, u, 8, p.idx_w_q, 512, 0, Wq + (size_t)2304 * 512, 512); return; } u -= U_IDXQ;
        if (u < U_UQR) { tr_setup(j, u, 8, p.a_w_uq, 1024, 3, Wq + (size_t)2048 * 512, 512); return; } u -= U_UQR;
        if (u < U_C1) { tr_setup(j, u, 64, p.cmp_k_w1, 256, 0, (bf16_t*)(p.ws + O_WC1), 4096); return; } u -= U_C1;
        if (u < U_C1) { tr_setup(j, u, 64, p.cmp_v_w1, 256, 0, (bf16_t*)(p.ws + O_WC1) + (size_t)256 * 4096, 4096); return; } u -= U_C1;
        tr_setup(j, u, 32, p.w_router, 32, 4, (bf16_t*)(p.ws + O_WRT), D);
    };
    auto setup8 = [&](TrJob& j, int u) {
        j.lddst = D;
        if (u < U_WIN) { j.src = p.w_in; j.ldsrc = 7552; j.kind = 1; j.dst = (bf16_t*)(p.ws + O_WIN8); j.k0 = (u & 15) * 128; j.n0 = 2048 + (u >> 4) * 128; j.dk0 = j.k0; j.dn0 = j.n0; return; } u -= U_WIN;
        if (u < U_BRB) { j.src = p.w_br_b; j.ldsrc = D; j.kind = 0; j.dst = (bf16_t*)(p.ws + O_WBRB); j.lddst = 1024; j.k0 = (u & 7) * 128; j.n0 = (u >> 3) * 128; j.dk0 = j.k0; j.dn0 = j.n0; return; } u -= U_BRB;
        if (u < U_OUT) { j.src = p.w_out; j.ldsrc = D; j.kind = 0; j.dst = (bf16_t*)(p.ws + O_WOUT); j.k0 = (u & 15) * 128; j.n0 = (u >> 4) * 128; j.dk0 = j.k0; j.dn0 = j.n0; return; } u -= U_OUT;
        const int e = u / (U_GU + U_DN), r = u - e * (U_GU + U_DN);
        if (r < U_GU) { j.src = p.w_gate_up + (size_t)e * D * 4096; j.ldsrc = 4096; j.kind = 2; j.dst = (bf16_t*)(p.ws + O_WGU + (size_t)e * 4096 * D + (size_t)r * 16384); j.k0 = (r & 15) * 128; j.n0 = (r >> 4) * 128; }
        else { const int r2 = r - U_GU; j.src = p.w_down + (size_t)e * D * D; j.ldsrc = D; j.kind = 0; j.dst = (bf16_t*)(p.ws + O_WDN + (size_t)e * D * D + (size_t)r2 * 16384); j.k0 = (r2 & 15) * 128; j.n0 = (r2 >> 4) * 128; }
        j.lddst = 128; j.dk0 = 0; j.dn0 = 0;
    };
    TrJob cur, nxt; f32x4 v[8];
    int u;
    for (int rp_ = 0; rp_ < ((PREP_REP & 2) ? 2 : 1); ++rp_) {
    u = blockIdx.x;
    if (u < NTR) { setup(cur, u); tr_load(cur, v, t); }
#pragma unroll 1
    for (; u < NTR; u += G) {
        __syncthreads();
        tr_lds_write(v, tile, t);
        __syncthreads();
        const bool more = u + G < NTR;
        if (more) { setup(nxt, u + G); tr_load(nxt, v, t); }
        tr_store(cur, tile, t);
        cur = nxt;
    }
    }
    auto clampu = [&](int x) { return x < NTR8 ? x : NTR8 - 1; };
    for (int rp_ = 0; rp_ < ((PREP_REP & 4) ? 2 : 1); ++rp_) {
    u = blockIdx.x;
    f32x4 v2[8]; float ok1, ok2;
    setup8(cur, clampu(u)); ok1 = tr8_load(cur, v, t);
    setup8(nxt, clampu(u + G)); ok2 = tr8_load(nxt, v2, t);
#pragma unroll 1
    for (; u < NTR8; u += 2 * G) {
        __syncthreads();
        tr8_lds_write(v, ok1, tile, t);
        __syncthreads();
        TrJob c = cur;
        setup8(cur, clampu(u + 2 * G)); ok1 = tr8_load(cur, v, t);
        tr8_store(c, tile, t);
        __syncthreads();
        tr8_lds_write(v2, ok2, tile, t);
        __syncthreads();
        c = nxt;
        setup8(nxt, clampu(u + 3 * G)); ok2 = tr8_load(nxt, v2, t);
        tr8_store(c, tile, t);
    }
    }
#if PREP_PROBE_MODE >= 2
    {
        unsigned chk = 0; unsigned char* dummy = (unsigned char*)(p.ws + O_HS);
        constexpr int U0 = U_WIN + U_BRB + U_OUT;
        TrJob pj, pn; f32x4 w[8]; float okp;
        int uu = U0 + blockIdx.x;
        setup8(pj, uu); okp = tr8_load(pj, w, t);
#pragma unroll 1
        for (; uu < NTR8; uu += G) {
#if PREP_PROBE_MODE == 2
            __syncthreads();
            tr8_lds_write(w, okp, tile, t);
            __syncthreads();
            setup8(pn, clampu(uu + G)); okp = tr8_load(pn, w, t);
            {   const int kc = t & 7, nb = t >> 3; constexpr float SC = pg8::W8_SCALE;
#pragma unroll
                for (int ps = 0; ps < 2; ++ps) { const int nn = nb + 64 * ps; const float* s = tile + (16 * kc) * 129 + nn;
                    chk ^= pg8::fp8x4(s[0] * SC, s[129] * SC, s[2 * 129] * SC, s[3 * 129] * SC) ^ pg8::fp8x4(s[4 * 129] * SC, s[5 * 129] * SC, s[6 * 129] * SC, s[7 * 129] * SC)
                         ^ pg8::fp8x4(s[8 * 129] * SC, s[9 * 129] * SC, s[10 * 129] * SC, s[11 * 129] * SC) ^ pg8::fp8x4(s[12 * 129] * SC, s[13 * 129] * SC, s[14 * 129] * SC, s[15 * 129] * SC); } }
            pj = pn;
#else
            u32x4 o0 = {pg8::fp8x4(w[0][0], w[0][1], w[0][2], w[0][3]), pg8::fp8x4(w[1][0], w[1][1], w[1][2], w[1][3]), pg8::fp8x4(w[2][0], w[2][1], w[2][2], w[2][3]), pg8::fp8x4(w[3][0], w[3][1], w[3][2], w[3][3])};
            u32x4 o1 = {pg8::fp8x4(w[4][0], w[4][1], w[4][2], w[4][3]), pg8::fp8x4(w[5][0], w[5][1], w[5][2], w[5][3]), pg8::fp8x4(w[6][0], w[6][1], w[6][2], w[6][3]), pg8::fp8x4(w[7][0], w[7][1], w[7][2], w[7][3])};
            setup8(pn, clampu(uu + G)); okp = tr8_load(pn, w, t);
            u32x4* dp = (u32x4*)(dummy + ((size_t)(uu - U0) * 512 + t) * 32); dp[0] = o0; dp[1] = o1;
            pj = pn;
#endif
        }
        if (chk == 0x12345678u && okp == 3.f) ((unsigned*)(p.ws + 115200))[0] = chk;
    }
#endif
#if PREP_PROBE_WC > 0
    {
        constexpr int WC = PREP_PROBE_WC, RW = WC / 4, RS = 512 / RW, R = 16384 / WC;
        float acc = 0.f; const int c4 = t % RW, r0 = t / RW;
#pragma unroll 1
        for (int pass = 0; pass < 2; ++pass) {
            const float* base = pass ? p.w_down : p.w_gate_up; const int ld = pass ? 2048 : 4096;
            const int nK = 65536 / R, ntiles = nK * (ld / WC);
#pragma unroll 1
            for (int uu = blockIdx.x; uu < ntiles; uu += G) {
#if PREP_PROBE_NFAST
                const int nN = ld / WC, nt_ = uu % nN, kt = uu / nN;
#else
                const int kt = uu % nK, nt_ = uu / nK;
#endif
                f32x4 w[8];
#pragma unroll
                for (int q = 0; q < 8; ++q) w[q] = __builtin_nontemporal_load((const f32x4*)(base + (size_t)(kt * R + r0 + RS * q) * ld + nt_ * WC + 4 * c4));
#pragma unroll
                for (int q = 0; q < 8; ++q) acc += (w[q][0] + w[q][1]) + (w[q][2] + w[q][3]);
            }
        }
        if (acc == 12345.678f) ((float*)(p.ws + 115200))[0] = acc;
    }
#endif
}

DI void phase_h1(const Params& p) {
    const int tz_ = tid_fresh(); const int lane = tz_ & 63, wid = __builtin_amdgcn_readfirstlane(tz_ >> 6);
    if (blockIdx.x == 0) { float a = 0.f; const float* cbp = (const float*)(p.ws + O_CBP);
        for (int sg = 0; sg < 64; ++sg) a += cbp[sg * 512 + tz_];
        ((float*)(p.ws + O_CBIAS))[tz_] = a; }
    bf16_t* H = (bf16_t*)(p.ws + O_H); float* rope = (float*)(p.ws + O_ROPE);
    for (int tok = blockIdx.x * 8 + wid; tok < NT; tok += gridDim.x * 8) {
        const int b = tok >> 13;
        const f32x4* xr = (const f32x4*)(p.x + (size_t)tok * D) + lane;
        f32x4 v[8]; float ss = 0.f;
#pragma unroll
        for (int i = 0; i < 8; ++i) { v[i] = xr[64 * i]; ss += v[i][0] * v[i][0] + v[i][1] * v[i][1] + v[i][2] * v[i][2] + v[i][3] * v[i][3]; }
        const float rs = rsqrtf(wave_sum(ss) * (1.f / D) + NORM_EPS);
#pragma unroll
        for (int i = 0; i < 8; ++i) { const int col = 4 * (lane + 64 * i); float o[4];
#pragma unroll
            for (int j = 0; j < 4; ++j) o[j] = v[i][j] * rs * p.g_pre_mix[col + j] * (1.f + mod_at(p, b, 2048 + col + j)) + mod_at(p, b, col + j);
            *(u32x2*)(H + (size_t)tok * D + col) = (u32x2){pk2(o[0], o[1]), pk2(o[2], o[3])};
            *(unsigned*)((unsigned char*)(p.ws + O_H8) + (size_t)tok * D + col) = pg8::fp8x4(o[0], o[1], o[2], o[3]); }
        if (lane < 24) { const float fr = lane < 16 ? (float)(2 * lane) * (1.f / 32.f) : (float)(2 * (lane - 16)) * (1.f / 16.f);
            const float inv = exp2f(-fr * 18.931568569324174f);
            const float ang = (float)p.pos[tok] * inv; float s, c; sincosf(ang, &s, &c);
            rope[(size_t)tok * 48 + 2 * lane] = c; rope[(size_t)tok * 48 + 2 * lane + 1] = s; }
    }
}

DI void phase_zpost(const Params& p) {
    const int tz_ = tid_fresh(); const int lane = tz_ & 63, wid = __builtin_amdgcn_readfirstlane(tz_ >> 6);
    const bf16_t* Z = (const bf16_t*)(p.ws + O_Z); const float* rope = (const float*)(p.ws + O_ROPE);
    bf16_t* cqn = (bf16_t*)(p.ws + O_CQN); bf16_t* kvt = (bf16_t*)(p.ws + O_KVT); bf16_t* kidx = (bf16_t*)(p.ws + O_KIDX);
    float* widx = (float*)(p.ws + O_WIDX); float* gates = (float*)(p.ws + O_GATES); bf16_t* bq = (bf16_t*)(p.ws + O_BQ); bf16_t* kvs = (bf16_t*)(p.ws + O_KVS);
    const f32x4 gq0 = *(const f32x4*)(p.a_cq_norm + lane * 8), gq1 = *(const f32x4*)(p.a_cq_norm + lane * 8 + 4), gkv = *(const f32x4*)(p.a_ckv_norm + lane * 4);
    const float ig = p.idx_g[lane], ibs = p.idx_b[lane];
    const int part = lane & 7;
    for (int tok = blockIdx.x * 8 + wid; tok < NT; tok += gridDim.x * 8) {
        const int b = tok >> 13, tq = tok & (T - 1);
        const bf16_t* zr = Z + (size_t)tok * ZC; const float* rt = rope + (size_t)tok * 48;
        const u32x4 rcq = *(const u32x4*)(zr + lane * 8);
        const u32x2 rkv = *(const u32x2*)(zr + ZC_CKV + lane * 4);
        const bf16_t rki = zr[ZC_KIDX + lane], rk1 = zr[ZC_KROPE + (lane & 15)], rk2 = zr[ZC_KROPE + 16 + (lane & 15)], rwi = zr[ZC_WIDX + (lane & 7)], rbg = zr[ZC_BGATE + (lane < 24 ? lane : 0)];
        u32x4 rh[3][2];
#pragma unroll
        for (int ps = 0; ps < 3; ++ps) { const int slot = ps * 64 + lane, s2 = slot < 160 ? slot : 159; const bf16_t* src = zr + ZC_BQ + (s2 >> 3) * 128 + (s2 & 7) * 16;
            rh[ps][0] = *(const u32x4*)src; rh[ps][1] = *(const u32x4*)(src + 8); }
        f32x4 rr[8];
#pragma unroll
        for (int i = 0; i < 8; ++i) rr[i] = *(const f32x4*)(rt + 4 * i);
        const float ric = rt[32 + 2 * (lane & 7)], ris = rt[33 + 2 * (lane & 7)], rkc = rt[2 * (lane & 15)], rks = rt[2 * (lane & 15) + 1];
        {
            float f[8]; unpack8(rcq, f); float ss = 0.f;
#pragma unroll
            for (int j = 0; j < 8; ++j) ss += f[j] * f[j];
            const float rs = rsqrtf(wave_sum(ss) * (1.f / 512.f) + NORM_EPS);
#pragma unroll
            for (int j = 0; j < 4; ++j) { f[j] = f[j] * rs * gq0[j]; f[4 + j] = f[4 + j] * rs * gq1[j]; }
            *(u32x4*)(cqn + (size_t)tok * 512 + lane * 8) = (u32x4){pk2(f[0], f[1]), pk2(f[2], f[3]), pk2(f[4], f[5]), pk2(f[6], f[7])};
        }
        {
            float f[4] = {bflo(rkv[0]), bfhi(rkv[0]), bflo(rkv[1]), bfhi(rkv[1])};
            const float rs = rsqrtf(wave_sum(f[0] * f[0] + f[1] * f[1] + f[2] * f[2] + f[3] * f[3]) * (1.f / 256.f) + NORM_EPS);
#pragma unroll
            for (int j = 0; j < 4; ++j) f[j] = f[j] * rs * gkv[j];
            *(u32x2*)(kvt + (size_t)tok * KVW + lane * 4) = (u32x2){pk2(f[0], f[1]), pk2(f[2], f[3])};
        }
        if (lane < 16) {
            const float x1 = bf2f(rk1), x2 = bf2f(rk2);
            kvt[(size_t)tok * KVW + 256 + lane] = f2bf(x1 * rkc - x2 * rks); kvt[(size_t)tok * KVW + 272 + lane] = f2bf(x2 * rkc + x1 * rks);
        }
        {
            const float v = bf2f(rki); const float mean = wave_sum(v) * (1.f / 64.f); const float xc = v - mean;
            const float var = wave_sum(xc * xc) * (1.f / 64.f);
            const float y = xc * rsqrtf(var + NORM_EPS) * ig + ibs;
            const float pr = __shfl_xor(y, 8); float o = y;
            if (lane < 8) o = y * ric - pr * ris;
            else if (lane < 16) o = y * ric + pr * ris;
            kidx[(size_t)tok * 64 + lane] = f2bf(o);
        }
        if (lane < 8) widx[(size_t)tok * 8 + lane] = bf2f(rwi) * (0.35355339059327373f * 0.125f);
        if (lane < 24) gates[(size_t)tok * 24 + lane] = sigmoidf_(bf2f(rbg));
#pragma unroll
        for (int ps = 0; ps < 3; ++ps) { const int slot = ps * 64 + lane; const int hh = slot >> 3;
            float f[16]; { float a[8], c[8]; unpack8(rh[ps][0], a); unpack8(rh[ps][1], c);
#pragma unroll
                for (int j = 0; j < 8; ++j) { f[j] = a[j]; f[8 + j] = c[j]; } }
            const bool dorope = (hh < 8 || (((hh - 8) >> 1) & 1) == 0) && part < 2;
#pragma unroll
            for (int i = 0; i < 16; ++i) { const float g = __shfl_xor(f[i], 1); const float c = rr[(2 * i) >> 2][(2 * i) & 3], s = rr[(2 * i + 1) >> 2][(2 * i + 1) & 3];
                const float ro = part == 0 ? f[i] * c - g * s : f[i] * c + g * s; f[i] = dorope ? ro : f[i]; }
            if (slot < 160) { bf16_t* dst;
                if (hh < 8) dst = bq + (size_t)tok * 1024 + hh * 128 + part * 16;
                else { const int i6 = (hh - 8) >> 1, g = (hh - 8) & 1; dst = kvs + ((((size_t)i6 * NB + b) * 2 + g) * T + tq) * 128 + part * 16; }
                *(u32x4*)dst = (u32x4){pk2(f[0], f[1]), pk2(f[2], f[3]), pk2(f[4], f[5]), pk2(f[6], f[7])};
                *(u32x4*)(dst + 8) = (u32x4){pk2(f[8], f[9]), pk2(f[10], f[11]), pk2(f[12], f[13]), pk2(f[14], f[15])}; } }
    }
}

DI void c2_rows(const Params& p, char* smem) {
    const int tz_ = tid_fresh(); const int lane = tz_ & 63, wid = __builtin_amdgcn_readfirstlane(tz_ >> 6);
    float* hrow = (float*)smem + wid * 256;
    const float* c1p = (const float*)(p.ws + O_C1P); const float* cb = (const float*)(p.ws + O_CBIAS); bf16_t* kcvc = (bf16_t*)(p.ws + O_KCVC);
    for (int row = blockIdx.x * 8 + wid; row < 4096; row += gridDim.x * 8) {
        const int kv = row >> 11, r = row & 2047, n = r & 511;
        f32x4 a = *(const f32x4*)(cb + kv * 256 + lane * 4);
#pragma unroll
        for (int s = 0; s < 16; ++s) a += *(const f32x4*)(c1p + ((size_t)(s * 2 + kv) * 2048 + r) * 256 + lane * 4);
#pragma unroll
        for (int j = 0; j < 4; ++j) { const float v = a[j]; const float u = 0.7978845608028654f * (v + 0.044715f * v * v * v); hrow[lane * 4 + j] = 0.5f * v * (1.f + tanhf(u)); }
        asm volatile("s_waitcnt lgkmcnt(0)" ::: "memory");
        const float* w2 = kv ? p.cmp_v_w2 : p.cmp_k_w2;
        float o0 = 0.f, o1 = 0.f;
#pragma unroll 16
        for (int j = 0; j < 256; ++j) { const float hv = hrow[j]; const float2 w = *(const float2*)(w2 + j * 128 + lane * 2); o0 += hv * w.x; o1 += hv * w.y; }
        if (n == 511) { o0 = 0.f; o1 = 0.f; }
        *(unsigned*)(kcvc + (size_t)row * 128 + lane * 2) = pk2(o0, o1);
        asm volatile("s_waitcnt lgkmcnt(0)" ::: "memory");
    }
}

DI unsigned short f16key(float v) { const _Float16 h = (_Float16)v; unsigned short u = __builtin_bit_cast(unsigned short, h); return (u & 0x8000u) ? (unsigned short)~u : (unsigned short)(u | 0x8000u); }
DI void topk256_select(const LAS unsigned* scw, int nk, unsigned short* out, int lane) {
    const int nw = (nk + 127) >> 7;
    auto ldk = [&](int i) -> unsigned { const int wi = i * 64 + lane; unsigned v = scw[wi]; if (2 * wi >= nk) v = 0u; else if (2 * wi + 1 >= nk) v &= 0xffffu; return v; };
    unsigned Tv = 0u;
    for (int bit = 15; bit >= 0; --bit) { const unsigned cand = Tv | (1u << bit); int cnt = 0;
#pragma unroll 4
        for (int i = 0; i < nw; ++i) { const unsigned kv = ldk(i); cnt += __popcll(__ballot((kv & 0xffffu) >= cand)) + __popcll(__ballot((kv >> 16) >= cand)); }
        if (cnt >= 256) Tv = cand; }
    int cgt = 0;
#pragma unroll 4
    for (int i = 0; i < nw; ++i) { const unsigned kv = ldk(i); cgt += __popcll(__ballot((kv & 0xffffu) > Tv)) + __popcll(__ballot((kv >> 16) > Tv)); }
    const int need = 256 - cgt; int pos = 0, eqc = 0;
    const unsigned long long ltm = (1ull << lane) - 1ull;
#pragma unroll 2
    for (int i = 0; i < nw; ++i) {
        const unsigned kv = ldk(i); const unsigned lo = kv & 0xffffu, hi = kv >> 16;
        const bool elo = lo == Tv, ehi = hi == Tv;
        const unsigned long long mlo = __ballot(elo), mhi = __ballot(ehi);
        const int below = __popcll(mlo & ltm) + __popcll(mhi & ltm);
        const bool slo = lo > Tv || (elo && eqc + below < need), shi = hi > Tv || (ehi && eqc + below + (elo ? 1 : 0) < need);
        const unsigned long long s0 = __ballot(slo), s1 = __ballot(shi);
        const int plo = pos + __popcll(s0 & ltm), phi = pos + __popcll(s0) + __popcll(s1 & ltm);
        const int kidx = 2 * (i * 64 + lane);
        if (slo) out[plo] = (unsigned short)kidx;
        if (shi) out[phi] = (unsigned short)(kidx + 1);
        pos += __popcll(s0) + __popcll(s1); eqc += __popcll(mlo) + __popcll(mhi); }
}
DI void phase_indexer(const Params& p, char* smem) {
    const int tz_ = tid_fresh(); const int lane = tz_ & 63, wid = __builtin_amdgcn_readfirstlane(tz_ >> 6);
    LAS unsigned short* sc = (LAS unsigned short*)(LAS char*)smem + wid * 8192;
    float* qf = (float*)(smem + 131072) + wid * 512;
    const bf16_t* Q = (const bf16_t*)(p.ws + O_QALL); const bf16_t* KI = (const bf16_t*)(p.ws + O_KIDX); const float* WI = (const float*)(p.ws + O_WIDX);
    unsigned short* SEL = (unsigned short*)(p.ws + O_SEL); int* NSEL = (int*)(p.ws + O_NSEL);
    for (int tok = (int)(NT / 8 - 1 - blockIdx.x) * 8 + wid; tok >= 0; tok -= gridDim.x * 8) {
        const int b = tok >> 13, tq = tok & (T - 1), nk = tq + 1;
        unsigned short* out = SEL + (size_t)tok * 256;
        if (nk <= 256) { for (int i = lane; i < 256; i += 64) out[i] = (unsigned short)(i < nk ? i : 0); if (lane == 0) NSEL[tok] = nk; continue; }
        { float f[8]; unpack8(*(const u32x4*)(Q + (size_t)tok * QC + 2304 + lane * 8), f);
#pragma unroll
          for (int j = 0; j < 8; ++j) qf[lane * 8 + j] = f[j]; }
        float wh[8];
#pragma unroll
        for (int h = 0; h < 8; ++h) wh[h] = WI[(size_t)tok * 8 + h];
        asm volatile("s_waitcnt lgkmcnt(0)" ::: "memory");
        for (int s = lane; s < nk; s += 64) {
            const bf16_t* kr = KI + ((size_t)b * T + s) * 64; float d[8];
#pragma unroll
            for (int h = 0; h < 8; ++h) d[h] = 0.f;
#pragma unroll 2
            for (int c = 0; c < 8; ++c) { float kf[8]; unpack8(*(const u32x4*)(kr + c * 8), kf);
#pragma unroll
                for (int h = 0; h < 8; ++h) { const f32x4 q0 = *(const f32x4*)(qf + h * 64 + c * 8), q1 = *(const f32x4*)(qf + h * 64 + c * 8 + 4);
                    d[h] += q0[0] * kf[0] + q0[1] * kf[1] + q0[2] * kf[2] + q0[3] * kf[3] + q1[0] * kf[4] + q1[1] * kf[5] + q1[2] * kf[6] + q1[3] * kf[7]; } }
            float score = 0.f;
#pragma unroll
            for (int h = 0; h < 8; ++h) score += wh[h] * fmaxf(d[h], 0.f);
            sc[s] = f16key(score); }
        asm volatile("s_waitcnt lgkmcnt(0)" ::: "memory");
        topk256_select((const LAS unsigned*)sc, nk, out, lane);
        if (lane == 0) NSEL[tok] = 256;
        asm volatile("s_waitcnt lgkmcnt(0)" ::: "memory");
    }
}

DI void phase_mla(const Params& p, char* smem) {
    const int tz_ = tid_fresh(); const int lane = tz_ & 63, wid = __builtin_amdgcn_readfirstlane(tz_ >> 6);
    float* qf = (float*)smem + wid * (8 * KVW + 8 * 256 + 128);
    float* pf = qf + 8 * KVW; unsigned short* selw = (unsigned short*)(pf + 8 * 256);
    const bf16_t* Q = (const bf16_t*)(p.ws + O_QALL); const bf16_t* KV = (const bf16_t*)(p.ws + O_KVT);
    const unsigned short* SEL = (const unsigned short*)(p.ws + O_SEL); const int* NSEL = (const int*)(p.ws + O_NSEL); bf16_t* OL = (bf16_t*)(p.ws + O_OLAT);
    for (int tok = blockIdx.x * 8 + wid; tok < NT; tok += gridDim.x * 8) {
        const int b = tok >> 13; const int cnt = NSEL[tok];
        const bf16_t* qr = Q + (size_t)tok * QC;
#pragma unroll 4
        for (int i = 0; i < 36; ++i) { const int e = lane + 64 * i;
            const int h = e / KVW, d = e - h * KVW; qf[e] = bf2f(d < 256 ? qr[h * 256 + d] : qr[2048 + h * 32 + (d - 256)]); }
        *(u32x2*)(selw + lane * 4) = *(const u32x2*)(SEL + (size_t)tok * 256 + lane * 4);
        asm volatile("s_waitcnt lgkmcnt(0)" ::: "memory");
        const bf16_t* rows[4];
#pragma unroll
        for (int j = 0; j < 4; ++j) { const int k = lane + 64 * j; const int idx = k < cnt ? selw[k] : 0; rows[j] = KV + ((size_t)b * T + idx) * KVW; }
        float acc[4][8];
#pragma unroll
        for (int j = 0; j < 4; ++j)
#pragma unroll
            for (int h = 0; h < 8; ++h) acc[j][h] = 0.f;
#pragma unroll 1
        for (int c = 0; c < 36; ++c) { float kf[4][8];
#pragma unroll
            for (int j = 0; j < 4; ++j) unpack8(*(const u32x4*)(rows[j] + c * 8), kf[j]);
#pragma unroll
            for (int h = 0; h < 8; ++h) { const f32x4 q0 = *(const f32x4*)(qf + h * KVW + c * 8), q1 = *(const f32x4*)(qf + h * KVW + c * 8 + 4);
#pragma unroll
                for (int j = 0; j < 4; ++j) acc[j][h] += q0[0] * kf[j][0] + q0[1] * kf[j][1] + q0[2] * kf[j][2] + q0[3] * kf[j][3] + q1[0] * kf[j][4] + q1[1] * kf[j][5] + q1[2] * kf[j][6] + q1[3] * kf[j][7]; } }
#pragma unroll
        for (int h = 0; h < 8; ++h) { float m = -INFINITY;
#pragma unroll
            for (int j = 0; j < 4; ++j) { acc[j][h] = (lane + 64 * j < cnt) ? acc[j][h] * ATT_SCALE : -INFINITY; m = fmaxf(m, acc[j][h]); }
            m = wave_max(m); float l = 0.f;
#pragma unroll
            for (int j = 0; j < 4; ++j) { acc[j][h] = (lane + 64 * j < cnt) ? __expf(acc[j][h] - m) : 0.f; l += acc[j][h]; }
            l = 1.f / fmaxf(wave_sum(l), 1e-30f);
#pragma unroll
            for (int j = 0; j < 4; ++j) pf[h * 256 + lane + 64 * j] = acc[j][h] * l; }
        asm volatile("s_waitcnt lgkmcnt(0)" ::: "memory");
        float o[8][4];
#pragma unroll
        for (int h = 0; h < 8; ++h)
#pragma unroll
            for (int j = 0; j < 4; ++j) o[h][j] = 0.f;
#pragma unroll 1
        for (int k0 = 0; k0 < 256; k0 += 8) { u32x2 vv[8];
#pragma unroll
            for (int kk = 0; kk < 8; ++kk) { const int k = k0 + kk; const int idx = k < cnt ? selw[k] : 0; vv[kk] = *(const u32x2*)(KV + ((size_t)b * T + idx) * KVW + lane * 4); }
#pragma unroll
            for (int kk = 0; kk < 8; ++kk) { const float v0 = bflo(vv[kk][0]), v1 = bfhi(vv[kk][0]), v2 = bflo(vv[kk][1]), v3 = bfhi(vv[kk][1]);
#pragma unroll
                for (int h = 0; h < 8; ++h) { const float ph = pf[h * 256 + k0 + kk]; o[h][0] += ph * v0; o[h][1] += ph * v1; o[h][2] += ph * v2; o[h][3] += ph * v3; } } }
#pragma unroll
        for (int h = 0; h < 8; ++h) *(u32x2*)(OL + (size_t)tok * D + h * 256 + lane * 4) = (u32x2){pk2(o[h][0], o[h][1]), pk2(o[h][2], o[h][3])};
        asm volatile("s_waitcnt lgkmcnt(0)" ::: "memory");
    }
}

DI void nsa_score(const bf16_t* kr, const float* qf, float (&s)[4]) {
#pragma unroll
    for (int j = 0; j < 4; ++j) s[j] = 0.f;
#pragma unroll 4
    for (int c = 0; c < 16; ++c) { float kf[8]; unpack8(*(const u32x4*)(kr + c * 8), kf);
#pragma unroll
        for (int j = 0; j < 4; ++j) { const f32x4 q0 = *(const f32x4*)(qf + j * 128 + c * 8), q1 = *(const f32x4*)(qf + j * 128 + c * 8 + 4);
            s[j] += q0[0] * kf[0] + q0[1] * kf[1] + q0[2] * kf[2] + q0[3] * kf[3] + q1[0] * kf[4] + q1[1] * kf[5] + q1[2] * kf[6] + q1[3] * kf[7]; } }
}
DI void phase_nsa(const Params& p, char* smem) {
    const int tz_ = tid_fresh(); const int lane = tz_ & 63, wid = __builtin_amdgcn_readfirstlane(tz_ >> 6);
    float* qf = (float*)smem + wid * (512 + 256 + 512 + 16); float* pb = qf + 512; float* psum = pb + 256; int* blk = (int*)(psum + 512);
    const bf16_t* BQ = (const bf16_t*)(p.ws + O_BQ); const bf16_t* kvs = (const bf16_t*)(p.ws + O_KVS); const bf16_t* kcvc = (const bf16_t*)(p.ws + O_KCVC);
    const float* gates = (const float*)(p.ws + O_GATES); bf16_t* OB = (bf16_t*)(p.ws + O_OB);
#pragma unroll 1
    for (int item = (NT * 2 / 8 - 1 - (int)blockIdx.x) * 8 + wid; item >= 0; item -= gridDim.x * 8) {
        const int tok = item >> 1, g = item & 1, b = tok >> 13, tq = tok & (T - 1);
        { float f[8]; unpack8(*(const u32x4*)(BQ + (size_t)tok * 1024 + g * 512 + lane * 8), f);
#pragma unroll
          for (int j = 0; j < 8; ++j) qf[lane * 8 + j] = f[j]; }
        asm volatile("s_waitcnt lgkmcnt(0)" ::: "memory");
        const size_t bg = (size_t)(b * 2 + g);
        const int nmax = tq >= 31 ? (tq - 31) >> 4 : -1;
        float res[4][2], o[4][2], m[4], l[4]; int ns = 0;
#pragma unroll
        for (int j = 0; j < 4; ++j) { res[j][0] = 0.f; res[j][1] = 0.f; }
#pragma unroll 1
        for (int step = 0; step < 4; ++step) {
            const int kind = step < 2 ? 0 : step - 1;
            const int mode = step == 0 ? 1 : (step == 1 ? 2 : 0);
            const bf16_t* kbase; const bf16_t* vbase; int nch;
            if (kind == 0) { kbase = kcvc + bg * 512 * 128; vbase = kcvc + (size_t)2048 * 128 + bg * 512 * 128; nch = 8; }
            else if (kind == 1) { kbase = kvs + (2 * (size_t)NB * 2 + bg) * T * 128; vbase = kvs + (3 * (size_t)NB * 2 + bg) * T * 128; nch = ns; }
            else { kbase = kvs + (4 * (size_t)NB * 2 + bg) * T * 128; vbase = kvs + (5 * (size_t)NB * 2 + bg) * T * 128; nch = 8; }
            if (mode != 2) {
#pragma unroll
                for (int j = 0; j < 4; ++j) { m[j] = -INFINITY; l[j] = 0.f; } }
#pragma unroll
            for (int j = 0; j < 4; ++j) { o[j][0] = 0.f; o[j][1] = 0.f; }
#pragma unroll 1
            for (int c = 0; c < nch; ++c) {
                int base, lim_lo, lim_hi;
                if (kind == 0) { base = 64 * c; lim_lo = 0; lim_hi = nmax; }
                else if (kind == 1) { base = blk[c] * 64; lim_lo = 0; lim_hi = tq; }
                else { base = tq - 511 + 64 * c; lim_lo = 0; lim_hi = tq; }
                const bool active = base <= lim_hi && base + 63 >= lim_lo;
                if (!active) { if (mode == 2) psum[c * 64 + lane] = 0.f; continue; }
                const int key = base + lane; const bool valid = key >= lim_lo && key <= lim_hi;
                float s[4]; nsa_score(kbase + (size_t)(key < 0 ? 0 : key) * 128, qf, s);
                float ps = 0.f;
#pragma unroll
                for (int j = 0; j < 4; ++j) {
                    const float sv = valid ? s[j] * ATT_SCALE : -INFINITY; float pj;
                    if (mode == 2) { pj = valid ? __expf(sv - m[j]) * l[j] : 0.f; ps += pj; }
                    else { const float mn = fmaxf(m[j], wave_max(sv));
                        const float alpha = (m[j] == -INFINITY) ? 0.f : __expf(m[j] - mn);
                        pj = (sv == -INFINITY) ? 0.f : __expf(sv - mn);
                        l[j] = l[j] * alpha + wave_sum(pj); m[j] = mn; o[j][0] *= alpha; o[j][1] *= alpha; }
                    pb[j * 64 + lane] = pj; }
                if (mode == 2) psum[c * 64 + lane] = ps;
                if (mode != 1) {
                    asm volatile("s_waitcnt lgkmcnt(0)" ::: "memory");
#pragma unroll 1
                    for (int k0 = 0; k0 < 64; k0 += 8) { unsigned vv[8];
#pragma unroll
                        for (int kk = 0; kk < 8; ++kk) { const int kx = base + k0 + kk; vv[kk] = *(const unsigned*)(vbase + (size_t)(kx < 0 ? 0 : kx) * 128 + lane * 2); }
#pragma unroll
                        for (int kk = 0; kk < 8; ++kk) { const float v0 = bflo(vv[kk]), v1 = bfhi(vv[kk]);
#pragma unroll
                            for (int j = 0; j < 4; ++j) { const float ph = pb[j * 64 + k0 + kk]; o[j][0] += ph * v0; o[j][1] += ph * v1; } } } }
                asm volatile("s_waitcnt lgkmcnt(0)" ::: "memory");
            }
            if (step == 0) {
#pragma unroll
                for (int j = 0; j < 4; ++j) { if (m[j] == -INFINITY) m[j] = 0.f; l[j] = 1.f / fmaxf(l[j], 1e-30f); }
                continue; }
#pragma unroll
            for (int j = 0; j < 4; ++j) { const float gt = gates[(size_t)tok * 24 + (g * 4 + j) * 3 + kind]; const float il = (mode == 2) ? gt : gt / fmaxf(l[j], 1e-30f);
                res[j][0] += il * o[j][0]; res[j][1] += il * o[j][1]; }
            if (step == 1) {
                asm volatile("s_waitcnt lgkmcnt(0)" ::: "memory");
                const int cur = tq >> 6; unsigned key[2];
#pragma unroll
                for (int hh = 0; hh < 2; ++hh) { const int mb = lane + 64 * hh; float imp = 0.f;
#pragma unroll
                    for (int d = -1; d < 4; ++d) { const int n = 4 * mb + d; if (n >= 0 && n < 512) imp += psum[n]; }
                    const bool adm = mb <= cur, forced = mb == 0 || mb == cur || mb == cur - 1;
                    key[hh] = !adm ? 0u : (forced ? (0xFF000000u | (unsigned)(127 - mb)) : ((((__float_as_uint(imp) >> 7) + 1u) << 7) | (unsigned)(127 - mb))); }
                unsigned Tv = 0u;
                for (int bit = 31; bit >= 0; --bit) { const unsigned cand = Tv | (1u << bit);
                    const int cnt = __popcll(__ballot(key[0] >= cand)) + __popcll(__ballot(key[1] >= cand)); if (cnt >= 16) Tv = cand; }
                if (Tv == 0u) Tv = 1u;
                const unsigned long long m0 = __ballot(key[0] >= Tv), m1 = __ballot(key[1] >= Tv);
                const unsigned long long ltm = (1ull << lane) - 1ull;
                if (key[0] >= Tv) blk[__popcll(m0 & ltm)] = lane;
                if (key[1] >= Tv) blk[__popcll(m0) + __popcll(m1 & ltm)] = lane + 64;
                ns = __popcll(m0) + __popcll(m1);
                asm volatile("s_waitcnt lgkmcnt(0)" ::: "memory"); }
        }
#pragma unroll
        for (int j = 0; j < 4; ++j) *(unsigned*)(OB + (size_t)tok * 1024 + (g * 4 + j) * 128 + lane * 2) = pk2(res[j][0], res[j][1]);
        asm volatile("s_waitcnt lgkmcnt(0)" ::: "memory");
    }
}

typedef float f32x16 __attribute__((ext_vector_type(16)));
typedef short s16x4 __attribute__((ext_vector_type(4)));
#define MFMA32(a, b, c) __builtin_amdgcn_mfma_f32_32x32x16_bf16((a), (b), (c), 0, 0, 0)
DI unsigned offb(unsigned row, unsigned ch) { return 256u * row + 16u * (ch ^ (((row & 3u) << 2) | ((row >> 2) & 3u))); }
DI unsigned cvt2(float a, float b) { typedef __bf16 b2 __attribute__((ext_vector_type(2))); typedef float f2 __attribute__((ext_vector_type(2))); const b2 r = __builtin_convertvector((f2){a, b}, b2); return __builtin_bit_cast(unsigned, r); }
DI bf16x8 pack_relu(const f32x16& x, int s) {
    u32x4 w = {cvt2(x[8 * s], x[8 * s + 1]), cvt2(x[8 * s + 2], x[8 * s + 3]), cvt2(x[8 * s + 4], x[8 * s + 5]), cvt2(x[8 * s + 6], x[8 * s + 7])};
#pragma unroll
    for (int i = 0; i < 4; ++i) { unsigned r; asm volatile("v_pk_max_i16 %0, %1, 0" : "=v"(r) : "v"(w[i])); w[i] = r; }
    return __builtin_bit_cast(bf16x8, w);
}
DI bf16x8 pack_p(const f32x16& x, int s) {
    const u32x4 w = {cvt2(x[8 * s], x[8 * s + 1]), cvt2(x[8 * s + 2], x[8 * s + 3]), cvt2(x[8 * s + 4], x[8 * s + 5]), cvt2(x[8 * s + 6], x[8 * s + 7])};
    return __builtin_bit_cast(bf16x8, w);
}
DI void nsa_tile_dma(LAS char* kb, LAS char* vb, const bf16_t* kt, const bf16_t* vt, int tid, int w) {
#pragma unroll
    for (int i = 0; i < 2; ++i) { const int id = tid + 512 * i; const unsigned row = id >> 4, pos = id & 15; const unsigned ch = pos ^ (((row & 3u) << 2) | ((row >> 2) & 3u));
        const size_t so = (size_t)row * 128 + ch * 8; const unsigned lo = (unsigned)(i * 512 + w * 64) * 16u;
        __builtin_amdgcn_global_load_lds((const unsigned*)(kt + so), (LAS unsigned*)(kb + lo), 16, 0, 0);
        __builtin_amdgcn_global_load_lds((const unsigned*)(vt + so), (LAS unsigned*)(vb + lo), 16, 0, 0); }
}
#define NSA_TR8(R, A, OFF) asm volatile( \
    "ds_read_b64_tr_b16 %0, %8 offset:%16\n\tds_read_b64_tr_b16 %1, %9 offset:%16\n\tds_read_b64_tr_b16 %2, %10 offset:%16\n\tds_read_b64_tr_b16 %3, %11 offset:%16\n\t" \
    "ds_read_b64_tr_b16 %4, %12 offset:%16\n\tds_read_b64_tr_b16 %5, %13 offset:%16\n\tds_read_b64_tr_b16 %6, %14 offset:%16\n\tds_read_b64_tr_b16 %7, %15 offset:%16\n\ts_waitcnt lgkmcnt(0)" \
    : "=&v"(R[0]), "=&v"(R[1]), "=&v"(R[2]), "=&v"(R[3]), "=&v"(R[4]), "=&v"(R[5]), "=&v"(R[6]), "=&v"(R[7]) \
    : "v"(A[0]), "v"(A[1]), "v"(A[2]), "v"(A[3]), "v"(A[4]), "v"(A[5]), "v"(A[6]), "v"(A[7]), "i"(OFF) : "memory")

#define NSA_TR4(R, A0, A1, A2, A3, OFF) asm volatile( \
    "ds_read_b64_tr_b16 %0, %4 offset:%8\n\tds_read_b64_tr_b16 %1, %5 offset:%8\n\tds_read_b64_tr_b16 %2, %6 offset:%8\n\tds_read_b64_tr_b16 %3, %7 offset:%8" \
    : "=&v"(R[0]), "=&v"(R[1]), "=&v"(R[2]), "=&v"(R[3]) : "v"(A0), "v"(A1), "v"(A2), "v"(A3), "i"(OFF) : "memory")
#define NSA_LWAIT(N, R) asm volatile("s_waitcnt lgkmcnt(" #N ")" : "+v"(R[0]), "+v"(R[1]), "+v"(R[2]), "+v"(R[3]) :: "memory")
struct NsaWave {
    float m, l;
    f32x16 O[4];
    bf16x8 q[8];
};
template <int MODE>
DI void nsa_tile_compute(NsaWave& W, unsigned kbuf, unsigned vbuf, const unsigned (&vaddr0)[8], int tq0, int kind, int kbeg, bool needmask, bool rowneed, int lane, LAS float* impA, LAS float* impL, int mblk0) {
    const int c = lane & 31, h = lane >> 5;
    constexpr float C2 = ATT_SCALE * 1.4426950408889634f;
    f32x16 s0, s1;
    const f32x16 zero16 = {0.f, 0.f, 0.f, 0.f, 0.f, 0.f, 0.f, 0.f, 0.f, 0.f, 0.f, 0.f, 0.f, 0.f, 0.f, 0.f};
    const unsigned f = ((c & 3u) << 2) | ((c >> 2) & 3u);
#ifndef NSA_REP_QK
#define NSA_REP_QK 1
#endif
    __builtin_amdgcn_s_setprio(1);
#pragma unroll 1
    for (int rq_ = 0; rq_ < NSA_REP_QK; ++rq_) {
        if (NSA_REP_QK > 1) asm volatile("" ::: "memory");
#pragma unroll
    for (int s = 0; s < 8; ++s) { const unsigned ch = (unsigned)(2 * s + h) ^ f;
        const bf16x8 a0 = *(const LAS bf16x8*)(size_t)(kbuf + 256u * c + 16u * ch), a1 = *(const LAS bf16x8*)(size_t)(kbuf + 8192u + 256u * c + 16u * ch);
        s0 = MFMA32(a0, W.q[s], s == 0 ? zero16 : s0); s1 = MFMA32(a1, W.q[s], s == 0 ? zero16 : s1); } }
    __builtin_amdgcn_s_setprio(0);
    if (needmask) {
        const int tq = tq0 + (c >> 2);
        const int lo = kind == 2 ? tq - 511 : 0, hi = kind == 0 ? (tq >= 31 ? (tq - 31) >> 4 : -1) : tq;
#pragma unroll
        for (int r = 0; r < 16; ++r) { const int k0 = kbeg + (r & 3) + 8 * (r >> 2) + 4 * h, k1 = k0 + 32;
            if (!(k0 >= lo && k0 <= hi)) s0[r] = -INFINITY;
            if (!(k1 >= lo && k1 <= hi)) s1[r] = -INFINITY; }
    }
    if (MODE != 2) {
        float mx = fmaxf(fmaxf(s0[0], s0[1]), s1[0]);
#pragma unroll
        for (int r = 2; r < 16; r += 2) mx = fmaxf(fmaxf(mx, s0[r]), s0[r + 1]);
#pragma unroll
        for (int r = 1; r < 15; r += 2) mx = fmaxf(fmaxf(mx, s1[r]), s1[r + 1]);
        mx = fmaxf(mx, s1[15]);
        mx = fmaxf(mx, __shfl_xor(mx, 32));
        if (!rowneed) mx = -INFINITY;
        const float mn = (W.m == -INFINITY || (mx - W.m) * C2 > 8.f) ? fmaxf(W.m, mx) : W.m;
        const float mu = (mn == -INFINITY) ? 0.f : mn;
        const float alpha = __builtin_amdgcn_exp2f((W.m - mu) * C2);
        const float nb = rowneed ? -mu * C2 : -INFINITY;
        float rs = 0.f;
#pragma unroll
        for (int r = 0; r < 16; ++r) { s0[r] = __builtin_amdgcn_exp2f(__builtin_fmaf(s0[r], C2, nb)); s1[r] = __builtin_amdgcn_exp2f(__builtin_fmaf(s1[r], C2, nb)); rs += s0[r] + s1[r]; }
        rs += __shfl_xor(rs, 32);
        W.l = W.l * alpha + rs; W.m = mn;
        if (MODE == 0 && !__all(alpha == 1.f)) {
#pragma unroll
            for (int d = 0; d < 4; ++d)
#pragma unroll
                for (int r = 0; r < 16; ++r) W.O[d][r] *= alpha; }
    } else {
#pragma unroll
        for (int r = 0; r < 16; ++r) { s0[r] = __builtin_amdgcn_exp2f((s0[r] - W.m) * C2) * W.l; s1[r] = __builtin_amdgcn_exp2f((s1[r] - W.m) * C2) * W.l; }
#pragma unroll
        for (int kb = 0; kb < 2; ++kb)
#pragma unroll
            for (int i = 0; i < 4; ++i) { const f32x16& sv = kb ? s1 : s0;
                float a = sv[4 * i] + sv[4 * i + 1] + sv[4 * i + 2] + sv[4 * i + 3], lv = sv[4 * i + 3];
                a += __shfl_xor(a, 1); a += __shfl_xor(a, 2); lv += __shfl_xor(lv, 1); lv += __shfl_xor(lv, 2);
                if ((c & 3) == 0) { const int mb = mblk0 + 8 * kb + 2 * i + h; impA[(c >> 2) * 128 + mb] = a; impL[(c >> 2) * 128 + mb] = lv; } }
    }
    if (MODE != 1) {
        unsigned vaddrl[8];
        { const unsigned q = (lane & 15) >> 2, pp = lane & 3, blk = (lane >> 4) & 1;
#pragma unroll
          for (int d = 0; d < 4; ++d)
#pragma unroll
              for (int t = 0; t < 2; ++t) vaddrl[2 * d + t] = vbuf + offb(8u * t + 4u * h + q, 4u * d + 2u * blk + (pp >> 1)) + 8u * (pp & 1u); }
        bf16x8 pf[4] = {pack_p(s0, 0), pack_p(s0, 1), pack_p(s1, 0), pack_p(s1, 1)};
        s16x4 RA[4], RB[4];
        asm volatile("s_waitcnt lgkmcnt(0)" ::: "memory");
        NSA_TR4(RA, vaddrl[0], vaddrl[1], vaddrl[2], vaddrl[3], 0);
        NSA_TR4(RB, vaddrl[4], vaddrl[5], vaddrl[6], vaddrl[7], 0);
#define NSA_PVSTEP(KS, NEXTOFF, HASNEXT) \
        NSA_LWAIT(4, RA); __builtin_amdgcn_sched_barrier(0); \
        { const bf16x8 v0_ = __builtin_shufflevector(RA[0], RA[1], 0, 1, 2, 3, 4, 5, 6, 7), v1_ = __builtin_shufflevector(RA[2], RA[3], 0, 1, 2, 3, 4, 5, 6, 7); \
          W.O[0] = MFMA32(v0_, pf[KS], W.O[0]); W.O[1] = MFMA32(v1_, pf[KS], W.O[1]); } \
        __builtin_amdgcn_sched_barrier(0); \
        if (HASNEXT) NSA_TR4(RA, vaddrl[0], vaddrl[1], vaddrl[2], vaddrl[3], NEXTOFF); \
        if (HASNEXT) NSA_LWAIT(4, RB); else NSA_LWAIT(0, RB); \
        __builtin_amdgcn_sched_barrier(0); \
        { const bf16x8 v2_ = __builtin_shufflevector(RB[0], RB[1], 0, 1, 2, 3, 4, 5, 6, 7), v3_ = __builtin_shufflevector(RB[2], RB[3], 0, 1, 2, 3, 4, 5, 6, 7); \
          W.O[2] = MFMA32(v2_, pf[KS], W.O[2]); W.O[3] = MFMA32(v3_, pf[KS], W.O[3]); } \
        __builtin_amdgcn_sched_barrier(0); \
        if (HASNEXT) NSA_TR4(RB, vaddrl[4], vaddrl[5], vaddrl[6], vaddrl[7], NEXTOFF);
        __builtin_amdgcn_s_setprio(1);
        NSA_PVSTEP(0, 4096, true) NSA_PVSTEP(1, 8192, true) NSA_PVSTEP(2, 12288, true) NSA_PVSTEP(3, 0, false)
        __builtin_amdgcn_s_setprio(0);
#undef NSA_PVSTEP
    }
}
DI void nsa_fold(const NsaWave& W, bf16_t* obrow, unsigned char* ob8row, float sc, bool first, bool last, int h) {
#pragma unroll
    for (int d = 0; d < 4; ++d)
#pragma unroll
        for (int i = 0; i < 4; ++i) { bf16_t* pp = obrow + 32 * d + 8 * i + 4 * h; float o0 = 0.f, o1 = 0.f, o2 = 0.f, o3 = 0.f;
            if (!first) { const u32x2 w = *(const u32x2*)pp; o0 = bflo(w[0]); o1 = bfhi(w[0]); o2 = bflo(w[1]); o3 = bfhi(w[1]); }
            o0 += sc * W.O[d][4 * i]; o1 += sc * W.O[d][4 * i + 1]; o2 += sc * W.O[d][4 * i + 2]; o3 += sc * W.O[d][4 * i + 3];
            if (last) *(unsigned*)(ob8row + 32 * d + 8 * i + 4 * h) = pg8::fp8x4(o0 * pg8::A8_SCALE, o1 * pg8::A8_SCALE, o2 * pg8::A8_SCALE, o3 * pg8::A8_SCALE);
            else *(u32x2*)pp = (u32x2){cvt2(o0, o1), cvt2(o2, o3)}; }
}
struct NsaRun { LAS char* L; unsigned lds0; const bf16_t* kbase; const bf16_t* vbase; int t0, nt, kind, tqmin, lo_min, lo_max, hi_min, hi_max, tid, w; LAS unsigned* selm; LAS float* impA; LAS float* impL; };
template <int MODE>
DI void nsa_tiles(NsaWave& W, const NsaRun& R, const unsigned (&vaddr)[8]) {
    if (R.nt <= 0) return;
    const int lane = R.tid & 63, c = lane & 31;
    __syncthreads();
    nsa_tile_dma(R.L, R.L + 16384, R.kbase + (size_t)R.t0 * 8192, R.vbase + (size_t)R.t0 * 8192, R.tid, R.w);
    asm volatile("s_waitcnt vmcnt(0)" ::: "memory");
    __syncthreads();
#pragma unroll 1
    for (int i = 0; i < R.nt; ++i) {
        const int cur = i & 1, tt = R.t0 + i, kbeg = tt * 64;
        if (i + 1 < R.nt) nsa_tile_dma(R.L + (cur ^ 1) * 32768, R.L + (cur ^ 1) * 32768 + 16384, R.kbase + (size_t)(tt + 1) * 8192, R.vbase + (size_t)(tt + 1) * 8192, R.tid, R.w);
        bool rowneed = true;
        if (R.kind == 1) { const unsigned wsel = R.selm[(c >> 2) * 4 + (tt >> 5)]; rowneed = (wsel >> (tt & 31)) & 1u; }
        const bool skip = kbeg > R.hi_max || kbeg + 63 < R.lo_min || (R.kind == 1 && __ballot(rowneed) == 0ull);
        if (!skip) {
            const bool needmask = !(kbeg >= R.lo_max && kbeg + 63 <= R.hi_min);
            const unsigned kb_ = R.lds0 + cur * 32768u, vb_ = kb_ + 16384u;
            nsa_tile_compute<MODE>(W, kb_, vb_, vaddr, R.tqmin, R.kind, kbeg, needmask, rowneed, lane, R.impA, R.impL, MODE == 2 ? tt * 16 : 0);
        }
        asm volatile("s_waitcnt vmcnt(0)" ::: "memory");
        __syncthreads();
    }
}
DI void phase_nsa_mfma(const Params& p, char* smem) {
    const int tid = tid_fresh(), lane = tid & 63, w = __builtin_amdgcn_readfirstlane(tid >> 6), c = lane & 31, h = lane >> 5;
    LAS char* L = (LAS char*)smem;
    const unsigned lds0 = (unsigned)(size_t)L;
    LAS float* impA = (LAS float*)(L + 65536) + w * 1024; LAS float* impL = (LAS float*)(L + 65536 + 32768) + w * 1024;
    LAS unsigned* selm = (LAS unsigned*)(L + 131072) + w * 32;
    const bf16_t* BQ = (const bf16_t*)(p.ws + O_BQ); const bf16_t* kvs = (const bf16_t*)(p.ws + O_KVS); const bf16_t* kcvc = (const bf16_t*)(p.ws + O_KCVC);
    const float* gates = (const float*)(p.ws + O_GATES); bf16_t* OB = (bf16_t*)(p.ws + O_OB);
    unsigned vaddr[8];
    { const unsigned q = (lane & 15) >> 2, pp = lane & 3, blk = (lane >> 4) & 1;
#pragma unroll
      for (int d = 0; d < 4; ++d)
#pragma unroll
          for (int t = 0; t < 2; ++t) vaddr[2 * d + t] = offb(8u * t + 4u * h + q, 4u * d + 2u * blk + (pp >> 1)) + 8u * (pp & 1u); }
#pragma unroll 1
    for (int P = blockIdx.x; P < 256; P += gridDim.x) {
#pragma unroll 1
        for (int half = 0; half < 2; ++half) {
            const int bg = P >> 6, x = P & 63, qb = half == 0 ? 127 - x : x, b = bg >> 1, g = bg & 1, q0 = qb * 64;
            NsaWave W;
            const int tqmin = q0 + 8 * w, tqmax = tqmin + 7; const int tok = b * T + tqmin + (c >> 2);
            { const bf16_t* qr = BQ + (size_t)tok * 1024 + (g * 4 + (c & 3)) * 128 + 8 * h;
#pragma unroll
              for (int s = 0; s < 8; ++s) W.q[s] = *(const bf16x8*)(qr + 16 * s); }
#pragma unroll
            for (int i = 0; i < 16; ++i) { impA[lane + 64 * i] = 0.f; impL[lane + 64 * i] = 0.f; }
            for (int step = 0; step < 4; ++step) {
                const int kind = step < 2 ? 0 : step - 1;
                const bf16_t* kbase; const bf16_t* vbase; int t0, nt;
                int lo_min, lo_max, hi_min, hi_max;
                if (kind == 0) { kbase = kcvc + (size_t)bg * 512 * 128; vbase = kcvc + (size_t)2048 * 128 + (size_t)bg * 512 * 128;
                    t0 = 0; const int nlast = (q0 + 63 - 31) >> 4; nt = q0 + 63 >= 31 ? (nlast >> 6) + 1 : 0;
                    lo_min = 0; lo_max = 0; hi_min = tqmin >= 31 ? (tqmin - 31) >> 4 : -1; hi_max = tqmax >= 31 ? (tqmax - 31) >> 4 : -1; }
                else if (kind == 1) { kbase = kvs + (2 * (size_t)NB * 2 + bg) * T * 128; vbase = kvs + (3 * (size_t)NB * 2 + bg) * T * 128;
                    t0 = 0; nt = qb + 1; lo_min = 0; lo_max = 0; hi_min = tqmin; hi_max = tqmax; }
                else { kbase = kvs + (4 * (size_t)NB * 2 + bg) * T * 128; vbase = kvs + (5 * (size_t)NB * 2 + bg) * T * 128;
                    t0 = qb >= 8 ? qb - 8 : 0; nt = qb - t0 + 1; lo_min = tqmin - 511; lo_max = tqmax - 511; hi_min = tqmin; hi_max = tqmax; }
                if (step != 1) { W.m = -INFINITY; W.l = 0.f; }
#pragma unroll
                for (int d = 0; d < 4; ++d)
#pragma unroll
                    for (int r = 0; r < 16; ++r) W.O[d][r] = 0.f;
                {   NsaRun R; R.L = L; R.lds0 = lds0; R.kbase = kbase; R.vbase = vbase; R.t0 = t0; R.nt = nt; R.kind = kind; R.tqmin = tqmin; R.lo_min = lo_min; R.lo_max = lo_max; R.hi_min = hi_min; R.hi_max = hi_max;
                    R.tid = tid; R.w = w; R.selm = selm; R.impA = impA; R.impL = impL;
                    if (step == 0) nsa_tiles<1>(W, R, vaddr); else if (step == 1) nsa_tiles<2>(W, R, vaddr); else nsa_tiles<0>(W, R, vaddr); }
                if (step == 0) { if (W.m == -INFINITY) W.m = 0.f; W.l = 1.f / fmaxf(W.l, 1e-30f); continue; }
                { int lz = lane; asm volatile("" : "+v"(lz)); const int cz = lz & 31; const int tokz = b * T + tqmin + (cz >> 2);
                  const float gv = gates[(size_t)tokz * 24 + (g * 4 + (cz & 3)) * 3 + kind];
                  nsa_fold(W, OB + (size_t)tokz * 1024 + (g * 4 + (cz & 3)) * 128, (unsigned char*)(p.ws + O_OB8) + (size_t)tokz * 1024 + (g * 4 + (cz & 3)) * 128, step == 1 ? gv : gv / fmaxf(W.l, 1e-30f), step == 1, step == 3, lz >> 5); }
                if (step == 1) {
                    asm volatile("s_waitcnt lgkmcnt(0)" ::: "memory");
#pragma unroll 1
                    for (int qi = 0; qi < 8; ++qi) { const int tqq = tqmin + qi, curb = tqq >> 6; unsigned key[2];
#pragma unroll
                        for (int hh = 0; hh < 2; ++hh) { const int mb = lane + 64 * hh; const float imp = impA[qi * 128 + mb] + (mb > 0 ? impL[qi * 128 + mb - 1] : 0.f);
                            const bool adm = mb <= curb, forced = mb == 0 || mb == curb || mb == curb - 1;
                            key[hh] = !adm ? 0u : (forced ? (0xFF000000u | (unsigned)(127 - mb)) : ((((__float_as_uint(imp) >> 7) + 1u) << 7) | (unsigned)(127 - mb))); }
                        unsigned Tv = 0u;
                        for (int bit = 31; bit >= 0; --bit) { const unsigned cand = Tv | (1u << bit);
                            const int cnt = __popcll(__ballot(key[0] >= cand)) + __popcll(__ballot(key[1] >= cand)); if (cnt >= 16) Tv = cand; }
                        if (Tv == 0u) Tv = 1u;
                        const unsigned long long m0 = __ballot(key[0] >= Tv), m1 = __ballot(key[1] >= Tv);
                        if (lane == 0) { selm[qi * 4] = (unsigned)m0; selm[qi * 4 + 1] = (unsigned)(m0 >> 32); selm[qi * 4 + 2] = (unsigned)m1; selm[qi * 4 + 3] = (unsigned)(m1 >> 32); } }
                    asm volatile("s_waitcnt lgkmcnt(0)" ::: "memory");
                }
            }
        }
    }
}

DI void topk256_hist(LAS unsigned short* sck, int nk, LAS unsigned* hist, unsigned short* out, int lane) {
    const int nit = (nk + 511) >> 9;
    const unsigned long long ltm = (1ull << lane) - 1ull;
    const int sub = lane & 1;
    for (int k = nk + lane; k < 512 * nit; k += 64) sck[k] = 0;
    unsigned bsel = 0, cnt_above = 0;
#pragma unroll 1
    for (int rpp_ = 0; rpp_ < ((SEL_REP & 1) ? 2 : 1); ++rpp_) { bsel = 0; cnt_above = 0; asm volatile("" : "+v"(bsel), "+v"(cnt_above));
#pragma unroll 1
    for (int pass = 0; pass < 2; ++pass) {
        *(LAS u32x4*)(hist + 8 * lane) = (u32x4){0u, 0u, 0u, 0u}; *(LAS u32x4*)(hist + 8 * lane + 4) = (u32x4){0u, 0u, 0u, 0u};
        asm volatile("s_waitcnt lgkmcnt(0)" ::: "memory");
#pragma unroll 1
        for (int i = 0; i < nit; ++i) { const int k0 = 8 * (i * 64 + lane); const u32x4 wv = *(const LAS u32x4*)(sck + k0);
#pragma unroll
            for (int j = 0; j < 8; ++j) { const unsigned key = (j & 1) ? (wv[j >> 1] >> 16) : (wv[j >> 1] & 0xffffu);
                if (pass == 0) __hip_atomic_fetch_add(hist + 2 * (key >> 8) + sub, 1u, __ATOMIC_RELAXED, __HIP_MEMORY_SCOPE_WORKGROUP);
                else if ((key >> 8) == bsel) __hip_atomic_fetch_add(hist + 2 * (key & 255u) + sub, 1u, __ATOMIC_RELAXED, __HIP_MEMORY_SCOPE_WORKGROUP); } }
        asm volatile("s_waitcnt lgkmcnt(0)" ::: "memory");
        const u32x4 h0 = *(const LAS u32x4*)(hist + 8 * lane), h1 = *(const LAS u32x4*)(hist + 8 * lane + 4);
        const u32x4 c4 = {h0[0] + h0[1], h0[2] + h0[3], h1[0] + h1[1], h1[2] + h1[3]};
        const unsigned tot = c4[0] + c4[1] + c4[2] + c4[3];
        unsigned inc = tot;
#pragma unroll
        for (int o = 1; o < 64; o <<= 1) { const unsigned v = __shfl_down(inc, o); if (lane + o < 64) inc += v; }
        unsigned above = cnt_above + inc - tot;
        int found = -1; unsigned fabove = 0;
#pragma unroll
        for (int bb = 3; bb >= 0; --bb) { if (found < 0 && above < 256u && above + c4[bb] >= 256u) { found = 4 * lane + bb; fabove = above; } above += c4[bb]; }
        const unsigned long long fm = __ballot(found >= 0); const int src = __builtin_ctzll(fm);
        const unsigned fb = (unsigned)__shfl(found, src); cnt_above = (unsigned)__shfl((int)fabove, src);
        bsel = pass == 0 ? fb : ((bsel << 8) | fb);
    }
    }
    const unsigned Tv = bsel; const int need = 256 - (int)cnt_above; int pos = 0, eqc = 0;
#pragma unroll 1
    for (int rpe_ = 0; rpe_ < ((SEL_REP & 2) ? 2 : 1); ++rpe_) { pos = 0; eqc = 0; asm volatile("" : "+v"(pos), "+v"(eqc));
#pragma unroll 1
    for (int i = 0; i < nit; ++i) { const int k0 = 8 * (i * 64 + lane); const u32x4 wv = *(const LAS u32x4*)(sck + k0);
        bool eq[8], sl[8]; bool anyeq = false;
#pragma unroll
        for (int j = 0; j < 8; ++j) { const unsigned key = (j & 1) ? (wv[j >> 1] >> 16) : (wv[j >> 1] & 0xffffu); eq[j] = key == Tv; sl[j] = key > Tv; anyeq |= eq[j]; }
        if (__ballot(anyeq) != 0ull) {
            int below = 0, own = 0, etot = 0;
#pragma unroll
            for (int j = 0; j < 8; ++j) { const unsigned long long em = __ballot(eq[j]); below += __popcll(em & ltm); etot += __popcll(em); }
#pragma unroll
            for (int j = 0; j < 8; ++j) if (eq[j]) { if (eqc + below + own < need) sl[j] = true; ++own; }
            eqc += etot; }
#pragma unroll
        for (int j = 0; j < 8; ++j) { const unsigned long long sm = __ballot(sl[j]); if (sl[j]) out[pos + __popcll(sm & ltm)] = (unsigned short)(k0 + j); pos += __popcll(sm); } }
    }
}
DI void phase_indexer_mfma(const Params& p, char* smem) {
    const int tid = tid_fresh(), lane = tid & 63, w = __builtin_amdgcn_readfirstlane(tid >> 6), c = lane & 31, hh = lane >> 5;
    LAS unsigned short* sc = (LAS unsigned short*)(LAS char*)smem;
    LAS unsigned* hist = (LAS unsigned*)((LAS char*)smem + 131072) + w * 512;
    const bf16_t* Q = (const bf16_t*)(p.ws + O_QALL); const bf16_t* KI = (const bf16_t*)(p.ws + O_KIDX); const float* WI = (const float*)(p.ws + O_WIDX);
    unsigned short* SEL = (unsigned short*)(p.ws + O_SEL); int* NSEL = (int*)(p.ws + O_NSEL);
    const float* rope = (const float*)(p.ws + O_ROPE);
    c2_rows(p, smem);
    __syncthreads();
#pragma unroll 1
    for (int rnd = 0; rnd * (int)gridDim.x < NT / 8; ++rnd) {
        const int slot = (rnd & 1) ? (int)gridDim.x - 1 - (int)blockIdx.x : (int)blockIdx.x;
        const int u = NT / 8 - 1 - (rnd * (int)gridDim.x + slot);
        if (u < 0) continue;
        const int tok0 = u * 8, b = tok0 >> 13, q0 = tok0 & (T - 1), nkmax = q0 + 8;
        const int tok = tok0 + w, nk = q0 + w + 1;
        unsigned short* out = SEL + (size_t)tok * 256;
#ifndef IDX_REP_SCORE
#define IDX_REP_SCORE 1
#endif
#ifndef IDX_REP_SEL
#define IDX_REP_SEL 1
#endif
        for (int rs_ = 0; rs_ < IDX_REP_SCORE; ++rs_)
        if (nkmax > 256) {
            bf16x8 qa[2][4], Wf[2][2];
#pragma unroll
            for (int rb = 0; rb < 2; ++rb) { const bf16_t* qr = Q + (size_t)(tok0 + 4 * rb + (c >> 3)) * QC + 2304 + (c & 7) * 64 + 8 * hh;
#pragma unroll
                for (int s = 0; s < 4; ++s) qa[rb][s] = *(const bf16x8*)(qr + 16 * s);
                {
                    const float* rt = rope + (size_t)(tok0 + 4 * rb + (c >> 3)) * 48 + 32;
                    const u32x4 own = __builtin_bit_cast(u32x4, qa[rb][0]); u32x4 oth;
#pragma unroll
                    for (int k = 0; k < 4; ++k) oth[k] = (unsigned)__shfl_xor((int)own[k], 32);
                    float xa[8], xb[8], xr[8]; unpack8(own, xa); unpack8(oth, xb);
#pragma unroll
                    for (int j = 0; j < 8; ++j) { const float cs = rt[2 * j], sn = rt[2 * j + 1]; xr[j] = hh == 0 ? xa[j] * cs - xb[j] * sn : xa[j] * cs + xb[j] * sn; }
                    const u32x4 pk = {pk2(xr[0], xr[1]), pk2(xr[2], xr[3]), pk2(xr[4], xr[5]), pk2(xr[6], xr[7])};
                    qa[rb][0] = __builtin_bit_cast(bf16x8, pk); }
                { f32x4 wv = {0.f, 0.f, 0.f, 0.f}; if (c < 8) wv = *(const f32x4*)(WI + (size_t)(tok0 + c) * 8 + 4 * hh);
#pragma unroll
                  for (int sp = 0; sp < 2; ++sp) { const bool m0 = c == 4 * rb + 2 * sp, m1 = c == 4 * rb + 2 * sp + 1;
                      const u32x4 pkw = {m0 ? pk2(wv[0], wv[1]) : 0u, m0 ? pk2(wv[2], wv[3]) : 0u, m1 ? pk2(wv[0], wv[1]) : 0u, m1 ? pk2(wv[2], wv[3]) : 0u};
                      Wf[rb][sp] = __builtin_bit_cast(bf16x8, pkw); } } }
            const int npair = (nkmax + 63) >> 6;
            const bf16_t* kbase = KI + ((size_t)b * T + c) * 64 + 8 * hh;
            bf16x8 kb[2][4], kn[2][4];
            auto ldk = [&](bf16x8 (&dst)[2][4], int pr) {
#pragma unroll
                for (int tt = 0; tt < 2; ++tt) { int key0 = 64 * pr + 32 * tt; if (key0 + 31 >= T) key0 = T - 32;
#pragma unroll
                    for (int s = 0; s < 4; ++s) dst[tt][s] = *(const bf16x8*)(kbase + (size_t)key0 * 64 + 16 * s); } };
            if (w < npair) ldk(kb, w);
#pragma unroll
            for (int tt = 0; tt < 2; ++tt)
#pragma unroll
                for (int s = 0; s < 4; ++s) asm volatile("" : "+v"(kb[tt][s]));
#pragma unroll 1
            for (int pr = w; pr < npair; pr += 8) {
                if (pr + 8 < npair) ldk(kn, pr + 8);
#pragma unroll
                for (int tt = 0; tt < 2; ++tt) {
                    const int key = 64 * pr + 32 * tt + c;
                    f32x16 a0, a1; const f32x16 z16 = {0.f, 0.f, 0.f, 0.f, 0.f, 0.f, 0.f, 0.f, 0.f, 0.f, 0.f, 0.f, 0.f, 0.f, 0.f, 0.f};
#pragma unroll
                    for (int s = 0; s < 4; ++s) { a0 = MFMA32(qa[0][s], kb[tt][s], s == 0 ? z16 : a0); a1 = MFMA32(qa[1][s], kb[tt][s], s == 0 ? z16 : a1); }
                    f32x16 d2 = MFMA32(Wf[0][0], pack_relu(a0, 0), z16);
                    d2 = MFMA32(Wf[0][1], pack_relu(a0, 1), d2); d2 = MFMA32(Wf[1][0], pack_relu(a1, 0), d2); d2 = MFMA32(Wf[1][1], pack_relu(a1, 1), d2);
                    if (key < 8192) {
#pragma unroll
                        for (int qq = 0; qq < 4; ++qq) sc[(4 * hh + qq) * 8192 + key] = f16key(d2[qq]); }
                }
#pragma unroll
                for (int tt = 0; tt < 2; ++tt)
#pragma unroll
                    for (int s = 0; s < 4; ++s) kb[tt][s] = kn[tt][s];
            }
        }
        __syncthreads();
        if (nk <= 256) { for (int i = lane; i < 256; i += 64) out[i] = (unsigned short)(i < nk ? i : 0); if (lane == 0) NSEL[tok] = nk; }
        else { for (int rs_ = 0; rs_ < IDX_REP_SEL; ++rs_) topk256_hist(sc + w * 8192, nk, hist, out, lane); if (lane == 0) NSEL[tok] = 256; }
        __syncthreads();
    }
}

#define MFMA16(a, b, c) __builtin_amdgcn_mfma_f32_16x16x32_bf16((a), (b), (c), 0, 0, 0)
#define MLA_ROW 592
#define MLA_TR8(R, BASE, OFF) asm volatile( \
    "ds_read_b64_tr_b16 %0, %8 offset:%9\n\tds_read_b64_tr_b16 %1, %8 offset:%10\n\tds_read_b64_tr_b16 %2, %8 offset:%11\n\tds_read_b64_tr_b16 %3, %8 offset:%12\n\t" \
    "ds_read_b64_tr_b16 %4, %8 offset:%13\n\tds_read_b64_tr_b16 %5, %8 offset:%14\n\tds_read_b64_tr_b16 %6, %8 offset:%15\n\tds_read_b64_tr_b16 %7, %8 offset:%16\n\ts_waitcnt lgkmcnt(0)" \
    : "=&v"(R[0]), "=&v"(R[1]), "=&v"(R[2]), "=&v"(R[3]), "=&v"(R[4]), "=&v"(R[5]), "=&v"(R[6]), "=&v"(R[7]) \
    : "v"(BASE), "i"(OFF), "i"((OFF) + 16 * MLA_ROW), "i"((OFF) + 32), "i"((OFF) + 32 + 16 * MLA_ROW), "i"((OFF) + 64), "i"((OFF) + 64 + 16 * MLA_ROW), "i"((OFF) + 96), "i"((OFF) + 96 + 16 * MLA_ROW) : "memory")
DI void phase_mla_mfma(const Params& p, char* smem) {
    const int tid = tid_fresh(), lane = tid & 63, w = __builtin_amdgcn_readfirstlane(tid >> 6), fr = lane & 15, g = lane >> 4;
    LAS char* buf = (LAS char*)smem + w * (32 * MLA_ROW);
    const unsigned lbase = (unsigned)(size_t)buf;
    const bf16_t* Q = (const bf16_t*)(p.ws + O_QALL); const bf16_t* KV = (const bf16_t*)(p.ws + O_KVT);
    const unsigned short* SEL = (const unsigned short*)(p.ws + O_SEL); const int* NSEL = (const int*)(p.ws + O_NSEL); bf16_t* OL = (bf16_t*)(p.ws + O_OLAT);
    constexpr float C2 = ATT_SCALE * 1.4426950408889634f;
    int pf_cnt = 0, pf_s0 = 0, pf_s1 = 0;
    { const int tok = blockIdx.x * 8 + w; if (tok < NT) { pf_cnt = NSEL[tok]; if (lane < 32) { pf_s0 = SEL[(size_t)tok * 256 + lane]; pf_s1 = SEL[(size_t)tok * 256 + 32 + lane]; } } }
#pragma unroll 1
    for (int tok = blockIdx.x * 8 + w; tok < NT; tok += gridDim.x * 8) {
        const int b = tok >> 13; const int cnt = pf_cnt; const int cur_s0 = pf_s0, cur_s1 = pf_s1;
        { const int tn = tok + gridDim.x * 8; if (tn < NT) { pf_cnt = NSEL[tn]; if (lane < 32) { pf_s0 = SEL[(size_t)tn * 256 + lane]; pf_s1 = SEL[(size_t)tn * 256 + 32 + lane]; } } }
        bf16x8 qf[9];
        { const bf16_t* qr = Q + (size_t)tok * QC; const bf16x8 z8 = {0, 0, 0, 0, 0, 0, 0, 0};
#pragma unroll
          for (int s = 0; s < 8; ++s) qf[s] = fr < 8 ? *(const bf16x8*)(qr + fr * 256 + 32 * s + 8 * g) : z8;
          qf[8] = fr < 8 ? *(const bf16x8*)(qr + 2048 + fr * 32 + 8 * g) : z8;
          {
              const float* rt = (const float*)(p.ws + O_ROPE) + (size_t)tok * 48;
              const u32x4 own = __builtin_bit_cast(u32x4, qf[8]); u32x4 oth;
#pragma unroll
              for (int k = 0; k < 4; ++k) oth[k] = (unsigned)__shfl_xor((int)own[k], 32);
              float xa[8], xb[8], xr[8]; unpack8(own, xa); unpack8(oth, xb);
#pragma unroll
              for (int j = 0; j < 8; ++j) { const int fi = 8 * (g & 1) + j; const float cs = rt[2 * fi], sn = rt[2 * fi + 1]; xr[j] = g < 2 ? xa[j] * cs - xb[j] * sn : xa[j] * cs + xb[j] * sn; }
              const u32x4 pk = {pk2(xr[0], xr[1]), pk2(xr[2], xr[3]), pk2(xr[4], xr[5]), pk2(xr[6], xr[7])};
              qf[8] = __builtin_bit_cast(bf16x8, pk); } }
        f32x4 O[16];
#pragma unroll
        for (int d = 0; d < 16; ++d) O[d] = (f32x4){0.f, 0.f, 0.f, 0.f};
        float m = -INFINITY, l = 0.f;
        const int nchunk = (cnt + 31) >> 5;
        u32x4 st[18]; int selv_n = 0;
        const bf16_t* kvb = KV + (size_t)b * T * KVW;
        auto issue = [&](int selv, int lz) {
#pragma unroll
            for (int i = 0; i < 16; ++i) { const int r0 = __builtin_amdgcn_readlane(selv, 2 * i), r1 = __builtin_amdgcn_readlane(selv, 2 * i + 1); const int row = lz < 32 ? r0 : r1;
                st[i] = *(const u32x4*)(kvb + (size_t)row * KVW + (lz & 31) * 8); }
#pragma unroll
            for (int i = 0; i < 2; ++i) { const int row = __shfl(selv, 16 * i + (lz >> 2)); st[16 + i] = *(const u32x4*)(kvb + (size_t)row * KVW + 256 + (lz & 3) * 8); } };
        { int lz = lane; asm volatile("" : "+v"(lz));
          int selv = 0; if (lz < 32 && lz < cnt) selv = cur_s0;
          if (lz < 32 && 32 + lz < cnt) selv_n = cur_s1;
          issue(selv, lz); }
#pragma unroll 1
        for (int ch = 0; ch < nchunk; ++ch) {
            int lz = lane; asm volatile("" : "+v"(lz));
#pragma unroll
            for (int i = 0; i < 16; ++i) *(LAS u32x4*)(buf + (2 * i + (lz >> 5)) * MLA_ROW + (lz & 31) * 16) = st[i];
#pragma unroll
            for (int i = 0; i < 2; ++i) *(LAS u32x4*)(buf + (16 * i + (lz >> 2)) * MLA_ROW + 512 + (lz & 3) * 16) = st[16 + i];
            if (ch + 1 < nchunk) {
                const int selv = selv_n; selv_n = 0;
                { const int k = (ch + 2) * 32 + lz; if (lz < 32 && k < cnt) selv_n = SEL[(size_t)tok * 256 + k]; }
                issue(selv, lz); }
            asm volatile("s_waitcnt lgkmcnt(0)" ::: "memory");
            const int frz = lz & 15, gz = lz >> 4;
            f32x4 s0, s1; const f32x4 z4 = {0.f, 0.f, 0.f, 0.f};
#pragma unroll
            for (int s = 0; s < 9; ++s) { const bf16x8 a0 = *(const LAS bf16x8*)(buf + frz * MLA_ROW + (32 * s + 8 * gz) * 2), a1 = *(const LAS bf16x8*)(buf + (frz + 16) * MLA_ROW + (32 * s + 8 * gz) * 2);
                s0 = MFMA16(a0, qf[s], s == 0 ? z4 : s0); s1 = MFMA16(a1, qf[s], s == 0 ? z4 : s1); }
            float mx = -INFINITY;
#pragma unroll
            for (int j = 0; j < 4; ++j) { if (ch * 32 + 4 * gz + j >= cnt) s0[j] = -INFINITY; if (ch * 32 + 16 + 4 * gz + j >= cnt) s1[j] = -INFINITY; mx = fmaxf(mx, fmaxf(s0[j], s1[j])); }
            mx = fmaxf(mx, __shfl_xor(mx, 16)); mx = fmaxf(mx, __shfl_xor(mx, 32));
            const float mn = fmaxf(m, mx), mu = (mn == -INFINITY) ? 0.f : mn;
            const float alpha = __builtin_amdgcn_exp2f((m - mu) * C2);
            float rs = 0.f;
#pragma unroll
            for (int j = 0; j < 4; ++j) { s0[j] = __builtin_amdgcn_exp2f((s0[j] - mu) * C2); s1[j] = __builtin_amdgcn_exp2f((s1[j] - mu) * C2); rs += s0[j] + s1[j]; }
            rs += __shfl_xor(rs, 16); rs += __shfl_xor(rs, 32);
            l = l * alpha + rs; m = mn;
            if (!__all(alpha == 1.f)) {
#pragma unroll
                for (int d = 0; d < 16; ++d) O[d] *= alpha; }
            const u32x4 pw = {cvt2(s0[0], s0[1]), cvt2(s0[2], s0[3]), cvt2(s1[0], s1[1]), cvt2(s1[2], s1[3])};
            const bf16x8 pf = __builtin_bit_cast(bf16x8, pw);
            const unsigned tb = lbase + (unsigned)(4 * gz + (frz >> 2)) * MLA_ROW + 8u * (frz & 3);
#pragma unroll
            for (int dq = 0; dq < 4; ++dq) { s16x4 R[8];
                if (dq == 0) MLA_TR8(R, tb, 0); else if (dq == 1) MLA_TR8(R, tb, 128); else if (dq == 2) MLA_TR8(R, tb, 256); else MLA_TR8(R, tb, 384);
#pragma unroll
                for (int d = 0; d < 4; ++d) { const bf16x8 vf = __builtin_shufflevector(R[2 * d], R[2 * d + 1], 0, 1, 2, 3, 4, 5, 6, 7); O[4 * dq + d] = MFMA16(vf, pf, O[4 * dq + d]); } }
            asm volatile("s_waitcnt lgkmcnt(0)" ::: "memory");
        }
        const float il16 = pg8::A8_SCALE / fmaxf(l, 1e-30f);
        if (fr < 8) {
#pragma unroll
            for (int d = 0; d < 16; ++d) *(unsigned*)((unsigned char*)OL + (size_t)tok * D + fr * 256 + 16 * d + 4 * g) = pg8::fp8x4(O[d][0] * il16, O[d][1] * il16, O[d][2] * il16, O[d][3] * il16); }
    }
}

DI void phase_post_mix(const Params& p, char* smem, bool count) {
    const int tz_ = tid_fresh(); const int lane = tz_ & 63, wid = __builtin_amdgcn_readfirstlane(tz_ >> 6);
    float* part = (float*)smem;
    int* lcnt = (int*)(smem + 8 * 32 * 33 * 4);
    const bf16_t* MO = (const bf16_t*)(p.ws + O_MO); float* X1 = (float*)(p.ws + O_X1); bf16_t* H = (bf16_t*)(p.ws + O_H); const bf16_t* WR = (const bf16_t*)(p.ws + O_WRT);
    int* TOPI = (int*)(p.ws + O_TOPI); float* TOPW = (float*)(p.ws + O_TOPW); int* cnts = (int*)(p.ws + O_CNT);
    float* cvec = (float*)(smem + 36864);
#pragma unroll 1
    for (int ck = blockIdx.x; ck < NT / 64; ck += gridDim.x) {
        {   const int b = (ck * 64) >> 13;
            __syncthreads();
            *(f32x4*)(cvec + 4 * tz_) = *(const f32x4*)((const float*)(p.ws + O_MODACC) + b * 12288 + 4096 + 4 * tz_);
            *(f32x4*)(cvec + 2048 + 4 * tz_) = *(const f32x4*)(p.g_post_mix + 4 * tz_);
            *(f32x4*)(cvec + 4096 + 4 * tz_) = *(const f32x4*)(p.g_pre_ffn + 4 * tz_);
            *(f32x4*)(cvec + 6144 + 4 * tz_) = *(const f32x4*)((const float*)(p.ws + O_MODACC) + b * 12288 + 4 * 2048 + 4 * tz_);
            *(f32x4*)(cvec + 8192 + 4 * tz_) = *(const f32x4*)((const float*)(p.ws + O_MODACC) + b * 12288 + 3 * 2048 + 4 * tz_);
            __syncthreads(); }
#pragma unroll 1
        for (int j = 0; j < 8; ++j) {
            const int tok = ck * 64 + wid * 8 + j;
            u32x2 mo[8]; f32x4 xr[8];
#pragma unroll
            for (int i = 0; i < 8; ++i) { mo[i] = *(const u32x2*)(MO + (size_t)tok * D + 4 * (lane + 64 * i)); xr[i] = *(const f32x4*)(p.x + (size_t)tok * D + 4 * (lane + 64 * i)); }
            float v[32]; float ss = 0.f;
#pragma unroll
            for (int i = 0; i < 8; ++i) { const u32x2 w = mo[i];
                v[4 * i] = bflo(w[0]); v[4 * i + 1] = bfhi(w[0]); v[4 * i + 2] = bflo(w[1]); v[4 * i + 3] = bfhi(w[1]); }
#pragma unroll
            for (int i = 0; i < 32; ++i) ss += v[i] * v[i];
            const float rs = rsqrtf(wave_sum(ss) * (1.f / D) + NORM_EPS);
            float ss2 = 0.f;
#pragma unroll
            for (int i = 0; i < 8; ++i) { const int col = 4 * (lane + 64 * i); const f32x4 xv = xr[i], mg = *(const f32x4*)(cvec + col), gp = *(const f32x4*)(cvec + 2048 + col); f32x4 o;
#pragma unroll
                for (int q = 0; q < 4; ++q) { o[q] = xv[q] + mg[q] * (v[4 * i + q] * rs * gp[q]); v[4 * i + q] = o[q]; ss2 += o[q] * o[q]; }
                *(f32x4*)(X1 + (size_t)tok * D + col) = o; }
            const float rs2 = rsqrtf(wave_sum(ss2) * (1.f / D) + NORM_EPS);
#pragma unroll
            for (int i = 0; i < 8; ++i) { const int col = 4 * (lane + 64 * i); const f32x4 gf = *(const f32x4*)(cvec + 4096 + col), ms = *(const f32x4*)(cvec + 6144 + col), mh = *(const f32x4*)(cvec + 8192 + col); f32x4 hv;
#pragma unroll
                for (int q = 0; q < 4; ++q) hv[q] = v[4 * i + q] * rs2 * gf[q] * (1.f + ms[q]) + mh[q];
                *(u32x2*)(H + (size_t)tok * D + col) = (u32x2){pk2(hv[0], hv[1]), pk2(hv[2], hv[3])}; }
        }
        asm volatile("s_waitcnt vmcnt(0)" ::: "memory");
        __syncthreads();
        if (tz_ < 32) lcnt[tz_] = 0;
        {
            const int c = lane & 31, hh = lane >> 5, rb = wid & 1, ks = wid >> 1;
            const bf16_t* ap = H + (size_t)(ck * 64 + 32 * rb + c) * D + 512 * ks + 8 * hh; const bf16_t* bp = WR + (size_t)c * D + 512 * ks + 8 * hh;
            f32x16 acc;
#pragma unroll
            for (int i = 0; i < 16; ++i) acc[i] = 0.f;
#pragma unroll 8
            for (int sx = 0; sx < 32; ++sx) { const bf16x8 a = *(const bf16x8*)(ap + 16 * sx), bb = *(const bf16x8*)(bp + 16 * sx); acc = MFMA32(a, bb, acc); }
#pragma unroll
            for (int r = 0; r < 16; ++r) part[(wid * 32 + (r & 3) + 8 * (r >> 2) + 4 * hh) * 33 + c] = acc[r];
        }
        __syncthreads();
        if (tz_ < 64) {
            const int rbt = tz_ >> 5, row = tz_ & 31, tok = ck * 64 + tz_;
            float lg[32];
#pragma unroll
            for (int e = 0; e < 32; ++e) lg[e] = p.b_router[e] + part[((0 * 2 + rbt) * 32 + row) * 33 + e] + part[((1 * 2 + rbt) * 32 + row) * 33 + e] + part[((2 * 2 + rbt) * 32 + row) * 33 + e] + part[((3 * 2 + rbt) * 32 + row) * 33 + e];
            int te[4]; float tv[4];
#pragma unroll
            for (int k = 0; k < 4; ++k) { float mx = lg[0]; int bi = 0;
#pragma unroll
                for (int e = 1; e < 32; ++e) if (lg[e] > mx) { mx = lg[e]; bi = e; }
                te[k] = bi; tv[k] = mx;
#pragma unroll
                for (int e = 0; e < 32; ++e) if (e == bi) lg[e] = -INFINITY; }
            const float e1 = __expf(tv[1] - tv[0]), e2 = __expf(tv[2] - tv[0]), e3 = __expf(tv[3] - tv[0]); const float inv = 1.f / (1.f + e1 + e2 + e3);
            *(int4*)(TOPI + tok * 4) = make_int4(te[0], te[1], te[2], te[3]);
            *(f32x4*)(TOPW + tok * 4) = (f32x4){inv, e1 * inv, e2 * inv, e3 * inv};
            atomicAdd(lcnt + te[0], 1); atomicAdd(lcnt + te[1], 1); atomicAdd(lcnt + te[2], 1); atomicAdd(lcnt + te[3], 1);
        }
        __syncthreads();
        if (count && tz_ < 32) atomicAdd(cnts + tz_, lcnt[tz_]);
    }
}

DI int moe_tables(const Params& p, LAS int* tile_e, LAS int* pstart) {
    int* cnts = (int*)(p.ws + O_CNT);
    if (threadIdx.x < 64) {
        const int e = threadIdx.x & 31;
        const int c = __hip_atomic_load(cnts + e, __ATOMIC_RELAXED, __HIP_MEMORY_SCOPE_AGENT);
        const int nt = (c + 255) >> 8; int inc = nt;
#pragma unroll
        for (int o = 1; o < 32; o <<= 1) { const int v = __shfl_up(inc, o, 32); if (e >= o) inc += v; }
        const int start = inc - nt;
        if (threadIdx.x < 32) { pstart[e] = start * 256; for (int i = 0; i < nt; ++i) tile_e[start + i] = e; if (e == 31) pstart[NEXP] = inc; } }
    __syncthreads();
    return pstart[NEXP];
}
DI void phase_moe_gather(const Params& p, char* smem) {
    const int tz_ = tid_fresh(); const int lane = tz_ & 63, wid = __builtin_amdgcn_readfirstlane(tz_ >> 6);
    LAS int* tile_e = (LAS int*)(LAS char*)smem; LAS int* pstart = tile_e + 320; LAS int* lcnt = pstart + 40; LAS int* lbase = lcnt + 32;
    (void)moe_tables(p, tile_e, pstart);
    const bf16_t* H = (const bf16_t*)(p.ws + O_H); unsigned char* HS = (unsigned char*)(p.ws + O_HS);
    const int* TOPI = (const int*)(p.ws + O_TOPI); const float* TOPW = (const float*)(p.ws + O_TOPW); int* TSLOT = (int*)(p.ws + O_TSLOT); float* SLOTW = (float*)(p.ws + O_SLOTW);
    int* fill = (int*)(p.ws + O_CNT) + 32;
#pragma unroll 1
    for (int ck = blockIdx.x; ck < NT / 64; ck += gridDim.x) {
        const int tok0 = ck * 64 + wid * 8;
        __syncthreads();
        if (tz_ < 32) lcnt[tz_] = 0;
        __syncthreads();
        int e = 0, rank = 0;
        if (lane < 32) { e = TOPI[tok0 * 4 + lane]; rank = atomicAdd((int*)(lcnt + e), 1); }
        __syncthreads();
        if (tz_ < 32) lbase[tz_] = atomicAdd(fill + tz_, lcnt[tz_]);
        __syncthreads();
        int slot = 0;
        if (lane < 32) { slot = pstart[e] + lbase[e] + rank; TSLOT[tok0 * 4 + lane] = slot; SLOTW[slot] = TOPW[tok0 * 4 + lane]; }
#pragma unroll 2
        for (int j = 0; j < 8; ++j) { u32x2 hv[4];
#pragma unroll
            for (int i = 0; i < 4; ++i) { float f[8]; unpack8(*(const u32x4*)(H + (size_t)(tok0 + j) * D + 8 * (lane + 64 * i)), f);
                hv[i] = (u32x2){pg8::fp8x4(f[0], f[1], f[2], f[3]), pg8::fp8x4(f[4], f[5], f[6], f[7])}; }
#pragma unroll
            for (int k = 0; k < 4; ++k) { const int sl = __shfl(slot, j * 4 + k);
#pragma unroll
                for (int i = 0; i < 4; ++i) *(u32x2*)(HS + (size_t)sl * D + 8 * (lane + 64 * i)) = hv[i]; } }
    }
}
DI void phase_final(const Params& p) {
    const int tz_ = tid_fresh(); const int lane = tz_ & 63, wid = __builtin_amdgcn_readfirstlane(tz_ >> 6);
    const unsigned char* YS = (const unsigned char*)(p.ws + O_YS); const float* X1 = (const float*)(p.ws + O_X1); const int* TSLOT = (const int*)(p.ws + O_TSLOT);
    for (int tok = blockIdx.x * 8 + wid; tok < NT; tok += gridDim.x * 8) {
        const int b = tok >> 13; float v[32];
#pragma unroll
        for (int i = 0; i < 32; ++i) v[i] = 0.f;
#pragma unroll
        for (int k = 0; k < 4; ++k) { const int slot = TSLOT[tok * 4 + k];
#pragma unroll
            for (int i = 0; i < 8; ++i) { const unsigned w = *(const unsigned*)(YS + (size_t)slot * D + 4 * (lane + 64 * i));
                const auto lo = __builtin_amdgcn_cvt_pk_f32_fp8((int)w, false), hi = __builtin_amdgcn_cvt_pk_f32_fp8((int)w, true);
                v[4 * i] += lo[0]; v[4 * i + 1] += lo[1]; v[4 * i + 2] += hi[0]; v[4 * i + 3] += hi[1]; } }
#pragma unroll
        for (int i = 0; i < 32; ++i) v[i] *= pg8::Y8_INV;
        float ss = 0.f;
#pragma unroll
        for (int i = 0; i < 32; ++i) ss += v[i] * v[i];
        const float rs = rsqrtf(wave_sum(ss) * (1.f / D) + NORM_EPS);
#pragma unroll
        for (int i = 0; i < 8; ++i) { const int col = 4 * (lane + 64 * i); const f32x4 xv = *(const f32x4*)(X1 + (size_t)tok * D + col); f32x4 o;
#pragma unroll
            for (int j = 0; j < 4; ++j) o[j] = xv[j] + mod_at(p, b, 5 * 2048 + col + j) * (v[4 * i + j] * rs * p.g_post_ffn[col + j]);
            *(f32x4*)(p.out + (size_t)tok * D + col) = o; }
    }
}

#ifndef PHMASK
#define PHMASK 0xFFFFFFFFu
#endif
#define PHON(ph) (((PHMASK) >> (ph)) & 1u)
#ifndef REPMASK
#define REPMASK 0u
#endif
#define REP(ph) _Pragma("unroll 1") for (int rep_ = 0; rep_ <= (int)(((REPMASK) >> (ph)) & 1u); ++rep_)
enum { PH_PREP = 0, PH_H1, PH_GIN, PH_ZPOST, PH_GQ, PH_QROPE, PH_IDX, PH_MLA, PH_NSA, PH_MERGE, PH_GOUT, PH_POSTMIX, PH_GATHER, PH_GU, PH_DN, PH_FINAL, PH_END };

__global__ void __launch_bounds__(512, 2) mega(Params p, int lo, int hi) {
    extern __shared__ __attribute__((aligned(16))) char smem[];
    LAS unsigned char* lds = (LAS unsigned char*)(LAS char*)smem;
    volatile LAS unsigned* xbw = (volatile LAS unsigned*)(LAS char*)(smem + LDS_BYTES - 16);
    XcdBarrier bar; bar.bar = (unsigned*)p.ws; bar.x = 0; bar.st = xbw;
    if (hi - lo > 1) { if (threadIdx.x == 0) { xbw[0] = 0u; xbw[1] = 0u; } __syncthreads(); bar = xcd_barrier_post((unsigned*)p.ws, xbw); }
    const int G = gridDim.x, c = blockIdx.x;
#define SEAM(ph) if ((ph) + 1 < hi) xcd_barrier(bar);
    if (PHON(PH_PREP) && lo <= PH_PREP && PH_PREP < hi) { REP(PH_PREP) { phase_prep(p, smem); } SEAM(PH_PREP) }
    if (PHON(PH_H1) && lo <= PH_H1 && PH_H1 < hi) { REP(PH_H1) { phase_h1(p); } SEAM(PH_H1) }
    if (PHON(PH_GIN) && lo <= PH_GIN && PH_GIN < hi) { REP(PH_GIN) {
        { pg8::PlainSched S; S.init(NT, 2048, G, c, p.ws + O_H, D, p.ws + O_WIN, D);
          pg8::EpiBf16 E; E.O = (bf16_t*)(p.ws + O_Z); E.ldc = ZC; E.scale = 1.f;
          pg8::gemm_phase(lds, pg8::Gemm{D, D, D}, S, E); }
        { pg8::PlainSched S; S.init(NT, ZC - 2048, G, c, p.ws + O_H8, D / 2, p.ws + O_WIN8 + (size_t)2048 * D, D / 2);
          pg8::EpiBf16 E; E.O = (bf16_t*)(p.ws + O_Z) + 2048; E.ldc = ZC; E.scale = pg8::W8_INV;
          pg8::gemm_phase_fp8(lds, pg8::Gemm{D / 2, D / 2, D / 2}, S, E); }
        } SEAM(PH_GIN) }
    if (PHON(PH_ZPOST) && lo <= PH_ZPOST && PH_ZPOST < hi) { REP(PH_ZPOST) { phase_zpost(p); } SEAM(PH_ZPOST) }
    if (PHON(PH_GQ) && lo <= PH_GQ && PH_GQ < hi) { REP(PH_GQ) {
        { pg8::PlainSched S; S.init(NT, QC, G, c, p.ws + O_CQN, 512, p.ws + O_WQ, 512);
          pg8::EpiBf16 E; E.O = (bf16_t*)(p.ws + O_QALL); E.ldc = QC; E.scale = 1.f;
          pg8::gemm_phase(lds, pg8::Gemm{512, 512, 512}, S, E); }
        { pg8::C1Sched S; S.G = G; S.c = c; S.kvs = p.ws + O_KVS; S.w = p.ws + O_WC1;
          pg8::EpiC1 E; E.C = (float*)(p.ws + O_C1P);
          pg8::gemm_phase(lds, pg8::Gemm{2048, 4096, 256}, S, E); }
        } SEAM(PH_GQ) }
    if (PHON(PH_IDX) && lo <= PH_IDX && PH_IDX < hi) { REP(PH_IDX) {
#ifdef IDX_NAIVE
        phase_indexer(p, smem);
#else
        phase_indexer_mfma(p, smem);
#endif
        } SEAM(PH_IDX) }
    if (PHON(PH_MLA) && lo <= PH_MLA && PH_MLA < hi) { REP(PH_MLA) {
#ifdef MLA_NAIVE
        phase_mla(p, smem);
#else
        phase_mla_mfma(p, smem);
#endif
        } SEAM(PH_MLA) }
    if (PHON(PH_NSA) && lo <= PH_NSA && PH_NSA < hi) { REP(PH_NSA) {
#ifdef NSA_NAIVE
        phase_nsa(p, smem);
#else
        phase_nsa_mfma(p, smem);
#endif
        } SEAM(PH_NSA) }
    if (PHON(PH_MERGE) && lo <= PH_MERGE && PH_MERGE < hi) { REP(PH_MERGE) {
        { pg8::PlainSched S; S.init(NT, D, G, c, p.ws + O_OLAT, D / 2, p.ws + O_WO, D / 2);
          pg8::EpiMerge<false> E; E.P = (bf16_t*)(p.ws + O_MERGED); E.O8 = nullptr; E.Z = (const bf16_t*)(p.ws + O_Z); E.gcol0 = ZC_MG; E.scale = pg8::A8W8_INV;
          pg8::gemm_phase_fp8(lds, pg8::Gemm{D / 2, D / 2, D / 2}, S, E); }
        { pg8::PlainSched S; S.init(NT, D, G, c, p.ws + O_OB8, 512, p.ws + O_WBRB, 512);
          pg8::EpiMerge<true> E; E.P = (bf16_t*)(p.ws + O_MERGED); E.O8 = (unsigned char*)(p.ws + O_MG8); E.Z = (const bf16_t*)(p.ws + O_Z); E.gcol0 = ZC_MG + 2048; E.scale = pg8::A8W8_INV;
          pg8::gemm_phase_fp8(lds, pg8::Gemm{512, 512, 512}, S, E); }
        } SEAM(PH_MERGE) }
    if (PHON(PH_GOUT) && lo <= PH_GOUT && PH_GOUT < hi) { REP(PH_GOUT) {
        pg8::PlainSched S; S.init(NT, D, G, c, p.ws + O_MG8, D / 2, p.ws + O_WOUT, D / 2);
        pg8::EpiBf16 E; E.O = (bf16_t*)(p.ws + O_MO); E.ldc = D; E.scale = pg8::A8W8_INV;
        pg8::gemm_phase_fp8(lds, pg8::Gemm{D / 2, D / 2, D / 2}, S, E); } SEAM(PH_GOUT) }
    if (PHON(PH_POSTMIX) && lo <= PH_POSTMIX && PH_POSTMIX < hi) { REP(PH_POSTMIX) { phase_post_mix(p, smem, rep_ == 0); } SEAM(PH_POSTMIX) }
    if (PHON(PH_GATHER) && lo <= PH_GATHER && PH_GATHER < hi) { REP(PH_GATHER) { phase_moe_gather(p, smem); } SEAM(PH_GATHER) }
    if (PHON(PH_GU) && lo <= PH_GU && PH_GU < hi) { REP(PH_GU) {
        LAS int* tile_e = (LAS int*)(LAS char*)(smem + 131072); LAS int* pstart = tile_e + 320;
        const int mt = moe_tables(p, tile_e, pstart);
        pg8::MoeSched S; S.G = G; S.c = c; S.nN = 16; S.total = mt * 16; S.tile_e = tile_e; S.A = p.ws + O_HS; S.W = p.ws + O_WGU; S.w_exp = (size_t)4096 * D;
        pg8::EpiGU E; E.O = (unsigned char*)(p.ws + O_ACT); E.bias = p.b_gate_up;
        pg8::gemm_phase_fp8(lds, pg8::Gemm{D / 2, D / 2, D / 2, 64, 16384}, S, E); } SEAM(PH_GU) }
    if (PHON(PH_DN) && lo <= PH_DN && PH_DN < hi) { REP(PH_DN) {
        LAS int* tile_e = (LAS int*)(LAS char*)(smem + 131072); LAS int* pstart = tile_e + 320;
        const int mt = moe_tables(p, tile_e, pstart);
        pg8::MoeSched S; S.G = G; S.c = c; S.nN = 8; S.total = mt * 8; S.tile_e = tile_e; S.A = p.ws + O_ACT; S.W = p.ws + O_WDN; S.w_exp = (size_t)D * D;
        pg8::EpiDN E; E.O = (unsigned char*)(p.ws + O_YS); E.bias = p.b_down; E.slotw = (const float*)(p.ws + O_SLOTW);
        pg8::gemm_phase_fp8(lds, pg8::Gemm{D / 2, D / 2, D / 2, 64, 16384}, S, E); } SEAM(PH_DN) }
    if (PHON(PH_FINAL) && lo <= PH_FINAL && PH_FINAL < hi) { REP(PH_FINAL) { phase_final(p); } }
#undef SEAM
}

extern "C" void kernel_launch(void* const* d_in, const int* in_sizes, int n_in, void* d_out, int out_size, void* d_ws, size_t ws_size, hipStream_t stream) {
    static int grid = 0;
    if (grid == 0) {
        if (n_in != 33 || out_size != NT * D || ws_size < WS_END) { fprintf(stderr, "kernel_launch: unexpected shapes (n_in %d out %d ws %zu need %zu)\n", n_in, out_size, ws_size, (size_t)WS_END); grid = -1; return; }
        int dev = 0, cus = 0;
        if (hipGetDevice(&dev) != hipSuccess || hipDeviceGetAttribute(&cus, hipDeviceAttributeMultiprocessorCount, dev) != hipSuccess) { grid = -1; return; }
        if (hipFuncSetAttribute((const void*)mega, hipFuncAttributeMaxDynamicSharedMemorySize, LDS_BYTES) != hipSuccess) { fprintf(stderr, "kernel_launch: hipFuncSetAttribute failed\n"); grid = -1; return; }
        int per_cu = 0; (void)hipOccupancyMaxActiveBlocksPerMultiprocessor(&per_cu, (const void*)mega, 512, LDS_BYTES); (void)hipGetLastError();
        grid = cus;
    }
    if (grid < 0) return;
    Params p{};
    const float** pf = (const float**)&p;
    for (int i = 0; i < 33; ++i) pf[i] = (const float*)d_in[i];
    p.pos = (const int*)d_in[2];
    p.out = (float*)d_out; p.ws = (char*)d_ws;
    hipMemsetAsync(d_ws, 0, ZERO_BYTES, stream);
#ifdef MK_UNFUSED
    for (int ph = 0; ph < PH_END; ++ph) hipLaunchKernelGGL(mega, dim3(grid), dim3(512), LDS_BYTES, stream, p, ph, ph + 1);
#else
    hipLaunchKernelGGL(mega, dim3(grid), dim3(512), LDS_BYTES, stream, p, 0, (int)PH_END);
#endif
}
```

```cpp
#include <hip/hip_runtime.h>
#include <stdint.h>
#include <stdio.h>

#define LAS __attribute__((address_space(3)))
#define DI __device__ __forceinline__
typedef unsigned short bf16_t;
typedef short bf16x8 __attribute__((ext_vector_type(8)));
typedef float f32x4 __attribute__((ext_vector_type(4)));
typedef unsigned u32x4 __attribute__((ext_vector_type(4)));
typedef unsigned u32x2 __attribute__((ext_vector_type(2)));

#define PREP_PROBE_WC 0
#define PREP_PROBE_MODE 0
#define PREP_REP 0
#define SEL_REP 0
#define PREP_REP_LO 0
#define PREP_REP_HI 100000
#define PREP_PROBE_NFAST 0
constexpr int NB = 2, T = 8192, NT = NB * T, D = 2048;
constexpr int ZC = 7680;
constexpr int ZC_CKV = 512, ZC_KROPE = 768, ZC_KIDX = 800, ZC_WIDX = 864, ZC_BGATE = 872, ZC_BQ = 1024, ZC_MG = 3584;
constexpr int QC = 2816;
constexpr int KVW = 288;
constexpr int NEXP = 32, SLOTS = 73728, MAXMT = SLOTS / 256;
constexpr float NORM_EPS = 1e-6f;
constexpr float ATT_SCALE = 0.08838834764831845f;
constexpr int LDS_BYTES = 152 * 1024;

constexpr size_t al256(size_t x) { return (x + 255) & ~(size_t)255; }
constexpr size_t ZERO_BYTES = 131072;
constexpr size_t O_MODACC = 16384, O_CNT = 114688;
constexpr size_t O_ROPE = ZERO_BYTES;
constexpr size_t O_WIN = O_ROPE + al256((size_t)NT * 48 * 4);
constexpr size_t O_WQ = O_WIN + al256((size_t)ZC * D * 2);
constexpr size_t O_WO = O_WQ + al256((size_t)QC * 512 * 2);
constexpr size_t O_WBRB = O_WO + al256((size_t)D * D * 2);
constexpr size_t O_WOUT = O_WBRB + al256((size_t)D * 1024 * 2);
constexpr size_t O_WC1 = O_WOUT + al256((size_t)D * D * 2);
constexpr size_t O_CBIAS = O_WC1 + al256((size_t)2 * 256 * 4096 * 2);
constexpr size_t O_CBP = O_CBIAS + al256(2 * 256 * 4);
constexpr size_t O_WRT = O_CBP + al256(64 * 2 * 256 * 4);
constexpr size_t O_WGU = O_WRT + al256((size_t)256 * D * 2);
constexpr size_t O_WDN = O_WGU + al256((size_t)NEXP * 4096 * D * 2);
constexpr size_t O_H = O_WDN + al256((size_t)NEXP * D * D * 2);
constexpr size_t O_Z = O_H + al256((size_t)NT * D * 2);
constexpr size_t O_CQN = O_Z + al256((size_t)NT * ZC * 2);
constexpr size_t O_KVT = O_CQN + al256((size_t)NT * 512 * 2);
constexpr size_t O_KIDX = O_KVT + al256((size_t)NT * KVW * 2);
constexpr size_t O_WIDX = O_KIDX + al256((size_t)NT * 64 * 2);
constexpr size_t O_GATES = O_WIDX + al256((size_t)NT * 8 * 4);
constexpr size_t O_BQ = O_GATES + al256((size_t)NT * 24 * 4);
constexpr size_t KVS_ONE = (size_t)NB * 2 * T * 128;
constexpr size_t O_KVS = O_BQ + al256((size_t)NT * 1024 * 2);
constexpr size_t O_QALL = O_KVS + al256(6 * KVS_ONE * 2 + 65536);
constexpr size_t O_C1P = O_QALL + al256((size_t)NT * QC * 2);
constexpr size_t O_KCVC = O_C1P + al256((size_t)16 * 2 * 2048 * 256 * 4);
constexpr size_t O_SEL = O_KCVC + al256((size_t)2 * 2048 * 128 * 2);
constexpr size_t O_NSEL = O_SEL + al256((size_t)NT * 256 * 2);
constexpr size_t O_OLAT = O_NSEL + al256((size_t)NT * 4);
constexpr size_t O_OB = O_OLAT + al256((size_t)NT * D * 2);
constexpr size_t O_MERGED = O_OB + al256((size_t)NT * 1024 * 2);
constexpr size_t O_MO = O_MERGED + al256((size_t)NT * D * 2);
constexpr size_t O_X1 = O_MO + al256((size_t)NT * D * 2);
constexpr size_t O_TOPI = O_X1 + al256((size_t)NT * D * 4);
constexpr size_t O_TOPW = O_TOPI + al256((size_t)NT * 4 * 4);
constexpr size_t O_TSLOT = O_TOPW + al256((size_t)NT * 4 * 4);
constexpr size_t O_SLOTW = O_TSLOT + al256((size_t)NT * 4 * 4);
constexpr size_t O_HS = O_SLOTW + al256((size_t)SLOTS * 4);
constexpr size_t O_ACT = O_HS + al256((size_t)SLOTS * D);
constexpr size_t O_YS = O_ACT + al256((size_t)SLOTS * D);
constexpr size_t O_OB8 = O_YS + al256((size_t)SLOTS * D * 2);
constexpr size_t O_MG8 = O_OB8 + al256((size_t)NT * 1024);
constexpr size_t O_WIN8 = O_MG8 + al256((size_t)NT * D);
constexpr size_t O_H8 = O_WIN8 + al256((size_t)ZC * D);
constexpr size_t WS_END = O_H8 + al256((size_t)NT * D);

struct Params {
    const float* x; const float* c; const int* pos; const float* w_ada; const float* b_ada;
    const float* g_pre_mix; const float* g_post_mix; const float* g_pre_ffn; const float* g_post_ffn;
    const float* w_in; const float* a_cq_norm; const float* a_ckv_norm; const float* a_w_uq; const float* a_w_uk; const float* a_w_uv;
    const float* idx_w_q; const float* idx_g; const float* idx_b;
    const float* cmp_k_pe; const float* cmp_k_w1; const float* cmp_k_w2; const float* cmp_v_pe; const float* cmp_v_w1; const float* cmp_v_w2;
    const float* w_br_a; const float* w_br_b; const float* w_out; const float* w_router; const float* b_router;
    const float* w_gate_up; const float* b_gate_up; const float* w_down; const float* b_down;
    float* out; char* ws;
};

DI int tid_fresh() { int t = threadIdx.x; asm volatile("" : "+v"(t)); return t; }
DI float bf2f(bf16_t v) { return __uint_as_float((unsigned)v << 16); }
DI float bflo(unsigned w) { return __uint_as_float(w << 16); }
DI float bfhi(unsigned w) { return __uint_as_float(w & 0xffff0000u); }
DI bf16_t f2bf(float f) { unsigned u = __float_as_uint(f); u += 0x7FFFu + ((u >> 16) & 1u); return (bf16_t)(u >> 16); }
DI unsigned pk2(float lo, float hi) { unsigned r; asm volatile("v_cvt_pk_bf16_f32 %0, %1, %2" : "=v"(r) : "v"(lo), "v"(hi)); return r; }
DI float wave_sum(float v) {
#pragma unroll
    for (int o = 1; o < 64; o <<= 1) v += __shfl_xor(v, o);
    return v;
}
DI float wave_max(float v) {
#pragma unroll
    for (int o = 1; o < 64; o <<= 1) v = fmaxf(v, __shfl_xor(v, o));
    return v;
}
DI float sigmoidf_(float v) { return __builtin_amdgcn_rcpf(1.f + __expf(-v)); }
DI void unpack8(const u32x4& w, float (&f)[8]) {
    f[0] = bflo(w[0]); f[1] = bfhi(w[0]); f[2] = bflo(w[1]); f[3] = bfhi(w[1]); f[4] = bflo(w[2]); f[5] = bfhi(w[2]); f[6] = bflo(w[3]); f[7] = bfhi(w[3]);
}
DI float mod_at(const Params& p, int b, int j) { return ((const float*)(p.ws + O_MODACC))[b * 12288 + j]; }

#define XB_TMO      128
#define XB_XCNT(j)  (256  + 64 * (j))
#define XB_XSUB(j)  (1280 + 64 * (j))
#define XB_XGEN(j)  (2304 + 64 * (j))
#define XB_TOP      3328
#define XB_TOPGEN   3392
#define XCD_BAR_WORDS 3456
#define XB_SPIN_CAP (1u << 22)
DI unsigned xb_ld(unsigned* p)              { return __hip_atomic_load(p, __ATOMIC_RELAXED, __HIP_MEMORY_SCOPE_AGENT); }
DI unsigned xb_add(unsigned* p, unsigned v) { return __hip_atomic_fetch_add(p, v, __ATOMIC_RELAXED, __HIP_MEMORY_SCOPE_AGENT); }
DI unsigned xb_xcc_id() { return (unsigned)__builtin_amdgcn_s_getreg((3 << 11) | 20) & 0xFu; }
#define XB_SPIN(cond, bar) do { unsigned _sp = 0; while (cond) { __builtin_amdgcn_s_sleep(1); \
    if ((++_sp & 255u) == 0u) { if (xb_ld(&(bar)[XB_TMO])) break; if (_sp > XB_SPIN_CAP) { atomicAdd(&(bar)[XB_TMO], 1u); break; } } } } while (0)
struct XcdBarrier { unsigned* bar; unsigned x; volatile LAS unsigned* st; };
DI XcdBarrier xcd_barrier_post(unsigned* bar, volatile LAS unsigned* st) {
    XcdBarrier b; b.bar = bar; b.x = xb_xcc_id(); b.st = st;
    if (threadIdx.x == 0) (void)xb_add(&bar[XB_XCNT(b.x)], 1u);
    return b;
}
DI void xcd_barrier_complete(unsigned* bar, unsigned x, unsigned& nloc, unsigned& nx) {
    const unsigned G = gridDim.x * gridDim.y * gridDim.z;
    unsigned sum, cnt, mine, sp = 0u;
    for (;;) {
        sum = 0u; cnt = 0u; mine = 0u;
#pragma unroll
        for (unsigned j = 0; j < 16; ++j) { const unsigned c = xb_ld(&bar[XB_XCNT(j)]); sum += c; cnt += (c > 0u) ? 1u : 0u; mine = (j == x) ? c : mine; }
        if (sum == G) break;
        __builtin_amdgcn_s_sleep(1);
        if ((++sp & 255u) == 0u) { if (xb_ld(&bar[XB_TMO])) break; if (sp > XB_SPIN_CAP) { atomicAdd(&bar[XB_TMO], 1u); break; } }
    }
    nloc = mine > 0u ? mine : 1u; nx = cnt > 0u ? cnt : 1u;
}
DI void xcd_barrier(const XcdBarrier& b) {
    asm volatile("s_waitcnt vmcnt(0)" ::: "memory");
    __syncthreads();
    if (threadIdx.x == 0) {
        unsigned* bar = b.bar;
        __builtin_amdgcn_s_waitcnt(0);
        unsigned nloc = b.st[0], nx = b.st[1];
        if (nloc == 0u) { xcd_barrier_complete(bar, b.x, nloc, nx); b.st[0] = nloc; b.st[1] = nx; }
        const unsigned old = xb_add(&bar[XB_XSUB(b.x)], 1u);
        const unsigned gen = old / nloc;
        if (old + 1u == (gen + 1u) * nloc) {
            __builtin_amdgcn_fence(__ATOMIC_RELEASE, "agent");
            asm volatile("s_waitcnt vmcnt(0)" ::: "memory");
            const unsigned og = xb_add(&bar[XB_TOP], 1u);
            const unsigned tg = og / nx;
            if (og + 1u == (tg + 1u) * nx) xb_add(&bar[XB_TOPGEN], 1u);
            else XB_SPIN(xb_ld(&bar[XB_TOPGEN]) == tg, bar);
            __builtin_amdgcn_fence(__ATOMIC_ACQUIRE, "agent");
            xb_add(&bar[XB_XGEN(b.x)], 1u);
            asm volatile("s_waitcnt vmcnt(0)" ::: "memory");
        } else {
            XB_SPIN(xb_ld(&bar[XB_XGEN(b.x)]) == gen, bar);
            __builtin_amdgcn_fence(__ATOMIC_ACQUIRE, "agent");
            asm volatile("s_waitcnt vmcnt(0)" ::: "memory");
        }
    }
    __syncthreads();
}

namespace pg8 {
constexpr int BM = 256, BK = 64, HALF = 128, HTB = HALF * BK * 2, STAGE_BYTES = 8 * HTB, NXCD = 8, WGM = 8;
DI int lds_byte(int r, int c) { const int st = (r >> 4) * 2 + (c >> 5), rr = r & 15, cc = c & 31, ob = rr * 64 + cc * 2; return st * 1024 + (ob ^ (((ob >> 9) & 1) << 5)); }
DI void stage_rc(int b, int& R, int& C) { const int st = b / 1024, sb = b % 1024, swz = sb ^ (((sb >> 9) & 1) << 5); R = (st >> 1) * 16 + swz / 64; C = (st & 1) * 32 + (swz % 64) / 2; }
DI int perm32(int rho) { const int n = rho >> 4, i = rho & 15; return 8 * (i >> 2) + 4 * n + (i & 3); }

struct Unit { int pm, pn, e; const char* a; const char* b; const int* rows; };
struct Gemm { int lda, ldb, K; int brow = ldb; int bk = BK * 2; };

struct PlainSched {
    int nM, nN, nwg, G, c; const char* A; const char* Bt; size_t a_tile, b_tile;
    DI void init(int M, int N, int G_, int c_, const void* A_, int lda, const void* Bt_, int ldb) {
        nM = M / BM; nN = N / BM; nwg = nM * nN; G = G_; c = c_; A = (const char*)A_; Bt = (const char*)Bt_; a_tile = (size_t)BM * lda * 2; b_tile = (size_t)BM * ldb * 2; }
    DI bool next(int i, Unit& u) const {
        const long L = (long)i * G + c; if (L >= nwg) return false;
        int wgid = (int)L; { const int q = nwg / NXCD, r = nwg % NXCD, xcd = wgid % NXCD, off = wgid / NXCD; wgid = (xcd < r ? xcd * (q + 1) : r * (q + 1) + (xcd - r) * q) + off; }
        const int nig = WGM * nN, gid = wgid / nig, fm = gid * WGM, gsz = (nM - fm) < WGM ? (nM - fm) : WGM;
        u.pm = fm + ((wgid % nig) % gsz); u.pn = (wgid % nig) / gsz; u.e = 0;
        u.a = A + (size_t)u.pm * a_tile; u.b = Bt + (size_t)u.pn * b_tile; return true;
    }
};

typedef int v4i_t __attribute__((ext_vector_type(4)));
typedef int v8i_t __attribute__((ext_vector_type(8)));
#ifndef PG8_SP2
#define PG8_SP2 true
#endif
template <class Epi, class Sched, bool SP2 = PG8_SP2>
DI void gemm_phase(LAS unsigned char* lds, const Gemm g, const Sched& S, const Epi& E) {
    const int tid = tid_fresh(), wid = __builtin_amdgcn_readfirstlane(tid >> 6), lane = tid & 63, wr = wid >> 2, wc = wid & 3, fr = lane & 15, fq = lane >> 4;
    const int K = g.K, nt = K / BK;
    unsigned voffA[2], voffB[2];
#pragma unroll
    for (int i = 0; i < 2; ++i) { int R, C; stage_rc(tid * 16 + i * 8192, R, C); const int Rb = Epi::PERM ? ((R & ~31) + perm32(R & 31)) : R;
        voffA[i] = (unsigned)(R * g.lda + C) * 2u; voffB[i] = (unsigned)(Rb * g.ldb + C) * 2u; }
    const size_t kstep = (size_t)(BK * 2);
    const size_t hstepA = (size_t)HALF * g.lda * 2, hstepB = (size_t)HALF * g.ldb * 2;
    const unsigned ldsw = (unsigned)wid * 1024u;
    const int aoff = lds_byte(wr * 64 + fr, fq * 8), boff = lds_byte(wc * 32 + fr, fq * 8);
#define PG8_SA(b, h) (((b) * 2 + (h)) * HTB)
#define PG8_SB(b, h) ((4 + (b) * 2 + (h)) * HTB)
#define PG8_STAGE(bufoff, gbase, voff) do { _Pragma("unroll") for (int _i = 0; _i < 2; ++_i) \
        __builtin_amdgcn_global_load_lds((const unsigned*)((const char*)(gbase) + (voff)[_i]), (LAS unsigned*)(lds + (bufoff) + ldsw + _i * 8192), 16, 0, 0); } while (0)
#define PG8_LDA(dst, b, h) do { _Pragma("unroll") for (int m = 0; m < 4; ++m) _Pragma("unroll") for (int k = 0; k < 2; ++k) dst[m][k] = *(const LAS bf16x8*)(lds + PG8_SA(b, h) + aoff + m * 2048 + k * 1024); } while (0)
#define PG8_LDB(dst, b, h) do { _Pragma("unroll") for (int n = 0; n < 2; ++n) _Pragma("unroll") for (int k = 0; k < 2; ++k) dst[n][k] = *(const LAS bf16x8*)(lds + PG8_SB(b, h) + boff + n * 2048 + k * 1024); } while (0)
#define PG8_MMA(ai, bj, At, Bt) do { __builtin_amdgcn_s_setprio(1); _Pragma("unroll") for (int m = 0; m < 4; ++m) _Pragma("unroll") for (int n = 0; n < 2; ++n) _Pragma("unroll") for (int k = 0; k < 2; ++k) \
        acc[ai][bj][m][n] = __builtin_amdgcn_mfma_f32_16x16x32_bf16(Bt[n][k], At[m][k], acc[ai][bj][m][n], 0, 0, 0); __builtin_amdgcn_s_setprio(0); } while (0)
#define PG8_WAIT_V(n) asm volatile("s_waitcnt vmcnt(" #n ")" ::: "memory")
#define PG8_WAIT_L(n) asm volatile("s_waitcnt lgkmcnt(" #n ")" ::: "memory")
#define PG8_BAR __builtin_amdgcn_s_barrier()
#define PG8_SCHED __builtin_amdgcn_sched_barrier(0)
    Unit cur, nxt; int ui = 0;
    if (!S.next(0, cur)) return;
    f32x4 acc[2][2][4][2];
#pragma unroll
    for (int a = 0; a < 2; ++a)
#pragma unroll
        for (int b = 0; b < 2; ++b)
#pragma unroll
            for (int m = 0; m < 4; ++m)
#pragma unroll
                for (int n = 0; n < 2; ++n) acc[a][b][m][n] = (f32x4){0.f, 0.f, 0.f, 0.f};
    bf16x8 At[4][2], B0[2][2], B1[2][2];
    const char* cA = cur.a; const char* cB = cur.b;
    if constexpr (SP2) {
        PG8_STAGE(PG8_SB(0, 0), cB, voffB); PG8_STAGE(PG8_SB(0, 1), cB + hstepB, voffB); PG8_STAGE(PG8_SA(0, 0), cA, voffA); PG8_STAGE(PG8_SA(0, 1), cA + hstepA, voffA);
        if (wr == 1) PG8_BAR;
        PG8_WAIT_V(2); PG8_BAR;
        PG8_STAGE(PG8_SB(1, 0), cB + kstep, voffB); PG8_STAGE(PG8_SA(1, 0), cA + kstep, voffA); PG8_STAGE(PG8_SB(1, 1), cB + hstepB + kstep, voffB);
        PG8_WAIT_V(6); PG8_BAR;
    } else {
        PG8_STAGE(PG8_SB(0, 0), cB, voffB); PG8_STAGE(PG8_SA(0, 0), cA, voffA); PG8_STAGE(PG8_SB(0, 1), cB + hstepB, voffB); PG8_STAGE(PG8_SA(0, 1), cA + hstepA, voffA);
        if (wr == 1) PG8_BAR;
        PG8_WAIT_V(4); PG8_BAR;
        PG8_STAGE(PG8_SB(1, 0), cB + kstep, voffB); PG8_STAGE(PG8_SA(1, 0), cA + kstep, voffA); PG8_STAGE(PG8_SB(1, 1), cB + hstepB + kstep, voffB);
        PG8_WAIT_V(6); PG8_BAR;
    }
    for (;;) {
        const bool has_next = S.next(ui + 1, nxt);
        const char* nA = has_next ? nxt.a : cA; const char* nB = has_next ? nxt.b : cB;
        for (int t = 0; t < nt; t += 2) {
            const bool last = (t == nt - 2);
            const char* a1 = cA + (size_t)(t + 1) * kstep;
            const char* a2 = last ? nA : cA + (size_t)(t + 2) * kstep; const char* b2 = last ? nB : cB + (size_t)(t + 2) * kstep;
            const char* a3 = a2 + kstep; const char* b3 = b2 + kstep;
            if constexpr (SP2) {
            PG8_LDB(B0, 0, 0); PG8_LDB(B1, 0, 1); PG8_SCHED; PG8_LDA(At, 0, 0); PG8_STAGE(PG8_SA(1, 1), a1 + hstepA, voffA);
            PG8_WAIT_V(8); PG8_WAIT_L(0); PG8_BAR; PG8_MMA(0, 0, At, B0); PG8_MMA(0, 1, At, B1); PG8_BAR; PG8_SCHED;
            PG8_LDA(At, 0, 1); PG8_STAGE(PG8_SB(0, 0), b2, voffB); PG8_STAGE(PG8_SB(0, 1), b2 + hstepB, voffB); PG8_STAGE(PG8_SA(0, 0), a2, voffA);
            PG8_WAIT_V(8); PG8_WAIT_L(0); PG8_BAR; PG8_MMA(1, 0, At, B0); PG8_MMA(1, 1, At, B1); PG8_BAR; PG8_SCHED;
            PG8_LDB(B0, 1, 0); PG8_LDB(B1, 1, 1); PG8_SCHED; PG8_LDA(At, 1, 0); PG8_STAGE(PG8_SA(0, 1), a2 + hstepA, voffA);
            PG8_WAIT_V(8); PG8_WAIT_L(0); PG8_BAR; PG8_MMA(0, 0, At, B0); PG8_MMA(0, 1, At, B1); PG8_BAR; PG8_SCHED;
            PG8_LDA(At, 1, 1); PG8_STAGE(PG8_SB(1, 0), b3, voffB); PG8_STAGE(PG8_SB(1, 1), b3 + hstepB, voffB); PG8_STAGE(PG8_SA(1, 0), a3, voffA);
            PG8_WAIT_V(8); PG8_WAIT_L(0); PG8_BAR; PG8_MMA(1, 0, At, B0); PG8_MMA(1, 1, At, B1); PG8_BAR; PG8_SCHED;
            } else {
            PG8_LDB(B0, 0, 0); PG8_SCHED; PG8_LDA(At, 0, 0); PG8_STAGE(PG8_SA(1, 1), a1 + hstepA, voffA);
            PG8_WAIT_L(8); PG8_BAR; PG8_WAIT_L(0); PG8_MMA(0, 0, At, B0); PG8_BAR; PG8_SCHED;
            PG8_LDB(B1, 0, 1); PG8_STAGE(PG8_SB(0, 0), b2, voffB);
            PG8_BAR; PG8_WAIT_L(0); PG8_MMA(0, 1, At, B1); PG8_BAR;
            PG8_LDA(At, 0, 1); PG8_STAGE(PG8_SA(0, 0), a2, voffA);
            PG8_BAR; PG8_WAIT_L(0); PG8_MMA(1, 0, At, B0); PG8_BAR; PG8_SCHED;
            PG8_STAGE(PG8_SB(0, 1), b2 + hstepB, voffB);
            PG8_WAIT_V(6); PG8_BAR; PG8_MMA(1, 1, At, B1); PG8_BAR;
            PG8_LDB(B0, 1, 0); PG8_SCHED; PG8_LDA(At, 1, 0); PG8_STAGE(PG8_SA(0, 1), a2 + hstepA, voffA);
            PG8_WAIT_L(8); PG8_BAR; PG8_WAIT_L(0); PG8_MMA(0, 0, At, B0); PG8_BAR; PG8_SCHED;
            PG8_LDB(B1, 1, 1); PG8_STAGE(PG8_SB(1, 0), b3, voffB);
            PG8_BAR; PG8_WAIT_L(0); PG8_MMA(0, 1, At, B1); PG8_BAR;
            PG8_LDA(At, 1, 1); PG8_STAGE(PG8_SA(1, 0), a3, voffA);
            PG8_BAR; PG8_WAIT_L(0); PG8_MMA(1, 0, At, B0); PG8_BAR; PG8_SCHED;
            PG8_STAGE(PG8_SB(1, 1), b3 + hstepB, voffB);
            PG8_WAIT_V(6); PG8_BAR; PG8_MMA(1, 1, At, B1); PG8_BAR;
            }
        }
        E(acc, cur, wr, wc, fr, fq);
        if (!has_next) break;
#pragma unroll
        for (int a = 0; a < 2; ++a)
#pragma unroll
            for (int b = 0; b < 2; ++b)
#pragma unroll
                for (int m = 0; m < 4; ++m)
#pragma unroll
                    for (int n = 0; n < 2; ++n) acc[a][b][m][n] = (f32x4){0.f, 0.f, 0.f, 0.f};
        cur = nxt; cA = nA; cB = nB; ++ui;
    }
    PG8_WAIT_V(0);
    if (wr == 0) PG8_BAR;
    PG8_BAR;
#undef PG8_SA
#undef PG8_SB
#undef PG8_STAGE
#undef PG8_LDA
#undef PG8_LDB
#undef PG8_MMA
#undef PG8_WAIT_V
#undef PG8_WAIT_L
#undef PG8_BAR
#undef PG8_SCHED
}

template <class Epi, class Sched, bool SP2 = PG8_SP2, bool GA = false>
DI void gemm_phase_fp8(LAS unsigned char* lds, const Gemm g, const Sched& S, const Epi& E) {
    const int tid = tid_fresh(), wid = __builtin_amdgcn_readfirstlane(tid >> 6), lane = tid & 63, wr = wid >> 2, wc = wid & 3, fr = lane & 15, fq = lane >> 4;
    const int K = g.K, nt = K / BK;
    static_assert(!GA || SP2, "gathered A rows: super-phase loop only");
    unsigned voffA[2], voffB[2]; int rloc[2]; unsigned cby[2];
#pragma unroll
    for (int i = 0; i < 2; ++i) { int R, C; stage_rc(tid * 16 + i * 8192, R, C); const int Rb = Epi::PERM ? ((R & ~31) + perm32(R & 31)) : R;
        voffA[i] = (unsigned)(R * g.lda + C) * 2u; voffB[i] = (unsigned)(Rb * g.brow + C) * 2u; rloc[i] = R; cby[i] = (unsigned)C * 2u; }
    unsigned vgC[2][2] = {{0u, 0u}, {0u, 0u}}, vgN[2][2] = {{0u, 0u}, {0u, 0u}};
    auto ldrows = [&](const Unit& u_, unsigned (&dst)[2][2]) {
#pragma unroll
        for (int h = 0; h < 2; ++h)
#pragma unroll
            for (int i = 0; i < 2; ++i) dst[h][i] = (unsigned)u_.rows[h * HALF + rloc[i]] * (unsigned)(g.lda * 2) + cby[i]; };
    const size_t kstep = (size_t)(BK * 2), kstepB = (size_t)g.bk;
    const size_t hstepA = (size_t)HALF * g.lda * 2, hstepB = (size_t)HALF * g.ldb * 2;
    const unsigned ldsw = (unsigned)wid * 1024u;
    const int aoff = lds_byte(wr * 64 + fr, fq * 8), boff = lds_byte(wc * 32 + fr, fq * 8);
#define PG8_SA(b, h) (((b) * 2 + (h)) * HTB)
#define PG8_SB(b, h) ((4 + (b) * 2 + (h)) * HTB)
#define PG8_STAGE(bufoff, gbase, voff) do { _Pragma("unroll") for (int _i = 0; _i < 2; ++_i) \
        __builtin_amdgcn_global_load_lds((const unsigned*)((const char*)(gbase) + (voff)[_i]), (LAS unsigned*)(lds + (bufoff) + ldsw + _i * 8192), 16, 0, 0); } while (0)
#define PG8_STA(bufoff, h, kp, nx) do { if constexpr (GA) { const unsigned o0_ = (nx) ? vgN[h][0] : vgC[h][0], o1_ = (nx) ? vgN[h][1] : vgC[h][1]; \
        __builtin_amdgcn_global_load_lds((const unsigned*)((const char*)(kp) + o0_), (LAS unsigned*)(lds + (bufoff) + ldsw), 16, 0, 0); \
        __builtin_amdgcn_global_load_lds((const unsigned*)((const char*)(kp) + o1_), (LAS unsigned*)(lds + (bufoff) + ldsw + 8192), 16, 0, 0); } \
        else PG8_STAGE(bufoff, (kp) + ((h) ? hstepA : 0), voffA); } while (0)
#define PG8_LDA(dst, b, h) do { _Pragma("unroll") for (int m = 0; m < 4; ++m) { const v4i_t lo_ = *(const LAS v4i_t*)(lds + PG8_SA(b, h) + aoff + m * 2048), hi_ = *(const LAS v4i_t*)(lds + PG8_SA(b, h) + aoff + m * 2048 + 1024); dst[m] = __builtin_shufflevector(lo_, hi_, 0, 1, 2, 3, 4, 5, 6, 7); } } while (0)
#define PG8_LDB(dst, b, h) do { _Pragma("unroll") for (int n = 0; n < 2; ++n) { const v4i_t lo_ = *(const LAS v4i_t*)(lds + PG8_SB(b, h) + boff + n * 2048), hi_ = *(const LAS v4i_t*)(lds + PG8_SB(b, h) + boff + n * 2048 + 1024); dst[n] = __builtin_shufflevector(lo_, hi_, 0, 1, 2, 3, 4, 5, 6, 7); } } while (0)
#define PG8_MMA(ai, bj, At, Bt) do { __builtin_amdgcn_s_setprio(1); _Pragma("unroll") for (int m = 0; m < 4; ++m) _Pragma("unroll") for (int n = 0; n < 2; ++n) \
        asm volatile("v_mfma_scale_f32_16x16x128_f8f6f4 %0, %1, %2, %0, %3, %3 op_sel_hi:[0,0,0]" : "+v"(acc[ai][bj][m][n]) : "v"(Bt[n]), "v"(At[m]), "v"(sc127)); __builtin_amdgcn_s_setprio(0); } while (0)
#define PG8_WAIT_V(n) asm volatile("s_waitcnt vmcnt(" #n ")" ::: "memory")
#define PG8_WAIT_L(n) asm volatile("s_waitcnt lgkmcnt(" #n ")" ::: "memory")
#define PG8_BAR __builtin_amdgcn_s_barrier()
#define PG8_SCHED __builtin_amdgcn_sched_barrier(0)
    Unit cur, nxt; int ui = 0;
    if (!S.next(0, cur)) return;
    f32x4 acc[2][2][4][2];
#pragma unroll
    for (int a = 0; a < 2; ++a)
#pragma unroll
        for (int b = 0; b < 2; ++b)
#pragma unroll
            for (int m = 0; m < 4; ++m)
#pragma unroll
                for (int n = 0; n < 2; ++n) acc[a][b][m][n] = (f32x4){0.f, 0.f, 0.f, 0.f};
    v8i_t At[4], B0[2], B1[2];
    int sc127 = 127; asm volatile("" : "+v"(sc127));
    const char* cA = cur.a; const char* cB = cur.b;
    float pre_[Epi::NPRE > 0 ? Epi::NPRE : 1];
    if constexpr (Epi::NPRE > 0) E.pre(cur, wr, wc, fr, fq, pre_);
    if constexpr (SP2) {
        if constexpr (GA) { ldrows(cur, vgC); Unit n1_; if (S.next(1, n1_)) ldrows(n1_, vgN);
#pragma unroll
            for (int h = 0; h < 2; ++h)
#pragma unroll
                for (int i = 0; i < 2; ++i) asm volatile("" : "+v"(vgC[h][i]), "+v"(vgN[h][i])); }
        PG8_STAGE(PG8_SB(0, 0), cB, voffB); PG8_STAGE(PG8_SB(0, 1), cB + hstepB, voffB); PG8_STA(PG8_SA(0, 0), 0, cA, false); PG8_STA(PG8_SA(0, 1), 1, cA, false);
        if (wr == 1) PG8_BAR;
        PG8_WAIT_V(2); PG8_BAR;
        PG8_STAGE(PG8_SB(1, 0), cB + kstepB, voffB); PG8_STA(PG8_SA(1, 0), 0, cA + kstep, false); PG8_STAGE(PG8_SB(1, 1), cB + hstepB + kstepB, voffB);
        PG8_WAIT_V(6); PG8_BAR;
    } else {
        PG8_STAGE(PG8_SB(0, 0), cB, voffB); PG8_STAGE(PG8_SA(0, 0), cA, voffA); PG8_STAGE(PG8_SB(0, 1), cB + hstepB, voffB); PG8_STAGE(PG8_SA(0, 1), cA + hstepA, voffA);
        if (wr == 1) PG8_BAR;
        PG8_WAIT_V(4); PG8_BAR;
        PG8_STAGE(PG8_SB(1, 0), cB + kstepB, voffB); PG8_STAGE(PG8_SA(1, 0), cA + kstep, voffA); PG8_STAGE(PG8_SB(1, 1), cB + hstepB + kstepB, voffB);
        PG8_WAIT_V(6); PG8_BAR;
    }
    for (;;) {
        const bool has_next = S.next(ui + 1, nxt);
        const char* nA = has_next ? nxt.a : cA; const char* nB = has_next ? nxt.b : cB;
        for (int t = 0; t < nt; t += 2) {
            const bool last = (t == nt - 2); const bool lastn = last && has_next; (void)lastn;
            const char* a1 = cA + (size_t)(t + 1) * kstep;
            const char* a2 = last ? nA : cA + (size_t)(t + 2) * kstep; const char* b2 = last ? nB : cB + (size_t)(t + 2) * kstepB;
            const char* a3 = a2 + kstep; const char* b3 = b2 + kstepB;
            if constexpr (SP2) {
            PG8_LDB(B0, 0, 0); PG8_LDB(B1, 0, 1); PG8_SCHED; PG8_LDA(At, 0, 0); PG8_STA(PG8_SA(1, 1), 1, a1, false);
            PG8_WAIT_V(8); PG8_WAIT_L(0); PG8_BAR; PG8_MMA(0, 0, At, B0); PG8_MMA(0, 1, At, B1); PG8_BAR; PG8_SCHED;
            PG8_LDA(At, 0, 1); PG8_STAGE(PG8_SB(0, 0), b2, voffB); PG8_STAGE(PG8_SB(0, 1), b2 + hstepB, voffB); PG8_STA(PG8_SA(0, 0), 0, a2, lastn);
            PG8_WAIT_V(8); PG8_WAIT_L(0); PG8_BAR; PG8_MMA(1, 0, At, B0); PG8_MMA(1, 1, At, B1); PG8_BAR; PG8_SCHED;
            PG8_LDB(B0, 1, 0); PG8_LDB(B1, 1, 1); PG8_SCHED; PG8_LDA(At, 1, 0); PG8_STA(PG8_SA(0, 1), 1, a2, lastn);
            PG8_WAIT_V(8); PG8_WAIT_L(0); PG8_BAR; PG8_MMA(0, 0, At, B0); PG8_MMA(0, 1, At, B1); PG8_BAR; PG8_SCHED;
            PG8_LDA(At, 1, 1); PG8_STAGE(PG8_SB(1, 0), b3, voffB); PG8_STAGE(PG8_SB(1, 1), b3 + hstepB, voffB); PG8_STA(PG8_SA(1, 0), 0, a3, lastn);
            PG8_WAIT_V(8); PG8_WAIT_L(0); PG8_BAR; PG8_MMA(1, 0, At, B0); PG8_MMA(1, 1, At, B1); PG8_BAR; PG8_SCHED;
            } else {
            PG8_LDB(B0, 0, 0); PG8_SCHED; PG8_LDA(At, 0, 0); PG8_STAGE(PG8_SA(1, 1), a1 + hstepA, voffA);
            PG8_WAIT_L(8); PG8_BAR; PG8_WAIT_L(0); PG8_MMA(0, 0, At, B0); PG8_BAR; PG8_SCHED;
            PG8_LDB(B1, 0, 1); PG8_STAGE(PG8_SB(0, 0), b2, voffB);
            PG8_BAR; PG8_WAIT_L(0); PG8_MMA(0, 1, At, B1); PG8_BAR;
            PG8_LDA(At, 0, 1); PG8_STAGE(PG8_SA(0, 0), a2, voffA);
            PG8_BAR; PG8_WAIT_L(0); PG8_MMA(1, 0, At, B0); PG8_BAR; PG8_SCHED;
            PG8_STAGE(PG8_SB(0, 1), b2 + hstepB, voffB);
            PG8_WAIT_V(6); PG8_BAR; PG8_MMA(1, 1, At, B1); PG8_BAR;
            PG8_LDB(B0, 1, 0); PG8_SCHED; PG8_LDA(At, 1, 0); PG8_STAGE(PG8_SA(0, 1), a2 + hstepA, voffA);
            PG8_WAIT_L(8); PG8_BAR; PG8_WAIT_L(0); PG8_MMA(0, 0, At, B0); PG8_BAR; PG8_SCHED;
            PG8_LDB(B1, 1, 1); PG8_STAGE(PG8_SB(1, 0), b3, voffB);
            PG8_BAR; PG8_WAIT_L(0); PG8_MMA(0, 1, At, B1); PG8_BAR;
            PG8_LDA(At, 1, 1); PG8_STAGE(PG8_SA(1, 0), a3, voffA);
            PG8_BAR; PG8_WAIT_L(0); PG8_MMA(1, 0, At, B0); PG8_BAR; PG8_SCHED;
            PG8_STAGE(PG8_SB(1, 1), b3 + hstepB, voffB);
            PG8_WAIT_V(6); PG8_BAR; PG8_MMA(1, 1, At, B1); PG8_BAR;
            }
        }
        int rwT[2][2] = {{0, 0}, {0, 0}}; bool h2_ = false;
        if constexpr (GA) { Unit n2_; h2_ = has_next && S.next(ui + 2, n2_);
            if (h2_) {
#pragma unroll
                for (int h = 0; h < 2; ++h)
#pragma unroll
                    for (int i = 0; i < 2; ++i) rwT[h][i] = n2_.rows[h * HALF + rloc[i]]; } }
        asm volatile("s_nop 15\n\ts_nop 15" ::: "memory");
        if constexpr (Epi::NPRE > 0) E.run(acc, cur, wr, wc, fr, fq, pre_); else E(acc, cur, wr, wc, fr, fq);
        if (!has_next) break;
        if constexpr (GA) {
#pragma unroll
            for (int h = 0; h < 2; ++h)
#pragma unroll
                for (int i = 0; i < 2; ++i) { asm volatile("" : "+v"(rwT[h][i])); vgC[h][i] = vgN[h][i]; if (h2_) vgN[h][i] = (unsigned)rwT[h][i] * (unsigned)(g.lda * 2) + cby[i]; } }
#pragma unroll
        for (int a = 0; a < 2; ++a)
#pragma unroll
            for (int b = 0; b < 2; ++b)
#pragma unroll
                for (int m = 0; m < 4; ++m)
#pragma unroll
                    for (int n = 0; n < 2; ++n) acc[a][b][m][n] = (f32x4){0.f, 0.f, 0.f, 0.f};
        cur = nxt; cA = nA; cB = nB; ++ui;
        if constexpr (Epi::NPRE > 0) E.pre(cur, wr, wc, fr, fq, pre_);
    }
    PG8_WAIT_V(0);
    if (wr == 0) PG8_BAR;
    PG8_BAR;
#undef PG8_SA
#undef PG8_SB
#undef PG8_STAGE
#undef PG8_STA
#undef PG8_LDA
#undef PG8_LDB
#undef PG8_MMA
#undef PG8_WAIT_V
#undef PG8_WAIT_L
#undef PG8_BAR
#undef PG8_SCHED
}

typedef f32x4 Acc[2][2][4][2];
struct EpiBf16 {
    static constexpr bool PERM = true; static constexpr int NPRE = 0; bf16_t* O; int ldc; float scale;
    DI void operator()(const Acc& acc, const Unit& u, int wr, int wc, int fr, int fq) const {
        const int row0 = u.pm * BM + wr * 64 + fr, col0 = u.pn * BM + wc * 32 + 8 * fq;
#pragma unroll
        for (int ai = 0; ai < 2; ++ai)
#pragma unroll
            for (int m = 0; m < 4; ++m) { bf16_t* rowp = O + (size_t)(row0 + ai * HALF + m * 16) * ldc + col0;
#pragma unroll
                for (int bj = 0; bj < 2; ++bj) { const f32x4 v0 = acc[ai][bj][m][0] * scale, v1 = acc[ai][bj][m][1] * scale;
                    *(u32x4*)(rowp + bj * HALF) = (u32x4){pk2(v0[0], v0[1]), pk2(v0[2], v0[3]), pk2(v1[0], v1[1]), pk2(v1[2], v1[3])}; } }
    }
};
struct EpiZ16 {
    static constexpr bool PERM = true; bf16_t* O; bf16_t* bq; int ldc;
    DI void operator()(const Acc& acc, const Unit& u, int wr, int wc, int fr, int fq) const {
        const int row0 = u.pm * BM + wr * 64 + fr, col0 = u.pn * BM + wc * 32 + 8 * fq; const bool qt = u.pn >= 4;
#pragma unroll
        for (int ai = 0; ai < 2; ++ai)
#pragma unroll
            for (int m = 0; m < 4; ++m) { const int row = row0 + ai * HALF + m * 16;
#pragma unroll
                for (int bj = 0; bj < 2; ++bj) { const f32x4 v0 = acc[ai][bj][m][0], v1 = acc[ai][bj][m][1];
                    bf16_t* dst = qt ? bq + (size_t)row * 1024 + (col0 - 1024) + bj * HALF : O + (size_t)row * ldc + col0 + bj * HALF;
                    *(u32x4*)dst = (u32x4){pk2(v0[0], v0[1]), pk2(v0[2], v0[3]), pk2(v1[0], v1[1]), pk2(v1[2], v1[3])}; } }
    }
};
struct EpiZ8 {
    static constexpr bool PERM = true; static constexpr int NPRE = 0; bf16_t* O; bf16_t* kvs; int ldc; float scale;
    DI void operator()(const Acc& acc, const Unit& u, int wr, int wc, int fr, int fq) const {
        const int row0 = u.pm * BM + wr * 64 + fr, col0 = u.pn * BM + wc * 32 + 8 * fq; const bool vt = u.pn < 6;
#pragma unroll
        for (int ai = 0; ai < 2; ++ai)
#pragma unroll
            for (int m = 0; m < 4; ++m) { const int row = row0 + ai * HALF + m * 16; const int b = row >> 13, tq = row & (T - 1);
#pragma unroll
                for (int bj = 0; bj < 2; ++bj) { const f32x4 v0 = acc[ai][bj][m][0] * scale, v1 = acc[ai][bj][m][1] * scale;
                    bf16_t* dst = vt ? kvs + ((((size_t)u.pn * NB + b) * 2 + bj) * T + tq) * 128 + wc * 32 + 8 * fq : O + (size_t)row * ldc + col0 + bj * HALF;
                    *(u32x4*)dst = (u32x4){pk2(v0[0], v0[1]), pk2(v0[2], v0[3]), pk2(v1[0], v1[1]), pk2(v1[2], v1[3])}; } }
    }
};
struct EpiC1 {
    static constexpr bool PERM = false; float* C;
    DI void operator()(const Acc& acc, const Unit& u, int wr, int wc, int fr, int fq) const {
        const int row0 = u.pm * BM + wr * 64 + fr, col0 = wc * 32 + 4 * fq;
        float* base = C + (size_t)u.e * 2048 * 256;
#pragma unroll
        for (int ai = 0; ai < 2; ++ai)
#pragma unroll
            for (int m = 0; m < 4; ++m) { float* rowp = base + (size_t)(row0 + ai * HALF + m * 16) * 256 + col0;
#pragma unroll
                for (int bj = 0; bj < 2; ++bj)
#pragma unroll
                    for (int n = 0; n < 2; ++n) *(f32x4*)(rowp + bj * HALF + n * 16) = acc[ai][bj][m][n]; }
    }
};
DI unsigned fp8x4_nc(float a, float b, float c, float d) { int w = 0; w = __builtin_amdgcn_cvt_pk_fp8_f32(a, b, w, false); w = __builtin_amdgcn_cvt_pk_fp8_f32(c, d, w, true); return (unsigned)w; }
DI float clamp8(float v) { return __builtin_amdgcn_fmed3f(v, -448.f, 448.f); }
DI unsigned fp8x4(float a, float b, float c, float d) { int w = 0; w = __builtin_amdgcn_cvt_pk_fp8_f32(clamp8(a), clamp8(b), w, false); w = __builtin_amdgcn_cvt_pk_fp8_f32(clamp8(c), clamp8(d), w, true); return (unsigned)w; }
constexpr float W8_SCALE = 256.f, W8_INV = 1.f / 256.f, A8_SCALE = 16.f, A8W8_INV = 1.f / 4096.f, Y8_SCALE = 32.f, Y8_INV = 1.f / 32.f;
template <bool ADD> struct EpiMerge {
    static constexpr bool PERM = true; static constexpr int NPRE = 0; bf16_t* P; unsigned char* O8; const bf16_t* Z; int gcol0; float scale;
    DI void operator()(const Acc& acc, const Unit& u, int wr, int wc, int fr, int fq) const {
        const int row0 = u.pm * BM + wr * 64 + fr, col0 = u.pn * BM + wc * 32 + 8 * fq;
#pragma unroll
        for (int ai = 0; ai < 2; ++ai) {
            u32x4 gz[4][2], pz[4][2];
#pragma unroll
            for (int m = 0; m < 4; ++m) { const size_t row = (size_t)(row0 + ai * HALF + m * 16);
#pragma unroll
                for (int bj = 0; bj < 2; ++bj) { const int col = col0 + bj * HALF; gz[m][bj] = *(const u32x4*)(Z + row * ZC + gcol0 + col); if (ADD) pz[m][bj] = *(const u32x4*)(P + row * D + col); } }
#pragma unroll
            for (int m = 0; m < 4; ++m) { const size_t row = (size_t)(row0 + ai * HALF + m * 16);
#pragma unroll
                for (int bj = 0; bj < 2; ++bj) { const int col = col0 + bj * HALF;
                    float g[8], o[8]; unpack8(gz[m][bj], g);
                    const f32x4 v0 = acc[ai][bj][m][0] * scale, v1 = acc[ai][bj][m][1] * scale;
                    if (ADD) unpack8(pz[m][bj], o);
#pragma unroll
                    for (int j = 0; j < 8; ++j) { const float a = j < 4 ? v0[j & 3] : v1[j & 3]; o[j] = (ADD ? o[j] : 0.f) + sigmoidf_(g[j]) * a; }
                    if (ADD) *(u32x2*)(O8 + row * D + col) = (u32x2){fp8x4(o[0] * A8_SCALE, o[1] * A8_SCALE, o[2] * A8_SCALE, o[3] * A8_SCALE), fp8x4(o[4] * A8_SCALE, o[5] * A8_SCALE, o[6] * A8_SCALE, o[7] * A8_SCALE)};
                    else *(u32x4*)(P + row * D + col) = (u32x4){pk2(o[0], o[1]), pk2(o[2], o[3]), pk2(o[4], o[5]), pk2(o[6], o[7])}; } }
        }
    }
};
struct EpiGU {
    static constexpr bool PERM = true; static constexpr int NPRE = 16; unsigned char* O; const float* bias;
    DI void pre(const Unit& u, int wr, int wc, int fr, int fq, float (&pv)[16]) const {
        const float* bg = bias + (size_t)u.e * 4096 + u.pn * HALF + wc * 32 + 8 * fq; const float* bu = bg + 2048;
#pragma unroll
        for (int j = 0; j < 8; ++j) { pv[j] = bg[j]; pv[8 + j] = bu[j]; }
    }
    DI void run(const Acc& acc, const Unit& u, int wr, int wc, int fr, int fq, const float (&pv)[16]) const {
        const int row0 = u.pm * BM + wr * 64 + fr, c0 = u.pn * HALF + wc * 32 + 8 * fq;
        float bgv[8], buv[8];
#pragma unroll
        for (int j = 0; j < 8; ++j) { bgv[j] = pv[j]; buv[j] = pv[8 + j]; }
#pragma unroll
        for (int ai = 0; ai < 2; ++ai)
#pragma unroll
            for (int m = 0; m < 4; ++m) { unsigned char* rowp = O + (size_t)(row0 + ai * HALF + m * 16) * D + c0;
                float o[8];
#pragma unroll
                for (int j = 0; j < 8; ++j) { float gt = (j < 4 ? acc[ai][0][m][0][j & 3] : acc[ai][0][m][1][j & 3]) * W8_INV + bgv[j];
                    float up = (j < 4 ? acc[ai][1][m][0][j & 3] : acc[ai][1][m][1][j & 3]) * W8_INV + buv[j];
                    gt = fminf(gt, 7.f); up = fminf(fmaxf(up, -7.f), 7.f);
                    const float gs = gt * __builtin_amdgcn_rcpf(1.f + __builtin_amdgcn_exp2f(gt * (-1.702f * 1.4426950408889634f))); o[j] = __builtin_fmaf(gs, up, gs); }
                *(u32x2*)rowp = (u32x2){fp8x4_nc(o[0], o[1], o[2], o[3]), fp8x4_nc(o[4], o[5], o[6], o[7])}; }
    }
};
struct EpiDN {
    static constexpr bool PERM = true; static constexpr int NPRE = 24; unsigned char* O; const float* bias; const float* slotw;
    DI void pre(const Unit& u, int wr, int wc, int fr, int fq, float (&pv)[24]) const {
        const int row0 = u.pm * BM + wr * 64 + fr, col0 = u.pn * BM + wc * 32 + 8 * fq;
#pragma unroll
        for (int bj = 0; bj < 2; ++bj)
#pragma unroll
            for (int j = 0; j < 8; ++j) pv[bj * 8 + j] = bias[(size_t)u.e * D + col0 + bj * HALF + j];
#pragma unroll
        for (int ai = 0; ai < 2; ++ai)
#pragma unroll
            for (int m = 0; m < 4; ++m) pv[16 + ai * 4 + m] = slotw[row0 + ai * HALF + m * 16];
    }
    DI void run(const Acc& acc, const Unit& u, int wr, int wc, int fr, int fq, const float (&pv)[24]) const {
        const int row0 = u.pm * BM + wr * 64 + fr, col0 = u.pn * BM + wc * 32 + 8 * fq;
        float bv[2][8];
#pragma unroll
        for (int bj = 0; bj < 2; ++bj)
#pragma unroll
            for (int j = 0; j < 8; ++j) bv[bj][j] = pv[bj * 8 + j];
        float sw[2][4];
#pragma unroll
        for (int ai = 0; ai < 2; ++ai)
#pragma unroll
            for (int m = 0; m < 4; ++m) sw[ai][m] = pv[16 + ai * 4 + m];
#pragma unroll
        for (int ai = 0; ai < 2; ++ai)
#pragma unroll
            for (int m = 0; m < 4; ++m) { const int row = row0 + ai * HALF + m * 16; const float w = sw[ai][m] * Y8_SCALE; unsigned char* rowp = O + (size_t)row * D + col0;
#pragma unroll
                for (int bj = 0; bj < 2; ++bj) { float o[8];
#pragma unroll
                    for (int j = 0; j < 8; ++j) o[j] = ((j < 4 ? acc[ai][bj][m][0][j & 3] : acc[ai][bj][m][1][j & 3]) * W8_INV + bv[bj][j]) * w;
                    *(u32x2*)(rowp + bj * HALF) = (u32x2){fp8x4(o[0], o[1], o[2], o[3]), fp8x4(o[4], o[5], o[6], o[7])}; } }
    }
};
constexpr int C1_SPLIT = 4;
struct C1Sched {
    int G, c; const char* kvs; const char* w;
    DI bool next(int i, Unit& u) const {
        const int L = i * G + (G - 1 - c); if (L >= 16 * C1_SPLIT) return false;
        const int kv = L / (8 * C1_SPLIT), s = (L >> 3) % C1_SPLIT, pm = L & 7;
        u.pm = pm; u.pn = 0; u.e = s * 2 + kv;
        u.a = kvs + ((size_t)kv * KVS_ONE + (size_t)pm * 256 * 2048 + (size_t)s * (4096 / C1_SPLIT)) * 2;
        u.b = w + ((size_t)kv * 256 * 4096 + (size_t)s * (4096 / C1_SPLIT)) * 2; return true;
    }
};
struct MoeSched {
    int G, c, nN, total; const LAS int* tile_e; const char* A; const char* W; size_t w_exp;
    const int* rows = nullptr;
    DI bool next(int i, Unit& u) const {
        const int L = i * G + c; if (L >= total) return false;
        const int mt = L / nN, pn = L - mt * nN; const int e = __builtin_amdgcn_readfirstlane(tile_e[mt]);
        u.pm = mt; u.pn = pn; u.e = e;
        u.a = rows ? A : A + (size_t)mt * 256 * D; u.rows = rows ? rows + mt * 256 : nullptr; u.b = W + (size_t)e * w_exp + (size_t)pn * 256 * D; return true;
    }
};
}

DI int colmap(int kind, int n) {
    if (kind == 0) return n;
    if (kind == 1) {
        if (n < 872) return n;
        if (n < 896) return 3432 + (n - 872);
        if (n < 1024) return -1;
        if (n < 2048) return 872 + (n - 1024);
        if (n < 3584) return 1896 + (n - 2048);
        return 3456 + (n - 3584);
    }
    if (kind == 2) { const int pn = n >> 8, r = n & 255; return r < 128 ? pn * 128 + r : 2048 + pn * 128 + (r - 128); }
    if (kind == 4) return n < 32 ? n : -1;
    { const int h = n >> 5, d = n & 31; return h * 128 + d; }
}
struct TrJob { const float* src; bf16_t* dst; int ldsrc, lddst, kind, k0, n0, dk0, dn0; };
DI void tr_load(const TrJob& j, f32x4 (&v)[8], int t) {
    const int c4 = t & 63, r0 = t >> 6; const int sc = colmap(j.kind, j.n0 + 4 * c4);
#pragma unroll
    for (int q = 0; q < 8; ++q) v[q] = (f32x4){0.f, 0.f, 0.f, 0.f};
    if (sc >= 0) {
#pragma unroll
        for (int q = 0; q < 8; ++q) v[q] = __builtin_nontemporal_load((const f32x4*)(j.src + (size_t)(j.k0 + r0 + 8 * q) * j.ldsrc + sc));
    }
}
DI void tr_lds_write(const f32x4 (&v)[8], float* tile, int t) {
    const int c4 = t & 63, r0 = t >> 6;
#pragma unroll
    for (int q = 0; q < 8; ++q) { float* tp = tile + (r0 + 8 * q) * 257 + 4 * c4; tp[0] = v[q][0]; tp[1] = v[q][1]; tp[2] = v[q][2]; tp[3] = v[q][3]; }
}
DI void tr_store(const TrJob& j, const float* tile, int t) {
    const int kk8 = (t & 7) * 8, nb = t >> 3;
#pragma unroll
    for (int ps = 0; ps < 4; ++ps) { const int nn = nb + 64 * ps; const float* s = tile + kk8 * 257 + nn;
        u32x4 o = {pk2(s[0], s[257]), pk2(s[2 * 257], s[3 * 257]), pk2(s[4 * 257], s[5 * 257]), pk2(s[6 * 257], s[7 * 257])};
        *(u32x4*)(j.dst + (size_t)(j.n0 + nn) * j.lddst + j.k0 + kk8) = o; }
}
DI void tr_setup(TrJob& j, int u, int nK, const float* src, int ldsrc, int kind, bf16_t* dst, int lddst) {
    const int kt = u % nK, ntile = u / nK; j.src = src; j.dst = dst; j.ldsrc = ldsrc; j.lddst = lddst; j.kind = kind; j.k0 = kt * 64; j.n0 = ntile * 256;
}
DI float tr8_load(const TrJob& j, f32x4 (&v)[8], int t) {
    const int c4 = t & 31, r0 = t >> 5; const int sc = colmap(j.kind, j.n0 + 4 * c4); const int scc = sc < 0 ? 0 : sc;
#pragma unroll
    for (int q = 0; q < 8; ++q) v[q] = __builtin_nontemporal_load((const f32x4*)(j.src + (size_t)(j.k0 + r0 + 16 * q) * j.ldsrc + scc));
    return sc < 0 ? 0.f : 1.f;
}
DI void tr8_lds_write(const f32x4 (&v)[8], float ok, float* tile, int t) {
    const int c4 = t & 31, r0 = t >> 5;
#pragma unroll
    for (int q = 0; q < 8; ++q) { float* tp = tile + (r0 + 16 * q) * 129 + 4 * c4; tp[0] = v[q][0] * ok; tp[1] = v[q][1] * ok; tp[2] = v[q][2] * ok; tp[3] = v[q][3] * ok; }
}
DI void tr8_store(const TrJob& j, const float* tile, int t) {
    const int kc = t & 7, nb = t >> 3; constexpr float SC = pg8::W8_SCALE;
#pragma unroll
    for (int ps = 0; ps < 2; ++ps) { const int nn = nb + 64 * ps; const float* s = tile + (16 * kc) * 129 + nn;
        u32x4 o = {pg8::fp8x4(s[0] * SC, s[129] * SC, s[2 * 129] * SC, s[3 * 129] * SC), pg8::fp8x4(s[4 * 129] * SC, s[5 * 129] * SC, s[6 * 129] * SC, s[7 * 129] * SC),
                   pg8::fp8x4(s[8 * 129] * SC, s[9 * 129] * SC, s[10 * 129] * SC, s[11 * 129] * SC), pg8::fp8x4(s[12 * 129] * SC, s[13 * 129] * SC, s[14 * 129] * SC, s[15 * 129] * SC)};
        __builtin_nontemporal_store(o, (u32x4*)((unsigned char*)j.dst + (size_t)(j.dn0 + nn) * j.lddst + j.dk0 + 16 * kc)); }
}
DI void phase_prep(const Params& p, char* smem) {
    float* tile = (float*)smem;
    const int t = tid_fresh(), G = gridDim.x;
    for (int i = blockIdx.x * 512 + t; i < SLOTS; i += G * 512) ((int*)(p.ws + O_HS))[i] = 0;
    constexpr int U_ADA = 256, U_ABS = 128, U_WO = 256, U_CB = 128, SPECIAL = U_ADA + U_ABS + U_WO + U_CB;
    constexpr int U_WINB = 32 * 8, U_WIN = 16 * 44, U_IDXQ = 8 * 2, U_UQR = 8, U_BRB = 16 * 8, U_OUT = 32 * 8, U_C1 = 64, U_RT = 32, U_GU = 32 * 16, U_DN = 32 * 8;
    constexpr int NTR = U_WINB + U_IDXQ + U_UQR + 2 * U_C1 + U_RT, NTR8 = U_WIN + U_BRB + U_OUT + NEXP * (U_GU + U_DN);
    bf16_t* Wq = (bf16_t*)(p.ws + O_WQ);
    for (int rp_ = 0; rp_ < ((PREP_REP & 1) ? 2 : 1); ++rp_)
    for (int u0 = blockIdx.x; u0 < SPECIAL; u0 += G) {
        int u = u0;
        if (rp_ == 1 && (u0 < PREP_REP_LO || u0 >= PREP_REP_HI)) continue;
        if (u < U_ADA) {
            const int c4 = t % 12, kg = t / 12; f32x4 a0 = {0.f, 0.f, 0.f, 0.f}, a1 = {0.f, 0.f, 0.f, 0.f};
            if (kg < 42) { const int col = u * 48 + c4 * 4;
#pragma unroll 7
                for (int k = kg; k < 2048; k += 42) { const float c0 = p.c[k], c1 = p.c[2048 + k]; const float s0 = c0 * sigmoidf_(c0), s1 = c1 * sigmoidf_(c1);
                    const f32x4 w = *(const f32x4*)(p.w_ada + (size_t)k * 12288 + col); a0 += w * s0; a1 += w * s1; } }
            __syncthreads();
            if (kg < 42) { float* tp = tile + (kg * 12 + c4) * 8;
#pragma unroll
                for (int j = 0; j < 4; ++j) { tp[j] = a0[j]; tp[4 + j] = a1[j]; } }
            __syncthreads();
            if (t < 96) { const int bb = t / 48, cc = t % 48; float acc = 0.f;
                for (int g2 = 0; g2 < 42; ++g2) acc += tile[(g2 * 12 + (cc >> 2)) * 8 + bb * 4 + (cc & 3)];
                ((float*)(p.ws + O_MODACC))[bb * 12288 + u * 48 + cc] = acc + p.b_ada[u * 48 + cc]; }
            continue; }
        u -= U_ADA;
        if (u < U_ABS) {
            typedef float f32x16_ __attribute__((ext_vector_type(16)));
            const int h = u >> 4, ct = (u >> 1) & 7, wv_ = __builtin_amdgcn_readfirstlane(t >> 6), rtile = (u & 1) * 8 + wv_, c = t & 31, hh = (t & 63) >> 5;
            const float* ka = p.a_w_uk + (size_t)(ct * 32 + c) * 768 + h * 96 + 8 * hh;
            const float* qb_ = p.a_w_uq + (size_t)(rtile * 32 + c) * 1024 + h * 128 + 32 + 8 * hh;
            f32x16_ acc;
#pragma unroll
            for (int i = 0; i < 16; ++i) acc[i] = 0.f;
#pragma unroll
            for (int s = 0; s < 6; ++s) { const f32x4 a0 = *(const f32x4*)(ka + 16 * s), a1 = *(const f32x4*)(ka + 16 * s + 4), b0 = *(const f32x4*)(qb_ + 16 * s), b1 = *(const f32x4*)(qb_ + 16 * s + 4);
                const u32x4 pa = {pk2(a0[0], a0[1]), pk2(a0[2], a0[3]), pk2(a1[0], a1[1]), pk2(a1[2], a1[3])}, pb = {pk2(b0[0], b0[1]), pk2(b0[2], b0[3]), pk2(b1[0], b1[1]), pk2(b1[2], b1[3])};
                acc = __builtin_amdgcn_mfma_f32_32x32x16_bf16(__builtin_bit_cast(bf16x8, pa), __builtin_bit_cast(bf16x8, pb), acc, 0, 0, 0); }
#pragma unroll
            for (int q = 0; q < 16; ++q) Wq[(size_t)(h * 256 + ct * 32 + (q & 3) + 8 * (q >> 2) + 4 * hh) * 512 + rtile * 32 + c] = f2bf(acc[q]);
            continue; }
        u -= U_ABS;
        if (u < U_WO) {
            typedef float f32x16_ __attribute__((ext_vector_type(16)));
            const int h = u >> 5, rt = (u >> 2) & 7, nq = u & 3, wv_ = __builtin_amdgcn_readfirstlane(t >> 6), c = t & 31, hh = (t & 63) >> 5;
            const float* ua = p.a_w_uv + (size_t)(h * 256 + rt * 32 + c) * 128 + 8 * hh;
            bf16x8 af[8];
#pragma unroll
            for (int s = 0; s < 8; ++s) { const f32x4 x0 = *(const f32x4*)(ua + 16 * s), x1 = *(const f32x4*)(ua + 16 * s + 4);
                const u32x4 pk = {pk2(x0[0], x0[1]), pk2(x0[2], x0[3]), pk2(x1[0], x1[1]), pk2(x1[2], x1[3])}; af[s] = __builtin_bit_cast(bf16x8, pk); }
#pragma unroll 1
            for (int tt = 0; tt < 2; ++tt) { const int n0 = (nq * 16 + wv_ * 2 + tt) * 32;
                const float* wb = p.w_br_a + (size_t)(h * 128 + 8 * hh) * D + n0 + c;
                f32x16_ acc;
#pragma unroll
                for (int i = 0; i < 16; ++i) acc[i] = 0.f;
#pragma unroll
                for (int s = 0; s < 8; ++s) { float b[8];
#pragma unroll
                    for (int j = 0; j < 8; ++j) b[j] = wb[(size_t)(16 * s + j) * D];
                    const u32x4 pk = {pk2(b[0], b[1]), pk2(b[2], b[3]), pk2(b[4], b[5]), pk2(b[6], b[7])};
                    acc = __builtin_amdgcn_mfma_f32_32x32x16_bf16(af[s], __builtin_bit_cast(bf16x8, pk), acc, 0, 0, 0); }
                constexpr float SW = pg8::W8_SCALE;
                unsigned char* op = (unsigned char*)(p.ws + O_WO) + (size_t)(n0 + c) * D + h * 256 + rt * 32 + 4 * hh;
#pragma unroll
                for (int g4 = 0; g4 < 4; ++g4) *(unsigned*)(op + 8 * g4) = pg8::fp8x4(acc[4 * g4] * SW, acc[4 * g4 + 1] * SW, acc[4 * g4 + 2] * SW, acc[4 * g4 + 3] * SW); }
            continue; }
        u -= U_WO;
        {
            const int kv = u >> 6, seg = u & 63;
            if (t < 256) { const float* pe = kv ? p.cmp_v_pe : p.cmp_k_pe; const float* w1 = kv ? p.cmp_v_w1 : p.cmp_k_w1; float a = 0.f;
#pragma unroll 16
                for (int i = seg * 64; i < seg * 64 + 64; ++i) a += pe[i] * w1[(size_t)i * 256 + t];
                ((float*)(p.ws + O_CBP))[(seg * 2 + kv) * 256 + t] = a; } }
    }
    auto setup = [&](TrJob& j, int u) {
        if (u < U_WINB) { tr_setup(j, u, 32, p.w_in, 7552, 1, (bf16_t*)(p.ws + O_WIN), D); return; } u -= U_WINB;
        if (u < U_IDXQ) { tr_setup(j, u, 8, p.idx_w_q, 512, 0, Wq + (size_t)2304 * 512, 512); return; } u -= U_IDXQ;
        if (u < U_UQR) { tr_setup(j, u, 8, p.a_w_uq, 1024, 3, Wq + (size_t)2048 * 512, 512); return; } u -= U_UQR;
        if (u < U_C1) { tr_setup(j, u, 64, p.cmp_k_w1, 256, 0, (bf16_t*)(p.ws + O_WC1), 4096); return; } u -= U_C1;
        if (u < U_C1) { tr_setup(j, u, 64, p.cmp_v_w1, 256, 0, (bf16_t*)(p.ws + O_WC1) + (size_t)256 * 4096, 4096); return; } u -= U_C1;
        tr_setup(j, u, 32, p.w_router, 32, 4, (bf16_t*)(p.ws + O_WRT), D);
    };
    auto setup8 = [&](TrJob& j, int u) {
        j.lddst = D;
        if (u < U_WIN) { j.src = p.w_in; j.ldsrc = 7552; j.kind = 1; j.dst = (bf16_t*)(p.ws + O_WIN8); j.k0 = (u & 15) * 128; j.n0 = 2048 + (u >> 4) * 128; j.dk0 = j.k0; j.dn0 = j.n0; return; } u -= U_WIN;
        if (u < U_BRB) { j.src = p.w_br_b; j.ldsrc = D; j.kind = 0; j.dst = (bf16_t*)(p.ws + O_WBRB); j.lddst = 1024; j.k0 = (u & 7) * 128; j.n0 = (u >> 3) * 128; j.dk0 = j.k0; j.dn0 = j.n0; return; } u -= U_BRB;
        if (u < U_OUT) { j.src = p.w_out; j.ldsrc = D; j.kind = 0; j.dst = (bf16_t*)(p.ws + O_WOUT); j.k0 = (u & 15) * 128; j.n0 = (u >> 4) * 128; j.dk0 = j.k0; j.dn0 = j.n0; return; } u -= U_OUT;
        const int e = u / (U_GU + U_DN), r = u - e * (U_GU + U_DN);
        if (r < U_GU) { j.src = p.w_gate_up + (size_t)e * D * 4096; j.ldsrc = 4096; j.kind = 2; j.dst = (bf16_t*)(p.ws + O_WGU + (size_t)e * 4096 * D + (size_t)r * 16384); j.k0 = (r & 15) * 128; j.n0 = (r >> 4) * 128; }
        else { const int r2 = r - U_GU; j.src = p.w_down + (size_t)e * D * D; j.ldsrc = D; j.kind = 0; j.dst = (bf16_t*)(p.ws + O_WDN + (size_t)e * D * D + (size_t)r2 * 16384); j.k0 = (r2 & 15) * 128; j.n0 = (r2 >> 4) * 128; }
        j.lddst = 128; j.dk0 = 0; j.dn0 = 0;
    };
    TrJob cur, nxt; f32x4 v[8];
    int u;
    for (int rp_ = 0; rp_ < ((PREP_REP & 2) ? 2 : 1); ++rp_) {
    u = blockIdx.x;
    if (u < NTR) { setup(cur, u); tr_load(cur, v, t); }
#pragma unroll 1
    for (; u < NTR; u += G) {
        __syncthreads();
        tr_lds_write(v, tile, t);
        __syncthreads();
        const bool more = u + G < NTR;
        if (more) { setup(nxt, u + G); tr_load(nxt, v, t); }
        tr_store(cur, tile, t);
        cur = nxt;
    }
    }
    auto clampu = [&](int x) { return x < NTR8 ? x : NTR8 - 1; };
    for (int rp_ = 0; rp_ < ((PREP_REP & 4) ? 2 : 1); ++rp_) {
    u = blockIdx.x;
    f32x4 v2[8]; float ok1, ok2;
    setup8(cur, clampu(u)); ok1 = tr8_load(cur, v, t);
    setup8(nxt, clampu(u + G)); ok2 = tr8_load(nxt, v2, t);
#pragma unroll 1
    for (; u < NTR8; u += 2 * G) {
        __syncthreads();
        tr8_lds_write(v, ok1, tile, t);
        __syncthreads();
        TrJob c = cur;
        setup8(cur, clampu(u + 2 * G)); ok1 = tr8_load(cur, v, t);
        tr8_store(c, tile, t);
        __syncthreads();
        tr8_lds_write(v2, ok2, tile, t);
        __syncthreads();
        c = nxt;
        setup8(nxt, clampu(u + 3 * G)); ok2 = tr8_load(nxt, v2, t);
        tr8_store(c, tile, t);
    }
    }
#if PREP_PROBE_MODE >= 2
    {
        unsigned chk = 0; unsigned char* dummy = (unsigned char*)(p.ws + O_HS);
        constexpr int U0 = U_WIN + U_BRB + U_OUT;
        TrJob pj, pn; f32x4 w[8]; float okp;
        int uu = U0 + blockIdx.x;
        setup8(pj, uu); okp = tr8_load(pj, w, t);
#pragma unroll 1
        for (; uu < NTR8; uu += G) {
#if PREP_PROBE_MODE == 2
            __syncthreads();
            tr8_lds_write(w, okp, tile, t);
            __syncthreads();
            setup8(pn, clampu(uu + G)); okp = tr8_load(pn, w, t);
            {   const int kc = t & 7, nb = t >> 3; constexpr float SC = pg8::W8_SCALE;
#pragma unroll
                for (int ps = 0; ps < 2; ++ps) { const int nn = nb + 64 * ps; const float* s = tile + (16 * kc) * 129 + nn;
                    chk ^= pg8::fp8x4(s[0] * SC, s[129] * SC, s[2 * 129] * SC, s[3 * 129] * SC) ^ pg8::fp8x4(s[4 * 129] * SC, s[5 * 129] * SC, s[6 * 129] * SC, s[7 * 129] * SC)
                         ^ pg8::fp8x4(s[8 * 129] * SC, s[9 * 129] * SC, s[10 * 129] * SC, s[11 * 129] * SC) ^ pg8::fp8x4(s[12 * 129] * SC, s[13 * 129] * SC, s[14 * 129] * SC, s[15 * 129] * SC); } }
            pj = pn;
#else
            u32x4 o0 = {pg8::fp8x4(w[0][0], w[0][1], w[0][2], w[0][3]), pg8::fp8x4(w[1][0], w[1][1], w[1][2], w[1][3]), pg8::fp8x4(w[2][0], w[2][1], w[2][2], w[2][3]), pg8::fp8x4(w[3][0], w[3][1], w[3][2], w[3][3])};
            u32x4 o1 = {pg8::fp8x4(w[4][0], w[4][1], w[4][2], w[4][3]), pg8::fp8x4(w[5][0], w[5][1], w[5][2], w[5][3]), pg8::fp8x4(w[6][0], w[6][1], w[6][2], w[6][3]), pg8::fp8x4(w[7][0], w[7][1], w[7][2], w[7][3])};
            setup8(pn, clampu(uu + G)); okp = tr8_load(pn, w, t);
            u32x4* dp = (u32x4*)(dummy + ((size_t)(uu - U0) * 512 + t) * 32); dp[0] = o0; dp[1] = o1;
            pj = pn;
#endif
        }
        if (chk == 0x12345678u && okp == 3.f) ((unsigned*)(p.ws + 115200))[0] = chk;
    }
#endif
#if PREP_PROBE_WC > 0
    {
        constexpr int WC = PREP_PROBE_WC, RW = WC / 4, RS = 512 / RW, R = 16384 / WC;
        float acc = 0.f; const int c4 = t % RW, r0 = t / RW;
#pragma unroll 1
        for (int pass = 0; pass < 2; ++pass) {
            const float* base = pass ? p.w_down : p.w_gate_up; const int ld = pass ? 2048 : 4096;
            const int nK = 65536 / R, ntiles = nK * (ld / WC);
#pragma unroll 1
            for (int uu = blockIdx.x; uu < ntiles; uu += G) {
#if PREP_PROBE_NFAST
                const int nN = ld / WC, nt_ = uu % nN, kt = uu / nN;
#else
                const int kt = uu % nK, nt_ = uu / nK;
#endif
                f32x4 w[8];
#pragma unroll
                for (int q = 0; q < 8; ++q) w[q] = __builtin_nontemporal_load((const f32x4*)(base + (size_t)(kt * R + r0 + RS * q) * ld + nt_ * WC + 4 * c4));
#pragma unroll
                for (int q = 0; q < 8; ++q) acc += (w[q][0] + w[q][1]) + (w[q][2] + w[q][3]);
            }
        }
        if (acc == 12345.678f) ((float*)(p.ws + 115200))[0] = acc;
    }
#endif
}

DI void phase_h1(const Params& p) {
    const int tz_ = tid_fresh(); const int lane = tz_ & 63, wid = __builtin_amdgcn_readfirstlane(tz_ >> 6);
    if (blockIdx.x == 0) { float a = 0.f; const float* cbp = (const float*)(p.ws + O_CBP);
        for (int sg = 0; sg < 64; ++sg) a += cbp[sg * 512 + tz_];
        ((float*)(p.ws + O_CBIAS))[tz_] = a; }
    bf16_t* H = (bf16_t*)(p.ws + O_H); float* rope = (float*)(p.ws + O_ROPE);
    f32x4 hca[8], hcb[8]; int hb = -1;
    for (int tok = blockIdx.x * 8 + wid; tok < NT; tok += gridDim.x * 8) {
        const int b = tok >> 13;
        if (b != hb) { hb = b;
#pragma unroll
            for (int i = 0; i < 8; ++i) { const int col = 4 * (lane + 64 * i); const float* mb = (const float*)(p.ws + O_MODACC) + b * 12288;
                const f32x4 g = *(const f32x4*)(p.g_pre_mix + col), sc = *(const f32x4*)(mb + 2048 + col), sh = *(const f32x4*)(mb + col);
                hca[i] = g * (1.f + sc); hcb[i] = sh; } }
        const f32x4* xr = (const f32x4*)(p.x + (size_t)tok * D) + lane;
        f32x4 v[8]; float ss = 0.f;
#pragma unroll
        for (int i = 0; i < 8; ++i) { v[i] = __builtin_nontemporal_load(xr + 64 * i); ss += v[i][0] * v[i][0] + v[i][1] * v[i][1] + v[i][2] * v[i][2] + v[i][3] * v[i][3]; }
        const float rs = rsqrtf(wave_sum(ss) * (1.f / D) + NORM_EPS);
#pragma unroll
        for (int i = 0; i < 8; ++i) { const int col = 4 * (lane + 64 * i); float o[4];
#pragma unroll
            for (int j = 0; j < 4; ++j) o[j] = v[i][j] * rs * hca[i][j] + hcb[i][j];
            *(u32x2*)(H + (size_t)tok * D + col) = (u32x2){pk2(o[0], o[1]), pk2(o[2], o[3])};
            *(unsigned*)((unsigned char*)(p.ws + O_H8) + (size_t)tok * D + col) = pg8::fp8x4(o[0], o[1], o[2], o[3]); }
        if (lane < 24) { const float fr = lane < 16 ? (float)(2 * lane) * (1.f / 32.f) : (float)(2 * (lane - 16)) * (1.f / 16.f);
            const float inv = exp2f(-fr * 18.931568569324174f);
            const float ang = (float)p.pos[tok] * inv; float s, c; sincosf(ang, &s, &c);
            rope[(size_t)tok * 48 + 2 * lane] = c; rope[(size_t)tok * 48 + 2 * lane + 1] = s; }
    }
}

DI void phase_zpost(const Params& p) {
    const int tz_ = tid_fresh(); const int lane = tz_ & 63, wid = __builtin_amdgcn_readfirstlane(tz_ >> 6);
    const bf16_t* Z = (const bf16_t*)(p.ws + O_Z); const float* rope = (const float*)(p.ws + O_ROPE);
    bf16_t* cqn = (bf16_t*)(p.ws + O_CQN); bf16_t* kvt = (bf16_t*)(p.ws + O_KVT); bf16_t* kidx = (bf16_t*)(p.ws + O_KIDX);
    float* widx = (float*)(p.ws + O_WIDX); float* gates = (float*)(p.ws + O_GATES); bf16_t* bq = (bf16_t*)(p.ws + O_BQ); bf16_t* kvs = (bf16_t*)(p.ws + O_KVS);
    const f32x4 gq0 = *(const f32x4*)(p.a_cq_norm + lane * 8), gq1 = *(const f32x4*)(p.a_cq_norm + lane * 8 + 4), gkv = *(const f32x4*)(p.a_ckv_norm + lane * 4);
    const float ig = p.idx_g[lane], ibs = p.idx_b[lane];
    const int part = lane & 7;
    for (int tok = blockIdx.x * 8 + wid; tok < NT; tok += gridDim.x * 8) {
        const int b = tok >> 13, tq = tok & (T - 1);
        const bf16_t* zr = Z + (size_t)tok * ZC; const float* rt = rope + (size_t)tok * 48;
        const u32x4 rcq = __builtin_nontemporal_load((const u32x4*)(zr + lane * 8));
        const u32x2 rkv = __builtin_nontemporal_load((const u32x2*)(zr + ZC_CKV + lane * 4));
        const bf16_t rki = zr[ZC_KIDX + lane], rk1 = zr[ZC_KROPE + (lane & 15)], rk2 = zr[ZC_KROPE + 16 + (lane & 15)], rwi = zr[ZC_WIDX + (lane & 7)], rbg = zr[ZC_BGATE + (lane < 24 ? lane : 0)];
        bf16_t* rp_; { const int r = lane < 28 ? lane : 27, hr = r >> 1, pt = r & 1;
            if (hr < 8) rp_ = bq + (size_t)tok * 1024 + hr * 128 + pt * 16;
            else { const int kk = hr - 8, i6 = 2 * (kk >> 1), g = kk & 1; rp_ = kvs + ((((size_t)i6 * NB + b) * 2 + g) * T + tq) * 128 + pt * 16; } }
        const u32x4 rh0 = *(const u32x4*)rp_, rh1 = *(const u32x4*)(rp_ + 8);
        f32x4 rr[8];
#pragma unroll
        for (int i = 0; i < 8; ++i) rr[i] = *(const f32x4*)(rt + 4 * i);
        const float ric = rt[32 + 2 * (lane & 7)], ris = rt[33 + 2 * (lane & 7)], rkc = rt[2 * (lane & 15)], rks = rt[2 * (lane & 15) + 1];
        {
            float f[8]; unpack8(rcq, f); float ss = 0.f;
#pragma unroll
            for (int j = 0; j < 8; ++j) ss += f[j] * f[j];
            const float rs = rsqrtf(wave_sum(ss) * (1.f / 512.f) + NORM_EPS);
#pragma unroll
            for (int j = 0; j < 4; ++j) { f[j] = f[j] * rs * gq0[j]; f[4 + j] = f[4 + j] * rs * gq1[j]; }
            *(u32x4*)(cqn + (size_t)tok * 512 + lane * 8) = (u32x4){pk2(f[0], f[1]), pk2(f[2], f[3]), pk2(f[4], f[5]), pk2(f[6], f[7])};
        }
        {
            float f[4] = {bflo(rkv[0]), bfhi(rkv[0]), bflo(rkv[1]), bfhi(rkv[1])};
            const float rs = rsqrtf(wave_sum(f[0] * f[0] + f[1] * f[1] + f[2] * f[2] + f[3] * f[3]) * (1.f / 256.f) + NORM_EPS);
#pragma unroll
            for (int j = 0; j < 4; ++j) f[j] = f[j] * rs * gkv[j];
            *(u32x2*)(kvt + (size_t)tok * KVW + lane * 4) = (u32x2){pk2(f[0], f[1]), pk2(f[2], f[3])};
        }
        if (lane < 16) {
            const float x1 = bf2f(rk1), x2 = bf2f(rk2);
            kvt[(size_t)tok * KVW + 256 + lane] = f2bf(x1 * rkc - x2 * rks); kvt[(size_t)tok * KVW + 272 + lane] = f2bf(x2 * rkc + x1 * rks);
        }
        {
            const float v = bf2f(rki); const float mean = wave_sum(v) * (1.f / 64.f); const float xc = v - mean;
            const float var = wave_sum(xc * xc) * (1.f / 64.f);
            const float y = xc * rsqrtf(var + NORM_EPS) * ig + ibs;
            const float pr = __shfl_xor(y, 8); float o = y;
            if (lane < 8) o = y * ric - pr * ris;
            else if (lane < 16) o = y * ric + pr * ris;
            kidx[(size_t)tok * 64 + lane] = f2bf(o);
        }
        if (lane < 8) widx[(size_t)tok * 8 + lane] = bf2f(rwi) * (0.35355339059327373f * 0.125f);
        if (lane < 24) gates[(size_t)tok * 24 + lane] = sigmoidf_(bf2f(rbg));
        {
            float f[16]; { float a[8], c[8]; unpack8(rh0, a); unpack8(rh1, c);
#pragma unroll
                for (int j = 0; j < 8; ++j) { f[j] = a[j]; f[8 + j] = c[j]; } }
            const int pt = lane & 1;
#pragma unroll
            for (int i = 0; i < 16; ++i) { const float g = __shfl_xor(f[i], 1); const float c = rr[(2 * i) >> 2][(2 * i) & 3], s = rr[(2 * i + 1) >> 2][(2 * i + 1) & 3];
                f[i] = pt == 0 ? f[i] * c - g * s : f[i] * c + g * s; }
            if (lane < 28) {
                *(u32x4*)rp_ = (u32x4){pk2(f[0], f[1]), pk2(f[2], f[3]), pk2(f[4], f[5]), pk2(f[6], f[7])};
                *(u32x4*)(rp_ + 8) = (u32x4){pk2(f[8], f[9]), pk2(f[10], f[11]), pk2(f[12], f[13]), pk2(f[14], f[15])}; } }
    }
}

DI void c2_rows(const Params& p, char* smem) {
    const int tz_ = tid_fresh(); const int lane = tz_ & 63, wid = __builtin_amdgcn_readfirstlane(tz_ >> 6);
    float* hrow = (float*)smem + wid * 256;
    float* w2s = (float*)(smem + 8192);
    const float* c1p = (const float*)(p.ws + O_C1P); const float* cb = (const float*)(p.ws + O_CBIAS); bf16_t* kcvc = (bf16_t*)(p.ws + O_KCVC);
    for (int row0 = blockIdx.x * 8; row0 < 4096; row0 += gridDim.x * 8) {
        const int row = row0 + wid;
        const int kv = row >> 11, r = row & 2047, n = r & 511;
        {   const float* w2g = kv ? p.cmp_v_w2 : p.cmp_k_w2;
            __syncthreads();
#pragma unroll
            for (int i = 0; i < 16; ++i) *(f32x4*)(w2s + 4 * (tz_ + 512 * i)) = *(const f32x4*)(w2g + 4 * (tz_ + 512 * i));
            __syncthreads(); }
        f32x4 a = *(const f32x4*)(cb + kv * 256 + lane * 4);
#pragma unroll
        for (int s = 0; s < pg8::C1_SPLIT; ++s) a += *(const f32x4*)(c1p + ((size_t)(s * 2 + kv) * 2048 + r) * 256 + lane * 4);
#pragma unroll
        for (int j = 0; j < 4; ++j) { const float v = a[j]; const float u = 0.7978845608028654f * (v + 0.044715f * v * v * v); hrow[lane * 4 + j] = 0.5f * v * (1.f + tanhf(u)); }
        asm volatile("s_waitcnt lgkmcnt(0)" ::: "memory");
        float o0 = 0.f, o1 = 0.f;
#pragma unroll 16
        for (int j = 0; j < 256; ++j) { const float hv = hrow[j]; const float2 w = *(const float2*)(w2s + j * 128 + lane * 2); o0 += hv * w.x; o1 += hv * w.y; }
        if (n == 511) { o0 = 0.f; o1 = 0.f; }
        *(unsigned*)(kcvc + (size_t)row * 128 + lane * 2) = pk2(o0, o1);
        asm volatile("s_waitcnt lgkmcnt(0)" ::: "memory");
    }
}

DI unsigned short f16key(float v) { const _Float16 h = (_Float16)v; unsigned short u = __builtin_bit_cast(unsigned short, h); return (u & 0x8000u) ? (unsigned short)~u : (unsigned short)(u | 0x8000u); }
DI void topk256_select(const LAS unsigned* scw, int nk, unsigned short* out, int lane) {
    const int nw = (nk + 127) >> 7;
    auto ldk = [&](int i) -> unsigned { const int wi = i * 64 + lane; unsigned v = scw[wi]; if (2 * wi >= nk) v = 0u; else if (2 * wi + 1 >= nk) v &= 0xffffu; return v; };
    unsigned Tv = 0u;
    for (int bit = 15; bit >= 0; --bit) { const unsigned cand = Tv | (1u << bit); int cnt = 0;
#pragma unroll 4
        for (int i = 0; i < nw; ++i) { const unsigned kv = ldk(i); cnt += __popcll(__ballot((kv & 0xffffu) >= cand)) + __popcll(__ballot((kv >> 16) >= cand)); }
        if (cnt >= 256) Tv = cand; }
    int cgt = 0;
#pragma unroll 4
    for (int i = 0; i < nw; ++i) { const unsigned kv = ldk(i); cgt += __popcll(__ballot((kv & 0xffffu) > Tv)) + __popcll(__ballot((kv >> 16) > Tv)); }
    const int need = 256 - cgt; int pos = 0, eqc = 0;
    const unsigned long long ltm = (1ull << lane) - 1ull;
#pragma unroll 2
    for (int i = 0; i < nw; ++i) {
        const unsigned kv = ldk(i); const unsigned lo = kv & 0xffffu, hi = kv >> 16;
        const bool elo = lo == Tv, ehi = hi == Tv;
        const unsigned long long mlo = __ballot(elo), mhi = __ballot(ehi);
        const int below = __popcll(mlo & ltm) + __popcll(mhi & ltm);
        const bool slo = lo > Tv || (elo && eqc + below < need), shi = hi > Tv || (ehi && eqc + below + (elo ? 1 : 0) < need);
        const unsigned long long s0 = __ballot(slo), s1 = __ballot(shi);
        const int plo = pos + __popcll(s0 & ltm), phi = pos + __popcll(s0) + __popcll(s1 & ltm);
        const int kidx = 2 * (i * 64 + lane);
        if (slo) out[plo] = (unsigned short)kidx;
        if (shi) out[phi] = (unsigned short)(kidx + 1);
        pos += __popcll(s0) + __popcll(s1); eqc += __popcll(mlo) + __popcll(mhi); }
}
DI void phase_indexer(const Params& p, char* smem) {
    const int tz_ = tid_fresh(); const int lane = tz_ & 63, wid = __builtin_amdgcn_readfirstlane(tz_ >> 6);
    LAS unsigned short* sc = (LAS unsigned short*)(LAS char*)smem + wid * 8192;
    float* qf = (float*)(smem + 131072) + wid * 512;
    const bf16_t* Q = (const bf16_t*)(p.ws + O_QALL); const bf16_t* KI = (const bf16_t*)(p.ws + O_KIDX); const float* WI = (const float*)(p.ws + O_WIDX);
    unsigned short* SEL = (unsigned short*)(p.ws + O_SEL); int* NSEL = (int*)(p.ws + O_NSEL);
    for (int tok = (int)(NT / 8 - 1 - blockIdx.x) * 8 + wid; tok >= 0; tok -= gridDim.x * 8) {
        const int b = tok >> 13, tq = tok & (T - 1), nk = tq + 1;
        unsigned short* out = SEL + (size_t)tok * 256;
        if (nk <= 256) { for (int i = lane; i < 256; i += 64) out[i] = (unsigned short)(i < nk ? i : 0); if (lane == 0) NSEL[tok] = nk; continue; }
        { float f[8]; unpack8(*(const u32x4*)(Q + (size_t)tok * QC + 2304 + lane * 8), f);
#pragma unroll
          for (int j = 0; j < 8; ++j) qf[lane * 8 + j] = f[j]; }
        float wh[8];
#pragma unroll
        for (int h = 0; h < 8; ++h) wh[h] = WI[(size_t)tok * 8 + h];
        asm volatile("s_waitcnt lgkmcnt(0)" ::: "memory");
        for (int s = lane; s < nk; s += 64) {
            const bf16_t* kr = KI + ((size_t)b * T + s) * 64; float d[8];
#pragma unroll
            for (int h = 0; h < 8; ++h) d[h] = 0.f;
#pragma unroll 2
            for (int c = 0; c < 8; ++c) { float kf[8]; unpack8(*(const u32x4*)(kr + c * 8), kf);
#pragma unroll
                for (int h = 0; h < 8; ++h) { const f32x4 q0 = *(const f32x4*)(qf + h * 64 + c * 8), q1 = *(const f32x4*)(qf + h * 64 + c * 8 + 4);
                    d[h] += q0[0] * kf[0] + q0[1] * kf[1] + q0[2] * kf[2] + q0[3] * kf[3] + q1[0] * kf[4] + q1[1] * kf[5] + q1[2] * kf[6] + q1[3] * kf[7]; } }
            float score = 0.f;
#pragma unroll
            for (int h = 0; h < 8; ++h) score += wh[h] * fmaxf(d[h], 0.f);
            sc[s] = f16key(score); }
        asm volatile("s_waitcnt lgkmcnt(0)" ::: "memory");
        topk256_select((const LAS unsigned*)sc, nk, out, lane);
        if (lane == 0) NSEL[tok] = 256;
        asm volatile("s_waitcnt lgkmcnt(0)" ::: "memory");
    }
}

DI void phase_mla(const Params& p, char* smem) {
    const int tz_ = tid_fresh(); const int lane = tz_ & 63, wid = __builtin_amdgcn_readfirstlane(tz_ >> 6);
    float* qf = (float*)smem + wid * (8 * KVW + 8 * 256 + 128);
    float* pf = qf + 8 * KVW; unsigned short* selw = (unsigned short*)(pf + 8 * 256);
    const bf16_t* Q = (const bf16_t*)(p.ws + O_QALL); const bf16_t* KV = (const bf16_t*)(p.ws + O_KVT);
    const unsigned short* SEL = (const unsigned short*)(p.ws + O_SEL); const int* NSEL = (const int*)(p.ws + O_NSEL); bf16_t* OL = (bf16_t*)(p.ws + O_OLAT);
    for (int tok = blockIdx.x * 8 + wid; tok < NT; tok += gridDim.x * 8) {
        const int b = tok >> 13; const int cnt = NSEL[tok];
        const bf16_t* qr = Q + (size_t)tok * QC;
#pragma unroll 4
        for (int i = 0; i < 36; ++i) { const int e = lane + 64 * i;
            const int h = e / KVW, d = e - h * KVW; qf[e] = bf2f(d < 256 ? qr[h * 256 + d] : qr[2048 + h * 32 + (d - 256)]); }
        *(u32x2*)(selw + lane * 4) = *(const u32x2*)(SEL + (size_t)tok * 256 + lane * 4);
        asm volatile("s_waitcnt lgkmcnt(0)" ::: "memory");
        const bf16_t* rows[4];
#pragma unroll
        for (int j = 0; j < 4; ++j) { const int k = lane + 64 * j; const int idx = k < cnt ? selw[k] : 0; rows[j] = KV + ((size_t)b * T + idx) * KVW; }
        float acc[4][8];
#pragma unroll
        for (int j = 0; j < 4; ++j)
#pragma unroll
            for (int h = 0; h < 8; ++h) acc[j][h] = 0.f;
#pragma unroll 1
        for (int c = 0; c < 36; ++c) { float kf[4][8];
#pragma unroll
            for (int j = 0; j < 4; ++j) unpack8(*(const u32x4*)(rows[j] + c * 8), kf[j]);
#pragma unroll
            for (int h = 0; h < 8; ++h) { const f32x4 q0 = *(const f32x4*)(qf + h * KVW + c * 8), q1 = *(const f32x4*)(qf + h * KVW + c * 8 + 4);
#pragma unroll
                for (int j = 0; j < 4; ++j) acc[j][h] += q0[0] * kf[j][0] + q0[1] * kf[j][1] + q0[2] * kf[j][2] + q0[3] * kf[j][3] + q1[0] * kf[j][4] + q1[1] * kf[j][5] + q1[2] * kf[j][6] + q1[3] * kf[j][7]; } }
#pragma unroll
        for (int h = 0; h < 8; ++h) { float m = -INFINITY;
#pragma unroll
            for (int j = 0; j < 4; ++j) { acc[j][h] = (lane + 64 * j < cnt) ? acc[j][h] * ATT_SCALE : -INFINITY; m = fmaxf(m, acc[j][h]); }
            m = wave_max(m); float l = 0.f;
#pragma unroll
            for (int j = 0; j < 4; ++j) { acc[j][h] = (lane + 64 * j < cnt) ? __expf(acc[j][h] - m) : 0.f; l += acc[j][h]; }
            l = 1.f / fmaxf(wave_sum(l), 1e-30f);
#pragma unroll
            for (int j = 0; j < 4; ++j) pf[h * 256 + lane + 64 * j] = acc[j][h] * l; }
        asm volatile("s_waitcnt lgkmcnt(0)" ::: "memory");
        float o[8][4];
#pragma unroll
        for (int h = 0; h < 8; ++h)
#pragma unroll
            for (int j = 0; j < 4; ++j) o[h][j] = 0.f;
#pragma unroll 1
        for (int k0 = 0; k0 < 256; k0 += 8) { u32x2 vv[8];
#pragma unroll
            for (int kk = 0; kk < 8; ++kk) { const int k = k0 + kk; const int idx = k < cnt ? selw[k] : 0; vv[kk] = *(const u32x2*)(KV + ((size_t)b * T + idx) * KVW + lane * 4); }
#pragma unroll
            for (int kk = 0; kk < 8; ++kk) { const float v0 = bflo(vv[kk][0]), v1 = bfhi(vv[kk][0]), v2 = bflo(vv[kk][1]), v3 = bfhi(vv[kk][1]);
#pragma unroll
                for (int h = 0; h < 8; ++h) { const float ph = pf[h * 256 + k0 + kk]; o[h][0] += ph * v0; o[h][1] += ph * v1; o[h][2] += ph * v2; o[h][3] += ph * v3; } } }
#pragma unroll
        for (int h = 0; h < 8; ++h) *(u32x2*)(OL + (size_t)tok * D + h * 256 + lane * 4) = (u32x2){pk2(o[h][0], o[h][1]), pk2(o[h][2], o[h][3])};
        asm volatile("s_waitcnt lgkmcnt(0)" ::: "memory");
    }
}

DI void nsa_score(const bf16_t* kr, const float* qf, float (&s)[4]) {
#pragma unroll
    for (int j = 0; j < 4; ++j) s[j] = 0.f;
#pragma unroll 4
    for (int c = 0; c < 16; ++c) { float kf[8]; unpack8(*(const u32x4*)(kr + c * 8), kf);
#pragma unroll
        for (int j = 0; j < 4; ++j) { const f32x4 q0 = *(const f32x4*)(qf + j * 128 + c * 8), q1 = *(const f32x4*)(qf + j * 128 + c * 8 + 4);
            s[j] += q0[0] * kf[0] + q0[1] * kf[1] + q0[2] * kf[2] + q0[3] * kf[3] + q1[0] * kf[4] + q1[1] * kf[5] + q1[2] * kf[6] + q1[3] * kf[7]; } }
}
DI void phase_nsa(const Params& p, char* smem) {
    const int tz_ = tid_fresh(); const int lane = tz_ & 63, wid = __builtin_amdgcn_readfirstlane(tz_ >> 6);
    float* qf = (float*)smem + wid * (512 + 256 + 512 + 16); float* pb = qf + 512; float* psum = pb + 256; int* blk = (int*)(psum + 512);
    const bf16_t* BQ = (const bf16_t*)(p.ws + O_BQ); const bf16_t* kvs = (const bf16_t*)(p.ws + O_KVS); const bf16_t* kcvc = (const bf16_t*)(p.ws + O_KCVC);
    const float* gates = (const float*)(p.ws + O_GATES); bf16_t* OB = (bf16_t*)(p.ws + O_OB);
#pragma unroll 1
    for (int item = (NT * 2 / 8 - 1 - (int)blockIdx.x) * 8 + wid; item >= 0; item -= gridDim.x * 8) {
        const int tok = item >> 1, g = item & 1, b = tok >> 13, tq = tok & (T - 1);
        { float f[8]; unpack8(*(const u32x4*)(BQ + (size_t)tok * 1024 + g * 512 + lane * 8), f);
#pragma unroll
          for (int j = 0; j < 8; ++j) qf[lane * 8 + j] = f[j]; }
        asm volatile("s_waitcnt lgkmcnt(0)" ::: "memory");
        const size_t bg = (size_t)(b * 2 + g);
        const int nmax = tq >= 31 ? (tq - 31) >> 4 : -1;
        float res[4][2], o[4][2], m[4], l[4]; int ns = 0;
#pragma unroll
        for (int j = 0; j < 4; ++j) { res[j][0] = 0.f; res[j][1] = 0.f; }
#pragma unroll 1
        for (int step = 0; step < 4; ++step) {
            const int kind = step < 2 ? 0 : step - 1;
            const int mode = step == 0 ? 1 : (step == 1 ? 2 : 0);
            const bf16_t* kbase; const bf16_t* vbase; int nch;
            if (kind == 0) { kbase = kcvc + bg * 512 * 128; vbase = kcvc + (size_t)2048 * 128 + bg * 512 * 128; nch = 8; }
            else if (kind == 1) { kbase = kvs + (2 * (size_t)NB * 2 + bg) * T * 128; vbase = kvs + (3 * (size_t)NB * 2 + bg) * T * 128; nch = ns; }
            else { kbase = kvs + (4 * (size_t)NB * 2 + bg) * T * 128; vbase = kvs + (5 * (size_t)NB * 2 + bg) * T * 128; nch = 8; }
            if (mode != 2) {
#pragma unroll
                for (int j = 0; j < 4; ++j) { m[j] = -INFINITY; l[j] = 0.f; } }
#pragma unroll
            for (int j = 0; j < 4; ++j) { o[j][0] = 0.f; o[j][1] = 0.f; }
#pragma unroll 1
            for (int c = 0; c < nch; ++c) {
                int base, lim_lo, lim_hi;
                if (kind == 0) { base = 64 * c; lim_lo = 0; lim_hi = nmax; }
                else if (kind == 1) { base = blk[c] * 64; lim_lo = 0; lim_hi = tq; }
                else { base = tq - 511 + 64 * c; lim_lo = 0; lim_hi = tq; }
                const bool active = base <= lim_hi && base + 63 >= lim_lo;
                if (!active) { if (mode == 2) psum[c * 64 + lane] = 0.f; continue; }
                const int key = base + lane; const bool valid = key >= lim_lo && key <= lim_hi;
                float s[4]; nsa_score(kbase + (size_t)(key < 0 ? 0 : key) * 128, qf, s);
                float ps = 0.f;
#pragma unroll
                for (int j = 0; j < 4; ++j) {
                    const float sv = valid ? s[j] * ATT_SCALE : -INFINITY; float pj;
                    if (mode == 2) { pj = valid ? __expf(sv - m[j]) * l[j] : 0.f; ps += pj; }
                    else { const float mn = fmaxf(m[j], wave_max(sv));
                        const float alpha = (m[j] == -INFINITY) ? 0.f : __expf(m[j] - mn);
                        pj = (sv == -INFINITY) ? 0.f : __expf(sv - mn);
                        l[j] = l[j] * alpha + wave_sum(pj); m[j] = mn; o[j][0] *= alpha; o[j][1] *= alpha; }
                    pb[j * 64 + lane] = pj; }
                if (mode == 2) psum[c * 64 + lane] = ps;
                if (mode != 1) {
                    asm volatile("s_waitcnt lgkmcnt(0)" ::: "memory");
#pragma unroll 1
                    for (int k0 = 0; k0 < 64; k0 += 8) { unsigned vv[8];
#pragma unroll
                        for (int kk = 0; kk < 8; ++kk) { const int kx = base + k0 + kk; vv[kk] = *(const unsigned*)(vbase + (size_t)(kx < 0 ? 0 : kx) * 128 + lane * 2); }
#pragma unroll
                        for (int kk = 0; kk < 8; ++kk) { const float v0 = bflo(vv[kk]), v1 = bfhi(vv[kk]);
#pragma unroll
                            for (int j = 0; j < 4; ++j) { const float ph = pb[j * 64 + k0 + kk]; o[j][0] += ph * v0; o[j][1] += ph * v1; } } } }
                asm volatile("s_waitcnt lgkmcnt(0)" ::: "memory");
            }
            if (step == 0) {
#pragma unroll
                for (int j = 0; j < 4; ++j) { if (m[j] == -INFINITY) m[j] = 0.f; l[j] = 1.f / fmaxf(l[j], 1e-30f); }
                continue; }
#pragma unroll
            for (int j = 0; j < 4; ++j) { const float gt = gates[(size_t)tok * 24 + (g * 4 + j) * 3 + kind]; const float il = (mode == 2) ? gt : gt / fmaxf(l[j], 1e-30f);
                res[j][0] += il * o[j][0]; res[j][1] += il * o[j][1]; }
            if (step == 1) {
                asm volatile("s_waitcnt lgkmcnt(0)" ::: "memory");
                const int cur = tq >> 6; unsigned key[2];
#pragma unroll
                for (int hh = 0; hh < 2; ++hh) { const int mb = lane + 64 * hh; float imp = 0.f;
#pragma unroll
                    for (int d = -1; d < 4; ++d) { const int n = 4 * mb + d; if (n >= 0 && n < 512) imp += psum[n]; }
                    const bool adm = mb <= cur, forced = mb == 0 || mb == cur || mb == cur - 1;
                    key[hh] = !adm ? 0u : (forced ? (0xFF000000u | (unsigned)(127 - mb)) : ((((__float_as_uint(imp) >> 7) + 1u) << 7) | (unsigned)(127 - mb))); }
                unsigned Tv = 0u;
                for (int bit = 31; bit >= 0; --bit) { const unsigned cand = Tv | (1u << bit);
                    const int cnt = __popcll(__ballot(key[0] >= cand)) + __popcll(__ballot(key[1] >= cand)); if (cnt >= 16) Tv = cand; }
                if (Tv == 0u) Tv = 1u;
                const unsigned long long m0 = __ballot(key[0] >= Tv), m1 = __ballot(key[1] >= Tv);
                const unsigned long long ltm = (1ull << lane) - 1ull;
                if (key[0] >= Tv) blk[__popcll(m0 & ltm)] = lane;
                if (key[1] >= Tv) blk[__popcll(m0) + __popcll(m1 & ltm)] = lane + 64;
                ns = __popcll(m0) + __popcll(m1);
                asm volatile("s_waitcnt lgkmcnt(0)" ::: "memory"); }
        }
#pragma unroll
        for (int j = 0; j < 4; ++j) *(unsigned*)(OB + (size_t)tok * 1024 + (g * 4 + j) * 128 + lane * 2) = pk2(res[j][0], res[j][1]);
        asm volatile("s_waitcnt lgkmcnt(0)" ::: "memory");
    }
}

typedef float f32x16 __attribute__((ext_vector_type(16)));
typedef short s16x4 __attribute__((ext_vector_type(4)));
#define MFMA32(a, b, c) __builtin_amdgcn_mfma_f32_32x32x16_bf16((a), (b), (c), 0, 0, 0)
DI unsigned offb(unsigned row, unsigned ch) { return 256u * row + 16u * (ch ^ (((row & 3u) << 2) | ((row >> 2) & 3u))); }
DI unsigned cvt2(float a, float b) { typedef __bf16 b2 __attribute__((ext_vector_type(2))); typedef float f2 __attribute__((ext_vector_type(2))); const b2 r = __builtin_convertvector((f2){a, b}, b2); return __builtin_bit_cast(unsigned, r); }
DI bf16x8 pack_relu(const f32x16& x, int s) {
    u32x4 w = {cvt2(x[8 * s], x[8 * s + 1]), cvt2(x[8 * s + 2], x[8 * s + 3]), cvt2(x[8 * s + 4], x[8 * s + 5]), cvt2(x[8 * s + 6], x[8 * s + 7])};
#pragma unroll
    for (int i = 0; i < 4; ++i) { unsigned r; asm volatile("v_pk_max_i16 %0, %1, 0" : "=v"(r) : "v"(w[i])); w[i] = r; }
    return __builtin_bit_cast(bf16x8, w);
}
DI bf16x8 pack_p(const f32x16& x, int s) {
    const u32x4 w = {cvt2(x[8 * s], x[8 * s + 1]), cvt2(x[8 * s + 2], x[8 * s + 3]), cvt2(x[8 * s + 4], x[8 * s + 5]), cvt2(x[8 * s + 6], x[8 * s + 7])};
    return __builtin_bit_cast(bf16x8, w);
}
DI void nsa_tile_dma(LAS char* kb, LAS char* vb, const bf16_t* kt, const bf16_t* vt, int tid, int w) {
#pragma unroll
    for (int i = 0; i < 2; ++i) { const int id = tid + 512 * i; const unsigned row = id >> 4, pos = id & 15; const unsigned ch = pos ^ (((row & 3u) << 2) | ((row >> 2) & 3u));
        const size_t so = (size_t)row * 128 + ch * 8; const unsigned lo = (unsigned)(i * 512 + w * 64) * 16u;
        __builtin_amdgcn_global_load_lds((const unsigned*)(kt + so), (LAS unsigned*)(kb + lo), 16, 0, 0);
        __builtin_amdgcn_global_load_lds((const unsigned*)(vt + so), (LAS unsigned*)(vb + lo), 16, 0, 0); }
}
#define NSA_TR8(R, A, OFF) asm volatile( \
    "ds_read_b64_tr_b16 %0, %8 offset:%16\n\tds_read_b64_tr_b16 %1, %9 offset:%16\n\tds_read_b64_tr_b16 %2, %10 offset:%16\n\tds_read_b64_tr_b16 %3, %11 offset:%16\n\t" \
    "ds_read_b64_tr_b16 %4, %12 offset:%16\n\tds_read_b64_tr_b16 %5, %13 offset:%16\n\tds_read_b64_tr_b16 %6, %14 offset:%16\n\tds_read_b64_tr_b16 %7, %15 offset:%16\n\ts_waitcnt lgkmcnt(0)" \
    : "=&v"(R[0]), "=&v"(R[1]), "=&v"(R[2]), "=&v"(R[3]), "=&v"(R[4]), "=&v"(R[5]), "=&v"(R[6]), "=&v"(R[7]) \
    : "v"(A[0]), "v"(A[1]), "v"(A[2]), "v"(A[3]), "v"(A[4]), "v"(A[5]), "v"(A[6]), "v"(A[7]), "i"(OFF) : "memory")

#define NSA_TR4(R, A0, A1, A2, A3, OFF) asm volatile( \
    "ds_read_b64_tr_b16 %0, %4 offset:%8\n\tds_read_b64_tr_b16 %1, %5 offset:%8\n\tds_read_b64_tr_b16 %2, %6 offset:%8\n\tds_read_b64_tr_b16 %3, %7 offset:%8" \
    : "=&v"(R[0]), "=&v"(R[1]), "=&v"(R[2]), "=&v"(R[3]) : "v"(A0), "v"(A1), "v"(A2), "v"(A3), "i"(OFF) : "memory")
#define NSA_LWAIT(N, R) asm volatile("s_waitcnt lgkmcnt(" #N ")" : "+v"(R[0]), "+v"(R[1]), "+v"(R[2]), "+v"(R[3]) :: "memory")
struct NsaWave {
    float m, l;
    f32x16 O[4];
    bf16x8 q[8];
};
template <int MODE>
DI void nsa_tile_compute(NsaWave& W, unsigned kbuf, unsigned vbuf, const unsigned (&vaddr0)[8], int tq0, int kind, int kbeg, bool needmask, bool rowneed, int lane, LAS float* impA, LAS float* impL, int mblk0) {
    const int c = lane & 31, h = lane >> 5;
    constexpr float C2 = ATT_SCALE * 1.4426950408889634f;
    f32x16 s0, s1;
    const f32x16 zero16 = {0.f, 0.f, 0.f, 0.f, 0.f, 0.f, 0.f, 0.f, 0.f, 0.f, 0.f, 0.f, 0.f, 0.f, 0.f, 0.f};
    const unsigned f = ((c & 3u) << 2) | ((c >> 2) & 3u);
#ifndef NSA_REP_QK
#define NSA_REP_QK 1
#endif
    __builtin_amdgcn_s_setprio(1);
#pragma unroll 1
    for (int rq_ = 0; rq_ < NSA_REP_QK; ++rq_) {
        if (NSA_REP_QK > 1) asm volatile("" ::: "memory");
#pragma unroll
    for (int s = 0; s < 8; ++s) { const unsigned ch = (unsigned)(2 * s + h) ^ f;
        const bf16x8 a0 = *(const LAS bf16x8*)(size_t)(kbuf + 256u * c + 16u * ch), a1 = *(const LAS bf16x8*)(size_t)(kbuf + 8192u + 256u * c + 16u * ch);
        s0 = MFMA32(a0, W.q[s], s == 0 ? zero16 : s0); s1 = MFMA32(a1, W.q[s], s == 0 ? zero16 : s1); } }
    __builtin_amdgcn_s_setprio(0);
    if (needmask) {
        const int tq = tq0 + (c >> 2);
        const int lo = kind == 2 ? tq - 511 : 0, hi = kind == 0 ? (tq >= 31 ? (tq - 31) >> 4 : -1) : tq;
#pragma unroll
        for (int r = 0; r < 16; ++r) { const int k0 = kbeg + (r & 3) + 8 * (r >> 2) + 4 * h, k1 = k0 + 32;
            if (!(k0 >= lo && k0 <= hi)) s0[r] = -INFINITY;
            if (!(k1 >= lo && k1 <= hi)) s1[r] = -INFINITY; }
    }
    if (MODE != 2) {
        float mx = fmaxf(fmaxf(s0[0], s0[1]), s1[0]);
#pragma unroll
        for (int r = 2; r < 16; r += 2) mx = fmaxf(fmaxf(mx, s0[r]), s0[r + 1]);
#pragma unroll
        for (int r = 1; r < 15; r += 2) mx = fmaxf(fmaxf(mx, s1[r]), s1[r + 1]);
        mx = fmaxf(mx, s1[15]);
        mx = fmaxf(mx, __shfl_xor(mx, 32));
        if (!rowneed) mx = -INFINITY;
        const float mn = (W.m == -INFINITY || (mx - W.m) * C2 > 8.f) ? fmaxf(W.m, mx) : W.m;
        const float mu = (mn == -INFINITY) ? 0.f : mn;
        const float alpha = __builtin_amdgcn_exp2f((W.m - mu) * C2);
        const float nb = rowneed ? -mu * C2 : -INFINITY;
        float rs = 0.f;
#pragma unroll
        for (int r = 0; r < 16; ++r) { s0[r] = __builtin_amdgcn_exp2f(__builtin_fmaf(s0[r], C2, nb)); s1[r] = __builtin_amdgcn_exp2f(__builtin_fmaf(s1[r], C2, nb)); rs += s0[r] + s1[r]; }
        rs += __shfl_xor(rs, 32);
        W.l = W.l * alpha + rs; W.m = mn;
        if (MODE == 0 && !__all(alpha == 1.f)) {
#pragma unroll
            for (int d = 0; d < 4; ++d)
#pragma unroll
                for (int r = 0; r < 16; ++r) W.O[d][r] *= alpha; }
    } else {
#pragma unroll
        for (int r = 0; r < 16; ++r) { s0[r] = __builtin_amdgcn_exp2f((s0[r] - W.m) * C2) * W.l; s1[r] = __builtin_amdgcn_exp2f((s1[r] - W.m) * C2) * W.l; }
#pragma unroll
        for (int kb = 0; kb < 2; ++kb)
#pragma unroll
            for (int i = 0; i < 4; ++i) { const f32x16& sv = kb ? s1 : s0;
                float a = sv[4 * i] + sv[4 * i + 1] + sv[4 * i + 2] + sv[4 * i + 3], lv = sv[4 * i + 3];
                a += __shfl_xor(a, 1); a += __shfl_xor(a, 2); lv += __shfl_xor(lv, 1); lv += __shfl_xor(lv, 2);
                if ((c & 3) == 0) { const int mb = mblk0 + 8 * kb + 2 * i + h; impA[(c >> 2) * 128 + mb] = a; impL[(c >> 2) * 128 + mb] = lv; } }
    }
    if (MODE != 1) {
        unsigned vaddrl[8];
        { const unsigned q = (lane & 15) >> 2, pp = lane & 3, blk = (lane >> 4) & 1;
#pragma unroll
          for (int d = 0; d < 4; ++d)
#pragma unroll
              for (int t = 0; t < 2; ++t) vaddrl[2 * d + t] = vbuf + offb(8u * t + 4u * h + q, 4u * d + 2u * blk + (pp >> 1)) + 8u * (pp & 1u); }
        bf16x8 pf[4] = {pack_p(s0, 0), pack_p(s0, 1), pack_p(s1, 0), pack_p(s1, 1)};
        s16x4 RA[4], RB[4];
        asm volatile("s_waitcnt lgkmcnt(0)" ::: "memory");
        NSA_TR4(RA, vaddrl[0], vaddrl[1], vaddrl[2], vaddrl[3], 0);
        NSA_TR4(RB, vaddrl[4], vaddrl[5], vaddrl[6], vaddrl[7], 0);
#define NSA_PVSTEP(KS, NEXTOFF, HASNEXT) \
        NSA_LWAIT(4, RA); __builtin_amdgcn_sched_barrier(0); \
        { const bf16x8 v0_ = __builtin_shufflevector(RA[0], RA[1], 0, 1, 2, 3, 4, 5, 6, 7), v1_ = __builtin_shufflevector(RA[2], RA[3], 0, 1, 2, 3, 4, 5, 6, 7); \
          W.O[0] = MFMA32(v0_, pf[KS], W.O[0]); W.O[1] = MFMA32(v1_, pf[KS], W.O[1]); } \
        __builtin_amdgcn_sched_barrier(0); \
        if (HASNEXT) NSA_TR4(RA, vaddrl[0], vaddrl[1], vaddrl[2], vaddrl[3], NEXTOFF); \
        if (HASNEXT) NSA_LWAIT(4, RB); else NSA_LWAIT(0, RB); \
        __builtin_amdgcn_sched_barrier(0); \
        { const bf16x8 v2_ = __builtin_shufflevector(RB[0], RB[1], 0, 1, 2, 3, 4, 5, 6, 7), v3_ = __builtin_shufflevector(RB[2], RB[3], 0, 1, 2, 3, 4, 5, 6, 7); \
          W.O[2] = MFMA32(v2_, pf[KS], W.O[2]); W.O[3] = MFMA32(v3_, pf[KS], W.O[3]); } \
        __builtin_amdgcn_sched_barrier(0); \
        if (HASNEXT) NSA_TR4(RB, vaddrl[4], vaddrl[5], vaddrl[6], vaddrl[7], NEXTOFF);
        __builtin_amdgcn_s_setprio(1);
        NSA_PVSTEP(0, 4096, true) NSA_PVSTEP(1, 8192, true) NSA_PVSTEP(2, 12288, true) NSA_PVSTEP(3, 0, false)
        __builtin_amdgcn_s_setprio(0);
#undef NSA_PVSTEP
    }
}
DI void nsa_fold(const NsaWave& W, bf16_t* obrow, unsigned char* ob8row, float sc, bool first, bool last, int h) {
#pragma unroll
    for (int d = 0; d < 4; ++d)
#pragma unroll
        for (int i = 0; i < 4; ++i) { bf16_t* pp = obrow + 32 * d + 8 * i + 4 * h; float o0 = 0.f, o1 = 0.f, o2 = 0.f, o3 = 0.f;
            if (!first) { const u32x2 w = *(const u32x2*)pp; o0 = bflo(w[0]); o1 = bfhi(w[0]); o2 = bflo(w[1]); o3 = bfhi(w[1]); }
            o0 += sc * W.O[d][4 * i]; o1 += sc * W.O[d][4 * i + 1]; o2 += sc * W.O[d][4 * i + 2]; o3 += sc * W.O[d][4 * i + 3];
            if (last) *(unsigned*)(ob8row + 32 * d + 8 * i + 4 * h) = pg8::fp8x4(o0 * pg8::A8_SCALE, o1 * pg8::A8_SCALE, o2 * pg8::A8_SCALE, o3 * pg8::A8_SCALE);
            else *(u32x2*)pp = (u32x2){cvt2(o0, o1), cvt2(o2, o3)}; }
}
struct NsaRun { LAS char* L; unsigned lds0; const bf16_t* kbase; const bf16_t* vbase; int t0, nt, kind, tqmin, lo_min, lo_max, hi_min, hi_max, tid, w; LAS unsigned* selm; LAS float* impA; LAS float* impL;
    const bf16_t* nk; const bf16_t* nv; bool nvalid; };
template <int MODE>
DI void nsa_tiles(NsaWave& W, const NsaRun& R, const unsigned (&vaddr)[8], int& bpar, bool& pend) {
    if (R.nt <= 0) return;
    const int lane = R.tid & 63, c = lane & 31;
    if (!pend) { __syncthreads();
        nsa_tile_dma(R.L + bpar * 32768, R.L + bpar * 32768 + 16384, R.kbase + (size_t)R.t0 * 8192, R.vbase + (size_t)R.t0 * 8192, R.tid, R.w); }
    asm volatile("s_waitcnt vmcnt(0)" ::: "memory");
    __syncthreads();
#pragma unroll 1
    for (int i = 0; i < R.nt; ++i) {
        const int cur = (i + bpar) & 1, tt = R.t0 + i, kbeg = tt * 64;
        if (i + 1 < R.nt) nsa_tile_dma(R.L + (cur ^ 1) * 32768, R.L + (cur ^ 1) * 32768 + 16384, R.kbase + (size_t)(tt + 1) * 8192, R.vbase + (size_t)(tt + 1) * 8192, R.tid, R.w);
        else if (R.nvalid) nsa_tile_dma(R.L + (cur ^ 1) * 32768, R.L + (cur ^ 1) * 32768 + 16384, R.nk, R.nv, R.tid, R.w);
        bool rowneed = true;
        if (R.kind == 1) { const unsigned wsel = R.selm[(c >> 2) * 4 + (tt >> 5)]; rowneed = (wsel >> (tt & 31)) & 1u; }
        const bool skip = kbeg > R.hi_max || kbeg + 63 < R.lo_min || (R.kind == 1 && __ballot(rowneed) == 0ull);
        if (!skip) {
            const bool needmask = !(kbeg >= R.lo_max && kbeg + 63 <= R.hi_min);
            const unsigned kb_ = R.lds0 + cur * 32768u, vb_ = kb_ + 16384u;
            nsa_tile_compute<MODE>(W, kb_, vb_, vaddr, R.tqmin, R.kind, kbeg, needmask, rowneed, lane, R.impA, R.impL, MODE == 2 ? tt * 16 : 0);
        }
        asm volatile("s_waitcnt vmcnt(0)" ::: "memory");
        __syncthreads();
    }
    bpar = (R.nt + bpar) & 1; pend = R.nvalid;
}
DI void phase_nsa_mfma(const Params& p, char* smem) {
    const int tid = tid_fresh(), lane = tid & 63, w = __builtin_amdgcn_readfirstlane(tid >> 6), c = lane & 31, h = lane >> 5;
    LAS char* L = (LAS char*)smem;
    const unsigned lds0 = (unsigned)(size_t)L;
    LAS float* impA = (LAS float*)(L + 65536) + w * 1024; LAS float* impL = (LAS float*)(L + 65536 + 32768) + w * 1024;
    LAS unsigned* selm = (LAS unsigned*)(L + 131072) + w * 32;
    const bf16_t* BQ = (const bf16_t*)(p.ws + O_BQ); const bf16_t* kvs = (const bf16_t*)(p.ws + O_KVS); const bf16_t* kcvc = (const bf16_t*)(p.ws + O_KCVC);
    const float* gates = (const float*)(p.ws + O_GATES); bf16_t* OB = (bf16_t*)(p.ws + O_OB);
    unsigned vaddr[8];
    { const unsigned q = (lane & 15) >> 2, pp = lane & 3, blk = (lane >> 4) & 1;
#pragma unroll
      for (int d = 0; d < 4; ++d)
#pragma unroll
          for (int t = 0; t < 2; ++t) vaddr[2 * d + t] = offb(8u * t + 4u * h + q, 4u * d + 2u * blk + (pp >> 1)) + 8u * (pp & 1u); }
    int bpar = 0; bool pend = false;
#pragma unroll 1
    for (int P = blockIdx.x; P < 256; P += gridDim.x) {
#pragma unroll 1
        for (int half = 0; half < 2; ++half) {
            const int bg = P >> 6, x = P & 63, qb = half == 0 ? 127 - x : x, b = bg >> 1, g = bg & 1, q0 = qb * 64;
            auto firsttile = [&](int hf, int st, const bf16_t*& kp, const bf16_t*& vp) -> bool {
                const int qb_ = hf == 0 ? 127 - x : x, q0_ = qb_ * 64, kd = st < 2 ? 0 : st - 1; const bf16_t* kb_; const bf16_t* vb_; int t0_, nt_;
                if (kd == 0) { kb_ = kcvc + (size_t)bg * 512 * 128; vb_ = kcvc + (size_t)2048 * 128 + (size_t)bg * 512 * 128; t0_ = 0; const int nl_ = (q0_ + 63 - 31) >> 4; nt_ = q0_ + 63 >= 31 ? (nl_ >> 6) + 1 : 0; }
                else if (kd == 1) { kb_ = kvs + (2 * (size_t)NB * 2 + bg) * T * 128; vb_ = kvs + (3 * (size_t)NB * 2 + bg) * T * 128; t0_ = 0; nt_ = qb_ + 1; }
                else { kb_ = kvs + (4 * (size_t)NB * 2 + bg) * T * 128; vb_ = kvs + (5 * (size_t)NB * 2 + bg) * T * 128; t0_ = qb_ >= 8 ? qb_ - 8 : 0; nt_ = qb_ - t0_ + 1; }
                kp = kb_ + (size_t)t0_ * 8192; vp = vb_ + (size_t)t0_ * 8192; return nt_ > 0; };
            NsaWave W;
            const int tqmin = q0 + 8 * w, tqmax = tqmin + 7; const int tok = b * T + tqmin + (c >> 2);
            { const bf16_t* qr = BQ + (size_t)tok * 1024 + (g * 4 + (c & 3)) * 128 + 8 * h;
#pragma unroll
              for (int s = 0; s < 8; ++s) W.q[s] = *(const bf16x8*)(qr + 16 * s); }
#pragma unroll
            for (int i = 0; i < 16; ++i) { impA[lane + 64 * i] = 0.f; impL[lane + 64 * i] = 0.f; }
            for (int step = 0; step < 4; ++step) {
                const int kind = step < 2 ? 0 : step - 1;
                const bf16_t* kbase; const bf16_t* vbase; int t0, nt;
                int lo_min, lo_max, hi_min, hi_max;
                if (kind == 0) { kbase = kcvc + (size_t)bg * 512 * 128; vbase = kcvc + (size_t)2048 * 128 + (size_t)bg * 512 * 128;
                    t0 = 0; const int nlast = (q0 + 63 - 31) >> 4; nt = q0 + 63 >= 31 ? (nlast >> 6) + 1 : 0;
                    lo_min = 0; lo_max = 0; hi_min = tqmin >= 31 ? (tqmin - 31) >> 4 : -1; hi_max = tqmax >= 31 ? (tqmax - 31) >> 4 : -1; }
                else if (kind == 1) { kbase = kvs + (2 * (size_t)NB * 2 + bg) * T * 128; vbase = kvs + (3 * (size_t)NB * 2 + bg) * T * 128;
                    t0 = 0; nt = qb + 1; lo_min = 0; lo_max = 0; hi_min = tqmin; hi_max = tqmax; }
                else { kbase = kvs + (4 * (size_t)NB * 2 + bg) * T * 128; vbase = kvs + (5 * (size_t)NB * 2 + bg) * T * 128;
                    t0 = qb >= 8 ? qb - 8 : 0; nt = qb - t0 + 1; lo_min = tqmin - 511; lo_max = tqmax - 511; hi_min = tqmin; hi_max = tqmax; }
                if (step != 1) { W.m = -INFINITY; W.l = 0.f; }
#pragma unroll
                for (int d = 0; d < 4; ++d)
#pragma unroll
                    for (int r = 0; r < 16; ++r) W.O[d][r] = 0.f;
                {   NsaRun R; R.L = L; R.lds0 = lds0; R.kbase = kbase; R.vbase = vbase; R.t0 = t0; R.nt = nt; R.kind = kind; R.tqmin = tqmin; R.lo_min = lo_min; R.lo_max = lo_max; R.hi_min = hi_min; R.hi_max = hi_max;
                    R.tid = tid; R.w = w; R.selm = selm; R.impA = impA; R.impL = impL;
                    { int nh = half, ns_ = step + 1; if (ns_ == 4) { ns_ = 0; nh = half + 1; }
                      R.nk = nullptr; R.nv = nullptr; R.nvalid = nh < 2 && firsttile(nh, ns_, R.nk, R.nv); }
                    if (step == 0) nsa_tiles<1>(W, R, vaddr, bpar, pend); else if (step == 1) nsa_tiles<2>(W, R, vaddr, bpar, pend); else nsa_tiles<0>(W, R, vaddr, bpar, pend); }
                if (step == 0) { if (W.m == -INFINITY) W.m = 0.f; W.l = 1.f / fmaxf(W.l, 1e-30f); continue; }
                { int lz = lane; asm volatile("" : "+v"(lz)); const int cz = lz & 31; const int tokz = b * T + tqmin + (cz >> 2);
                  const float gv = gates[(size_t)tokz * 24 + (g * 4 + (cz & 3)) * 3 + kind];
                  nsa_fold(W, OB + (size_t)tokz * 1024 + (g * 4 + (cz & 3)) * 128, (unsigned char*)(p.ws + O_OB8) + (size_t)tokz * 1024 + (g * 4 + (cz & 3)) * 128, step == 1 ? gv : gv / fmaxf(W.l, 1e-30f), step == 1, step == 3, lz >> 5); }
                if (step == 1) {
                    asm volatile("s_waitcnt lgkmcnt(0)" ::: "memory");
#pragma unroll 1
                    for (int qi = 0; qi < 8; ++qi) { const int tqq = tqmin + qi, curb = tqq >> 6; unsigned key[2];
#pragma unroll
                        for (int hh = 0; hh < 2; ++hh) { const int mb = lane + 64 * hh; const float imp = impA[qi * 128 + mb] + (mb > 0 ? impL[qi * 128 + mb - 1] : 0.f);
                            const bool adm = mb <= curb, forced = mb == 0 || mb == curb || mb == curb - 1;
                            key[hh] = !adm ? 0u : (forced ? (0xFF000000u | (unsigned)(127 - mb)) : ((((__float_as_uint(imp) >> 7) + 1u) << 7) | (unsigned)(127 - mb))); }
                        unsigned Tv = 0u;
                        for (int bit = 31; bit >= 0; --bit) { const unsigned cand = Tv | (1u << bit);
                            const int cnt = __popcll(__ballot(key[0] >= cand)) + __popcll(__ballot(key[1] >= cand)); if (cnt >= 16) Tv = cand; }
                        if (Tv == 0u) Tv = 1u;
                        const unsigned long long m0 = __ballot(key[0] >= Tv), m1 = __ballot(key[1] >= Tv);
                        if (lane == 0) { selm[qi * 4] = (unsigned)m0; selm[qi * 4 + 1] = (unsigned)(m0 >> 32); selm[qi * 4 + 2] = (unsigned)m1; selm[qi * 4 + 3] = (unsigned)(m1 >> 32); } }
                    asm volatile("s_waitcnt lgkmcnt(0)" ::: "memory");
                }
            }
        }
    }
}

DI void topk256_hist(LAS unsigned short* sck, int nk, LAS unsigned* hist, unsigned short* out, int lane) {
    const int nit = (nk + 511) >> 9;
    const unsigned long long ltm = (1ull << lane) - 1ull;
    const int sub = lane & 1;
    for (int k = nk + lane; k < 512 * nit; k += 64) sck[k] = 0;
    unsigned bsel = 0, cnt_above = 0;
#pragma unroll 1
    for (int rpp_ = 0; rpp_ < ((SEL_REP & 1) ? 2 : 1); ++rpp_) { bsel = 0; cnt_above = 0; asm volatile("" : "+v"(bsel), "+v"(cnt_above));
#pragma unroll 1
    for (int pass = 0; pass < 2; ++pass) {
        *(LAS u32x4*)(hist + 8 * lane) = (u32x4){0u, 0u, 0u, 0u}; *(LAS u32x4*)(hist + 8 * lane + 4) = (u32x4){0u, 0u, 0u, 0u};
        asm volatile("s_waitcnt lgkmcnt(0)" ::: "memory");
#pragma unroll 1
        for (int i = 0; i < nit; ++i) { const int k0 = 8 * (i * 64 + lane); const u32x4 wv = *(const LAS u32x4*)(sck + k0);
#pragma unroll
            for (int j = 0; j < 8; ++j) { const unsigned key = (j & 1) ? (wv[j >> 1] >> 16) : (wv[j >> 1] & 0xffffu);
                if (pass == 0) __hip_atomic_fetch_add(hist + 2 * (key >> 8) + sub, 1u, __ATOMIC_RELAXED, __HIP_MEMORY_SCOPE_WORKGROUP);
                else if ((key >> 8) == bsel) __hip_atomic_fetch_add(hist + 2 * (key & 255u) + sub, 1u, __ATOMIC_RELAXED, __HIP_MEMORY_SCOPE_WORKGROUP); } }
        asm volatile("s_waitcnt lgkmcnt(0)" ::: "memory");
        const u32x4 h0 = *(const LAS u32x4*)(hist + 8 * lane), h1 = *(const LAS u32x4*)(hist + 8 * lane + 4);
        const u32x4 c4 = {h0[0] + h0[1], h0[2] + h0[3], h1[0] + h1[1], h1[2] + h1[3]};
        const unsigned tot = c4[0] + c4[1] + c4[2] + c4[3];
        unsigned inc = tot;
#pragma unroll
        for (int o = 1; o < 64; o <<= 1) { const unsigned v = __shfl_down(inc, o); if (lane + o < 64) inc += v; }
        unsigned above = cnt_above + inc - tot;
        int found = -1; unsigned fabove = 0;
#pragma unroll
        for (int bb = 3; bb >= 0; --bb) { if (found < 0 && above < 256u && above + c4[bb] >= 256u) { found = 4 * lane + bb; fabove = above; } above += c4[bb]; }
        const unsigned long long fm = __ballot(found >= 0); const int src = __builtin_ctzll(fm);
        const unsigned fb = (unsigned)__shfl(found, src); cnt_above = (unsigned)__shfl((int)fabove, src);
        bsel = pass == 0 ? fb : ((bsel << 8) | fb);
    }
    }
    const unsigned Tv = bsel; const int need = 256 - (int)cnt_above; int pos = 0, eqc = 0;
#pragma unroll 1
    for (int rpe_ = 0; rpe_ < ((SEL_REP & 2) ? 2 : 1); ++rpe_) { pos = 0; eqc = 0; asm volatile("" : "+v"(pos), "+v"(eqc));
#pragma unroll 1
    for (int i = 0; i < nit; ++i) { const int k0 = 8 * (i * 64 + lane); const u32x4 wv = *(const LAS u32x4*)(sck + k0);
        bool eq[8], sl[8]; bool anyeq = false;
#pragma unroll
        for (int j = 0; j < 8; ++j) { const unsigned key = (j & 1) ? (wv[j >> 1] >> 16) : (wv[j >> 1] & 0xffffu); eq[j] = key == Tv; sl[j] = key > Tv; anyeq |= eq[j]; }
        if (__ballot(anyeq) != 0ull) {
            int below = 0, own = 0, etot = 0;
#pragma unroll
            for (int j = 0; j < 8; ++j) { const unsigned long long em = __ballot(eq[j]); below += __popcll(em & ltm); etot += __popcll(em); }
#pragma unroll
            for (int j = 0; j < 8; ++j) if (eq[j]) { if (eqc + below + own < need) sl[j] = true; ++own; }
            eqc += etot; }
#pragma unroll
        for (int j = 0; j < 8; ++j) { const unsigned long long sm = __ballot(sl[j]); if (sl[j]) out[pos + __popcll(sm & ltm)] = (unsigned short)(k0 + j); pos += __popcll(sm); } }
    }
}
DI void phase_indexer_mfma(const Params& p, char* smem) {
    const int tid = tid_fresh(), lane = tid & 63, w = __builtin_amdgcn_readfirstlane(tid >> 6), c = lane & 31, hh = lane >> 5;
    LAS unsigned short* sc = (LAS unsigned short*)(LAS char*)smem;
    LAS unsigned* hist = (LAS unsigned*)((LAS char*)smem + 131072) + w * 512;
    const bf16_t* Q = (const bf16_t*)(p.ws + O_QALL); const bf16_t* KI = (const bf16_t*)(p.ws + O_KIDX); const float* WI = (const float*)(p.ws + O_WIDX);
    unsigned short* SEL = (unsigned short*)(p.ws + O_SEL); int* NSEL = (int*)(p.ws + O_NSEL);
    const float* rope = (const float*)(p.ws + O_ROPE);
#pragma unroll 1
    for (int rnd = 0; rnd * (int)gridDim.x < NT / 8; ++rnd) {
        const int slot = (rnd & 1) ? (int)gridDim.x - 1 - (int)blockIdx.x : (int)blockIdx.x;
        const int u = NT / 8 - 1 - (rnd * (int)gridDim.x + slot);
        if (u < 0) continue;
        const int tok0 = u * 8, b = tok0 >> 13, q0 = tok0 & (T - 1), nkmax = q0 + 8;
        const int tok = tok0 + w, nk = q0 + w + 1;
        unsigned short* out = SEL + (size_t)tok * 256;
#ifndef IDX_REP_SCORE
#define IDX_REP_SCORE 1
#endif
#ifndef IDX_REP_SEL
#define IDX_REP_SEL 1
#endif
        for (int rs_ = 0; rs_ < IDX_REP_SCORE; ++rs_)
        if (nkmax > 256) {
            const int npair = (nkmax + 63) >> 6;
            const bf16_t* kbase = KI + ((size_t)b * T + c) * 64 + 8 * hh;
            bf16x8 kb[2][4], kn[2][4];
            auto ldk = [&](bf16x8 (&dst)[2][4], int pr) {
#pragma unroll
                for (int tt = 0; tt < 2; ++tt) { int key0 = 64 * pr + 32 * tt; if (key0 + 31 >= T) key0 = T - 32;
#pragma unroll
                    for (int s = 0; s < 4; ++s) dst[tt][s] = *(const bf16x8*)(kbase + (size_t)key0 * 64 + 16 * s); } };
            if (w < npair) ldk(kb, w);
            bf16x8 qa[2][4], Wf[2][2];
            {
                f32x4 rtv[2][4];
#pragma unroll
                for (int rb = 0; rb < 2; ++rb) { const bf16_t* qr = Q + (size_t)(tok0 + 4 * rb + (c >> 3)) * QC + 2304 + (c & 7) * 64 + 8 * hh;
                    const float* rt = rope + (size_t)(tok0 + 4 * rb + (c >> 3)) * 48 + 32;
#pragma unroll
                    for (int s = 0; s < 4; ++s) { qa[rb][s] = *(const bf16x8*)(qr + 16 * s); rtv[rb][s] = *(const f32x4*)(rt + 4 * s); } }
                const f32x4 wv = *(const f32x4*)(WI + (size_t)(tok0 + (c & 7)) * 8 + 4 * hh);
#pragma unroll
                for (int rb = 0; rb < 2; ++rb) {
                    const u32x4 own = __builtin_bit_cast(u32x4, qa[rb][0]); u32x4 oth;
#pragma unroll
                    for (int k = 0; k < 4; ++k) oth[k] = (unsigned)__shfl_xor((int)own[k], 32);
                    float xa[8], xb[8], xr[8]; unpack8(own, xa); unpack8(oth, xb);
#pragma unroll
                    for (int j = 0; j < 8; ++j) { const float cs = rtv[rb][(2 * j) >> 2][(2 * j) & 3], sn = rtv[rb][(2 * j + 1) >> 2][(2 * j + 1) & 3]; xr[j] = hh == 0 ? xa[j] * cs - xb[j] * sn : xa[j] * cs + xb[j] * sn; }
                    const u32x4 pk = {pk2(xr[0], xr[1]), pk2(xr[2], xr[3]), pk2(xr[4], xr[5]), pk2(xr[6], xr[7])};
                    qa[rb][0] = __builtin_bit_cast(bf16x8, pk); }
                const unsigned p01 = pk2(wv[0], wv[1]), p23 = pk2(wv[2], wv[3]);
#pragma unroll
                for (int rb = 0; rb < 2; ++rb)
#pragma unroll
                    for (int sp = 0; sp < 2; ++sp) { const bool m0 = c == 4 * rb + 2 * sp, m1 = c == 4 * rb + 2 * sp + 1;
                        const u32x4 pkw = {m0 ? p01 : 0u, m0 ? p23 : 0u, m1 ? p01 : 0u, m1 ? p23 : 0u};
                        Wf[rb][sp] = __builtin_bit_cast(bf16x8, pkw); } }
#pragma unroll
            for (int tt = 0; tt < 2; ++tt)
#pragma unroll
                for (int s = 0; s < 4; ++s) asm volatile("" : "+v"(kb[tt][s]));
            __syncthreads();
#pragma unroll 1
            for (int pr = w; pr < npair; pr += 8) {
                if (pr + 8 < npair) ldk(kn, pr + 8);
#pragma unroll
                for (int tt = 0; tt < 2; ++tt) {
                    const int key = 64 * pr + 32 * tt + c;
                    f32x16 a0, a1; const f32x16 z16 = {0.f, 0.f, 0.f, 0.f, 0.f, 0.f, 0.f, 0.f, 0.f, 0.f, 0.f, 0.f, 0.f, 0.f, 0.f, 0.f};
#pragma unroll
                    for (int s = 0; s < 4; ++s) { a0 = MFMA32(qa[0][s], kb[tt][s], s == 0 ? z16 : a0); a1 = MFMA32(qa[1][s], kb[tt][s], s == 0 ? z16 : a1); }
                    f32x16 d2 = MFMA32(Wf[0][0], pack_relu(a0, 0), z16);
                    d2 = MFMA32(Wf[0][1], pack_relu(a0, 1), d2); d2 = MFMA32(Wf[1][0], pack_relu(a1, 0), d2); d2 = MFMA32(Wf[1][1], pack_relu(a1, 1), d2);
                    if (key < 8192) {
#pragma unroll
                        for (int qq = 0; qq < 4; ++qq) sc[(4 * hh + qq) * 8192 + key] = f16key(d2[qq]); }
                }
#pragma unroll
                for (int tt = 0; tt < 2; ++tt)
#pragma unroll
                    for (int s = 0; s < 4; ++s) kb[tt][s] = kn[tt][s];
            }
        }
        __syncthreads();
        if (nk <= 256) { for (int i = lane; i < 256; i += 64) out[i] = (unsigned short)(i < nk ? i : 0); if (lane == 0) NSEL[tok] = nk; }
        else { for (int rs_ = 0; rs_ < IDX_REP_SEL; ++rs_) topk256_hist(sc + w * 8192, nk, hist, out, lane); if (lane == 0) NSEL[tok] = 256; }
    }
    __syncthreads();
    c2_rows(p, smem);
}

#define MFMA16(a, b, c) __builtin_amdgcn_mfma_f32_16x16x32_bf16((a), (b), (c), 0, 0, 0)
#define MLA_ROW 592
#define MLA_TR8(R, BASE, OFF) asm volatile( \
    "ds_read_b64_tr_b16 %0, %8 offset:%9\n\tds_read_b64_tr_b16 %1, %8 offset:%10\n\tds_read_b64_tr_b16 %2, %8 offset:%11\n\tds_read_b64_tr_b16 %3, %8 offset:%12\n\t" \
    "ds_read_b64_tr_b16 %4, %8 offset:%13\n\tds_read_b64_tr_b16 %5, %8 offset:%14\n\tds_read_b64_tr_b16 %6, %8 offset:%15\n\tds_read_b64_tr_b16 %7, %8 offset:%16\n\ts_waitcnt lgkmcnt(0)" \
    : "=&v"(R[0]), "=&v"(R[1]), "=&v"(R[2]), "=&v"(R[3]), "=&v"(R[4]), "=&v"(R[5]), "=&v"(R[6]), "=&v"(R[7]) \
    : "v"(BASE), "i"(OFF), "i"((OFF) + 16 * MLA_ROW), "i"((OFF) + 32), "i"((OFF) + 32 + 16 * MLA_ROW), "i"((OFF) + 64), "i"((OFF) + 64 + 16 * MLA_ROW), "i"((OFF) + 96), "i"((OFF) + 96 + 16 * MLA_ROW) : "memory")
DI void phase_mla_mfma(const Params& p, char* smem) {
    const int tid = tid_fresh(), lane = tid & 63, w = __builtin_amdgcn_readfirstlane(tid >> 6), fr = lane & 15, g = lane >> 4;
    LAS char* buf = (LAS char*)smem + w * (32 * MLA_ROW);
    const unsigned lbase = (unsigned)(size_t)buf;
    const bf16_t* Q = (const bf16_t*)(p.ws + O_QALL); const bf16_t* KV = (const bf16_t*)(p.ws + O_KVT);
    const unsigned short* SEL = (const unsigned short*)(p.ws + O_SEL); const int* NSEL = (const int*)(p.ws + O_NSEL); bf16_t* OL = (bf16_t*)(p.ws + O_OLAT);
    constexpr float C2 = ATT_SCALE * 1.4426950408889634f;
    int pf_cnt = 0, pf_s0 = 0, pf_s1 = 0;
    { const int tok = blockIdx.x * 8 + w; if (tok < NT) { pf_cnt = NSEL[tok]; if (lane < 32) { pf_s0 = SEL[(size_t)tok * 256 + lane]; pf_s1 = SEL[(size_t)tok * 256 + 32 + lane]; } } }
    u32x4 st[18]; int selv_n = 0; bool have0 = false;
#pragma unroll 1
    for (int tok = blockIdx.x * 8 + w; tok < NT; tok += gridDim.x * 8) {
        const int b = tok >> 13; const int cnt = pf_cnt; const int cur_s0 = pf_s0, cur_s1 = pf_s1;
        { const int tn = tok + gridDim.x * 8; if (tn < NT) { pf_cnt = NSEL[tn]; if (lane < 32) { pf_s0 = SEL[(size_t)tn * 256 + lane]; pf_s1 = SEL[(size_t)tn * 256 + 32 + lane]; } } }
        bf16x8 qf[9];
        { const bf16_t* qr = Q + (size_t)tok * QC; const bf16x8 z8 = {0, 0, 0, 0, 0, 0, 0, 0};
#pragma unroll
          for (int s = 0; s < 8; ++s) qf[s] = fr < 8 ? *(const bf16x8*)(qr + fr * 256 + 32 * s + 8 * g) : z8;
          qf[8] = fr < 8 ? *(const bf16x8*)(qr + 2048 + fr * 32 + 8 * g) : z8;
          {
              const float* rt = (const float*)(p.ws + O_ROPE) + (size_t)tok * 48;
              const u32x4 own = __builtin_bit_cast(u32x4, qf[8]); u32x4 oth;
#pragma unroll
              for (int k = 0; k < 4; ++k) oth[k] = (unsigned)__shfl_xor((int)own[k], 32);
              float xa[8], xb[8], xr[8]; unpack8(own, xa); unpack8(oth, xb);
#pragma unroll
              for (int j = 0; j < 8; ++j) { const int fi = 8 * (g & 1) + j; const float cs = rt[2 * fi], sn = rt[2 * fi + 1]; xr[j] = g < 2 ? xa[j] * cs - xb[j] * sn : xa[j] * cs + xb[j] * sn; }
              const u32x4 pk = {pk2(xr[0], xr[1]), pk2(xr[2], xr[3]), pk2(xr[4], xr[5]), pk2(xr[6], xr[7])};
              qf[8] = __builtin_bit_cast(bf16x8, pk); } }
        f32x4 O[16];
#pragma unroll
        for (int d = 0; d < 16; ++d) O[d] = (f32x4){0.f, 0.f, 0.f, 0.f};
        float m = -INFINITY, l = 0.f;
        const int nchunk = (cnt + 31) >> 5;
        const bf16_t* kvb = KV + (size_t)b * T * KVW;
        auto issue = [&](const bf16_t* kvb, int selv, int lz) {
#pragma unroll
            for (int i = 0; i < 16; ++i) { const int r0 = __builtin_amdgcn_readlane(selv, 2 * i), r1 = __builtin_amdgcn_readlane(selv, 2 * i + 1); const int row = lz < 32 ? r0 : r1;
                st[i] = *(const u32x4*)(kvb + (size_t)row * KVW + (lz & 31) * 8); }
#pragma unroll
            for (int i = 0; i < 2; ++i) { const int row = __shfl(selv, 16 * i + (lz >> 2)); st[16 + i] = *(const u32x4*)(kvb + (size_t)row * KVW + 256 + (lz & 3) * 8); } };
        if (!have0) { int lz = lane; asm volatile("" : "+v"(lz));
          int selv = 0; if (lz < 32 && lz < cnt) selv = cur_s0;
          selv_n = 0; if (lz < 32 && 32 + lz < cnt) selv_n = cur_s1;
          issue(kvb, selv, lz); }
#pragma unroll 1
        for (int ch = 0; ch < nchunk; ++ch) {
            int lz = lane; asm volatile("" : "+v"(lz));
#pragma unroll
            for (int i = 0; i < 16; ++i) *(LAS u32x4*)(buf + (2 * i + (lz >> 5)) * MLA_ROW + (lz & 31) * 16) = st[i];
#pragma unroll
            for (int i = 0; i < 2; ++i) *(LAS u32x4*)(buf + (16 * i + (lz >> 2)) * MLA_ROW + 512 + (lz & 3) * 16) = st[16 + i];
            if (ch + 1 < nchunk) {
                const int selv = selv_n; selv_n = 0;
                { const int k = (ch + 2) * 32 + lz; if (lz < 32 && k < cnt) selv_n = SEL[(size_t)tok * 256 + k]; }
                issue(kvb, selv, lz); }
            else {
                const int tn = tok + (int)gridDim.x * 8; have0 = tn < NT;
                if (have0) { const int cn = pf_cnt; int selv = 0; if (lz < 32 && lz < cn) selv = pf_s0;
                    selv_n = 0; if (lz < 32 && 32 + lz < cn) selv_n = pf_s1;
                    issue(KV + (size_t)(tn >> 13) * T * KVW, selv, lz); } }
            asm volatile("s_waitcnt lgkmcnt(0)" ::: "memory");
            const int frz = lz & 15, gz = lz >> 4;
            f32x4 s0, s1; const f32x4 z4 = {0.f, 0.f, 0.f, 0.f};
#pragma unroll
            for (int s = 0; s < 9; ++s) { const bf16x8 a0 = *(const LAS bf16x8*)(buf + frz * MLA_ROW + (32 * s + 8 * gz) * 2), a1 = *(const LAS bf16x8*)(buf + (frz + 16) * MLA_ROW + (32 * s + 8 * gz) * 2);
                s0 = MFMA16(a0, qf[s], s == 0 ? z4 : s0); s1 = MFMA16(a1, qf[s], s == 0 ? z4 : s1); }
            float mx = -INFINITY;
#pragma unroll
            for (int j = 0; j < 4; ++j) { if (ch * 32 + 4 * gz + j >= cnt) s0[j] = -INFINITY; if (ch * 32 + 16 + 4 * gz + j >= cnt) s1[j] = -INFINITY; mx = fmaxf(mx, fmaxf(s0[j], s1[j])); }
            mx = fmaxf(mx, __shfl_xor(mx, 16)); mx = fmaxf(mx, __shfl_xor(mx, 32));
            const float mn = fmaxf(m, mx), mu = (mn == -INFINITY) ? 0.f : mn;
            const float alpha = __builtin_amdgcn_exp2f((m - mu) * C2);
            float rs = 0.f;
#pragma unroll
            for (int j = 0; j < 4; ++j) { s0[j] = __builtin_amdgcn_exp2f((s0[j] - mu) * C2); s1[j] = __builtin_amdgcn_exp2f((s1[j] - mu) * C2); rs += s0[j] + s1[j]; }
            rs += __shfl_xor(rs, 16); rs += __shfl_xor(rs, 32);
            l = l * alpha + rs; m = mn;
            if (!__all(alpha == 1.f)) {
#pragma unroll
                for (int d = 0; d < 16; ++d) O[d] *= alpha; }
            const u32x4 pw = {cvt2(s0[0], s0[1]), cvt2(s0[2], s0[3]), cvt2(s1[0], s1[1]), cvt2(s1[2], s1[3])};
            const bf16x8 pf = __builtin_bit_cast(bf16x8, pw);
            const unsigned tb = lbase + (unsigned)(4 * gz + (frz >> 2)) * MLA_ROW + 8u * (frz & 3);
#pragma unroll
            for (int dq = 0; dq < 4; ++dq) { s16x4 R[8];
                if (dq == 0) MLA_TR8(R, tb, 0); else if (dq == 1) MLA_TR8(R, tb, 128); else if (dq == 2) MLA_TR8(R, tb, 256); else MLA_TR8(R, tb, 384);
#pragma unroll
                for (int d = 0; d < 4; ++d) { const bf16x8 vf = __builtin_shufflevector(R[2 * d], R[2 * d + 1], 0, 1, 2, 3, 4, 5, 6, 7); O[4 * dq + d] = MFMA16(vf, pf, O[4 * dq + d]); } }
            asm volatile("s_waitcnt lgkmcnt(0)" ::: "memory");
        }
        const float il16 = pg8::A8_SCALE / fmaxf(l, 1e-30f);
        if (fr < 8) {
#pragma unroll
            for (int d = 0; d < 16; ++d) *(unsigned*)((unsigned char*)OL + (size_t)tok * D + fr * 256 + 16 * d + 4 * g) = pg8::fp8x4(O[d][0] * il16, O[d][1] * il16, O[d][2] * il16, O[d][3] * il16); }
    }
}

DI void phase_post_mix(const Params& p, char* smem, bool count) {
    const int tz_ = tid_fresh(); const int lane = tz_ & 63, wid = __builtin_amdgcn_readfirstlane(tz_ >> 6);
    float* part = (float*)smem;
    int* lcnt = (int*)(smem + 8 * 32 * 33 * 4);
    const bf16_t* MO = (const bf16_t*)(p.ws + O_MO); bf16_t* X1 = (bf16_t*)(p.ws + O_X1); bf16_t* H = (bf16_t*)(p.ws + O_H); const bf16_t* WR = (const bf16_t*)(p.ws + O_WRT);
    int* TOPI = (int*)(p.ws + O_TOPI); float* TOPW = (float*)(p.ws + O_TOPW); int* cnts = (int*)(p.ws + O_CNT); unsigned char* H28 = (unsigned char*)(p.ws + O_H8);
    float* cvec = (float*)(smem + 36864);
#pragma unroll 1
    for (int ck = blockIdx.x; ck < NT / 64; ck += gridDim.x) {
        {   const int b = (ck * 64) >> 13;
            __syncthreads();
            *(f32x4*)(cvec + 4 * tz_) = *(const f32x4*)((const float*)(p.ws + O_MODACC) + b * 12288 + 4096 + 4 * tz_);
            *(f32x4*)(cvec + 2048 + 4 * tz_) = *(const f32x4*)(p.g_post_mix + 4 * tz_);
            *(f32x4*)(cvec + 4096 + 4 * tz_) = *(const f32x4*)(p.g_pre_ffn + 4 * tz_);
            *(f32x4*)(cvec + 6144 + 4 * tz_) = *(const f32x4*)((const float*)(p.ws + O_MODACC) + b * 12288 + 4 * 2048 + 4 * tz_);
            *(f32x4*)(cvec + 8192 + 4 * tz_) = *(const f32x4*)((const float*)(p.ws + O_MODACC) + b * 12288 + 3 * 2048 + 4 * tz_);
            __syncthreads(); }
#pragma unroll 1
        for (int j = 0; j < 8; ++j) {
            const int tok = ck * 64 + wid * 8 + j;
            u32x2 mo[8]; f32x4 xr[8];
#pragma unroll
            for (int i = 0; i < 8; ++i) { mo[i] = __builtin_nontemporal_load((const u32x2*)(MO + (size_t)tok * D + 4 * (lane + 64 * i))); xr[i] = __builtin_nontemporal_load((const f32x4*)(p.x + (size_t)tok * D + 4 * (lane + 64 * i))); }
            float v[32]; float ss = 0.f;
#pragma unroll
            for (int i = 0; i < 8; ++i) { const u32x2 w = mo[i];
                v[4 * i] = bflo(w[0]); v[4 * i + 1] = bfhi(w[0]); v[4 * i + 2] = bflo(w[1]); v[4 * i + 3] = bfhi(w[1]); }
#pragma unroll
            for (int i = 0; i < 32; ++i) ss += v[i] * v[i];
            const float rs = rsqrtf(wave_sum(ss) * (1.f / D) + NORM_EPS);
            float ss2 = 0.f;
#pragma unroll
            for (int i = 0; i < 8; ++i) { const int col = 4 * (lane + 64 * i); const f32x4 xv = xr[i], mg = *(const f32x4*)(cvec + col), gp = *(const f32x4*)(cvec + 2048 + col); f32x4 o;
#pragma unroll
                for (int q = 0; q < 4; ++q) { o[q] = xv[q] + mg[q] * (v[4 * i + q] * rs * gp[q]); v[4 * i + q] = o[q]; ss2 += o[q] * o[q]; }
                __builtin_nontemporal_store((u32x2){pk2(o[0], o[1]), pk2(o[2], o[3])}, (u32x2*)(X1 + (size_t)tok * D + col)); }
            const float rs2 = rsqrtf(wave_sum(ss2) * (1.f / D) + NORM_EPS);
#pragma unroll
            for (int i = 0; i < 8; ++i) { const int col = 4 * (lane + 64 * i); const f32x4 gf = *(const f32x4*)(cvec + 4096 + col), ms = *(const f32x4*)(cvec + 6144 + col), mh = *(const f32x4*)(cvec + 8192 + col); f32x4 hv;
#pragma unroll
                for (int q = 0; q < 4; ++q) hv[q] = v[4 * i + q] * rs2 * gf[q] * (1.f + ms[q]) + mh[q];
                *(u32x2*)(H + (size_t)tok * D + col) = (u32x2){pk2(hv[0], hv[1]), pk2(hv[2], hv[3])};
                *(unsigned*)(H28 + (size_t)tok * D + col) = pg8::fp8x4(hv[0], hv[1], hv[2], hv[3]); }
        }
        asm volatile("s_waitcnt vmcnt(0)" ::: "memory");
        __syncthreads();
        if (tz_ < 32) lcnt[tz_] = 0;
        {
            const int c = lane & 31, hh = lane >> 5, rb = wid & 1, ks = wid >> 1;
            const bf16_t* ap = H + (size_t)(ck * 64 + 32 * rb + c) * D + 512 * ks + 8 * hh; const bf16_t* bp = WR + (size_t)c * D + 512 * ks + 8 * hh;
            f32x16 acc;
#pragma unroll
            for (int i = 0; i < 16; ++i) acc[i] = 0.f;
#pragma unroll 8
            for (int sx = 0; sx < 32; ++sx) { const bf16x8 a = *(const bf16x8*)(ap + 16 * sx), bb = *(const bf16x8*)(bp + 16 * sx); acc = MFMA32(a, bb, acc); }
#pragma unroll
            for (int r = 0; r < 16; ++r) part[(wid * 32 + (r & 3) + 8 * (r >> 2) + 4 * hh) * 33 + c] = acc[r];
        }
        __syncthreads();
        if (tz_ < 64) {
            const int rbt = tz_ >> 5, row = tz_ & 31, tok = ck * 64 + tz_;
            float lg[32];
#pragma unroll
            for (int e = 0; e < 32; ++e) lg[e] = p.b_router[e] + part[((0 * 2 + rbt) * 32 + row) * 33 + e] + part[((1 * 2 + rbt) * 32 + row) * 33 + e] + part[((2 * 2 + rbt) * 32 + row) * 33 + e] + part[((3 * 2 + rbt) * 32 + row) * 33 + e];
            int te[4]; float tv[4];
#pragma unroll
            for (int k = 0; k < 4; ++k) { float mx = lg[0]; int bi = 0;
#pragma unroll
                for (int e = 1; e < 32; ++e) if (lg[e] > mx) { mx = lg[e]; bi = e; }
                te[k] = bi; tv[k] = mx;
#pragma unroll
                for (int e = 0; e < 32; ++e) if (e == bi) lg[e] = -INFINITY; }
            const float e1 = __expf(tv[1] - tv[0]), e2 = __expf(tv[2] - tv[0]), e3 = __expf(tv[3] - tv[0]); const float inv = 1.f / (1.f + e1 + e2 + e3);
            *(int4*)(TOPI + tok * 4) = make_int4(te[0], te[1], te[2], te[3]);
            *(f32x4*)(TOPW + tok * 4) = (f32x4){inv, e1 * inv, e2 * inv, e3 * inv};
            atomicAdd(lcnt + te[0], 1); atomicAdd(lcnt + te[1], 1); atomicAdd(lcnt + te[2], 1); atomicAdd(lcnt + te[3], 1);
        }
        __syncthreads();
        if (count && tz_ < 32) atomicAdd(cnts + tz_, lcnt[tz_]);
    }
}

DI int moe_tables(const Params& p, LAS int* tile_e, LAS int* pstart) {
    int* cnts = (int*)(p.ws + O_CNT);
    if (threadIdx.x < 64) {
        const int e = threadIdx.x & 31;
        const int c = __hip_atomic_load(cnts + e, __ATOMIC_RELAXED, __HIP_MEMORY_SCOPE_AGENT);
        const int nt = (c + 255) >> 8; int inc = nt;
#pragma unroll
        for (int o = 1; o < 32; o <<= 1) { const int v = __shfl_up(inc, o, 32); if (e >= o) inc += v; }
        const int start = inc - nt;
        if (threadIdx.x < 32) { pstart[e] = start * 256; for (int i = 0; i < nt; ++i) tile_e[start + i] = e; if (e == 31) pstart[NEXP] = inc; } }
    __syncthreads();
    return pstart[NEXP];
}
DI void phase_moe_gather(const Params& p, char* smem) {
    const int tz_ = tid_fresh(); const int lane = tz_ & 63, wid = __builtin_amdgcn_readfirstlane(tz_ >> 6);
    LAS int* tile_e = (LAS int*)(LAS char*)smem; LAS int* pstart = tile_e + 320; LAS int* lcnt = pstart + 40; LAS int* lbase = lcnt + 32;
    (void)moe_tables(p, tile_e, pstart);
    int* SLOT_TOK = (int*)(p.ws + O_HS);
    const int* TOPI = (const int*)(p.ws + O_TOPI); const float* TOPW = (const float*)(p.ws + O_TOPW); int* TSLOT = (int*)(p.ws + O_TSLOT); float* SLOTW = (float*)(p.ws + O_SLOTW);
    int* fill = (int*)(p.ws + O_CNT) + 32;
#pragma unroll 1
    for (int ck = blockIdx.x; ck < NT / 64; ck += gridDim.x) {
        const int tok0 = ck * 64 + wid * 8;
        __syncthreads();
        if (tz_ < 32) lcnt[tz_] = 0;
        __syncthreads();
        int e = 0, rank = 0;
        if (lane < 32) { e = TOPI[tok0 * 4 + lane]; rank = atomicAdd((int*)(lcnt + e), 1); }
        __syncthreads();
        if (tz_ < 32) lbase[tz_] = atomicAdd(fill + tz_, lcnt[tz_]);
        __syncthreads();
        int slot = 0;
        if (lane < 32) { slot = pstart[e] + lbase[e] + rank; TSLOT[tok0 * 4 + lane] = slot; SLOTW[slot] = TOPW[tok0 * 4 + lane]; SLOT_TOK[slot] = tok0 + (lane >> 2); }
        (void)slot;
    }
}
DI void phase_final(const Params& p) {
    const int tz_ = tid_fresh(); const int lane = tz_ & 63, wid = __builtin_amdgcn_readfirstlane(tz_ >> 6);
    const unsigned char* YS = (const unsigned char*)(p.ws + O_YS); const bf16_t* X1 = (const bf16_t*)(p.ws + O_X1); const int* TSLOT = (const int*)(p.ws + O_TSLOT);
    f32x4 cm[8]; int cb = -1;
    for (int tok = blockIdx.x * 8 + wid; tok < NT; tok += gridDim.x * 8) {
        const int b = tok >> 13; float v[32];
        if (b != cb) { cb = b;
#pragma unroll
            for (int i = 0; i < 8; ++i) { const int col = 4 * (lane + 64 * i); cm[i] = *(const f32x4*)((const float*)(p.ws + O_MODACC) + b * 12288 + 5 * 2048 + col) * *(const f32x4*)(p.g_post_ffn + col); } }
        u32x2 xr[8];
#pragma unroll
        for (int i = 0; i < 8; ++i) xr[i] = __builtin_nontemporal_load((const u32x2*)(X1 + (size_t)tok * D + 4 * (lane + 64 * i)));
#pragma unroll
        for (int i = 0; i < 32; ++i) v[i] = 0.f;
#pragma unroll
        for (int k = 0; k < 4; ++k) { const int slot = TSLOT[tok * 4 + k];
#pragma unroll
            for (int i = 0; i < 8; ++i) { const unsigned w = __builtin_nontemporal_load((const unsigned*)(YS + (size_t)slot * D + 4 * (lane + 64 * i)));
                const auto lo = __builtin_amdgcn_cvt_pk_f32_fp8((int)w, false), hi = __builtin_amdgcn_cvt_pk_f32_fp8((int)w, true);
                v[4 * i] += lo[0]; v[4 * i + 1] += lo[1]; v[4 * i + 2] += hi[0]; v[4 * i + 3] += hi[1]; } }
#pragma unroll
        for (int i = 0; i < 32; ++i) v[i] *= pg8::Y8_INV;
        float ss = 0.f;
#pragma unroll
        for (int i = 0; i < 32; ++i) ss += v[i] * v[i];
        const float rs = rsqrtf(wave_sum(ss) * (1.f / D) + NORM_EPS);
#pragma unroll
        for (int i = 0; i < 8; ++i) { const int col = 4 * (lane + 64 * i); const float x0 = bflo(xr[i][0]), x1 = bfhi(xr[i][0]), x2 = bflo(xr[i][1]), x3 = bfhi(xr[i][1]); f32x4 o;
            o[0] = x0 + cm[i][0] * (v[4 * i] * rs); o[1] = x1 + cm[i][1] * (v[4 * i + 1] * rs); o[2] = x2 + cm[i][2] * (v[4 * i + 2] * rs); o[3] = x3 + cm[i][3] * (v[4 * i + 3] * rs);
            __builtin_nontemporal_store(o, (f32x4*)(p.out + (size_t)tok * D + col)); }
    }
}

#ifndef PHMASK
#define PHMASK 0xFFFFFFFFu
#endif
#define PHON(ph) (((PHMASK) >> (ph)) & 1u)
#ifndef REPMASK
#define REPMASK 0u
#endif
#define REP(ph) _Pragma("unroll 1") for (int rep_ = 0; rep_ <= (int)(((REPMASK) >> (ph)) & 1u); ++rep_)
enum { PH_PREP = 0, PH_H1, PH_GIN, PH_ZPOST, PH_GQ, PH_QROPE, PH_IDX, PH_MLA, PH_NSA, PH_MERGE, PH_GOUT, PH_POSTMIX, PH_GATHER, PH_GU, PH_DN, PH_FINAL, PH_END };

__global__ void __launch_bounds__(512, 2) mega(Params p, int lo, int hi) {
    extern __shared__ __attribute__((aligned(16))) char smem[];
    LAS unsigned char* lds = (LAS unsigned char*)(LAS char*)smem;
    volatile LAS unsigned* xbw = (volatile LAS unsigned*)(LAS char*)(smem + LDS_BYTES - 16);
    XcdBarrier bar; bar.bar = (unsigned*)p.ws; bar.x = 0; bar.st = xbw;
    if (hi - lo > 1) { if (threadIdx.x == 0) { xbw[0] = 0u; xbw[1] = 0u; } __syncthreads(); bar = xcd_barrier_post((unsigned*)p.ws, xbw); }
    const int G = gridDim.x, c = blockIdx.x;
#define SEAM(ph) if ((ph) + 1 < hi) xcd_barrier(bar);
    if (PHON(PH_PREP) && lo <= PH_PREP && PH_PREP < hi) { REP(PH_PREP) { phase_prep(p, smem); } SEAM(PH_PREP) }
    if (PHON(PH_H1) && lo <= PH_H1 && PH_H1 < hi) { REP(PH_H1) { phase_h1(p); } SEAM(PH_H1) }
    if (PHON(PH_GIN) && lo <= PH_GIN && PH_GIN < hi) { REP(PH_GIN) {
        { pg8::PlainSched S; S.init(NT, 2048, G, c, p.ws + O_H, D, p.ws + O_WIN, D);
          pg8::EpiZ16 E; E.O = (bf16_t*)(p.ws + O_Z); E.bq = (bf16_t*)(p.ws + O_BQ); E.ldc = ZC;
          pg8::gemm_phase(lds, pg8::Gemm{D, D, D}, S, E); }
        { pg8::PlainSched S; S.init(NT, ZC - 2048, G, c, p.ws + O_H8, D / 2, p.ws + O_WIN8 + (size_t)2048 * D, D / 2);
          pg8::EpiZ8 E; E.O = (bf16_t*)(p.ws + O_Z) + 2048; E.kvs = (bf16_t*)(p.ws + O_KVS); E.ldc = ZC; E.scale = pg8::W8_INV;
          pg8::gemm_phase_fp8(lds, pg8::Gemm{D / 2, D / 2, D / 2}, S, E); }
        } SEAM(PH_GIN) }
    if (PHON(PH_ZPOST) && lo <= PH_ZPOST && PH_ZPOST < hi) { REP(PH_ZPOST) { phase_zpost(p); } SEAM(PH_ZPOST) }
    if (PHON(PH_GQ) && lo <= PH_GQ && PH_GQ < hi) { REP(PH_GQ) {
        { pg8::PlainSched S; S.init(NT, QC, G, c, p.ws + O_CQN, 512, p.ws + O_WQ, 512);
          pg8::EpiBf16 E; E.O = (bf16_t*)(p.ws + O_QALL); E.ldc = QC; E.scale = 1.f;
          pg8::gemm_phase(lds, pg8::Gemm{512, 512, 512}, S, E); }
        { pg8::C1Sched S; S.G = G; S.c = c; S.kvs = p.ws + O_KVS; S.w = p.ws + O_WC1;
          pg8::EpiC1 E; E.C = (float*)(p.ws + O_C1P);
          pg8::gemm_phase(lds, pg8::Gemm{2048, 4096, 4096 / pg8::C1_SPLIT}, S, E); }
        } SEAM(PH_GQ) }
    if (PHON(PH_IDX) && lo <= PH_IDX && PH_IDX < hi) { REP(PH_IDX) {
#ifdef IDX_NAIVE
        phase_indexer(p, smem);
#else
        phase_indexer_mfma(p, smem);
#endif
        } SEAM(PH_IDX) }
    if (PHON(PH_MLA) && lo <= PH_MLA && PH_MLA < hi) { REP(PH_MLA) {
#ifdef MLA_NAIVE
        phase_mla(p, smem);
#else
        phase_mla_mfma(p, smem);
#endif
        } __syncthreads(); }
    if (PHON(PH_NSA) && lo <= PH_NSA && PH_NSA < hi) { REP(PH_NSA) {
#ifdef NSA_NAIVE
        phase_nsa(p, smem);
#else
        phase_nsa_mfma(p, smem);
#endif
        } SEAM(PH_NSA) }
    if (PHON(PH_MERGE) && lo <= PH_MERGE && PH_MERGE < hi) { REP(PH_MERGE) {
        { pg8::PlainSched S; S.init(NT, D, G, c, p.ws + O_OLAT, D / 2, p.ws + O_WO, D / 2);
          pg8::EpiMerge<false> E; E.P = (bf16_t*)(p.ws + O_MERGED); E.O8 = nullptr; E.Z = (const bf16_t*)(p.ws + O_Z); E.gcol0 = ZC_MG; E.scale = pg8::A8W8_INV;
          pg8::gemm_phase_fp8(lds, pg8::Gemm{D / 2, D / 2, D / 2}, S, E); }
        { pg8::PlainSched S; S.init(NT, D, G, c, p.ws + O_OB8, 512, p.ws + O_WBRB, 512);
          pg8::EpiMerge<true> E; E.P = (bf16_t*)(p.ws + O_MERGED); E.O8 = (unsigned char*)(p.ws + O_MG8); E.Z = (const bf16_t*)(p.ws + O_Z); E.gcol0 = ZC_MG + 2048; E.scale = pg8::A8W8_INV;
          pg8::gemm_phase_fp8(lds, pg8::Gemm{512, 512, 512}, S, E); }
        } SEAM(PH_MERGE) }
    if (PHON(PH_GOUT) && lo <= PH_GOUT && PH_GOUT < hi) { REP(PH_GOUT) {
        pg8::PlainSched S; S.init(NT, D, G, c, p.ws + O_MG8, D / 2, p.ws + O_WOUT, D / 2);
        pg8::EpiBf16 E; E.O = (bf16_t*)(p.ws + O_MO); E.ldc = D; E.scale = pg8::A8W8_INV;
        pg8::gemm_phase_fp8(lds, pg8::Gemm{D / 2, D / 2, D / 2}, S, E); } SEAM(PH_GOUT) }
    if (PHON(PH_POSTMIX) && lo <= PH_POSTMIX && PH_POSTMIX < hi) { REP(PH_POSTMIX) { phase_post_mix(p, smem, rep_ == 0); } SEAM(PH_POSTMIX) }
    if (PHON(PH_GATHER) && lo <= PH_GATHER && PH_GATHER < hi) { REP(PH_GATHER) { phase_moe_gather(p, smem); } SEAM(PH_GATHER) }
    if (PHON(PH_GU) && lo <= PH_GU && PH_GU < hi) { REP(PH_GU) {
        LAS int* tile_e = (LAS int*)(LAS char*)(smem + 131072); LAS int* pstart = tile_e + 320;
        const int mt = moe_tables(p, tile_e, pstart);
        pg8::MoeSched S; S.G = G; S.c = c; S.nN = 16; S.total = mt * 16; S.tile_e = tile_e; S.A = p.ws + O_H8; S.rows = (const int*)(p.ws + O_HS); S.W = p.ws + O_WGU; S.w_exp = (size_t)4096 * D;
        pg8::EpiGU E; E.O = (unsigned char*)(p.ws + O_ACT); E.bias = p.b_gate_up;
        pg8::gemm_phase_fp8<decltype(E), decltype(S), PG8_SP2, true>(lds, pg8::Gemm{D / 2, D / 2, D / 2, 64, 16384}, S, E); } SEAM(PH_GU) }
    if (PHON(PH_DN) && lo <= PH_DN && PH_DN < hi) { REP(PH_DN) {
        LAS int* tile_e = (LAS int*)(LAS char*)(smem + 131072); LAS int* pstart = tile_e + 320;
        const int mt = moe_tables(p, tile_e, pstart);
        pg8::MoeSched S; S.G = G; S.c = c; S.nN = 8; S.total = mt * 8; S.tile_e = tile_e; S.A = p.ws + O_ACT; S.W = p.ws + O_WDN; S.w_exp = (size_t)D * D;
        pg8::EpiDN E; E.O = (unsigned char*)(p.ws + O_YS); E.bias = p.b_down; E.slotw = (const float*)(p.ws + O_SLOTW);
        pg8::gemm_phase_fp8(lds, pg8::Gemm{D / 2, D / 2, D / 2, 64, 16384}, S, E); } SEAM(PH_DN) }
    if (PHON(PH_FINAL) && lo <= PH_FINAL && PH_FINAL < hi) { REP(PH_FINAL) { phase_final(p); } }
#undef SEAM
}

extern "C" void kernel_launch(void* const* d_in, const int* in_sizes, int n_in, void* d_out, int out_size, void* d_ws, size_t ws_size, hipStream_t stream) {
    static int grid = 0;
    if (grid == 0) {
        if (n_in != 33 || out_size != NT * D || ws_size < WS_END) { fprintf(stderr, "kernel_launch: unexpected shapes (n_in %d out %d ws %zu need %zu)\n", n_in, out_size, ws_size, (size_t)WS_END); grid = -1; return; }
        int dev = 0, cus = 0;
        if (hipGetDevice(&dev) != hipSuccess || hipDeviceGetAttribute(&cus, hipDeviceAttributeMultiprocessorCount, dev) != hipSuccess) { grid = -1; return; }
        if (hipFuncSetAttribute((const void*)mega, hipFuncAttributeMaxDynamicSharedMemorySize, LDS_BYTES) != hipSuccess) { fprintf(stderr, "kernel_launch: hipFuncSetAttribute failed\n"); grid = -1; return; }
        int per_cu = 0; (void)hipOccupancyMaxActiveBlocksPerMultiprocessor(&per_cu, (const void*)mega, 512, LDS_BYTES); (void)hipGetLastError();
        grid = cus;
    }
    if (grid < 0) return;
    Params p{};
    const float** pf = (const float**)&p;
    for (int i = 0; i < 33; ++i) pf[i] = (const float*)d_in[i];
    p.pos = (const int*)d_in[2];
    p.out = (float*)d_out; p.ws = (char*)d_ws;
    hipMemsetAsync(d_ws, 0, ZERO_BYTES, stream);
#ifdef MK_UNFUSED
    for (int ph = 0; ph < PH_END; ++ph) hipLaunchKernelGGL(mega, dim3(grid), dim3(512), LDS_BYTES, stream, p, ph, ph + 1);
#else
    hipLaunchKernelGGL(mega, dim3(grid), dim3(512), LDS_BYTES, stream, p, 0, (int)PH_END);
#endif
}
```
